# Optimizing an MI355X kernel written in HIP

```python
import math, functools
import jax, jax.numpy as jnp
from jax import lax
import numpy as np

D_MODEL = 1024
BATCH = 16
SEQ = 256
DEPTH = 4
DEC_BATCH = 2
DEC_SEQ = 1024
PAST_LEN = 512

GRID_W = 64
N_EVEN = (DEPTH + 1) // 2
N_ODD = DEPTH // 2
D_MIX = D_MODEL
FFN_DIM = 2816
N_MOD = 9
NORM_EPS = 1e-6
ROPE_THETA = 10000.0
Q_BLOCK = 128
FORGET_BIAS = 3.0
HA = 8
DH_A = 64
WIN_R = 8
WIN_C = 16
HB = 8
NOPE_B = 64
ROPE_B = 32
VDIM_B = 64
Q_RANK = 768
KV_RANK = 256
HC = 4
DQK_C = 64
DV_C = 128
CHUNK = 64
HD = 8
HKV_D = 2
DH_D = 64
E_IN = 3 * HA * DH_A + Q_RANK + KV_RANK + ROPE_B
O_IN = 2 * HC * DQK_C + 2 * HC * DV_C + 4 * HC + HD * DH_D + 2 * HKV_D * DH_D

kernel_name = 'hybrid_diffusion_prefix_step'


def rms_norm(x, g):
    xf = x.astype(jnp.float32)
    y = xf * lax.rsqrt(jnp.mean(xf * xf, axis=-1, keepdims=True) + NORM_EPS)
    return (y * g.astype(jnp.float32)).astype(x.dtype)


def split_cols(p, sizes):
    cuts = [int(s) for s in np.cumsum(sizes)[:-1]]
    return jnp.split(p, cuts, axis=-1)


def modulation(cond, w, b):
    return (jax.nn.silu(cond) @ w + b)[:, None, :]


def swiglu(h, w_in, w_out):
    g, u = jnp.split(h @ w_in, 2, axis=-1)
    return (jax.nn.silu(g) * u) @ w_out


def _rotate(x, pos):
    half = x.shape[-1] // 2
    freqs = ROPE_THETA ** (-jnp.arange(half, dtype=jnp.float32) / half)
    ang = pos.astype(jnp.float32)[:, None] * freqs[None, :]
    cos = jnp.cos(ang)[None, :, None, :]
    sin = jnp.sin(ang)[None, :, None, :]
    xf = x.astype(jnp.float32)
    x1, x2 = xf[..., :half], xf[..., half:]
    return jnp.concatenate([x1 * cos - x2 * sin, x2 * cos + x1 * sin], axis=-1).astype(x.dtype)


def axial_rope(x):
    t = jnp.arange(x.shape[1])
    d = x.shape[-1] // 2
    return jnp.concatenate([_rotate(x[..., :d], t // GRID_W), _rotate(x[..., d:], t % GRID_W)], axis=-1)


def block_attention(q, k, v):
    B, T, H, dk = q.shape
    Hk = k.shape[2]
    G = H // Hk
    dv = v.shape[-1]
    scale = dk ** -0.5
    nb = T // Q_BLOCK
    qb = q.reshape(B, nb, Q_BLOCK, Hk, G, dk).swapaxes(0, 1)

    def one_block(q_blk):
        s = jnp.einsum('bqngd,bsnd->bngqs', q_blk, k).astype(jnp.float32) * scale
        p = jax.nn.softmax(s, axis=-1).astype(v.dtype)
        return jnp.einsum('bngqs,bsnd->bqngd', p, v)

    o = lax.map(one_block, qb)
    return o.swapaxes(0, 1).reshape(B, T, H, dv)


def neighbourhood_attention(q, k, v, k_ctx, v_ctx, rpb):
    B, T, H, dh = q.shape
    rows = T // GRID_W
    wr = min(WIN_R, rows)
    scale = dh ** -0.5
    qg = q.reshape(B, rows, GRID_W, H, dh).swapaxes(0, 1)
    kg = k.reshape(B, rows, GRID_W, H, dh)
    vg = v.reshape(B, rows, GRID_W, H, dh)
    r = jnp.arange(rows)
    rs = jnp.clip(r - wr // 2, 0, rows - wr)
    col = jnp.arange(GRID_W)
    cs = jnp.clip(col - WIN_C // 2, 0, GRID_W - WIN_C)
    col_ok = (col[None, :] >= cs[:, None]) & (col[None, :] < cs[:, None] + WIN_C)
    co_idx = jnp.clip(col[None, :] - col[:, None], 1 - WIN_C, WIN_C - 1) + (WIN_C - 1)
    ro = jnp.arange(wr)
    n_band = wr * GRID_W

    def row_block(args):
        q_r, r_i, s_i = args
        kb = lax.dynamic_slice_in_dim(kg, s_i, wr, axis=1)
        vb = lax.dynamic_slice_in_dim(vg, s_i, wr, axis=1)
        ro_idx = s_i + ro - r_i + (WIN_R - 1)
        bias = rpb[:, ro_idx[None, :, None], co_idx[:, None, :]]
        s_band = jnp.einsum('bqhd,bwkhd->bhqwk', q_r, kb).astype(jnp.float32) * scale + bias.astype(jnp.float32)
        s_band = jnp.where(col_ok[:, None, :], s_band, -jnp.inf)
        s_ctx = jnp.einsum('bqhd,blhd->bhql', q_r, k_ctx).astype(jnp.float32) * scale
        s = jnp.concatenate([s_band.reshape(B, H, GRID_W, n_band), s_ctx], axis=-1)
        p = jax.nn.softmax(s, axis=-1).astype(v.dtype)
        p_band = p[..., :n_band].reshape(B, H, GRID_W, wr, GRID_W)
        return (jnp.einsum('bhqwk,bwkhd->bqhd', p_band, vb)
                + jnp.einsum('bhql,blhd->bqhd', p[..., n_band:], v_ctx))

    o = lax.map(row_block, (qg, r, rs))
    return o.swapaxes(0, 1).reshape(B, T, H, dh)


def mlstm_chunked(q, k, v, ig, lf, C0, n0, m0):
    f32 = jnp.float32
    B, T, H, dk = q.shape
    dv = v.shape[-1]
    nc = T // CHUNK

    def chunks(a):
        return a.astype(f32).reshape((B, nc, CHUNK) + a.shape[2:]).swapaxes(0, 1)

    causal = jnp.tril(jnp.ones((CHUNK, CHUNK), dtype=bool))

    def step(carry, inp):
        C, n, m = carry
        qc, kc, vc, ic, fc = inp
        b = jnp.cumsum(fc, axis=1).swapaxes(1, 2)
        it = ic.swapaxes(1, 2)
        log_d = jnp.where(causal, b[..., :, None] - b[..., None, :] + it[..., None, :], -jnp.inf)
        inter = b + m[..., None]
        m_t = jnp.maximum(inter, jnp.max(log_d, axis=-1))
        s = jnp.einsum('blhd,bshd->bhls', qc, kc) * jnp.exp(log_d - m_t[..., None])
        w0 = jnp.exp(inter - m_t)
        num = jnp.einsum('bhls,bshv->bhlv', s, vc) + w0[..., None] * jnp.einsum('blhd,bhvd->bhlv', qc, C)
        den = jnp.sum(s, axis=-1) + w0 * jnp.einsum('blhd,bhd->bhl', qc, n)
        h = num / jnp.maximum(jnp.abs(den), jnp.exp(-m_t))[..., None]
        b_last = b[..., -1]
        g = b_last[..., None] - b + it
        m_new = jnp.maximum(b_last + m, jnp.max(g, axis=-1))
        wg = jnp.exp(g - m_new[..., None])
        decay = jnp.exp(b_last + m - m_new)
        C_new = decay[..., None, None] * C + jnp.einsum('bhs,bshv,bshd->bhvd', wg, vc, kc)
        n_new = decay[..., None] * n + jnp.einsum('bhs,bshd->bhd', wg, kc)
        return (C_new, n_new, m_new), h.swapaxes(1, 2)

    xs = (chunks(q), chunks(k), chunks(v), chunks(ig), chunks(lf))
    (C, n, m), hs = lax.scan(step, (C0.astype(f32), n0.astype(f32), m0.astype(f32)), xs)
    return hs.swapaxes(0, 1).reshape(B, T, H, dv), C, n, m


def mlstm_bidir(q, k, v, gates, gate_bias, C0, n0, m0):
    g = gates.astype(jnp.float32) + gate_bias.astype(jnp.float32)
    flip = lambda a: jnp.flip(a, axis=1)
    h_f, C_f, n_f, m_f = mlstm_chunked(q, k, v, g[:, :, 0], jax.nn.log_sigmoid(g[:, :, 1]),
                                       C0[:, 0], n0[:, 0], m0[:, 0])
    h_b, C_b, n_b, m_b = mlstm_chunked(flip(q), flip(k), flip(v), flip(g[:, :, 2]),
                                       flip(jax.nn.log_sigmoid(g[:, :, 3])), C0[:, 1], n0[:, 1], m0[:, 1])
    return h_f + flip(h_b), jnp.stack([C_f, C_b], axis=1), jnp.stack([n_f, n_b], axis=1), jnp.stack([m_f, m_b], axis=1)


def mla_keys(k_nope, k_rope):
    B, S = k_nope.shape[0], k_nope.shape[1]
    return jnp.concatenate([k_nope, jnp.broadcast_to(k_rope, (B, S, HB, ROPE_B)).astype(k_nope.dtype)], axis=-1)


def even_mixer(h, w_in, w_out, rpb, q_norm, wq_up, kv_norm, wkv_up, ctx):
    B, T, _ = h.shape
    aq, ak, av, cq, ckv, krope = split_cols(h @ w_in, [HA * DH_A] * 3 + [Q_RANK, KV_RANK, ROPE_B])
    aq, ak, av = [t.reshape(B, T, HA, DH_A) for t in (aq, ak, av)]
    qb = (rms_norm(cq, q_norm) @ wq_up).reshape(B, T, HB, NOPE_B + ROPE_B)
    ckv = rms_norm(ckv, kv_norm)
    kvb = (ckv @ wkv_up).reshape(B, T, HB, NOPE_B + VDIM_B)
    if ctx is None:
        oa = block_attention(aq, ak, av)
        kb = mla_keys(kvb[..., :NOPE_B], krope[:, :, None, :])
        ob = block_attention(qb, kb, kvb[..., NOPE_B:])
        new = (ak, av, ckv, krope)
    else:
        c_ak, c_av, c_ckv, c_krope = ctx
        L = c_ckv.shape[1]
        oa = neighbourhood_attention(aq, ak, av, c_ak, c_av, rpb)
        qb = jnp.concatenate([qb[..., :NOPE_B], axial_rope(qb[..., NOPE_B:])], axis=-1)
        kb_lat = mla_keys(kvb[..., :NOPE_B], axial_rope(krope[:, :, None, :]))
        c_kv = (c_ckv @ wkv_up).reshape(B, L, HB, NOPE_B + VDIM_B)
        kb_ctx = mla_keys(c_kv[..., :NOPE_B], c_krope[:, :, None, :])
        ob = block_attention(qb, jnp.concatenate([kb_lat, kb_ctx], axis=1),
                             jnp.concatenate([kvb[..., NOPE_B:], c_kv[..., NOPE_B:]], axis=1))
        new = None
    out = jnp.concatenate([oa.reshape(B, T, HA * DH_A), ob.reshape(B, T, HB * VDIM_B)], axis=-1) @ w_out
    return out, new


def odd_mixer(h, w_in, w_out, gate_bias, out_norm, q_norm, k_norm, ctx):
    B, T, _ = h.shape
    cq, ck, cv, co, cg, dq, dk, dv = split_cols(
        h @ w_in, [HC * DQK_C, HC * DQK_C, HC * DV_C, HC * DV_C, 4 * HC, HD * DH_D, HKV_D * DH_D, HKV_D * DH_D])
    cq = cq.reshape(B, T, HC, DQK_C)
    ck = ck.reshape(B, T, HC, DQK_C) * (DQK_C ** -0.5)
    cv = cv.reshape(B, T, HC, DV_C)
    cg = cg.reshape(B, T, 4, HC)
    dq = rms_norm(dq.reshape(B, T, HD, DH_D), q_norm)
    dk = rms_norm(dk.reshape(B, T, HKV_D, DH_D), k_norm)
    dv = dv.reshape(B, T, HKV_D, DH_D)
    if ctx is None:
        C0 = jnp.zeros((B, 2, HC, DV_C, DQK_C), jnp.float32)
        n0 = jnp.zeros((B, 2, HC, DQK_C), jnp.float32)
        m0 = jnp.zeros((B, 2, HC), jnp.float32)
        od = block_attention(dq, dk, dv)
    else:
        c_dk, c_dv, C0, n0, m0 = ctx
        od = block_attention(axial_rope(dq), jnp.concatenate([axial_rope(dk), c_dk], axis=1),
                             jnp.concatenate([dv, c_dv], axis=1))
    hc, C, n, m = mlstm_bidir(cq, ck, cv, cg, gate_bias, C0, n0, m0)
    hc = (jax.nn.sigmoid(co.reshape(B, T, HC, DV_C).astype(jnp.float32)) * rms_norm(hc, out_norm)).astype(h.dtype)
    out = jnp.concatenate([hc.reshape(B, T, HC * DV_C), od.reshape(B, T, HD * DH_D)], axis=-1) @ w_out
    new = (dk, dv, C, n, m) if ctx is None else None
    return out, new


def layer(x, mod, norm_g, ffn_in, ffn_out, mixer):
    sh1, sc1, g1, sh2, sc2, g2, sh3, sc3, g3 = jnp.split(mod, N_MOD, axis=-1)
    x = x + 0.5 * g1 * swiglu(rms_norm(x, norm_g[0]) * (1 + sc1) + sh1, ffn_in[0], ffn_out[0])
    mix, new = mixer(rms_norm(x, norm_g[1]) * (1 + sc2) + sh2)
    x = x + g2 * mix
    x = x + 0.5 * g3 * swiglu(rms_norm(x, norm_g[2]) * (1 + sc3) + sh3, ffn_in[1], ffn_out[1])
    return x, new


def setup_inputs(seed: int = 0) -> dict:
    key = jax.random.key(seed)
    ks = iter(jax.random.split(key, 40))

    def nrm(shape, s=1.0):
        return s * jax.random.normal(next(ks), shape, jnp.float32)

    D = D_MODEL
    gate_center = jnp.array([0.0, FORGET_BIAS, 0.0, FORGET_BIAS], jnp.float32)[None, :, None]
    return {
        'x_prompt': nrm((BATCH, SEQ, D)),
        'x_sample': nrm((DEC_BATCH, DEC_SEQ, D)),
        'cache_a_k': nrm((DEC_BATCH, N_EVEN, PAST_LEN, HA, DH_A)),
        'cache_a_v': nrm((DEC_BATCH, N_EVEN, PAST_LEN, HA, DH_A)),
        'cache_b_ckv': nrm((DEC_BATCH, N_EVEN, PAST_LEN, KV_RANK)),
        'cache_b_krope': nrm((DEC_BATCH, N_EVEN, PAST_LEN, ROPE_B)),
        'cache_d_k': nrm((DEC_BATCH, N_ODD, PAST_LEN, HKV_D, DH_D)),
        'cache_d_v': nrm((DEC_BATCH, N_ODD, PAST_LEN, HKV_D, DH_D)),
        'state_c_C': nrm((DEC_BATCH, N_ODD, 2, HC, DV_C, DQK_C), 0.1),
        'state_c_n': nrm((DEC_BATCH, N_ODD, 2, HC, DQK_C), 0.1),
        'state_c_m': nrm((DEC_BATCH, N_ODD, 2, HC), 0.5),
        'c': nrm((DEC_BATCH, D)),
        'c_ctx': nrm((D,)),
        'w_mod': nrm((DEPTH, D, N_MOD * D), 0.5 * D ** -0.5),
        'b_mod': nrm((DEPTH, N_MOD * D), 0.01),
        'norm_g': 1.0 + nrm((DEPTH, 3, D), 0.02),
        'ffn_in': nrm((DEPTH, 2, D, 2 * FFN_DIM), D ** -0.5),
        'ffn_out': nrm((DEPTH, 2, FFN_DIM, D), FFN_DIM ** -0.5),
        'w_in_even': nrm((N_EVEN, D, E_IN), D ** -0.5),
        'w_in_odd': nrm((N_ODD, D, O_IN), D ** -0.5),
        'w_out': nrm((DEPTH, D_MIX, D), D_MIX ** -0.5),
        'a_rpb': nrm((N_EVEN, HA, 2 * WIN_R - 1, 2 * WIN_C - 1), 0.1),
        'b_q_norm': 1.0 + nrm((N_EVEN, Q_RANK), 0.02),
        'b_wq_up': nrm((N_EVEN, Q_RANK, HB * (NOPE_B + ROPE_B)), Q_RANK ** -0.5),
        'b_kv_norm': 1.0 + nrm((N_EVEN, KV_RANK), 0.02),
        'b_wkv_up': nrm((N_EVEN, KV_RANK, HB * (NOPE_B + VDIM_B)), KV_RANK ** -0.5),
        'c_gate_bias': gate_center + nrm((N_ODD, 4, HC), 0.1),
        'c_out_norm': 1.0 + nrm((N_ODD, HC, DV_C), 0.02),
        'd_q_norm': 1.0 + nrm((N_ODD, DH_D), 0.02),
        'd_k_norm': 1.0 + nrm((N_ODD, DH_D), 0.02),
        'final_norm': 1.0 + nrm((D,), 0.02),
    }


def reference(x_prompt, x_sample, cache_a_k, cache_a_v, cache_b_ckv, cache_b_krope, cache_d_k, cache_d_v,
              state_c_C, state_c_n, state_c_m, c, c_ctx, w_mod, b_mod, norm_g, ffn_in, ffn_out,
              w_in_even, w_in_odd, w_out, a_rpb, b_q_norm, b_wq_up, b_kv_norm, b_wkv_up,
              c_gate_bias, c_out_norm, d_q_norm, d_k_norm, final_norm):
    xp = x_prompt
    xs = x_sample
    even_new = []
    odd_new = []
    for l in range(DEPTH):
        m_ctx = modulation(c_ctx[None, :], w_mod[l], b_mod[l])
        m_lat = modulation(c, w_mod[l], b_mod[l])
        if l % 2 == 0:
            e = l // 2
            mixer = functools.partial(even_mixer, w_in=w_in_even[e], w_out=w_out[l], rpb=a_rpb[e],
                                      q_norm=b_q_norm[e], wq_up=b_wq_up[e], kv_norm=b_kv_norm[e],
                                      wkv_up=b_wkv_up[e])
            ctx_cache = (cache_a_k[:, e], cache_a_v[:, e], cache_b_ckv[:, e], cache_b_krope[:, e])
            xp, new = layer(xp, m_ctx, norm_g[l], ffn_in[l], ffn_out[l], functools.partial(mixer, ctx=None))
            xs, _ = layer(xs, m_lat, norm_g[l], ffn_in[l], ffn_out[l], functools.partial(mixer, ctx=ctx_cache))
            even_new.append(new)
        else:
            o = l // 2
            mixer = functools.partial(odd_mixer, w_in=w_in_odd[o], w_out=w_out[l], gate_bias=c_gate_bias[o],
                                      out_norm=c_out_norm[o], q_norm=d_q_norm[o], k_norm=d_k_norm[o])
            ctx_cache = (cache_d_k[:, o], cache_d_v[:, o], state_c_C[:, o], state_c_n[:, o], state_c_m[:, o])
            xp, new = layer(xp, m_ctx, norm_g[l], ffn_in[l], ffn_out[l], functools.partial(mixer, ctx=None))
            xs, _ = layer(xs, m_lat, norm_g[l], ffn_in[l], ffn_out[l], functools.partial(mixer, ctx=ctx_cache))
            odd_new.append(new)
    y_prompt = rms_norm(xp, final_norm)
    y_sample = rms_norm(xs, final_norm)
    new_a_k = jnp.stack([t[0] for t in even_new], axis=1)
    new_a_v = jnp.stack([t[1] for t in even_new], axis=1)
    new_b_ckv = jnp.stack([t[2] for t in even_new], axis=1)
    new_b_krope = jnp.stack([t[3] for t in even_new], axis=1)
    new_d_k = jnp.stack([t[0] for t in odd_new], axis=1)
    new_d_v = jnp.stack([t[1] for t in odd_new], axis=1)
    new_c_C = jnp.stack([t[2] for t in odd_new], axis=1)
    new_c_n = jnp.stack([t[3] for t in odd_new], axis=1)
    new_c_m = jnp.stack([t[4] for t in odd_new], axis=1)
    return (y_prompt, y_sample, new_a_k, new_a_v, new_b_ckv, new_b_krope, new_d_k, new_d_v, new_c_C, new_c_n, new_c_m)
```

```cpp
#include <hip/hip_runtime.h>
#include <hip/hip_cooperative_groups.h>
#include <cstdio>
#include <cstdint>
namespace cg = cooperative_groups;

#ifndef MULTI
#define MULTI 0
#endif

typedef unsigned short u16;
typedef __attribute__((ext_vector_type(8))) short bf16x8;
typedef __attribute__((ext_vector_type(4))) short s16x4;
typedef __attribute__((ext_vector_type(4))) float f32x4;
typedef __attribute__((ext_vector_type(4))) unsigned int u32x4;

#define NTOK 6144
#define NPR 4096
#define LDS_BYTES 77824
#define NPHASE 54
#define EPS 1e-6f

struct Params {
  const float *x_prompt, *x_sample, *cache_a_k, *cache_a_v, *cache_b_ckv, *cache_b_krope, *cache_d_k, *cache_d_v;
  const float *state_C, *state_n, *state_m, *c, *c_ctx, *w_mod, *b_mod, *norm_g, *ffn_in, *ffn_out;
  const float *w_in_even, *w_in_odd, *w_out, *a_rpb, *b_q_norm, *b_wq_up, *b_kv_norm, *b_wkv_up;
  const float *c_gate_bias, *c_out_norm, *d_q_norm, *d_k_norm, *final_norm;
  float* out;
  u16 *wt_ffn_in, *wt_ffn_out, *wt_in_e, *wt_in_o, *wt_out, *wt_qup, *wt_kvup;
  float *mod, *x, *proj, *qb, *dC, *dn, *dm, *cp, *np, *mp;
  u16 *xn, *h, *mix, *qa, *ka, *kactx, *vta_p, *vta_s, *kb, *vtb_p, *vtb_s, *cqn, *ckvn, *cctxn, *kd, *vtd_p, *vtd_s;
  unsigned* bar;
  int ph0, ph1;
};

typedef const __attribute__((address_space(4))) Params& PRM;
#define O_YP 0
#define O_YS 4194304
#define O_AK 6291456
#define O_AV 10485760
#define O_CKV 14680064
#define O_KR 16777216
#define O_DK 17039360
#define O_DV 18087936
#define O_CC 19136512
#define O_CN 21233664
#define O_CM 21250048

__device__ __forceinline__ int get_tid() { int t = threadIdx.x; asm volatile("" : "+v"(t)); return t; }
__device__ __forceinline__ int get_bid() { int t = blockIdx.x; asm volatile("" : "+s"(t)); return t; }
typedef __attribute__((ext_vector_type(2))) __bf16 bf16x2_t;
typedef __attribute__((ext_vector_type(2))) float f32x2_t;
__device__ __forceinline__ unsigned pack2(float a, float b) {
  f32x2_t v = {a, b};
  bf16x2_t r = __builtin_convertvector(v, bf16x2_t);
  return __builtin_bit_cast(unsigned, r);
}
__device__ __forceinline__ u16 f2bf(float f) { return (u16)(pack2(f, 0.f) & 0xffffu); }
__device__ __forceinline__ float wsum(float v) {
#pragma unroll
  for (int o = 32; o; o >>= 1) v += __shfl_xor(v, o);
  return v;
}
__device__ __forceinline__ float wmaxr(float v) {
#pragma unroll
  for (int o = 32; o; o >>= 1) v = fmaxf(v, __shfl_xor(v, o));
  return v;
}
__device__ __forceinline__ float silu_f(float x) { return x / (1.f + __expf(-x)); }
__device__ __forceinline__ float sigmoid_f(float x) { return 1.f / (1.f + __expf(-x)); }
__device__ __forceinline__ float logsig_f(float x) { return fminf(x, 0.f) - __logf(1.f + __expf(-fabsf(x))); }
__device__ __forceinline__ void sincos_r(float a, float& s, float& c) {
  float n = rintf(a * 0.15915494309f);
  float r = fmaf(-n, 6.2831855f, a);
  r = fmaf(-n, -1.7484555e-7f, r);
  s = __sinf(r); c = __cosf(r);
}
__device__ __forceinline__ int grp_of(int m) { return m < NPR ? 0 : 1 + ((m - NPR) >> 10); }
__device__ __forceinline__ int keyrow(int m) { return m < NPR ? m : NPR + ((m - NPR) >> 10) * 1536 + ((m - NPR) & 1023); }
__device__ __forceinline__ f32x4 mfma16(bf16x8 a, bf16x8 b, f32x4 c) { return __builtin_amdgcn_mfma_f32_16x16x32_bf16(a, b, c, 0, 0, 0); }

#define XB_TMO      128
#define XB_XCNT(j)  (256  + 64 * (j))
#define XB_XSUB(j)  (1280 + 64 * (j))
#define XB_XGEN(j)  (2304 + 64 * (j))
#define XB_TOP      3328
#define XB_TOPGEN   3392
#define XCD_BAR_WORDS 3456
#define XB_SPIN_CAP (1u << 18)
#define LAS __attribute__((address_space(3)))

__device__ __forceinline__ unsigned xb_ld(unsigned* p)              { return __hip_atomic_load(p, __ATOMIC_RELAXED, __HIP_MEMORY_SCOPE_AGENT); }
__device__ __forceinline__ unsigned xb_add(unsigned* p, unsigned v) { return __hip_atomic_fetch_add(p, v, __ATOMIC_RELAXED, __HIP_MEMORY_SCOPE_AGENT); }
__device__ __forceinline__ unsigned xb_xcc_id() { return (unsigned)__builtin_amdgcn_s_getreg((3 << 11) | 20) & 0xFu; }
#define XB_SPIN(cond, bar) do { unsigned _sp = 0; while (cond) { __builtin_amdgcn_s_sleep(1); \
    if ((++_sp & 255u) == 0u) { if (xb_ld(&(bar)[XB_TMO])) break; if (_sp > XB_SPIN_CAP) { atomicAdd(&(bar)[XB_TMO], 1u); break; } } } } while (0)

struct XcdBarrier {
    unsigned* bar; unsigned x;
    volatile LAS unsigned* st;
};

__device__ __forceinline__ XcdBarrier xcd_barrier_post(unsigned* bar, volatile LAS unsigned* st) {
    XcdBarrier b; b.bar = bar; b.x = xb_xcc_id(); b.st = st;
    if (threadIdx.x == 0) (void)xb_add(&bar[XB_XCNT(b.x)], 1u);
    return b;
}
__device__ __forceinline__ void xcd_barrier_complete(unsigned* bar, unsigned x, unsigned& nloc, unsigned& nx) {
    const unsigned G = gridDim.x * gridDim.y * gridDim.z;
    unsigned sum, cnt, mine, sp = 0u;
    for (;;) {
        sum = 0u; cnt = 0u; mine = 0u;
#pragma unroll
        for (unsigned j = 0; j < 16; ++j) { const unsigned c = xb_ld(&bar[XB_XCNT(j)]); sum += c; cnt += (c > 0u) ? 1u : 0u; mine = (j == x) ? c : mine; }
        if (sum == G) break;
        __builtin_amdgcn_s_sleep(1);
        if ((++sp & 255u) == 0u) { if (xb_ld(&bar[XB_TMO])) break; if (sp > XB_SPIN_CAP) { atomicAdd(&bar[XB_TMO], 1u); break; } }
    }
    nloc = mine > 0u ? mine : 1u; nx = cnt > 0u ? cnt : 1u;
}

__device__ __forceinline__ void xcd_barrier(const XcdBarrier& b) {
    asm volatile("s_waitcnt vmcnt(0)" ::: "memory");
    __syncthreads();
    if (threadIdx.x == 0) {
        unsigned* bar = b.bar;
        __builtin_amdgcn_s_waitcnt(0);
        unsigned nloc = b.st[0], nx = b.st[1];
        if (nloc == 0u) { xcd_barrier_complete(bar, b.x, nloc, nx); b.st[0] = nloc; b.st[1] = nx; }
        const unsigned old = xb_add(&bar[XB_XSUB(b.x)], 1u);
        const unsigned gen = old / nloc;
        if (old + 1u == (gen + 1u) * nloc) {
            __builtin_amdgcn_fence(__ATOMIC_RELEASE, "agent");
            asm volatile("s_waitcnt vmcnt(0)" ::: "memory");
            const unsigned og = xb_add(&bar[XB_TOP], 1u);
            const unsigned tg = og / nx;
            if (og + 1u == (tg + 1u) * nx) xb_add(&bar[XB_TOPGEN], 1u);
            else XB_SPIN(xb_ld(&bar[XB_TOPGEN]) == tg, bar);
            __builtin_amdgcn_fence(__ATOMIC_ACQUIRE, "agent");
            xb_add(&bar[XB_XGEN(b.x)], 1u);
            asm volatile("s_waitcnt vmcnt(0)" ::: "memory");
        } else {
            XB_SPIN(xb_ld(&bar[XB_XGEN(b.x)]) == gen, bar);
            __builtin_amdgcn_fence(__ATOMIC_ACQUIRE, "agent");
            asm volatile("s_waitcnt vmcnt(0)" ::: "memory");
        }
    }
    __syncthreads();
}


__device__ __forceinline__ void conv_tile(const float* __restrict__ src, int K, int N, int perm, u16* __restrict__ dst, int kt2, int nt, float* tile) {
  const int tid = get_tid();
  {
    const int c4 = tid & 15, kr = tid >> 4;
    const int n = nt * 64 + c4 * 4;
    const bool valid = n < N;
    int col = n;
    if (perm) { int G = n >> 4, w = n & 15, sub = w >> 2; col = ((sub & 1) ? 2816 : 0) + G * 8 + (sub >> 1) * 4 + (w & 3); }
    float4 v[8];
#pragma unroll
    for (int i = 0; i < 8; ++i) {
      int kk = kr + 16 * i;
      v[i] = valid ? *(const float4*)(src + (size_t)(kt2 * 128 + kk) * N + col) : make_float4(0.f, 0.f, 0.f, 0.f);
    }
#pragma unroll
    for (int i = 0; i < 8; ++i) {
      int kk = kr + 16 * i;
      float* t = tile + (kk >> 6) * 4160 + (kk & 63) * 65 + c4 * 4;
      t[0] = v[i].x; t[1] = v[i].y; t[2] = v[i].z; t[3] = v[i].w;
    }
  }
  __syncthreads();
  {
    const int k8 = (tid & 7) * 8;
#pragma unroll
    for (int hh = 0; hh < 2; ++hh)
#pragma unroll
      for (int i = 0; i < 2; ++i) {
        int nn2 = (tid >> 3) + 32 * i;
        float v[8];
#pragma unroll
        for (int e = 0; e < 8; ++e) v[e] = tile[hh * 4160 + (k8 + e) * 65 + nn2];
        uint4 o; o.x = pack2(v[0], v[1]); o.y = pack2(v[2], v[3]); o.z = pack2(v[4], v[5]); o.w = pack2(v[6], v[7]);
        *(uint4*)(dst + (size_t)(nt * 64 + nn2) * K + kt2 * 128 + hh * 64 + k8) = o;
      }
  }
  __syncthreads();
}

__device__ __forceinline__ void mod_task(PRM p, int t, float* sm) {
  const int l = t / 144, cb = t % 144, tid = get_tid();
  float* sc = sm;
  float* red = sm + 3072;
  for (int i = tid; i < 3072; i += 256) {
    int g = i >> 10, k = i & 1023;
    float v = g == 0 ? p.c_ctx[k] : p.c[(g - 1) * 1024 + k];
    sc[i] = silu_f(v);
  }
  __syncthreads();
  const int c4 = tid & 15, kg = tid >> 4;
  const float* w = p.w_mod + (size_t)l * 1024 * 9216 + (size_t)(kg * 64) * 9216 + cb * 64 + c4 * 4;
  float a[3][4];
#pragma unroll
  for (int g = 0; g < 3; ++g)
#pragma unroll
    for (int q = 0; q < 4; ++q) a[g][q] = 0.f;
  for (int k = 0; k < 64; k += 8) {
    float4 wv[8];
#pragma unroll
    for (int e = 0; e < 8; ++e) wv[e] = *(const float4*)(w + (size_t)(k + e) * 9216);
#pragma unroll
    for (int e = 0; e < 8; ++e) {
      int kk = kg * 64 + k + e;
#pragma unroll
      for (int g = 0; g < 3; ++g) {
        float sv = sc[g * 1024 + kk];
        a[g][0] = fmaf(sv, wv[e].x, a[g][0]); a[g][1] = fmaf(sv, wv[e].y, a[g][1]);
        a[g][2] = fmaf(sv, wv[e].z, a[g][2]); a[g][3] = fmaf(sv, wv[e].w, a[g][3]);
      }
    }
  }
#pragma unroll
  for (int g = 0; g < 3; ++g)
#pragma unroll
    for (int q = 0; q < 4; ++q) red[(kg * 3 + g) * 64 + c4 * 4 + q] = a[g][q];
  __syncthreads();
  if (tid < 192) {
    int g = tid >> 6, c2 = tid & 63;
    float s = 0.f;
#pragma unroll
    for (int q = 0; q < 16; ++q) s += red[(q * 3 + g) * 64 + c2];
    int j = cb * 64 + c2;
    p.mod[(size_t)(l * 3 + g) * 9216 + j] = s + p.b_mod[l * 9216 + j];
  }
  __syncthreads();
}

__device__ __forceinline__ int conv_layer_count(int l) { return (l & 1) ? 2544 : 2680; }
__device__ __forceinline__ void conv_layer_task(PRM p, int l, int u, float* sm) {
  const float* src; u16* dst; int K, N, Npad, perm = 0, tp, mat0;
  const int eo = l >> 1;
  const int nin = (l & 1) ? 304 : 336;
  if (u < 1408) { K = 1024; N = 5632; Npad = 5632; perm = 1; tp = 704; src = p.ffn_in; dst = p.wt_ffn_in; mat0 = l * 2; }
  else if ((u -= 1408) < 704) { K = 2816; N = 1024; Npad = 1024; tp = 352; src = p.ffn_out; dst = p.wt_ffn_out; mat0 = l * 2; }
  else if ((u -= 704) < nin) {
    if (l & 1) { K = 1024; N = 2320; Npad = 2432; tp = 304; src = p.w_in_odd; dst = p.wt_in_o; mat0 = eo; }
    else { K = 1024; N = 2592; Npad = 2688; tp = 336; src = p.w_in_even; dst = p.wt_in_e; mat0 = eo; }
  }
  else if ((u -= nin) < 128) { K = 1024; N = 1024; Npad = 1024; tp = 128; src = p.w_out; dst = p.wt_out; mat0 = l; }
  else if ((u -= 128) < 72) { K = 768; N = 768; Npad = 768; tp = 72; src = p.b_wq_up; dst = p.wt_qup; mat0 = eo; }
  else { u -= 72; K = 256; N = 1024; Npad = 1024; tp = 32; src = p.b_wkv_up; dst = p.wt_kvup; mat0 = eo; }
  int mat = mat0 + u / tp, r = u % tp;
  int nkt = K / 128;
  int kt = r % nkt, nt = r / nkt;
  conv_tile(src + (size_t)mat * K * N, K, N, perm, dst + (size_t)mat * Npad * K, kt, nt, sm);
}

__device__ __forceinline__ void phase0(PRM p, char* smem) {
  float* sm = (float*)smem;
  const int NMOD = 144, NCOPY = 1536, NCONV = 2680;
  const int total = NMOD + NCOPY + NCONV;
  for (int t = get_bid(); t < total; t += gridDim.x) {
    if (t < NMOD) { mod_task(p, t, sm); continue; }
    int u = t - NMOD;
    if (u < NCOPY) {
      const int tid = get_tid();
#pragma unroll
      for (int i = 0; i < 4; ++i) {
        size_t idx = ((size_t)u * 1024 + i * 256 + tid);
        const float4* src = idx < (size_t)NPR * 256 ? (const float4*)p.x_prompt + idx : (const float4*)p.x_sample + (idx - (size_t)NPR * 256);
        ((float4*)p.x)[idx] = *src;
      }
      continue;
    }
    conv_layer_task(p, 0, u - NCOPY, sm);
  }
}

__device__ __forceinline__ void norm_phase(PRM p, int l, int which) {
  const int lane = get_tid() & 63, wave = get_tid() >> 6;
  const int nrows_wave = NTOK / 4;
  const int stride = gridDim.x;
  for (int t0 = get_bid(); t0 < nrows_wave; t0 += 3 * stride) {
    float4 v[3][4];
    float ss[3];
#pragma unroll
    for (int k = 0; k < 3; ++k) {
      const int t = t0 + k * stride;
      if (t < nrows_wave) {
        const float4* xr = (const float4*)(p.x + (size_t)(t * 4 + wave) * 1024);
#pragma unroll
        for (int i = 0; i < 4; ++i) v[k][i] = xr[i * 64 + lane];
      }
    }
#pragma unroll
    for (int k = 0; k < 3; ++k) {
      float a = 0.f;
#pragma unroll
      for (int i = 0; i < 4; ++i) a += v[k][i].x * v[k][i].x + v[k][i].y * v[k][i].y + v[k][i].z * v[k][i].z + v[k][i].w * v[k][i].w;
      ss[k] = wsum(a);
    }
#pragma unroll
    for (int k = 0; k < 3; ++k) {
      const int t = t0 + k * stride;
      if (t >= nrows_wave) continue;
      const int m = t * 4 + wave;
      const float r = rsqrtf(ss[k] * (1.f / 1024.f) + EPS);
      if (which == 3) {
        float4* o = (float4*)(p.out + (size_t)m * 1024);
#pragma unroll
        for (int i = 0; i < 4; ++i) {
          float4 g = ((const float4*)p.final_norm)[i * 64 + lane];
          float4 y; y.x = v[k][i].x * r * g.x; y.y = v[k][i].y * r * g.y; y.z = v[k][i].z * r * g.z; y.w = v[k][i].w * r * g.w;
          o[i * 64 + lane] = y;
        }
      } else {
        const float* md = p.mod + (size_t)(l * 3 + grp_of(m)) * 9216 + which * 3072;
        const float4* sh = (const float4*)md;
        const float4* sc = (const float4*)(md + 1024);
        const float4* gg = (const float4*)(p.norm_g + (size_t)(l * 3 + which) * 1024);
#pragma unroll
        for (int i = 0; i < 4; ++i) {
          float4 g = gg[i * 64 + lane], s = sc[i * 64 + lane], b = sh[i * 64 + lane];
          float y0 = v[k][i].x * r * g.x * (1.f + s.x) + b.x;
          float y1 = v[k][i].y * r * g.y * (1.f + s.y) + b.y;
          float y2 = v[k][i].z * r * g.z * (1.f + s.z) + b.z;
          float y3 = v[k][i].w * r * g.w * (1.f + s.w) + b.w;
          uint2 o; o.x = pack2(y0, y1); o.y = pack2(y2, y3);
          *(uint2*)(p.xn + (size_t)m * 1024 + (i * 64 + lane) * 4) = o;
        }
      }
    }
  }
}

struct EpiP {
  float* C; int ldc;
  const float* gate;
  u16* H;
  u16 *kb, *vtp, *vts; int ctx;
};
enum { EPI_STORE = 0, EPI_RESID = 1, EPI_SWIGLU = 2, EPI_KVUP = 3 };

template <int FI, int FJ, bool SWAP>
__device__ __forceinline__ void g_compute(f32x4 (&acc)[FI][FJ], const u16* Ac, const u16* Bc, int q4, int rsw) {
  __builtin_amdgcn_s_setprio(1);
#pragma unroll
  for (int ks = 0; ks < 2; ++ks) {
    bf16x8 a[FI];
    const int co = ((ks * 4 + q4) ^ rsw) << 3;
#pragma unroll
    for (int i = 0; i < FI; ++i) a[i] = *(const bf16x8*)(Ac + i * 1024 + co);
#pragma unroll
    for (int j0 = 0; j0 < FJ; j0 += 4) {
      bf16x8 b[4];
#pragma unroll
      for (int j = 0; j < 4; ++j) if (j0 + j < FJ) b[j] = *(const bf16x8*)(Bc + (j0 + j) * 1024 + co);
#pragma unroll
      for (int j = 0; j < 4; ++j)
        if (j0 + j < FJ) {
#pragma unroll
          for (int i = 0; i < FI; ++i) acc[i][j0 + j] = SWAP ? mfma16(b[j], a[i], acc[i][j0 + j]) : mfma16(a[i], b[j], acc[i][j0 + j]);
        }
    }
  }
  __builtin_amdgcn_s_setprio(0);
}

template <int EPI, int WMW, int WNW, int FI, int FJ>
__device__ __forceinline__ void gemm_tile(const u16* __restrict__ A, const u16* __restrict__ Wt, int K, int tm, int tn, const EpiP& e, char* smem) {
  constexpr int BM = WMW * FI * 16, BN = WNW * FJ * 16;
  constexpr int NA = (BM * 8 + 255) / 256, NB = (BN * 8 + 255) / 256;
  constexpr int BUFSZ = (BM + BN) * 64;
  u16* As = (u16*)smem;
  u16* Bs = As + BM * 64;
  const int tid = get_tid(), lane = tid & 63, wave = tid >> 6, wm = wave / WNW, wn = wave % WNW, l15 = lane & 15, q4 = lane >> 4;
  const int lr = tid >> 3, lc = tid & 7;
  const u16* Ag = A + (size_t)(tm * BM + lr) * K + lc * 8;
  const u16* Bg = Wt + (size_t)(tn * BN + lr) * K + lc * 8;
  const int st_off = lr * 64 + ((lc ^ ((lr >> 1) & 7)) << 3);
  const int rsw = (l15 >> 1) & 7;
  const int a_row = (wm * FI * 16 + l15) * 64, b_row = (wn * FJ * 16 + l15) * 64;
  u32x4 ra0[NA], rb0[NB], ra1[NA], rb1[NB];
  f32x4 acc[FI][FJ];
#pragma unroll
  for (int i = 0; i < FI; ++i)
#pragma unroll
    for (int j = 0; j < FJ; ++j) acc[i][j] = (f32x4){0.f, 0.f, 0.f, 0.f};
  const int nk = K >> 6;
#define GL(RA, RB, KT) { _Pragma("unroll") for (int i = 0; i < NA; ++i) if ((i + 1) * 32 <= BM || lr + 32 * i < BM) RA[i] = *(const u32x4*)(Ag + (size_t)i * 32 * K + (KT) * 64); \
                         _Pragma("unroll") for (int i = 0; i < NB; ++i) if ((i + 1) * 32 <= BN || lr + 32 * i < BN) RB[i] = *(const u32x4*)(Bg + (size_t)i * 32 * K + (KT) * 64); }
#define GS(RA, RB, BUF) { _Pragma("unroll") for (int i = 0; i < NA; ++i) if ((i + 1) * 32 <= BM || lr + 32 * i < BM) *(u32x4*)(As + (BUF) * BUFSZ + st_off + i * 2048) = RA[i]; \
                          _Pragma("unroll") for (int i = 0; i < NB; ++i) if ((i + 1) * 32 <= BN || lr + 32 * i < BN) *(u32x4*)(Bs + (BUF) * BUFSZ + st_off + i * 2048) = RB[i]; }
  GL(ra0, rb0, 0);
  if (nk > 1) GL(ra1, rb1, 1);
  GS(ra0, rb0, 0);
  __syncthreads();
  for (int kt = 0; kt < nk; kt += 2) {
    if (kt + 2 < nk) GL(ra0, rb0, kt + 2);
    g_compute<FI, FJ, (EPI != EPI_KVUP)>(acc, As + a_row, Bs + b_row, q4, rsw);
    if (kt + 1 < nk) GS(ra1, rb1, 1);
    __syncthreads();
    if (kt + 1 >= nk) break;
    if (kt + 3 < nk) GL(ra1, rb1, kt + 3);
    g_compute<FI, FJ, (EPI != EPI_KVUP)>(acc, As + BUFSZ + a_row, Bs + BUFSZ + b_row, q4, rsw);
    if (kt + 2 < nk) GS(ra0, rb0, 0);
    __syncthreads();
  }
#undef GL
#undef GS
  const int mb = tm * BM + wm * FI * 16 + q4 * 4;
  const int nb = tn * BN + wn * FJ * 16;
  const int mrow = tm * BM + wm * FI * 16 + l15;
  if (EPI == EPI_STORE) {
#pragma unroll
    for (int i = 0; i < FI; ++i)
#pragma unroll
      for (int j = 0; j < FJ; ++j) *(f32x4*)(e.C + (size_t)(mrow + i * 16) * e.ldc + nb + j * 16 + q4 * 4) = acc[i][j];
  } else if (EPI == EPI_RESID) {
    const float cf = e.ldc ? 0.5f : 1.0f;
    const f32x4 cfv = {cf, cf, cf, cf};
#pragma unroll
    for (int i = 0; i < FI; ++i) {
      const int m = mrow + i * 16;
      const float* gt = e.gate + (size_t)grp_of(m) * 9216;
#pragma unroll
      for (int j = 0; j < FJ; ++j) {
        const int n = nb + j * 16 + q4 * 4;
        f32x4 g = *(const f32x4*)(gt + n);
        f32x4* px = (f32x4*)(e.C + (size_t)m * 1024 + n);
        f32x4 xv = *px;
        xv += g * cfv * acc[i][j];
        *px = xv;
      }
    }
  } else if (EPI == EPI_SWIGLU) {
    const bool odd = (q4 & 1) != 0;
#pragma unroll
    for (int j = 0; j < FJ; ++j) {
      const int hj = ((nb >> 4) + j) * 8 + (q4 >> 1) * 4;
#pragma unroll
      for (int i2 = 0; i2 < FI / 2; ++i2) {
        float hv[4];
#pragma unroll
        for (int r = 0; r < 4; ++r) {
          float send = odd ? acc[2 * i2][j][r] : acc[2 * i2 + 1][j][r];
          float recv = __shfl_xor(send, 16);
          float g = odd ? recv : acc[2 * i2][j][r];
          float u = odd ? acc[2 * i2 + 1][j][r] : recv;
          hv[r] = silu_f(g) * u;
        }
        const int m = mrow + (2 * i2 + (odd ? 1 : 0)) * 16;
        uint2 o; o.x = pack2(hv[0], hv[1]); o.y = pack2(hv[2], hv[3]);
        *(uint2*)(e.H + (size_t)m * 2816 + hj) = o;
      }
    }
  } else if (EPI == EPI_KVUP) {
#pragma unroll
    for (int j = 0; j < FJ; ++j) {
      const int n0 = nb + j * 16;
      const int hh = n0 >> 7, wb = n0 & 127;
#pragma unroll
      for (int i = 0; i < FI; ++i) {
        const int m0 = mb + i * 16;
        int krow; u16* vt;
        if (e.ctx) {
          int b = m0 >> 9, key = m0 & 511;
          krow = NPR + b * 1536 + 1024 + key;
          vt = e.vts + (size_t)((b * 8 + hh) * 64) * 1536 + 1024 + key;
        } else if (m0 < NPR) {
          int b = m0 >> 8, t = m0 & 255;
          krow = m0;
          vt = e.vtp + (size_t)((b * 8 + hh) * 64) * 256 + t;
        } else {
          int s = m0 - NPR, b = s >> 10, t = s & 1023;
          krow = NPR + b * 1536 + t;
          vt = e.vts + (size_t)((b * 8 + hh) * 64) * 1536 + t;
        }
        if (wb < 64) {
#pragma unroll
          for (int r = 0; r < 4; ++r) e.kb[(size_t)(krow + r) * 768 + hh * 96 + wb + l15] = f2bf(acc[i][j][r]);
        } else {
          const int d = wb - 64 + l15;
          const size_t L = (e.ctx || m0 >= NPR) ? 1536 : 256;
          uint2 o; o.x = pack2(acc[i][j][0], acc[i][j][1]); o.y = pack2(acc[i][j][2], acc[i][j][3]);
          *(uint2*)(vt + (size_t)d * L) = o;
        }
      }
    }
  }
}

template <int EPI, int WMW, int WNW, int FI, int FJ>
__device__ __forceinline__ void gemm_phase(const u16* A, const u16* Wt, int K, int Mt, int Nt, const EpiP& e, char* smem) {
  for (int t = get_bid(); t < Mt * Nt; t += gridDim.x) gemm_tile<EPI, WMW, WNW, FI, FJ>(A, Wt, K, t % Mt, t / Mt, e, smem);
}

__device__ __forceinline__ void ffn_in_phase(PRM p, int l, int which, const EpiP& e, char* smem) {
  const u16* Wt = p.wt_ffn_in + (size_t)(l * 2 + which) * 5632 * 1024;
  for (int t = get_bid(); t < 2112; t += gridDim.x) gemm_tile<EPI_SWIGLU, 2, 2, 4, 4>(p.xn, Wt, 1024, t % 48, t / 48, e, smem);
  const int G = gridDim.x;
  const int tail = 2112 % G;
  const int bid = get_bid();
  if (l < 3 && bid >= tail) {
    const int nfree = G - tail;
    const int cnt = conv_layer_count(l + 1);
    const int half = cnt >> 1;
    const int lo = which ? half : 0, hi = which ? cnt : half;
    for (int c = lo + (bid - tail); c < hi; c += nfree) conv_layer_task(p, l + 1, c, (float*)smem);
    for (int c = bid - tail; c < 72; c += nfree) mod_task(p, (l + 1) * 144 + which * 72 + c, (float*)smem);
  }
}

__device__ __forceinline__ void rope_store_kb(PRM p, float val, int lane, int t, bool sample, int krow) {
  float outv = val;
  if (sample) {
    float partner = __shfl_xor(val, 8);
    int w = lane & 15, fi = w & 7;
    float pos = (float)((lane & 16) ? (t & 63) : (t >> 6));
    float fr = __expf(-9.210340372f * (float)fi * 0.125f);
    float s, c; sincos_r(pos * fr, s, c);
    outv = (w < 8) ? val * c - partner * s : val * c + partner * s;
  }
  if (lane < 32) {
    u16 b = f2bf(outv);
#pragma unroll
    for (int h = 0; h < 8; ++h) p.kb[(size_t)krow * 768 + h * 96 + 64 + lane] = b;
  }
}

__device__ __forceinline__ void post_even(PRM p, int e) {
  const int tid = get_tid(), lane = tid & 63, wave = tid >> 6;
  const int NT = NTOK / 4;
  const int NC = 256;
  for (int task = get_bid(); task < NT + NC; task += gridDim.x) {
    if (task < NT) {
      const int m0 = task * 4, m = m0 + wave;
      const bool pr = m < NPR;
      const int b = pr ? (m >> 8) : ((m - NPR) >> 10);
      const int t = pr ? (m & 255) : ((m - NPR) & 1023);
      const float* row = p.proj + (size_t)m * 2688;
      {
        float4 a0 = *(const float4*)(row + lane * 8), a1 = *(const float4*)(row + lane * 8 + 4);
        uint4 o; o.x = pack2(a0.x, a0.y); o.y = pack2(a0.z, a0.w); o.z = pack2(a1.x, a1.y); o.w = pack2(a1.z, a1.w);
        *(uint4*)(p.qa + (size_t)m * 512 + lane * 8) = o;
        float4 k0 = *(const float4*)(row + 512 + lane * 8), k1 = *(const float4*)(row + 512 + lane * 8 + 4);
        o.x = pack2(k0.x, k0.y); o.y = pack2(k0.z, k0.w); o.z = pack2(k1.x, k1.y); o.w = pack2(k1.z, k1.w);
        *(uint4*)(p.ka + (size_t)m * 512 + lane * 8) = o;
        if (pr) {
          float* ok = p.out + O_AK + ((size_t)(b * 2 + e) * 256 + t) * 512 + lane * 8;
          *(float4*)ok = k0; *(float4*)(ok + 4) = k1;
          float4 v0 = *(const float4*)(row + 1024 + lane * 8), v1 = *(const float4*)(row + 1024 + lane * 8 + 4);
          float* ov = p.out + O_AV + ((size_t)(b * 2 + e) * 256 + t) * 512 + lane * 8;
          *(float4*)ov = v0; *(float4*)(ov + 4) = v1;
        }
      }
      {
        float4 c0 = *(const float4*)(row + 1536 + lane * 12), c1 = *(const float4*)(row + 1536 + lane * 12 + 4), c2 = *(const float4*)(row + 1536 + lane * 12 + 8);
        float ss = c0.x * c0.x + c0.y * c0.y + c0.z * c0.z + c0.w * c0.w + c1.x * c1.x + c1.y * c1.y + c1.z * c1.z + c1.w * c1.w +
                   c2.x * c2.x + c2.y * c2.y + c2.z * c2.z + c2.w * c2.w;
        ss = wsum(ss);
        float r = rsqrtf(ss * (1.f / 768.f) + EPS);
        const float* g = p.b_q_norm + e * 768 + lane * 12;
        float4 g0 = *(const float4*)g, g1 = *(const float4*)(g + 4), g2 = *(const float4*)(g + 8);
        uint2 o0, o1, o2;
        o0.x = pack2(c0.x * r * g0.x, c0.y * r * g0.y); o0.y = pack2(c0.z * r * g0.z, c0.w * r * g0.w);
        o1.x = pack2(c1.x * r * g1.x, c1.y * r * g1.y); o1.y = pack2(c1.z * r * g1.z, c1.w * r * g1.w);
        o2.x = pack2(c2.x * r * g2.x, c2.y * r * g2.y); o2.y = pack2(c2.z * r * g2.z, c2.w * r * g2.w);
        u16* d = p.cqn + (size_t)m * 768 + lane * 12;
        *(uint2*)d = o0; *(uint2*)(d + 4) = o1; *(uint2*)(d + 8) = o2;
      }
      {
        float4 c0 = *(const float4*)(row + 2304 + lane * 4);
        float ss = wsum(c0.x * c0.x + c0.y * c0.y + c0.z * c0.z + c0.w * c0.w);
        float r = rsqrtf(ss * (1.f / 256.f) + EPS);
        float4 g0 = *(const float4*)(p.b_kv_norm + e * 256 + lane * 4);
        float4 y; y.x = c0.x * r * g0.x; y.y = c0.y * r * g0.y; y.z = c0.z * r * g0.z; y.w = c0.w * r * g0.w;
        uint2 o; o.x = pack2(y.x, y.y); o.y = pack2(y.z, y.w);
        *(uint2*)(p.ckvn + (size_t)m * 256 + lane * 4) = o;
        if (pr) *(float4*)(p.out + O_CKV + ((size_t)(b * 2 + e) * 256 + t) * 256 + lane * 4) = y;
      }
      {
        float val = row[2560 + (lane & 31)];
        if (pr && lane < 32) p.out[O_KR + ((size_t)(b * 2 + e) * 256 + t) * 32 + lane] = val;
        rope_store_kb(p, val, lane, t, !pr, keyrow(m));
      }
      {
        const bool pr0 = m0 < NPR;
        const int b0 = pr0 ? (m0 >> 8) : ((m0 - NPR) >> 10);
        const int t0 = pr0 ? (m0 & 255) : ((m0 - NPR) & 1023);
#pragma unroll
        for (int i = 0; i < 2; ++i) {
          int pp = tid + 256 * i, h = pp >> 6, d = pp & 63;
          const float* src = p.proj + (size_t)m0 * 2688 + 1024 + h * 64 + d;
          float v0 = src[0], v1 = src[2688], v2 = src[2 * 2688], v3 = src[3 * 2688];
          uint2 o; o.x = pack2(v0, v1); o.y = pack2(v2, v3);
          u16* dst = pr0 ? p.vta_p + (size_t)((b0 * 8 + h) * 64 + d) * 256 + t0 : p.vta_s + (size_t)((b0 * 8 + h) * 64 + d) * 1536 + t0;
          *(uint2*)dst = o;
        }
      }
    } else {
      const int ct = task - NT;
      const int b = ct >> 7, key0 = (ct & 127) * 4;
      {
        const float* src = p.cache_a_k + ((size_t)(b * 2 + e) * 512 + key0) * 512;
        u16* dst = p.kactx + ((size_t)b * 512 + key0) * 512;
#pragma unroll
        for (int i = 0; i < 2; ++i) {
          int idx = (tid + 256 * i) * 4;
          float4 v = *(const float4*)(src + idx);
          uint2 o; o.x = pack2(v.x, v.y); o.y = pack2(v.z, v.w);
          *(uint2*)(dst + idx) = o;
        }
      }
      {
        const float* src = p.cache_a_v + ((size_t)(b * 2 + e) * 512 + key0) * 512;
#pragma unroll
        for (int i = 0; i < 2; ++i) {
          int pp = tid + 256 * i, h = pp >> 6, d = pp & 63;
          float v0 = src[pp], v1 = src[512 + pp], v2 = src[1024 + pp], v3 = src[1536 + pp];
          uint2 o; o.x = pack2(v0, v1); o.y = pack2(v2, v3);
          *(uint2*)(p.vta_s + (size_t)((b * 8 + h) * 64 + d) * 1536 + 1024 + key0) = o;
        }
      }
      {
        const float* src = p.cache_b_ckv + ((size_t)(b * 2 + e) * 512 + key0) * 256;
        float4 v = *(const float4*)(src + tid * 4);
        uint2 o; o.x = pack2(v.x, v.y); o.y = pack2(v.z, v.w);
        *(uint2*)(p.cctxn + ((size_t)b * 512 + key0) * 256 + tid * 4) = o;
      }
      {
        const float* src = p.cache_b_krope + ((size_t)(b * 2 + e) * 512 + key0) * 32;
#pragma unroll
        for (int i = 0; i < 4; ++i) {
          int idx = tid + 256 * i;
          int kk = idx >> 8, h = (idx >> 5) & 7, dd = idx & 31;
          p.kb[(size_t)(NPR + b * 1536 + 1024 + key0 + kk) * 768 + h * 96 + 64 + dd] = f2bf(src[kk * 32 + dd]);
        }
      }
    }
  }
}

__device__ __forceinline__ void post_odd(PRM p, int o) {
  const int tid = get_tid(), lane = tid & 63, wave = tid >> 6;
  const int NT = NTOK / 4, NC = 256;
  for (int task = get_bid(); task < NT + NC; task += gridDim.x) {
    if (task < NT) {
      const int m0 = task * 4, m = m0 + wave;
      const bool pr = m < NPR;
      const int b = pr ? (m >> 8) : ((m - NPR) >> 10);
      const int t = pr ? (m & 255) : ((m - NPR) & 1023);
      const float* row = p.proj + (size_t)m * 2432;
      float rs = 0.f, rc = 1.f;
      if (!pr) {
        int w = lane & 31, fi = w & 15;
        float pos = (float)((lane & 32) ? (t & 63) : (t >> 6));
        float fr = __expf(-9.210340372f * (float)fi * (1.f / 16.f));
        sincos_r(pos * fr, rs, rc);
      }
      const bool lo = (lane & 16) == 0;
      const float gq = p.d_q_norm[o * 64 + lane], gk = p.d_k_norm[o * 64 + lane];
#pragma unroll
      for (int hd = 0; hd < 8; ++hd) {
        float v = row[1552 + hd * 64 + lane];
        float ss = wsum(v * v);
        float y = v * rsqrtf(ss * (1.f / 64.f) + EPS) * gq;
        if (!pr) { float pt = __shfl_xor(y, 16); y = lo ? y * rc - pt * rs : y * rc + pt * rs; }
        p.qa[(size_t)m * 512 + hd * 64 + lane] = f2bf(y);
      }
#pragma unroll
      for (int kh = 0; kh < 2; ++kh) {
        float v = row[2064 + kh * 64 + lane];
        float ss = wsum(v * v);
        float y = v * rsqrtf(ss * (1.f / 64.f) + EPS) * gk;
        if (pr) p.out[O_DK + ((size_t)(b * 2 + o) * 256 + t) * 128 + kh * 64 + lane] = y;
        else { float pt = __shfl_xor(y, 16); y = lo ? y * rc - pt * rs : y * rc + pt * rs; }
        p.kd[(size_t)keyrow(m) * 128 + kh * 64 + lane] = f2bf(y);
        if (pr) p.out[O_DV + ((size_t)(b * 2 + o) * 256 + t) * 128 + kh * 64 + lane] = row[2192 + kh * 64 + lane];
      }
      if (tid < 128) {
        const bool pr0 = m0 < NPR;
        const int b0 = pr0 ? (m0 >> 8) : ((m0 - NPR) >> 10);
        const int t0 = pr0 ? (m0 & 255) : ((m0 - NPR) & 1023);
        int kh = tid >> 6, d = tid & 63;
        const float* src = p.proj + (size_t)m0 * 2432 + 2192 + tid;
        float v0 = src[0], v1 = src[2432], v2 = src[2 * 2432], v3 = src[3 * 2432];
        uint2 oo; oo.x = pack2(v0, v1); oo.y = pack2(v2, v3);
        u16* dst = pr0 ? p.vtd_p + (size_t)((b0 * 2 + kh) * 64 + d) * 256 + t0 : p.vtd_s + (size_t)((b0 * 2 + kh) * 64 + d) * 1536 + t0;
        *(uint2*)dst = oo;
      }
    } else {
      const int ct = task - NT;
      const int b = ct >> 7, key0 = (ct & 127) * 4;
      {
        const float* src = p.cache_d_k + ((size_t)(b * 2 + o) * 512 + key0) * 128;
        if (tid < 128) {
          float4 v = *(const float4*)(src + tid * 4);
          uint2 oo; oo.x = pack2(v.x, v.y); oo.y = pack2(v.z, v.w);
          *(uint2*)(p.kd + (size_t)(NPR + b * 1536 + 1024 + key0) * 128 + tid * 4) = oo;
        } else {
          int pp = tid - 128, kh = pp >> 6, d = pp & 63;
          const float* sv = p.cache_d_v + ((size_t)(b * 2 + o) * 512 + key0) * 128;
          float v0 = sv[pp], v1 = sv[128 + pp], v2 = sv[256 + pp], v3 = sv[384 + pp];
          uint2 oo; oo.x = pack2(v0, v1); oo.y = pack2(v2, v3);
          *(uint2*)(p.vtd_s + (size_t)((b * 2 + kh) * 64 + d) * 1536 + 1024 + key0) = oo;
        }
      }
    }
  }
}

struct AttnSt { float m, l; f32x4 o[4]; };
template <int KS> struct KVf { bf16x8 k0[KS], k1[KS]; s16x4 v0[4], v1[4]; };

template <int KS>
__device__ __forceinline__ void attn_load(KVf<KS>& f, const u16* __restrict__ Kb, int kstride, const u16* __restrict__ Vtb, int vtstride, int l15, int q4) {
  const u16* k0p = Kb + (size_t)l15 * kstride + q4 * 8;
  const u16* k1p = k0p + (size_t)16 * kstride;
#pragma unroll
  for (int ks = 0; ks < KS; ++ks) { f.k0[ks] = *(const bf16x8*)(k0p + ks * 32); f.k1[ks] = *(const bf16x8*)(k1p + ks * 32); }
#pragma unroll
  for (int dt = 0; dt < 4; ++dt) {
    const u16* vp = Vtb + (size_t)(dt * 16 + l15) * vtstride + q4 * 4;
    f.v0[dt] = *(const s16x4*)vp; f.v1[dt] = *(const s16x4*)(vp + 16);
  }
}

template <int KS>
__device__ __forceinline__ void attn_comp(AttnSt& st, const bf16x8 (&qf)[KS], const KVf<KS>& f, float scale, int q4,
                                          bool masked, const float* rpbrow, int qc, int kc0) {
  f32x4 s0 = {0.f, 0.f, 0.f, 0.f}, s1 = {0.f, 0.f, 0.f, 0.f};
#pragma unroll
  for (int ks = 0; ks < KS; ++ks) { s0 = mfma16(f.k0[ks], qf[ks], s0); s1 = mfma16(f.k1[ks], qf[ks], s1); }
  float sv[8];
#pragma unroll
  for (int j = 0; j < 4; ++j) { sv[j] = s0[j] * scale; sv[4 + j] = s1[j] * scale; }
  if (masked) {
    const int cs = min(max(qc - 8, 0), 48);
#pragma unroll
    for (int e = 0; e < 8; ++e) {
      int kc = kc0 + (e >> 2) * 16 + q4 * 4 + (e & 3);
      bool ok = (kc >= cs) && (kc < cs + 16);
      int di = min(max(kc - qc, -15), 15) + 15;
      sv[e] = ok ? sv[e] + rpbrow[di] : -INFINITY;
    }
  }
  float mx = sv[0];
#pragma unroll
  for (int e = 1; e < 8; ++e) mx = fmaxf(mx, sv[e]);
  mx = fmaxf(mx, __shfl_xor(mx, 16));
  mx = fmaxf(mx, __shfl_xor(mx, 32));
  const float mnew = fmaxf(st.m, mx);
  const float alpha = __expf(st.m - mnew);
  float pe[8], ls = 0.f;
#pragma unroll
  for (int e = 0; e < 8; ++e) { pe[e] = __expf(sv[e] - mnew); ls += pe[e]; }
  st.l = st.l * alpha + ls;
  st.m = mnew;
  bf16x8 pf;
#pragma unroll
  for (int e = 0; e < 8; ++e) pf[e] = (short)f2bf(pe[e]);
#pragma unroll
  for (int dt = 0; dt < 4; ++dt) {
    bf16x8 vf = (bf16x8){f.v0[dt].x, f.v0[dt].y, f.v0[dt].z, f.v0[dt].w, f.v1[dt].x, f.v1[dt].y, f.v1[dt].z, f.v1[dt].w};
    st.o[dt] *= alpha;
    st.o[dt] = mfma16(vf, pf, st.o[dt]);
  }
}

__device__ __forceinline__ void attn_init(AttnSt& st) {
  st.m = -1e30f; st.l = 0.f;
#pragma unroll
  for (int dt = 0; dt < 4; ++dt) st.o[dt] = (f32x4){0.f, 0.f, 0.f, 0.f};
}
__device__ __forceinline__ void attn_fin(AttnSt& st, u16* outp  , int l15, int q4) {
  float lt = st.l;
  lt += __shfl_xor(lt, 16);
  lt += __shfl_xor(lt, 32);
  const float inv = 1.f / lt;
#pragma unroll
  for (int dt = 0; dt < 4; ++dt) {
    uint2 o; o.x = pack2(st.o[dt][0] * inv, st.o[dt][1] * inv); o.y = pack2(st.o[dt][2] * inv, st.o[dt][3] * inv);
    *(uint2*)(outp + (size_t)l15 * 1024 + dt * 16 + q4 * 4) = o;
  }
}

#define AT_VSTR 72
template <int KS> struct ATile { static constexpr int KSTR = KS * 32 + 8; static constexpr int BUF = 64 * (KS * 32 + 8) + 64 * AT_VSTR; };
template <int KS> struct AStage { u32x4 k[KS]; u32x4 v[2]; };

template <int KS>
__device__ __forceinline__ void at_load(AStage<KS>& r, const u16* __restrict__ Kg, int kstride, const u16* __restrict__ Vg, int vtstride, int tid) {
#pragma unroll
  for (int i = 0; i < KS; ++i) {
    int c = tid + 256 * i; int row = c / (KS * 4), ch = c - row * (KS * 4);
    r.k[i] = *(const u32x4*)(Kg + (unsigned)(row * kstride + ch * 8));
  }
#pragma unroll
  for (int i = 0; i < 2; ++i) {
    int c = tid + 256 * i; int row = c >> 3, ch = c & 7;
    r.v[i] = *(const u32x4*)(Vg + (unsigned)(row * vtstride + ch * 8));
  }
}
template <int KS>
__device__ __forceinline__ void at_store(const AStage<KS>& r, u16* buf, int tid) {
  u16* Ks = buf; u16* Vs = buf + 64 * ATile<KS>::KSTR;
#pragma unroll
  for (int i = 0; i < KS; ++i) {
    int c = tid + 256 * i; int row = c / (KS * 4), ch = c - row * (KS * 4);
    *(u32x4*)(Ks + row * ATile<KS>::KSTR + ch * 8) = r.k[i];
  }
#pragma unroll
  for (int i = 0; i < 2; ++i) {
    int c = tid + 256 * i; int row = c >> 3, ch = c & 7;
    *(u32x4*)(Vs + row * AT_VSTR + ch * 8) = r.v[i];
  }
}

template <int KS>
__device__ __forceinline__ void at_comp(AttnSt& st, const bf16x8 (&qf)[KS], const u16* buf, float scale, int l15, int q4,
                                        bool masked, const float* rpbrow, int qc) {
  const u16* Ks = buf; const u16* Vs = buf + 64 * ATile<KS>::KSTR;
  f32x4 s[4];
#pragma unroll
  for (int kt = 0; kt < 4; ++kt) {
    s[kt] = (f32x4){0.f, 0.f, 0.f, 0.f};
#pragma unroll
    for (int ks = 0; ks < KS; ++ks) {
      bf16x8 a = *(const bf16x8*)(Ks + (kt * 16 + l15) * ATile<KS>::KSTR + ks * 32 + q4 * 8);
      s[kt] = mfma16(a, qf[ks], s[kt]);
    }
  }
  float sv[16];
  const float sc2 = scale * 1.4426950408889634f;
#pragma unroll
  for (int kt = 0; kt < 4; ++kt)
#pragma unroll
    for (int j = 0; j < 4; ++j) sv[kt * 4 + j] = s[kt][j] * sc2;
  if (masked) {
    const int cs = min(max(qc - 8, 0), 48);
#pragma unroll
    for (int e = 0; e < 16; ++e) {
      int kc = (e >> 2) * 16 + q4 * 4 + (e & 3);
      bool ok = (kc >= cs) && (kc < cs + 16);
      int di = min(max(kc - qc, -15), 15) + 15;
      sv[e] = ok ? sv[e] + rpbrow[di] : -INFINITY;
    }
  }
  float mx = sv[0];
#pragma unroll
  for (int e = 1; e < 16; ++e) mx = fmaxf(mx, sv[e]);
  mx = fmaxf(mx, __shfl_xor(mx, 16));
  mx = fmaxf(mx, __shfl_xor(mx, 32));
  const float mnew = fmaxf(st.m, mx);
  const float alpha = __builtin_amdgcn_exp2f(st.m - mnew);
  float ls = 0.f;
#pragma unroll
  for (int e = 0; e < 16; ++e) { sv[e] = __builtin_amdgcn_exp2f(sv[e] - mnew); ls += sv[e]; }
  st.l = st.l * alpha + ls;
  st.m = mnew;
  bf16x8 pf[2];
#pragma unroll
  for (int hf = 0; hf < 2; ++hf) {
    u32x4 pw;
    pw[0] = pack2(sv[hf * 8 + 0], sv[hf * 8 + 1]); pw[1] = pack2(sv[hf * 8 + 2], sv[hf * 8 + 3]);
    pw[2] = pack2(sv[hf * 8 + 4], sv[hf * 8 + 5]); pw[3] = pack2(sv[hf * 8 + 6], sv[hf * 8 + 7]);
    pf[hf] = __builtin_bit_cast(bf16x8, pw);
  }
#pragma unroll
  for (int dt = 0; dt < 4; ++dt) {
    st.o[dt] *= alpha;
#pragma unroll
    for (int hf = 0; hf < 2; ++hf) {
      const u16* vp = Vs + (dt * 16 + l15) * AT_VSTR + hf * 32 + q4 * 4;
      s16x4 v0 = *(const s16x4*)vp;
      s16x4 v1 = *(const s16x4*)(vp + 16);
      bf16x8 vf = (bf16x8){v0.x, v0.y, v0.z, v0.w, v1.x, v1.y, v1.z, v1.w};
      st.o[dt] = mfma16(vf, pf[hf], st.o[dt]);
    }
  }
}

template <int KS>
__device__ __forceinline__ void at_run_plain(AttnSt& st, const bf16x8 (&qf)[KS], const u16* Kbase, int kstride, const u16* Vbase, int vtstride,
                                             int nt, float scale, u16* lds, int tid, int l15, int q4) {
  AStage<KS> r0, r1;
  at_load<KS>(r0, Kbase, kstride, Vbase, vtstride, tid);
  if (nt > 1) at_load<KS>(r1, Kbase + (size_t)64 * kstride, kstride, Vbase + 64, vtstride, tid);
  at_store<KS>(r0, lds, tid);
  __syncthreads();
  for (int t = 0; t < nt; t += 2) {
    if (t + 2 < nt) at_load<KS>(r0, Kbase + (size_t)(t + 2) * 64 * kstride, kstride, Vbase + (t + 2) * 64, vtstride, tid);
    at_comp<KS>(st, qf, lds, scale, l15, q4, false, nullptr, 0);
    if (t + 1 < nt) at_store<KS>(r1, lds + ATile<KS>::BUF, tid);
    __syncthreads();
    if (t + 1 >= nt) break;
    if (t + 3 < nt) at_load<KS>(r1, Kbase + (size_t)(t + 3) * 64 * kstride, kstride, Vbase + (t + 3) * 64, vtstride, tid);
    at_comp<KS>(st, qf, lds + ATile<KS>::BUF, scale, l15, q4, false, nullptr, 0);
    if (t + 2 < nt) at_store<KS>(r0, lds, tid);
    __syncthreads();
  }
}

__device__ __forceinline__ void load_q64(bf16x8 (&qf)[2], const u16* Q, int qstride, int l15, int q4) {
#pragma unroll
  for (int ks = 0; ks < 2; ++ks) qf[ks] = *(const bf16x8*)(Q + (size_t)l15 * qstride + ks * 32 + q4 * 8);
}
__device__ __forceinline__ void load_q_mla(bf16x8 (&qf)[3], const float* Qf, int l15, int q4, bool sample, int t0) {
  const float* qr = Qf + (size_t)l15 * 768 + q4 * 8;
#pragma unroll
  for (int ks = 0; ks < 3; ++ks) {
    float4 a = *(const float4*)(qr + ks * 32), b = *(const float4*)(qr + ks * 32 + 4);
    float v[8] = {a.x, a.y, a.z, a.w, b.x, b.y, b.z, b.w};
    if (ks == 2 && sample) {
      const int t = t0 + l15;
      const float pos = (float)((q4 & 2) ? (t & 63) : (t >> 6));
#pragma unroll
      for (int jj = 0; jj < 8; ++jj) {
        float pt = __shfl_xor(v[jj], 16);
        float fr = __expf(-9.210340372f * (float)jj * 0.125f);
        float sn, cs; sincos_r(pos * fr, sn, cs);
        v[jj] = (q4 & 1) ? v[jj] * cs + pt * sn : v[jj] * cs - pt * sn;
      }
    }
#pragma unroll
    for (int jj = 0; jj < 8; ++jj) qf[ks][jj] = (short)f2bf(v[jj]);
  }
}

__device__ __forceinline__ void attn_even_phase(PRM p, int e, char* smem) {
  u16* lds = (u16*)smem;
  const int tid = get_tid(), lane = tid & 63, wave = tid >> 6, l15 = lane & 15, q4 = lane >> 4;
  const float scaleB = 0.10206207261596577f;
  for (int bt = get_bid(); bt < 1536; bt += gridDim.x) {
    AttnSt st; attn_init(st);
    if (bt < 256) {
      int qb = bt & 15, h = (bt >> 4) & 7, b = bt >> 7;
      int mq = NPR + b * 1024 + qb * 64 + wave * 16;
      bf16x8 qf[3]; load_q_mla(qf, p.qb + (size_t)mq * 768 + h * 96, l15, q4, true, qb * 64 + wave * 16);
      at_run_plain<3>(st, qf, p.kb + (size_t)(NPR + b * 1536) * 768 + h * 96, 768, p.vtb_s + (size_t)((b * 8 + h) * 64) * 1536, 1536, 24, scaleB, lds, tid, l15, q4);
      attn_fin(st, p.mix + (size_t)mq * 1024 + 512 + h * 64, l15, q4);
    } else if (bt < 512) {
      int u = bt - 256;
      int r = u & 15, h = (u >> 4) & 7, b = u >> 7;
      int mq = NPR + b * 1024 + r * 64 + wave * 16;
      bf16x8 qf[2]; load_q64(qf, p.qa + (size_t)mq * 512 + h * 64, 512, l15, q4);
      const u16* Vt = p.vta_s + (size_t)((b * 8 + h) * 64) * 1536;
      const u16* Kc = p.kactx + (size_t)b * 512 * 512 + h * 64;
      const int rs = min(max(r - 4, 0), 8);
      const u16* Kw = p.ka + (size_t)(NPR + b * 1024 + rs * 64) * 512 + h * 64;
      const float* rpb0 = p.a_rpb + ((size_t)(e * 8 + h) * 15 + (rs - r + 7)) * 31;
      const int qc = wave * 16 + l15;
      float* rpl = (float*)(lds + 2 * ATile<2>::BUF);
      if (tid < 248) { int rr = tid / 31, cc = tid - rr * 31; rpl[rr * 32 + cc] = rpb0[rr * 31 + cc] * 1.4426950408889634f; }
      AStage<2> r0, r1;
#define NB_LOAD(R, T) { if ((T) < 8) at_load<2>(R, Kc + (size_t)(T) * 64 * 512, 512, Vt + 1024 + (T) * 64, 1536, tid); \
                        else at_load<2>(R, Kw + (size_t)((T) - 8) * 64 * 512, 512, Vt + (rs + (T) - 8) * 64, 1536, tid); }
#define NB_COMP(BUFP, T) { if ((T) < 8) at_comp<2>(st, qf, BUFP, 0.125f, l15, q4, false, nullptr, 0); \
                           else at_comp<2>(st, qf, BUFP, 0.125f, l15, q4, true, rpl + ((T) - 8) * 32, qc); }
      NB_LOAD(r0, 0);
      NB_LOAD(r1, 1);
      at_store<2>(r0, lds, tid);
      __syncthreads();
      for (int t = 0; t < 16; t += 2) {
        if (t + 2 < 16) NB_LOAD(r0, t + 2);
        NB_COMP(lds, t);
        at_store<2>(r1, lds + ATile<2>::BUF, tid);
        __syncthreads();
        if (t + 3 < 16) NB_LOAD(r1, t + 3);
        NB_COMP(lds + ATile<2>::BUF, t + 1);
        if (t + 2 < 16) at_store<2>(r0, lds, tid);
        __syncthreads();
      }
#undef NB_LOAD
#undef NB_COMP
      attn_fin(st, p.mix + (size_t)mq * 1024 + h * 64, l15, q4);
    } else if (bt < 1024) {
      int u = bt - 512;
      int qb = u & 3, h = (u >> 2) & 7, b = u >> 5;
      int mq = b * 256 + qb * 64 + wave * 16;
      bf16x8 qf[3]; load_q_mla(qf, p.qb + (size_t)mq * 768 + h * 96, l15, q4, false, 0);
      at_run_plain<3>(st, qf, p.kb + (size_t)(b * 256) * 768 + h * 96, 768, p.vtb_p + (size_t)((b * 8 + h) * 64) * 256, 256, 4, scaleB, lds, tid, l15, q4);
      attn_fin(st, p.mix + (size_t)mq * 1024 + 512 + h * 64, l15, q4);
    } else {
      int u = bt - 1024;
      int qb = u & 3, h = (u >> 2) & 7, b = u >> 5;
      int mq = b * 256 + qb * 64 + wave * 16;
      bf16x8 qf[2]; load_q64(qf, p.qa + (size_t)mq * 512 + h * 64, 512, l15, q4);
      at_run_plain<2>(st, qf, p.ka + (size_t)(b * 256) * 512 + h * 64, 512, p.vta_p + (size_t)((b * 8 + h) * 64) * 256, 256, 4, 0.125f, lds, tid, l15, q4);
      attn_fin(st, p.mix + (size_t)mq * 1024 + h * 64, l15, q4);
    }
  }
}

__device__ __forceinline__ int mslot(int sq, int h, int dir, int j) {
  return sq < 16 ? ((sq * 4 + h) * 2 + dir) * 4 + j : 512 + (((sq - 16) * 4 + h) * 2 + dir) * 16 + j;
}

__device__ __forceinline__ void mlstm1_task(PRM p, int o, int task, float* sm) {
  const int tid = get_tid(), lane = tid & 63, wave = tid >> 6;
  int sq, h, dir, j;
  if (task < 512) { j = task & 3; dir = (task >> 2) & 1; h = (task >> 3) & 3; sq = task >> 5; }
  else { int u = task - 512; j = u & 15; dir = (u >> 4) & 1; h = (u >> 5) & 3; sq = 16 + (u >> 7); }
  const int T = sq < 16 ? 256 : 1024;
  const int base = sq < 16 ? sq * 256 : NPR + (sq - 16) * 1024;
  const int slot = task;
  float* ks = sm;
  float* vs = sm + 4096;
  float* wg = sm + 4096 + 8192;
  if (wave == 0) {
    int s = 64 * j + lane;
    int t = dir ? T - 1 - s : s;
    const float* row = p.proj + (size_t)(base + t) * 2432 + 1536;
    float ig = row[(dir * 2 + 0) * 4 + h] + p.c_gate_bias[o * 16 + (dir * 2 + 0) * 4 + h];
    float fg = row[(dir * 2 + 1) * 4 + h] + p.c_gate_bias[o * 16 + (dir * 2 + 1) * 4 + h];
    float bsum = logsig_f(fg);
#pragma unroll
    for (int off = 1; off < 64; off <<= 1) { float v = __shfl_up(bsum, off); if (lane >= off) bsum += v; }
    float blast = __shfl(bsum, 63);
    float g = blast - bsum + ig;
    float ml = wmaxr(g);
    wg[lane] = __expf(g - ml);
    if (lane == 0) { p.dm[slot * 2] = ml; p.dm[slot * 2 + 1] = blast; }
  }
#pragma unroll
  for (int ii = 0; ii < 4; ++ii) {
    int i = (tid >> 4) + 16 * ii, c4 = tid & 15;
    int s = 64 * j + i; int t = dir ? T - 1 - s : s;
    float4 v = *(const float4*)(p.proj + (size_t)(base + t) * 2432 + 256 + h * 64 + c4 * 4);
    v.x *= 0.125f; v.y *= 0.125f; v.z *= 0.125f; v.w *= 0.125f;
    *(float4*)(ks + i * 64 + c4 * 4) = v;
  }
#pragma unroll
  for (int ii = 0; ii < 8; ++ii) {
    int i = (tid >> 5) + 8 * ii, c4 = tid & 31;
    int s = 64 * j + i; int t = dir ? T - 1 - s : s;
    *(float4*)(vs + i * 128 + c4 * 4) = *(const float4*)(p.proj + (size_t)(base + t) * 2432 + 512 + h * 128 + c4 * 4);
  }
  __syncthreads();
  const int dg = tid & 15, vg8 = tid >> 4;
  f32x4 acc[8];
#pragma unroll
  for (int q = 0; q < 8; ++q) acc[q] = (f32x4){0.f, 0.f, 0.f, 0.f};
  f32x4 nacc = {0.f, 0.f, 0.f, 0.f};
#pragma unroll 4
  for (int i = 0; i < 64; ++i) {
    f32x4 kd = *(const f32x4*)(ks + i * 64 + dg * 4) * wg[i];
    nacc += kd;
    f32x4 va = *(const f32x4*)(vs + i * 128 + vg8 * 8);
    f32x4 vb = *(const f32x4*)(vs + i * 128 + vg8 * 8 + 4);
    acc[0] += kd * va[0]; acc[1] += kd * va[1]; acc[2] += kd * va[2]; acc[3] += kd * va[3];
    acc[4] += kd * vb[0]; acc[5] += kd * vb[1]; acc[6] += kd * vb[2]; acc[7] += kd * vb[3];
  }
  float* dc = p.dC + (size_t)slot * 8192;
#pragma unroll
  for (int q = 0; q < 8; ++q) *(f32x4*)(dc + (vg8 * 8 + q) * 64 + dg * 4) = acc[q];
  if (vg8 == 0) *(f32x4*)(p.dn + slot * 64 + dg * 4) = nacc;
  __syncthreads();
}

__device__ __forceinline__ void mlstm2_task(PRM p, int o, int task, float* sm) {
  const int tid = get_tid(), lane = tid & 63, wave = tid >> 6;
  int sq, h, c;
  if (task < 256) { c = task & 3; h = (task >> 2) & 3; sq = task >> 4; }
  else { int u = task - 256; c = u & 15; h = (u >> 4) & 3; sq = 16 + (u >> 6); }
  const bool pr = sq < 16;
  const int nc = pr ? 4 : 16;
  const int base = (pr ? sq * 256 : NPR + (sq - 16) * 1024) + c * 64;
  float* qT = sm;
  float* kT = sm + 4352;
  float* CT = kT;
  float* St = sm + 2 * 4352;
  float* vh = sm + 3 * 4352;
  float* smalls = sm + 4 * 4352;
  float* bl = smalls;
  float* itb = smalls + 64;
  float* mt = smalls + 128;
  float* w0 = smalls + 192;
  float* nv = smalls + 256;
  float* nq = smalls + 320;
  float* den = smalls + 384;
  float* scal = smalls + 448;

  const int tl = tid >> 4, tx = tid & 15;
  const int l0 = tl * 4, x0 = tx * 4;
  float hacc[2][4][4];
#pragma unroll
  for (int a = 0; a < 2; ++a)
#pragma unroll
    for (int b2 = 0; b2 < 4; ++b2)
#pragma unroll
      for (int c2 = 0; c2 < 4; ++c2) hacc[a][b2][c2] = 0.f;

  f32x4 qv[4], kv[4];
#pragma unroll
  for (int ii = 0; ii < 4; ++ii) {
    int i = (tid >> 4) + 16 * ii, c4 = tid & 15;
    const float* row = p.proj + (size_t)(base + i) * 2432 + h * 64 + c4 * 4;
    qv[ii] = *(const f32x4*)row;
    kv[ii] = *(const f32x4*)(row + 256);
  }
#pragma unroll
  for (int ii = 0; ii < 4; ++ii) {
    int i = (tid >> 4) + 16 * ii, c4 = tid & 15;
    qT[(c4 * 4 + 0) * 68 + i] = qv[ii].x; qT[(c4 * 4 + 1) * 68 + i] = qv[ii].y; qT[(c4 * 4 + 2) * 68 + i] = qv[ii].z; qT[(c4 * 4 + 3) * 68 + i] = qv[ii].w;
  }
#pragma unroll 1
  for (int dir = 0; dir < 2; ++dir) {
    const int j = dir ? nc - 1 - c : c;
    const int slj = mslot(sq, h, dir, j);
    const float mprev = p.mp[slj];
    float cr[16]; f32x4 vr[4];
    const float* cpp = p.cp + (size_t)slj * 8192;
#pragma unroll
    for (int r = 0; r < 16; ++r) cr[r] = cpp[tid + 256 * r];
#pragma unroll
    for (int ii = 0; ii < 4; ++ii) {
      int i = (tid >> 4) + 16 * ii, c4 = tid & 15;
      vr[ii] = *(const f32x4*)(p.proj + (size_t)(base + i) * 2432 + 512 + h * 128 + c4 * 4);
    }
    if (wave == 0) {
      const int i = lane;
      const int tau = dir ? 63 - i : i;
      const float* row = p.proj + (size_t)(base + tau) * 2432 + 1536;
      float ig = row[(dir * 2 + 0) * 4 + h] + p.c_gate_bias[o * 16 + (dir * 2 + 0) * 4 + h];
      float fg = row[(dir * 2 + 1) * 4 + h] + p.c_gate_bias[o * 16 + (dir * 2 + 1) * 4 + h];
      float bsum = logsig_f(fg);
#pragma unroll
      for (int off = 1; off < 64; off <<= 1) { float v = __shfl_up(bsum, off); if (lane >= off) bsum += v; }
      float ib = ig - bsum;
      float pm = ib;
#pragma unroll
      for (int off = 1; off < 64; off <<= 1) { float v = __shfl_up(pm, off); if (lane >= off) pm = fmaxf(pm, v); }
      float mti = fmaxf(bsum + mprev, bsum + pm);
      bl[tau] = bsum; itb[tau] = ib; mt[tau] = mti; w0[tau] = __expf(bsum + mprev - mti);
    }
#pragma unroll
    for (int ii = 0; ii < 4; ++ii) {
      int i = (tid >> 4) + 16 * ii, c4 = tid & 15;
      kT[(c4 * 4 + 0) * 68 + i] = kv[ii].x * 0.125f; kT[(c4 * 4 + 1) * 68 + i] = kv[ii].y * 0.125f;
      kT[(c4 * 4 + 2) * 68 + i] = kv[ii].z * 0.125f; kT[(c4 * 4 + 3) * 68 + i] = kv[ii].w * 0.125f;
    }
    if (tid < 64) nv[tid] = p.np[slj * 64 + tid];
    __syncthreads();
    {
      float a[4][4];
#pragma unroll
      for (int r = 0; r < 4; ++r)
#pragma unroll
        for (int q = 0; q < 4; ++q) a[r][q] = 0.f;
#pragma unroll 2
      for (int d = 0; d < 64; ++d) {
        float4 q4v = *(const float4*)(qT + d * 68 + l0);
        float4 k4v = *(const float4*)(kT + d * 68 + x0);
        float qa[4] = {q4v.x, q4v.y, q4v.z, q4v.w}, kk[4] = {k4v.x, k4v.y, k4v.z, k4v.w};
#pragma unroll
        for (int r = 0; r < 4; ++r)
#pragma unroll
          for (int q = 0; q < 4; ++q) a[r][q] = fmaf(qa[r], kk[q], a[r][q]);
      }
      float rsum[4];
#pragma unroll
      for (int r = 0; r < 4; ++r) {
        const int l = l0 + r;
        const float bll = bl[l], mtl = mt[l];
        rsum[r] = 0.f;
#pragma unroll
        for (int q = 0; q < 4; ++q) {
          const int s = x0 + q;
          const bool ok = dir ? (s >= l) : (s <= l);
          float sv = ok ? a[r][q] * __expf(bll + itb[s] - mtl) : 0.f;
          St[s * 68 + l] = sv;
          rsum[r] += sv;
        }
        rsum[r] += __shfl_xor(rsum[r], 1); rsum[r] += __shfl_xor(rsum[r], 2);
        rsum[r] += __shfl_xor(rsum[r], 4); rsum[r] += __shfl_xor(rsum[r], 8);
        if (tx == 0) den[l] = rsum[r];
      }
    }
    __syncthreads();
    if (tid < 64) {
      float s = 0.f;
#pragma unroll 4
      for (int d = 0; d < 64; ++d) s = fmaf(qT[d * 68 + tid], nv[d], s);
      nq[tid] = s;
    }
#pragma unroll 1
    for (int vhalf = 0; vhalf < 2; ++vhalf) {
#pragma unroll
      for (int r = 0; r < 16; ++r) {
        int e = tid + 256 * r;
        CT[(e & 63) * 68 + (e >> 6)] = cr[r];
      }
#pragma unroll
      for (int ii = 0; ii < 4; ++ii) {
        int i = (tid >> 4) + 16 * ii, c4 = tid & 15;
        *(f32x4*)(vh + i * 68 + c4 * 4) = vr[ii];
      }
      if (vhalf == 0) {
#pragma unroll
        for (int r = 0; r < 16; ++r) cr[r] = cpp[4096 + tid + 256 * r];
#pragma unroll
        for (int ii = 0; ii < 4; ++ii) {
          int i = (tid >> 4) + 16 * ii, c4 = tid & 15;
          vr[ii] = *(const f32x4*)(p.proj + (size_t)(base + i) * 2432 + 512 + h * 128 + 64 + c4 * 4);
        }
      }
      __syncthreads();
      {
        float a1[4][4], a2[4][4];
#pragma unroll
        for (int r = 0; r < 4; ++r)
#pragma unroll
          for (int q = 0; q < 4; ++q) { a1[r][q] = 0.f; a2[r][q] = 0.f; }
#pragma unroll 2
        for (int s = 0; s < 64; ++s) {
          float4 sa = *(const float4*)(St + s * 68 + l0);
          float4 vb = *(const float4*)(vh + s * 68 + x0);
          float4 qa4 = *(const float4*)(qT + s * 68 + l0);
          float4 cb4 = *(const float4*)(CT + s * 68 + x0);
          float sl4[4] = {sa.x, sa.y, sa.z, sa.w}, vv[4] = {vb.x, vb.y, vb.z, vb.w};
          float qq[4] = {qa4.x, qa4.y, qa4.z, qa4.w}, cc[4] = {cb4.x, cb4.y, cb4.z, cb4.w};
#pragma unroll
          for (int r = 0; r < 4; ++r)
#pragma unroll
            for (int q = 0; q < 4; ++q) { a1[r][q] = fmaf(sl4[r], vv[q], a1[r][q]); a2[r][q] = fmaf(qq[r], cc[q], a2[r][q]); }
        }
#pragma unroll
        for (int r = 0; r < 4; ++r) {
          const int l = l0 + r;
          const float w = w0[l];
          const float dn_ = den[l] + w * nq[l];
          const float dd = fmaxf(fabsf(dn_), __expf(-mt[l]));
          const float inv = 1.f / dd;
#pragma unroll
          for (int q = 0; q < 4; ++q) { float hv = (a1[r][q] + w * a2[r][q]) * inv; if (vhalf == 0) hacc[0][r][q] += hv; else hacc[1][r][q] += hv; }
        }
      }
      __syncthreads();
    }
  }
#pragma unroll
  for (int r = 0; r < 4; ++r) {
    float ss = 0.f;
#pragma unroll
    for (int a = 0; a < 2; ++a)
#pragma unroll
      for (int q = 0; q < 4; ++q) ss += hacc[a][r][q] * hacc[a][r][q];
    ss += __shfl_xor(ss, 1); ss += __shfl_xor(ss, 2); ss += __shfl_xor(ss, 4); ss += __shfl_xor(ss, 8);
    const float rn = rsqrtf(ss * (1.f / 128.f) + EPS);
    const int m = base + l0 + r;
#pragma unroll
    for (int a = 0; a < 2; ++a) {
      const int v0 = a * 64 + x0;
      float4 co = *(const float4*)(p.proj + (size_t)m * 2432 + 1024 + h * 128 + v0);
      float4 gn = *(const float4*)(p.c_out_norm + (size_t)(o * 4 + h) * 128 + v0);
      float y0 = sigmoid_f(co.x) * hacc[a][r][0] * rn * gn.x;
      float y1 = sigmoid_f(co.y) * hacc[a][r][1] * rn * gn.y;
      float y2 = sigmoid_f(co.z) * hacc[a][r][2] * rn * gn.z;
      float y3 = sigmoid_f(co.w) * hacc[a][r][3] * rn * gn.w;
      uint2 oo; oo.x = pack2(y0, y1); oo.y = pack2(y2, y3);
      *(uint2*)(p.mix + (size_t)m * 1024 + h * 128 + v0) = oo;
    }
  }
  __syncthreads();
}

__device__ __forceinline__ void mlstm2_mfma(PRM p, int o, int task, char* smem) {
  const int tid = get_tid(), lane = tid & 63, wave = tid >> 6, l15 = lane & 15, q4 = lane >> 4;
  int sq, h, c;
  if (task < 256) { c = task & 3; h = (task >> 2) & 3; sq = task >> 4; }
  else { int u = task - 256; c = u & 15; h = (u >> 4) & 3; sq = 16 + (u >> 6); }
  const bool pr = sq < 16;
  const int nc = pr ? 4 : 16;
  const int base = (pr ? sq * 256 : NPR + (sq - 16) * 1024) + c * 64;
  u16* Qb = (u16*)smem;
  u16* Kb = Qb + 64 * 72;
  u16* Vt = Kb + 64 * 72;
  u16* Cb = Vt + 128 * 72;
  float* sml = (float*)(Cb + 128 * 72);
  float* bl = sml; float* itb = sml + 64; float* mt = sml + 128; float* w0 = sml + 192; float* nv = sml + 256;
#pragma unroll
  for (int ii = 0; ii < 4; ++ii) {
    int i = (tid >> 4) + 16 * ii, c4 = tid & 15;
    const float* row = p.proj + (size_t)(base + i) * 2432 + h * 64 + c4 * 4;
    f32x4 qv = *(const f32x4*)row;
    f32x4 kv = *(const f32x4*)(row + 256);
    uint2 a; a.x = pack2(qv[0], qv[1]); a.y = pack2(qv[2], qv[3]);
    uint2 b; b.x = pack2(kv[0] * 0.125f, kv[1] * 0.125f); b.y = pack2(kv[2] * 0.125f, kv[3] * 0.125f);
    *(uint2*)(Qb + i * 72 + c4 * 4) = a;
    *(uint2*)(Kb + i * 72 + c4 * 4) = b;
  }
#pragma unroll
  for (int ii = 0; ii < 8; ++ii) {
    int i = (tid >> 5) + 8 * ii, c4 = tid & 31;
    f32x4 vv = *(const f32x4*)(p.proj + (size_t)(base + i) * 2432 + 512 + h * 128 + c4 * 4);
    unsigned w01 = pack2(vv[0], vv[1]), w23 = pack2(vv[2], vv[3]);
    Vt[(c4 * 4 + 0) * 72 + i] = (u16)(w01 & 0xffffu); Vt[(c4 * 4 + 1) * 72 + i] = (u16)(w01 >> 16);
    Vt[(c4 * 4 + 2) * 72 + i] = (u16)(w23 & 0xffffu); Vt[(c4 * 4 + 3) * 72 + i] = (u16)(w23 >> 16);
  }
  f32x4 hacc[8];
#pragma unroll
  for (int vt = 0; vt < 8; ++vt) hacc[vt] = (f32x4){0.f, 0.f, 0.f, 0.f};
  const int lrow = wave * 16 + l15;
#pragma unroll 1
  for (int dir = 0; dir < 2; ++dir) {
    const int j = dir ? nc - 1 - c : c;
    const int slj = mslot(sq, h, dir, j);
    const float mprev = p.mp[slj];
    {
      const f32x4* cpp = (const f32x4*)(p.cp + (size_t)slj * 8192);
#pragma unroll
      for (int r = 0; r < 8; ++r) {
        int e4 = tid + 256 * r;
        f32x4 cv = cpp[e4];
        uint2 a; a.x = pack2(cv[0], cv[1]); a.y = pack2(cv[2], cv[3]);
        *(uint2*)(Cb + (e4 >> 4) * 72 + (e4 & 15) * 4) = a;
      }
    }
    if (tid < 64) nv[tid] = p.np[slj * 64 + tid];
    if (wave == 0) {
      const int i = lane;
      const int tau = dir ? 63 - i : i;
      const float* row = p.proj + (size_t)(base + tau) * 2432 + 1536;
      float ig = row[(dir * 2 + 0) * 4 + h] + p.c_gate_bias[o * 16 + (dir * 2 + 0) * 4 + h];
      float fg = row[(dir * 2 + 1) * 4 + h] + p.c_gate_bias[o * 16 + (dir * 2 + 1) * 4 + h];
      float bsum = logsig_f(fg);
#pragma unroll
      for (int off = 1; off < 64; off <<= 1) { float v = __shfl_up(bsum, off); if (lane >= off) bsum += v; }
      float ib = ig - bsum;
      float pm = ib;
#pragma unroll
      for (int off = 1; off < 64; off <<= 1) { float v = __shfl_up(pm, off); if (lane >= off) pm = fmaxf(pm, v); }
      float mti = fmaxf(bsum + mprev, bsum + pm);
      bl[tau] = bsum; itb[tau] = ib; mt[tau] = mti; w0[tau] = __expf(bsum + mprev - mti);
    }
    __syncthreads();
    const float bll = bl[lrow], mtl = mt[lrow], w0l = w0[lrow];
    bf16x8 qf[2];
#pragma unroll
    for (int ks = 0; ks < 2; ++ks) qf[ks] = *(const bf16x8*)(Qb + lrow * 72 + ks * 32 + q4 * 8);
    float nqp = 0.f;
#pragma unroll
    for (int ks = 0; ks < 2; ++ks)
#pragma unroll
      for (int jj = 0; jj < 8; ++jj) {
        float qe = __uint_as_float(((unsigned)(unsigned short)qf[ks][jj]) << 16);
        nqp = fmaf(qe, nv[ks * 32 + q4 * 8 + jj], nqp);
      }
    nqp += __shfl_xor(nqp, 16); nqp += __shfl_xor(nqp, 32);
    f32x4 oacc[8];
#pragma unroll
    for (int vt = 0; vt < 8; ++vt) {
      oacc[vt] = (f32x4){0.f, 0.f, 0.f, 0.f};
#pragma unroll
      for (int ks = 0; ks < 2; ++ks) {
        bf16x8 a = *(const bf16x8*)(Cb + (vt * 16 + l15) * 72 + ks * 32 + q4 * 8);
        oacc[vt] = mfma16(a, qf[ks], oacc[vt]);
      }
      oacc[vt] *= w0l;
    }
    float sv[16];
    float dsum = 0.f;
#pragma unroll
    for (int st = 0; st < 4; ++st) {
      f32x4 sa = {0.f, 0.f, 0.f, 0.f};
#pragma unroll
      for (int ks = 0; ks < 2; ++ks) {
        bf16x8 a = *(const bf16x8*)(Kb + (st * 16 + l15) * 72 + ks * 32 + q4 * 8);
        sa = mfma16(a, qf[ks], sa);
      }
#pragma unroll
      for (int r = 0; r < 4; ++r) {
        const int sidx = st * 16 + q4 * 4 + r;
        const bool ok = dir ? (sidx >= lrow) : (sidx <= lrow);
        float val = ok ? sa[r] * __expf(bll + itb[sidx] - mtl) : 0.f;
        sv[st * 4 + r] = val;
        dsum += val;
      }
    }
    dsum += __shfl_xor(dsum, 16); dsum += __shfl_xor(dsum, 32);
    bf16x8 pf[2];
#pragma unroll
    for (int hf = 0; hf < 2; ++hf) {
      u32x4 pw;
      pw[0] = pack2(sv[hf * 8 + 0], sv[hf * 8 + 1]); pw[1] = pack2(sv[hf * 8 + 2], sv[hf * 8 + 3]);
      pw[2] = pack2(sv[hf * 8 + 4], sv[hf * 8 + 5]); pw[3] = pack2(sv[hf * 8 + 6], sv[hf * 8 + 7]);
      pf[hf] = __builtin_bit_cast(bf16x8, pw);
    }
    const float dn_ = dsum + w0l * nqp;
    const float inv = 1.f / fmaxf(fabsf(dn_), __expf(-mtl));
#pragma unroll
    for (int vt = 0; vt < 8; ++vt) {
#pragma unroll
      for (int hf = 0; hf < 2; ++hf) {
        const u16* vp = Vt + (vt * 16 + l15) * 72 + hf * 32 + q4 * 4;
        s16x4 v0 = *(const s16x4*)vp;
        s16x4 v1 = *(const s16x4*)(vp + 16);
        bf16x8 vf = (bf16x8){v0.x, v0.y, v0.z, v0.w, v1.x, v1.y, v1.z, v1.w};
        oacc[vt] = mfma16(vf, pf[hf], oacc[vt]);
      }
      hacc[vt] += oacc[vt] * inv;
    }
    __syncthreads();
  }
  float ss = 0.f;
#pragma unroll
  for (int vt = 0; vt < 8; ++vt)
#pragma unroll
    for (int r = 0; r < 4; ++r) ss += hacc[vt][r] * hacc[vt][r];
  ss += __shfl_xor(ss, 16); ss += __shfl_xor(ss, 32);
  const float rn = rsqrtf(ss * (1.f / 128.f) + EPS);
  const int m = base + lrow;
#pragma unroll
  for (int vt = 0; vt < 8; ++vt) {
    const int v0 = vt * 16 + q4 * 4;
    f32x4 co = *(const f32x4*)(p.proj + (size_t)m * 2432 + 1024 + h * 128 + v0);
    f32x4 gn = *(const f32x4*)(p.c_out_norm + (size_t)(o * 4 + h) * 128 + v0);
    float y0 = sigmoid_f(co[0]) * hacc[vt][0] * rn * gn[0];
    float y1 = sigmoid_f(co[1]) * hacc[vt][1] * rn * gn[1];
    float y2 = sigmoid_f(co[2]) * hacc[vt][2] * rn * gn[2];
    float y3 = sigmoid_f(co[3]) * hacc[vt][3] * rn * gn[3];
    uint2 oo; oo.x = pack2(y0, y1); oo.y = pack2(y2, y3);
    *(uint2*)(p.mix + (size_t)m * 1024 + h * 128 + v0) = oo;
  }
  __syncthreads();
}

__device__ __forceinline__ void mlstm_scan_phase(PRM p, int o) {
  const int tid = get_tid();
  for (int task = get_bid(); task < 576; task += gridDim.x) {
    const int sc = task >> 2, slice = task & 3;
    int sq, h, dir;
    if (sc < 128) { sq = sc >> 3; h = (sc >> 1) & 3; dir = sc & 1; }
    else { int u = sc - 128; sq = 16 + (u >> 3); h = (u >> 1) & 3; dir = u & 1; }
    const bool pr = sq < 16;
    const int nc = pr ? 4 : 16;
    const int sidx = pr ? ((sq * 2 + o) * 2 + dir) * 4 + h : 0;
    const int cidx = pr ? 0 : (((sq - 16) * 2 + o) * 2 + dir) * 4 + h;
    const int e0 = slice * 2048 + tid;
    float C[8];
#pragma unroll
    for (int r = 0; r < 8; ++r) C[r] = pr ? 0.f : p.state_C[(size_t)cidx * 8192 + e0 + 256 * r];
    const bool nthr = (slice == 0) && (tid < 64);
    float n = (pr || !nthr) ? 0.f : p.state_n[cidx * 64 + tid];
    float m = pr ? 0.f : p.state_m[cidx];
#pragma unroll 4
    for (int j = 0; j < nc; ++j) {
      const int sl = mslot(sq, h, dir, j);
      float* cp = p.cp + (size_t)sl * 8192 + e0;
      const float* dc = p.dC + (size_t)sl * 8192 + e0;
#pragma unroll
      for (int r = 0; r < 8; ++r) cp[256 * r] = C[r];
      if (nthr) { p.np[sl * 64 + tid] = n; if (tid == 0) p.mp[sl] = m; }
      const float ml = p.dm[sl * 2], bls = p.dm[sl * 2 + 1];
      const float mn = fmaxf(bls + m, ml);
      const float ca = __expf(bls + m - mn), cb = __expf(ml - mn);
#pragma unroll
      for (int r = 0; r < 8; ++r) C[r] = ca * C[r] + cb * dc[256 * r];
      if (nthr) n = ca * n + cb * p.dn[sl * 64 + tid];
      m = mn;
    }
    if (pr) {
      float* oc = p.out + O_CC + (size_t)sidx * 8192 + e0;
#pragma unroll
      for (int r = 0; r < 8; ++r) oc[256 * r] = C[r];
      if (nthr) { p.out[O_CN + (size_t)sidx * 64 + tid] = n; if (tid == 0) p.out[O_CM + sidx] = m; }
    }
  }
}

__device__ __forceinline__ void odd_mid_phase(PRM p, int o, char* smem) {
  u16* lds = (u16*)smem;
  const int tid = get_tid(), lane = tid & 63, wave = tid >> 6, l15 = lane & 15, q4 = lane >> 4;
  for (int bt = get_bid(); bt < 256 + 768 + 512; bt += gridDim.x) {
    if (bt < 256) {
      int qb = bt & 15, hq = (bt >> 4) & 7, b = bt >> 7;
      int kvh = hq >> 2;
      int mq = NPR + b * 1024 + qb * 64 + wave * 16;
      AttnSt st; attn_init(st);
      bf16x8 qf[2]; load_q64(qf, p.qa + (size_t)mq * 512 + hq * 64, 512, l15, q4);
      at_run_plain<2>(st, qf, p.kd + (size_t)(NPR + b * 1536) * 128 + kvh * 64, 128, p.vtd_s + (size_t)((b * 2 + kvh) * 64) * 1536, 1536, 24, 0.125f, lds, tid, l15, q4);
      attn_fin(st, p.mix + (size_t)mq * 1024 + 512 + hq * 64, l15, q4);
    } else if (bt < 256 + 768) {
      mlstm1_task(p, o, bt - 256, (float*)smem);
    } else {
      int u = bt - 1024;
      int qb = u & 3, hq = (u >> 2) & 7, b = u >> 5;
      int kvh = hq >> 2;
      int mq = b * 256 + qb * 64 + wave * 16;
      AttnSt st; attn_init(st);
      bf16x8 qf[2]; load_q64(qf, p.qa + (size_t)mq * 512 + hq * 64, 512, l15, q4);
      at_run_plain<2>(st, qf, p.kd + (size_t)(b * 256) * 128 + kvh * 64, 128, p.vtd_p + (size_t)((b * 2 + kvh) * 64) * 256, 256, 4, 0.125f, lds, tid, l15, q4);
      attn_fin(st, p.mix + (size_t)mq * 1024 + 512 + hq * 64, l15, q4);
    }
  }
}

__device__ __forceinline__ void run_phase(PRM p, int ph, char* smem) {
  if (ph == 0) { phase0(p, smem); return; }
  if (ph == NPHASE - 1) { norm_phase(p, 0, 3); return; }
  const int l = (ph - 1) / 13, s = (ph - 1) % 13;
  const int eo = l >> 1;
  const bool even = (l & 1) == 0;
  EpiP e{};
  const float* modl = p.mod + (size_t)l * 3 * 9216;
  switch (s) {
    case 0: norm_phase(p, l, 0); break;
    case 1: e.H = p.h; ffn_in_phase(p, l, 0, e, smem); break;
    case 2: e.C = p.x; e.gate = modl + 2 * 1024; e.ldc = 1;
            gemm_phase<EPI_RESID, 2, 2, 3, 4>(p.h, p.wt_ffn_out + (size_t)(l * 2 + 0) * 1024 * 2816, 2816, 64, 8, e, smem); break;
    case 3: norm_phase(p, l, 1); break;
    case 4:
      if (even) { e.C = p.proj; e.ldc = 2688; gemm_phase<EPI_STORE, 2, 2, 4, 4>(p.xn, p.wt_in_e + (size_t)eo * 2688 * 1024, 1024, 48, 21, e, smem); }
      else { e.C = p.proj; e.ldc = 2432; gemm_phase<EPI_STORE, 2, 2, 4, 4>(p.xn, p.wt_in_o + (size_t)eo * 2432 * 1024, 1024, 48, 19, e, smem); }
      break;
    case 5: if (even) post_even(p, eo); else post_odd(p, eo); break;
    case 6:
      if (even) {
        EpiP eq{}; eq.C = p.qb; eq.ldc = 768;
        EpiP ek{}; ek.kb = p.kb; ek.vtp = p.vtb_p; ek.vts = p.vtb_s; ek.ctx = 0;
        EpiP ec = ek; ec.ctx = 1;
        const u16* wq = p.wt_qup + (size_t)eo * 768 * 768;
        const u16* wk = p.wt_kvup + (size_t)eo * 1024 * 256;
        for (int t = get_bid(); t < 288 + 384 + 64; t += gridDim.x) {
          if (t < 288) gemm_tile<EPI_STORE, 2, 2, 4, 4>(p.cqn, wq, 768, t % 48, t / 48, eq, smem);
          else if (t < 672) { int u = t - 288; gemm_tile<EPI_KVUP, 2, 2, 4, 4>(p.ckvn, wk, 256, u % 48, u / 48, ek, smem); }
          else { int u = t - 672; gemm_tile<EPI_KVUP, 2, 2, 4, 4>(p.cctxn, wk, 256, u % 8, u / 8, ec, smem); }
        }
      } else odd_mid_phase(p, eo, smem);
      break;
    case 7: if (!even) mlstm_scan_phase(p, eo); break;
    case 8:
      if (even) attn_even_phase(p, eo, smem);
      else { for (int t = get_bid(); t < 384; t += gridDim.x) mlstm2_mfma(p, eo, t, smem); }
      break;
    case 9: e.C = p.x; e.gate = modl + 5 * 1024; e.ldc = 0;
            gemm_phase<EPI_RESID, 2, 2, 3, 4>(p.mix, p.wt_out + (size_t)l * 1024 * 1024, 1024, 64, 8, e, smem); break;
    case 10: norm_phase(p, l, 2); break;
    case 11: e.H = p.h; ffn_in_phase(p, l, 1, e, smem); break;
    case 12: e.C = p.x; e.gate = modl + 8 * 1024; e.ldc = 1;
             gemm_phase<EPI_RESID, 2, 2, 3, 4>(p.h, p.wt_ffn_out + (size_t)(l * 2 + 1) * 1024 * 2816, 2816, 64, 8, e, smem); break;
  }
}

__global__ void __launch_bounds__(256, 2) mega(Params p) {
  __shared__ __attribute__((aligned(16))) char smem[LDS_BYTES];
  __shared__ uint4 xb_words;
  cg::grid_group grid = cg::this_grid();
  if (threadIdx.x == 0) xb_words = make_uint4(0u, 0u, 0u, 0u);
  __syncthreads();
  XcdBarrier xb = xcd_barrier_post(p.bar, (volatile LAS unsigned*)&xb_words);
  for (int ph = p.ph0; ph < p.ph1; ++ph) {
    const __attribute__((address_space(4))) Params* pp = (const __attribute__((address_space(4))) Params*)__builtin_amdgcn_kernarg_segment_ptr();
    if (ph > 0 && ph < NPHASE - 1 && ((ph - 1) % 13) == 7 && ((((ph - 1) / 13) & 1) == 0)) continue;
    asm volatile("" : "+s"(pp));
    run_phase(*pp, ph, smem);
#ifndef REPMASK
#define REPMASK 0
#endif
#ifndef REPPAR
#define REPPAR 0
#endif
    if (REPMASK) {
      int bit = ph == 0 ? 13 : (ph == NPHASE - 1 ? 14 : (ph - 1) % 13);
      int lay = (ph - 1) / 13;
      bool parok = REPPAR == 0 || ph == 0 || ph == NPHASE - 1 || (REPPAR == 1 && (lay & 1) == 0) || (REPPAR == 2 && (lay & 1) == 1);
      if (((REPMASK >> bit) & 1) && parok) { xcd_barrier(xb); asm volatile("" : "+s"(pp)); run_phase(*pp, ph, smem); }
    }
    if (ph + 1 < p.ph1) {
      if (p.ph1 > 100000) grid.sync();
      xcd_barrier(xb);
    }
  }
}

extern "C" void kernel_launch(void* const* d_in, const int* in_sizes, int n_in, void* d_out, int out_size, void* d_ws, size_t ws_size,
                              hipStream_t stream) {
  static int grid_blocks = 0;
  if (!grid_blocks) {
    int dev = 0, cus = 0, per_cu = 0;
    hipGetDevice(&dev);
    hipDeviceGetAttribute(&cus, hipDeviceAttributeMultiprocessorCount, dev);
    hipOccupancyMaxActiveBlocksPerMultiprocessor(&per_cu, mega, 256, 0);
    if (per_cu < 1) per_cu = 1;
    if (per_cu > 2) per_cu = 2;
    grid_blocks = cus * per_cu;
  }
  Params p{};
  const float** ip = (const float**)&p.x_prompt;
  for (int i = 0; i < 31; ++i) ip[i] = (const float*)d_in[i];
  p.out = (float*)d_out;
  char* w = (char*)d_ws;
  size_t off = 0;
  auto take = [&](size_t bytes) { char* r = w + off; off += (bytes + 255) & ~(size_t)255; return r; };
  p.wt_ffn_in = (u16*)take((size_t)8 * 5632 * 1024 * 2);
  p.wt_ffn_out = (u16*)take((size_t)8 * 1024 * 2816 * 2);
  p.wt_in_e = (u16*)take((size_t)2 * 2688 * 1024 * 2);
  p.wt_in_o = (u16*)take((size_t)2 * 2432 * 1024 * 2);
  p.wt_out = (u16*)take((size_t)4 * 1024 * 1024 * 2);
  p.wt_qup = (u16*)take((size_t)2 * 768 * 768 * 2);
  p.wt_kvup = (u16*)take((size_t)2 * 1024 * 256 * 2);
  p.mod = (float*)take((size_t)12 * 9216 * 4);
  p.x = (float*)take((size_t)NTOK * 1024 * 4);
  p.proj = (float*)take((size_t)NTOK * 2688 * 4);
  p.qb = (float*)take((size_t)NTOK * 768 * 4);
  p.dC = (float*)take((size_t)768 * 8192 * 4);
  p.dn = (float*)take((size_t)768 * 64 * 4);
  p.dm = (float*)take((size_t)768 * 2 * 4);
  p.cp = (float*)take((size_t)768 * 8192 * 4);
  p.np = (float*)take((size_t)768 * 64 * 4);
  p.mp = (float*)take((size_t)768 * 4);
  p.xn = (u16*)take((size_t)NTOK * 1024 * 2);
  p.h = (u16*)take((size_t)NTOK * 2816 * 2);
  p.mix = (u16*)take((size_t)NTOK * 1024 * 2);
  p.qa = (u16*)take((size_t)NTOK * 512 * 2);
  p.ka = (u16*)take((size_t)NTOK * 512 * 2);
  p.kactx = (u16*)take((size_t)1024 * 512 * 2);
  p.vta_p = (u16*)take((size_t)16 * 8 * 64 * 256 * 2);
  p.vta_s = (u16*)take((size_t)2 * 8 * 64 * 1536 * 2);
  p.kb = (u16*)take((size_t)7168 * 768 * 2);
  p.vtb_p = (u16*)take((size_t)16 * 8 * 64 * 256 * 2);
  p.vtb_s = (u16*)take((size_t)2 * 8 * 64 * 1536 * 2);
  p.cqn = (u16*)take((size_t)NTOK * 768 * 2);
  p.ckvn = (u16*)take((size_t)NTOK * 256 * 2);
  p.cctxn = (u16*)take((size_t)1024 * 256 * 2);
  p.kd = (u16*)take((size_t)7168 * 128 * 2);
  p.vtd_p = (u16*)take((size_t)16 * 2 * 64 * 256 * 2);
  p.vtd_s = (u16*)take((size_t)2 * 2 * 64 * 1536 * 2);
  p.bar = (unsigned*)take((size_t)XCD_BAR_WORDS * 4);
  if (off > ws_size) { fprintf(stderr, "kernel_launch: workspace too small: need %zu have %zu\n", off, ws_size); return; }
  hipMemsetAsync(p.bar, 0, (size_t)XCD_BAR_WORDS * 4, stream);
#if MULTI
  for (int ph = 0; ph < NPHASE; ++ph) {
    p.ph0 = ph; p.ph1 = ph + 1;
    hipLaunchKernelGGL(mega, dim3(grid_blocks), dim3(256), 0, stream, p);
  }
#else
  p.ph0 = 0; p.ph1 = NPHASE;
  void* args[] = {&p};
  hipError_t e = hipLaunchCooperativeKernel((void*)mega, dim3(grid_blocks), dim3(256), args, 0, stream);
  if (e != hipSuccess) fprintf(stderr, "cooperative launch failed: %s (grid %d)\n", hipGetErrorString(e), grid_blocks);
#endif
}
```

```cpp
#include <hip/hip_runtime.h>
#include <hip/hip_cooperative_groups.h>
#include <cstdio>
#include <cstdint>
namespace cg = cooperative_groups;

#ifndef MULTI
#define MULTI 0
#endif

typedef unsigned short u16;
typedef __attribute__((ext_vector_type(8))) short bf16x8;
typedef __attribute__((ext_vector_type(4))) short s16x4;
typedef __attribute__((ext_vector_type(4))) float f32x4;
typedef __attribute__((ext_vector_type(4))) unsigned int u32x4;

#define NTOK 6144
#define NPR 4096
#define LDS_HALF 77824
#define LDS_BYTES (2 * LDS_HALF)
#define NPHASE 54
#define EPS 1e-6f

struct Params {
  const float *x_prompt, *x_sample, *cache_a_k, *cache_a_v, *cache_b_ckv, *cache_b_krope, *cache_d_k, *cache_d_v;
  const float *state_C, *state_n, *state_m, *c, *c_ctx, *w_mod, *b_mod, *norm_g, *ffn_in, *ffn_out;
  const float *w_in_even, *w_in_odd, *w_out, *a_rpb, *b_q_norm, *b_wq_up, *b_kv_norm, *b_wkv_up;
  const float *c_gate_bias, *c_out_norm, *d_q_norm, *d_k_norm, *final_norm;
  float* out;
  u16 *wt_ffn_in, *wt_ffn_out, *wt_in_e, *wt_in_o, *wt_out, *wt_qup, *wt_kvup;
  float *mod, *x, *proj, *qb, *dC, *dn, *dm, *cp, *np, *mp;
  u16 *xn, *h, *mix, *qa, *ka, *kactx, *vta_p, *vta_s, *kb, *vtb_p, *vtb_s, *cqn, *ckvn, *cctxn, *kd, *vtd_p, *vtd_s;
  unsigned* bar;
  int ph0, ph1;
};

typedef const __attribute__((address_space(4))) Params& PRM;
#define O_YP 0
#define O_YS 4194304
#define O_AK 6291456
#define O_AV 10485760
#define O_CKV 14680064
#define O_KR 16777216
#define O_DK 17039360
#define O_DV 18087936
#define O_CC 19136512
#define O_CN 21233664
#define O_CM 21250048

__device__ __forceinline__ int get_tid() { int t = threadIdx.x & 255; asm volatile("" : "+v"(t)); return t; }
__device__ __forceinline__ int rtid_raw() { int t = threadIdx.x; asm volatile("" : "+v"(t)); return t; }
__device__ __forceinline__ int get_bid() { int t = blockIdx.x * 2 + __builtin_amdgcn_readfirstlane(rtid_raw() >> 8); asm volatile("" : "+s"(t)); return t; }
__device__ __forceinline__ int vgrid() { return (int)gridDim.x * 2; }
__device__ __forceinline__ int rtid() { int t = threadIdx.x; asm volatile("" : "+v"(t)); return t; }
__device__ __forceinline__ int rbid() { int t = blockIdx.x; asm volatile("" : "+s"(t)); return t; }
typedef __attribute__((ext_vector_type(2))) __bf16 bf16x2_t;
typedef __attribute__((ext_vector_type(2))) float f32x2_t;
__device__ __forceinline__ unsigned pack2(float a, float b) {
  f32x2_t v = {a, b};
  bf16x2_t r = __builtin_convertvector(v, bf16x2_t);
  return __builtin_bit_cast(unsigned, r);
}
__device__ __forceinline__ u16 f2bf(float f) { return (u16)(pack2(f, 0.f) & 0xffffu); }
__device__ __forceinline__ float shx(float v, int m) {
  int l = __builtin_amdgcn_mbcnt_hi(-1, __builtin_amdgcn_mbcnt_lo(-1, 0));
  asm volatile("" : "+v"(l));
  return __int_as_float(__builtin_amdgcn_ds_bpermute((l ^ m) << 2, __float_as_int(v)));
}
__device__ __forceinline__ float wsum(float v) {
#pragma unroll
  for (int o = 32; o; o >>= 1) v += shx(v, o);
  return v;
}
__device__ __forceinline__ float wmaxr(float v) {
#pragma unroll
  for (int o = 32; o; o >>= 1) v = fmaxf(v, shx(v, o));
  return v;
}
__device__ __forceinline__ float silu_f(float x) { return x / (1.f + __expf(-x)); }
__device__ __forceinline__ float sigmoid_f(float x) { return 1.f / (1.f + __expf(-x)); }
__device__ __forceinline__ float logsig_f(float x) { return fminf(x, 0.f) - __logf(1.f + __expf(-fabsf(x))); }
__device__ __forceinline__ void sincos_r(float a, float& s, float& c) {
  float n = rintf(a * 0.15915494309f);
  float r = fmaf(-n, 6.2831855f, a);
  r = fmaf(-n, -1.7484555e-7f, r);
  s = __sinf(r); c = __cosf(r);
}
__device__ __forceinline__ int grp_of(int m) { return m < NPR ? 0 : 1 + ((m - NPR) >> 10); }
__device__ __forceinline__ int keyrow(int m) { return m < NPR ? m : NPR + ((m - NPR) >> 10) * 1536 + ((m - NPR) & 1023); }
__device__ __forceinline__ f32x4 mfma16(bf16x8 a, bf16x8 b, f32x4 c) { return __builtin_amdgcn_mfma_f32_16x16x32_bf16(a, b, c, 0, 0, 0); }

#define XB_TMO      128
#define XB_XCNT(j)  (256  + 64 * (j))
#define XB_XSUB(j)  (1280 + 64 * (j))
#define XB_XGEN(j)  (2304 + 64 * (j))
#define XB_TOP      3328
#define XB_TOPGEN   3392
#define XCD_BAR_WORDS 3456
#define XB_SPIN_CAP (1u << 18)
#define LAS __attribute__((address_space(3)))

__device__ __forceinline__ unsigned xb_ld(unsigned* p)              { return __hip_atomic_load(p, __ATOMIC_RELAXED, __HIP_MEMORY_SCOPE_AGENT); }
__device__ __forceinline__ unsigned xb_add(unsigned* p, unsigned v) { return __hip_atomic_fetch_add(p, v, __ATOMIC_RELAXED, __HIP_MEMORY_SCOPE_AGENT); }
__device__ __forceinline__ unsigned xb_xcc_id() { return (unsigned)__builtin_amdgcn_s_getreg((3 << 11) | 20) & 0xFu; }
#define XB_SPIN(cond, bar) do { unsigned _sp = 0; while (cond) { __builtin_amdgcn_s_sleep(1); \
    if ((++_sp & 255u) == 0u) { if (xb_ld(&(bar)[XB_TMO])) break; if (_sp > XB_SPIN_CAP) { atomicAdd(&(bar)[XB_TMO], 1u); break; } } } } while (0)

struct XcdBarrier {
    unsigned* bar; unsigned x;
    volatile LAS unsigned* st;
};

__device__ __forceinline__ XcdBarrier xcd_barrier_post(unsigned* bar, volatile LAS unsigned* st) {
    XcdBarrier b; b.bar = bar; b.x = xb_xcc_id(); b.st = st;
    if (threadIdx.x == 0) (void)xb_add(&bar[XB_XCNT(b.x)], 1u);
    return b;
}
__device__ __forceinline__ void xcd_barrier_complete(unsigned* bar, unsigned x, unsigned& nloc, unsigned& nx) {
    const unsigned G = gridDim.x * gridDim.y * gridDim.z;
    unsigned sum, cnt, mine, sp = 0u;
    for (;;) {
        sum = 0u; cnt = 0u; mine = 0u;
#pragma unroll
        for (unsigned j = 0; j < 16; ++j) { const unsigned c = xb_ld(&bar[XB_XCNT(j)]); sum += c; cnt += (c > 0u) ? 1u : 0u; mine = (j == x) ? c : mine; }
        if (sum == G) break;
        __builtin_amdgcn_s_sleep(1);
        if ((++sp & 255u) == 0u) { if (xb_ld(&bar[XB_TMO])) break; if (sp > XB_SPIN_CAP) { atomicAdd(&bar[XB_TMO], 1u); break; } }
    }
    nloc = mine > 0u ? mine : 1u; nx = cnt > 0u ? cnt : 1u;
}

__device__ __forceinline__ void xcd_barrier(const XcdBarrier& b) {
    asm volatile("s_waitcnt vmcnt(0)" ::: "memory");
    __syncthreads();
    if (threadIdx.x == 0) {
        unsigned* bar = b.bar;
        __builtin_amdgcn_s_waitcnt(0);
        unsigned nloc = b.st[0], nx = b.st[1];
        if (nloc == 0u) { xcd_barrier_complete(bar, b.x, nloc, nx); b.st[0] = nloc; b.st[1] = nx; }
        const unsigned old = xb_add(&bar[XB_XSUB(b.x)], 1u);
        const unsigned gen = old / nloc;
        if (old + 1u == (gen + 1u) * nloc) {
            __builtin_amdgcn_fence(__ATOMIC_RELEASE, "agent");
            asm volatile("s_waitcnt vmcnt(0)" ::: "memory");
            const unsigned og = xb_add(&bar[XB_TOP], 1u);
            const unsigned tg = og / nx;
            if (og + 1u == (tg + 1u) * nx) xb_add(&bar[XB_TOPGEN], 1u);
            else XB_SPIN(xb_ld(&bar[XB_TOPGEN]) == tg, bar);
            __builtin_amdgcn_fence(__ATOMIC_ACQUIRE, "agent");
            xb_add(&bar[XB_XGEN(b.x)], 1u);
            asm volatile("s_waitcnt vmcnt(0)" ::: "memory");
        } else {
            XB_SPIN(xb_ld(&bar[XB_XGEN(b.x)]) == gen, bar);
            __builtin_amdgcn_fence(__ATOMIC_ACQUIRE, "agent");
            asm volatile("s_waitcnt vmcnt(0)" ::: "memory");
        }
    }
    __syncthreads();
}


__device__ __forceinline__ void conv_tile(const float* __restrict__ src, int K, int N, int perm, u16* __restrict__ dst, int kt2, int nt, float* tile) {
  const int tid = get_tid();
  {
    const int c4 = tid & 15, kr = tid >> 4;
    const int n = nt * 64 + c4 * 4;
    const bool valid = n < N;
    int col = n;
    if (perm) { int G = n >> 4, w = n & 15, sub = w >> 2; col = ((sub & 1) ? 2816 : 0) + G * 8 + (sub >> 1) * 4 + (w & 3); }
    float4 v[8];
#pragma unroll
    for (int i = 0; i < 8; ++i) {
      int kk = kr + 16 * i;
      v[i] = valid ? *(const float4*)(src + (size_t)(kt2 * 128 + kk) * N + col) : make_float4(0.f, 0.f, 0.f, 0.f);
    }
#pragma unroll
    for (int i = 0; i < 8; ++i) {
      int kk = kr + 16 * i;
      float* t = tile + (kk >> 6) * 4160 + (kk & 63) * 65 + c4 * 4;
      t[0] = v[i].x; t[1] = v[i].y; t[2] = v[i].z; t[3] = v[i].w;
    }
  }
  __syncthreads();
  {
    const int k8 = (tid & 7) * 8;
#pragma unroll
    for (int hh = 0; hh < 2; ++hh)
#pragma unroll
      for (int i = 0; i < 2; ++i) {
        int nn2 = (tid >> 3) + 32 * i;
        float v[8];
#pragma unroll
        for (int e = 0; e < 8; ++e) v[e] = tile[hh * 4160 + (k8 + e) * 65 + nn2];
        uint4 o; o.x = pack2(v[0], v[1]); o.y = pack2(v[2], v[3]); o.z = pack2(v[4], v[5]); o.w = pack2(v[6], v[7]);
        *(uint4*)(dst + (size_t)(nt * 64 + nn2) * K + kt2 * 128 + hh * 64 + k8) = o;
      }
  }
  __syncthreads();
}

__device__ __forceinline__ void mod_task(PRM p, int t, float* sm) {
  const int l = t / 144, cb = t % 144, tid = get_tid();
  float* sc = sm;
  float* red = sm + 3072;
  for (int i = tid; i < 3072; i += 256) {
    int g = i >> 10, k = i & 1023;
    float v = g == 0 ? p.c_ctx[k] : p.c[(g - 1) * 1024 + k];
    sc[i] = silu_f(v);
  }
  __syncthreads();
  const int c4 = tid & 15, kg = tid >> 4;
  const float* w = p.w_mod + (size_t)l * 1024 * 9216 + (size_t)(kg * 64) * 9216 + cb * 64 + c4 * 4;
  float a[3][4];
#pragma unroll
  for (int g = 0; g < 3; ++g)
#pragma unroll
    for (int q = 0; q < 4; ++q) a[g][q] = 0.f;
  for (int k = 0; k < 64; k += 8) {
    float4 wv[8];
#pragma unroll
    for (int e = 0; e < 8; ++e) wv[e] = *(const float4*)(w + (size_t)(k + e) * 9216);
#pragma unroll
    for (int e = 0; e < 8; ++e) {
      int kk = kg * 64 + k + e;
#pragma unroll
      for (int g = 0; g < 3; ++g) {
        float sv = sc[g * 1024 + kk];
        a[g][0] = fmaf(sv, wv[e].x, a[g][0]); a[g][1] = fmaf(sv, wv[e].y, a[g][1]);
        a[g][2] = fmaf(sv, wv[e].z, a[g][2]); a[g][3] = fmaf(sv, wv[e].w, a[g][3]);
      }
    }
  }
#pragma unroll
  for (int g = 0; g < 3; ++g)
#pragma unroll
    for (int q = 0; q < 4; ++q) red[(kg * 3 + g) * 64 + c4 * 4 + q] = a[g][q];
  __syncthreads();
  if (tid < 192) {
    int g = tid >> 6, c2 = tid & 63;
    float s = 0.f;
#pragma unroll
    for (int q = 0; q < 16; ++q) s += red[(q * 3 + g) * 64 + c2];
    int j = cb * 64 + c2;
    p.mod[(size_t)(l * 3 + g) * 9216 + j] = s + p.b_mod[l * 9216 + j];
  }
  __syncthreads();
}

__device__ __forceinline__ int conv_layer_count(int l) { return (l & 1) ? 2544 : 2680; }
__device__ __forceinline__ void conv_layer_task(PRM p, int l, int u, float* sm) {
  const float* src; u16* dst; int K, N, Npad, perm = 0, tp, mat0;
  const int eo = l >> 1;
  const int nin = (l & 1) ? 304 : 336;
  if (u < 1408) { K = 1024; N = 5632; Npad = 5632; perm = 1; tp = 704; src = p.ffn_in; dst = p.wt_ffn_in; mat0 = l * 2; }
  else if ((u -= 1408) < 704) { K = 2816; N = 1024; Npad = 1024; tp = 352; src = p.ffn_out; dst = p.wt_ffn_out; mat0 = l * 2; }
  else if ((u -= 704) < nin) {
    if (l & 1) { K = 1024; N = 2320; Npad = 2432; tp = 304; src = p.w_in_odd; dst = p.wt_in_o; mat0 = eo; }
    else { K = 1024; N = 2592; Npad = 2688; tp = 336; src = p.w_in_even; dst = p.wt_in_e; mat0 = eo; }
  }
  else if ((u -= nin) < 128) { K = 1024; N = 1024; Npad = 1024; tp = 128; src = p.w_out; dst = p.wt_out; mat0 = l; }
  else if ((u -= 128) < 72) { K = 768; N = 768; Npad = 768; tp = 72; src = p.b_wq_up; dst = p.wt_qup; mat0 = eo; }
  else { u -= 72; K = 256; N = 1024; Npad = 1024; tp = 32; src = p.b_wkv_up; dst = p.wt_kvup; mat0 = eo; }
  int mat = mat0 + u / tp, r = u % tp;
  int nkt = K / 128;
  int kt = r % nkt, nt = r / nkt;
  conv_tile(src + (size_t)mat * K * N, K, N, perm, dst + (size_t)mat * Npad * K, kt, nt, sm);
}

__device__ __forceinline__ void phase0(PRM p, char* smem) {
  float* sm = (float*)smem;
  const int NMOD = 144, NCOPY = 1536, NCONV = 2680;
  const int total = NMOD + NCOPY + NCONV;
  for (int t = get_bid(); t < total; t += vgrid()) {
    if (t < NMOD) { mod_task(p, t, sm); continue; }
    int u = t - NMOD;
    if (u < NCOPY) {
      const int tid = get_tid();
#pragma unroll
      for (int i = 0; i < 4; ++i) {
        size_t idx = ((size_t)u * 1024 + i * 256 + tid);
        const float4* src = idx < (size_t)NPR * 256 ? (const float4*)p.x_prompt + idx : (const float4*)p.x_sample + (idx - (size_t)NPR * 256);
        ((float4*)p.x)[idx] = *src;
      }
      continue;
    }
    conv_layer_task(p, 0, u - NCOPY, sm);
  }
}

__device__ __forceinline__ void norm_phase(PRM p, int l, int which) {
  const int lane = get_tid() & 63, wave = get_tid() >> 6;
  const int nrows_wave = NTOK / 4;
  const int stride = vgrid();
  for (int t0 = get_bid(); t0 < nrows_wave; t0 += 3 * stride) {
    float4 v[3][4];
    float ss[3];
#pragma unroll
    for (int k = 0; k < 3; ++k) {
      const int t = t0 + k * stride;
      if (t < nrows_wave) {
        const float4* xr = (const float4*)(p.x + (size_t)(t * 4 + wave) * 1024);
#pragma unroll
        for (int i = 0; i < 4; ++i) v[k][i] = xr[i * 64 + lane];
      }
    }
#pragma unroll
    for (int k = 0; k < 3; ++k) {
      float a = 0.f;
#pragma unroll
      for (int i = 0; i < 4; ++i) a += v[k][i].x * v[k][i].x + v[k][i].y * v[k][i].y + v[k][i].z * v[k][i].z + v[k][i].w * v[k][i].w;
      ss[k] = wsum(a);
    }
#pragma unroll
    for (int k = 0; k < 3; ++k) {
      const int t = t0 + k * stride;
      if (t >= nrows_wave) continue;
      const int m = t * 4 + wave;
      const float r = rsqrtf(ss[k] * (1.f / 1024.f) + EPS);
      if (which == 3) {
        float4* o = (float4*)(p.out + (size_t)m * 1024);
#pragma unroll
        for (int i = 0; i < 4; ++i) {
          float4 g = ((const float4*)p.final_norm)[i * 64 + lane];
          float4 y; y.x = v[k][i].x * r * g.x; y.y = v[k][i].y * r * g.y; y.z = v[k][i].z * r * g.z; y.w = v[k][i].w * r * g.w;
          o[i * 64 + lane] = y;
        }
      } else {
        const float* md = p.mod + (size_t)(l * 3 + grp_of(m)) * 9216 + which * 3072;
        const float4* sh = (const float4*)md;
        const float4* sc = (const float4*)(md + 1024);
        const float4* gg = (const float4*)(p.norm_g + (size_t)(l * 3 + which) * 1024);
#pragma unroll
        for (int i = 0; i < 4; ++i) {
          float4 g = gg[i * 64 + lane], s = sc[i * 64 + lane], b = sh[i * 64 + lane];
          float y0 = v[k][i].x * r * g.x * (1.f + s.x) + b.x;
          float y1 = v[k][i].y * r * g.y * (1.f + s.y) + b.y;
          float y2 = v[k][i].z * r * g.z * (1.f + s.z) + b.z;
          float y3 = v[k][i].w * r * g.w * (1.f + s.w) + b.w;
          uint2 o; o.x = pack2(y0, y1); o.y = pack2(y2, y3);
          *(uint2*)(p.xn + (size_t)m * 1024 + (i * 64 + lane) * 4) = o;
        }
      }
    }
  }
}

struct EpiP {
  float* C; int ldc;
  const float* gate;
  u16* H;
  u16 *kb, *vtp, *vts; int ctx;
};
enum { EPI_STORE = 0, EPI_RESID = 1, EPI_SWIGLU = 2, EPI_KVUP = 3 };

template <int FI, int FJ, bool SWAP>
__device__ __forceinline__ void g_compute(f32x4 (&acc)[FI][FJ], const u16* Ac, const u16* Bc, int q4, int rsw) {
  __builtin_amdgcn_s_setprio(1);
#pragma unroll
  for (int ks = 0; ks < 2; ++ks) {
    const int co = ((ks * 4 + q4) ^ rsw) << 3;
#pragma unroll
    for (int j0 = 0; j0 < FJ; j0 += 4) {
      bf16x8 b[4];
#pragma unroll
      for (int j = 0; j < 4; ++j) if (j0 + j < FJ) b[j] = *(const bf16x8*)(Bc + (j0 + j) * 1024 + co);
#pragma unroll
      for (int i0 = 0; i0 < FI; i0 += 4) {
        bf16x8 a[4];
#pragma unroll
        for (int i = 0; i < 4; ++i) if (i0 + i < FI) a[i] = *(const bf16x8*)(Ac + (i0 + i) * 1024 + co);
#pragma unroll
        for (int j = 0; j < 4; ++j)
          if (j0 + j < FJ) {
#pragma unroll
            for (int i = 0; i < 4; ++i)
              if (i0 + i < FI) acc[i0 + i][j0 + j] = SWAP ? mfma16(b[j], a[i], acc[i0 + i][j0 + j]) : mfma16(a[i], b[j], acc[i0 + i][j0 + j]);
          }
      }
    }
  }
  __builtin_amdgcn_s_setprio(0);
}

template <int EPI, int WMW, int WNW, int FI, int FJ, int DEPTH>
__device__ __forceinline__ void gemm_tile(const u16* __restrict__ A, const u16* __restrict__ Wt, int K, int tm, int tn, const EpiP& e, char* smem) {
  constexpr int BM = WMW * FI * 16, BN = WNW * FJ * 16;
  constexpr int NA = BM / 64, NB = BN / 64;
  constexpr int BUFSZ = (BM + BN) * 64;
  static_assert(WMW * WNW == 8 && BM % 64 == 0 && BN % 64 == 0, "tile");
  u16* As = (u16*)smem;
  u16* Bs = As + BM * 64;
  const int tid = rtid(), lane = tid & 63, wave = tid >> 6, wm = wave / WNW, wn = wave % WNW, l15 = lane & 15, q4 = lane >> 4;
  const int lr = tid >> 3, lc = tid & 7;
  const u16* Ag = A + (size_t)(tm * BM + lr) * K + lc * 8;
  const u16* Bg = Wt + (size_t)(tn * BN + lr) * K + lc * 8;
  const int st_off = lr * 64 + ((lc ^ ((lr >> 1) & 7)) << 3);
  const int rsw = (l15 >> 1) & 7;
  const int a_row = (wm * FI * 16 + l15) * 64, b_row = (wn * FJ * 16 + l15) * 64;
  f32x4 acc[FI][FJ];
#pragma unroll
  for (int i = 0; i < FI; ++i)
#pragma unroll
    for (int j = 0; j < FJ; ++j) acc[i][j] = (f32x4){0.f, 0.f, 0.f, 0.f};
  const int nk = K >> 6;
#define GL(RA, RB, KT) { _Pragma("unroll") for (int i = 0; i < NA; ++i) RA[i] = *(const u32x4*)(Ag + (size_t)i * 64 * K + (KT) * 64); \
                         _Pragma("unroll") for (int i = 0; i < NB; ++i) RB[i] = *(const u32x4*)(Bg + (size_t)i * 64 * K + (KT) * 64); }
#define GS(RA, RB, BUF) { _Pragma("unroll") for (int i = 0; i < NA; ++i) *(u32x4*)(As + (BUF) * BUFSZ + st_off + i * 4096) = RA[i]; \
                          _Pragma("unroll") for (int i = 0; i < NB; ++i) *(u32x4*)(Bs + (BUF) * BUFSZ + st_off + i * 4096) = RB[i]; }
  if constexpr (DEPTH == 3) {
    constexpr int ST = (BM + BN) * 32;
    constexpr int NA4 = BM * 4 / 512, NB4 = BN * 4 / 512;
    const int nk32 = K >> 5;
    const int fs = (-(tid >> 4)) & 3;
    const u16* Ad = A + (size_t)(tm * BM + (tid >> 2)) * K + (((tid & 3) ^ fs) << 3);
    const u16* Bd = Wt + (size_t)(tn * BN + (tid >> 2)) * K + (((tid & 3) ^ fs) << 3);
    u16* Al = As + tid * 8;
    u16* Bl = As + BM * 32 + tid * 8;
    const int fr = (-(l15 >> 2)) & 3;
    const int co3 = (q4 ^ fr) << 3;
    const int a_row3 = (wm * FI * 16 + l15) * 32 + co3, b_row3 = BM * 32 + (wn * FJ * 16 + l15) * 32 + co3;
    static_assert(FI == 8 && FJ == 4, "ring path is written for 8x4 fragments per wave");
    const unsigned lbase = (unsigned)(size_t)As;
#define GD3(KT, BUF) { _Pragma("unroll") for (int i = 0; i < NA4; ++i) __builtin_amdgcn_global_load_lds((const unsigned*)(Ad + (size_t)i * 128 * K + (KT) * 32), (unsigned*)(Al + (BUF) * ST + i * 4096), 16, 0, 0); \
                       _Pragma("unroll") for (int i = 0; i < NB4; ++i) __builtin_amdgcn_global_load_lds((const unsigned*)(Bd + (size_t)i * 128 * K + (KT) * 32), (unsigned*)(Bl + (BUF) * ST + i * 4096), 16, 0, 0); }
    asm volatile("s_waitcnt vmcnt(0)" ::: "memory");
    GD3(0, 0);
    if (nk32 > 1) GD3(1, 1);
    if (nk32 > 2) GD3(2, 2);
#define RING_STEP(J) { \
      const int kt = kt0 + (J); \
      if (kt + 2 < nk32) asm volatile("s_waitcnt vmcnt(%0)" :: "n"(2 * (NA4 + NB4)) : "memory"); \
      else if (kt + 1 < nk32) asm volatile("s_waitcnt vmcnt(%0)" :: "n"(NA4 + NB4) : "memory"); \
      else asm volatile("s_waitcnt vmcnt(0)" ::: "memory"); \
      asm volatile("s_waitcnt lgkmcnt(0)" ::: "memory"); \
      __builtin_amdgcn_s_barrier(); \
      asm volatile("" ::: "memory"); \
      if (kt + 3 < nk32) GD3(kt + 3, ((J) + 3) & 3); \
      const unsigned aad = lbase + (unsigned)(((J) * ST + a_row3) * 2); \
      const unsigned bad = lbase + (unsigned)(((J) * ST + b_row3) * 2); \
      bf16x8 b0, b1, b2, b3, a0, a1, a2, a3; \
      asm volatile("ds_read_b128 %0, %1" : "=v"(b0) : "v"(bad)); \
      asm volatile("ds_read_b128 %0, %1 offset:1024" : "=v"(b1) : "v"(bad)); \
      asm volatile("ds_read_b128 %0, %1 offset:2048" : "=v"(b2) : "v"(bad)); \
      asm volatile("ds_read_b128 %0, %1 offset:3072" : "=v"(b3) : "v"(bad)); \
      asm volatile("ds_read_b128 %0, %1" : "=v"(a0) : "v"(aad)); \
      asm volatile("ds_read_b128 %0, %1 offset:1024" : "=v"(a1) : "v"(aad)); \
      asm volatile("ds_read_b128 %0, %1 offset:2048" : "=v"(a2) : "v"(aad)); \
      asm volatile("ds_read_b128 %0, %1 offset:3072" : "=v"(a3) : "v"(aad)); \
      asm volatile("s_waitcnt lgkmcnt(0)" : "+v"(b0), "+v"(b1), "+v"(b2), "+v"(b3), "+v"(a0), "+v"(a1), "+v"(a2), "+v"(a3)); \
      __builtin_amdgcn_s_setprio(1); \
      { bf16x8 bb[4] = {b0, b1, b2, b3}; bf16x8 aa[4] = {a0, a1, a2, a3}; \
        _Pragma("unroll") for (int j = 0; j < 4; ++j) \
          _Pragma("unroll") for (int i = 0; i < 4; ++i) acc[i][j] = mfma16(bb[j], aa[i], acc[i][j]); } \
      asm volatile("ds_read_b128 %0, %1 offset:4096" : "=v"(a0) : "v"(aad)); \
      asm volatile("ds_read_b128 %0, %1 offset:5120" : "=v"(a1) : "v"(aad)); \
      asm volatile("ds_read_b128 %0, %1 offset:6144" : "=v"(a2) : "v"(aad)); \
      asm volatile("ds_read_b128 %0, %1 offset:7168" : "=v"(a3) : "v"(aad)); \
      asm volatile("s_waitcnt lgkmcnt(0)" : "+v"(b0), "+v"(b1), "+v"(b2), "+v"(b3), "+v"(a0), "+v"(a1), "+v"(a2), "+v"(a3)); \
      { bf16x8 bb[4] = {b0, b1, b2, b3}; bf16x8 aa[4] = {a0, a1, a2, a3}; \
        _Pragma("unroll") for (int j = 0; j < 4; ++j) \
          _Pragma("unroll") for (int i = 0; i < 4; ++i) acc[4 + i][j] = mfma16(bb[j], aa[i], acc[4 + i][j]); } \
      __builtin_amdgcn_s_setprio(0); }
    for (int kt0 = 0; kt0 < nk32; kt0 += 4) {
      RING_STEP(0) RING_STEP(1) RING_STEP(2) RING_STEP(3)
    }
#undef RING_STEP
#undef GD3
    __syncthreads();
  } else if constexpr (DEPTH == 0) {
    const int swz = (lr >> 1) & 7;
    const u16* Ad = A + (size_t)(tm * BM + lr) * K + ((lc ^ swz) << 3);
    const u16* Bd = Wt + (size_t)(tn * BN + lr) * K + ((lc ^ swz) << 3);
    u16* Al = As + tid * 8;
    u16* Bl = Bs + tid * 8;
#define GD(KT, BUF) { _Pragma("unroll") for (int i = 0; i < NA; ++i) __builtin_amdgcn_global_load_lds((const unsigned*)(Ad + (size_t)i * 64 * K + (KT) * 64), (unsigned*)(Al + (BUF) * BUFSZ + i * 4096), 16, 0, 0); \
                      _Pragma("unroll") for (int i = 0; i < NB; ++i) __builtin_amdgcn_global_load_lds((const unsigned*)(Bd + (size_t)i * 64 * K + (KT) * 64), (unsigned*)(Bl + (BUF) * BUFSZ + i * 4096), 16, 0, 0); }
    GD(0, 0);
    asm volatile("s_waitcnt vmcnt(0)" ::: "memory");
    __syncthreads();
    for (int kt = 0; kt < nk; kt += 2) {
      if (kt + 1 < nk) GD(kt + 1, 1);
      g_compute<FI, FJ, (EPI != EPI_KVUP)>(acc, As + a_row, Bs + b_row, q4, rsw);
      asm volatile("s_waitcnt vmcnt(0)" ::: "memory");
      __syncthreads();
      if (kt + 1 >= nk) break;
      if (kt + 2 < nk) GD(kt + 2, 0);
      g_compute<FI, FJ, (EPI != EPI_KVUP)>(acc, As + BUFSZ + a_row, Bs + BUFSZ + b_row, q4, rsw);
      asm volatile("s_waitcnt vmcnt(0)" ::: "memory");
      __syncthreads();
    }
#undef GD
  } else if constexpr (DEPTH == 2) {
    u32x4 ra0[NA], rb0[NB], ra1[NA], rb1[NB];
    GL(ra0, rb0, 0);
    if (nk > 1) GL(ra1, rb1, 1);
    GS(ra0, rb0, 0);
    __syncthreads();
    for (int kt = 0; kt < nk; kt += 2) {
      if (kt + 2 < nk) GL(ra0, rb0, kt + 2);
      g_compute<FI, FJ, (EPI != EPI_KVUP)>(acc, As + a_row, Bs + b_row, q4, rsw);
      if (kt + 1 < nk) GS(ra1, rb1, 1);
      __syncthreads();
      if (kt + 1 >= nk) break;
      if (kt + 3 < nk) GL(ra1, rb1, kt + 3);
      g_compute<FI, FJ, (EPI != EPI_KVUP)>(acc, As + BUFSZ + a_row, Bs + BUFSZ + b_row, q4, rsw);
      if (kt + 2 < nk) GS(ra0, rb0, 0);
      __syncthreads();
    }
  } else {
    u32x4 ra0[NA], rb0[NB];
    GL(ra0, rb0, 0);
    GS(ra0, rb0, 0);
    __syncthreads();
    for (int kt = 0; kt < nk; kt += 2) {
      if (kt + 1 < nk) GL(ra0, rb0, kt + 1);
      g_compute<FI, FJ, (EPI != EPI_KVUP)>(acc, As + a_row, Bs + b_row, q4, rsw);
      if (kt + 1 < nk) GS(ra0, rb0, 1);
      __syncthreads();
      if (kt + 1 >= nk) break;
      if (kt + 2 < nk) GL(ra0, rb0, kt + 2);
      g_compute<FI, FJ, (EPI != EPI_KVUP)>(acc, As + BUFSZ + a_row, Bs + BUFSZ + b_row, q4, rsw);
      if (kt + 2 < nk) GS(ra0, rb0, 0);
      __syncthreads();
    }
  }
#undef GL
#undef GS
  const int mb = tm * BM + wm * FI * 16 + q4 * 4;
  const int nb = tn * BN + wn * FJ * 16;
  const int mrow = tm * BM + wm * FI * 16 + l15;
  if (EPI == EPI_STORE) {
#pragma unroll
    for (int i = 0; i < FI; ++i)
#pragma unroll
      for (int j = 0; j < FJ; ++j) *(f32x4*)(e.C + (size_t)(mrow + i * 16) * e.ldc + nb + j * 16 + q4 * 4) = acc[i][j];
  } else if (EPI == EPI_RESID) {
    const float cf = e.ldc ? 0.5f : 1.0f;
    const f32x4 cfv = {cf, cf, cf, cf};
#pragma unroll
    for (int i = 0; i < FI; ++i) {
      const int m = mrow + i * 16;
      const float* gt = e.gate + (size_t)grp_of(m) * 9216;
#pragma unroll
      for (int j = 0; j < FJ; ++j) {
        const int n = nb + j * 16 + q4 * 4;
        f32x4 g = *(const f32x4*)(gt + n);
        f32x4* px = (f32x4*)(e.C + (size_t)m * 1024 + n);
        f32x4 xv = *px;
        xv += g * cfv * acc[i][j];
        *px = xv;
      }
    }
  } else if (EPI == EPI_SWIGLU) {
    const bool odd = (q4 & 1) != 0;
#pragma unroll
    for (int j = 0; j < FJ; ++j) {
      const int hj = ((nb >> 4) + j) * 8 + (q4 >> 1) * 4;
#pragma unroll
      for (int i2 = 0; i2 < FI / 2; ++i2) {
        float hv[4];
#pragma unroll
        for (int r = 0; r < 4; ++r) {
          float send = odd ? acc[2 * i2][j][r] : acc[2 * i2 + 1][j][r];
          float recv = shx(send, 16);
          float g = odd ? recv : acc[2 * i2][j][r];
          float u = odd ? acc[2 * i2 + 1][j][r] : recv;
          hv[r] = silu_f(g) * u;
        }
        const int m = mrow + (2 * i2 + (odd ? 1 : 0)) * 16;
        uint2 o; o.x = pack2(hv[0], hv[1]); o.y = pack2(hv[2], hv[3]);
        *(uint2*)(e.H + (size_t)m * 2816 + hj) = o;
      }
    }
  } else if (EPI == EPI_KVUP) {
#pragma unroll
    for (int j = 0; j < FJ; ++j) {
      const int n0 = nb + j * 16;
      const int hh = n0 >> 7, wb = n0 & 127;
#pragma unroll
      for (int i = 0; i < FI; ++i) {
        const int m0 = mb + i * 16;
        int krow; u16* vt;
        if (e.ctx) {
          int b = m0 >> 9, key = m0 & 511;
          krow = NPR + b * 1536 + 1024 + key;
          vt = e.vts + (size_t)((b * 8 + hh) * 64) * 1536 + 1024 + key;
        } else if (m0 < NPR) {
          int b = m0 >> 8, t = m0 & 255;
          krow = m0;
          vt = e.vtp + (size_t)((b * 8 + hh) * 64) * 256 + t;
        } else {
          int s = m0 - NPR, b = s >> 10, t = s & 1023;
          krow = NPR + b * 1536 + t;
          vt = e.vts + (size_t)((b * 8 + hh) * 64) * 1536 + t;
        }
        if (wb < 64) {
#pragma unroll
          for (int r = 0; r < 4; ++r) e.kb[(size_t)(krow + r) * 768 + hh * 96 + wb + l15] = f2bf(acc[i][j][r]);
        } else {
          const int d = wb - 64 + l15;
          const size_t L = (e.ctx || m0 >= NPR) ? 1536 : 256;
          uint2 o; o.x = pack2(acc[i][j][0], acc[i][j][1]); o.y = pack2(acc[i][j][2], acc[i][j][3]);
          *(uint2*)(vt + (size_t)d * L) = o;
        }
      }
    }
  }
}

template <int EPI, int WMW, int WNW, int FI, int FJ, int DEPTH>
__device__ __forceinline__ void gemm_phase(const u16* A, const u16* Wt, int K, int Mt, int Nt, const EpiP& e, char* smem) {
  for (int t = rbid(); t < Mt * Nt; t += (int)gridDim.x) gemm_tile<EPI, WMW, WNW, FI, FJ, DEPTH>(A, Wt, K, t % Mt, t / Mt, e, smem);
}

__device__ __forceinline__ void ffn_in_phase(PRM p, int l, int which, const EpiP& e, char* smem) {
  const u16* Wt = p.wt_ffn_in + (size_t)(l * 2 + which) * 5632 * 1024;
  const int G = (int)gridDim.x;
  const int nfull = (528 / G) * G;
  for (int t = rbid(); t < nfull; t += G) gemm_tile<EPI_SWIGLU, 2, 4, 8, 4, 3>(p.xn, Wt, 1024, t % 24, t / 24, e, smem);
  const int nq = (528 - nfull) * 4;
  const int bid = rbid();
  for (int u = bid; u < nq; u += G) {
    const int t = nfull + (u >> 2), sub = u & 3;
    gemm_tile<EPI_SWIGLU, 4, 2, 2, 4, 2>(p.xn, Wt, 1024, (t % 24) * 2 + (sub >> 1), (t / 24) * 2 + (sub & 1), e, smem);
  }
  const int tail = nq < G ? nq : G;
  if (l < 3 && bid >= tail) {
    const int vb = rtid() >> 8;
    char* vsm = smem + vb * LDS_HALF;
    const int nfree = (G - tail) * 2;
    const int vrank = (bid - tail) * 2 + vb;
    const int cnt = conv_layer_count(l + 1);
    const int half = cnt >> 1;
    const int lo = which ? half : 0, hi = which ? cnt : half;
    for (int c = lo + vrank; c < hi; c += nfree) conv_layer_task(p, l + 1, c, (float*)vsm);
    for (int c = vrank; c < 72; c += nfree) mod_task(p, (l + 1) * 144 + which * 72 + c, (float*)vsm);
  }
}

__device__ __forceinline__ void rope_store_kb(PRM p, float val, int lane, int t, bool sample, int krow) {
  float outv = val;
  if (sample) {
    float partner = shx(val, 8);
    int w = lane & 15, fi = w & 7;
    float pos = (float)((lane & 16) ? (t & 63) : (t >> 6));
    float fr = __expf(-9.210340372f * (float)fi * 0.125f);
    float s, c; sincos_r(pos * fr, s, c);
    outv = (w < 8) ? val * c - partner * s : val * c + partner * s;
  }
  if (lane < 32) {
    u16 b = f2bf(outv);
#pragma unroll
    for (int h = 0; h < 8; ++h) p.kb[(size_t)krow * 768 + h * 96 + 64 + lane] = b;
  }
}

__device__ __forceinline__ void post_even(PRM p, int e) {
  const int tid = get_tid(), lane = tid & 63, wave = tid >> 6;
  const int NT = NTOK / 4;
  const int NC = 256;
  for (int task = get_bid(); task < NT + NC; task += vgrid()) {
    if (task < NT) {
      const int m0 = task * 4, m = m0 + wave;
      const bool pr = m < NPR;
      const int b = pr ? (m >> 8) : ((m - NPR) >> 10);
      const int t = pr ? (m & 255) : ((m - NPR) & 1023);
      const float* row = p.proj + (size_t)m * 2688;
      {
        float4 a0 = *(const float4*)(row + lane * 8), a1 = *(const float4*)(row + lane * 8 + 4);
        uint4 o; o.x = pack2(a0.x, a0.y); o.y = pack2(a0.z, a0.w); o.z = pack2(a1.x, a1.y); o.w = pack2(a1.z, a1.w);
        *(uint4*)(p.qa + (size_t)m * 512 + lane * 8) = o;
        float4 k0 = *(const float4*)(row + 512 + lane * 8), k1 = *(const float4*)(row + 512 + lane * 8 + 4);
        o.x = pack2(k0.x, k0.y); o.y = pack2(k0.z, k0.w); o.z = pack2(k1.x, k1.y); o.w = pack2(k1.z, k1.w);
        *(uint4*)(p.ka + (size_t)m * 512 + lane * 8) = o;
        if (pr) {
          float* ok = p.out + O_AK + ((size_t)(b * 2 + e) * 256 + t) * 512 + lane * 8;
          *(float4*)ok = k0; *(float4*)(ok + 4) = k1;
          float4 v0 = *(const float4*)(row + 1024 + lane * 8), v1 = *(const float4*)(row + 1024 + lane * 8 + 4);
          float* ov = p.out + O_AV + ((size_t)(b * 2 + e) * 256 + t) * 512 + lane * 8;
          *(float4*)ov = v0; *(float4*)(ov + 4) = v1;
        }
      }
      {
        float4 c0 = *(const float4*)(row + 1536 + lane * 12), c1 = *(const float4*)(row + 1536 + lane * 12 + 4), c2 = *(const float4*)(row + 1536 + lane * 12 + 8);
        float ss = c0.x * c0.x + c0.y * c0.y + c0.z * c0.z + c0.w * c0.w + c1.x * c1.x + c1.y * c1.y + c1.z * c1.z + c1.w * c1.w +
                   c2.x * c2.x + c2.y * c2.y + c2.z * c2.z + c2.w * c2.w;
        ss = wsum(ss);
        float r = rsqrtf(ss * (1.f / 768.f) + EPS);
        const float* g = p.b_q_norm + e * 768 + lane * 12;
        float4 g0 = *(const float4*)g, g1 = *(const float4*)(g + 4), g2 = *(const float4*)(g + 8);
        uint2 o0, o1, o2;
        o0.x = pack2(c0.x * r * g0.x, c0.y * r * g0.y); o0.y = pack2(c0.z * r * g0.z, c0.w * r * g0.w);
        o1.x = pack2(c1.x * r * g1.x, c1.y * r * g1.y); o1.y = pack2(c1.z * r * g1.z, c1.w * r * g1.w);
        o2.x = pack2(c2.x * r * g2.x, c2.y * r * g2.y); o2.y = pack2(c2.z * r * g2.z, c2.w * r * g2.w);
        u16* d = p.cqn + (size_t)m * 768 + lane * 12;
        *(uint2*)d = o0; *(uint2*)(d + 4) = o1; *(uint2*)(d + 8) = o2;
      }
      {
        float4 c0 = *(const float4*)(row + 2304 + lane * 4);
        float ss = wsum(c0.x * c0.x + c0.y * c0.y + c0.z * c0.z + c0.w * c0.w);
        float r = rsqrtf(ss * (1.f / 256.f) + EPS);
        float4 g0 = *(const float4*)(p.b_kv_norm + e * 256 + lane * 4);
        float4 y; y.x = c0.x * r * g0.x; y.y = c0.y * r * g0.y; y.z = c0.z * r * g0.z; y.w = c0.w * r * g0.w;
        uint2 o; o.x = pack2(y.x, y.y); o.y = pack2(y.z, y.w);
        *(uint2*)(p.ckvn + (size_t)m * 256 + lane * 4) = o;
        if (pr) *(float4*)(p.out + O_CKV + ((size_t)(b * 2 + e) * 256 + t) * 256 + lane * 4) = y;
      }
      {
        float val = row[2560 + (lane & 31)];
        if (pr && lane < 32) p.out[O_KR + ((size_t)(b * 2 + e) * 256 + t) * 32 + lane] = val;
        rope_store_kb(p, val, lane, t, !pr, keyrow(m));
      }
      {
        const bool pr0 = m0 < NPR;
        const int b0 = pr0 ? (m0 >> 8) : ((m0 - NPR) >> 10);
        const int t0 = pr0 ? (m0 & 255) : ((m0 - NPR) & 1023);
#pragma unroll
        for (int i = 0; i < 2; ++i) {
          int pp = tid + 256 * i, h = pp >> 6, d = pp & 63;
          const float* src = p.proj + (size_t)m0 * 2688 + 1024 + h * 64 + d;
          float v0 = src[0], v1 = src[2688], v2 = src[2 * 2688], v3 = src[3 * 2688];
          uint2 o; o.x = pack2(v0, v1); o.y = pack2(v2, v3);
          u16* dst = pr0 ? p.vta_p + (size_t)((b0 * 8 + h) * 64 + d) * 256 + t0 : p.vta_s + (size_t)((b0 * 8 + h) * 64 + d) * 1536 + t0;
          *(uint2*)dst = o;
        }
      }
    } else {
      const int ct = task - NT;
      const int b = ct >> 7, key0 = (ct & 127) * 4;
      {
        const float* src = p.cache_a_k + ((size_t)(b * 2 + e) * 512 + key0) * 512;
        u16* dst = p.kactx + ((size_t)b * 512 + key0) * 512;
#pragma unroll
        for (int i = 0; i < 2; ++i) {
          int idx = (tid + 256 * i) * 4;
          float4 v = *(const float4*)(src + idx);
          uint2 o; o.x = pack2(v.x, v.y); o.y = pack2(v.z, v.w);
          *(uint2*)(dst + idx) = o;
        }
      }
      {
        const float* src = p.cache_a_v + ((size_t)(b * 2 + e) * 512 + key0) * 512;
#pragma unroll
        for (int i = 0; i < 2; ++i) {
          int pp = tid + 256 * i, h = pp >> 6, d = pp & 63;
          float v0 = src[pp], v1 = src[512 + pp], v2 = src[1024 + pp], v3 = src[1536 + pp];
          uint2 o; o.x = pack2(v0, v1); o.y = pack2(v2, v3);
          *(uint2*)(p.vta_s + (size_t)((b * 8 + h) * 64 + d) * 1536 + 1024 + key0) = o;
        }
      }
      {
        const float* src = p.cache_b_ckv + ((size_t)(b * 2 + e) * 512 + key0) * 256;
        float4 v = *(const float4*)(src + tid * 4);
        uint2 o; o.x = pack2(v.x, v.y); o.y = pack2(v.z, v.w);
        *(uint2*)(p.cctxn + ((size_t)b * 512 + key0) * 256 + tid * 4) = o;
      }
      {
        const float* src = p.cache_b_krope + ((size_t)(b * 2 + e) * 512 + key0) * 32;
#pragma unroll
        for (int i = 0; i < 4; ++i) {
          int idx = tid + 256 * i;
          int kk = idx >> 8, h = (idx >> 5) & 7, dd = idx & 31;
          p.kb[(size_t)(NPR + b * 1536 + 1024 + key0 + kk) * 768 + h * 96 + 64 + dd] = f2bf(src[kk * 32 + dd]);
        }
      }
    }
  }
}

__device__ __forceinline__ void post_odd(PRM p, int o) {
  const int tid = get_tid(), lane = tid & 63, wave = tid >> 6;
  const int NT = NTOK / 4, NC = 256;
  for (int task = get_bid(); task < NT + NC; task += vgrid()) {
    if (task < NT) {
      const int m0 = task * 4, m = m0 + wave;
      const bool pr = m < NPR;
      const int b = pr ? (m >> 8) : ((m - NPR) >> 10);
      const int t = pr ? (m & 255) : ((m - NPR) & 1023);
      const float* row = p.proj + (size_t)m * 2432;
      float rs = 0.f, rc = 1.f;
      if (!pr) {
        int w = lane & 31, fi = w & 15;
        float pos = (float)((lane & 32) ? (t & 63) : (t >> 6));
        float fr = __expf(-9.210340372f * (float)fi * (1.f / 16.f));
        sincos_r(pos * fr, rs, rc);
      }
      const bool lo = (lane & 16) == 0;
      const float gq = p.d_q_norm[o * 64 + lane], gk = p.d_k_norm[o * 64 + lane];
#pragma unroll
      for (int hd = 0; hd < 8; ++hd) {
        float v = row[1552 + hd * 64 + lane];
        float ss = wsum(v * v);
        float y = v * rsqrtf(ss * (1.f / 64.f) + EPS) * gq;
        if (!pr) { float pt = shx(y, 16); y = lo ? y * rc - pt * rs : y * rc + pt * rs; }
        p.qa[(size_t)m * 512 + hd * 64 + lane] = f2bf(y);
      }
#pragma unroll
      for (int kh = 0; kh < 2; ++kh) {
        float v = row[2064 + kh * 64 + lane];
        float ss = wsum(v * v);
        float y = v * rsqrtf(ss * (1.f / 64.f) + EPS) * gk;
        if (pr) p.out[O_DK + ((size_t)(b * 2 + o) * 256 + t) * 128 + kh * 64 + lane] = y;
        else { float pt = shx(y, 16); y = lo ? y * rc - pt * rs : y * rc + pt * rs; }
        p.kd[(size_t)keyrow(m) * 128 + kh * 64 + lane] = f2bf(y);
        if (pr) p.out[O_DV + ((size_t)(b * 2 + o) * 256 + t) * 128 + kh * 64 + lane] = row[2192 + kh * 64 + lane];
      }
      if (tid < 128) {
        const bool pr0 = m0 < NPR;
        const int b0 = pr0 ? (m0 >> 8) : ((m0 - NPR) >> 10);
        const int t0 = pr0 ? (m0 & 255) : ((m0 - NPR) & 1023);
        int kh = tid >> 6, d = tid & 63;
        const float* src = p.proj + (size_t)m0 * 2432 + 2192 + tid;
        float v0 = src[0], v1 = src[2432], v2 = src[2 * 2432], v3 = src[3 * 2432];
        uint2 oo; oo.x = pack2(v0, v1); oo.y = pack2(v2, v3);
        u16* dst = pr0 ? p.vtd_p + (size_t)((b0 * 2 + kh) * 64 + d) * 256 + t0 : p.vtd_s + (size_t)((b0 * 2 + kh) * 64 + d) * 1536 + t0;
        *(uint2*)dst = oo;
      }
    } else {
      const int ct = task - NT;
      const int b = ct >> 7, key0 = (ct & 127) * 4;
      {
        const float* src = p.cache_d_k + ((size_t)(b * 2 + o) * 512 + key0) * 128;
        if (tid < 128) {
          float4 v = *(const float4*)(src + tid * 4);
          uint2 oo; oo.x = pack2(v.x, v.y); oo.y = pack2(v.z, v.w);
          *(uint2*)(p.kd + (size_t)(NPR + b * 1536 + 1024 + key0) * 128 + tid * 4) = oo;
        } else {
          int pp = tid - 128, kh = pp >> 6, d = pp & 63;
          const float* sv = p.cache_d_v + ((size_t)(b * 2 + o) * 512 + key0) * 128;
          float v0 = sv[pp], v1 = sv[128 + pp], v2 = sv[256 + pp], v3 = sv[384 + pp];
          uint2 oo; oo.x = pack2(v0, v1); oo.y = pack2(v2, v3);
          *(uint2*)(p.vtd_s + (size_t)((b * 2 + kh) * 64 + d) * 1536 + 1024 + key0) = oo;
        }
      }
    }
  }
}

struct AttnSt { float m, l; f32x4 o[4]; };
template <int KS> struct KVf { bf16x8 k0[KS], k1[KS]; s16x4 v0[4], v1[4]; };

template <int KS>
__device__ __forceinline__ void attn_load(KVf<KS>& f, const u16* __restrict__ Kb, int kstride, const u16* __restrict__ Vtb, int vtstride, int l15, int q4) {
  const u16* k0p = Kb + (size_t)l15 * kstride + q4 * 8;
  const u16* k1p = k0p + (size_t)16 * kstride;
#pragma unroll
  for (int ks = 0; ks < KS; ++ks) { f.k0[ks] = *(const bf16x8*)(k0p + ks * 32); f.k1[ks] = *(const bf16x8*)(k1p + ks * 32); }
#pragma unroll
  for (int dt = 0; dt < 4; ++dt) {
    const u16* vp = Vtb + (size_t)(dt * 16 + l15) * vtstride + q4 * 4;
    f.v0[dt] = *(const s16x4*)vp; f.v1[dt] = *(const s16x4*)(vp + 16);
  }
}

template <int KS>
__device__ __forceinline__ void attn_comp(AttnSt& st, const bf16x8 (&qf)[KS], const KVf<KS>& f, float scale, int q4,
                                          bool masked, const float* rpbrow, int qc, int kc0) {
  f32x4 s0 = {0.f, 0.f, 0.f, 0.f}, s1 = {0.f, 0.f, 0.f, 0.f};
#pragma unroll
  for (int ks = 0; ks < KS; ++ks) { s0 = mfma16(f.k0[ks], qf[ks], s0); s1 = mfma16(f.k1[ks], qf[ks], s1); }
  float sv[8];
#pragma unroll
  for (int j = 0; j < 4; ++j) { sv[j] = s0[j] * scale; sv[4 + j] = s1[j] * scale; }
  if (masked) {
    const int cs = min(max(qc - 8, 0), 48);
#pragma unroll
    for (int e = 0; e < 8; ++e) {
      int kc = kc0 + (e >> 2) * 16 + q4 * 4 + (e & 3);
      bool ok = (kc >= cs) && (kc < cs + 16);
      int di = min(max(kc - qc, -15), 15) + 15;
      sv[e] = ok ? sv[e] + rpbrow[di] : -INFINITY;
    }
  }
  float mx = sv[0];
#pragma unroll
  for (int e = 1; e < 8; ++e) mx = fmaxf(mx, sv[e]);
  mx = fmaxf(mx, shx(mx, 16));
  mx = fmaxf(mx, shx(mx, 32));
  const float mnew = fmaxf(st.m, mx);
  const float alpha = __expf(st.m - mnew);
  float pe[8], ls = 0.f;
#pragma unroll
  for (int e = 0; e < 8; ++e) { pe[e] = __expf(sv[e] - mnew); ls += pe[e]; }
  st.l = st.l * alpha + ls;
  st.m = mnew;
  bf16x8 pf;
#pragma unroll
  for (int e = 0; e < 8; ++e) pf[e] = (short)f2bf(pe[e]);
#pragma unroll
  for (int dt = 0; dt < 4; ++dt) {
    bf16x8 vf = (bf16x8){f.v0[dt].x, f.v0[dt].y, f.v0[dt].z, f.v0[dt].w, f.v1[dt].x, f.v1[dt].y, f.v1[dt].z, f.v1[dt].w};
    st.o[dt] *= alpha;
    st.o[dt] = mfma16(vf, pf, st.o[dt]);
  }
}

__device__ __forceinline__ void attn_init(AttnSt& st) {
  st.m = -1e30f; st.l = 0.f;
#pragma unroll
  for (int dt = 0; dt < 4; ++dt) st.o[dt] = (f32x4){0.f, 0.f, 0.f, 0.f};
}
__device__ __forceinline__ void attn_fin(AttnSt& st, u16* outp  , int l15, int q4) {
  float lt = st.l;
  lt += shx(lt, 16);
  lt += shx(lt, 32);
  const float inv = 1.f / lt;
#pragma unroll
  for (int dt = 0; dt < 4; ++dt) {
    uint2 o; o.x = pack2(st.o[dt][0] * inv, st.o[dt][1] * inv); o.y = pack2(st.o[dt][2] * inv, st.o[dt][3] * inv);
    *(uint2*)(outp + (size_t)l15 * 1024 + dt * 16 + q4 * 4) = o;
  }
}

#define AT_VSTR 72
template <int KS> struct ATile { static constexpr int KSTR = KS * 32 + 8; static constexpr int BUF = 64 * (KS * 32 + 8) + 64 * AT_VSTR; };
template <int KS> struct AStage { u32x4 k[KS]; u32x4 v[2]; };

template <int KS>
__device__ __forceinline__ void at_load(AStage<KS>& r, const u16* __restrict__ Kg, int kstride, const u16* __restrict__ Vg, int vtstride, int tid) {
#pragma unroll
  for (int i = 0; i < KS; ++i) {
    int c = tid + 256 * i; int row = c / (KS * 4), ch = c - row * (KS * 4);
    r.k[i] = *(const u32x4*)(Kg + (unsigned)(row * kstride + ch * 8));
  }
#pragma unroll
  for (int i = 0; i < 2; ++i) {
    int c = tid + 256 * i; int row = c >> 3, ch = c & 7;
    r.v[i] = *(const u32x4*)(Vg + (unsigned)(row * vtstride + ch * 8));
  }
}
template <int KS>
__device__ __forceinline__ void at_store(const AStage<KS>& r, u16* buf, int tid) {
  u16* Ks = buf; u16* Vs = buf + 64 * ATile<KS>::KSTR;
#pragma unroll
  for (int i = 0; i < KS; ++i) {
    int c = tid + 256 * i; int row = c / (KS * 4), ch = c - row * (KS * 4);
    *(u32x4*)(Ks + row * ATile<KS>::KSTR + ch * 8) = r.k[i];
  }
#pragma unroll
  for (int i = 0; i < 2; ++i) {
    int c = tid + 256 * i; int row = c >> 3, ch = c & 7;
    *(u32x4*)(Vs + row * AT_VSTR + ch * 8) = r.v[i];
  }
}

template <int KS>
__device__ __forceinline__ void at_comp(AttnSt& st, const bf16x8 (&qf)[KS], const u16* buf, float scale, int l15, int q4,
                                        bool masked, const float* rpbrow, int qc) {
  const u16* Ks = buf; const u16* Vs = buf + 64 * ATile<KS>::KSTR;
  f32x4 s[4];
#pragma unroll
  for (int kt = 0; kt < 4; ++kt) {
    s[kt] = (f32x4){0.f, 0.f, 0.f, 0.f};
#pragma unroll
    for (int ks = 0; ks < KS; ++ks) {
      bf16x8 a = *(const bf16x8*)(Ks + (kt * 16 + l15) * ATile<KS>::KSTR + ks * 32 + q4 * 8);
      s[kt] = mfma16(a, qf[ks], s[kt]);
    }
  }
  float sv[16];
  const float sc2 = scale * 1.4426950408889634f;
#pragma unroll
  for (int kt = 0; kt < 4; ++kt)
#pragma unroll
    for (int j = 0; j < 4; ++j) sv[kt * 4 + j] = s[kt][j] * sc2;
  if (masked) {
    const int cs = min(max(qc - 8, 0), 48);
#pragma unroll
    for (int e = 0; e < 16; ++e) {
      int kc = (e >> 2) * 16 + q4 * 4 + (e & 3);
      bool ok = (kc >= cs) && (kc < cs + 16);
      int di = min(max(kc - qc, -15), 15) + 15;
      sv[e] = ok ? sv[e] + rpbrow[di] : -INFINITY;
    }
  }
  float mx = sv[0];
#pragma unroll
  for (int e = 1; e < 16; ++e) mx = fmaxf(mx, sv[e]);
  mx = fmaxf(mx, shx(mx, 16));
  mx = fmaxf(mx, shx(mx, 32));
  const float mnew = fmaxf(st.m, mx);
  const float alpha = __builtin_amdgcn_exp2f(st.m - mnew);
  float ls = 0.f;
#pragma unroll
  for (int e = 0; e < 16; ++e) { sv[e] = __builtin_amdgcn_exp2f(sv[e] - mnew); ls += sv[e]; }
  st.l = st.l * alpha + ls;
  st.m = mnew;
  bf16x8 pf[2];
#pragma unroll
  for (int hf = 0; hf < 2; ++hf) {
    u32x4 pw;
    pw[0] = pack2(sv[hf * 8 + 0], sv[hf * 8 + 1]); pw[1] = pack2(sv[hf * 8 + 2], sv[hf * 8 + 3]);
    pw[2] = pack2(sv[hf * 8 + 4], sv[hf * 8 + 5]); pw[3] = pack2(sv[hf * 8 + 6], sv[hf * 8 + 7]);
    pf[hf] = __builtin_bit_cast(bf16x8, pw);
  }
#pragma unroll
  for (int dt = 0; dt < 4; ++dt) {
    st.o[dt] *= alpha;
#pragma unroll
    for (int hf = 0; hf < 2; ++hf) {
      const u16* vp = Vs + (dt * 16 + l15) * AT_VSTR + hf * 32 + q4 * 4;
      s16x4 v0 = *(const s16x4*)vp;
      s16x4 v1 = *(const s16x4*)(vp + 16);
      bf16x8 vf = (bf16x8){v0.x, v0.y, v0.z, v0.w, v1.x, v1.y, v1.z, v1.w};
      st.o[dt] = mfma16(vf, pf[hf], st.o[dt]);
    }
  }
}

template <int KS>
__device__ __forceinline__ void at_run_plain(AttnSt& st, const bf16x8 (&qf)[KS], const u16* Kbase, int kstride, const u16* Vbase, int vtstride,
                                             int nt, float scale, u16* lds, int tid, int l15, int q4) {
  AStage<KS> r0, r1;
  at_load<KS>(r0, Kbase, kstride, Vbase, vtstride, tid);
  if (nt > 1) at_load<KS>(r1, Kbase + (size_t)64 * kstride, kstride, Vbase + 64, vtstride, tid);
  at_store<KS>(r0, lds, tid);
  __syncthreads();
  for (int t = 0; t < nt; t += 2) {
    if (t + 2 < nt) at_load<KS>(r0, Kbase + (size_t)(t + 2) * 64 * kstride, kstride, Vbase + (t + 2) * 64, vtstride, tid);
    at_comp<KS>(st, qf, lds, scale, l15, q4, false, nullptr, 0);
    if (t + 1 < nt) at_store<KS>(r1, lds + ATile<KS>::BUF, tid);
    __syncthreads();
    if (t + 1 >= nt) break;
    if (t + 3 < nt) at_load<KS>(r1, Kbase + (size_t)(t + 3) * 64 * kstride, kstride, Vbase + (t + 3) * 64, vtstride, tid);
    at_comp<KS>(st, qf, lds + ATile<KS>::BUF, scale, l15, q4, false, nullptr, 0);
    if (t + 2 < nt) at_store<KS>(r0, lds, tid);
    __syncthreads();
  }
}

__device__ __forceinline__ void load_q64(bf16x8 (&qf)[2], const u16* Q, int qstride, int l15, int q4) {
#pragma unroll
  for (int ks = 0; ks < 2; ++ks) qf[ks] = *(const bf16x8*)(Q + (size_t)l15 * qstride + ks * 32 + q4 * 8);
}
__device__ __forceinline__ void load_q_mla(bf16x8 (&qf)[3], const float* Qf, int l15, int q4, bool sample, int t0) {
  const float* qr = Qf + (size_t)l15 * 768 + q4 * 8;
#pragma unroll
  for (int ks = 0; ks < 3; ++ks) {
    float4 a = *(const float4*)(qr + ks * 32), b = *(const float4*)(qr + ks * 32 + 4);
    float v[8] = {a.x, a.y, a.z, a.w, b.x, b.y, b.z, b.w};
    if (ks == 2 && sample) {
      const int t = t0 + l15;
      const float pos = (float)((q4 & 2) ? (t & 63) : (t >> 6));
#pragma unroll
      for (int jj = 0; jj < 8; ++jj) {
        float pt = shx(v[jj], 16);
        float fr = __expf(-9.210340372f * (float)jj * 0.125f);
        float sn, cs; sincos_r(pos * fr, sn, cs);
        v[jj] = (q4 & 1) ? v[jj] * cs + pt * sn : v[jj] * cs - pt * sn;
      }
    }
#pragma unroll
    for (int jj = 0; jj < 8; ++jj) qf[ks][jj] = (short)f2bf(v[jj]);
  }
}

__device__ __forceinline__ void attn_even_phase(PRM p, int e, char* smem) {
  u16* lds = (u16*)smem;
  const int tid = get_tid(), lane = tid & 63, wave = tid >> 6, l15 = lane & 15, q4 = lane >> 4;
  const float scaleB = 0.10206207261596577f;
  for (int bt = get_bid(); bt < 1536; bt += vgrid()) {
    AttnSt st; attn_init(st);
    if (bt < 256) {
      int qb = bt & 15, h = (bt >> 4) & 7, b = bt >> 7;
      int mq = NPR + b * 1024 + qb * 64 + wave * 16;
      bf16x8 qf[3]; load_q_mla(qf, p.qb + (size_t)mq * 768 + h * 96, l15, q4, true, qb * 64 + wave * 16);
      at_run_plain<3>(st, qf, p.kb + (size_t)(NPR + b * 1536) * 768 + h * 96, 768, p.vtb_s + (size_t)((b * 8 + h) * 64) * 1536, 1536, 24, scaleB, lds, tid, l15, q4);
      attn_fin(st, p.mix + (size_t)mq * 1024 + 512 + h * 64, l15, q4);
    } else if (bt < 512) {
      int u = bt - 256;
      int r = u & 15, h = (u >> 4) & 7, b = u >> 7;
      int mq = NPR + b * 1024 + r * 64 + wave * 16;
      bf16x8 qf[2]; load_q64(qf, p.qa + (size_t)mq * 512 + h * 64, 512, l15, q4);
      const u16* Vt = p.vta_s + (size_t)((b * 8 + h) * 64) * 1536;
      const u16* Kc = p.kactx + (size_t)b * 512 * 512 + h * 64;
      const int rs = min(max(r - 4, 0), 8);
      const u16* Kw = p.ka + (size_t)(NPR + b * 1024 + rs * 64) * 512 + h * 64;
      const float* rpb0 = p.a_rpb + ((size_t)(e * 8 + h) * 15 + (rs - r + 7)) * 31;
      const int qc = wave * 16 + l15;
      float* rpl = (float*)(lds + 2 * ATile<2>::BUF);
      if (tid < 248) { int rr = tid / 31, cc = tid - rr * 31; rpl[rr * 32 + cc] = rpb0[rr * 31 + cc] * 1.4426950408889634f; }
      AStage<2> r0, r1;
#define NB_LOAD(R, T) { if ((T) < 8) at_load<2>(R, Kc + (size_t)(T) * 64 * 512, 512, Vt + 1024 + (T) * 64, 1536, tid); \
                        else at_load<2>(R, Kw + (size_t)((T) - 8) * 64 * 512, 512, Vt + (rs + (T) - 8) * 64, 1536, tid); }
#define NB_COMP(BUFP, T) { if ((T) < 8) at_comp<2>(st, qf, BUFP, 0.125f, l15, q4, false, nullptr, 0); \
                           else at_comp<2>(st, qf, BUFP, 0.125f, l15, q4, true, rpl + ((T) - 8) * 32, qc); }
      NB_LOAD(r0, 0);
      NB_LOAD(r1, 1);
      at_store<2>(r0, lds, tid);
      __syncthreads();
      for (int t = 0; t < 16; t += 2) {
        if (t + 2 < 16) NB_LOAD(r0, t + 2);
        NB_COMP(lds, t);
        at_store<2>(r1, lds + ATile<2>::BUF, tid);
        __syncthreads();
        if (t + 3 < 16) NB_LOAD(r1, t + 3);
        NB_COMP(lds + ATile<2>::BUF, t + 1);
        if (t + 2 < 16) at_store<2>(r0, lds, tid);
        __syncthreads();
      }
#undef NB_LOAD
#undef NB_COMP
      attn_fin(st, p.mix + (size_t)mq * 1024 + h * 64, l15, q4);
    } else if (bt < 1024) {
      int u = bt - 512;
      int qb = u & 3, h = (u >> 2) & 7, b = u >> 5;
      int mq = b * 256 + qb * 64 + wave * 16;
      bf16x8 qf[3]; load_q_mla(qf, p.qb + (size_t)mq * 768 + h * 96, l15, q4, false, 0);
      at_run_plain<3>(st, qf, p.kb + (size_t)(b * 256) * 768 + h * 96, 768, p.vtb_p + (size_t)((b * 8 + h) * 64) * 256, 256, 4, scaleB, lds, tid, l15, q4);
      attn_fin(st, p.mix + (size_t)mq * 1024 + 512 + h * 64, l15, q4);
    } else {
      int u = bt - 1024;
      int qb = u & 3, h = (u >> 2) & 7, b = u >> 5;
      int mq = b * 256 + qb * 64 + wave * 16;
      bf16x8 qf[2]; load_q64(qf, p.qa + (size_t)mq * 512 + h * 64, 512, l15, q4);
      at_run_plain<2>(st, qf, p.ka + (size_t)(b * 256) * 512 + h * 64, 512, p.vta_p + (size_t)((b * 8 + h) * 64) * 256, 256, 4, 0.125f, lds, tid, l15, q4);
      attn_fin(st, p.mix + (size_t)mq * 1024 + h * 64, l15, q4);
    }
  }
}

__device__ __forceinline__ int mslot(int sq, int h, int dir, int j) {
  return sq < 16 ? ((sq * 4 + h) * 2 + dir) * 4 + j : 512 + (((sq - 16) * 4 + h) * 2 + dir) * 16 + j;
}

__device__ __forceinline__ void mlstm1_task(PRM p, int o, int task, float* sm) {
  const int tid = get_tid(), lane = tid & 63, wave = tid >> 6;
  int sq, h, dir, j;
  if (task < 512) { j = task & 3; dir = (task >> 2) & 1; h = (task >> 3) & 3; sq = task >> 5; }
  else { int u = task - 512; j = u & 15; dir = (u >> 4) & 1; h = (u >> 5) & 3; sq = 16 + (u >> 7); }
  const int T = sq < 16 ? 256 : 1024;
  const int base = sq < 16 ? sq * 256 : NPR + (sq - 16) * 1024;
  const int slot = task;
  float* ks = sm;
  float* vs = sm + 4096;
  float* wg = sm + 4096 + 8192;
  if (wave == 0) {
    int s = 64 * j + lane;
    int t = dir ? T - 1 - s : s;
    const float* row = p.proj + (size_t)(base + t) * 2432 + 1536;
    float ig = row[(dir * 2 + 0) * 4 + h] + p.c_gate_bias[o * 16 + (dir * 2 + 0) * 4 + h];
    float fg = row[(dir * 2 + 1) * 4 + h] + p.c_gate_bias[o * 16 + (dir * 2 + 1) * 4 + h];
    float bsum = logsig_f(fg);
#pragma unroll
    for (int off = 1; off < 64; off <<= 1) { float v = __shfl_up(bsum, off); if (lane >= off) bsum += v; }
    float blast = __shfl(bsum, 63);
    float g = blast - bsum + ig;
    float ml = wmaxr(g);
    wg[lane] = __expf(g - ml);
    if (lane == 0) { p.dm[slot * 2] = ml; p.dm[slot * 2 + 1] = blast; }
  }
#pragma unroll
  for (int ii = 0; ii < 4; ++ii) {
    int i = (tid >> 4) + 16 * ii, c4 = tid & 15;
    int s = 64 * j + i; int t = dir ? T - 1 - s : s;
    float4 v = *(const float4*)(p.proj + (size_t)(base + t) * 2432 + 256 + h * 64 + c4 * 4);
    v.x *= 0.125f; v.y *= 0.125f; v.z *= 0.125f; v.w *= 0.125f;
    *(float4*)(ks + i * 64 + c4 * 4) = v;
  }
#pragma unroll
  for (int ii = 0; ii < 8; ++ii) {
    int i = (tid >> 5) + 8 * ii, c4 = tid & 31;
    int s = 64 * j + i; int t = dir ? T - 1 - s : s;
    *(float4*)(vs + i * 128 + c4 * 4) = *(const float4*)(p.proj + (size_t)(base + t) * 2432 + 512 + h * 128 + c4 * 4);
  }
  __syncthreads();
  const int dg = tid & 15, vg8 = tid >> 4;
  f32x4 acc[8];
#pragma unroll
  for (int q = 0; q < 8; ++q) acc[q] = (f32x4){0.f, 0.f, 0.f, 0.f};
  f32x4 nacc = {0.f, 0.f, 0.f, 0.f};
#pragma unroll 4
  for (int i = 0; i < 64; ++i) {
    f32x4 kd = *(const f32x4*)(ks + i * 64 + dg * 4) * wg[i];
    nacc += kd;
    f32x4 va = *(const f32x4*)(vs + i * 128 + vg8 * 8);
    f32x4 vb = *(const f32x4*)(vs + i * 128 + vg8 * 8 + 4);
    acc[0] += kd * va[0]; acc[1] += kd * va[1]; acc[2] += kd * va[2]; acc[3] += kd * va[3];
    acc[4] += kd * vb[0]; acc[5] += kd * vb[1]; acc[6] += kd * vb[2]; acc[7] += kd * vb[3];
  }
  float* dc = p.dC + (size_t)slot * 8192;
#pragma unroll
  for (int q = 0; q < 8; ++q) *(f32x4*)(dc + (vg8 * 8 + q) * 64 + dg * 4) = acc[q];
  if (vg8 == 0) *(f32x4*)(p.dn + slot * 64 + dg * 4) = nacc;
  __syncthreads();
}

__device__ __forceinline__ void mlstm2_task(PRM p, int o, int task, float* sm) {
  const int tid = get_tid(), lane = tid & 63, wave = tid >> 6;
  int sq, h, c;
  if (task < 256) { c = task & 3; h = (task >> 2) & 3; sq = task >> 4; }
  else { int u = task - 256; c = u & 15; h = (u >> 4) & 3; sq = 16 + (u >> 6); }
  const bool pr = sq < 16;
  const int nc = pr ? 4 : 16;
  const int base = (pr ? sq * 256 : NPR + (sq - 16) * 1024) + c * 64;
  float* qT = sm;
  float* kT = sm + 4352;
  float* CT = kT;
  float* St = sm + 2 * 4352;
  float* vh = sm + 3 * 4352;
  float* smalls = sm + 4 * 4352;
  float* bl = smalls;
  float* itb = smalls + 64;
  float* mt = smalls + 128;
  float* w0 = smalls + 192;
  float* nv = smalls + 256;
  float* nq = smalls + 320;
  float* den = smalls + 384;
  float* scal = smalls + 448;

  const int tl = tid >> 4, tx = tid & 15;
  const int l0 = tl * 4, x0 = tx * 4;
  float hacc[2][4][4];
#pragma unroll
  for (int a = 0; a < 2; ++a)
#pragma unroll
    for (int b2 = 0; b2 < 4; ++b2)
#pragma unroll
      for (int c2 = 0; c2 < 4; ++c2) hacc[a][b2][c2] = 0.f;

  f32x4 qv[4], kv[4];
#pragma unroll
  for (int ii = 0; ii < 4; ++ii) {
    int i = (tid >> 4) + 16 * ii, c4 = tid & 15;
    const float* row = p.proj + (size_t)(base + i) * 2432 + h * 64 + c4 * 4;
    qv[ii] = *(const f32x4*)row;
    kv[ii] = *(const f32x4*)(row + 256);
  }
#pragma unroll
  for (int ii = 0; ii < 4; ++ii) {
    int i = (tid >> 4) + 16 * ii, c4 = tid & 15;
    qT[(c4 * 4 + 0) * 68 + i] = qv[ii].x; qT[(c4 * 4 + 1) * 68 + i] = qv[ii].y; qT[(c4 * 4 + 2) * 68 + i] = qv[ii].z; qT[(c4 * 4 + 3) * 68 + i] = qv[ii].w;
  }
#pragma unroll 1
  for (int dir = 0; dir < 2; ++dir) {
    const int j = dir ? nc - 1 - c : c;
    const int slj = mslot(sq, h, dir, j);
    const float mprev = p.mp[slj];
    float cr[16]; f32x4 vr[4];
    const float* cpp = p.cp + (size_t)slj * 8192;
#pragma unroll
    for (int r = 0; r < 16; ++r) cr[r] = cpp[tid + 256 * r];
#pragma unroll
    for (int ii = 0; ii < 4; ++ii) {
      int i = (tid >> 4) + 16 * ii, c4 = tid & 15;
      vr[ii] = *(const f32x4*)(p.proj + (size_t)(base + i) * 2432 + 512 + h * 128 + c4 * 4);
    }
    if (wave == 0) {
      const int i = lane;
      const int tau = dir ? 63 - i : i;
      const float* row = p.proj + (size_t)(base + tau) * 2432 + 1536;
      float ig = row[(dir * 2 + 0) * 4 + h] + p.c_gate_bias[o * 16 + (dir * 2 + 0) * 4 + h];
      float fg = row[(dir * 2 + 1) * 4 + h] + p.c_gate_bias[o * 16 + (dir * 2 + 1) * 4 + h];
      float bsum = logsig_f(fg);
#pragma unroll
      for (int off = 1; off < 64; off <<= 1) { float v = __shfl_up(bsum, off); if (lane >= off) bsum += v; }
      float ib = ig - bsum;
      float pm = ib;
#pragma unroll
      for (int off = 1; off < 64; off <<= 1) { float v = __shfl_up(pm, off); if (lane >= off) pm = fmaxf(pm, v); }
      float mti = fmaxf(bsum + mprev, bsum + pm);
      bl[tau] = bsum; itb[tau] = ib; mt[tau] = mti; w0[tau] = __expf(bsum + mprev - mti);
    }
#pragma unroll
    for (int ii = 0; ii < 4; ++ii) {
      int i = (tid >> 4) + 16 * ii, c4 = tid & 15;
      kT[(c4 * 4 + 0) * 68 + i] = kv[ii].x * 0.125f; kT[(c4 * 4 + 1) * 68 + i] = kv[ii].y * 0.125f;
      kT[(c4 * 4 + 2) * 68 + i] = kv[ii].z * 0.125f; kT[(c4 * 4 + 3) * 68 + i] = kv[ii].w * 0.125f;
    }
    if (tid < 64) nv[tid] = p.np[slj * 64 + tid];
    __syncthreads();
    {
      float a[4][4];
#pragma unroll
      for (int r = 0; r < 4; ++r)
#pragma unroll
        for (int q = 0; q < 4; ++q) a[r][q] = 0.f;
#pragma unroll 2
      for (int d = 0; d < 64; ++d) {
        float4 q4v = *(const float4*)(qT + d * 68 + l0);
        float4 k4v = *(const float4*)(kT + d * 68 + x0);
        float qa[4] = {q4v.x, q4v.y, q4v.z, q4v.w}, kk[4] = {k4v.x, k4v.y, k4v.z, k4v.w};
#pragma unroll
        for (int r = 0; r < 4; ++r)
#pragma unroll
          for (int q = 0; q < 4; ++q) a[r][q] = fmaf(qa[r], kk[q], a[r][q]);
      }
      float rsum[4];
#pragma unroll
      for (int r = 0; r < 4; ++r) {
        const int l = l0 + r;
        const float bll = bl[l], mtl = mt[l];
        rsum[r] = 0.f;
#pragma unroll
        for (int q = 0; q < 4; ++q) {
          const int s = x0 + q;
          const bool ok = dir ? (s >= l) : (s <= l);
          float sv = ok ? a[r][q] * __expf(bll + itb[s] - mtl) : 0.f;
          St[s * 68 + l] = sv;
          rsum[r] += sv;
        }
        rsum[r] += shx(rsum[r], 1); rsum[r] += shx(rsum[r], 2);
        rsum[r] += shx(rsum[r], 4); rsum[r] += shx(rsum[r], 8);
        if (tx == 0) den[l] = rsum[r];
      }
    }
    __syncthreads();
    if (tid < 64) {
      float s = 0.f;
#pragma unroll 4
      for (int d = 0; d < 64; ++d) s = fmaf(qT[d * 68 + tid], nv[d], s);
      nq[tid] = s;
    }
#pragma unroll 1
    for (int vhalf = 0; vhalf < 2; ++vhalf) {
#pragma unroll
      for (int r = 0; r < 16; ++r) {
        int e = tid + 256 * r;
        CT[(e & 63) * 68 + (e >> 6)] = cr[r];
      }
#pragma unroll
      for (int ii = 0; ii < 4; ++ii) {
        int i = (tid >> 4) + 16 * ii, c4 = tid & 15;
        *(f32x4*)(vh + i * 68 + c4 * 4) = vr[ii];
      }
      if (vhalf == 0) {
#pragma unroll
        for (int r = 0; r < 16; ++r) cr[r] = cpp[4096 + tid + 256 * r];
#pragma unroll
        for (int ii = 0; ii < 4; ++ii) {
          int i = (tid >> 4) + 16 * ii, c4 = tid & 15;
          vr[ii] = *(const f32x4*)(p.proj + (size_t)(base + i) * 2432 + 512 + h * 128 + 64 + c4 * 4);
        }
      }
      __syncthreads();
      {
        float a1[4][4], a2[4][4];
#pragma unroll
        for (int r = 0; r < 4; ++r)
#pragma unroll
          for (int q = 0; q < 4; ++q) { a1[r][q] = 0.f; a2[r][q] = 0.f; }
#pragma unroll 2
        for (int s = 0; s < 64; ++s) {
          float4 sa = *(const float4*)(St + s * 68 + l0);
          float4 vb = *(const float4*)(vh + s * 68 + x0);
          float4 qa4 = *(const float4*)(qT + s * 68 + l0);
          float4 cb4 = *(const float4*)(CT + s * 68 + x0);
          float sl4[4] = {sa.x, sa.y, sa.z, sa.w}, vv[4] = {vb.x, vb.y, vb.z, vb.w};
          float qq[4] = {qa4.x, qa4.y, qa4.z, qa4.w}, cc[4] = {cb4.x, cb4.y, cb4.z, cb4.w};
#pragma unroll
          for (int r = 0; r < 4; ++r)
#pragma unroll
            for (int q = 0; q < 4; ++q) { a1[r][q] = fmaf(sl4[r], vv[q], a1[r][q]); a2[r][q] = fmaf(qq[r], cc[q], a2[r][q]); }
        }
#pragma unroll
        for (int r = 0; r < 4; ++r) {
          const int l = l0 + r;
          const float w = w0[l];
          const float dn_ = den[l] + w * nq[l];
          const float dd = fmaxf(fabsf(dn_), __expf(-mt[l]));
          const float inv = 1.f / dd;
#pragma unroll
          for (int q = 0; q < 4; ++q) { float hv = (a1[r][q] + w * a2[r][q]) * inv; if (vhalf == 0) hacc[0][r][q] += hv; else hacc[1][r][q] += hv; }
        }
      }
      __syncthreads();
    }
  }
#pragma unroll
  for (int r = 0; r < 4; ++r) {
    float ss = 0.f;
#pragma unroll
    for (int a = 0; a < 2; ++a)
#pragma unroll
      for (int q = 0; q < 4; ++q) ss += hacc[a][r][q] * hacc[a][r][q];
    ss += shx(ss, 1); ss += shx(ss, 2); ss += shx(ss, 4); ss += shx(ss, 8);
    const float rn = rsqrtf(ss * (1.f / 128.f) + EPS);
    const int m = base + l0 + r;
#pragma unroll
    for (int a = 0; a < 2; ++a) {
      const int v0 = a * 64 + x0;
      float4 co = *(const float4*)(p.proj + (size_t)m * 2432 + 1024 + h * 128 + v0);
      float4 gn = *(const float4*)(p.c_out_norm + (size_t)(o * 4 + h) * 128 + v0);
      float y0 = sigmoid_f(co.x) * hacc[a][r][0] * rn * gn.x;
      float y1 = sigmoid_f(co.y) * hacc[a][r][1] * rn * gn.y;
      float y2 = sigmoid_f(co.z) * hacc[a][r][2] * rn * gn.z;
      float y3 = sigmoid_f(co.w) * hacc[a][r][3] * rn * gn.w;
      uint2 oo; oo.x = pack2(y0, y1); oo.y = pack2(y2, y3);
      *(uint2*)(p.mix + (size_t)m * 1024 + h * 128 + v0) = oo;
    }
  }
  __syncthreads();
}

__device__ __forceinline__ void mlstm2_mfma(PRM p, int o, int task, char* smem) {
  const int tid = get_tid(), lane = tid & 63, wave = tid >> 6, l15 = lane & 15, q4 = lane >> 4;
  int sq, h, c;
  if (task < 256) { c = task & 3; h = (task >> 2) & 3; sq = task >> 4; }
  else { int u = task - 256; c = u & 15; h = (u >> 4) & 3; sq = 16 + (u >> 6); }
  const bool pr = sq < 16;
  const int nc = pr ? 4 : 16;
  const int base = (pr ? sq * 256 : NPR + (sq - 16) * 1024) + c * 64;
  u16* Qb = (u16*)smem;
  u16* Kb = Qb + 64 * 72;
  u16* Vt = Kb + 64 * 72;
  u16* Cb = Vt + 128 * 72;
  float* sml = (float*)(Cb + 128 * 72);
  float* bl = sml; float* itb = sml + 64; float* mt = sml + 128; float* w0 = sml + 192; float* nv = sml + 256;
#pragma unroll
  for (int ii = 0; ii < 4; ++ii) {
    int i = (tid >> 4) + 16 * ii, c4 = tid & 15;
    const float* row = p.proj + (size_t)(base + i) * 2432 + h * 64 + c4 * 4;
    f32x4 qv = *(const f32x4*)row;
    f32x4 kv = *(const f32x4*)(row + 256);
    uint2 a; a.x = pack2(qv[0], qv[1]); a.y = pack2(qv[2], qv[3]);
    uint2 b; b.x = pack2(kv[0] * 0.125f, kv[1] * 0.125f); b.y = pack2(kv[2] * 0.125f, kv[3] * 0.125f);
    *(uint2*)(Qb + i * 72 + c4 * 4) = a;
    *(uint2*)(Kb + i * 72 + c4 * 4) = b;
  }
#pragma unroll
  for (int ii = 0; ii < 8; ++ii) {
    int i = (tid >> 5) + 8 * ii, c4 = tid & 31;
    f32x4 vv = *(const f32x4*)(p.proj + (size_t)(base + i) * 2432 + 512 + h * 128 + c4 * 4);
    unsigned w01 = pack2(vv[0], vv[1]), w23 = pack2(vv[2], vv[3]);
    Vt[(c4 * 4 + 0) * 72 + i] = (u16)(w01 & 0xffffu); Vt[(c4 * 4 + 1) * 72 + i] = (u16)(w01 >> 16);
    Vt[(c4 * 4 + 2) * 72 + i] = (u16)(w23 & 0xffffu); Vt[(c4 * 4 + 3) * 72 + i] = (u16)(w23 >> 16);
  }
  f32x4 hacc[8];
#pragma unroll
  for (int vt = 0; vt < 8; ++vt) hacc[vt] = (f32x4){0.f, 0.f, 0.f, 0.f};
  const int lrow = wave * 16 + l15;
#pragma unroll 1
  for (int dir = 0; dir < 2; ++dir) {
    const int j = dir ? nc - 1 - c : c;
    const int slj = mslot(sq, h, dir, j);
    const float mprev = p.mp[slj];
    {
      const f32x4* cpp = (const f32x4*)(p.cp + (size_t)slj * 8192);
#pragma unroll
      for (int r = 0; r < 8; ++r) {
        int e4 = tid + 256 * r;
        f32x4 cv = cpp[e4];
        uint2 a; a.x = pack2(cv[0], cv[1]); a.y = pack2(cv[2], cv[3]);
        *(uint2*)(Cb + (e4 >> 4) * 72 + (e4 & 15) * 4) = a;
      }
    }
    if (tid < 64) nv[tid] = p.np[slj * 64 + tid];
    if (wave == 0) {
      const int i = lane;
      const int tau = dir ? 63 - i : i;
      const float* row = p.proj + (size_t)(base + tau) * 2432 + 1536;
      float ig = row[(dir * 2 + 0) * 4 + h] + p.c_gate_bias[o * 16 + (dir * 2 + 0) * 4 + h];
      float fg = row[(dir * 2 + 1) * 4 + h] + p.c_gate_bias[o * 16 + (dir * 2 + 1) * 4 + h];
      float bsum = logsig_f(fg);
#pragma unroll
      for (int off = 1; off < 64; off <<= 1) { float v = __shfl_up(bsum, off); if (lane >= off) bsum += v; }
      float ib = ig - bsum;
      float pm = ib;
#pragma unroll
      for (int off = 1; off < 64; off <<= 1) { float v = __shfl_up(pm, off); if (lane >= off) pm = fmaxf(pm, v); }
      float mti = fmaxf(bsum + mprev, bsum + pm);
      bl[tau] = bsum; itb[tau] = ib; mt[tau] = mti; w0[tau] = __expf(bsum + mprev - mti);
    }
    __syncthreads();
    const float bll = bl[lrow], mtl = mt[lrow], w0l = w0[lrow];
    bf16x8 qf[2];
#pragma unroll
    for (int ks = 0; ks < 2; ++ks) qf[ks] = *(const bf16x8*)(Qb + lrow * 72 + ks * 32 + q4 * 8);
    float nqp = 0.f;
#pragma unroll
    for (int ks = 0; ks < 2; ++ks)
#pragma unroll
      for (int jj = 0; jj < 8; ++jj) {
        float qe = __uint_as_float(((unsigned)(unsigned short)qf[ks][jj]) << 16);
        nqp = fmaf(qe, nv[ks * 32 + q4 * 8 + jj], nqp);
      }
    nqp += shx(nqp, 16); nqp += shx(nqp, 32);
    f32x4 oacc[8];
#pragma unroll
    for (int vt = 0; vt < 8; ++vt) {
      oacc[vt] = (f32x4){0.f, 0.f, 0.f, 0.f};
#pragma unroll
      for (int ks = 0; ks < 2; ++ks) {
        bf16x8 a = *(const bf16x8*)(Cb + (vt * 16 + l15) * 72 + ks * 32 + q4 * 8);
        oacc[vt] = mfma16(a, qf[ks], oacc[vt]);
      }
      oacc[vt] *= w0l;
    }
    float sv[16];
    float dsum = 0.f;
#pragma unroll
    for (int st = 0; st < 4; ++st) {
      f32x4 sa = {0.f, 0.f, 0.f, 0.f};
#pragma unroll
      for (int ks = 0; ks < 2; ++ks) {
        bf16x8 a = *(const bf16x8*)(Kb + (st * 16 + l15) * 72 + ks * 32 + q4 * 8);
        sa = mfma16(a, qf[ks], sa);
      }
#pragma unroll
      for (int r = 0; r < 4; ++r) {
        const int sidx = st * 16 + q4 * 4 + r;
        const bool ok = dir ? (sidx >= lrow) : (sidx <= lrow);
        float val = ok ? sa[r] * __expf(bll + itb[sidx] - mtl) : 0.f;
        sv[st * 4 + r] = val;
        dsum += val;
      }
    }
    dsum += shx(dsum, 16); dsum += shx(dsum, 32);
    bf16x8 pf[2];
#pragma unroll
    for (int hf = 0; hf < 2; ++hf) {
      u32x4 pw;
      pw[0] = pack2(sv[hf * 8 + 0], sv[hf * 8 + 1]); pw[1] = pack2(sv[hf * 8 + 2], sv[hf * 8 + 3]);
      pw[2] = pack2(sv[hf * 8 + 4], sv[hf * 8 + 5]); pw[3] = pack2(sv[hf * 8 + 6], sv[hf * 8 + 7]);
      pf[hf] = __builtin_bit_cast(bf16x8, pw);
    }
    const float dn_ = dsum + w0l * nqp;
    const float inv = 1.f / fmaxf(fabsf(dn_), __expf(-mtl));
#pragma unroll
    for (int vt = 0; vt < 8; ++vt) {
#pragma unroll
      for (int hf = 0; hf < 2; ++hf) {
        const u16* vp = Vt + (vt * 16 + l15) * 72 + hf * 32 + q4 * 4;
        s16x4 v0 = *(const s16x4*)vp;
        s16x4 v1 = *(const s16x4*)(vp + 16);
        bf16x8 vf = (bf16x8){v0.x, v0.y, v0.z, v0.w, v1.x, v1.y, v1.z, v1.w};
        oacc[vt] = mfma16(vf, pf[hf], oacc[vt]);
      }
      hacc[vt] += oacc[vt] * inv;
    }
    __syncthreads();
  }
  float ss = 0.f;
#pragma unroll
  for (int vt = 0; vt < 8; ++vt)
#pragma unroll
    for (int r = 0; r < 4; ++r) ss += hacc[vt][r] * hacc[vt][r];
  ss += shx(ss, 16); ss += shx(ss, 32);
  const float rn = rsqrtf(ss * (1.f / 128.f) + EPS);
  const int m = base + lrow;
#pragma unroll
  for (int vt = 0; vt < 8; ++vt) {
    const int v0 = vt * 16 + q4 * 4;
    f32x4 co = *(const f32x4*)(p.proj + (size_t)m * 2432 + 1024 + h * 128 + v0);
    f32x4 gn = *(const f32x4*)(p.c_out_norm + (size_t)(o * 4 + h) * 128 + v0);
    float y0 = sigmoid_f(co[0]) * hacc[vt][0] * rn * gn[0];
    float y1 = sigmoid_f(co[1]) * hacc[vt][1] * rn * gn[1];
    float y2 = sigmoid_f(co[2]) * hacc[vt][2] * rn * gn[2];
    float y3 = sigmoid_f(co[3]) * hacc[vt][3] * rn * gn[3];
    uint2 oo; oo.x = pack2(y0, y1); oo.y = pack2(y2, y3);
    *(uint2*)(p.mix + (size_t)m * 1024 + h * 128 + v0) = oo;
  }
  __syncthreads();
}

__device__ __forceinline__ void mlstm_scan_phase(PRM p, int o) {
  const int tid = get_tid();
  for (int task = get_bid(); task < 576; task += vgrid()) {
    const int sc = task >> 2, slice = task & 3;
    int sq, h, dir;
    if (sc < 128) { sq = sc >> 3; h = (sc >> 1) & 3; dir = sc & 1; }
    else { int u = sc - 128; sq = 16 + (u >> 3); h = (u >> 1) & 3; dir = u & 1; }
    const bool pr = sq < 16;
    const int nc = pr ? 4 : 16;
    const int sidx = pr ? ((sq * 2 + o) * 2 + dir) * 4 + h : 0;
    const int cidx = pr ? 0 : (((sq - 16) * 2 + o) * 2 + dir) * 4 + h;
    const int e0 = slice * 2048 + tid;
    float C[8];
#pragma unroll
    for (int r = 0; r < 8; ++r) C[r] = pr ? 0.f : p.state_C[(size_t)cidx * 8192 + e0 + 256 * r];
    const bool nthr = (slice == 0) && (tid < 64);
    float n = (pr || !nthr) ? 0.f : p.state_n[cidx * 64 + tid];
    float m = pr ? 0.f : p.state_m[cidx];
#pragma unroll 4
    for (int j = 0; j < nc; ++j) {
      const int sl = mslot(sq, h, dir, j);
      float* cp = p.cp + (size_t)sl * 8192 + e0;
      const float* dc = p.dC + (size_t)sl * 8192 + e0;
#pragma unroll
      for (int r = 0; r < 8; ++r) cp[256 * r] = C[r];
      if (nthr) { p.np[sl * 64 + tid] = n; if (tid == 0) p.mp[sl] = m; }
      const float ml = p.dm[sl * 2], bls = p.dm[sl * 2 + 1];
      const float mn = fmaxf(bls + m, ml);
      const float ca = __expf(bls + m - mn), cb = __expf(ml - mn);
#pragma unroll
      for (int r = 0; r < 8; ++r) C[r] = ca * C[r] + cb * dc[256 * r];
      if (nthr) n = ca * n + cb * p.dn[sl * 64 + tid];
      m = mn;
    }
    if (pr) {
      float* oc = p.out + O_CC + (size_t)sidx * 8192 + e0;
#pragma unroll
      for (int r = 0; r < 8; ++r) oc[256 * r] = C[r];
      if (nthr) { p.out[O_CN + (size_t)sidx * 64 + tid] = n; if (tid == 0) p.out[O_CM + sidx] = m; }
    }
  }
}

__device__ __forceinline__ void odd_mid_phase(PRM p, int o, char* smem) {
  u16* lds = (u16*)smem;
  const int tid = get_tid(), lane = tid & 63, wave = tid >> 6, l15 = lane & 15, q4 = lane >> 4;
  for (int bt = get_bid(); bt < 256 + 768 + 512; bt += vgrid()) {
    if (bt < 256) {
      int qb = bt & 15, hq = (bt >> 4) & 7, b = bt >> 7;
      int kvh = hq >> 2;
      int mq = NPR + b * 1024 + qb * 64 + wave * 16;
      AttnSt st; attn_init(st);
      bf16x8 qf[2]; load_q64(qf, p.qa + (size_t)mq * 512 + hq * 64, 512, l15, q4);
      at_run_plain<2>(st, qf, p.kd + (size_t)(NPR + b * 1536) * 128 + kvh * 64, 128, p.vtd_s + (size_t)((b * 2 + kvh) * 64) * 1536, 1536, 24, 0.125f, lds, tid, l15, q4);
      attn_fin(st, p.mix + (size_t)mq * 1024 + 512 + hq * 64, l15, q4);
    } else if (bt < 256 + 768) {
      mlstm1_task(p, o, bt - 256, (float*)smem);
    } else {
      int u = bt - 1024;
      int qb = u & 3, hq = (u >> 2) & 7, b = u >> 5;
      int kvh = hq >> 2;
      int mq = b * 256 + qb * 64 + wave * 16;
      AttnSt st; attn_init(st);
      bf16x8 qf[2]; load_q64(qf, p.qa + (size_t)mq * 512 + hq * 64, 512, l15, q4);
      at_run_plain<2>(st, qf, p.kd + (size_t)(b * 256) * 128 + kvh * 64, 128, p.vtd_p + (size_t)((b * 2 + kvh) * 64) * 256, 256, 4, 0.125f, lds, tid, l15, q4);
      attn_fin(st, p.mix + (size_t)mq * 1024 + 512 + hq * 64, l15, q4);
    }
  }
}

__device__ __forceinline__ void run_phase(PRM p, int ph, char* smem) {
  char* vsm = smem + (rtid() >> 8) * LDS_HALF;
  if (ph == 0) { phase0(p, vsm); return; }
  if (ph == NPHASE - 1) { norm_phase(p, 0, 3); return; }
  const int l = (ph - 1) / 13, s = (ph - 1) % 13;
  const int eo = l >> 1;
  const bool even = (l & 1) == 0;
  EpiP e{};
  const float* modl = p.mod + (size_t)l * 3 * 9216;
  switch (s) {
    case 0: norm_phase(p, l, 0); break;
    case 1: e.H = p.h; ffn_in_phase(p, l, 0, e, smem); break;
    case 2: e.C = p.x; e.gate = modl + 2 * 1024; e.ldc = 1;
            gemm_phase<EPI_RESID, 4, 2, 3, 4, 2>(p.h, p.wt_ffn_out + (size_t)(l * 2 + 0) * 1024 * 2816, 2816, 32, 8, e, smem); break;
    case 3: norm_phase(p, l, 1); break;
    case 4:
      if (even) { e.C = p.proj; e.ldc = 2688; gemm_phase<EPI_STORE, 4, 2, 4, 4, 2>(p.xn, p.wt_in_e + (size_t)eo * 2688 * 1024, 1024, 24, 21, e, smem); }
      else { e.C = p.proj; e.ldc = 2432; gemm_phase<EPI_STORE, 4, 2, 4, 4, 2>(p.xn, p.wt_in_o + (size_t)eo * 2432 * 1024, 1024, 24, 19, e, smem); }
      break;
    case 5: if (even) post_even(p, eo); else post_odd(p, eo); break;
    case 6:
      if (even) {
        EpiP eq{}; eq.C = p.qb; eq.ldc = 768;
        EpiP ek{}; ek.kb = p.kb; ek.vtp = p.vtb_p; ek.vts = p.vtb_s; ek.ctx = 0;
        EpiP ec = ek; ec.ctx = 1;
        const u16* wq = p.wt_qup + (size_t)eo * 768 * 768;
        const u16* wk = p.wt_kvup + (size_t)eo * 1024 * 256;
        for (int t = rbid(); t < 288 + 384 + 64; t += (int)gridDim.x) {
          if (t < 288) gemm_tile<EPI_STORE, 4, 2, 2, 4, 2>(p.cqn, wq, 768, t % 48, t / 48, eq, smem);
          else if (t < 672) { int u = t - 288; gemm_tile<EPI_KVUP, 4, 2, 2, 4, 2>(p.ckvn, wk, 256, u % 48, u / 48, ek, smem); }
          else { int u = t - 672; gemm_tile<EPI_KVUP, 4, 2, 2, 4, 2>(p.cctxn, wk, 256, u % 8, u / 8, ec, smem); }
        }
      } else odd_mid_phase(p, eo, vsm);
      break;
    case 7: if (!even) mlstm_scan_phase(p, eo); break;
    case 8:
      if (even) attn_even_phase(p, eo, vsm);
      else { for (int t = get_bid(); t < 384; t += vgrid()) mlstm2_mfma(p, eo, t, vsm); }
      break;
    case 9: e.C = p.x; e.gate = modl + 5 * 1024; e.ldc = 0;
            gemm_phase<EPI_RESID, 4, 2, 3, 4, 2>(p.mix, p.wt_out + (size_t)l * 1024 * 1024, 1024, 32, 8, e, smem); break;
    case 10: norm_phase(p, l, 2); break;
    case 11: e.H = p.h; ffn_in_phase(p, l, 1, e, smem); break;
    case 12: e.C = p.x; e.gate = modl + 8 * 1024; e.ldc = 1;
             gemm_phase<EPI_RESID, 4, 2, 3, 4, 2>(p.h, p.wt_ffn_out + (size_t)(l * 2 + 1) * 1024 * 2816, 2816, 32, 8, e, smem); break;
  }
}

__global__ void __launch_bounds__(512, 2) mega(Params p) {
  __shared__ __attribute__((aligned(16))) char smem[LDS_BYTES];
  __shared__ uint4 xb_words;
  cg::grid_group grid = cg::this_grid();
  if (threadIdx.x == 0) xb_words = make_uint4(0u, 0u, 0u, 0u);
  __syncthreads();
  XcdBarrier xb = xcd_barrier_post(p.bar, (volatile LAS unsigned*)&xb_words);
  for (int ph = p.ph0; ph < p.ph1; ++ph) {
    const __attribute__((address_space(4))) Params* pp = (const __attribute__((address_space(4))) Params*)__builtin_amdgcn_kernarg_segment_ptr();
    asm volatile("" : "+s"(pp));
    run_phase(*pp, ph, smem);
#ifndef REPMASK
#define REPMASK 0
#endif
#ifndef REPPAR
#define REPPAR 0
#endif
    if (REPMASK) {
      int bit = ph == 0 ? 13 : (ph == NPHASE - 1 ? 14 : (ph - 1) % 13);
      int lay = (ph - 1) / 13;
      bool parok = REPPAR == 0 || ph == 0 || ph == NPHASE - 1 || (REPPAR == 1 && (lay & 1) == 0) || (REPPAR == 2 && (lay & 1) == 1);
      if (((REPMASK >> bit) & 1) && parok) { xcd_barrier(xb); asm volatile("" : "+s"(pp)); run_phase(*pp, ph, smem); }
    }
    if (ph + 1 < p.ph1) {
      if (p.ph1 > 100000) grid.sync();
      xcd_barrier(xb);
    }
  }
}

extern "C" void kernel_launch(void* const* d_in, const int* in_sizes, int n_in, void* d_out, int out_size, void* d_ws, size_t ws_size,
                              hipStream_t stream) {
  static int grid_blocks = 0;
  if (!grid_blocks) {
    int dev = 0, cus = 0, per_cu = 0;
    hipGetDevice(&dev);
    hipDeviceGetAttribute(&cus, hipDeviceAttributeMultiprocessorCount, dev);
    hipOccupancyMaxActiveBlocksPerMultiprocessor(&per_cu, mega, 512, 0);
    per_cu = 1;
    grid_blocks = cus * per_cu;
  }
  Params p{};
  const float** ip = (const float**)&p.x_prompt;
  for (int i = 0; i < 31; ++i) ip[i] = (const float*)d_in[i];
  p.out = (float*)d_out;
  char* w = (char*)d_ws;
  size_t off = 0;
  auto take = [&](size_t bytes) { char* r = w + off; off += (bytes + 255) & ~(size_t)255; return r; };
  p.wt_ffn_in = (u16*)take((size_t)8 * 5632 * 1024 * 2);
  p.wt_ffn_out = (u16*)take((size_t)8 * 1024 * 2816 * 2);
  p.wt_in_e = (u16*)take((size_t)2 * 2688 * 1024 * 2);
  p.wt_in_o = (u16*)take((size_t)2 * 2432 * 1024 * 2);
  p.wt_out = (u16*)take((size_t)4 * 1024 * 1024 * 2);
  p.wt_qup = (u16*)take((size_t)2 * 768 * 768 * 2);
  p.wt_kvup = (u16*)take((size_t)2 * 1024 * 256 * 2);
  p.mod = (float*)take((size_t)12 * 9216 * 4);
  p.x = (float*)take((size_t)NTOK * 1024 * 4);
  p.proj = (float*)take((size_t)NTOK * 2688 * 4);
  p.qb = (float*)take((size_t)NTOK * 768 * 4);
  p.dC = (float*)take((size_t)768 * 8192 * 4);
  p.dn = (float*)take((size_t)768 * 64 * 4);
  p.dm = (float*)take((size_t)768 * 2 * 4);
  p.cp = (float*)take((size_t)768 * 8192 * 4);
  p.np = (float*)take((size_t)768 * 64 * 4);
  p.mp = (float*)take((size_t)768 * 4);
  p.xn = (u16*)take((size_t)NTOK * 1024 * 2);
  p.h = (u16*)take((size_t)NTOK * 2816 * 2);
  p.mix = (u16*)take((size_t)NTOK * 1024 * 2);
  p.qa = (u16*)take((size_t)NTOK * 512 * 2);
  p.ka = (u16*)take((size_t)NTOK * 512 * 2);
  p.kactx = (u16*)take((size_t)1024 * 512 * 2);
  p.vta_p = (u16*)take((size_t)16 * 8 * 64 * 256 * 2);
  p.vta_s = (u16*)take((size_t)2 * 8 * 64 * 1536 * 2);
  p.kb = (u16*)take((size_t)7168 * 768 * 2);
  p.vtb_p = (u16*)take((size_t)16 * 8 * 64 * 256 * 2);
  p.vtb_s = (u16*)take((size_t)2 * 8 * 64 * 1536 * 2);
  p.cqn = (u16*)take((size_t)NTOK * 768 * 2);
  p.ckvn = (u16*)take((size_t)NTOK * 256 * 2);
  p.cctxn = (u16*)take((size_t)1024 * 256 * 2);
  p.kd = (u16*)take((size_t)7168 * 128 * 2);
  p.vtd_p = (u16*)take((size_t)16 * 2 * 64 * 256 * 2);
  p.vtd_s = (u16*)take((size_t)2 * 2 * 64 * 1536 * 2);
  p.bar = (unsigned*)take((size_t)XCD_BAR_WORDS * 4);
  if (off > ws_size) { fprintf(stderr, "kernel_launch: workspace too small: need %zu have %zu\n", off, ws_size); return; }
  hipMemsetAsync(p.bar, 0, (size_t)XCD_BAR_WORDS * 4, stream);
#if MULTI
  for (int ph = 0; ph < NPHASE; ++ph) {
    p.ph0 = ph; p.ph1 = ph + 1;
    hipLaunchKernelGGL(mega, dim3(grid_blocks), dim3(512), 0, stream, p);
  }
#else
  p.ph0 = 0; p.ph1 = NPHASE;
  void* args[] = {&p};
  hipError_t e = hipLaunchCooperativeKernel((void*)mega, dim3(grid_blocks), dim3(512), args, 0, stream);
  if (e != hipSuccess) fprintf(stderr, "cooperative launch failed: %s (grid %d)\n", hipGetErrorString(e), grid_blocks);
#endif
}
```

```cpp
#include <hip/hip_runtime.h>
#include <hip/hip_cooperative_groups.h>
#include <cstdio>
#include <cstdint>
namespace cg = cooperative_groups;

#ifndef MULTI
#define MULTI 0
#endif

typedef unsigned short u16;
typedef __attribute__((ext_vector_type(8))) short bf16x8;
typedef __attribute__((ext_vector_type(4))) short s16x4;
typedef __attribute__((ext_vector_type(4))) float f32x4;
typedef __attribute__((ext_vector_type(4))) unsigned int u32x4;

#define NTOK 6144
#define NPR 4096
#define LDS_HALF 77824
#define LDS_BYTES (2 * LDS_HALF)
#define NPHASE 54
#define EPS 1e-6f

struct Params {
  const float *x_prompt, *x_sample, *cache_a_k, *cache_a_v, *cache_b_ckv, *cache_b_krope, *cache_d_k, *cache_d_v;
  const float *state_C, *state_n, *state_m, *c, *c_ctx, *w_mod, *b_mod, *norm_g, *ffn_in, *ffn_out;
  const float *w_in_even, *w_in_odd, *w_out, *a_rpb, *b_q_norm, *b_wq_up, *b_kv_norm, *b_wkv_up;
  const float *c_gate_bias, *c_out_norm, *d_q_norm, *d_k_norm, *final_norm;
  float* out;
  u16 *wt_ffn_in, *wt_ffn_out, *wt_in_e, *wt_in_o, *wt_out, *wt_qup, *wt_kvup;
  float *mod, *x, *proj, *qb, *dC, *dn, *dm, *cp, *np, *mp;
  u16 *xn, *h, *mix, *qa, *ka, *kactx, *vta_p, *vta_s, *kb, *vtb_p, *vtb_s, *cqn, *ckvn, *cctxn, *kd, *vtd_p, *vtd_s;
  unsigned* bar;
  int ph0, ph1;
};

typedef const __attribute__((address_space(4))) Params& PRM;
#define O_YP 0
#define O_YS 4194304
#define O_AK 6291456
#define O_AV 10485760
#define O_CKV 14680064
#define O_KR 16777216
#define O_DK 17039360
#define O_DV 18087936
#define O_CC 19136512
#define O_CN 21233664
#define O_CM 21250048

__device__ __forceinline__ int get_tid() { int t = threadIdx.x & 255; asm volatile("" : "+v"(t)); return t; }
__device__ __forceinline__ int rtid_raw() { int t = threadIdx.x; asm volatile("" : "+v"(t)); return t; }
__device__ __forceinline__ int get_bid() { int t = blockIdx.x * 2 + __builtin_amdgcn_readfirstlane(rtid_raw() >> 8); asm volatile("" : "+s"(t)); return t; }
__device__ __forceinline__ int vgrid() { return (int)gridDim.x * 2; }
__device__ __forceinline__ int rtid() { int t = threadIdx.x; asm volatile("" : "+v"(t)); return t; }
__device__ __forceinline__ int rbid() { int t = blockIdx.x; asm volatile("" : "+s"(t)); return t; }
typedef __attribute__((ext_vector_type(2))) __bf16 bf16x2_t;
typedef __attribute__((ext_vector_type(2))) float f32x2_t;
__device__ __forceinline__ unsigned pack2(float a, float b) {
  f32x2_t v = {a, b};
  bf16x2_t r = __builtin_convertvector(v, bf16x2_t);
  return __builtin_bit_cast(unsigned, r);
}
__device__ __forceinline__ u16 f2bf(float f) { return (u16)(pack2(f, 0.f) & 0xffffu); }
__device__ __forceinline__ float shx(float v, int m) {
  int l = __builtin_amdgcn_mbcnt_hi(-1, __builtin_amdgcn_mbcnt_lo(-1, 0));
  asm volatile("" : "+v"(l));
  return __int_as_float(__builtin_amdgcn_ds_bpermute((l ^ m) << 2, __float_as_int(v)));
}
__device__ __forceinline__ float wsum(float v) {
#pragma unroll
  for (int o = 32; o; o >>= 1) v += shx(v, o);
  return v;
}
__device__ __forceinline__ float wmaxr(float v) {
#pragma unroll
  for (int o = 32; o; o >>= 1) v = fmaxf(v, shx(v, o));
  return v;
}
__device__ __forceinline__ float silu_f(float x) { return x / (1.f + __expf(-x)); }
__device__ __forceinline__ float sigmoid_f(float x) { return 1.f / (1.f + __expf(-x)); }
__device__ __forceinline__ float logsig_f(float x) { return fminf(x, 0.f) - __logf(1.f + __expf(-fabsf(x))); }
__device__ __forceinline__ void sincos_r(float a, float& s, float& c) {
  float n = rintf(a * 0.15915494309f);
  float r = fmaf(-n, 6.2831855f, a);
  r = fmaf(-n, -1.7484555e-7f, r);
  s = __sinf(r); c = __cosf(r);
}
__device__ __forceinline__ int grp_of(int m) { return m < NPR ? 0 : 1 + ((m - NPR) >> 10); }
__device__ __forceinline__ int keyrow(int m) { return m < NPR ? m : NPR + ((m - NPR) >> 10) * 1536 + ((m - NPR) & 1023); }
__device__ __forceinline__ f32x4 mfma16(bf16x8 a, bf16x8 b, f32x4 c) { return __builtin_amdgcn_mfma_f32_16x16x32_bf16(a, b, c, 0, 0, 0); }

#define XB_TMO      128
#define XB_XCNT(j)  (256  + 64 * (j))
#define XB_XSUB(j)  (1280 + 64 * (j))
#define XB_XGEN(j)  (2304 + 64 * (j))
#define XB_TOP      3328
#define XB_TOPGEN   3392
#define XCD_BAR_WORDS 3456
#define XB_SPIN_CAP (1u << 18)
#define LAS __attribute__((address_space(3)))

__device__ __forceinline__ unsigned xb_ld(unsigned* p)              { return __hip_atomic_load(p, __ATOMIC_RELAXED, __HIP_MEMORY_SCOPE_AGENT); }
__device__ __forceinline__ unsigned xb_add(unsigned* p, unsigned v) { return __hip_atomic_fetch_add(p, v, __ATOMIC_RELAXED, __HIP_MEMORY_SCOPE_AGENT); }
__device__ __forceinline__ unsigned xb_xcc_id() { return (unsigned)__builtin_amdgcn_s_getreg((3 << 11) | 20) & 0xFu; }
#define XB_SPIN(cond, bar) do { unsigned _sp = 0; while (cond) { __builtin_amdgcn_s_sleep(1); \
    if ((++_sp & 255u) == 0u) { if (xb_ld(&(bar)[XB_TMO])) break; if (_sp > XB_SPIN_CAP) { atomicAdd(&(bar)[XB_TMO], 1u); break; } } } } while (0)

struct XcdBarrier {
    unsigned* bar; unsigned x;
    volatile LAS unsigned* st;
};

__device__ __forceinline__ XcdBarrier xcd_barrier_post(unsigned* bar, volatile LAS unsigned* st) {
    XcdBarrier b; b.bar = bar; b.x = xb_xcc_id(); b.st = st;
    if (threadIdx.x == 0) (void)xb_add(&bar[XB_XCNT(b.x)], 1u);
    return b;
}
__device__ __forceinline__ void xcd_barrier_complete(unsigned* bar, unsigned x, unsigned& nloc, unsigned& nx) {
    const unsigned G = gridDim.x * gridDim.y * gridDim.z;
    unsigned sum, cnt, mine, sp = 0u;
    for (;;) {
        sum = 0u; cnt = 0u; mine = 0u;
#pragma unroll
        for (unsigned j = 0; j < 16; ++j) { const unsigned c = xb_ld(&bar[XB_XCNT(j)]); sum += c; cnt += (c > 0u) ? 1u : 0u; mine = (j == x) ? c : mine; }
        if (sum == G) break;
        __builtin_amdgcn_s_sleep(1);
        if ((++sp & 255u) == 0u) { if (xb_ld(&bar[XB_TMO])) break; if (sp > XB_SPIN_CAP) { atomicAdd(&bar[XB_TMO], 1u); break; } }
    }
    nloc = mine > 0u ? mine : 1u; nx = cnt > 0u ? cnt : 1u;
}

__device__ __forceinline__ void xcd_barrier(const XcdBarrier& b) {
    asm volatile("s_waitcnt vmcnt(0)" ::: "memory");
    __syncthreads();
    if (threadIdx.x == 0) {
        unsigned* bar = b.bar;
        __builtin_amdgcn_s_waitcnt(0);
        unsigned nloc = b.st[0], nx = b.st[1];
        if (nloc == 0u) { xcd_barrier_complete(bar, b.x, nloc, nx); b.st[0] = nloc; b.st[1] = nx; }
        const unsigned old = xb_add(&bar[XB_XSUB(b.x)], 1u);
        const unsigned gen = old / nloc;
        if (old + 1u == (gen + 1u) * nloc) {
            __builtin_amdgcn_fence(__ATOMIC_RELEASE, "agent");
            asm volatile("s_waitcnt vmcnt(0)" ::: "memory");
            const unsigned og = xb_add(&bar[XB_TOP], 1u);
            const unsigned tg = og / nx;
            if (og + 1u == (tg + 1u) * nx) xb_add(&bar[XB_TOPGEN], 1u);
            else XB_SPIN(xb_ld(&bar[XB_TOPGEN]) == tg, bar);
            __builtin_amdgcn_fence(__ATOMIC_ACQUIRE, "agent");
            xb_add(&bar[XB_XGEN(b.x)], 1u);
            asm volatile("s_waitcnt vmcnt(0)" ::: "memory");
        } else {
            XB_SPIN(xb_ld(&bar[XB_XGEN(b.x)]) == gen, bar);
            __builtin_amdgcn_fence(__ATOMIC_ACQUIRE, "agent");
            asm volatile("s_waitcnt vmcnt(0)" ::: "memory");
        }
    }
    __syncthreads();
}


__device__ __forceinline__ void conv_tile(const float* __restrict__ src, int K, int N, int perm, u16* __restrict__ dst, int kt2, int nt, float* tile) {
  const int tid = get_tid();
  {
    const int c4 = tid & 15, kr = tid >> 4;
    const int n = nt * 64 + c4 * 4;
    const bool valid = n < N;
    int col = n;
    if (perm) { int G = n >> 4, w = n & 15, sub = w >> 2; col = ((sub & 1) ? 2816 : 0) + G * 8 + (sub >> 1) * 4 + (w & 3); }
    float4 v[8];
#pragma unroll
    for (int i = 0; i < 8; ++i) {
      int kk = kr + 16 * i;
      v[i] = valid ? *(const float4*)(src + (size_t)(kt2 * 128 + kk) * N + col) : make_float4(0.f, 0.f, 0.f, 0.f);
    }
#pragma unroll
    for (int i = 0; i < 8; ++i) {
      int kk = kr + 16 * i;
      float* t = tile + (kk >> 6) * 4160 + (kk & 63) * 65 + c4 * 4;
      t[0] = v[i].x; t[1] = v[i].y; t[2] = v[i].z; t[3] = v[i].w;
    }
  }
  __syncthreads();
  {
    const int k8 = (tid & 7) * 8;
#pragma unroll
    for (int hh = 0; hh < 2; ++hh)
#pragma unroll
      for (int i = 0; i < 2; ++i) {
        int nn2 = (tid >> 3) + 32 * i;
        float v[8];
#pragma unroll
        for (int e = 0; e < 8; ++e) v[e] = tile[hh * 4160 + (k8 + e) * 65 + nn2];
        uint4 o; o.x = pack2(v[0], v[1]); o.y = pack2(v[2], v[3]); o.z = pack2(v[4], v[5]); o.w = pack2(v[6], v[7]);
        *(uint4*)(dst + (size_t)(nt * 64 + nn2) * K + kt2 * 128 + hh * 64 + k8) = o;
      }
  }
  __syncthreads();
}

__device__ __forceinline__ void mod_task(PRM p, int t, float* sm) {
  const int l = t / 144, cb = t % 144, tid = get_tid();
  float* sc = sm;
  float* red = sm + 3072;
  for (int i = tid; i < 3072; i += 256) {
    int g = i >> 10, k = i & 1023;
    float v = g == 0 ? p.c_ctx[k] : p.c[(g - 1) * 1024 + k];
    sc[i] = silu_f(v);
  }
  __syncthreads();
  const int c4 = tid & 15, kg = tid >> 4;
  const float* w = p.w_mod + (size_t)l * 1024 * 9216 + (size_t)(kg * 64) * 9216 + cb * 64 + c4 * 4;
  float a[3][4];
#pragma unroll
  for (int g = 0; g < 3; ++g)
#pragma unroll
    for (int q = 0; q < 4; ++q) a[g][q] = 0.f;
  for (int k = 0; k < 64; k += 8) {
    float4 wv[8];
#pragma unroll
    for (int e = 0; e < 8; ++e) wv[e] = *(const float4*)(w + (size_t)(k + e) * 9216);
#pragma unroll
    for (int e = 0; e < 8; ++e) {
      int kk = kg * 64 + k + e;
#pragma unroll
      for (int g = 0; g < 3; ++g) {
        float sv = sc[g * 1024 + kk];
        a[g][0] = fmaf(sv, wv[e].x, a[g][0]); a[g][1] = fmaf(sv, wv[e].y, a[g][1]);
        a[g][2] = fmaf(sv, wv[e].z, a[g][2]); a[g][3] = fmaf(sv, wv[e].w, a[g][3]);
      }
    }
  }
#pragma unroll
  for (int g = 0; g < 3; ++g)
#pragma unroll
    for (int q = 0; q < 4; ++q) red[(kg * 3 + g) * 64 + c4 * 4 + q] = a[g][q];
  __syncthreads();
  if (tid < 192) {
    int g = tid >> 6, c2 = tid & 63;
    float s = 0.f;
#pragma unroll
    for (int q = 0; q < 16; ++q) s += red[(q * 3 + g) * 64 + c2];
    int j = cb * 64 + c2;
    p.mod[(size_t)(l * 3 + g) * 9216 + j] = s + p.b_mod[l * 9216 + j];
  }
  __syncthreads();
}

__device__ __forceinline__ int conv_layer_count(int l) { return (l & 1) ? 2544 : 2680; }
__device__ __forceinline__ void conv_layer_task(PRM p, int l, int u, float* sm) {
  const float* src; u16* dst; int K, N, Npad, perm = 0, tp, mat0;
  const int eo = l >> 1;
  const int nin = (l & 1) ? 304 : 336;
  if (u < 1408) { K = 1024; N = 5632; Npad = 5632; perm = 1; tp = 704; src = p.ffn_in; dst = p.wt_ffn_in; mat0 = l * 2; }
  else if ((u -= 1408) < 704) { K = 2816; N = 1024; Npad = 1024; tp = 352; src = p.ffn_out; dst = p.wt_ffn_out; mat0 = l * 2; }
  else if ((u -= 704) < nin) {
    if (l & 1) { K = 1024; N = 2320; Npad = 2432; tp = 304; src = p.w_in_odd; dst = p.wt_in_o; mat0 = eo; }
    else { K = 1024; N = 2592; Npad = 2688; tp = 336; src = p.w_in_even; dst = p.wt_in_e; mat0 = eo; }
  }
  else if ((u -= nin) < 128) { K = 1024; N = 1024; Npad = 1024; tp = 128; src = p.w_out; dst = p.wt_out; mat0 = l; }
  else if ((u -= 128) < 72) { K = 768; N = 768; Npad = 768; tp = 72; src = p.b_wq_up; dst = p.wt_qup; mat0 = eo; }
  else { u -= 72; K = 256; N = 1024; Npad = 1024; tp = 32; src = p.b_wkv_up; dst = p.wt_kvup; mat0 = eo; }
  int mat = mat0 + u / tp, r = u % tp;
  int nkt = K / 128;
  int kt = r % nkt, nt = r / nkt;
  conv_tile(src + (size_t)mat * K * N, K, N, perm, dst + (size_t)mat * Npad * K, kt, nt, sm);
}

__device__ __forceinline__ void phase0(PRM p, char* smem) {
  float* sm = (float*)smem;
  const int NMOD = 144, NCOPY = 1536, NCONV = 2680;
  const int total = NMOD + NCOPY + NCONV;
  for (int t = get_bid(); t < total; t += vgrid()) {
    if (t < NMOD) { mod_task(p, t, sm); continue; }
    int u = t - NMOD;
    if (u < NCOPY) {
      const int tid = get_tid();
#pragma unroll
      for (int i = 0; i < 4; ++i) {
        size_t idx = ((size_t)u * 1024 + i * 256 + tid);
        const float4* src = idx < (size_t)NPR * 256 ? (const float4*)p.x_prompt + idx : (const float4*)p.x_sample + (idx - (size_t)NPR * 256);
        ((float4*)p.x)[idx] = *src;
      }
      continue;
    }
    conv_layer_task(p, 0, u - NCOPY, sm);
  }
}

__device__ __forceinline__ void norm_phase(PRM p, int l, int which) {
  const int lane = get_tid() & 63, wave = get_tid() >> 6;
  const int nrows_wave = NTOK / 4;
  const int stride = vgrid();
  for (int t0 = get_bid(); t0 < nrows_wave; t0 += 3 * stride) {
    float4 v[3][4];
    float ss[3];
#pragma unroll
    for (int k = 0; k < 3; ++k) {
      const int t = t0 + k * stride;
      if (t < nrows_wave) {
        const float4* xr = (const float4*)(p.x + (size_t)(t * 4 + wave) * 1024);
#pragma unroll
        for (int i = 0; i < 4; ++i) v[k][i] = xr[i * 64 + lane];
      }
    }
#pragma unroll
    for (int k = 0; k < 3; ++k) {
      float a = 0.f;
#pragma unroll
      for (int i = 0; i < 4; ++i) a += v[k][i].x * v[k][i].x + v[k][i].y * v[k][i].y + v[k][i].z * v[k][i].z + v[k][i].w * v[k][i].w;
      ss[k] = wsum(a);
    }
#pragma unroll
    for (int k = 0; k < 3; ++k) {
      const int t = t0 + k * stride;
      if (t >= nrows_wave) continue;
      const int m = t * 4 + wave;
      const float r = rsqrtf(ss[k] * (1.f / 1024.f) + EPS);
      if (which == 3) {
        float4* o = (float4*)(p.out + (size_t)m * 1024);
#pragma unroll
        for (int i = 0; i < 4; ++i) {
          float4 g = ((const float4*)p.final_norm)[i * 64 + lane];
          float4 y; y.x = v[k][i].x * r * g.x; y.y = v[k][i].y * r * g.y; y.z = v[k][i].z * r * g.z; y.w = v[k][i].w * r * g.w;
          o[i * 64 + lane] = y;
        }
      } else {
        const float* md = p.mod + (size_t)(l * 3 + grp_of(m)) * 9216 + which * 3072;
        const float4* sh = (const float4*)md;
        const float4* sc = (const float4*)(md + 1024);
        const float4* gg = (const float4*)(p.norm_g + (size_t)(l * 3 + which) * 1024);
#pragma unroll
        for (int i = 0; i < 4; ++i) {
          float4 g = gg[i * 64 + lane], s = sc[i * 64 + lane], b = sh[i * 64 + lane];
          float y0 = v[k][i].x * r * g.x * (1.f + s.x) + b.x;
          float y1 = v[k][i].y * r * g.y * (1.f + s.y) + b.y;
          float y2 = v[k][i].z * r * g.z * (1.f + s.z) + b.z;
          float y3 = v[k][i].w * r * g.w * (1.f + s.w) + b.w;
          uint2 o; o.x = pack2(y0, y1); o.y = pack2(y2, y3);
          *(uint2*)(p.xn + (size_t)m * 1024 + (i * 64 + lane) * 4) = o;
        }
      }
    }
  }
}

struct EpiP {
  float* C; int ldc;
  const float* gate;
  u16* H;
  u16 *kb, *vtp, *vts; int ctx;
};
enum { EPI_STORE = 0, EPI_RESID = 1, EPI_SWIGLU = 2, EPI_KVUP = 3 };

template <int FI, int FJ, bool SWAP>
__device__ __forceinline__ void g_compute(f32x4 (&acc)[FI][FJ], const u16* Ac, const u16* Bc, int q4, int rsw) {
  __builtin_amdgcn_s_setprio(1);
#pragma unroll
  for (int ks = 0; ks < 2; ++ks) {
    const int co = ((ks * 4 + q4) ^ rsw) << 3;
#pragma unroll
    for (int j0 = 0; j0 < FJ; j0 += 4) {
      bf16x8 b[4];
#pragma unroll
      for (int j = 0; j < 4; ++j) if (j0 + j < FJ) b[j] = *(const bf16x8*)(Bc + (j0 + j) * 1024 + co);
#pragma unroll
      for (int i0 = 0; i0 < FI; i0 += 4) {
        bf16x8 a[4];
#pragma unroll
        for (int i = 0; i < 4; ++i) if (i0 + i < FI) a[i] = *(const bf16x8*)(Ac + (i0 + i) * 1024 + co);
#pragma unroll
        for (int j = 0; j < 4; ++j)
          if (j0 + j < FJ) {
#pragma unroll
            for (int i = 0; i < 4; ++i)
              if (i0 + i < FI) acc[i0 + i][j0 + j] = SWAP ? mfma16(b[j], a[i], acc[i0 + i][j0 + j]) : mfma16(a[i], b[j], acc[i0 + i][j0 + j]);
          }
      }
    }
  }
  __builtin_amdgcn_s_setprio(0);
}

template <int EPI, int WMW, int WNW, int FI, int FJ, int DEPTH>
__device__ __forceinline__ void gemm_tile(const u16* __restrict__ A, const u16* __restrict__ Wt, int K, int tm, int tn, const EpiP& e, char* smem) {
  constexpr int BM = WMW * FI * 16, BN = WNW * FJ * 16;
  constexpr int NA = BM / 64, NB = BN / 64;
  constexpr int BUFSZ = (BM + BN) * 64;
  static_assert(WMW * WNW == 8 && BM % 64 == 0 && BN % 64 == 0, "tile");
  u16* As = (u16*)smem;
  u16* Bs = As + BM * 64;
  const int tid = rtid(), lane = tid & 63, wave = tid >> 6, wm = wave / WNW, wn = wave % WNW, l15 = lane & 15, q4 = lane >> 4;
  const int lr = tid >> 3, lc = tid & 7;
  const u16* Ag = A + (size_t)(tm * BM + lr) * K + lc * 8;
  const u16* Bg = Wt + (size_t)(tn * BN + lr) * K + lc * 8;
  const int st_off = lr * 64 + ((lc ^ ((lr >> 1) & 7)) << 3);
  const int rsw = (l15 >> 1) & 7;
  const int a_row = (wm * FI * 16 + l15) * 64, b_row = (wn * FJ * 16 + l15) * 64;
  f32x4 acc[FI][FJ];
#pragma unroll
  for (int i = 0; i < FI; ++i)
#pragma unroll
    for (int j = 0; j < FJ; ++j) acc[i][j] = (f32x4){0.f, 0.f, 0.f, 0.f};
  const int nk = K >> 6;
#define GL(RA, RB, KT) { _Pragma("unroll") for (int i = 0; i < NA; ++i) RA[i] = *(const u32x4*)(Ag + (size_t)i * 64 * K + (KT) * 64); \
                         _Pragma("unroll") for (int i = 0; i < NB; ++i) RB[i] = *(const u32x4*)(Bg + (size_t)i * 64 * K + (KT) * 64); }
#define GS(RA, RB, BUF) { _Pragma("unroll") for (int i = 0; i < NA; ++i) *(u32x4*)(As + (BUF) * BUFSZ + st_off + i * 4096) = RA[i]; \
                          _Pragma("unroll") for (int i = 0; i < NB; ++i) *(u32x4*)(Bs + (BUF) * BUFSZ + st_off + i * 4096) = RB[i]; }
  if constexpr (DEPTH == 4) {
    static_assert(WMW == 4 && WNW == 2 && FJ == 4 && (FI == 3 || FI == 4), "ring4 tile");
    constexpr int ST = (BM + BN) * 32;
    const int nk32 = K >> 5;
    const int fs = (-(tid >> 4)) & 3;
    const int sc = ((tid & 3) ^ fs) << 3;
    const int r4 = tid >> 2;
    const bool three = (BM == 256) || (tid < 256);
    const u16* sp0 = A + (size_t)(tm * BM + r4) * K + sc;
    const int lo0 = tid * 8;
    const u16* sp1; int lo1; const u16* sp2; int lo2;
    if (BM == 256) {
      sp1 = A + (size_t)(tm * BM + 128 + r4) * K + sc;  lo1 = (tid + 512) * 8;
      sp2 = Wt + (size_t)(tn * BN + r4) * K + sc;       lo2 = BM * 32 + tid * 8;
    } else if (tid < 256) {
      sp1 = A + (size_t)(tm * BM + 128 + r4) * K + sc;  lo1 = (tid + 512) * 8;
      sp2 = Wt + (size_t)(tn * BN + 64 + r4) * K + sc;  lo2 = BM * 32 + (tid + 256) * 8;
    } else {
      sp1 = Wt + (size_t)(tn * BN + (r4 - 64)) * K + sc; lo1 = BM * 32 + (tid - 256) * 8;
      sp2 = sp1; lo2 = lo1;
    }
    const int fr = (-(l15 >> 2)) & 3;
    const int co3 = (q4 ^ fr) << 3;
    const int a_row3 = (wm * FI * 16 + l15) * 32 + co3, b_row3 = BM * 32 + (wn * FJ * 16 + l15) * 32 + co3;
    const unsigned lbase = (unsigned)(size_t)As;
#define GD4(KT, BUF) { __builtin_amdgcn_global_load_lds((const unsigned*)(sp0 + (KT) * 32), (unsigned*)(As + (BUF) * ST + lo0), 16, 0, 0); \
                       __builtin_amdgcn_global_load_lds((const unsigned*)(sp1 + (KT) * 32), (unsigned*)(As + (BUF) * ST + lo1), 16, 0, 0); \
                       if (three) __builtin_amdgcn_global_load_lds((const unsigned*)(sp2 + (KT) * 32), (unsigned*)(As + (BUF) * ST + lo2), 16, 0, 0); }
    asm volatile("s_waitcnt vmcnt(0)" ::: "memory");
    GD4(0, 0);
    if (nk32 > 1) GD4(1, 1);
    if (nk32 > 2) GD4(2, 2);
#define RING4_STEP(J) { \
      const int kt = kt0 + (J); \
      if (kt + 2 < nk32) { if (three) asm volatile("s_waitcnt vmcnt(6)" ::: "memory"); else asm volatile("s_waitcnt vmcnt(4)" ::: "memory"); } \
      else if (kt + 1 < nk32) { if (three) asm volatile("s_waitcnt vmcnt(3)" ::: "memory"); else asm volatile("s_waitcnt vmcnt(2)" ::: "memory"); } \
      else asm volatile("s_waitcnt vmcnt(0)" ::: "memory"); \
      asm volatile("s_waitcnt lgkmcnt(0)" ::: "memory"); \
      __builtin_amdgcn_s_barrier(); \
      asm volatile("" ::: "memory"); \
      if (kt + 3 < nk32) GD4(kt + 3, ((J) + 3) & 3); \
      const unsigned aad = lbase + (unsigned)(((J) * ST + a_row3) * 2); \
      const unsigned bad = lbase + (unsigned)(((J) * ST + b_row3) * 2); \
      bf16x8 b0, b1, b2, b3, a0, a1, a2, a3; \
      asm volatile("ds_read_b128 %0, %1" : "=v"(b0) : "v"(bad)); \
      asm volatile("ds_read_b128 %0, %1 offset:1024" : "=v"(b1) : "v"(bad)); \
      asm volatile("ds_read_b128 %0, %1 offset:2048" : "=v"(b2) : "v"(bad)); \
      asm volatile("ds_read_b128 %0, %1 offset:3072" : "=v"(b3) : "v"(bad)); \
      asm volatile("ds_read_b128 %0, %1" : "=v"(a0) : "v"(aad)); \
      asm volatile("ds_read_b128 %0, %1 offset:1024" : "=v"(a1) : "v"(aad)); \
      asm volatile("ds_read_b128 %0, %1 offset:2048" : "=v"(a2) : "v"(aad)); \
      if (FI == 4) { asm volatile("ds_read_b128 %0, %1 offset:3072" : "=v"(a3) : "v"(aad)); \
        asm volatile("s_waitcnt lgkmcnt(0)" : "+v"(b0), "+v"(b1), "+v"(b2), "+v"(b3), "+v"(a0), "+v"(a1), "+v"(a2), "+v"(a3)); } \
      else { asm volatile("s_waitcnt lgkmcnt(0)" : "+v"(b0), "+v"(b1), "+v"(b2), "+v"(b3), "+v"(a0), "+v"(a1), "+v"(a2)); a3 = a2; } \
      __builtin_amdgcn_s_setprio(1); \
      { bf16x8 bb[4] = {b0, b1, b2, b3}; bf16x8 aa[4] = {a0, a1, a2, a3}; \
        _Pragma("unroll") for (int j = 0; j < 4; ++j) \
          _Pragma("unroll") for (int i = 0; i < FI; ++i) acc[i][j] = mfma16(bb[j], aa[i], acc[i][j]); } \
      __builtin_amdgcn_s_setprio(0); }
    for (int kt0 = 0; kt0 < nk32; kt0 += 4) {
      RING4_STEP(0) RING4_STEP(1) RING4_STEP(2) RING4_STEP(3)
    }
#undef RING4_STEP
#undef GD4
    __syncthreads();
  } else if constexpr (DEPTH == 3) {
    constexpr int ST = (BM + BN) * 32;
    constexpr int NA4 = BM * 4 / 512, NB4 = BN * 4 / 512;
    const int nk32 = K >> 5;
    const int fs = (-(tid >> 4)) & 3;
    const u16* Ad = A + (size_t)(tm * BM + (tid >> 2)) * K + (((tid & 3) ^ fs) << 3);
    const u16* Bd = Wt + (size_t)(tn * BN + (tid >> 2)) * K + (((tid & 3) ^ fs) << 3);
    u16* Al = As + tid * 8;
    u16* Bl = As + BM * 32 + tid * 8;
    const int fr = (-(l15 >> 2)) & 3;
    const int co3 = (q4 ^ fr) << 3;
    const int a_row3 = (wm * FI * 16 + l15) * 32 + co3, b_row3 = BM * 32 + (wn * FJ * 16 + l15) * 32 + co3;
    static_assert(FI == 8 && FJ == 4, "ring path is written for 8x4 fragments per wave");
    const unsigned lbase = (unsigned)(size_t)As;
#define GD3(KT, BUF) { _Pragma("unroll") for (int i = 0; i < NA4; ++i) __builtin_amdgcn_global_load_lds((const unsigned*)(Ad + (size_t)i * 128 * K + (KT) * 32), (unsigned*)(Al + (BUF) * ST + i * 4096), 16, 0, 0); \
                       _Pragma("unroll") for (int i = 0; i < NB4; ++i) __builtin_amdgcn_global_load_lds((const unsigned*)(Bd + (size_t)i * 128 * K + (KT) * 32), (unsigned*)(Bl + (BUF) * ST + i * 4096), 16, 0, 0); }
    asm volatile("s_waitcnt vmcnt(0)" ::: "memory");
    GD3(0, 0);
    if (nk32 > 1) GD3(1, 1);
    if (nk32 > 2) GD3(2, 2);
#define RING_STEP(J) { \
      const int kt = kt0 + (J); \
      if (kt + 2 < nk32) asm volatile("s_waitcnt vmcnt(%0)" :: "n"(2 * (NA4 + NB4)) : "memory"); \
      else if (kt + 1 < nk32) asm volatile("s_waitcnt vmcnt(%0)" :: "n"(NA4 + NB4) : "memory"); \
      else asm volatile("s_waitcnt vmcnt(0)" ::: "memory"); \
      asm volatile("s_waitcnt lgkmcnt(0)" ::: "memory"); \
      __builtin_amdgcn_s_barrier(); \
      asm volatile("" ::: "memory"); \
      if (kt + 3 < nk32) GD3(kt + 3, ((J) + 3) & 3); \
      const unsigned aad = lbase + (unsigned)(((J) * ST + a_row3) * 2); \
      const unsigned bad = lbase + (unsigned)(((J) * ST + b_row3) * 2); \
      bf16x8 b0, b1, b2, b3, a0, a1, a2, a3; \
      asm volatile("ds_read_b128 %0, %1" : "=v"(b0) : "v"(bad)); \
      asm volatile("ds_read_b128 %0, %1 offset:1024" : "=v"(b1) : "v"(bad)); \
      asm volatile("ds_read_b128 %0, %1 offset:2048" : "=v"(b2) : "v"(bad)); \
      asm volatile("ds_read_b128 %0, %1 offset:3072" : "=v"(b3) : "v"(bad)); \
      asm volatile("ds_read_b128 %0, %1" : "=v"(a0) : "v"(aad)); \
      asm volatile("ds_read_b128 %0, %1 offset:1024" : "=v"(a1) : "v"(aad)); \
      asm volatile("ds_read_b128 %0, %1 offset:2048" : "=v"(a2) : "v"(aad)); \
      asm volatile("ds_read_b128 %0, %1 offset:3072" : "=v"(a3) : "v"(aad)); \
      asm volatile("s_waitcnt lgkmcnt(0)" : "+v"(b0), "+v"(b1), "+v"(b2), "+v"(b3), "+v"(a0), "+v"(a1), "+v"(a2), "+v"(a3)); \
      __builtin_amdgcn_s_setprio(1); \
      { bf16x8 bb[4] = {b0, b1, b2, b3}; bf16x8 aa[4] = {a0, a1, a2, a3}; \
        _Pragma("unroll") for (int j = 0; j < 4; ++j) \
          _Pragma("unroll") for (int i = 0; i < 4; ++i) acc[i][j] = mfma16(bb[j], aa[i], acc[i][j]); } \
      asm volatile("ds_read_b128 %0, %1 offset:4096" : "=v"(a0) : "v"(aad)); \
      asm volatile("ds_read_b128 %0, %1 offset:5120" : "=v"(a1) : "v"(aad)); \
      asm volatile("ds_read_b128 %0, %1 offset:6144" : "=v"(a2) : "v"(aad)); \
      asm volatile("ds_read_b128 %0, %1 offset:7168" : "=v"(a3) : "v"(aad)); \
      asm volatile("s_waitcnt lgkmcnt(0)" : "+v"(b0), "+v"(b1), "+v"(b2), "+v"(b3), "+v"(a0), "+v"(a1), "+v"(a2), "+v"(a3)); \
      { bf16x8 bb[4] = {b0, b1, b2, b3}; bf16x8 aa[4] = {a0, a1, a2, a3}; \
        _Pragma("unroll") for (int j = 0; j < 4; ++j) \
          _Pragma("unroll") for (int i = 0; i < 4; ++i) acc[4 + i][j] = mfma16(bb[j], aa[i], acc[4 + i][j]); } \
      __builtin_amdgcn_s_setprio(0); }
    for (int kt0 = 0; kt0 < nk32; kt0 += 4) {
      RING_STEP(0) RING_STEP(1) RING_STEP(2) RING_STEP(3)
    }
#undef RING_STEP
#undef GD3
    __syncthreads();
  } else if constexpr (DEPTH == 0) {
    const int swz = (lr >> 1) & 7;
    const u16* Ad = A + (size_t)(tm * BM + lr) * K + ((lc ^ swz) << 3);
    const u16* Bd = Wt + (size_t)(tn * BN + lr) * K + ((lc ^ swz) << 3);
    u16* Al = As + tid * 8;
    u16* Bl = Bs + tid * 8;
#define GD(KT, BUF) { _Pragma("unroll") for (int i = 0; i < NA; ++i) __builtin_amdgcn_global_load_lds((const unsigned*)(Ad + (size_t)i * 64 * K + (KT) * 64), (unsigned*)(Al + (BUF) * BUFSZ + i * 4096), 16, 0, 0); \
                      _Pragma("unroll") for (int i = 0; i < NB; ++i) __builtin_amdgcn_global_load_lds((const unsigned*)(Bd + (size_t)i * 64 * K + (KT) * 64), (unsigned*)(Bl + (BUF) * BUFSZ + i * 4096), 16, 0, 0); }
    GD(0, 0);
    asm volatile("s_waitcnt vmcnt(0)" ::: "memory");
    __syncthreads();
    for (int kt = 0; kt < nk; kt += 2) {
      if (kt + 1 < nk) GD(kt + 1, 1);
      g_compute<FI, FJ, (EPI != EPI_KVUP)>(acc, As + a_row, Bs + b_row, q4, rsw);
      asm volatile("s_waitcnt vmcnt(0)" ::: "memory");
      __syncthreads();
      if (kt + 1 >= nk) break;
      if (kt + 2 < nk) GD(kt + 2, 0);
      g_compute<FI, FJ, (EPI != EPI_KVUP)>(acc, As + BUFSZ + a_row, Bs + BUFSZ + b_row, q4, rsw);
      asm volatile("s_waitcnt vmcnt(0)" ::: "memory");
      __syncthreads();
    }
#undef GD
  } else if constexpr (DEPTH == 2) {
    u32x4 ra0[NA], rb0[NB], ra1[NA], rb1[NB];
    GL(ra0, rb0, 0);
    if (nk > 1) GL(ra1, rb1, 1);
    GS(ra0, rb0, 0);
    __syncthreads();
    for (int kt = 0; kt < nk; kt += 2) {
      if (kt + 2 < nk) GL(ra0, rb0, kt + 2);
      g_compute<FI, FJ, (EPI != EPI_KVUP)>(acc, As + a_row, Bs + b_row, q4, rsw);
      if (kt + 1 < nk) GS(ra1, rb1, 1);
      __syncthreads();
      if (kt + 1 >= nk) break;
      if (kt + 3 < nk) GL(ra1, rb1, kt + 3);
      g_compute<FI, FJ, (EPI != EPI_KVUP)>(acc, As + BUFSZ + a_row, Bs + BUFSZ + b_row, q4, rsw);
      if (kt + 2 < nk) GS(ra0, rb0, 0);
      __syncthreads();
    }
  } else {
    u32x4 ra0[NA], rb0[NB];
    GL(ra0, rb0, 0);
    GS(ra0, rb0, 0);
    __syncthreads();
    for (int kt = 0; kt < nk; kt += 2) {
      if (kt + 1 < nk) GL(ra0, rb0, kt + 1);
      g_compute<FI, FJ, (EPI != EPI_KVUP)>(acc, As + a_row, Bs + b_row, q4, rsw);
      if (kt + 1 < nk) GS(ra0, rb0, 1);
      __syncthreads();
      if (kt + 1 >= nk) break;
      if (kt + 2 < nk) GL(ra0, rb0, kt + 2);
      g_compute<FI, FJ, (EPI != EPI_KVUP)>(acc, As + BUFSZ + a_row, Bs + BUFSZ + b_row, q4, rsw);
      if (kt + 2 < nk) GS(ra0, rb0, 0);
      __syncthreads();
    }
  }
#undef GL
#undef GS
  const int mb = tm * BM + wm * FI * 16 + q4 * 4;
  const int nb = tn * BN + wn * FJ * 16;
  const int mrow = tm * BM + wm * FI * 16 + l15;
  if (EPI == EPI_STORE) {
#pragma unroll
    for (int i = 0; i < FI; ++i)
#pragma unroll
      for (int j = 0; j < FJ; ++j) *(f32x4*)(e.C + (size_t)(mrow + i * 16) * e.ldc + nb + j * 16 + q4 * 4) = acc[i][j];
  } else if (EPI == EPI_RESID) {
    const float cf = e.ldc ? 0.5f : 1.0f;
    const f32x4 cfv = {cf, cf, cf, cf};
#pragma unroll
    for (int i = 0; i < FI; ++i) {
      const int m = mrow + i * 16;
      const float* gt = e.gate + (size_t)grp_of(m) * 9216;
#pragma unroll
      for (int j = 0; j < FJ; ++j) {
        const int n = nb + j * 16 + q4 * 4;
        f32x4 g = *(const f32x4*)(gt + n);
        f32x4* px = (f32x4*)(e.C + (size_t)m * 1024 + n);
        f32x4 xv = *px;
        xv += g * cfv * acc[i][j];
        *px = xv;
      }
    }
  } else if (EPI == EPI_SWIGLU) {
    const bool odd = (q4 & 1) != 0;
#pragma unroll
    for (int j = 0; j < FJ; ++j) {
      const int hj = ((nb >> 4) + j) * 8 + (q4 >> 1) * 4;
#pragma unroll
      for (int i2 = 0; i2 < FI / 2; ++i2) {
        float hv[4];
#pragma unroll
        for (int r = 0; r < 4; ++r) {
          float send = odd ? acc[2 * i2][j][r] : acc[2 * i2 + 1][j][r];
          float recv = shx(send, 16);
          float g = odd ? recv : acc[2 * i2][j][r];
          float u = odd ? acc[2 * i2 + 1][j][r] : recv;
          hv[r] = silu_f(g) * u;
        }
        const int m = mrow + (2 * i2 + (odd ? 1 : 0)) * 16;
        uint2 o; o.x = pack2(hv[0], hv[1]); o.y = pack2(hv[2], hv[3]);
        *(uint2*)(e.H + (size_t)m * 2816 + hj) = o;
      }
    }
  } else if (EPI == EPI_KVUP) {
#pragma unroll
    for (int j = 0; j < FJ; ++j) {
      const int n0 = nb + j * 16;
      const int hh = n0 >> 7, wb = n0 & 127;
#pragma unroll
      for (int i = 0; i < FI; ++i) {
        const int m0 = mb + i * 16;
        int krow; u16* vt;
        if (e.ctx) {
          int b = m0 >> 9, key = m0 & 511;
          krow = NPR + b * 1536 + 1024 + key;
          vt = e.vts + (size_t)((b * 8 + hh) * 64) * 1536 + 1024 + key;
        } else if (m0 < NPR) {
          int b = m0 >> 8, t = m0 & 255;
          krow = m0;
          vt = e.vtp + (size_t)((b * 8 + hh) * 64) * 256 + t;
        } else {
          int s = m0 - NPR, b = s >> 10, t = s & 1023;
          krow = NPR + b * 1536 + t;
          vt = e.vts + (size_t)((b * 8 + hh) * 64) * 1536 + t;
        }
        if (wb < 64) {
#pragma unroll
          for (int r = 0; r < 4; ++r) e.kb[(size_t)(krow + r) * 768 + hh * 96 + wb + l15] = f2bf(acc[i][j][r]);
        } else {
          const int d = wb - 64 + l15;
          const size_t L = (e.ctx || m0 >= NPR) ? 1536 : 256;
          uint2 o; o.x = pack2(acc[i][j][0], acc[i][j][1]); o.y = pack2(acc[i][j][2], acc[i][j][3]);
          *(uint2*)(vt + (size_t)d * L) = o;
        }
      }
    }
  }
}

template <int EPI, int WMW, int WNW, int FI, int FJ, int DEPTH>
__device__ __forceinline__ void gemm_phase(const u16* A, const u16* Wt, int K, int Mt, int Nt, const EpiP& e, char* smem) {
  for (int t = rbid(); t < Mt * Nt; t += (int)gridDim.x) gemm_tile<EPI, WMW, WNW, FI, FJ, DEPTH>(A, Wt, K, t % Mt, t / Mt, e, smem);
}

__device__ __forceinline__ void ffn_in_phase(PRM p, int l, int which, const EpiP& e, char* smem) {
  const u16* Wt = p.wt_ffn_in + (size_t)(l * 2 + which) * 5632 * 1024;
  const int G = (int)gridDim.x;
  const int nfull = (528 / G) * G;
  for (int t = rbid(); t < nfull; t += G) gemm_tile<EPI_SWIGLU, 2, 4, 8, 4, 3>(p.xn, Wt, 1024, t % 24, t / 24, e, smem);
  const int nq = (528 - nfull) * 4;
  const int bid = rbid();
  for (int u = bid; u < nq; u += G) {
    const int t = nfull + (u >> 2), sub = u & 3;
    gemm_tile<EPI_SWIGLU, 4, 2, 2, 4, 2>(p.xn, Wt, 1024, (t % 24) * 2 + (sub >> 1), (t / 24) * 2 + (sub & 1), e, smem);
  }
  const int tail = nq < G ? nq : G;
  if (l < 3 && bid >= tail) {
    const int vb = rtid() >> 8;
    char* vsm = smem + vb * LDS_HALF;
    const int nfree = (G - tail) * 2;
    const int vrank = (bid - tail) * 2 + vb;
    const int cnt = conv_layer_count(l + 1);
    const int half = cnt >> 1;
    const int lo = which ? half : 0, hi = which ? cnt : half;
    for (int c = lo + vrank; c < hi; c += nfree) conv_layer_task(p, l + 1, c, (float*)vsm);
    for (int c = vrank; c < 72; c += nfree) mod_task(p, (l + 1) * 144 + which * 72 + c, (float*)vsm);
  }
}

__device__ __forceinline__ void rope_store_kb(PRM p, float val, int lane, int t, bool sample, int krow) {
  float outv = val;
  if (sample) {
    float partner = shx(val, 8);
    int w = lane & 15, fi = w & 7;
    float pos = (float)((lane & 16) ? (t & 63) : (t >> 6));
    float fr = __expf(-9.210340372f * (float)fi * 0.125f);
    float s, c; sincos_r(pos * fr, s, c);
    outv = (w < 8) ? val * c - partner * s : val * c + partner * s;
  }
  if (lane < 32) {
    u16 b = f2bf(outv);
#pragma unroll
    for (int h = 0; h < 8; ++h) p.kb[(size_t)krow * 768 + h * 96 + 64 + lane] = b;
  }
}

__device__ __forceinline__ void post_even(PRM p, int e) {
  const int tid = get_tid(), lane = tid & 63, wave = tid >> 6;
  const int NT = NTOK / 4;
  const int NC = 256;
  for (int task = get_bid(); task < NT + NC; task += vgrid()) {
    if (task < NT) {
      const int m0 = task * 4, m = m0 + wave;
      const bool pr = m < NPR;
      const int b = pr ? (m >> 8) : ((m - NPR) >> 10);
      const int t = pr ? (m & 255) : ((m - NPR) & 1023);
      const float* row = p.proj + (size_t)m * 2688;
      {
        float4 a0 = *(const float4*)(row + lane * 8), a1 = *(const float4*)(row + lane * 8 + 4);
        uint4 o; o.x = pack2(a0.x, a0.y); o.y = pack2(a0.z, a0.w); o.z = pack2(a1.x, a1.y); o.w = pack2(a1.z, a1.w);
        *(uint4*)(p.qa + (size_t)m * 512 + lane * 8) = o;
        float4 k0 = *(const float4*)(row + 512 + lane * 8), k1 = *(const float4*)(row + 512 + lane * 8 + 4);
        o.x = pack2(k0.x, k0.y); o.y = pack2(k0.z, k0.w); o.z = pack2(k1.x, k1.y); o.w = pack2(k1.z, k1.w);
        *(uint4*)(p.ka + (size_t)m * 512 + lane * 8) = o;
        if (pr) {
          float* ok = p.out + O_AK + ((size_t)(b * 2 + e) * 256 + t) * 512 + lane * 8;
          *(float4*)ok = k0; *(float4*)(ok + 4) = k1;
          float4 v0 = *(const float4*)(row + 1024 + lane * 8), v1 = *(const float4*)(row + 1024 + lane * 8 + 4);
          float* ov = p.out + O_AV + ((size_t)(b * 2 + e) * 256 + t) * 512 + lane * 8;
          *(float4*)ov = v0; *(float4*)(ov + 4) = v1;
        }
      }
      {
        float4 c0 = *(const float4*)(row + 1536 + lane * 12), c1 = *(const float4*)(row + 1536 + lane * 12 + 4), c2 = *(const float4*)(row + 1536 + lane * 12 + 8);
        float ss = c0.x * c0.x + c0.y * c0.y + c0.z * c0.z + c0.w * c0.w + c1.x * c1.x + c1.y * c1.y + c1.z * c1.z + c1.w * c1.w +
                   c2.x * c2.x + c2.y * c2.y + c2.z * c2.z + c2.w * c2.w;
        ss = wsum(ss);
        float r = rsqrtf(ss * (1.f / 768.f) + EPS);
        const float* g = p.b_q_norm + e * 768 + lane * 12;
        float4 g0 = *(const float4*)g, g1 = *(const float4*)(g + 4), g2 = *(const float4*)(g + 8);
        uint2 o0, o1, o2;
        o0.x = pack2(c0.x * r * g0.x, c0.y * r * g0.y); o0.y = pack2(c0.z * r * g0.z, c0.w * r * g0.w);
        o1.x = pack2(c1.x * r * g1.x, c1.y * r * g1.y); o1.y = pack2(c1.z * r * g1.z, c1.w * r * g1.w);
        o2.x = pack2(c2.x * r * g2.x, c2.y * r * g2.y); o2.y = pack2(c2.z * r * g2.z, c2.w * r * g2.w);
        u16* d = p.cqn + (size_t)m * 768 + lane * 12;
        *(uint2*)d = o0; *(uint2*)(d + 4) = o1; *(uint2*)(d + 8) = o2;
      }
      {
        float4 c0 = *(const float4*)(row + 2304 + lane * 4);
        float ss = wsum(c0.x * c0.x + c0.y * c0.y + c0.z * c0.z + c0.w * c0.w);
        float r = rsqrtf(ss * (1.f / 256.f) + EPS);
        float4 g0 = *(const float4*)(p.b_kv_norm + e * 256 + lane * 4);
        float4 y; y.x = c0.x * r * g0.x; y.y = c0.y * r * g0.y; y.z = c0.z * r * g0.z; y.w = c0.w * r * g0.w;
        uint2 o; o.x = pack2(y.x, y.y); o.y = pack2(y.z, y.w);
        *(uint2*)(p.ckvn + (size_t)m * 256 + lane * 4) = o;
        if (pr) *(float4*)(p.out + O_CKV + ((size_t)(b * 2 + e) * 256 + t) * 256 + lane * 4) = y;
      }
      {
        float val = row[2560 + (lane & 31)];
        if (pr && lane < 32) p.out[O_KR + ((size_t)(b * 2 + e) * 256 + t) * 32 + lane] = val;
        rope_store_kb(p, val, lane, t, !pr, keyrow(m));
      }
      {
        const bool pr0 = m0 < NPR;
        const int b0 = pr0 ? (m0 >> 8) : ((m0 - NPR) >> 10);
        const int t0 = pr0 ? (m0 & 255) : ((m0 - NPR) & 1023);
#pragma unroll
        for (int i = 0; i < 2; ++i) {
          int pp = tid + 256 * i, h = pp >> 6, d = pp & 63;
          const float* src = p.proj + (size_t)m0 * 2688 + 1024 + h * 64 + d;
          float v0 = src[0], v1 = src[2688], v2 = src[2 * 2688], v3 = src[3 * 2688];
          uint2 o; o.x = pack2(v0, v1); o.y = pack2(v2, v3);
          u16* dst = pr0 ? p.vta_p + (size_t)((b0 * 8 + h) * 64 + d) * 256 + t0 : p.vta_s + (size_t)((b0 * 8 + h) * 64 + d) * 1536 + t0;
          *(uint2*)dst = o;
        }
      }
    } else {
      const int ct = task - NT;
      const int b = ct >> 7, key0 = (ct & 127) * 4;
      {
        const float* src = p.cache_a_k + ((size_t)(b * 2 + e) * 512 + key0) * 512;
        u16* dst = p.kactx + ((size_t)b * 512 + key0) * 512;
#pragma unroll
        for (int i = 0; i < 2; ++i) {
          int idx = (tid + 256 * i) * 4;
          float4 v = *(const float4*)(src + idx);
          uint2 o; o.x = pack2(v.x, v.y); o.y = pack2(v.z, v.w);
          *(uint2*)(dst + idx) = o;
        }
      }
      {
        const float* src = p.cache_a_v + ((size_t)(b * 2 + e) * 512 + key0) * 512;
#pragma unroll
        for (int i = 0; i < 2; ++i) {
          int pp = tid + 256 * i, h = pp >> 6, d = pp & 63;
          float v0 = src[pp], v1 = src[512 + pp], v2 = src[1024 + pp], v3 = src[1536 + pp];
          uint2 o; o.x = pack2(v0, v1); o.y = pack2(v2, v3);
          *(uint2*)(p.vta_s + (size_t)((b * 8 + h) * 64 + d) * 1536 + 1024 + key0) = o;
        }
      }
      {
        const float* src = p.cache_b_ckv + ((size_t)(b * 2 + e) * 512 + key0) * 256;
        float4 v = *(const float4*)(src + tid * 4);
        uint2 o; o.x = pack2(v.x, v.y); o.y = pack2(v.z, v.w);
        *(uint2*)(p.cctxn + ((size_t)b * 512 + key0) * 256 + tid * 4) = o;
      }
      {
        const float* src = p.cache_b_krope + ((size_t)(b * 2 + e) * 512 + key0) * 32;
#pragma unroll
        for (int i = 0; i < 4; ++i) {
          int idx = tid + 256 * i;
          int kk = idx >> 8, h = (idx >> 5) & 7, dd = idx & 31;
          p.kb[(size_t)(NPR + b * 1536 + 1024 + key0 + kk) * 768 + h * 96 + 64 + dd] = f2bf(src[kk * 32 + dd]);
        }
      }
    }
  }
}

__device__ __forceinline__ void post_odd(PRM p, int o) {
  const int tid = get_tid(), lane = tid & 63, wave = tid >> 6;
  const int NT = NTOK / 4, NC = 256;
  for (int task = get_bid(); task < NT + NC; task += vgrid()) {
    if (task < NT) {
      const int m0 = task * 4, m = m0 + wave;
      const bool pr = m < NPR;
      const int b = pr ? (m >> 8) : ((m - NPR) >> 10);
      const int t = pr ? (m & 255) : ((m - NPR) & 1023);
      const float* row = p.proj + (size_t)m * 2432;
      float rs = 0.f, rc = 1.f;
      if (!pr) {
        int w = lane & 31, fi = w & 15;
        float pos = (float)((lane & 32) ? (t & 63) : (t >> 6));
        float fr = __expf(-9.210340372f * (float)fi * (1.f / 16.f));
        sincos_r(pos * fr, rs, rc);
      }
      const bool lo = (lane & 16) == 0;
      const float gq = p.d_q_norm[o * 64 + lane], gk = p.d_k_norm[o * 64 + lane];
#pragma unroll
      for (int hd = 0; hd < 8; ++hd) {
        float v = row[1552 + hd * 64 + lane];
        float ss = wsum(v * v);
        float y = v * rsqrtf(ss * (1.f / 64.f) + EPS) * gq;
        if (!pr) { float pt = shx(y, 16); y = lo ? y * rc - pt * rs : y * rc + pt * rs; }
        p.qa[(size_t)m * 512 + hd * 64 + lane] = f2bf(y);
      }
#pragma unroll
      for (int kh = 0; kh < 2; ++kh) {
        float v = row[2064 + kh * 64 + lane];
        float ss = wsum(v * v);
        float y = v * rsqrtf(ss * (1.f / 64.f) + EPS) * gk;
        if (pr) p.out[O_DK + ((size_t)(b * 2 + o) * 256 + t) * 128 + kh * 64 + lane] = y;
        else { float pt = shx(y, 16); y = lo ? y * rc - pt * rs : y * rc + pt * rs; }
        p.kd[(size_t)keyrow(m) * 128 + kh * 64 + lane] = f2bf(y);
        if (pr) p.out[O_DV + ((size_t)(b * 2 + o) * 256 + t) * 128 + kh * 64 + lane] = row[2192 + kh * 64 + lane];
      }
      if (tid < 128) {
        const bool pr0 = m0 < NPR;
        const int b0 = pr0 ? (m0 >> 8) : ((m0 - NPR) >> 10);
        const int t0 = pr0 ? (m0 & 255) : ((m0 - NPR) & 1023);
        int kh = tid >> 6, d = tid & 63;
        const float* src = p.proj + (size_t)m0 * 2432 + 2192 + tid;
        float v0 = src[0], v1 = src[2432], v2 = src[2 * 2432], v3 = src[3 * 2432];
        uint2 oo; oo.x = pack2(v0, v1); oo.y = pack2(v2, v3);
        u16* dst = pr0 ? p.vtd_p + (size_t)((b0 * 2 + kh) * 64 + d) * 256 + t0 : p.vtd_s + (size_t)((b0 * 2 + kh) * 64 + d) * 1536 + t0;
        *(uint2*)dst = oo;
      }
    } else {
      const int ct = task - NT;
      const int b = ct >> 7, key0 = (ct & 127) * 4;
      {
        const float* src = p.cache_d_k + ((size_t)(b * 2 + o) * 512 + key0) * 128;
        if (tid < 128) {
          float4 v = *(const float4*)(src + tid * 4);
          uint2 oo; oo.x = pack2(v.x, v.y); oo.y = pack2(v.z, v.w);
          *(uint2*)(p.kd + (size_t)(NPR + b * 1536 + 1024 + key0) * 128 + tid * 4) = oo;
        } else {
          int pp = tid - 128, kh = pp >> 6, d = pp & 63;
          const float* sv = p.cache_d_v + ((size_t)(b * 2 + o) * 512 + key0) * 128;
          float v0 = sv[pp], v1 = sv[128 + pp], v2 = sv[256 + pp], v3 = sv[384 + pp];
          uint2 oo; oo.x = pack2(v0, v1); oo.y = pack2(v2, v3);
          *(uint2*)(p.vtd_s + (size_t)((b * 2 + kh) * 64 + d) * 1536 + 1024 + key0) = oo;
        }
      }
    }
  }
}

struct AttnSt { float m, l; f32x4 o[4]; };
template <int KS> struct KVf { bf16x8 k0[KS], k1[KS]; s16x4 v0[4], v1[4]; };

template <int KS>
__device__ __forceinline__ void attn_load(KVf<KS>& f, const u16* __restrict__ Kb, int kstride, const u16* __restrict__ Vtb, int vtstride, int l15, int q4) {
  const u16* k0p = Kb + (size_t)l15 * kstride + q4 * 8;
  const u16* k1p = k0p + (size_t)16 * kstride;
#pragma unroll
  for (int ks = 0; ks < KS; ++ks) { f.k0[ks] = *(const bf16x8*)(k0p + ks * 32); f.k1[ks] = *(const bf16x8*)(k1p + ks * 32); }
#pragma unroll
  for (int dt = 0; dt < 4; ++dt) {
    const u16* vp = Vtb + (size_t)(dt * 16 + l15) * vtstride + q4 * 4;
    f.v0[dt] = *(const s16x4*)vp; f.v1[dt] = *(const s16x4*)(vp + 16);
  }
}

template <int KS>
__device__ __forceinline__ void attn_comp(AttnSt& st, const bf16x8 (&qf)[KS], const KVf<KS>& f, float scale, int q4,
                                          bool masked, const float* rpbrow, int qc, int kc0) {
  f32x4 s0 = {0.f, 0.f, 0.f, 0.f}, s1 = {0.f, 0.f, 0.f, 0.f};
#pragma unroll
  for (int ks = 0; ks < KS; ++ks) { s0 = mfma16(f.k0[ks], qf[ks], s0); s1 = mfma16(f.k1[ks], qf[ks], s1); }
  float sv[8];
#pragma unroll
  for (int j = 0; j < 4; ++j) { sv[j] = s0[j] * scale; sv[4 + j] = s1[j] * scale; }
  if (masked) {
    const int cs = min(max(qc - 8, 0), 48);
#pragma unroll
    for (int e = 0; e < 8; ++e) {
      int kc = kc0 + (e >> 2) * 16 + q4 * 4 + (e & 3);
      bool ok = (kc >= cs) && (kc < cs + 16);
      int di = min(max(kc - qc, -15), 15) + 15;
      sv[e] = ok ? sv[e] + rpbrow[di] : -INFINITY;
    }
  }
  float mx = sv[0];
#pragma unroll
  for (int e = 1; e < 8; ++e) mx = fmaxf(mx, sv[e]);
  mx = fmaxf(mx, shx(mx, 16));
  mx = fmaxf(mx, shx(mx, 32));
  const float mnew = fmaxf(st.m, mx);
  const float alpha = __expf(st.m - mnew);
  float pe[8], ls = 0.f;
#pragma unroll
  for (int e = 0; e < 8; ++e) { pe[e] = __expf(sv[e] - mnew); ls += pe[e]; }
  st.l = st.l * alpha + ls;
  st.m = mnew;
  bf16x8 pf;
#pragma unroll
  for (int e = 0; e < 8; ++e) pf[e] = (short)f2bf(pe[e]);
#pragma unroll
  for (int dt = 0; dt < 4; ++dt) {
    bf16x8 vf = (bf16x8){f.v0[dt].x, f.v0[dt].y, f.v0[dt].z, f.v0[dt].w, f.v1[dt].x, f.v1[dt].y, f.v1[dt].z, f.v1[dt].w};
    st.o[dt] *= alpha;
    st.o[dt] = mfma16(vf, pf, st.o[dt]);
  }
}

__device__ __forceinline__ void attn_init(AttnSt& st) {
  st.m = -1e30f; st.l = 0.f;
#pragma unroll
  for (int dt = 0; dt < 4; ++dt) st.o[dt] = (f32x4){0.f, 0.f, 0.f, 0.f};
}
__device__ __forceinline__ void attn_fin(AttnSt& st, u16* outp  , int l15, int q4) {
  float lt = st.l;
  lt += shx(lt, 16);
  lt += shx(lt, 32);
  const float inv = 1.f / lt;
#pragma unroll
  for (int dt = 0; dt < 4; ++dt) {
    uint2 o; o.x = pack2(st.o[dt][0] * inv, st.o[dt][1] * inv); o.y = pack2(st.o[dt][2] * inv, st.o[dt][3] * inv);
    *(uint2*)(outp + (size_t)l15 * 1024 + dt * 16 + q4 * 4) = o;
  }
}

#define AT_VSTR 72
template <int KS> struct ATile { static constexpr int KSTR = KS * 32 + 8; static constexpr int BUF = 64 * (KS * 32 + 8) + 64 * AT_VSTR; };
template <int KS> struct AStage { u32x4 k[KS]; u32x4 v[2]; };

template <int KS>
__device__ __forceinline__ void at_load(AStage<KS>& r, const u16* __restrict__ Kg, int kstride, const u16* __restrict__ Vg, int vtstride, int tid) {
#pragma unroll
  for (int i = 0; i < KS; ++i) {
    int c = tid + 256 * i; int row = c / (KS * 4), ch = c - row * (KS * 4);
    r.k[i] = *(const u32x4*)(Kg + (unsigned)(row * kstride + ch * 8));
  }
#pragma unroll
  for (int i = 0; i < 2; ++i) {
    int c = tid + 256 * i; int row = c >> 3, ch = c & 7;
    r.v[i] = *(const u32x4*)(Vg + (unsigned)(row * vtstride + ch * 8));
  }
}
template <int KS>
__device__ __forceinline__ void at_store(const AStage<KS>& r, u16* buf, int tid) {
  u16* Ks = buf; u16* Vs = buf + 64 * ATile<KS>::KSTR;
#pragma unroll
  for (int i = 0; i < KS; ++i) {
    int c = tid + 256 * i; int row = c / (KS * 4), ch = c - row * (KS * 4);
    *(u32x4*)(Ks + row * ATile<KS>::KSTR + ch * 8) = r.k[i];
  }
#pragma unroll
  for (int i = 0; i < 2; ++i) {
    int c = tid + 256 * i; int row = c >> 3, ch = c & 7;
    *(u32x4*)(Vs + row * AT_VSTR + ch * 8) = r.v[i];
  }
}

template <int KS>
__device__ __forceinline__ void at_comp(AttnSt& st, const bf16x8 (&qf)[KS], const u16* buf, float scale, int l15, int q4,
                                        bool masked, const float* rpbrow, int qc) {
  const u16* Ks = buf; const u16* Vs = buf + 64 * ATile<KS>::KSTR;
  f32x4 s[4];
#pragma unroll
  for (int kt = 0; kt < 4; ++kt) {
    s[kt] = (f32x4){0.f, 0.f, 0.f, 0.f};
#pragma unroll
    for (int ks = 0; ks < KS; ++ks) {
      bf16x8 a = *(const bf16x8*)(Ks + (kt * 16 + l15) * ATile<KS>::KSTR + ks * 32 + q4 * 8);
      s[kt] = mfma16(a, qf[ks], s[kt]);
    }
  }
  float sv[16];
  const float sc2 = scale * 1.4426950408889634f;
#pragma unroll
  for (int kt = 0; kt < 4; ++kt)
#pragma unroll
    for (int j = 0; j < 4; ++j) sv[kt * 4 + j] = s[kt][j] * sc2;
  if (masked) {
    const int cs = min(max(qc - 8, 0), 48);
#pragma unroll
    for (int e = 0; e < 16; ++e) {
      int kc = (e >> 2) * 16 + q4 * 4 + (e & 3);
      bool ok = (kc >= cs) && (kc < cs + 16);
      int di = min(max(kc - qc, -15), 15) + 15;
      sv[e] = ok ? sv[e] + rpbrow[di] : -INFINITY;
    }
  }
  float mx = sv[0];
#pragma unroll
  for (int e = 1; e < 16; ++e) mx = fmaxf(mx, sv[e]);
  mx = fmaxf(mx, shx(mx, 16));
  mx = fmaxf(mx, shx(mx, 32));
  const float mnew = fmaxf(st.m, mx);
  const float alpha = __builtin_amdgcn_exp2f(st.m - mnew);
  float ls = 0.f;
#pragma unroll
  for (int e = 0; e < 16; ++e) { sv[e] = __builtin_amdgcn_exp2f(sv[e] - mnew); ls += sv[e]; }
  st.l = st.l * alpha + ls;
  st.m = mnew;
  bf16x8 pf[2];
#pragma unroll
  for (int hf = 0; hf < 2; ++hf) {
    u32x4 pw;
    pw[0] = pack2(sv[hf * 8 + 0], sv[hf * 8 + 1]); pw[1] = pack2(sv[hf * 8 + 2], sv[hf * 8 + 3]);
    pw[2] = pack2(sv[hf * 8 + 4], sv[hf * 8 + 5]); pw[3] = pack2(sv[hf * 8 + 6], sv[hf * 8 + 7]);
    pf[hf] = __builtin_bit_cast(bf16x8, pw);
  }
#pragma unroll
  for (int dt = 0; dt < 4; ++dt) {
    st.o[dt] *= alpha;
#pragma unroll
    for (int hf = 0; hf < 2; ++hf) {
      const u16* vp = Vs + (dt * 16 + l15) * AT_VSTR + hf * 32 + q4 * 4;
      s16x4 v0 = *(const s16x4*)vp;
      s16x4 v1 = *(const s16x4*)(vp + 16);
      bf16x8 vf = (bf16x8){v0.x, v0.y, v0.z, v0.w, v1.x, v1.y, v1.z, v1.w};
      st.o[dt] = mfma16(vf, pf[hf], st.o[dt]);
    }
  }
}

template <int KS>
__device__ __forceinline__ void at_run_plain(AttnSt& st, const bf16x8 (&qf)[KS], const u16* Kbase, int kstride, const u16* Vbase, int vtstride,
                                             int nt, float scale, u16* lds, int tid, int l15, int q4) {
  AStage<KS> r0, r1;
  at_load<KS>(r0, Kbase, kstride, Vbase, vtstride, tid);
  if (nt > 1) at_load<KS>(r1, Kbase + (size_t)64 * kstride, kstride, Vbase + 64, vtstride, tid);
  at_store<KS>(r0, lds, tid);
  __syncthreads();
  for (int t = 0; t < nt; t += 2) {
    if (t + 2 < nt) at_load<KS>(r0, Kbase + (size_t)(t + 2) * 64 * kstride, kstride, Vbase + (t + 2) * 64, vtstride, tid);
    at_comp<KS>(st, qf, lds, scale, l15, q4, false, nullptr, 0);
    if (t + 1 < nt) at_store<KS>(r1, lds + ATile<KS>::BUF, tid);
    __syncthreads();
    if (t + 1 >= nt) break;
    if (t + 3 < nt) at_load<KS>(r1, Kbase + (size_t)(t + 3) * 64 * kstride, kstride, Vbase + (t + 3) * 64, vtstride, tid);
    at_comp<KS>(st, qf, lds + ATile<KS>::BUF, scale, l15, q4, false, nullptr, 0);
    if (t + 2 < nt) at_store<KS>(r0, lds, tid);
    __syncthreads();
  }
}

__device__ __forceinline__ void load_q64(bf16x8 (&qf)[2], const u16* Q, int qstride, int l15, int q4) {
#pragma unroll
  for (int ks = 0; ks < 2; ++ks) qf[ks] = *(const bf16x8*)(Q + (size_t)l15 * qstride + ks * 32 + q4 * 8);
}
__device__ __forceinline__ void load_q_mla(bf16x8 (&qf)[3], const float* Qf, int l15, int q4, bool sample, int t0) {
  const float* qr = Qf + (size_t)l15 * 768 + q4 * 8;
#pragma unroll
  for (int ks = 0; ks < 3; ++ks) {
    float4 a = *(const float4*)(qr + ks * 32), b = *(const float4*)(qr + ks * 32 + 4);
    float v[8] = {a.x, a.y, a.z, a.w, b.x, b.y, b.z, b.w};
    if (ks == 2 && sample) {
      const int t = t0 + l15;
      const float pos = (float)((q4 & 2) ? (t & 63) : (t >> 6));
#pragma unroll
      for (int jj = 0; jj < 8; ++jj) {
        float pt = shx(v[jj], 16);
        float fr = __expf(-9.210340372f * (float)jj * 0.125f);
        float sn, cs; sincos_r(pos * fr, sn, cs);
        v[jj] = (q4 & 1) ? v[jj] * cs + pt * sn : v[jj] * cs - pt * sn;
      }
    }
#pragma unroll
    for (int jj = 0; jj < 8; ++jj) qf[ks][jj] = (short)f2bf(v[jj]);
  }
}

__device__ __forceinline__ void attn_even_phase(PRM p, int e, char* smem) {
  u16* lds = (u16*)smem;
  const int tid = get_tid(), lane = tid & 63, wave = tid >> 6, l15 = lane & 15, q4 = lane >> 4;
  const float scaleB = 0.10206207261596577f;
  for (int bt = get_bid(); bt < 1536; bt += vgrid()) {
    AttnSt st; attn_init(st);
    if (bt < 256) {
      int qb = bt & 15, h = (bt >> 4) & 7, b = bt >> 7;
      int mq = NPR + b * 1024 + qb * 64 + wave * 16;
      bf16x8 qf[3]; load_q_mla(qf, p.qb + (size_t)mq * 768 + h * 96, l15, q4, true, qb * 64 + wave * 16);
      at_run_plain<3>(st, qf, p.kb + (size_t)(NPR + b * 1536) * 768 + h * 96, 768, p.vtb_s + (size_t)((b * 8 + h) * 64) * 1536, 1536, 24, scaleB, lds, tid, l15, q4);
      attn_fin(st, p.mix + (size_t)mq * 1024 + 512 + h * 64, l15, q4);
    } else if (bt < 512) {
      int u = bt - 256;
      int r = u & 15, h = (u >> 4) & 7, b = u >> 7;
      int mq = NPR + b * 1024 + r * 64 + wave * 16;
      bf16x8 qf[2]; load_q64(qf, p.qa + (size_t)mq * 512 + h * 64, 512, l15, q4);
      const u16* Vt = p.vta_s + (size_t)((b * 8 + h) * 64) * 1536;
      const u16* Kc = p.kactx + (size_t)b * 512 * 512 + h * 64;
      const int rs = min(max(r - 4, 0), 8);
      const u16* Kw = p.ka + (size_t)(NPR + b * 1024 + rs * 64) * 512 + h * 64;
      const float* rpb0 = p.a_rpb + ((size_t)(e * 8 + h) * 15 + (rs - r + 7)) * 31;
      const int qc = wave * 16 + l15;
      float* rpl = (float*)(lds + 2 * ATile<2>::BUF);
      if (tid < 248) { int rr = tid / 31, cc = tid - rr * 31; rpl[rr * 32 + cc] = rpb0[rr * 31 + cc] * 1.4426950408889634f; }
      AStage<2> r0, r1;
#define NB_LOAD(R, T) { if ((T) < 8) at_load<2>(R, Kc + (size_t)(T) * 64 * 512, 512, Vt + 1024 + (T) * 64, 1536, tid); \
                        else at_load<2>(R, Kw + (size_t)((T) - 8) * 64 * 512, 512, Vt + (rs + (T) - 8) * 64, 1536, tid); }
#define NB_COMP(BUFP, T) { if ((T) < 8) at_comp<2>(st, qf, BUFP, 0.125f, l15, q4, false, nullptr, 0); \
                           else at_comp<2>(st, qf, BUFP, 0.125f, l15, q4, true, rpl + ((T) - 8) * 32, qc); }
      NB_LOAD(r0, 0);
      NB_LOAD(r1, 1);
      at_store<2>(r0, lds, tid);
      __syncthreads();
      for (int t = 0; t < 16; t += 2) {
        if (t + 2 < 16) NB_LOAD(r0, t + 2);
        NB_COMP(lds, t);
        at_store<2>(r1, lds + ATile<2>::BUF, tid);
        __syncthreads();
        if (t + 3 < 16) NB_LOAD(r1, t + 3);
        NB_COMP(lds + ATile<2>::BUF, t + 1);
        if (t + 2 < 16) at_store<2>(r0, lds, tid);
        __syncthreads();
      }
#undef NB_LOAD
#undef NB_COMP
      attn_fin(st, p.mix + (size_t)mq * 1024 + h * 64, l15, q4);
    } else if (bt < 1024) {
      int u = bt - 512;
      int qb = u & 3, h = (u >> 2) & 7, b = u >> 5;
      int mq = b * 256 + qb * 64 + wave * 16;
      bf16x8 qf[3]; load_q_mla(qf, p.qb + (size_t)mq * 768 + h * 96, l15, q4, false, 0);
      at_run_plain<3>(st, qf, p.kb + (size_t)(b * 256) * 768 + h * 96, 768, p.vtb_p + (size_t)((b * 8 + h) * 64) * 256, 256, 4, scaleB, lds, tid, l15, q4);
      attn_fin(st, p.mix + (size_t)mq * 1024 + 512 + h * 64, l15, q4);
    } else {
      int u = bt - 1024;
      int qb = u & 3, h = (u >> 2) & 7, b = u >> 5;
      int mq = b * 256 + qb * 64 + wave * 16;
      bf16x8 qf[2]; load_q64(qf, p.qa + (size_t)mq * 512 + h * 64, 512, l15, q4);
      at_run_plain<2>(st, qf, p.ka + (size_t)(b * 256) * 512 + h * 64, 512, p.vta_p + (size_t)((b * 8 + h) * 64) * 256, 256, 4, 0.125f, lds, tid, l15, q4);
      attn_fin(st, p.mix + (size_t)mq * 1024 + h * 64, l15, q4);
    }
  }
}

__device__ __forceinline__ int mslot(int sq, int h, int dir, int j) {
  return sq < 16 ? ((sq * 4 + h) * 2 + dir) * 4 + j : 512 + (((sq - 16) * 4 + h) * 2 + dir) * 16 + j;
}

__device__ __forceinline__ void mlstm1_task(PRM p, int o, int task, float* sm) {
  const int tid = get_tid(), lane = tid & 63, wave = tid >> 6;
  int sq, h, dir, j;
  if (task < 512) { j = task & 3; dir = (task >> 2) & 1; h = (task >> 3) & 3; sq = task >> 5; }
  else { int u = task - 512; j = u & 15; dir = (u >> 4) & 1; h = (u >> 5) & 3; sq = 16 + (u >> 7); }
  const int T = sq < 16 ? 256 : 1024;
  const int base = sq < 16 ? sq * 256 : NPR + (sq - 16) * 1024;
  const int slot = task;
  float* ks = sm;
  float* vs = sm + 4096;
  float* wg = sm + 4096 + 8192;
  if (wave == 0) {
    int s = 64 * j + lane;
    int t = dir ? T - 1 - s : s;
    const float* row = p.proj + (size_t)(base + t) * 2432 + 1536;
    float ig = row[(dir * 2 + 0) * 4 + h] + p.c_gate_bias[o * 16 + (dir * 2 + 0) * 4 + h];
    float fg = row[(dir * 2 + 1) * 4 + h] + p.c_gate_bias[o * 16 + (dir * 2 + 1) * 4 + h];
    float bsum = logsig_f(fg);
#pragma unroll
    for (int off = 1; off < 64; off <<= 1) { float v = __shfl_up(bsum, off); if (lane >= off) bsum += v; }
    float blast = __shfl(bsum, 63);
    float g = blast - bsum + ig;
    float ml = wmaxr(g);
    wg[lane] = __expf(g - ml);
    if (lane == 0) { p.dm[slot * 2] = ml; p.dm[slot * 2 + 1] = blast; }
  }
#pragma unroll
  for (int ii = 0; ii < 4; ++ii) {
    int i = (tid >> 4) + 16 * ii, c4 = tid & 15;
    int s = 64 * j + i; int t = dir ? T - 1 - s : s;
    float4 v = *(const float4*)(p.proj + (size_t)(base + t) * 2432 + 256 + h * 64 + c4 * 4);
    v.x *= 0.125f; v.y *= 0.125f; v.z *= 0.125f; v.w *= 0.125f;
    *(float4*)(ks + i * 64 + c4 * 4) = v;
  }
#pragma unroll
  for (int ii = 0; ii < 8; ++ii) {
    int i = (tid >> 5) + 8 * ii, c4 = tid & 31;
    int s = 64 * j + i; int t = dir ? T - 1 - s : s;
    *(float4*)(vs + i * 128 + c4 * 4) = *(const float4*)(p.proj + (size_t)(base + t) * 2432 + 512 + h * 128 + c4 * 4);
  }
  __syncthreads();
  const int dg = tid & 15, vg8 = tid >> 4;
  f32x4 acc[8];
#pragma unroll
  for (int q = 0; q < 8; ++q) acc[q] = (f32x4){0.f, 0.f, 0.f, 0.f};
  f32x4 nacc = {0.f, 0.f, 0.f, 0.f};
#pragma unroll 4
  for (int i = 0; i < 64; ++i) {
    f32x4 kd = *(const f32x4*)(ks + i * 64 + dg * 4) * wg[i];
    nacc += kd;
    f32x4 va = *(const f32x4*)(vs + i * 128 + vg8 * 8);
    f32x4 vb = *(const f32x4*)(vs + i * 128 + vg8 * 8 + 4);
    acc[0] += kd * va[0]; acc[1] += kd * va[1]; acc[2] += kd * va[2]; acc[3] += kd * va[3];
    acc[4] += kd * vb[0]; acc[5] += kd * vb[1]; acc[6] += kd * vb[2]; acc[7] += kd * vb[3];
  }
  float* dc = p.dC + (size_t)slot * 8192;
#pragma unroll
  for (int q = 0; q < 8; ++q) *(f32x4*)(dc + (vg8 * 8 + q) * 64 + dg * 4) = acc[q];
  if (vg8 == 0) *(f32x4*)(p.dn + slot * 64 + dg * 4) = nacc;
  __syncthreads();
}

__device__ __forceinline__ void mlstm2_task(PRM p, int o, int task, float* sm) {
  const int tid = get_tid(), lane = tid & 63, wave = tid >> 6;
  int sq, h, c;
  if (task < 256) { c = task & 3; h = (task >> 2) & 3; sq = task >> 4; }
  else { int u = task - 256; c = u & 15; h = (u >> 4) & 3; sq = 16 + (u >> 6); }
  const bool pr = sq < 16;
  const int nc = pr ? 4 : 16;
  const int base = (pr ? sq * 256 : NPR + (sq - 16) * 1024) + c * 64;
  float* qT = sm;
  float* kT = sm + 4352;
  float* CT = kT;
  float* St = sm + 2 * 4352;
  float* vh = sm + 3 * 4352;
  float* smalls = sm + 4 * 4352;
  float* bl = smalls;
  float* itb = smalls + 64;
  float* mt = smalls + 128;
  float* w0 = smalls + 192;
  float* nv = smalls + 256;
  float* nq = smalls + 320;
  float* den = smalls + 384;
  float* scal = smalls + 448;

  const int tl = tid >> 4, tx = tid & 15;
  const int l0 = tl * 4, x0 = tx * 4;
  float hacc[2][4][4];
#pragma unroll
  for (int a = 0; a < 2; ++a)
#pragma unroll
    for (int b2 = 0; b2 < 4; ++b2)
#pragma unroll
      for (int c2 = 0; c2 < 4; ++c2) hacc[a][b2][c2] = 0.f;

  f32x4 qv[4], kv[4];
#pragma unroll
  for (int ii = 0; ii < 4; ++ii) {
    int i = (tid >> 4) + 16 * ii, c4 = tid & 15;
    const float* row = p.proj + (size_t)(base + i) * 2432 + h * 64 + c4 * 4;
    qv[ii] = *(const f32x4*)row;
    kv[ii] = *(const f32x4*)(row + 256);
  }
#pragma unroll
  for (int ii = 0; ii < 4; ++ii) {
    int i = (tid >> 4) + 16 * ii, c4 = tid & 15;
    qT[(c4 * 4 + 0) * 68 + i] = qv[ii].x; qT[(c4 * 4 + 1) * 68 + i] = qv[ii].y; qT[(c4 * 4 + 2) * 68 + i] = qv[ii].z; qT[(c4 * 4 + 3) * 68 + i] = qv[ii].w;
  }
#pragma unroll 1
  for (int dir = 0; dir < 2; ++dir) {
    const int j = dir ? nc - 1 - c : c;
    const int slj = mslot(sq, h, dir, j);
    const float mprev = p.mp[slj];
    float cr[16]; f32x4 vr[4];
    const float* cpp = p.cp + (size_t)slj * 8192;
#pragma unroll
    for (int r = 0; r < 16; ++r) cr[r] = cpp[tid + 256 * r];
#pragma unroll
    for (int ii = 0; ii < 4; ++ii) {
      int i = (tid >> 4) + 16 * ii, c4 = tid & 15;
      vr[ii] = *(const f32x4*)(p.proj + (size_t)(base + i) * 2432 + 512 + h * 128 + c4 * 4);
    }
    if (wave == 0) {
      const int i = lane;
      const int tau = dir ? 63 - i : i;
      const float* row = p.proj + (size_t)(base + tau) * 2432 + 1536;
      float ig = row[(dir * 2 + 0) * 4 + h] + p.c_gate_bias[o * 16 + (dir * 2 + 0) * 4 + h];
      float fg = row[(dir * 2 + 1) * 4 + h] + p.c_gate_bias[o * 16 + (dir * 2 + 1) * 4 + h];
      float bsum = logsig_f(fg);
#pragma unroll
      for (int off = 1; off < 64; off <<= 1) { float v = __shfl_up(bsum, off); if (lane >= off) bsum += v; }
      float ib = ig - bsum;
      float pm = ib;
#pragma unroll
      for (int off = 1; off < 64; off <<= 1) { float v = __shfl_up(pm, off); if (lane >= off) pm = fmaxf(pm, v); }
      float mti = fmaxf(bsum + mprev, bsum + pm);
      bl[tau] = bsum; itb[tau] = ib; mt[tau] = mti; w0[tau] = __expf(bsum + mprev - mti);
    }
#pragma unroll
    for (int ii = 0; ii < 4; ++ii) {
      int i = (tid >> 4) + 16 * ii, c4 = tid & 15;
      kT[(c4 * 4 + 0) * 68 + i] = kv[ii].x * 0.125f; kT[(c4 * 4 + 1) * 68 + i] = kv[ii].y * 0.125f;
      kT[(c4 * 4 + 2) * 68 + i] = kv[ii].z * 0.125f; kT[(c4 * 4 + 3) * 68 + i] = kv[ii].w * 0.125f;
    }
    if (tid < 64) nv[tid] = p.np[slj * 64 + tid];
    __syncthreads();
    {
      float a[4][4];
#pragma unroll
      for (int r = 0; r < 4; ++r)
#pragma unroll
        for (int q = 0; q < 4; ++q) a[r][q] = 0.f;
#pragma unroll 2
      for (int d = 0; d < 64; ++d) {
        float4 q4v = *(const float4*)(qT + d * 68 + l0);
        float4 k4v = *(const float4*)(kT + d * 68 + x0);
        float qa[4] = {q4v.x, q4v.y, q4v.z, q4v.w}, kk[4] = {k4v.x, k4v.y, k4v.z, k4v.w};
#pragma unroll
        for (int r = 0; r < 4; ++r)
#pragma unroll
          for (int q = 0; q < 4; ++q) a[r][q] = fmaf(qa[r], kk[q], a[r][q]);
      }
      float rsum[4];
#pragma unroll
      for (int r = 0; r < 4; ++r) {
        const int l = l0 + r;
        const float bll = bl[l], mtl = mt[l];
        rsum[r] = 0.f;
#pragma unroll
        for (int q = 0; q < 4; ++q) {
          const int s = x0 + q;
          const bool ok = dir ? (s >= l) : (s <= l);
          float sv = ok ? a[r][q] * __expf(bll + itb[s] - mtl) : 0.f;
          St[s * 68 + l] = sv;
          rsum[r] += sv;
        }
        rsum[r] += shx(rsum[r], 1); rsum[r] += shx(rsum[r], 2);
        rsum[r] += shx(rsum[r], 4); rsum[r] += shx(rsum[r], 8);
        if (tx == 0) den[l] = rsum[r];
      }
    }
    __syncthreads();
    if (tid < 64) {
      float s = 0.f;
#pragma unroll 4
      for (int d = 0; d < 64; ++d) s = fmaf(qT[d * 68 + tid], nv[d], s);
      nq[tid] = s;
    }
#pragma unroll 1
    for (int vhalf = 0; vhalf < 2; ++vhalf) {
#pragma unroll
      for (int r = 0; r < 16; ++r) {
        int e = tid + 256 * r;
        CT[(e & 63) * 68 + (e >> 6)] = cr[r];
      }
#pragma unroll
      for (int ii = 0; ii < 4; ++ii) {
        int i = (tid >> 4) + 16 * ii, c4 = tid & 15;
        *(f32x4*)(vh + i * 68 + c4 * 4) = vr[ii];
      }
      if (vhalf == 0) {
#pragma unroll
        for (int r = 0; r < 16; ++r) cr[r] = cpp[4096 + tid + 256 * r];
#pragma unroll
        for (int ii = 0; ii < 4; ++ii) {
          int i = (tid >> 4) + 16 * ii, c4 = tid & 15;
          vr[ii] = *(const f32x4*)(p.proj + (size_t)(base + i) * 2432 + 512 + h * 128 + 64 + c4 * 4);
        }
      }
      __syncthreads();
      {
        float a1[4][4], a2[4][4];
#pragma unroll
        for (int r = 0; r < 4; ++r)
#pragma unroll
          for (int q = 0; q < 4; ++q) { a1[r][q] = 0.f; a2[r][q] = 0.f; }
#pragma unroll 2
        for (int s = 0; s < 64; ++s) {
          float4 sa = *(const float4*)(St + s * 68 + l0);
          float4 vb = *(const float4*)(vh + s * 68 + x0);
          float4 qa4 = *(const float4*)(qT + s * 68 + l0);
          float4 cb4 = *(const float4*)(CT + s * 68 + x0);
          float sl4[4] = {sa.x, sa.y, sa.z, sa.w}, vv[4] = {vb.x, vb.y, vb.z, vb.w};
          float qq[4] = {qa4.x, qa4.y, qa4.z, qa4.w}, cc[4] = {cb4.x, cb4.y, cb4.z, cb4.w};
#pragma unroll
          for (int r = 0; r < 4; ++r)
#pragma unroll
            for (int q = 0; q < 4; ++q) { a1[r][q] = fmaf(sl4[r], vv[q], a1[r][q]); a2[r][q] = fmaf(qq[r], cc[q], a2[r][q]); }
        }
#pragma unroll
        for (int r = 0; r < 4; ++r) {
          const int l = l0 + r;
          const float w = w0[l];
          const float dn_ = den[l] + w * nq[l];
          const float dd = fmaxf(fabsf(dn_), __expf(-mt[l]));
          const float inv = 1.f / dd;
#pragma unroll
          for (int q = 0; q < 4; ++q) { float hv = (a1[r][q] + w * a2[r][q]) * inv; if (vhalf == 0) hacc[0][r][q] += hv; else hacc[1][r][q] += hv; }
        }
      }
      __syncthreads();
    }
  }
#pragma unroll
  for (int r = 0; r < 4; ++r) {
    float ss = 0.f;
#pragma unroll
    for (int a = 0; a < 2; ++a)
#pragma unroll
      for (int q = 0; q < 4; ++q) ss += hacc[a][r][q] * hacc[a][r][q];
    ss += shx(ss, 1); ss += shx(ss, 2); ss += shx(ss, 4); ss += shx(ss, 8);
    const float rn = rsqrtf(ss * (1.f / 128.f) + EPS);
    const int m = base + l0 + r;
#pragma unroll
    for (int a = 0; a < 2; ++a) {
      const int v0 = a * 64 + x0;
      float4 co = *(const float4*)(p.proj + (size_t)m * 2432 + 1024 + h * 128 + v0);
      float4 gn = *(const float4*)(p.c_out_norm + (size_t)(o * 4 + h) * 128 + v0);
      float y0 = sigmoid_f(co.x) * hacc[a][r][0] * rn * gn.x;
      float y1 = sigmoid_f(co.y) * hacc[a][r][1] * rn * gn.y;
      float y2 = sigmoid_f(co.z) * hacc[a][r][2] * rn * gn.z;
      float y3 = sigmoid_f(co.w) * hacc[a][r][3] * rn * gn.w;
      uint2 oo; oo.x = pack2(y0, y1); oo.y = pack2(y2, y3);
      *(uint2*)(p.mix + (size_t)m * 1024 + h * 128 + v0) = oo;
    }
  }
  __syncthreads();
}

__device__ __forceinline__ void mlstm2_mfma(PRM p, int o, int task, char* smem) {
  const int tid = get_tid(), lane = tid & 63, wave = tid >> 6, l15 = lane & 15, q4 = lane >> 4;
  int sq, h, c;
  if (task < 256) { c = task & 3; h = (task >> 2) & 3; sq = task >> 4; }
  else { int u = task - 256; c = u & 15; h = (u >> 4) & 3; sq = 16 + (u >> 6); }
  const bool pr = sq < 16;
  const int nc = pr ? 4 : 16;
  const int base = (pr ? sq * 256 : NPR + (sq - 16) * 1024) + c * 64;
  u16* Qb = (u16*)smem;
  u16* Kb = Qb + 64 * 72;
  u16* Vt = Kb + 64 * 72;
  u16* Cb = Vt + 128 * 72;
  float* sml = (float*)(Cb + 128 * 72);
  float* bl = sml; float* itb = sml + 64; float* mt = sml + 128; float* w0 = sml + 192; float* nv = sml + 256;
#pragma unroll
  for (int ii = 0; ii < 4; ++ii) {
    int i = (tid >> 4) + 16 * ii, c4 = tid & 15;
    const float* row = p.proj + (size_t)(base + i) * 2432 + h * 64 + c4 * 4;
    f32x4 qv = *(const f32x4*)row;
    f32x4 kv = *(const f32x4*)(row + 256);
    uint2 a; a.x = pack2(qv[0], qv[1]); a.y = pack2(qv[2], qv[3]);
    uint2 b; b.x = pack2(kv[0] * 0.125f, kv[1] * 0.125f); b.y = pack2(kv[2] * 0.125f, kv[3] * 0.125f);
    *(uint2*)(Qb + i * 72 + c4 * 4) = a;
    *(uint2*)(Kb + i * 72 + c4 * 4) = b;
  }
#pragma unroll
  for (int ii = 0; ii < 8; ++ii) {
    int i = (tid >> 5) + 8 * ii, c4 = tid & 31;
    f32x4 vv = *(const f32x4*)(p.proj + (size_t)(base + i) * 2432 + 512 + h * 128 + c4 * 4);
    unsigned w01 = pack2(vv[0], vv[1]), w23 = pack2(vv[2], vv[3]);
    Vt[(c4 * 4 + 0) * 72 + i] = (u16)(w01 & 0xffffu); Vt[(c4 * 4 + 1) * 72 + i] = (u16)(w01 >> 16);
    Vt[(c4 * 4 + 2) * 72 + i] = (u16)(w23 & 0xffffu); Vt[(c4 * 4 + 3) * 72 + i] = (u16)(w23 >> 16);
  }
  f32x4 hacc[8];
#pragma unroll
  for (int vt = 0; vt < 8; ++vt) hacc[vt] = (f32x4){0.f, 0.f, 0.f, 0.f};
  const int lrow = wave * 16 + l15;
#pragma unroll 1
  for (int dir = 0; dir < 2; ++dir) {
    const int j = dir ? nc - 1 - c : c;
    const int slj = mslot(sq, h, dir, j);
    const float mprev = p.mp[slj];
    {
      const f32x4* cpp = (const f32x4*)(p.cp + (size_t)slj * 8192);
#pragma unroll
      for (int r = 0; r < 8; ++r) {
        int e4 = tid + 256 * r;
        f32x4 cv = cpp[e4];
        uint2 a; a.x = pack2(cv[0], cv[1]); a.y = pack2(cv[2], cv[3]);
        *(uint2*)(Cb + (e4 >> 4) * 72 + (e4 & 15) * 4) = a;
      }
    }
    if (tid < 64) nv[tid] = p.np[slj * 64 + tid];
    if (wave == 0) {
      const int i = lane;
      const int tau = dir ? 63 - i : i;
      const float* row = p.proj + (size_t)(base + tau) * 2432 + 1536;
      float ig = row[(dir * 2 + 0) * 4 + h] + p.c_gate_bias[o * 16 + (dir * 2 + 0) * 4 + h];
      float fg = row[(dir * 2 + 1) * 4 + h] + p.c_gate_bias[o * 16 + (dir * 2 + 1) * 4 + h];
      float bsum = logsig_f(fg);
#pragma unroll
      for (int off = 1; off < 64; off <<= 1) { float v = __shfl_up(bsum, off); if (lane >= off) bsum += v; }
      float ib = ig - bsum;
      float pm = ib;
#pragma unroll
      for (int off = 1; off < 64; off <<= 1) { float v = __shfl_up(pm, off); if (lane >= off) pm = fmaxf(pm, v); }
      float mti = fmaxf(bsum + mprev, bsum + pm);
      bl[tau] = bsum; itb[tau] = ib; mt[tau] = mti; w0[tau] = __expf(bsum + mprev - mti);
    }
    __syncthreads();
    const float bll = bl[lrow], mtl = mt[lrow], w0l = w0[lrow];
    bf16x8 qf[2];
#pragma unroll
    for (int ks = 0; ks < 2; ++ks) qf[ks] = *(const bf16x8*)(Qb + lrow * 72 + ks * 32 + q4 * 8);
    float nqp = 0.f;
#pragma unroll
    for (int ks = 0; ks < 2; ++ks)
#pragma unroll
      for (int jj = 0; jj < 8; ++jj) {
        float qe = __uint_as_float(((unsigned)(unsigned short)qf[ks][jj]) << 16);
        nqp = fmaf(qe, nv[ks * 32 + q4 * 8 + jj], nqp);
      }
    nqp += shx(nqp, 16); nqp += shx(nqp, 32);
    f32x4 oacc[8];
#pragma unroll
    for (int vt = 0; vt < 8; ++vt) {
      oacc[vt] = (f32x4){0.f, 0.f, 0.f, 0.f};
#pragma unroll
      for (int ks = 0; ks < 2; ++ks) {
        bf16x8 a = *(const bf16x8*)(Cb + (vt * 16 + l15) * 72 + ks * 32 + q4 * 8);
        oacc[vt] = mfma16(a, qf[ks], oacc[vt]);
      }
      oacc[vt] *= w0l;
    }
    float sv[16];
    float dsum = 0.f;
#pragma unroll
    for (int st = 0; st < 4; ++st) {
      f32x4 sa = {0.f, 0.f, 0.f, 0.f};
#pragma unroll
      for (int ks = 0; ks < 2; ++ks) {
        bf16x8 a = *(const bf16x8*)(Kb + (st * 16 + l15) * 72 + ks * 32 + q4 * 8);
        sa = mfma16(a, qf[ks], sa);
      }
#pragma unroll
      for (int r = 0; r < 4; ++r) {
        const int sidx = st * 16 + q4 * 4 + r;
        const bool ok = dir ? (sidx >= lrow) : (sidx <= lrow);
        float val = ok ? sa[r] * __expf(bll + itb[sidx] - mtl) : 0.f;
        sv[st * 4 + r] = val;
        dsum += val;
      }
    }
    dsum += shx(dsum, 16); dsum += shx(dsum, 32);
    bf16x8 pf[2];
#pragma unroll
    for (int hf = 0; hf < 2; ++hf) {
      u32x4 pw;
      pw[0] = pack2(sv[hf * 8 + 0], sv[hf * 8 + 1]); pw[1] = pack2(sv[hf * 8 + 2], sv[hf * 8 + 3]);
      pw[2] = pack2(sv[hf * 8 + 4], sv[hf * 8 + 5]); pw[3] = pack2(sv[hf * 8 + 6], sv[hf * 8 + 7]);
      pf[hf] = __builtin_bit_cast(bf16x8, pw);
    }
    const float dn_ = dsum + w0l * nqp;
    const float inv = 1.f / fmaxf(fabsf(dn_), __expf(-mtl));
#pragma unroll
    for (int vt = 0; vt < 8; ++vt) {
#pragma unroll
      for (int hf = 0; hf < 2; ++hf) {
        const u16* vp = Vt + (vt * 16 + l15) * 72 + hf * 32 + q4 * 4;
        s16x4 v0 = *(const s16x4*)vp;
        s16x4 v1 = *(const s16x4*)(vp + 16);
        bf16x8 vf = (bf16x8){v0.x, v0.y, v0.z, v0.w, v1.x, v1.y, v1.z, v1.w};
        oacc[vt] = mfma16(vf, pf[hf], oacc[vt]);
      }
      hacc[vt] += oacc[vt] * inv;
    }
    __syncthreads();
  }
  float ss = 0.f;
#pragma unroll
  for (int vt = 0; vt < 8; ++vt)
#pragma unroll
    for (int r = 0; r < 4; ++r) ss += hacc[vt][r] * hacc[vt][r];
  ss += shx(ss, 16); ss += shx(ss, 32);
  const float rn = rsqrtf(ss * (1.f / 128.f) + EPS);
  const int m = base + lrow;
#pragma unroll
  for (int vt = 0; vt < 8; ++vt) {
    const int v0 = vt * 16 + q4 * 4;
    f32x4 co = *(const f32x4*)(p.proj + (size_t)m * 2432 + 1024 + h * 128 + v0);
    f32x4 gn = *(const f32x4*)(p.c_out_norm + (size_t)(o * 4 + h) * 128 + v0);
    float y0 = sigmoid_f(co[0]) * hacc[vt][0] * rn * gn[0];
    float y1 = sigmoid_f(co[1]) * hacc[vt][1] * rn * gn[1];
    float y2 = sigmoid_f(co[2]) * hacc[vt][2] * rn * gn[2];
    float y3 = sigmoid_f(co[3]) * hacc[vt][3] * rn * gn[3];
    uint2 oo; oo.x = pack2(y0, y1); oo.y = pack2(y2, y3);
    *(uint2*)(p.mix + (size_t)m * 1024 + h * 128 + v0) = oo;
  }
  __syncthreads();
}

__device__ __forceinline__ void mlstm_scan_phase(PRM p, int o) {
  const int tid = get_tid();
  for (int task = get_bid(); task < 576; task += vgrid()) {
    const int sc = task >> 2, slice = task & 3;
    int sq, h, dir;
    if (sc < 128) { sq = sc >> 3; h = (sc >> 1) & 3; dir = sc & 1; }
    else { int u = sc - 128; sq = 16 + (u >> 3); h = (u >> 1) & 3; dir = u & 1; }
    const bool pr = sq < 16;
    const int nc = pr ? 4 : 16;
    const int sidx = pr ? ((sq * 2 + o) * 2 + dir) * 4 + h : 0;
    const int cidx = pr ? 0 : (((sq - 16) * 2 + o) * 2 + dir) * 4 + h;
    const int e0 = slice * 2048 + tid;
    float C[8];
#pragma unroll
    for (int r = 0; r < 8; ++r) C[r] = pr ? 0.f : p.state_C[(size_t)cidx * 8192 + e0 + 256 * r];
    const bool nthr = (slice == 0) && (tid < 64);
    float n = (pr || !nthr) ? 0.f : p.state_n[cidx * 64 + tid];
    float m = pr ? 0.f : p.state_m[cidx];
#pragma unroll 4
    for (int j = 0; j < nc; ++j) {
      const int sl = mslot(sq, h, dir, j);
      float* cp = p.cp + (size_t)sl * 8192 + e0;
      const float* dc = p.dC + (size_t)sl * 8192 + e0;
#pragma unroll
      for (int r = 0; r < 8; ++r) cp[256 * r] = C[r];
      if (nthr) { p.np[sl * 64 + tid] = n; if (tid == 0) p.mp[sl] = m; }
      const float ml = p.dm[sl * 2], bls = p.dm[sl * 2 + 1];
      const float mn = fmaxf(bls + m, ml);
      const float ca = __expf(bls + m - mn), cb = __expf(ml - mn);
#pragma unroll
      for (int r = 0; r < 8; ++r) C[r] = ca * C[r] + cb * dc[256 * r];
      if (nthr) n = ca * n + cb * p.dn[sl * 64 + tid];
      m = mn;
    }
    if (pr) {
      float* oc = p.out + O_CC + (size_t)sidx * 8192 + e0;
#pragma unroll
      for (int r = 0; r < 8; ++r) oc[256 * r] = C[r];
      if (nthr) { p.out[O_CN + (size_t)sidx * 64 + tid] = n; if (tid == 0) p.out[O_CM + sidx] = m; }
    }
  }
}

__device__ __forceinline__ void odd_mid_phase(PRM p, int o, char* smem) {
  u16* lds = (u16*)smem;
  const int tid = get_tid(), lane = tid & 63, wave = tid >> 6, l15 = lane & 15, q4 = lane >> 4;
  for (int bt = get_bid(); bt < 256 + 768 + 512; bt += vgrid()) {
    if (bt < 256) {
      int qb = bt & 15, hq = (bt >> 4) & 7, b = bt >> 7;
      int kvh = hq >> 2;
      int mq = NPR + b * 1024 + qb * 64 + wave * 16;
      AttnSt st; attn_init(st);
      bf16x8 qf[2]; load_q64(qf, p.qa + (size_t)mq * 512 + hq * 64, 512, l15, q4);
      at_run_plain<2>(st, qf, p.kd + (size_t)(NPR + b * 1536) * 128 + kvh * 64, 128, p.vtd_s + (size_t)((b * 2 + kvh) * 64) * 1536, 1536, 24, 0.125f, lds, tid, l15, q4);
      attn_fin(st, p.mix + (size_t)mq * 1024 + 512 + hq * 64, l15, q4);
    } else if (bt < 256 + 768) {
      mlstm1_task(p, o, bt - 256, (float*)smem);
    } else {
      int u = bt - 1024;
      int qb = u & 3, hq = (u >> 2) & 7, b = u >> 5;
      int kvh = hq >> 2;
      int mq = b * 256 + qb * 64 + wave * 16;
      AttnSt st; attn_init(st);
      bf16x8 qf[2]; load_q64(qf, p.qa + (size_t)mq * 512 + hq * 64, 512, l15, q4);
      at_run_plain<2>(st, qf, p.kd + (size_t)(b * 256) * 128 + kvh * 64, 128, p.vtd_p + (size_t)((b * 2 + kvh) * 64) * 256, 256, 4, 0.125f, lds, tid, l15, q4);
      attn_fin(st, p.mix + (size_t)mq * 1024 + 512 + hq * 64, l15, q4);
    }
  }
}

__device__ __forceinline__ void run_phase(PRM p, int ph, char* smem) {
  char* vsm = smem + (rtid() >> 8) * LDS_HALF;
  if (ph == 0) { phase0(p, vsm); return; }
  if (ph == NPHASE - 1) { norm_phase(p, 0, 3); return; }
  const int l = (ph - 1) / 13, s = (ph - 1) % 13;
  const int eo = l >> 1;
  const bool even = (l & 1) == 0;
  EpiP e{};
  const float* modl = p.mod + (size_t)l * 3 * 9216;
  switch (s) {
    case 0: norm_phase(p, l, 0); break;
    case 1: e.H = p.h; ffn_in_phase(p, l, 0, e, smem); break;
    case 2: e.C = p.x; e.gate = modl + 2 * 1024; e.ldc = 1;
            gemm_phase<EPI_RESID, 4, 2, 3, 4, 4>(p.h, p.wt_ffn_out + (size_t)(l * 2 + 0) * 1024 * 2816, 2816, 32, 8, e, smem); break;
    case 3: norm_phase(p, l, 1); break;
    case 4:
      if (even) { e.C = p.proj; e.ldc = 2688; gemm_phase<EPI_STORE, 4, 2, 4, 4, 2>(p.xn, p.wt_in_e + (size_t)eo * 2688 * 1024, 1024, 24, 21, e, smem); }
      else { e.C = p.proj; e.ldc = 2432; gemm_phase<EPI_STORE, 4, 2, 4, 4, 2>(p.xn, p.wt_in_o + (size_t)eo * 2432 * 1024, 1024, 24, 19, e, smem); }
      break;
    case 5: if (even) post_even(p, eo); else post_odd(p, eo); break;
    case 6:
      if (even) {
        EpiP eq{}; eq.C = p.qb; eq.ldc = 768;
        EpiP ek{}; ek.kb = p.kb; ek.vtp = p.vtb_p; ek.vts = p.vtb_s; ek.ctx = 0;
        EpiP ec = ek; ec.ctx = 1;
        const u16* wq = p.wt_qup + (size_t)eo * 768 * 768;
        const u16* wk = p.wt_kvup + (size_t)eo * 1024 * 256;
        for (int t = rbid(); t < 288 + 384 + 64; t += (int)gridDim.x) {
          if (t < 288) gemm_tile<EPI_STORE, 4, 2, 2, 4, 2>(p.cqn, wq, 768, t % 48, t / 48, eq, smem);
          else if (t < 672) { int u = t - 288; gemm_tile<EPI_KVUP, 4, 2, 2, 4, 2>(p.ckvn, wk, 256, u % 48, u / 48, ek, smem); }
          else { int u = t - 672; gemm_tile<EPI_KVUP, 4, 2, 2, 4, 2>(p.cctxn, wk, 256, u % 8, u / 8, ec, smem); }
        }
      } else odd_mid_phase(p, eo, vsm);
      break;
    case 7: if (!even) mlstm_scan_phase(p, eo); break;
    case 8:
      if (even) attn_even_phase(p, eo, vsm);
      else { for (int t = get_bid(); t < 384; t += vgrid()) mlstm2_mfma(p, eo, t, vsm); }
      break;
    case 9: e.C = p.x; e.gate = modl + 5 * 1024; e.ldc = 0;
            gemm_phase<EPI_RESID, 4, 2, 3, 4, 4>(p.mix, p.wt_out + (size_t)l * 1024 * 1024, 1024, 32, 8, e, smem); break;
    case 10: norm_phase(p, l, 2); break;
    case 11: e.H = p.h; ffn_in_phase(p, l, 1, e, smem); break;
    case 12: e.C = p.x; e.gate = modl + 8 * 1024; e.ldc = 1;
             gemm_phase<EPI_RESID, 4, 2, 3, 4, 4>(p.h, p.wt_ffn_out + (size_t)(l * 2 + 1) * 1024 * 2816, 2816, 32, 8, e, smem); break;
  }
}

__global__ void __launch_bounds__(512, 2) mega(Params p) {
  __shared__ __attribute__((aligned(16))) char smem[LDS_BYTES];
  __shared__ uint4 xb_words;
  cg::grid_group grid = cg::this_grid();
  if (threadIdx.x == 0) xb_words = make_uint4(0u, 0u, 0u, 0u);
  __syncthreads();
  XcdBarrier xb = xcd_barrier_post(p.bar, (volatile LAS unsigned*)&xb_words);
  for (int ph = p.ph0; ph < p.ph1; ++ph) {
    const __attribute__((address_space(4))) Params* pp = (const __attribute__((address_space(4))) Params*)__builtin_amdgcn_kernarg_segment_ptr();
    asm volatile("" : "+s"(pp));
    run_phase(*pp, ph, smem);
#ifndef REPMASK
#define REPMASK 0
#endif
#ifndef REPPAR
#define REPPAR 0
#endif
    if (REPMASK) {
      int bit = ph == 0 ? 13 : (ph == NPHASE - 1 ? 14 : (ph - 1) % 13);
      int lay = (ph - 1) / 13;
      bool parok = REPPAR == 0 || ph == 0 || ph == NPHASE - 1 || (REPPAR == 1 && (lay & 1) == 0) || (REPPAR == 2 && (lay & 1) == 1);
      if (((REPMASK >> bit) & 1) && parok) { xcd_barrier(xb); asm volatile("" : "+s"(pp)); run_phase(*pp, ph, smem); }
    }
    if (ph + 1 < p.ph1) {
      if (p.ph1 > 100000) grid.sync();
      xcd_barrier(xb);
    }
  }
}

extern "C" void kernel_launch(void* const* d_in, const int* in_sizes, int n_in, void* d_out, int out_size, void* d_ws, size_t ws_size,
                              hipStream_t stream) {
  static int grid_blocks = 0;
  if (!grid_blocks) {
    int dev = 0, cus = 0, per_cu = 0;
    hipGetDevice(&dev);
    hipDeviceGetAttribute(&cus, hipDeviceAttributeMultiprocessorCount, dev);
    hipOccupancyMaxActiveBlocksPerMultiprocessor(&per_cu, mega, 512, 0);
    per_cu = 1;
    grid_blocks = cus * per_cu;
  }
  Params p{};
  const float** ip = (const float**)&p.x_prompt;
  for (int i = 0; i < 31; ++i) ip[i] = (const float*)d_in[i];
  p.out = (float*)d_out;
  char* w = (char*)d_ws;
  size_t off = 0;
  auto take = [&](size_t bytes) { char* r = w + off; off += (bytes + 255) & ~(size_t)255; return r; };
  p.wt_ffn_in = (u16*)take((size_t)8 * 5632 * 1024 * 2);
  p.wt_ffn_out = (u16*)take((size_t)8 * 1024 * 2816 * 2);
  p.wt_in_e = (u16*)take((size_t)2 * 2688 * 1024 * 2);
  p.wt_in_o = (u16*)take((size_t)2 * 2432 * 1024 * 2);
  p.wt_out = (u16*)take((size_t)4 * 1024 * 1024 * 2);
  p.wt_qup = (u16*)take((size_t)2 * 768 * 768 * 2);
  p.wt_kvup = (u16*)take((size_t)2 * 1024 * 256 * 2);
  p.mod = (float*)take((size_t)12 * 9216 * 4);
  p.x = (float*)take((size_t)NTOK * 1024 * 4);
  p.proj = (float*)take((size_t)NTOK * 2688 * 4);
  p.qb = (float*)take((size_t)NTOK * 768 * 4);
  p.dC = (float*)take((size_t)768 * 8192 * 4);
  p.dn = (float*)take((size_t)768 * 64 * 4);
  p.dm = (float*)take((size_t)768 * 2 * 4);
  p.cp = (float*)take((size_t)768 * 8192 * 4);
  p.np = (float*)take((size_t)768 * 64 * 4);
  p.mp = (float*)take((size_t)768 * 4);
  p.xn = (u16*)take((size_t)NTOK * 1024 * 2);
  p.h = (u16*)take((size_t)NTOK * 2816 * 2);
  p.mix = (u16*)take((size_t)NTOK * 1024 * 2);
  p.qa = (u16*)take((size_t)NTOK * 512 * 2);
  p.ka = (u16*)take((size_t)NTOK * 512 * 2);
  p.kactx = (u16*)take((size_t)1024 * 512 * 2);
  p.vta_p = (u16*)take((size_t)16 * 8 * 64 * 256 * 2);
  p.vta_s = (u16*)take((size_t)2 * 8 * 64 * 1536 * 2);
  p.kb = (u16*)take((size_t)7168 * 768 * 2);
  p.vtb_p = (u16*)take((size_t)16 * 8 * 64 * 256 * 2);
  p.vtb_s = (u16*)take((size_t)2 * 8 * 64 * 1536 * 2);
  p.cqn = (u16*)take((size_t)NTOK * 768 * 2);
  p.ckvn = (u16*)take((size_t)NTOK * 256 * 2);
  p.cctxn = (u16*)take((size_t)1024 * 256 * 2);
  p.kd = (u16*)take((size_t)7168 * 128 * 2);
  p.vtd_p = (u16*)take((size_t)16 * 2 * 64 * 256 * 2);
  p.vtd_s = (u16*)take((size_t)2 * 2 * 64 * 1536 * 2);
  p.bar = (unsigned*)take((size_t)XCD_BAR_WORDS * 4);
  if (off > ws_size) { fprintf(stderr, "kernel_launch: workspace too small: need %zu have %zu\n", off, ws_size); return; }
  hipMemsetAsync(p.bar, 0, (size_t)XCD_BAR_WORDS * 4, stream);
#if MULTI
  for (int ph = 0; ph < NPHASE; ++ph) {
    p.ph0 = ph; p.ph1 = ph + 1;
    hipLaunchKernelGGL(mega, dim3(grid_blocks), dim3(512), 0, stream, p);
  }
#else
  p.ph0 = 0; p.ph1 = NPHASE;
  void* args[] = {&p};
  hipError_t e = hipLaunchCooperativeKernel((void*)mega, dim3(grid_blocks), dim3(512), args, 0, stream);
  if (e != hipSuccess) fprintf(stderr, "cooperative launch failed: %s (grid %d)\n", hipGetErrorString(e), grid_blocks);
#endif
}
```

```cpp
#include <hip/hip_runtime.h>
#include <hip/hip_cooperative_groups.h>
#include <cstdio>
#include <cstdint>
namespace cg = cooperative_groups;

#ifndef MULTI
#define MULTI 0
#endif

typedef unsigned short u16;
typedef __attribute__((ext_vector_type(8))) short bf16x8;
typedef __attribute__((ext_vector_type(4))) short s16x4;
typedef __attribute__((ext_vector_type(4))) float f32x4;
typedef __attribute__((ext_vector_type(4))) unsigned int u32x4;

#define NTOK 6144
#define NPR 4096
#define LDS_HALF 77824
#define LDS_BYTES (2 * LDS_HALF)
#define NPHASE 54
#define EPS 1e-6f

struct Params {
  const float *x_prompt, *x_sample, *cache_a_k, *cache_a_v, *cache_b_ckv, *cache_b_krope, *cache_d_k, *cache_d_v;
  const float *state_C, *state_n, *state_m, *c, *c_ctx, *w_mod, *b_mod, *norm_g, *ffn_in, *ffn_out;
  const float *w_in_even, *w_in_odd, *w_out, *a_rpb, *b_q_norm, *b_wq_up, *b_kv_norm, *b_wkv_up;
  const float *c_gate_bias, *c_out_norm, *d_q_norm, *d_k_norm, *final_norm;
  float* out;
  u16 *wt_ffn_in, *wt_ffn_out, *wt_in_e, *wt_in_o, *wt_out, *wt_qup, *wt_kvup;
  float *mod, *x, *proj, *qb, *dC, *dn, *dm, *cp, *np, *mp;
  u16 *xn, *h, *mix, *qa, *ka, *kactx, *vta_p, *vta_s, *kb, *vtb_p, *vtb_s, *cqn, *ckvn, *cctxn, *kd, *vtd_p, *vtd_s;
  unsigned* bar;
  int ph0, ph1;
};

typedef const __attribute__((address_space(4))) Params& PRM;
#define O_YP 0
#define O_YS 4194304
#define O_AK 6291456
#define O_AV 10485760
#define O_CKV 14680064
#define O_KR 16777216
#define O_DK 17039360
#define O_DV 18087936
#define O_CC 19136512
#define O_CN 21233664
#define O_CM 21250048

__device__ __forceinline__ int get_tid() { int t = threadIdx.x & 255; asm volatile("" : "+v"(t)); return t; }
__device__ __forceinline__ int rtid_raw() { int t = threadIdx.x; asm volatile("" : "+v"(t)); return t; }
__device__ __forceinline__ int get_bid() { int t = blockIdx.x * 2 + __builtin_amdgcn_readfirstlane(rtid_raw() >> 8); asm volatile("" : "+s"(t)); return t; }
__device__ __forceinline__ int vgrid() { return (int)gridDim.x * 2; }
__device__ __forceinline__ int rtid() { int t = threadIdx.x; asm volatile("" : "+v"(t)); return t; }
__device__ __forceinline__ int rbid() { int t = blockIdx.x; asm volatile("" : "+s"(t)); return t; }
typedef __attribute__((ext_vector_type(2))) __bf16 bf16x2_t;
typedef __attribute__((ext_vector_type(2))) float f32x2_t;
__device__ __forceinline__ unsigned pack2(float a, float b) {
  f32x2_t v = {a, b};
  bf16x2_t r = __builtin_convertvector(v, bf16x2_t);
  return __builtin_bit_cast(unsigned, r);
}
__device__ __forceinline__ u16 f2bf(float f) { return (u16)(pack2(f, 0.f) & 0xffffu); }
__device__ __forceinline__ float shx(float v, int m) {
  int l = __builtin_amdgcn_mbcnt_hi(-1, __builtin_amdgcn_mbcnt_lo(-1, 0));
  asm volatile("" : "+v"(l));
  return __int_as_float(__builtin_amdgcn_ds_bpermute((l ^ m) << 2, __float_as_int(v)));
}
__device__ __forceinline__ float wsum(float v) {
#pragma unroll
  for (int o = 32; o; o >>= 1) v += shx(v, o);
  return v;
}
__device__ __forceinline__ float wmaxr(float v) {
#pragma unroll
  for (int o = 32; o; o >>= 1) v = fmaxf(v, shx(v, o));
  return v;
}
__device__ __forceinline__ float silu_f(float x) { return x / (1.f + __expf(-x)); }
__device__ __forceinline__ float sigmoid_f(float x) { return 1.f / (1.f + __expf(-x)); }
__device__ __forceinline__ float logsig_f(float x) { return fminf(x, 0.f) - __logf(1.f + __expf(-fabsf(x))); }
__device__ __forceinline__ void sincos_r(float a, float& s, float& c) {
  float n = rintf(a * 0.15915494309f);
  float r = fmaf(-n, 6.2831855f, a);
  r = fmaf(-n, -1.7484555e-7f, r);
  s = __sinf(r); c = __cosf(r);
}
__device__ __forceinline__ int grp_of(int m) { return m < NPR ? 0 : 1 + ((m - NPR) >> 10); }
__device__ __forceinline__ int keyrow(int m) { return m < NPR ? m : NPR + ((m - NPR) >> 10) * 1536 + ((m - NPR) & 1023); }
__device__ __forceinline__ f32x4 mfma16(bf16x8 a, bf16x8 b, f32x4 c) { return __builtin_amdgcn_mfma_f32_16x16x32_bf16(a, b, c, 0, 0, 0); }

#define XB_TMO      128
#define XB_XCNT(j)  (256  + 64 * (j))
#define XB_XSUB(j)  (1280 + 64 * (j))
#define XB_XGEN(j)  (2304 + 64 * (j))
#define XB_TOP      3328
#define XB_TOPGEN   3392
#define XCD_BAR_WORDS 3456
#define XB_SPIN_CAP (1u << 18)
#define LAS __attribute__((address_space(3)))

__device__ __forceinline__ unsigned xb_ld(unsigned* p)              { return __hip_atomic_load(p, __ATOMIC_RELAXED, __HIP_MEMORY_SCOPE_AGENT); }
__device__ __forceinline__ unsigned xb_add(unsigned* p, unsigned v) { return __hip_atomic_fetch_add(p, v, __ATOMIC_RELAXED, __HIP_MEMORY_SCOPE_AGENT); }
__device__ __forceinline__ unsigned xb_xcc_id() { return (unsigned)__builtin_amdgcn_s_getreg((3 << 11) | 20) & 0xFu; }
#define XB_SPIN(cond, bar) do { unsigned _sp = 0; while (cond) { __builtin_amdgcn_s_sleep(1); \
    if ((++_sp & 255u) == 0u) { if (xb_ld(&(bar)[XB_TMO])) break; if (_sp > XB_SPIN_CAP) { atomicAdd(&(bar)[XB_TMO], 1u); break; } } } } while (0)

struct XcdBarrier {
    unsigned* bar; unsigned x;
    volatile LAS unsigned* st;
};

__device__ __forceinline__ XcdBarrier xcd_barrier_post(unsigned* bar, volatile LAS unsigned* st) {
    XcdBarrier b; b.bar = bar; b.x = xb_xcc_id(); b.st = st;
    if (threadIdx.x == 0) (void)xb_add(&bar[XB_XCNT(b.x)], 1u);
    return b;
}
__device__ __forceinline__ void xcd_barrier_complete(unsigned* bar, unsigned x, unsigned& nloc, unsigned& nx) {
    const unsigned G = gridDim.x * gridDim.y * gridDim.z;
    unsigned sum, cnt, mine, sp = 0u;
    for (;;) {
        sum = 0u; cnt = 0u; mine = 0u;
#pragma unroll
        for (unsigned j = 0; j < 16; ++j) { const unsigned c = xb_ld(&bar[XB_XCNT(j)]); sum += c; cnt += (c > 0u) ? 1u : 0u; mine = (j == x) ? c : mine; }
        if (sum == G) break;
        __builtin_amdgcn_s_sleep(1);
        if ((++sp & 255u) == 0u) { if (xb_ld(&bar[XB_TMO])) break; if (sp > XB_SPIN_CAP) { atomicAdd(&bar[XB_TMO], 1u); break; } }
    }
    nloc = mine > 0u ? mine : 1u; nx = cnt > 0u ? cnt : 1u;
}

__device__ __forceinline__ void xcd_barrier(const XcdBarrier& b) {
    asm volatile("s_waitcnt vmcnt(0)" ::: "memory");
    __syncthreads();
    if (threadIdx.x == 0) {
        unsigned* bar = b.bar;
        __builtin_amdgcn_s_waitcnt(0);
        unsigned nloc = b.st[0], nx = b.st[1];
        if (nloc == 0u) { xcd_barrier_complete(bar, b.x, nloc, nx); b.st[0] = nloc; b.st[1] = nx; }
        const unsigned old = xb_add(&bar[XB_XSUB(b.x)], 1u);
        const unsigned gen = old / nloc;
        if (old + 1u == (gen + 1u) * nloc) {
            __builtin_amdgcn_fence(__ATOMIC_RELEASE, "agent");
            asm volatile("s_waitcnt vmcnt(0)" ::: "memory");
            const unsigned og = xb_add(&bar[XB_TOP], 1u);
            const unsigned tg = og / nx;
            if (og + 1u == (tg + 1u) * nx) xb_add(&bar[XB_TOPGEN], 1u);
            else XB_SPIN(xb_ld(&bar[XB_TOPGEN]) == tg, bar);
            __builtin_amdgcn_fence(__ATOMIC_ACQUIRE, "agent");
            xb_add(&bar[XB_XGEN(b.x)], 1u);
            asm volatile("s_waitcnt vmcnt(0)" ::: "memory");
        } else {
            XB_SPIN(xb_ld(&bar[XB_XGEN(b.x)]) == gen, bar);
            __builtin_amdgcn_fence(__ATOMIC_ACQUIRE, "agent");
            asm volatile("s_waitcnt vmcnt(0)" ::: "memory");
        }
    }
    __syncthreads();
}


__device__ __forceinline__ void conv_tile(const float* __restrict__ src, int K, int N, int perm, u16* __restrict__ dst, int kt2, int nt, float* tile) {
  const int tid = get_tid();
  {
    const int c4 = tid & 15, kr = tid >> 4;
    const int n = nt * 64 + c4 * 4;
    const bool valid = n < N;
    int col = n;
    if (perm) { int G = n >> 4, w = n & 15, sub = w >> 2; col = ((sub & 1) ? 2816 : 0) + G * 8 + (sub >> 1) * 4 + (w & 3); }
    float4 v[8];
#pragma unroll
    for (int i = 0; i < 8; ++i) {
      int kk = kr + 16 * i;
      v[i] = valid ? *(const float4*)(src + (size_t)(kt2 * 128 + kk) * N + col) : make_float4(0.f, 0.f, 0.f, 0.f);
    }
#pragma unroll
    for (int i = 0; i < 8; ++i) {
      int kk = kr + 16 * i;
      float* t = tile + (kk >> 6) * 4160 + (kk & 63) * 65 + c4 * 4;
      t[0] = v[i].x; t[1] = v[i].y; t[2] = v[i].z; t[3] = v[i].w;
    }
  }
  __syncthreads();
  {
    const int k8 = (tid & 7) * 8;
#pragma unroll
    for (int hh = 0; hh < 2; ++hh)
#pragma unroll
      for (int i = 0; i < 2; ++i) {
        int nn2 = (tid >> 3) + 32 * i;
        float v[8];
#pragma unroll
        for (int e = 0; e < 8; ++e) v[e] = tile[hh * 4160 + (k8 + e) * 65 + nn2];
        uint4 o; o.x = pack2(v[0], v[1]); o.y = pack2(v[2], v[3]); o.z = pack2(v[4], v[5]); o.w = pack2(v[6], v[7]);
        *(uint4*)(dst + (size_t)(nt * 64 + nn2) * K + kt2 * 128 + hh * 64 + k8) = o;
      }
  }
  __syncthreads();
}

__device__ __forceinline__ void mod_task(PRM p, int t, float* sm) {
  const int l = t / 144, cb = t % 144, tid = get_tid();
  float* sc = sm;
  float* red = sm + 3072;
  for (int i = tid; i < 3072; i += 256) {
    int g = i >> 10, k = i & 1023;
    float v = g == 0 ? p.c_ctx[k] : p.c[(g - 1) * 1024 + k];
    sc[i] = silu_f(v);
  }
  __syncthreads();
  const int c4 = tid & 15, kg = tid >> 4;
  const float* w = p.w_mod + (size_t)l * 1024 * 9216 + (size_t)(kg * 64) * 9216 + cb * 64 + c4 * 4;
  float a[3][4];
#pragma unroll
  for (int g = 0; g < 3; ++g)
#pragma unroll
    for (int q = 0; q < 4; ++q) a[g][q] = 0.f;
  for (int k = 0; k < 64; k += 8) {
    float4 wv[8];
#pragma unroll
    for (int e = 0; e < 8; ++e) wv[e] = *(const float4*)(w + (size_t)(k + e) * 9216);
#pragma unroll
    for (int e = 0; e < 8; ++e) {
      int kk = kg * 64 + k + e;
#pragma unroll
      for (int g = 0; g < 3; ++g) {
        float sv = sc[g * 1024 + kk];
        a[g][0] = fmaf(sv, wv[e].x, a[g][0]); a[g][1] = fmaf(sv, wv[e].y, a[g][1]);
        a[g][2] = fmaf(sv, wv[e].z, a[g][2]); a[g][3] = fmaf(sv, wv[e].w, a[g][3]);
      }
    }
  }
#pragma unroll
  for (int g = 0; g < 3; ++g)
#pragma unroll
    for (int q = 0; q < 4; ++q) red[(kg * 3 + g) * 64 + c4 * 4 + q] = a[g][q];
  __syncthreads();
  if (tid < 192) {
    int g = tid >> 6, c2 = tid & 63;
    float s = 0.f;
#pragma unroll
    for (int q = 0; q < 16; ++q) s += red[(q * 3 + g) * 64 + c2];
    int j = cb * 64 + c2;
    p.mod[(size_t)(l * 3 + g) * 9216 + j] = s + p.b_mod[l * 9216 + j];
  }
  __syncthreads();
}

__device__ __forceinline__ int conv_layer_count(int l) { return (l & 1) ? 2544 : 2680; }
__device__ __forceinline__ void conv_layer_task(PRM p, int l, int u, float* sm) {
  const float* src; u16* dst; int K, N, Npad, perm = 0, tp, mat0;
  const int eo = l >> 1;
  const int nin = (l & 1) ? 304 : 336;
  if (u < 1408) { K = 1024; N = 5632; Npad = 5632; perm = 1; tp = 704; src = p.ffn_in; dst = p.wt_ffn_in; mat0 = l * 2; }
  else if ((u -= 1408) < 704) { K = 2816; N = 1024; Npad = 1024; tp = 352; src = p.ffn_out; dst = p.wt_ffn_out; mat0 = l * 2; }
  else if ((u -= 704) < nin) {
    if (l & 1) { K = 1024; N = 2320; Npad = 2432; tp = 304; src = p.w_in_odd; dst = p.wt_in_o; mat0 = eo; }
    else { K = 1024; N = 2592; Npad = 2688; tp = 336; src = p.w_in_even; dst = p.wt_in_e; mat0 = eo; }
  }
  else if ((u -= nin) < 128) { K = 1024; N = 1024; Npad = 1024; tp = 128; src = p.w_out; dst = p.wt_out; mat0 = l; }
  else if ((u -= 128) < 72) { K = 768; N = 768; Npad = 768; tp = 72; src = p.b_wq_up; dst = p.wt_qup; mat0 = eo; }
  else { u -= 72; K = 256; N = 1024; Npad = 1024; tp = 32; src = p.b_wkv_up; dst = p.wt_kvup; mat0 = eo; }
  int mat = mat0 + u / tp, r = u % tp;
  int nkt = K / 128;
  int kt = r % nkt, nt = r / nkt;
  conv_tile(src + (size_t)mat * K * N, K, N, perm, dst + (size_t)mat * Npad * K, kt, nt, sm);
}

__device__ __forceinline__ void phase0(PRM p, char* smem) {
  float* sm = (float*)smem;
  const int NMOD = 144, NCOPY = 1536, NCONV = 2680;
  const int total = NMOD + NCOPY + NCONV;
  for (int t = get_bid(); t < total; t += vgrid()) {
    if (t < NMOD) { mod_task(p, t, sm); continue; }
    int u = t - NMOD;
    if (u < NCOPY) {
      const int tid = get_tid();
#pragma unroll
      for (int i = 0; i < 4; ++i) {
        size_t idx = ((size_t)u * 1024 + i * 256 + tid);
        const float4* src = idx < (size_t)NPR * 256 ? (const float4*)p.x_prompt + idx : (const float4*)p.x_sample + (idx - (size_t)NPR * 256);
        ((float4*)p.x)[idx] = *src;
      }
      continue;
    }
    conv_layer_task(p, 0, u - NCOPY, sm);
  }
}

__device__ __forceinline__ void norm_phase(PRM p, int l, int which) {
  const int lane = get_tid() & 63, wave = get_tid() >> 6;
  const int nrows_wave = NTOK / 4;
  const int stride = vgrid();
  for (int t0 = get_bid(); t0 < nrows_wave; t0 += 3 * stride) {
    float4 v[3][4];
    float ss[3];
#pragma unroll
    for (int k = 0; k < 3; ++k) {
      const int t = t0 + k * stride;
      if (t < nrows_wave) {
        const float4* xr = (const float4*)(p.x + (size_t)(t * 4 + wave) * 1024);
#pragma unroll
        for (int i = 0; i < 4; ++i) v[k][i] = xr[i * 64 + lane];
      }
    }
#pragma unroll
    for (int k = 0; k < 3; ++k) {
      float a = 0.f;
#pragma unroll
      for (int i = 0; i < 4; ++i) a += v[k][i].x * v[k][i].x + v[k][i].y * v[k][i].y + v[k][i].z * v[k][i].z + v[k][i].w * v[k][i].w;
      ss[k] = wsum(a);
    }
#pragma unroll
    for (int k = 0; k < 3; ++k) {
      const int t = t0 + k * stride;
      if (t >= nrows_wave) continue;
      const int m = t * 4 + wave;
      const float r = rsqrtf(ss[k] * (1.f / 1024.f) + EPS);
      if (which == 3) {
        float4* o = (float4*)(p.out + (size_t)m * 1024);
#pragma unroll
        for (int i = 0; i < 4; ++i) {
          float4 g = ((const float4*)p.final_norm)[i * 64 + lane];
          float4 y; y.x = v[k][i].x * r * g.x; y.y = v[k][i].y * r * g.y; y.z = v[k][i].z * r * g.z; y.w = v[k][i].w * r * g.w;
          o[i * 64 + lane] = y;
        }
      } else {
        const float* md = p.mod + (size_t)(l * 3 + grp_of(m)) * 9216 + which * 3072;
        const float4* sh = (const float4*)md;
        const float4* sc = (const float4*)(md + 1024);
        const float4* gg = (const float4*)(p.norm_g + (size_t)(l * 3 + which) * 1024);
#pragma unroll
        for (int i = 0; i < 4; ++i) {
          float4 g = gg[i * 64 + lane], s = sc[i * 64 + lane], b = sh[i * 64 + lane];
          float y0 = v[k][i].x * r * g.x * (1.f + s.x) + b.x;
          float y1 = v[k][i].y * r * g.y * (1.f + s.y) + b.y;
          float y2 = v[k][i].z * r * g.z * (1.f + s.z) + b.z;
          float y3 = v[k][i].w * r * g.w * (1.f + s.w) + b.w;
          uint2 o; o.x = pack2(y0, y1); o.y = pack2(y2, y3);
          *(uint2*)(p.xn + (size_t)m * 1024 + (i * 64 + lane) * 4) = o;
        }
      }
    }
  }
}

struct EpiP {
  float* C; int ldc;
  const float* gate;
  u16* H;
  u16 *kb, *vtp, *vts; int ctx;
};
enum { EPI_STORE = 0, EPI_RESID = 1, EPI_SWIGLU = 2, EPI_KVUP = 3 };

template <int FI, int FJ, bool SWAP>
__device__ __forceinline__ void g_compute(f32x4 (&acc)[FI][FJ], const u16* Ac, const u16* Bc, int q4, int rsw) {
  __builtin_amdgcn_s_setprio(1);
#pragma unroll
  for (int ks = 0; ks < 2; ++ks) {
    const int co = ((ks * 4 + q4) ^ rsw) << 3;
#pragma unroll
    for (int j0 = 0; j0 < FJ; j0 += 4) {
      bf16x8 b[4];
#pragma unroll
      for (int j = 0; j < 4; ++j) if (j0 + j < FJ) b[j] = *(const bf16x8*)(Bc + (j0 + j) * 1024 + co);
#pragma unroll
      for (int i0 = 0; i0 < FI; i0 += 4) {
        bf16x8 a[4];
#pragma unroll
        for (int i = 0; i < 4; ++i) if (i0 + i < FI) a[i] = *(const bf16x8*)(Ac + (i0 + i) * 1024 + co);
#pragma unroll
        for (int j = 0; j < 4; ++j)
          if (j0 + j < FJ) {
#pragma unroll
            for (int i = 0; i < 4; ++i)
              if (i0 + i < FI) acc[i0 + i][j0 + j] = SWAP ? mfma16(b[j], a[i], acc[i0 + i][j0 + j]) : mfma16(a[i], b[j], acc[i0 + i][j0 + j]);
          }
      }
    }
  }
  __builtin_amdgcn_s_setprio(0);
}

template <int EPI, int WMW, int WNW, int FI, int FJ, int DEPTH>
__device__ __forceinline__ void gemm_tile(const u16* __restrict__ A, const u16* __restrict__ Wt, int K, int tm, int tn, const EpiP& e, char* smem) {
  constexpr int BM = WMW * FI * 16, BN = WNW * FJ * 16;
  constexpr int NA = BM / 64, NB = BN / 64;
  constexpr int BUFSZ = (BM + BN) * 64;
  static_assert(WMW * WNW == 8 && BM % 64 == 0 && BN % 64 == 0, "tile");
  u16* As = (u16*)smem;
  u16* Bs = As + BM * 64;
  const int tid = rtid(), lane = tid & 63, wave = tid >> 6, wm = wave / WNW, wn = wave % WNW, l15 = lane & 15, q4 = lane >> 4;
  const int lr = tid >> 3, lc = tid & 7;
  const u16* Ag = A + (size_t)(tm * BM + lr) * K + lc * 8;
  const u16* Bg = Wt + (size_t)(tn * BN + lr) * K + lc * 8;
  const int st_off = lr * 64 + ((lc ^ ((lr >> 1) & 7)) << 3);
  const int rsw = (l15 >> 1) & 7;
  const int a_row = (wm * FI * 16 + l15) * 64, b_row = (wn * FJ * 16 + l15) * 64;
  f32x4 acc[FI][FJ];
#pragma unroll
  for (int i = 0; i < FI; ++i)
#pragma unroll
    for (int j = 0; j < FJ; ++j) acc[i][j] = (f32x4){0.f, 0.f, 0.f, 0.f};
  const int nk = K >> 6;
#define GL(RA, RB, KT) { _Pragma("unroll") for (int i = 0; i < NA; ++i) RA[i] = *(const u32x4*)(Ag + (size_t)i * 64 * K + (KT) * 64); \
                         _Pragma("unroll") for (int i = 0; i < NB; ++i) RB[i] = *(const u32x4*)(Bg + (size_t)i * 64 * K + (KT) * 64); }
#define GS(RA, RB, BUF) { _Pragma("unroll") for (int i = 0; i < NA; ++i) *(u32x4*)(As + (BUF) * BUFSZ + st_off + i * 4096) = RA[i]; \
                          _Pragma("unroll") for (int i = 0; i < NB; ++i) *(u32x4*)(Bs + (BUF) * BUFSZ + st_off + i * 4096) = RB[i]; }
  if constexpr (DEPTH == 4) {
    static_assert(WMW == 4 && WNW == 2 && FJ == 4 && (FI == 3 || FI == 4), "ring4 tile");
    constexpr int ST = (BM + BN) * 32;
    const int nk32 = K >> 5;
    const int fs = (-(tid >> 4)) & 3;
    const int sc = ((tid & 3) ^ fs) << 3;
    const int r4 = tid >> 2;
    const bool three = (BM == 256) || (tid < 256);
    const u16* sp0 = A + (size_t)(tm * BM + r4) * K + sc;
    const int lo0 = tid * 8;
    const u16* sp1; int lo1; const u16* sp2; int lo2;
    if (BM == 256) {
      sp1 = A + (size_t)(tm * BM + 128 + r4) * K + sc;  lo1 = (tid + 512) * 8;
      sp2 = Wt + (size_t)(tn * BN + r4) * K + sc;       lo2 = BM * 32 + tid * 8;
    } else if (tid < 256) {
      sp1 = A + (size_t)(tm * BM + 128 + r4) * K + sc;  lo1 = (tid + 512) * 8;
      sp2 = Wt + (size_t)(tn * BN + 64 + r4) * K + sc;  lo2 = BM * 32 + (tid + 256) * 8;
    } else {
      sp1 = Wt + (size_t)(tn * BN + (r4 - 64)) * K + sc; lo1 = BM * 32 + (tid - 256) * 8;
      sp2 = sp1; lo2 = lo1;
    }
    const int fr = (-(l15 >> 2)) & 3;
    const int co3 = (q4 ^ fr) << 3;
    const int a_row3 = (wm * FI * 16 + l15) * 32 + co3, b_row3 = BM * 32 + (wn * FJ * 16 + l15) * 32 + co3;
    const unsigned lbase = (unsigned)(size_t)As;
#define GD4(KT, BUF) { __builtin_amdgcn_global_load_lds((const unsigned*)(sp0 + (KT) * 32), (unsigned*)(As + (BUF) * ST + lo0), 16, 0, 0); \
                       __builtin_amdgcn_global_load_lds((const unsigned*)(sp1 + (KT) * 32), (unsigned*)(As + (BUF) * ST + lo1), 16, 0, 0); \
                       if (three) __builtin_amdgcn_global_load_lds((const unsigned*)(sp2 + (KT) * 32), (unsigned*)(As + (BUF) * ST + lo2), 16, 0, 0); }
    asm volatile("s_waitcnt vmcnt(0)" ::: "memory");
    GD4(0, 0);
    if (nk32 > 1) GD4(1, 1);
    if (nk32 > 2) GD4(2, 2);
#define RING4_STEP(J) { \
      const int kt = kt0 + (J); \
      if (kt + 2 < nk32) { if (three) asm volatile("s_waitcnt vmcnt(6)" ::: "memory"); else asm volatile("s_waitcnt vmcnt(4)" ::: "memory"); } \
      else if (kt + 1 < nk32) { if (three) asm volatile("s_waitcnt vmcnt(3)" ::: "memory"); else asm volatile("s_waitcnt vmcnt(2)" ::: "memory"); } \
      else asm volatile("s_waitcnt vmcnt(0)" ::: "memory"); \
      asm volatile("s_waitcnt lgkmcnt(0)" ::: "memory"); \
      __builtin_amdgcn_s_barrier(); \
      asm volatile("" ::: "memory"); \
      const unsigned aad = lbase + (unsigned)(((J) * ST + a_row3) * 2); \
      const unsigned bad = lbase + (unsigned)(((J) * ST + b_row3) * 2); \
      bf16x8 b0, b1, b2, b3, a0, a1, a2, a3; \
      asm volatile("ds_read_b128 %0, %1" : "=v"(b0) : "v"(bad)); \
      asm volatile("ds_read_b128 %0, %1 offset:1024" : "=v"(b1) : "v"(bad)); \
      asm volatile("ds_read_b128 %0, %1 offset:2048" : "=v"(b2) : "v"(bad)); \
      asm volatile("ds_read_b128 %0, %1 offset:3072" : "=v"(b3) : "v"(bad)); \
      asm volatile("ds_read_b128 %0, %1" : "=v"(a0) : "v"(aad)); \
      asm volatile("ds_read_b128 %0, %1 offset:1024" : "=v"(a1) : "v"(aad)); \
      asm volatile("ds_read_b128 %0, %1 offset:2048" : "=v"(a2) : "v"(aad)); \
      if (FI == 4) { asm volatile("ds_read_b128 %0, %1 offset:3072" : "=v"(a3) : "v"(aad)); \
        asm volatile("s_waitcnt lgkmcnt(0)" : "+v"(b0), "+v"(b1), "+v"(b2), "+v"(b3), "+v"(a0), "+v"(a1), "+v"(a2), "+v"(a3)); } \
      else { asm volatile("s_waitcnt lgkmcnt(0)" : "+v"(b0), "+v"(b1), "+v"(b2), "+v"(b3), "+v"(a0), "+v"(a1), "+v"(a2)); a3 = a2; } \
      __builtin_amdgcn_s_setprio(1); \
      { bf16x8 bb[4] = {b0, b1, b2, b3}; bf16x8 aa[4] = {a0, a1, a2, a3}; \
        _Pragma("unroll") for (int j = 0; j < 4; ++j) \
          _Pragma("unroll") for (int i = 0; i < FI; ++i) acc[i][j] = mfma16(bb[j], aa[i], acc[i][j]); } \
      __builtin_amdgcn_s_setprio(0); \
      if (kt + 3 < nk32) GD4(kt + 3, ((J) + 3) & 3);     \
      }
    for (int kt0 = 0; kt0 < nk32; kt0 += 4) {
      RING4_STEP(0) RING4_STEP(1) RING4_STEP(2) RING4_STEP(3)
    }
#undef RING4_STEP
#undef GD4
    __syncthreads();
  } else if constexpr (DEPTH == 3) {
    constexpr int ST = (BM + BN) * 32;
    constexpr int NA4 = BM * 4 / 512, NB4 = BN * 4 / 512;
    const int nk32 = K >> 5;
    const int fs = (-(tid >> 4)) & 3;
    const u16* Ad = A + (size_t)(tm * BM + (tid >> 2)) * K + (((tid & 3) ^ fs) << 3);
    const u16* Bd = Wt + (size_t)(tn * BN + (tid >> 2)) * K + (((tid & 3) ^ fs) << 3);
    u16* Al = As + tid * 8;
    u16* Bl = As + BM * 32 + tid * 8;
    const int fr = (-(l15 >> 2)) & 3;
    const int co3 = (q4 ^ fr) << 3;
    const int a_row3 = (wm * FI * 16 + l15) * 32 + co3, b_row3 = BM * 32 + (wn * FJ * 16 + l15) * 32 + co3;
    static_assert(FI == 8 && FJ == 4, "ring path is written for 8x4 fragments per wave");
    const unsigned lbase = (unsigned)(size_t)As;
#define GD3(KT, BUF) { _Pragma("unroll") for (int i = 0; i < NA4; ++i) __builtin_amdgcn_global_load_lds((const unsigned*)(Ad + (size_t)i * 128 * K + (KT) * 32), (unsigned*)(Al + (BUF) * ST + i * 4096), 16, 0, 0); \
                       _Pragma("unroll") for (int i = 0; i < NB4; ++i) __builtin_amdgcn_global_load_lds((const unsigned*)(Bd + (size_t)i * 128 * K + (KT) * 32), (unsigned*)(Bl + (BUF) * ST + i * 4096), 16, 0, 0); }
    asm volatile("s_waitcnt vmcnt(0)" ::: "memory");
    GD3(0, 0);
    if (nk32 > 1) GD3(1, 1);
    if (nk32 > 2) GD3(2, 2);
#define RING_STEP(J) { \
      const int kt = kt0 + (J); \
      if (kt + 2 < nk32) asm volatile("s_waitcnt vmcnt(%0)" :: "n"(2 * (NA4 + NB4)) : "memory"); \
      else if (kt + 1 < nk32) asm volatile("s_waitcnt vmcnt(%0)" :: "n"(NA4 + NB4) : "memory"); \
      else asm volatile("s_waitcnt vmcnt(0)" ::: "memory"); \
      asm volatile("s_waitcnt lgkmcnt(0)" ::: "memory"); \
      __builtin_amdgcn_s_barrier(); \
      asm volatile("" ::: "memory"); \
      const unsigned aad = lbase + (unsigned)(((J) * ST + a_row3) * 2); \
      const unsigned bad = lbase + (unsigned)(((J) * ST + b_row3) * 2); \
      bf16x8 b0, b1, b2, b3, a0, a1, a2, a3; \
      asm volatile("ds_read_b128 %0, %1" : "=v"(b0) : "v"(bad)); \
      asm volatile("ds_read_b128 %0, %1 offset:1024" : "=v"(b1) : "v"(bad)); \
      asm volatile("ds_read_b128 %0, %1 offset:2048" : "=v"(b2) : "v"(bad)); \
      asm volatile("ds_read_b128 %0, %1 offset:3072" : "=v"(b3) : "v"(bad)); \
      asm volatile("ds_read_b128 %0, %1" : "=v"(a0) : "v"(aad)); \
      asm volatile("ds_read_b128 %0, %1 offset:1024" : "=v"(a1) : "v"(aad)); \
      asm volatile("ds_read_b128 %0, %1 offset:2048" : "=v"(a2) : "v"(aad)); \
      asm volatile("ds_read_b128 %0, %1 offset:3072" : "=v"(a3) : "v"(aad)); \
      asm volatile("s_waitcnt lgkmcnt(0)" : "+v"(b0), "+v"(b1), "+v"(b2), "+v"(b3), "+v"(a0), "+v"(a1), "+v"(a2), "+v"(a3)); \
      __builtin_amdgcn_s_setprio(1); \
      { bf16x8 bb[4] = {b0, b1, b2, b3}; bf16x8 aa[4] = {a0, a1, a2, a3}; \
        _Pragma("unroll") for (int j = 0; j < 4; ++j) \
          _Pragma("unroll") for (int i = 0; i < 4; ++i) acc[i][j] = mfma16(bb[j], aa[i], acc[i][j]); } \
      if (kt + 3 < nk32) GD3(kt + 3, ((J) + 3) & 3);     \
      asm volatile("ds_read_b128 %0, %1 offset:4096" : "=v"(a0) : "v"(aad)); \
      asm volatile("ds_read_b128 %0, %1 offset:5120" : "=v"(a1) : "v"(aad)); \
      asm volatile("ds_read_b128 %0, %1 offset:6144" : "=v"(a2) : "v"(aad)); \
      asm volatile("ds_read_b128 %0, %1 offset:7168" : "=v"(a3) : "v"(aad)); \
      asm volatile("s_waitcnt lgkmcnt(0)" : "+v"(b0), "+v"(b1), "+v"(b2), "+v"(b3), "+v"(a0), "+v"(a1), "+v"(a2), "+v"(a3)); \
      { bf16x8 bb[4] = {b0, b1, b2, b3}; bf16x8 aa[4] = {a0, a1, a2, a3}; \
        _Pragma("unroll") for (int j = 0; j < 4; ++j) \
          _Pragma("unroll") for (int i = 0; i < 4; ++i) acc[4 + i][j] = mfma16(bb[j], aa[i], acc[4 + i][j]); } \
      __builtin_amdgcn_s_setprio(0); }
    for (int kt0 = 0; kt0 < nk32; kt0 += 4) {
      RING_STEP(0) RING_STEP(1) RING_STEP(2) RING_STEP(3)
    }
#undef RING_STEP
#undef GD3
    __syncthreads();
  } else if constexpr (DEPTH == 0) {
    const int swz = (lr >> 1) & 7;
    const u16* Ad = A + (size_t)(tm * BM + lr) * K + ((lc ^ swz) << 3);
    const u16* Bd = Wt + (size_t)(tn * BN + lr) * K + ((lc ^ swz) << 3);
    u16* Al = As + tid * 8;
    u16* Bl = Bs + tid * 8;
#define GD(KT, BUF) { _Pragma("unroll") for (int i = 0; i < NA; ++i) __builtin_amdgcn_global_load_lds((const unsigned*)(Ad + (size_t)i * 64 * K + (KT) * 64), (unsigned*)(Al + (BUF) * BUFSZ + i * 4096), 16, 0, 0); \
                      _Pragma("unroll") for (int i = 0; i < NB; ++i) __builtin_amdgcn_global_load_lds((const unsigned*)(Bd + (size_t)i * 64 * K + (KT) * 64), (unsigned*)(Bl + (BUF) * BUFSZ + i * 4096), 16, 0, 0); }
    GD(0, 0);
    asm volatile("s_waitcnt vmcnt(0)" ::: "memory");
    __syncthreads();
    for (int kt = 0; kt < nk; kt += 2) {
      if (kt + 1 < nk) GD(kt + 1, 1);
      g_compute<FI, FJ, (EPI != EPI_KVUP)>(acc, As + a_row, Bs + b_row, q4, rsw);
      asm volatile("s_waitcnt vmcnt(0)" ::: "memory");
      __syncthreads();
      if (kt + 1 >= nk) break;
      if (kt + 2 < nk) GD(kt + 2, 0);
      g_compute<FI, FJ, (EPI != EPI_KVUP)>(acc, As + BUFSZ + a_row, Bs + BUFSZ + b_row, q4, rsw);
      asm volatile("s_waitcnt vmcnt(0)" ::: "memory");
      __syncthreads();
    }
#undef GD
  } else if constexpr (DEPTH == 2) {
    u32x4 ra0[NA], rb0[NB], ra1[NA], rb1[NB];
    GL(ra0, rb0, 0);
    if (nk > 1) GL(ra1, rb1, 1);
    GS(ra0, rb0, 0);
    __syncthreads();
    for (int kt = 0; kt < nk; kt += 2) {
      if (kt + 2 < nk) GL(ra0, rb0, kt + 2);
      g_compute<FI, FJ, (EPI != EPI_KVUP)>(acc, As + a_row, Bs + b_row, q4, rsw);
      if (kt + 1 < nk) GS(ra1, rb1, 1);
      __syncthreads();
      if (kt + 1 >= nk) break;
      if (kt + 3 < nk) GL(ra1, rb1, kt + 3);
      g_compute<FI, FJ, (EPI != EPI_KVUP)>(acc, As + BUFSZ + a_row, Bs + BUFSZ + b_row, q4, rsw);
      if (kt + 2 < nk) GS(ra0, rb0, 0);
      __syncthreads();
    }
  } else {
    u32x4 ra0[NA], rb0[NB];
    GL(ra0, rb0, 0);
    GS(ra0, rb0, 0);
    __syncthreads();
    for (int kt = 0; kt < nk; kt += 2) {
      if (kt + 1 < nk) GL(ra0, rb0, kt + 1);
      g_compute<FI, FJ, (EPI != EPI_KVUP)>(acc, As + a_row, Bs + b_row, q4, rsw);
      if (kt + 1 < nk) GS(ra0, rb0, 1);
      __syncthreads();
      if (kt + 1 >= nk) break;
      if (kt + 2 < nk) GL(ra0, rb0, kt + 2);
      g_compute<FI, FJ, (EPI != EPI_KVUP)>(acc, As + BUFSZ + a_row, Bs + BUFSZ + b_row, q4, rsw);
      if (kt + 2 < nk) GS(ra0, rb0, 0);
      __syncthreads();
    }
  }
#undef GL
#undef GS
  const int mb = tm * BM + wm * FI * 16 + q4 * 4;
  const int nb = tn * BN + wn * FJ * 16;
  const int mrow = tm * BM + wm * FI * 16 + l15;
  if (EPI == EPI_STORE) {
#pragma unroll
    for (int i = 0; i < FI; ++i)
#pragma unroll
      for (int j = 0; j < FJ; ++j) *(f32x4*)(e.C + (size_t)(mrow + i * 16) * e.ldc + nb + j * 16 + q4 * 4) = acc[i][j];
  } else if (EPI == EPI_RESID) {
    const float cf = e.ldc ? 0.5f : 1.0f;
    const f32x4 cfv = {cf, cf, cf, cf};
#pragma unroll
    for (int i = 0; i < FI; ++i) {
      const int m = mrow + i * 16;
      const float* gt = e.gate + (size_t)grp_of(m) * 9216;
#pragma unroll
      for (int j = 0; j < FJ; ++j) {
        const int n = nb + j * 16 + q4 * 4;
        f32x4 g = *(const f32x4*)(gt + n);
        f32x4* px = (f32x4*)(e.C + (size_t)m * 1024 + n);
        f32x4 xv = *px;
        xv += g * cfv * acc[i][j];
        *px = xv;
      }
    }
  } else if (EPI == EPI_SWIGLU) {
    const bool odd = (q4 & 1) != 0;
#pragma unroll
    for (int j = 0; j < FJ; ++j) {
      const int hj = ((nb >> 4) + j) * 8 + (q4 >> 1) * 4;
#pragma unroll
      for (int i2 = 0; i2 < FI / 2; ++i2) {
        float hv[4];
#pragma unroll
        for (int r = 0; r < 4; ++r) {
          float send = odd ? acc[2 * i2][j][r] : acc[2 * i2 + 1][j][r];
          float recv = shx(send, 16);
          float g = odd ? recv : acc[2 * i2][j][r];
          float u = odd ? acc[2 * i2 + 1][j][r] : recv;
          hv[r] = silu_f(g) * u;
        }
        const int m = mrow + (2 * i2 + (odd ? 1 : 0)) * 16;
        uint2 o; o.x = pack2(hv[0], hv[1]); o.y = pack2(hv[2], hv[3]);
        *(uint2*)(e.H + (size_t)m * 2816 + hj) = o;
      }
    }
  } else if (EPI == EPI_KVUP) {
#pragma unroll
    for (int j = 0; j < FJ; ++j) {
      const int n0 = nb + j * 16;
      const int hh = n0 >> 7, wb = n0 & 127;
#pragma unroll
      for (int i = 0; i < FI; ++i) {
        const int m0 = mb + i * 16;
        int krow; u16* vt;
        if (e.ctx) {
          int b = m0 >> 9, key = m0 & 511;
          krow = NPR + b * 1536 + 1024 + key;
          vt = e.vts + (size_t)((b * 8 + hh) * 64) * 1536 + 1024 + key;
        } else if (m0 < NPR) {
          int b = m0 >> 8, t = m0 & 255;
          krow = m0;
          vt = e.vtp + (size_t)((b * 8 + hh) * 64) * 256 + t;
        } else {
          int s = m0 - NPR, b = s >> 10, t = s & 1023;
          krow = NPR + b * 1536 + t;
          vt = e.vts + (size_t)((b * 8 + hh) * 64) * 1536 + t;
        }
        if (wb < 64) {
#pragma unroll
          for (int r = 0; r < 4; ++r) e.kb[(size_t)(krow + r) * 768 + hh * 96 + wb + l15] = f2bf(acc[i][j][r]);
        } else {
          const int d = wb - 64 + l15;
          const size_t L = (e.ctx || m0 >= NPR) ? 1536 : 256;
          uint2 o; o.x = pack2(acc[i][j][0], acc[i][j][1]); o.y = pack2(acc[i][j][2], acc[i][j][3]);
          *(uint2*)(vt + (size_t)d * L) = o;
        }
      }
    }
  }
}

template <int EPI, int WMW, int WNW, int FI, int FJ, int DEPTH>
__device__ __forceinline__ void gemm_phase(const u16* A, const u16* Wt, int K, int Mt, int Nt, const EpiP& e, char* smem) {
  for (int t = rbid(); t < Mt * Nt; t += (int)gridDim.x) gemm_tile<EPI, WMW, WNW, FI, FJ, DEPTH>(A, Wt, K, t % Mt, t / Mt, e, smem);
}

__device__ __forceinline__ void ffn_in_phase(PRM p, int l, int which, const EpiP& e, char* smem) {
  const u16* Wt = p.wt_ffn_in + (size_t)(l * 2 + which) * 5632 * 1024;
  const int G = (int)gridDim.x;
  const int nfull = (528 / G) * G;
  for (int t = rbid(); t < nfull; t += G) gemm_tile<EPI_SWIGLU, 2, 4, 8, 4, 3>(p.xn, Wt, 1024, t % 24, t / 24, e, smem);
  const int nq = (528 - nfull) * 4;
  const int bid = rbid();
  for (int u = bid; u < nq; u += G) {
    const int t = nfull + (u >> 2), sub = u & 3;
    gemm_tile<EPI_SWIGLU, 4, 2, 2, 4, 2>(p.xn, Wt, 1024, (t % 24) * 2 + (sub >> 1), (t / 24) * 2 + (sub & 1), e, smem);
  }
  const int tail = nq < G ? nq : G;
  if (l < 3 && bid >= tail) {
    const int vb = rtid() >> 8;
    char* vsm = smem + vb * LDS_HALF;
    const int nfree = (G - tail) * 2;
    const int vrank = (bid - tail) * 2 + vb;
    const int cnt = conv_layer_count(l + 1);
    const int half = cnt >> 1;
    const int lo = which ? half : 0, hi = which ? cnt : half;
    for (int c = lo + vrank; c < hi; c += nfree) conv_layer_task(p, l + 1, c, (float*)vsm);
    for (int c = vrank; c < 72; c += nfree) mod_task(p, (l + 1) * 144 + which * 72 + c, (float*)vsm);
  }
}

__device__ __forceinline__ void rope_store_kb(PRM p, float val, int lane, int t, bool sample, int krow) {
  float outv = val;
  if (sample) {
    float partner = shx(val, 8);
    int w = lane & 15, fi = w & 7;
    float pos = (float)((lane & 16) ? (t & 63) : (t >> 6));
    float fr = __expf(-9.210340372f * (float)fi * 0.125f);
    float s, c; sincos_r(pos * fr, s, c);
    outv = (w < 8) ? val * c - partner * s : val * c + partner * s;
  }
  if (lane < 32) {
    u16 b = f2bf(outv);
#pragma unroll
    for (int h = 0; h < 8; ++h) p.kb[(size_t)krow * 768 + h * 96 + 64 + lane] = b;
  }
}

__device__ __forceinline__ void post_even(PRM p, int e) {
  const int tid = get_tid(), lane = tid & 63, wave = tid >> 6;
  const int NT = NTOK / 4;
  const int NC = 256;
  for (int task = get_bid(); task < NT + NC; task += vgrid()) {
    if (task < NT) {
      const int m0 = task * 4, m = m0 + wave;
      const bool pr = m < NPR;
      const int b = pr ? (m >> 8) : ((m - NPR) >> 10);
      const int t = pr ? (m & 255) : ((m - NPR) & 1023);
      const float* row = p.proj + (size_t)m * 2688;
      {
        float4 a0 = *(const float4*)(row + lane * 8), a1 = *(const float4*)(row + lane * 8 + 4);
        uint4 o; o.x = pack2(a0.x, a0.y); o.y = pack2(a0.z, a0.w); o.z = pack2(a1.x, a1.y); o.w = pack2(a1.z, a1.w);
        *(uint4*)(p.qa + (size_t)m * 512 + lane * 8) = o;
        float4 k0 = *(const float4*)(row + 512 + lane * 8), k1 = *(const float4*)(row + 512 + lane * 8 + 4);
        o.x = pack2(k0.x, k0.y); o.y = pack2(k0.z, k0.w); o.z = pack2(k1.x, k1.y); o.w = pack2(k1.z, k1.w);
        *(uint4*)(p.ka + (size_t)m * 512 + lane * 8) = o;
        if (pr) {
          float* ok = p.out + O_AK + ((size_t)(b * 2 + e) * 256 + t) * 512 + lane * 8;
          *(float4*)ok = k0; *(float4*)(ok + 4) = k1;
          float4 v0 = *(const float4*)(row + 1024 + lane * 8), v1 = *(const float4*)(row + 1024 + lane * 8 + 4);
          float* ov = p.out + O_AV + ((size_t)(b * 2 + e) * 256 + t) * 512 + lane * 8;
          *(float4*)ov = v0; *(float4*)(ov + 4) = v1;
        }
      }
      {
        float4 c0 = *(const float4*)(row + 1536 + lane * 12), c1 = *(const float4*)(row + 1536 + lane * 12 + 4), c2 = *(const float4*)(row + 1536 + lane * 12 + 8);
        float ss = c0.x * c0.x + c0.y * c0.y + c0.z * c0.z + c0.w * c0.w + c1.x * c1.x + c1.y * c1.y + c1.z * c1.z + c1.w * c1.w +
                   c2.x * c2.x + c2.y * c2.y + c2.z * c2.z + c2.w * c2.w;
        ss = wsum(ss);
        float r = rsqrtf(ss * (1.f / 768.f) + EPS);
        const float* g = p.b_q_norm + e * 768 + lane * 12;
        float4 g0 = *(const float4*)g, g1 = *(const float4*)(g + 4), g2 = *(const float4*)(g + 8);
        uint2 o0, o1, o2;
        o0.x = pack2(c0.x * r * g0.x, c0.y * r * g0.y); o0.y = pack2(c0.z * r * g0.z, c0.w * r * g0.w);
        o1.x = pack2(c1.x * r * g1.x, c1.y * r * g1.y); o1.y = pack2(c1.z * r * g1.z, c1.w * r * g1.w);
        o2.x = pack2(c2.x * r * g2.x, c2.y * r * g2.y); o2.y = pack2(c2.z * r * g2.z, c2.w * r * g2.w);
        u16* d = p.cqn + (size_t)m * 768 + lane * 12;
        *(uint2*)d = o0; *(uint2*)(d + 4) = o1; *(uint2*)(d + 8) = o2;
      }
      {
        float4 c0 = *(const float4*)(row + 2304 + lane * 4);
        float ss = wsum(c0.x * c0.x + c0.y * c0.y + c0.z * c0.z + c0.w * c0.w);
        float r = rsqrtf(ss * (1.f / 256.f) + EPS);
        float4 g0 = *(const float4*)(p.b_kv_norm + e * 256 + lane * 4);
        float4 y; y.x = c0.x * r * g0.x; y.y = c0.y * r * g0.y; y.z = c0.z * r * g0.z; y.w = c0.w * r * g0.w;
        uint2 o; o.x = pack2(y.x, y.y); o.y = pack2(y.z, y.w);
        *(uint2*)(p.ckvn + (size_t)m * 256 + lane * 4) = o;
        if (pr) *(float4*)(p.out + O_CKV + ((size_t)(b * 2 + e) * 256 + t) * 256 + lane * 4) = y;
      }
      {
        float val = row[2560 + (lane & 31)];
        if (pr && lane < 32) p.out[O_KR + ((size_t)(b * 2 + e) * 256 + t) * 32 + lane] = val;
        rope_store_kb(p, val, lane, t, !pr, keyrow(m));
      }
      {
        const bool pr0 = m0 < NPR;
        const int b0 = pr0 ? (m0 >> 8) : ((m0 - NPR) >> 10);
        const int t0 = pr0 ? (m0 & 255) : ((m0 - NPR) & 1023);
#pragma unroll
        for (int i = 0; i < 2; ++i) {
          int pp = tid + 256 * i, h = pp >> 6, d = pp & 63;
          const float* src = p.proj + (size_t)m0 * 2688 + 1024 + h * 64 + d;
          float v0 = src[0], v1 = src[2688], v2 = src[2 * 2688], v3 = src[3 * 2688];
          uint2 o; o.x = pack2(v0, v1); o.y = pack2(v2, v3);
          u16* dst = pr0 ? p.vta_p + (size_t)((b0 * 8 + h) * 64 + d) * 256 + t0 : p.vta_s + (size_t)((b0 * 8 + h) * 64 + d) * 1536 + t0;
          *(uint2*)dst = o;
        }
      }
    } else {
      const int ct = task - NT;
      const int b = ct >> 7, key0 = (ct & 127) * 4;
      {
        const float* src = p.cache_a_k + ((size_t)(b * 2 + e) * 512 + key0) * 512;
        u16* dst = p.kactx + ((size_t)b * 512 + key0) * 512;
#pragma unroll
        for (int i = 0; i < 2; ++i) {
          int idx = (tid + 256 * i) * 4;
          float4 v = *(const float4*)(src + idx);
          uint2 o; o.x = pack2(v.x, v.y); o.y = pack2(v.z, v.w);
          *(uint2*)(dst + idx) = o;
        }
      }
      {
        const float* src = p.cache_a_v + ((size_t)(b * 2 + e) * 512 + key0) * 512;
#pragma unroll
        for (int i = 0; i < 2; ++i) {
          int pp = tid + 256 * i, h = pp >> 6, d = pp & 63;
          float v0 = src[pp], v1 = src[512 + pp], v2 = src[1024 + pp], v3 = src[1536 + pp];
          uint2 o; o.x = pack2(v0, v1); o.y = pack2(v2, v3);
          *(uint2*)(p.vta_s + (size_t)((b * 8 + h) * 64 + d) * 1536 + 1024 + key0) = o;
        }
      }
      {
        const float* src = p.cache_b_ckv + ((size_t)(b * 2 + e) * 512 + key0) * 256;
        float4 v = *(const float4*)(src + tid * 4);
        uint2 o; o.x = pack2(v.x, v.y); o.y = pack2(v.z, v.w);
        *(uint2*)(p.cctxn + ((size_t)b * 512 + key0) * 256 + tid * 4) = o;
      }
      {
        const float* src = p.cache_b_krope + ((size_t)(b * 2 + e) * 512 + key0) * 32;
#pragma unroll
        for (int i = 0; i < 4; ++i) {
          int idx = tid + 256 * i;
          int kk = idx >> 8, h = (idx >> 5) & 7, dd = idx & 31;
          p.kb[(size_t)(NPR + b * 1536 + 1024 + key0 + kk) * 768 + h * 96 + 64 + dd] = f2bf(src[kk * 32 + dd]);
        }
      }
    }
  }
}

__device__ __forceinline__ void post_odd(PRM p, int o) {
  const int tid = get_tid(), lane = tid & 63, wave = tid >> 6;
  const int NT = NTOK / 4, NC = 256;
  for (int task = get_bid(); task < NT + NC; task += vgrid()) {
    if (task < NT) {
      const int m0 = task * 4, m = m0 + wave;
      const bool pr = m < NPR;
      const int b = pr ? (m >> 8) : ((m - NPR) >> 10);
      const int t = pr ? (m & 255) : ((m - NPR) & 1023);
      const float* row = p.proj + (size_t)m * 2432;
      float rs = 0.f, rc = 1.f;
      if (!pr) {
        int w = lane & 31, fi = w & 15;
        float pos = (float)((lane & 32) ? (t & 63) : (t >> 6));
        float fr = __expf(-9.210340372f * (float)fi * (1.f / 16.f));
        sincos_r(pos * fr, rs, rc);
      }
      const bool lo = (lane & 16) == 0;
      const float gq = p.d_q_norm[o * 64 + lane], gk = p.d_k_norm[o * 64 + lane];
#pragma unroll
      for (int hd = 0; hd < 8; ++hd) {
        float v = row[1552 + hd * 64 + lane];
        float ss = wsum(v * v);
        float y = v * rsqrtf(ss * (1.f / 64.f) + EPS) * gq;
        if (!pr) { float pt = shx(y, 16); y = lo ? y * rc - pt * rs : y * rc + pt * rs; }
        p.qa[(size_t)m * 512 + hd * 64 + lane] = f2bf(y);
      }
#pragma unroll
      for (int kh = 0; kh < 2; ++kh) {
        float v = row[2064 + kh * 64 + lane];
        float ss = wsum(v * v);
        float y = v * rsqrtf(ss * (1.f / 64.f) + EPS) * gk;
        if (pr) p.out[O_DK + ((size_t)(b * 2 + o) * 256 + t) * 128 + kh * 64 + lane] = y;
        else { float pt = shx(y, 16); y = lo ? y * rc - pt * rs : y * rc + pt * rs; }
        p.kd[(size_t)keyrow(m) * 128 + kh * 64 + lane] = f2bf(y);
        if (pr) p.out[O_DV + ((size_t)(b * 2 + o) * 256 + t) * 128 + kh * 64 + lane] = row[2192 + kh * 64 + lane];
      }
      if (tid < 128) {
        const bool pr0 = m0 < NPR;
        const int b0 = pr0 ? (m0 >> 8) : ((m0 - NPR) >> 10);
        const int t0 = pr0 ? (m0 & 255) : ((m0 - NPR) & 1023);
        int kh = tid >> 6, d = tid & 63;
        const float* src = p.proj + (size_t)m0 * 2432 + 2192 + tid;
        float v0 = src[0], v1 = src[2432], v2 = src[2 * 2432], v3 = src[3 * 2432];
        uint2 oo; oo.x = pack2(v0, v1); oo.y = pack2(v2, v3);
        u16* dst = pr0 ? p.vtd_p + (size_t)((b0 * 2 + kh) * 64 + d) * 256 + t0 : p.vtd_s + (size_t)((b0 * 2 + kh) * 64 + d) * 1536 + t0;
        *(uint2*)dst = oo;
      }
    } else {
      const int ct = task - NT;
      const int b = ct >> 7, key0 = (ct & 127) * 4;
      {
        const float* src = p.cache_d_k + ((size_t)(b * 2 + o) * 512 + key0) * 128;
        if (tid < 128) {
          float4 v = *(const float4*)(src + tid * 4);
          uint2 oo; oo.x = pack2(v.x, v.y); oo.y = pack2(v.z, v.w);
          *(uint2*)(p.kd + (size_t)(NPR + b * 1536 + 1024 + key0) * 128 + tid * 4) = oo;
        } else {
          int pp = tid - 128, kh = pp >> 6, d = pp & 63;
          const float* sv = p.cache_d_v + ((size_t)(b * 2 + o) * 512 + key0) * 128;
          float v0 = sv[pp], v1 = sv[128 + pp], v2 = sv[256 + pp], v3 = sv[384 + pp];
          uint2 oo; oo.x = pack2(v0, v1); oo.y = pack2(v2, v3);
          *(uint2*)(p.vtd_s + (size_t)((b * 2 + kh) * 64 + d) * 1536 + 1024 + key0) = oo;
        }
      }
    }
  }
}

struct AttnSt { float m, l; f32x4 o[4]; };
template <int KS> struct KVf { bf16x8 k0[KS], k1[KS]; s16x4 v0[4], v1[4]; };

template <int KS>
__device__ __forceinline__ void attn_load(KVf<KS>& f, const u16* __restrict__ Kb, int kstride, const u16* __restrict__ Vtb, int vtstride, int l15, int q4) {
  const u16* k0p = Kb + (size_t)l15 * kstride + q4 * 8;
  const u16* k1p = k0p + (size_t)16 * kstride;
#pragma unroll
  for (int ks = 0; ks < KS; ++ks) { f.k0[ks] = *(const bf16x8*)(k0p + ks * 32); f.k1[ks] = *(const bf16x8*)(k1p + ks * 32); }
#pragma unroll
  for (int dt = 0; dt < 4; ++dt) {
    const u16* vp = Vtb + (size_t)(dt * 16 + l15) * vtstride + q4 * 4;
    f.v0[dt] = *(const s16x4*)vp; f.v1[dt] = *(const s16x4*)(vp + 16);
  }
}

template <int KS>
__device__ __forceinline__ void attn_comp(AttnSt& st, const bf16x8 (&qf)[KS], const KVf<KS>& f, float scale, int q4,
                                          bool masked, const float* rpbrow, int qc, int kc0) {
  f32x4 s0 = {0.f, 0.f, 0.f, 0.f}, s1 = {0.f, 0.f, 0.f, 0.f};
#pragma unroll
  for (int ks = 0; ks < KS; ++ks) { s0 = mfma16(f.k0[ks], qf[ks], s0); s1 = mfma16(f.k1[ks], qf[ks], s1); }
  float sv[8];
#pragma unroll
  for (int j = 0; j < 4; ++j) { sv[j] = s0[j] * scale; sv[4 + j] = s1[j] * scale; }
  if (masked) {
    const int cs = min(max(qc - 8, 0), 48);
#pragma unroll
    for (int e = 0; e < 8; ++e) {
      int kc = kc0 + (e >> 2) * 16 + q4 * 4 + (e & 3);
      bool ok = (kc >= cs) && (kc < cs + 16);
      int di = min(max(kc - qc, -15), 15) + 15;
      sv[e] = ok ? sv[e] + rpbrow[di] : -INFINITY;
    }
  }
  float mx = sv[0];
#pragma unroll
  for (int e = 1; e < 8; ++e) mx = fmaxf(mx, sv[e]);
  mx = fmaxf(mx, shx(mx, 16));
  mx = fmaxf(mx, shx(mx, 32));
  const float mnew = fmaxf(st.m, mx);
  const float alpha = __expf(st.m - mnew);
  float pe[8], ls = 0.f;
#pragma unroll
  for (int e = 0; e < 8; ++e) { pe[e] = __expf(sv[e] - mnew); ls += pe[e]; }
  st.l = st.l * alpha + ls;
  st.m = mnew;
  bf16x8 pf;
#pragma unroll
  for (int e = 0; e < 8; ++e) pf[e] = (short)f2bf(pe[e]);
#pragma unroll
  for (int dt = 0; dt < 4; ++dt) {
    bf16x8 vf = (bf16x8){f.v0[dt].x, f.v0[dt].y, f.v0[dt].z, f.v0[dt].w, f.v1[dt].x, f.v1[dt].y, f.v1[dt].z, f.v1[dt].w};
    st.o[dt] *= alpha;
    st.o[dt] = mfma16(vf, pf, st.o[dt]);
  }
}

__device__ __forceinline__ void attn_init(AttnSt& st) {
  st.m = -1e30f; st.l = 0.f;
#pragma unroll
  for (int dt = 0; dt < 4; ++dt) st.o[dt] = (f32x4){0.f, 0.f, 0.f, 0.f};
}
__device__ __forceinline__ void attn_fin(AttnSt& st, u16* outp  , int l15, int q4) {
  float lt = st.l;
  lt += shx(lt, 16);
  lt += shx(lt, 32);
  const float inv = 1.f / lt;
#pragma unroll
  for (int dt = 0; dt < 4; ++dt) {
    uint2 o; o.x = pack2(st.o[dt][0] * inv, st.o[dt][1] * inv); o.y = pack2(st.o[dt][2] * inv, st.o[dt][3] * inv);
    *(uint2*)(outp + (size_t)l15 * 1024 + dt * 16 + q4 * 4) = o;
  }
}

#define AT_VSTR 72
template <int KS> struct ATile { static constexpr int KSTR = KS * 32 + 8; static constexpr int BUF = 64 * (KS * 32 + 8) + 64 * AT_VSTR; };
template <int KS> struct AStage { u32x4 k[KS]; u32x4 v[2]; };

template <int KS>
__device__ __forceinline__ void at_load(AStage<KS>& r, const u16* __restrict__ Kg, int kstride, const u16* __restrict__ Vg, int vtstride, int tid) {
#pragma unroll
  for (int i = 0; i < KS; ++i) {
    int c = tid + 256 * i; int row = c / (KS * 4), ch = c - row * (KS * 4);
    r.k[i] = *(const u32x4*)(Kg + (unsigned)(row * kstride + ch * 8));
  }
#pragma unroll
  for (int i = 0; i < 2; ++i) {
    int c = tid + 256 * i; int row = c >> 3, ch = c & 7;
    r.v[i] = *(const u32x4*)(Vg + (unsigned)(row * vtstride + ch * 8));
  }
}
template <int KS>
__device__ __forceinline__ void at_store(const AStage<KS>& r, u16* buf, int tid) {
  u16* Ks = buf; u16* Vs = buf + 64 * ATile<KS>::KSTR;
#pragma unroll
  for (int i = 0; i < KS; ++i) {
    int c = tid + 256 * i; int row = c / (KS * 4), ch = c - row * (KS * 4);
    *(u32x4*)(Ks + row * ATile<KS>::KSTR + ch * 8) = r.k[i];
  }
#pragma unroll
  for (int i = 0; i < 2; ++i) {
    int c = tid + 256 * i; int row = c >> 3, ch = c & 7;
    *(u32x4*)(Vs + row * AT_VSTR + ch * 8) = r.v[i];
  }
}

template <int KS>
__device__ __forceinline__ void at_comp(AttnSt& st, const bf16x8 (&qf)[KS], const u16* buf, float scale, int l15, int q4,
                                        bool masked, const float* rpbrow, int qc) {
  const u16* Ks = buf; const u16* Vs = buf + 64 * ATile<KS>::KSTR;
  f32x4 s[4];
#pragma unroll
  for (int kt = 0; kt < 4; ++kt) {
    s[kt] = (f32x4){0.f, 0.f, 0.f, 0.f};
#pragma unroll
    for (int ks = 0; ks < KS; ++ks) {
      bf16x8 a = *(const bf16x8*)(Ks + (kt * 16 + l15) * ATile<KS>::KSTR + ks * 32 + q4 * 8);
      s[kt] = mfma16(a, qf[ks], s[kt]);
    }
  }
  float sv[16];
  const float sc2 = scale * 1.4426950408889634f;
#pragma unroll
  for (int kt = 0; kt < 4; ++kt)
#pragma unroll
    for (int j = 0; j < 4; ++j) sv[kt * 4 + j] = s[kt][j] * sc2;
  if (masked) {
    const int cs = min(max(qc - 8, 0), 48);
#pragma unroll
    for (int e = 0; e < 16; ++e) {
      int kc = (e >> 2) * 16 + q4 * 4 + (e & 3);
      bool ok = (kc >= cs) && (kc < cs + 16);
      int di = min(max(kc - qc, -15), 15) + 15;
      sv[e] = ok ? sv[e] + rpbrow[di] : -INFINITY;
    }
  }
  float mx = sv[0];
#pragma unroll
  for (int e = 1; e < 16; ++e) mx = fmaxf(mx, sv[e]);
  mx = fmaxf(mx, shx(mx, 16));
  mx = fmaxf(mx, shx(mx, 32));
  const float mnew = fmaxf(st.m, mx);
  const float alpha = __builtin_amdgcn_exp2f(st.m - mnew);
  float ls = 0.f;
#pragma unroll
  for (int e = 0; e < 16; ++e) { sv[e] = __builtin_amdgcn_exp2f(sv[e] - mnew); ls += sv[e]; }
  st.l = st.l * alpha + ls;
  st.m = mnew;
  bf16x8 pf[2];
#pragma unroll
  for (int hf = 0; hf < 2; ++hf) {
    u32x4 pw;
    pw[0] = pack2(sv[hf * 8 + 0], sv[hf * 8 + 1]); pw[1] = pack2(sv[hf * 8 + 2], sv[hf * 8 + 3]);
    pw[2] = pack2(sv[hf * 8 + 4], sv[hf * 8 + 5]); pw[3] = pack2(sv[hf * 8 + 6], sv[hf * 8 + 7]);
    pf[hf] = __builtin_bit_cast(bf16x8, pw);
  }
#pragma unroll
  for (int dt = 0; dt < 4; ++dt) {
    st.o[dt] *= alpha;
#pragma unroll
    for (int hf = 0; hf < 2; ++hf) {
      const u16* vp = Vs + (dt * 16 + l15) * AT_VSTR + hf * 32 + q4 * 4;
      s16x4 v0 = *(const s16x4*)vp;
      s16x4 v1 = *(const s16x4*)(vp + 16);
      bf16x8 vf = (bf16x8){v0.x, v0.y, v0.z, v0.w, v1.x, v1.y, v1.z, v1.w};
      st.o[dt] = mfma16(vf, pf[hf], st.o[dt]);
    }
  }
}

template <int KS>
__device__ __forceinline__ void at_run_plain(AttnSt& st, const bf16x8 (&qf)[KS], const u16* Kbase, int kstride, const u16* Vbase, int vtstride,
                                             int nt, float scale, u16* lds, int tid, int l15, int q4) {
  AStage<KS> r0, r1;
  at_load<KS>(r0, Kbase, kstride, Vbase, vtstride, tid);
  if (nt > 1) at_load<KS>(r1, Kbase + (size_t)64 * kstride, kstride, Vbase + 64, vtstride, tid);
  at_store<KS>(r0, lds, tid);
  __syncthreads();
  for (int t = 0; t < nt; t += 2) {
    if (t + 2 < nt) at_load<KS>(r0, Kbase + (size_t)(t + 2) * 64 * kstride, kstride, Vbase + (t + 2) * 64, vtstride, tid);
    at_comp<KS>(st, qf, lds, scale, l15, q4, false, nullptr, 0);
    if (t + 1 < nt) at_store<KS>(r1, lds + ATile<KS>::BUF, tid);
    __syncthreads();
    if (t + 1 >= nt) break;
    if (t + 3 < nt) at_load<KS>(r1, Kbase + (size_t)(t + 3) * 64 * kstride, kstride, Vbase + (t + 3) * 64, vtstride, tid);
    at_comp<KS>(st, qf, lds + ATile<KS>::BUF, scale, l15, q4, false, nullptr, 0);
    if (t + 2 < nt) at_store<KS>(r0, lds, tid);
    __syncthreads();
  }
}

__device__ __forceinline__ void load_q64(bf16x8 (&qf)[2], const u16* Q, int qstride, int l15, int q4) {
#pragma unroll
  for (int ks = 0; ks < 2; ++ks) qf[ks] = *(const bf16x8*)(Q + (size_t)l15 * qstride + ks * 32 + q4 * 8);
}
__device__ __forceinline__ void load_q_mla(bf16x8 (&qf)[3], const float* Qf, int l15, int q4, bool sample, int t0) {
  const float* qr = Qf + (size_t)l15 * 768 + q4 * 8;
#pragma unroll
  for (int ks = 0; ks < 3; ++ks) {
    float4 a = *(const float4*)(qr + ks * 32), b = *(const float4*)(qr + ks * 32 + 4);
    float v[8] = {a.x, a.y, a.z, a.w, b.x, b.y, b.z, b.w};
    if (ks == 2 && sample) {
      const int t = t0 + l15;
      const float pos = (float)((q4 & 2) ? (t & 63) : (t >> 6));
#pragma unroll
      for (int jj = 0; jj < 8; ++jj) {
        float pt = shx(v[jj], 16);
        float fr = __expf(-9.210340372f * (float)jj * 0.125f);
        float sn, cs; sincos_r(pos * fr, sn, cs);
        v[jj] = (q4 & 1) ? v[jj] * cs + pt * sn : v[jj] * cs - pt * sn;
      }
    }
#pragma unroll
    for (int jj = 0; jj < 8; ++jj) qf[ks][jj] = (short)f2bf(v[jj]);
  }
}

__device__ __forceinline__ void attn_even_phase(PRM p, int e, char* smem) {
  u16* lds = (u16*)smem;
  const int tid = get_tid(), lane = tid & 63, wave = tid >> 6, l15 = lane & 15, q4 = lane >> 4;
  const float scaleB = 0.10206207261596577f;
  for (int bt = get_bid(); bt < 1536; bt += vgrid()) {
    AttnSt st; attn_init(st);
    if (bt < 256) {
      int qb = bt & 15, h = (bt >> 4) & 7, b = bt >> 7;
      int mq = NPR + b * 1024 + qb * 64 + wave * 16;
      bf16x8 qf[3]; load_q_mla(qf, p.qb + (size_t)mq * 768 + h * 96, l15, q4, true, qb * 64 + wave * 16);
      at_run_plain<3>(st, qf, p.kb + (size_t)(NPR + b * 1536) * 768 + h * 96, 768, p.vtb_s + (size_t)((b * 8 + h) * 64) * 1536, 1536, 24, scaleB, lds, tid, l15, q4);
      attn_fin(st, p.mix + (size_t)mq * 1024 + 512 + h * 64, l15, q4);
    } else if (bt < 512) {
      int u = bt - 256;
      int r = u & 15, h = (u >> 4) & 7, b = u >> 7;
      int mq = NPR + b * 1024 + r * 64 + wave * 16;
      bf16x8 qf[2]; load_q64(qf, p.qa + (size_t)mq * 512 + h * 64, 512, l15, q4);
      const u16* Vt = p.vta_s + (size_t)((b * 8 + h) * 64) * 1536;
      const u16* Kc = p.kactx + (size_t)b * 512 * 512 + h * 64;
      const int rs = min(max(r - 4, 0), 8);
      const u16* Kw = p.ka + (size_t)(NPR + b * 1024 + rs * 64) * 512 + h * 64;
      const float* rpb0 = p.a_rpb + ((size_t)(e * 8 + h) * 15 + (rs - r + 7)) * 31;
      const int qc = wave * 16 + l15;
      float* rpl = (float*)(lds + 2 * ATile<2>::BUF);
      if (tid < 248) { int rr = tid / 31, cc = tid - rr * 31; rpl[rr * 32 + cc] = rpb0[rr * 31 + cc] * 1.4426950408889634f; }
      AStage<2> r0, r1;
#define NB_LOAD(R, T) { if ((T) < 8) at_load<2>(R, Kc + (size_t)(T) * 64 * 512, 512, Vt + 1024 + (T) * 64, 1536, tid); \
                        else at_load<2>(R, Kw + (size_t)((T) - 8) * 64 * 512, 512, Vt + (rs + (T) - 8) * 64, 1536, tid); }
#define NB_COMP(BUFP, T) { if ((T) < 8) at_comp<2>(st, qf, BUFP, 0.125f, l15, q4, false, nullptr, 0); \
                           else at_comp<2>(st, qf, BUFP, 0.125f, l15, q4, true, rpl + ((T) - 8) * 32, qc); }
      NB_LOAD(r0, 0);
      NB_LOAD(r1, 1);
      at_store<2>(r0, lds, tid);
      __syncthreads();
      for (int t = 0; t < 16; t += 2) {
        if (t + 2 < 16) NB_LOAD(r0, t + 2);
        NB_COMP(lds, t);
        at_store<2>(r1, lds + ATile<2>::BUF, tid);
        __syncthreads();
        if (t + 3 < 16) NB_LOAD(r1, t + 3);
        NB_COMP(lds + ATile<2>::BUF, t + 1);
        if (t + 2 < 16) at_store<2>(r0, lds, tid);
        __syncthreads();
      }
#undef NB_LOAD
#undef NB_COMP
      attn_fin(st, p.mix + (size_t)mq * 1024 + h * 64, l15, q4);
    } else if (bt < 1024) {
      int u = bt - 512;
      int qb = u & 3, h = (u >> 2) & 7, b = u >> 5;
      int mq = b * 256 + qb * 64 + wave * 16;
      bf16x8 qf[3]; load_q_mla(qf, p.qb + (size_t)mq * 768 + h * 96, l15, q4, false, 0);
      at_run_plain<3>(st, qf, p.kb + (size_t)(b * 256) * 768 + h * 96, 768, p.vtb_p + (size_t)((b * 8 + h) * 64) * 256, 256, 4, scaleB, lds, tid, l15, q4);
      attn_fin(st, p.mix + (size_t)mq * 1024 + 512 + h * 64, l15, q4);
    } else {
      int u = bt - 1024;
      int qb = u & 3, h = (u >> 2) & 7, b = u >> 5;
      int mq = b * 256 + qb * 64 + wave * 16;
      bf16x8 qf[2]; load_q64(qf, p.qa + (size_t)mq * 512 + h * 64, 512, l15, q4);
      at_run_plain<2>(st, qf, p.ka + (size_t)(b * 256) * 512 + h * 64, 512, p.vta_p + (size_t)((b * 8 + h) * 64) * 256, 256, 4, 0.125f, lds, tid, l15, q4);
      attn_fin(st, p.mix + (size_t)mq * 1024 + h * 64, l15, q4);
    }
  }
}

__device__ __forceinline__ int mslot(int sq, int h, int dir, int j) {
  return sq < 16 ? ((sq * 4 + h) * 2 + dir) * 4 + j : 512 + (((sq - 16) * 4 + h) * 2 + dir) * 16 + j;
}

__device__ __forceinline__ void mlstm1_task(PRM p, int o, int task, float* sm) {
  const int tid = get_tid(), lane = tid & 63, wave = tid >> 6;
  int sq, h, dir, j;
  if (task < 512) { j = task & 3; dir = (task >> 2) & 1; h = (task >> 3) & 3; sq = task >> 5; }
  else { int u = task - 512; j = u & 15; dir = (u >> 4) & 1; h = (u >> 5) & 3; sq = 16 + (u >> 7); }
  const int T = sq < 16 ? 256 : 1024;
  const int base = sq < 16 ? sq * 256 : NPR + (sq - 16) * 1024;
  const int slot = task;
  float* ks = sm;
  float* vs = sm + 4096;
  float* wg = sm + 4096 + 8192;
  if (wave == 0) {
    int s = 64 * j + lane;
    int t = dir ? T - 1 - s : s;
    const float* row = p.proj + (size_t)(base + t) * 2432 + 1536;
    float ig = row[(dir * 2 + 0) * 4 + h] + p.c_gate_bias[o * 16 + (dir * 2 + 0) * 4 + h];
    float fg = row[(dir * 2 + 1) * 4 + h] + p.c_gate_bias[o * 16 + (dir * 2 + 1) * 4 + h];
    float bsum = logsig_f(fg);
#pragma unroll
    for (int off = 1; off < 64; off <<= 1) { float v = __shfl_up(bsum, off); if (lane >= off) bsum += v; }
    float blast = __shfl(bsum, 63);
    float g = blast - bsum + ig;
    float ml = wmaxr(g);
    wg[lane] = __expf(g - ml);
    if (lane == 0) { p.dm[slot * 2] = ml; p.dm[slot * 2 + 1] = blast; }
  }
#pragma unroll
  for (int ii = 0; ii < 4; ++ii) {
    int i = (tid >> 4) + 16 * ii, c4 = tid & 15;
    int s = 64 * j + i; int t = dir ? T - 1 - s : s;
    float4 v = *(const float4*)(p.proj + (size_t)(base + t) * 2432 + 256 + h * 64 + c4 * 4);
    v.x *= 0.125f; v.y *= 0.125f; v.z *= 0.125f; v.w *= 0.125f;
    *(float4*)(ks + i * 64 + c4 * 4) = v;
  }
#pragma unroll
  for (int ii = 0; ii < 8; ++ii) {
    int i = (tid >> 5) + 8 * ii, c4 = tid & 31;
    int s = 64 * j + i; int t = dir ? T - 1 - s : s;
    *(float4*)(vs + i * 128 + c4 * 4) = *(const float4*)(p.proj + (size_t)(base + t) * 2432 + 512 + h * 128 + c4 * 4);
  }
  __syncthreads();
  const int dg = tid & 15, vg8 = tid >> 4;
  f32x4 acc[8];
#pragma unroll
  for (int q = 0; q < 8; ++q) acc[q] = (f32x4){0.f, 0.f, 0.f, 0.f};
  f32x4 nacc = {0.f, 0.f, 0.f, 0.f};
#pragma unroll 4
  for (int i = 0; i < 64; ++i) {
    f32x4 kd = *(const f32x4*)(ks + i * 64 + dg * 4) * wg[i];
    nacc += kd;
    f32x4 va = *(const f32x4*)(vs + i * 128 + vg8 * 8);
    f32x4 vb = *(const f32x4*)(vs + i * 128 + vg8 * 8 + 4);
    acc[0] += kd * va[0]; acc[1] += kd * va[1]; acc[2] += kd * va[2]; acc[3] += kd * va[3];
    acc[4] += kd * vb[0]; acc[5] += kd * vb[1]; acc[6] += kd * vb[2]; acc[7] += kd * vb[3];
  }
  float* dc = p.dC + (size_t)slot * 8192;
#pragma unroll
  for (int q = 0; q < 8; ++q) *(f32x4*)(dc + (vg8 * 8 + q) * 64 + dg * 4) = acc[q];
  if (vg8 == 0) *(f32x4*)(p.dn + slot * 64 + dg * 4) = nacc;
  __syncthreads();
}

__device__ __forceinline__ void mlstm2_task(PRM p, int o, int task, float* sm) {
  const int tid = get_tid(), lane = tid & 63, wave = tid >> 6;
  int sq, h, c;
  if (task < 256) { c = task & 3; h = (task >> 2) & 3; sq = task >> 4; }
  else { int u = task - 256; c = u & 15; h = (u >> 4) & 3; sq = 16 + (u >> 6); }
  const bool pr = sq < 16;
  const int nc = pr ? 4 : 16;
  const int base = (pr ? sq * 256 : NPR + (sq - 16) * 1024) + c * 64;
  float* qT = sm;
  float* kT = sm + 4352;
  float* CT = kT;
  float* St = sm + 2 * 4352;
  float* vh = sm + 3 * 4352;
  float* smalls = sm + 4 * 4352;
  float* bl = smalls;
  float* itb = smalls + 64;
  float* mt = smalls + 128;
  float* w0 = smalls + 192;
  float* nv = smalls + 256;
  float* nq = smalls + 320;
  float* den = smalls + 384;
  float* scal = smalls + 448;

  const int tl = tid >> 4, tx = tid & 15;
  const int l0 = tl * 4, x0 = tx * 4;
  float hacc[2][4][4];
#pragma unroll
  for (int a = 0; a < 2; ++a)
#pragma unroll
    for (int b2 = 0; b2 < 4; ++b2)
#pragma unroll
      for (int c2 = 0; c2 < 4; ++c2) hacc[a][b2][c2] = 0.f;

  f32x4 qv[4], kv[4];
#pragma unroll
  for (int ii = 0; ii < 4; ++ii) {
    int i = (tid >> 4) + 16 * ii, c4 = tid & 15;
    const float* row = p.proj + (size_t)(base + i) * 2432 + h * 64 + c4 * 4;
    qv[ii] = *(const f32x4*)row;
    kv[ii] = *(const f32x4*)(row + 256);
  }
#pragma unroll
  for (int ii = 0; ii < 4; ++ii) {
    int i = (tid >> 4) + 16 * ii, c4 = tid & 15;
    qT[(c4 * 4 + 0) * 68 + i] = qv[ii].x; qT[(c4 * 4 + 1) * 68 + i] = qv[ii].y; qT[(c4 * 4 + 2) * 68 + i] = qv[ii].z; qT[(c4 * 4 + 3) * 68 + i] = qv[ii].w;
  }
#pragma unroll 1
  for (int dir = 0; dir < 2; ++dir) {
    const int j = dir ? nc - 1 - c : c;
    const int slj = mslot(sq, h, dir, j);
    const float mprev = p.mp[slj];
    float cr[16]; f32x4 vr[4];
    const float* cpp = p.cp + (size_t)slj * 8192;
#pragma unroll
    for (int r = 0; r < 16; ++r) cr[r] = cpp[tid + 256 * r];
#pragma unroll
    for (int ii = 0; ii < 4; ++ii) {
      int i = (tid >> 4) + 16 * ii, c4 = tid & 15;
      vr[ii] = *(const f32x4*)(p.proj + (size_t)(base + i) * 2432 + 512 + h * 128 + c4 * 4);
    }
    if (wave == 0) {
      const int i = lane;
      const int tau = dir ? 63 - i : i;
      const float* row = p.proj + (size_t)(base + tau) * 2432 + 1536;
      float ig = row[(dir * 2 + 0) * 4 + h] + p.c_gate_bias[o * 16 + (dir * 2 + 0) * 4 + h];
      float fg = row[(dir * 2 + 1) * 4 + h] + p.c_gate_bias[o * 16 + (dir * 2 + 1) * 4 + h];
      float bsum = logsig_f(fg);
#pragma unroll
      for (int off = 1; off < 64; off <<= 1) { float v = __shfl_up(bsum, off); if (lane >= off) bsum += v; }
      float ib = ig - bsum;
      float pm = ib;
#pragma unroll
      for (int off = 1; off < 64; off <<= 1) { float v = __shfl_up(pm, off); if (lane >= off) pm = fmaxf(pm, v); }
      float mti = fmaxf(bsum + mprev, bsum + pm);
      bl[tau] = bsum; itb[tau] = ib; mt[tau] = mti; w0[tau] = __expf(bsum + mprev - mti);
    }
#pragma unroll
    for (int ii = 0; ii < 4; ++ii) {
      int i = (tid >> 4) + 16 * ii, c4 = tid & 15;
      kT[(c4 * 4 + 0) * 68 + i] = kv[ii].x * 0.125f; kT[(c4 * 4 + 1) * 68 + i] = kv[ii].y * 0.125f;
      kT[(c4 * 4 + 2) * 68 + i] = kv[ii].z * 0.125f; kT[(c4 * 4 + 3) * 68 + i] = kv[ii].w * 0.125f;
    }
    if (tid < 64) nv[tid] = p.np[slj * 64 + tid];
    __syncthreads();
    {
      float a[4][4];
#pragma unroll
      for (int r = 0; r < 4; ++r)
#pragma unroll
        for (int q = 0; q < 4; ++q) a[r][q] = 0.f;
#pragma unroll 2
      for (int d = 0; d < 64; ++d) {
        float4 q4v = *(const float4*)(qT + d * 68 + l0);
        float4 k4v = *(const float4*)(kT + d * 68 + x0);
        float qa[4] = {q4v.x, q4v.y, q4v.z, q4v.w}, kk[4] = {k4v.x, k4v.y, k4v.z, k4v.w};
#pragma unroll
        for (int r = 0; r < 4; ++r)
#pragma unroll
          for (int q = 0; q < 4; ++q) a[r][q] = fmaf(qa[r], kk[q], a[r][q]);
      }
      float rsum[4];
#pragma unroll
      for (int r = 0; r < 4; ++r) {
        const int l = l0 + r;
        const float bll = bl[l], mtl = mt[l];
        rsum[r] = 0.f;
#pragma unroll
        for (int q = 0; q < 4; ++q) {
          const int s = x0 + q;
          const bool ok = dir ? (s >= l) : (s <= l);
          float sv = ok ? a[r][q] * __expf(bll + itb[s] - mtl) : 0.f;
          St[s * 68 + l] = sv;
          rsum[r] += sv;
        }
        rsum[r] += shx(rsum[r], 1); rsum[r] += shx(rsum[r], 2);
        rsum[r] += shx(rsum[r], 4); rsum[r] += shx(rsum[r], 8);
        if (tx == 0) den[l] = rsum[r];
      }
    }
    __syncthreads();
    if (tid < 64) {
      float s = 0.f;
#pragma unroll 4
      for (int d = 0; d < 64; ++d) s = fmaf(qT[d * 68 + tid], nv[d], s);
      nq[tid] = s;
    }
#pragma unroll 1
    for (int vhalf = 0; vhalf < 2; ++vhalf) {
#pragma unroll
      for (int r = 0; r < 16; ++r) {
        int e = tid + 256 * r;
        CT[(e & 63) * 68 + (e >> 6)] = cr[r];
      }
#pragma unroll
      for (int ii = 0; ii < 4; ++ii) {
        int i = (tid >> 4) + 16 * ii, c4 = tid & 15;
        *(f32x4*)(vh + i * 68 + c4 * 4) = vr[ii];
      }
      if (vhalf == 0) {
#pragma unroll
        for (int r = 0; r < 16; ++r) cr[r] = cpp[4096 + tid + 256 * r];
#pragma unroll
        for (int ii = 0; ii < 4; ++ii) {
          int i = (tid >> 4) + 16 * ii, c4 = tid & 15;
          vr[ii] = *(const f32x4*)(p.proj + (size_t)(base + i) * 2432 + 512 + h * 128 + 64 + c4 * 4);
        }
      }
      __syncthreads();
      {
        float a1[4][4], a2[4][4];
#pragma unroll
        for (int r = 0; r < 4; ++r)
#pragma unroll
          for (int q = 0; q < 4; ++q) { a1[r][q] = 0.f; a2[r][q] = 0.f; }
#pragma unroll 2
        for (int s = 0; s < 64; ++s) {
          float4 sa = *(const float4*)(St + s * 68 + l0);
          float4 vb = *(const float4*)(vh + s * 68 + x0);
          float4 qa4 = *(const float4*)(qT + s * 68 + l0);
          float4 cb4 = *(const float4*)(CT + s * 68 + x0);
          float sl4[4] = {sa.x, sa.y, sa.z, sa.w}, vv[4] = {vb.x, vb.y, vb.z, vb.w};
          float qq[4] = {qa4.x, qa4.y, qa4.z, qa4.w}, cc[4] = {cb4.x, cb4.y, cb4.z, cb4.w};
#pragma unroll
          for (int r = 0; r < 4; ++r)
#pragma unroll
            for (int q = 0; q < 4; ++q) { a1[r][q] = fmaf(sl4[r], vv[q], a1[r][q]); a2[r][q] = fmaf(qq[r], cc[q], a2[r][q]); }
        }
#pragma unroll
        for (int r = 0; r < 4; ++r) {
          const int l = l0 + r;
          const float w = w0[l];
          const float dn_ = den[l] + w * nq[l];
          const float dd = fmaxf(fabsf(dn_), __expf(-mt[l]));
          const float inv = 1.f / dd;
#pragma unroll
          for (int q = 0; q < 4; ++q) { float hv = (a1[r][q] + w * a2[r][q]) * inv; if (vhalf == 0) hacc[0][r][q] += hv; else hacc[1][r][q] += hv; }
        }
      }
      __syncthreads();
    }
  }
#pragma unroll
  for (int r = 0; r < 4; ++r) {
    float ss = 0.f;
#pragma unroll
    for (int a = 0; a < 2; ++a)
#pragma unroll
      for (int q = 0; q < 4; ++q) ss += hacc[a][r][q] * hacc[a][r][q];
    ss += shx(ss, 1); ss += shx(ss, 2); ss += shx(ss, 4); ss += shx(ss, 8);
    const float rn = rsqrtf(ss * (1.f / 128.f) + EPS);
    const int m = base + l0 + r;
#pragma unroll
    for (int a = 0; a < 2; ++a) {
      const int v0 = a * 64 + x0;
      float4 co = *(const float4*)(p.proj + (size_t)m * 2432 + 1024 + h * 128 + v0);
      float4 gn = *(const float4*)(p.c_out_norm + (size_t)(o * 4 + h) * 128 + v0);
      float y0 = sigmoid_f(co.x) * hacc[a][r][0] * rn * gn.x;
      float y1 = sigmoid_f(co.y) * hacc[a][r][1] * rn * gn.y;
      float y2 = sigmoid_f(co.z) * hacc[a][r][2] * rn * gn.z;
      float y3 = sigmoid_f(co.w) * hacc[a][r][3] * rn * gn.w;
      uint2 oo; oo.x = pack2(y0, y1); oo.y = pack2(y2, y3);
      *(uint2*)(p.mix + (size_t)m * 1024 + h * 128 + v0) = oo;
    }
  }
  __syncthreads();
}

__device__ __forceinline__ void mlstm2_mfma(PRM p, int o, int task, char* smem) {
  const int tid = get_tid(), lane = tid & 63, wave = tid >> 6, l15 = lane & 15, q4 = lane >> 4;
  int sq, h, c;
  if (task < 256) { c = task & 3; h = (task >> 2) & 3; sq = task >> 4; }
  else { int u = task - 256; c = u & 15; h = (u >> 4) & 3; sq = 16 + (u >> 6); }
  const bool pr = sq < 16;
  const int nc = pr ? 4 : 16;
  const int base = (pr ? sq * 256 : NPR + (sq - 16) * 1024) + c * 64;
  u16* Qb = (u16*)smem;
  u16* Kb = Qb + 64 * 72;
  u16* Vt = Kb + 64 * 72;
  u16* Cb = Vt + 128 * 72;
  float* sml = (float*)(Cb + 128 * 72);
  float* bl = sml; float* itb = sml + 64; float* mt = sml + 128; float* w0 = sml + 192; float* nv = sml + 256;
#pragma unroll
  for (int ii = 0; ii < 4; ++ii) {
    int i = (tid >> 4) + 16 * ii, c4 = tid & 15;
    const float* row = p.proj + (size_t)(base + i) * 2432 + h * 64 + c4 * 4;
    f32x4 qv = *(const f32x4*)row;
    f32x4 kv = *(const f32x4*)(row + 256);
    uint2 a; a.x = pack2(qv[0], qv[1]); a.y = pack2(qv[2], qv[3]);
    uint2 b; b.x = pack2(kv[0] * 0.125f, kv[1] * 0.125f); b.y = pack2(kv[2] * 0.125f, kv[3] * 0.125f);
    *(uint2*)(Qb + i * 72 + c4 * 4) = a;
    *(uint2*)(Kb + i * 72 + c4 * 4) = b;
  }
#pragma unroll
  for (int ii = 0; ii < 8; ++ii) {
    int i = (tid >> 5) + 8 * ii, c4 = tid & 31;
    f32x4 vv = *(const f32x4*)(p.proj + (size_t)(base + i) * 2432 + 512 + h * 128 + c4 * 4);
    unsigned w01 = pack2(vv[0], vv[1]), w23 = pack2(vv[2], vv[3]);
    Vt[(c4 * 4 + 0) * 72 + i] = (u16)(w01 & 0xffffu); Vt[(c4 * 4 + 1) * 72 + i] = (u16)(w01 >> 16);
    Vt[(c4 * 4 + 2) * 72 + i] = (u16)(w23 & 0xffffu); Vt[(c4 * 4 + 3) * 72 + i] = (u16)(w23 >> 16);
  }
  f32x4 hacc[8];
#pragma unroll
  for (int vt = 0; vt < 8; ++vt) hacc[vt] = (f32x4){0.f, 0.f, 0.f, 0.f};
  const int lrow = wave * 16 + l15;
#pragma unroll 1
  for (int dir = 0; dir < 2; ++dir) {
    const int j = dir ? nc - 1 - c : c;
    const int slj = mslot(sq, h, dir, j);
    const float mprev = p.mp[slj];
    {
      const f32x4* cpp = (const f32x4*)(p.cp + (size_t)slj * 8192);
#pragma unroll
      for (int r = 0; r < 8; ++r) {
        int e4 = tid + 256 * r;
        f32x4 cv = cpp[e4];
        uint2 a; a.x = pack2(cv[0], cv[1]); a.y = pack2(cv[2], cv[3]);
        *(uint2*)(Cb + (e4 >> 4) * 72 + (e4 & 15) * 4) = a;
      }
    }
    if (tid < 64) nv[tid] = p.np[slj * 64 + tid];
    if (wave == 0) {
      const int i = lane;
      const int tau = dir ? 63 - i : i;
      const float* row = p.proj + (size_t)(base + tau) * 2432 + 1536;
      float ig = row[(dir * 2 + 0) * 4 + h] + p.c_gate_bias[o * 16 + (dir * 2 + 0) * 4 + h];
      float fg = row[(dir * 2 + 1) * 4 + h] + p.c_gate_bias[o * 16 + (dir * 2 + 1) * 4 + h];
      float bsum = logsig_f(fg);
#pragma unroll
      for (int off = 1; off < 64; off <<= 1) { float v = __shfl_up(bsum, off); if (lane >= off) bsum += v; }
      float ib = ig - bsum;
      float pm = ib;
#pragma unroll
      for (int off = 1; off < 64; off <<= 1) { float v = __shfl_up(pm, off); if (lane >= off) pm = fmaxf(pm, v); }
      float mti = fmaxf(bsum + mprev, bsum + pm);
      bl[tau] = bsum; itb[tau] = ib; mt[tau] = mti; w0[tau] = __expf(bsum + mprev - mti);
    }
    __syncthreads();
    const float bll = bl[lrow], mtl = mt[lrow], w0l = w0[lrow];
    bf16x8 qf[2];
#pragma unroll
    for (int ks = 0; ks < 2; ++ks) qf[ks] = *(const bf16x8*)(Qb + lrow * 72 + ks * 32 + q4 * 8);
    float nqp = 0.f;
#pragma unroll
    for (int ks = 0; ks < 2; ++ks)
#pragma unroll
      for (int jj = 0; jj < 8; ++jj) {
        float qe = __uint_as_float(((unsigned)(unsigned short)qf[ks][jj]) << 16);
        nqp = fmaf(qe, nv[ks * 32 + q4 * 8 + jj], nqp);
      }
    nqp += shx(nqp, 16); nqp += shx(nqp, 32);
    f32x4 oacc[8];
#pragma unroll
    for (int vt = 0; vt < 8; ++vt) {
      oacc[vt] = (f32x4){0.f, 0.f, 0.f, 0.f};
#pragma unroll
      for (int ks = 0; ks < 2; ++ks) {
        bf16x8 a = *(const bf16x8*)(Cb + (vt * 16 + l15) * 72 + ks * 32 + q4 * 8);
        oacc[vt] = mfma16(a, qf[ks], oacc[vt]);
      }
      oacc[vt] *= w0l;
    }
    float sv[16];
    float dsum = 0.f;
#pragma unroll
    for (int st = 0; st < 4; ++st) {
      f32x4 sa = {0.f, 0.f, 0.f, 0.f};
#pragma unroll
      for (int ks = 0; ks < 2; ++ks) {
        bf16x8 a = *(const bf16x8*)(Kb + (st * 16 + l15) * 72 + ks * 32 + q4 * 8);
        sa = mfma16(a, qf[ks], sa);
      }
#pragma unroll
      for (int r = 0; r < 4; ++r) {
        const int sidx = st * 16 + q4 * 4 + r;
        const bool ok = dir ? (sidx >= lrow) : (sidx <= lrow);
        float val = ok ? sa[r] * __expf(bll + itb[sidx] - mtl) : 0.f;
        sv[st * 4 + r] = val;
        dsum += val;
      }
    }
    dsum += shx(dsum, 16); dsum += shx(dsum, 32);
    bf16x8 pf[2];
#pragma unroll
    for (int hf = 0; hf < 2; ++hf) {
      u32x4 pw;
      pw[0] = pack2(sv[hf * 8 + 0], sv[hf * 8 + 1]); pw[1] = pack2(sv[hf * 8 + 2], sv[hf * 8 + 3]);
      pw[2] = pack2(sv[hf * 8 + 4], sv[hf * 8 + 5]); pw[3] = pack2(sv[hf * 8 + 6], sv[hf * 8 + 7]);
      pf[hf] = __builtin_bit_cast(bf16x8, pw);
    }
    const float dn_ = dsum + w0l * nqp;
    const float inv = 1.f / fmaxf(fabsf(dn_), __expf(-mtl));
#pragma unroll
    for (int vt = 0; vt < 8; ++vt) {
#pragma unroll
      for (int hf = 0; hf < 2; ++hf) {
        const u16* vp = Vt + (vt * 16 + l15) * 72 + hf * 32 + q4 * 4;
        s16x4 v0 = *(const s16x4*)vp;
        s16x4 v1 = *(const s16x4*)(vp + 16);
        bf16x8 vf = (bf16x8){v0.x, v0.y, v0.z, v0.w, v1.x, v1.y, v1.z, v1.w};
        oacc[vt] = mfma16(vf, pf[hf], oacc[vt]);
      }
      hacc[vt] += oacc[vt] * inv;
    }
    __syncthreads();
  }
  float ss = 0.f;
#pragma unroll
  for (int vt = 0; vt < 8; ++vt)
#pragma unroll
    for (int r = 0; r < 4; ++r) ss += hacc[vt][r] * hacc[vt][r];
  ss += shx(ss, 16); ss += shx(ss, 32);
  const float rn = rsqrtf(ss * (1.f / 128.f) + EPS);
  const int m = base + lrow;
#pragma unroll
  for (int vt = 0; vt < 8; ++vt) {
    const int v0 = vt * 16 + q4 * 4;
    f32x4 co = *(const f32x4*)(p.proj + (size_t)m * 2432 + 1024 + h * 128 + v0);
    f32x4 gn = *(const f32x4*)(p.c_out_norm + (size_t)(o * 4 + h) * 128 + v0);
    float y0 = sigmoid_f(co[0]) * hacc[vt][0] * rn * gn[0];
    float y1 = sigmoid_f(co[1]) * hacc[vt][1] * rn * gn[1];
    float y2 = sigmoid_f(co[2]) * hacc[vt][2] * rn * gn[2];
    float y3 = sigmoid_f(co[3]) * hacc[vt][3] * rn * gn[3];
    uint2 oo; oo.x = pack2(y0, y1); oo.y = pack2(y2, y3);
    *(uint2*)(p.mix + (size_t)m * 1024 + h * 128 + v0) = oo;
  }
  __syncthreads();
}

__device__ __forceinline__ void mlstm_scan_phase(PRM p, int o) {
  const int tid = get_tid();
  for (int task = get_bid(); task < 576; task += vgrid()) {
    const int sc = task >> 2, slice = task & 3;
    int sq, h, dir;
    if (sc < 128) { sq = sc >> 3; h = (sc >> 1) & 3; dir = sc & 1; }
    else { int u = sc - 128; sq = 16 + (u >> 3); h = (u >> 1) & 3; dir = u & 1; }
    const bool pr = sq < 16;
    const int nc = pr ? 4 : 16;
    const int sidx = pr ? ((sq * 2 + o) * 2 + dir) * 4 + h : 0;
    const int cidx = pr ? 0 : (((sq - 16) * 2 + o) * 2 + dir) * 4 + h;
    const int e0 = slice * 2048 + tid;
    float C[8];
#pragma unroll
    for (int r = 0; r < 8; ++r) C[r] = pr ? 0.f : p.state_C[(size_t)cidx * 8192 + e0 + 256 * r];
    const bool nthr = (slice == 0) && (tid < 64);
    float n = (pr || !nthr) ? 0.f : p.state_n[cidx * 64 + tid];
    float m = pr ? 0.f : p.state_m[cidx];
#pragma unroll 4
    for (int j = 0; j < nc; ++j) {
      const int sl = mslot(sq, h, dir, j);
      float* cp = p.cp + (size_t)sl * 8192 + e0;
      const float* dc = p.dC + (size_t)sl * 8192 + e0;
#pragma unroll
      for (int r = 0; r < 8; ++r) cp[256 * r] = C[r];
      if (nthr) { p.np[sl * 64 + tid] = n; if (tid == 0) p.mp[sl] = m; }
      const float ml = p.dm[sl * 2], bls = p.dm[sl * 2 + 1];
      const float mn = fmaxf(bls + m, ml);
      const float ca = __expf(bls + m - mn), cb = __expf(ml - mn);
#pragma unroll
      for (int r = 0; r < 8; ++r) C[r] = ca * C[r] + cb * dc[256 * r];
      if (nthr) n = ca * n + cb * p.dn[sl * 64 + tid];
      m = mn;
    }
    if (pr) {
      float* oc = p.out + O_CC + (size_t)sidx * 8192 + e0;
#pragma unroll
      for (int r = 0; r < 8; ++r) oc[256 * r] = C[r];
      if (nthr) { p.out[O_CN + (size_t)sidx * 64 + tid] = n; if (tid == 0) p.out[O_CM + sidx] = m; }
    }
  }
}

__device__ __forceinline__ void odd_mid_phase(PRM p, int o, char* smem) {
  u16* lds = (u16*)smem;
  const int tid = get_tid(), lane = tid & 63, wave = tid >> 6, l15 = lane & 15, q4 = lane >> 4;
  for (int bt = get_bid(); bt < 256 + 768 + 512; bt += vgrid()) {
    if (bt < 256) {
      int qb = bt & 15, hq = (bt >> 4) & 7, b = bt >> 7;
      int kvh = hq >> 2;
      int mq = NPR + b * 1024 + qb * 64 + wave * 16;
      AttnSt st; attn_init(st);
      bf16x8 qf[2]; load_q64(qf, p.qa + (size_t)mq * 512 + hq * 64, 512, l15, q4);
      at_run_plain<2>(st, qf, p.kd + (size_t)(NPR + b * 1536) * 128 + kvh * 64, 128, p.vtd_s + (size_t)((b * 2 + kvh) * 64) * 1536, 1536, 24, 0.125f, lds, tid, l15, q4);
      attn_fin(st, p.mix + (size_t)mq * 1024 + 512 + hq * 64, l15, q4);
    } else if (bt < 256 + 768) {
      mlstm1_task(p, o, bt - 256, (float*)smem);
    } else {
      int u = bt - 1024;
      int qb = u & 3, hq = (u >> 2) & 7, b = u >> 5;
      int kvh = hq >> 2;
      int mq = b * 256 + qb * 64 + wave * 16;
      AttnSt st; attn_init(st);
      bf16x8 qf[2]; load_q64(qf, p.qa + (size_t)mq * 512 + hq * 64, 512, l15, q4);
      at_run_plain<2>(st, qf, p.kd + (size_t)(b * 256) * 128 + kvh * 64, 128, p.vtd_p + (size_t)((b * 2 + kvh) * 64) * 256, 256, 4, 0.125f, lds, tid, l15, q4);
      attn_fin(st, p.mix + (size_t)mq * 1024 + 512 + hq * 64, l15, q4);
    }
  }
}

__device__ __forceinline__ void run_phase(PRM p, int ph, char* smem) {
  char* vsm = smem + (rtid() >> 8) * LDS_HALF;
  if (ph == 0) { phase0(p, vsm); return; }
  if (ph == NPHASE - 1) { norm_phase(p, 0, 3); return; }
  const int l = (ph - 1) / 13, s = (ph - 1) % 13;
  const int eo = l >> 1;
  const bool even = (l & 1) == 0;
  EpiP e{};
  const float* modl = p.mod + (size_t)l * 3 * 9216;
  switch (s) {
    case 0: norm_phase(p, l, 0); break;
    case 1: e.H = p.h; ffn_in_phase(p, l, 0, e, smem); break;
    case 2: e.C = p.x; e.gate = modl + 2 * 1024; e.ldc = 1;
            gemm_phase<EPI_RESID, 4, 2, 3, 4, 4>(p.h, p.wt_ffn_out + (size_t)(l * 2 + 0) * 1024 * 2816, 2816, 32, 8, e, smem); break;
    case 3: norm_phase(p, l, 1); break;
    case 4:
      if (even) { e.C = p.proj; e.ldc = 2688; gemm_phase<EPI_STORE, 4, 2, 4, 4, 2>(p.xn, p.wt_in_e + (size_t)eo * 2688 * 1024, 1024, 24, 21, e, smem); }
      else { e.C = p.proj; e.ldc = 2432; gemm_phase<EPI_STORE, 4, 2, 4, 4, 2>(p.xn, p.wt_in_o + (size_t)eo * 2432 * 1024, 1024, 24, 19, e, smem); }
      break;
    case 5: if (even) post_even(p, eo); else post_odd(p, eo); break;
    case 6:
      if (even) {
        EpiP eq{}; eq.C = p.qb; eq.ldc = 768;
        EpiP ek{}; ek.kb = p.kb; ek.vtp = p.vtb_p; ek.vts = p.vtb_s; ek.ctx = 0;
        EpiP ec = ek; ec.ctx = 1;
        const u16* wq = p.wt_qup + (size_t)eo * 768 * 768;
        const u16* wk = p.wt_kvup + (size_t)eo * 1024 * 256;
        for (int t = rbid(); t < 288 + 384 + 64; t += (int)gridDim.x) {
          if (t < 288) gemm_tile<EPI_STORE, 4, 2, 2, 4, 2>(p.cqn, wq, 768, t % 48, t / 48, eq, smem);
          else if (t < 672) { int u = t - 288; gemm_tile<EPI_KVUP, 4, 2, 2, 4, 2>(p.ckvn, wk, 256, u % 48, u / 48, ek, smem); }
          else { int u = t - 672; gemm_tile<EPI_KVUP, 4, 2, 2, 4, 2>(p.cctxn, wk, 256, u % 8, u / 8, ec, smem); }
        }
      } else odd_mid_phase(p, eo, vsm);
      break;
    case 7: if (!even) mlstm_scan_phase(p, eo); break;
    case 8:
      if (even) attn_even_phase(p, eo, vsm);
      else { for (int t = get_bid(); t < 384; t += vgrid()) mlstm2_mfma(p, eo, t, vsm); }
      break;
    case 9: e.C = p.x; e.gate = modl + 5 * 1024; e.ldc = 0;
            gemm_phase<EPI_RESID, 4, 2, 3, 4, 2>(p.mix, p.wt_out + (size_t)l * 1024 * 1024, 1024, 32, 8, e, smem); break;
    case 10: norm_phase(p, l, 2); break;
    case 11: e.H = p.h; ffn_in_phase(p, l, 1, e, smem); break;
    case 12: e.C = p.x; e.gate = modl + 8 * 1024; e.ldc = 1;
             gemm_phase<EPI_RESID, 4, 2, 3, 4, 4>(p.h, p.wt_ffn_out + (size_t)(l * 2 + 1) * 1024 * 2816, 2816, 32, 8, e, smem); break;
  }
}

__global__ void __launch_bounds__(512, 2) mega(Params p) {
  __shared__ __attribute__((aligned(16))) char smem[LDS_BYTES];
  __shared__ uint4 xb_words;
  cg::grid_group grid = cg::this_grid();
  if (threadIdx.x == 0) xb_words = make_uint4(0u, 0u, 0u, 0u);
  __syncthreads();
  XcdBarrier xb = xcd_barrier_post(p.bar, (volatile LAS unsigned*)&xb_words);
  for (int ph = p.ph0; ph < p.ph1; ++ph) {
    const __attribute__((address_space(4))) Params* pp = (const __attribute__((address_space(4))) Params*)__builtin_amdgcn_kernarg_segment_ptr();
    asm volatile("" : "+s"(pp));
    run_phase(*pp, ph, smem);
#ifndef REPMASK
#define REPMASK 0
#endif
#ifndef REPPAR
#define REPPAR 0
#endif
    if (REPMASK) {
      int bit = ph == 0 ? 13 : (ph == NPHASE - 1 ? 14 : (ph - 1) % 13);
      int lay = (ph - 1) / 13;
      bool parok = REPPAR == 0 || ph == 0 || ph == NPHASE - 1 || (REPPAR == 1 && (lay & 1) == 0) || (REPPAR == 2 && (lay & 1) == 1);
      if (((REPMASK >> bit) & 1) && parok) { xcd_barrier(xb); asm volatile("" : "+s"(pp)); run_phase(*pp, ph, smem); }
    }
    if (ph + 1 < p.ph1) {
      if (p.ph1 > 100000) grid.sync();
      xcd_barrier(xb);
    }
  }
}

extern "C" void kernel_launch(void* const* d_in, const int* in_sizes, int n_in, void* d_out, int out_size, void* d_ws, size_t ws_size,
                              hipStream_t stream) {
  static int grid_blocks = 0;
  if (!grid_blocks) {
    int dev = 0, cus = 0, per_cu = 0;
    hipGetDevice(&dev);
    hipDeviceGetAttribute(&cus, hipDeviceAttributeMultiprocessorCount, dev);
    hipOccupancyMaxActiveBlocksPerMultiprocessor(&per_cu, mega, 512, 0);
    per_cu = 1;
    grid_blocks = cus * per_cu;
  }
  Params p{};
  const float** ip = (const float**)&p.x_prompt;
  for (int i = 0; i < 31; ++i) ip[i] = (const float*)d_in[i];
  p.out = (float*)d_out;
  char* w = (char*)d_ws;
  size_t off = 0;
  auto take = [&](size_t bytes) { char* r = w + off; off += (bytes + 255) & ~(size_t)255; return r; };
  p.wt_ffn_in = (u16*)take((size_t)8 * 5632 * 1024 * 2);
  p.wt_ffn_out = (u16*)take((size_t)8 * 1024 * 2816 * 2);
  p.wt_in_e = (u16*)take((size_t)2 * 2688 * 1024 * 2);
  p.wt_in_o = (u16*)take((size_t)2 * 2432 * 1024 * 2);
  p.wt_out = (u16*)take((size_t)4 * 1024 * 1024 * 2);
  p.wt_qup = (u16*)take((size_t)2 * 768 * 768 * 2);
  p.wt_kvup = (u16*)take((size_t)2 * 1024 * 256 * 2);
  p.mod = (float*)take((size_t)12 * 9216 * 4);
  p.x = (float*)take((size_t)NTOK * 1024 * 4);
  p.proj = (float*)take((size_t)NTOK * 2688 * 4);
  p.qb = (float*)take((size_t)NTOK * 768 * 4);
  p.dC = (float*)take((size_t)768 * 8192 * 4);
  p.dn = (float*)take((size_t)768 * 64 * 4);
  p.dm = (float*)take((size_t)768 * 2 * 4);
  p.cp = (float*)take((size_t)768 * 8192 * 4);
  p.np = (float*)take((size_t)768 * 64 * 4);
  p.mp = (float*)take((size_t)768 * 4);
  p.xn = (u16*)take((size_t)NTOK * 1024 * 2);
  p.h = (u16*)take((size_t)NTOK * 2816 * 2);
  p.mix = (u16*)take((size_t)NTOK * 1024 * 2);
  p.qa = (u16*)take((size_t)NTOK * 512 * 2);
  p.ka = (u16*)take((size_t)NTOK * 512 * 2);
  p.kactx = (u16*)take((size_t)1024 * 512 * 2);
  p.vta_p = (u16*)take((size_t)16 * 8 * 64 * 256 * 2);
  p.vta_s = (u16*)take((size_t)2 * 8 * 64 * 1536 * 2);
  p.kb = (u16*)take((size_t)7168 * 768 * 2);
  p.vtb_p = (u16*)take((size_t)16 * 8 * 64 * 256 * 2);
  p.vtb_s = (u16*)take((size_t)2 * 8 * 64 * 1536 * 2);
  p.cqn = (u16*)take((size_t)NTOK * 768 * 2);
  p.ckvn = (u16*)take((size_t)NTOK * 256 * 2);
  p.cctxn = (u16*)take((size_t)1024 * 256 * 2);
  p.kd = (u16*)take((size_t)7168 * 128 * 2);
  p.vtd_p = (u16*)take((size_t)16 * 2 * 64 * 256 * 2);
  p.vtd_s = (u16*)take((size_t)2 * 2 * 64 * 1536 * 2);
  p.bar = (unsigned*)take((size_t)XCD_BAR_WORDS * 4);
  if (off > ws_size) { fprintf(stderr, "kernel_launch: workspace too small: need %zu have %zu\n", off, ws_size); return; }
  hipMemsetAsync(p.bar, 0, (size_t)XCD_BAR_WORDS * 4, stream);
#if MULTI
  for (int ph = 0; ph < NPHASE; ++ph) {
    p.ph0 = ph; p.ph1 = ph + 1;
    hipLaunchKernelGGL(mega, dim3(grid_blocks), dim3(512), 0, stream, p);
  }
#else
  p.ph0 = 0; p.ph1 = NPHASE;
  void* args[] = {&p};
  hipError_t e = hipLaunchCooperativeKernel((void*)mega, dim3(grid_blocks), dim3(512), args, 0, stream);
  if (e != hipSuccess) fprintf(stderr, "cooperative launch failed: %s (grid %d)\n", hipGetErrorString(e), grid_blocks);
#endif
}
```

```cpp
#include <hip/hip_runtime.h>
#include <hip/hip_cooperative_groups.h>
#include <cstdio>
#include <cstdint>
namespace cg = cooperative_groups;

#ifndef MULTI
#define MULTI 0
#endif

typedef unsigned short u16;
typedef __attribute__((ext_vector_type(8))) short bf16x8;
typedef __attribute__((ext_vector_type(4))) short s16x4;
typedef __attribute__((ext_vector_type(4))) float f32x4;
typedef __attribute__((ext_vector_type(4))) unsigned int u32x4;

#define NTOK 6144
#define NPR 4096
#define LDS_HALF 77824
#define LDS_BYTES (2 * LDS_HALF)
#define NPHASE 54
#define EPS 1e-6f

struct Params {
  const float *x_prompt, *x_sample, *cache_a_k, *cache_a_v, *cache_b_ckv, *cache_b_krope, *cache_d_k, *cache_d_v;
  const float *state_C, *state_n, *state_m, *c, *c_ctx, *w_mod, *b_mod, *norm_g, *ffn_in, *ffn_out;
  const float *w_in_even, *w_in_odd, *w_out, *a_rpb, *b_q_norm, *b_wq_up, *b_kv_norm, *b_wkv_up;
  const float *c_gate_bias, *c_out_norm, *d_q_norm, *d_k_norm, *final_norm;
  float* out;
  u16 *wt_ffn_in, *wt_ffn_out, *wt_in_e, *wt_in_o, *wt_out, *wt_qup, *wt_kvup;
  float *mod, *x, *proj, *qb, *dC, *dn, *dm, *cp, *np, *mp;
  u16 *xn, *h, *mix, *qa, *ka, *kactx, *vta_p, *vta_s, *kb, *vtb_p, *vtb_s, *cqn, *ckvn, *cctxn, *kd, *vtd_p, *vtd_s;
  unsigned* bar;
  int ph0, ph1;
};

typedef const __attribute__((address_space(4))) Params& PRM;
#define O_YP 0
#define O_YS 4194304
#define O_AK 6291456
#define O_AV 10485760
#define O_CKV 14680064
#define O_KR 16777216
#define O_DK 17039360
#define O_DV 18087936
#define O_CC 19136512
#define O_CN 21233664
#define O_CM 21250048

__device__ __forceinline__ int get_tid() { int t = threadIdx.x & 255; asm volatile("" : "+v"(t)); return t; }
__device__ __forceinline__ int rtid_raw() { int t = threadIdx.x; asm volatile("" : "+v"(t)); return t; }
__device__ __forceinline__ int get_bid() { int t = blockIdx.x * 2 + __builtin_amdgcn_readfirstlane(rtid_raw() >> 8); asm volatile("" : "+s"(t)); return t; }
__device__ __forceinline__ int vgrid() { return (int)gridDim.x * 2; }
__device__ __forceinline__ int rtid() { int t = threadIdx.x; asm volatile("" : "+v"(t)); return t; }
__device__ __forceinline__ int rbid() { int t = blockIdx.x; asm volatile("" : "+s"(t)); return t; }
typedef __attribute__((ext_vector_type(2))) __bf16 bf16x2_t;
typedef __attribute__((ext_vector_type(2))) float f32x2_t;
__device__ __forceinline__ unsigned pack2(float a, float b) {
  f32x2_t v = {a, b};
  bf16x2_t r = __builtin_convertvector(v, bf16x2_t);
  return __builtin_bit_cast(unsigned, r);
}
__device__ __forceinline__ u16 f2bf(float f) { return (u16)(pack2(f, 0.f) & 0xffffu); }
__device__ __forceinline__ float shx(float v, int m) {
  int l = __builtin_amdgcn_mbcnt_hi(-1, __builtin_amdgcn_mbcnt_lo(-1, 0));
  asm volatile("" : "+v"(l));
  return __int_as_float(__builtin_amdgcn_ds_bpermute((l ^ m) << 2, __float_as_int(v)));
}
__device__ __forceinline__ float wsum(float v) {
#pragma unroll
  for (int o = 32; o; o >>= 1) v += shx(v, o);
  return v;
}
__device__ __forceinline__ float wmaxr(float v) {
#pragma unroll
  for (int o = 32; o; o >>= 1) v = fmaxf(v, shx(v, o));
  return v;
}
__device__ __forceinline__ float silu_f(float x) { return x / (1.f + __expf(-x)); }
__device__ __forceinline__ float sigmoid_f(float x) { return 1.f / (1.f + __expf(-x)); }
__device__ __forceinline__ float logsig_f(float x) { return fminf(x, 0.f) - __logf(1.f + __expf(-fabsf(x))); }
__device__ __forceinline__ void sincos_r(float a, float& s, float& c) {
  float n = rintf(a * 0.15915494309f);
  float r = fmaf(-n, 6.2831855f, a);
  r = fmaf(-n, -1.7484555e-7f, r);
  s = __sinf(r); c = __cosf(r);
}
__device__ __forceinline__ int grp_of(int m) { return m < NPR ? 0 : 1 + ((m - NPR) >> 10); }
__device__ __forceinline__ int keyrow(int m) { return m < NPR ? m : NPR + ((m - NPR) >> 10) * 1536 + ((m - NPR) & 1023); }
__device__ __forceinline__ f32x4 mfma16(bf16x8 a, bf16x8 b, f32x4 c) { return __builtin_amdgcn_mfma_f32_16x16x32_bf16(a, b, c, 0, 0, 0); }

#define XB_TMO      128
#define XB_XCNT(j)  (256  + 64 * (j))
#define XB_XSUB(j)  (1280 + 64 * (j))
#define XB_XGEN(j)  (2304 + 64 * (j))
#define XB_TOP      3328
#define XB_TOPGEN   3392
#define XCD_BAR_WORDS 3456
#define XB_SPIN_CAP (1u << 18)
#define LAS __attribute__((address_space(3)))

__device__ __forceinline__ unsigned xb_ld(unsigned* p)              { return __hip_atomic_load(p, __ATOMIC_RELAXED, __HIP_MEMORY_SCOPE_AGENT); }
__device__ __forceinline__ unsigned xb_add(unsigned* p, unsigned v) { return __hip_atomic_fetch_add(p, v, __ATOMIC_RELAXED, __HIP_MEMORY_SCOPE_AGENT); }
__device__ __forceinline__ unsigned xb_xcc_id() { return (unsigned)__builtin_amdgcn_s_getreg((3 << 11) | 20) & 0xFu; }
#define XB_SPIN(cond, bar) do { unsigned _sp = 0; while (cond) { __builtin_amdgcn_s_sleep(1); \
    if ((++_sp & 255u) == 0u) { if (xb_ld(&(bar)[XB_TMO])) break; if (_sp > XB_SPIN_CAP) { atomicAdd(&(bar)[XB_TMO], 1u); break; } } } } while (0)

struct XcdBarrier {
    unsigned* bar; unsigned x;
    volatile LAS unsigned* st;
};

__device__ __forceinline__ XcdBarrier xcd_barrier_post(unsigned* bar, volatile LAS unsigned* st) {
    XcdBarrier b; b.bar = bar; b.x = xb_xcc_id(); b.st = st;
    if (threadIdx.x == 0) (void)xb_add(&bar[XB_XCNT(b.x)], 1u);
    return b;
}
__device__ __forceinline__ void xcd_barrier_complete(unsigned* bar, unsigned x, unsigned& nloc, unsigned& nx) {
    const unsigned G = gridDim.x * gridDim.y * gridDim.z;
    unsigned sum, cnt, mine, sp = 0u;
    for (;;) {
        sum = 0u; cnt = 0u; mine = 0u;
#pragma unroll
        for (unsigned j = 0; j < 16; ++j) { const unsigned c = xb_ld(&bar[XB_XCNT(j)]); sum += c; cnt += (c > 0u) ? 1u : 0u; mine = (j == x) ? c : mine; }
        if (sum == G) break;
        __builtin_amdgcn_s_sleep(1);
        if ((++sp & 255u) == 0u) { if (xb_ld(&bar[XB_TMO])) break; if (sp > XB_SPIN_CAP) { atomicAdd(&bar[XB_TMO], 1u); break; } }
    }
    nloc = mine > 0u ? mine : 1u; nx = cnt > 0u ? cnt : 1u;
}

__device__ __forceinline__ void xcd_barrier(const XcdBarrier& b) {
    asm volatile("s_waitcnt vmcnt(0)" ::: "memory");
    __syncthreads();
    if (threadIdx.x == 0) {
        unsigned* bar = b.bar;
        __builtin_amdgcn_s_waitcnt(0);
        unsigned nloc = b.st[0], nx = b.st[1];
        if (nloc == 0u) { xcd_barrier_complete(bar, b.x, nloc, nx); b.st[0] = nloc; b.st[1] = nx; }
        const unsigned old = xb_add(&bar[XB_XSUB(b.x)], 1u);
        const unsigned gen = old / nloc;
        if (old + 1u == (gen + 1u) * nloc) {
            __builtin_amdgcn_fence(__ATOMIC_RELEASE, "agent");
            asm volatile("s_waitcnt vmcnt(0)" ::: "memory");
            const unsigned og = xb_add(&bar[XB_TOP], 1u);
            const unsigned tg = og / nx;
            if (og + 1u == (tg + 1u) * nx) xb_add(&bar[XB_TOPGEN], 1u);
            else XB_SPIN(xb_ld(&bar[XB_TOPGEN]) == tg, bar);
            __builtin_amdgcn_fence(__ATOMIC_ACQUIRE, "agent");
            xb_add(&bar[XB_XGEN(b.x)], 1u);
            asm volatile("s_waitcnt vmcnt(0)" ::: "memory");
        } else {
            XB_SPIN(xb_ld(&bar[XB_XGEN(b.x)]) == gen, bar);
            __builtin_amdgcn_fence(__ATOMIC_ACQUIRE, "agent");
            asm volatile("s_waitcnt vmcnt(0)" ::: "memory");
        }
    }
    __syncthreads();
}


__device__ __forceinline__ void conv_tile(const float* __restrict__ src, int K, int N, int perm, u16* __restrict__ dst, int kt2, int nt, float* tile) {
  const int tid = get_tid();
  {
    const int c4 = tid & 15, kr = tid >> 4;
    const int n = nt * 64 + c4 * 4;
    const bool valid = n < N;
    int col = n;
    if (perm) { int G = n >> 4, w = n & 15, sub = w >> 2; col = ((sub & 1) ? 2816 : 0) + G * 8 + (sub >> 1) * 4 + (w & 3); }
    float4 v[8];
#pragma unroll
    for (int i = 0; i < 8; ++i) {
      int kk = kr + 16 * i;
      v[i] = valid ? *(const float4*)(src + (size_t)(kt2 * 128 + kk) * N + col) : make_float4(0.f, 0.f, 0.f, 0.f);
    }
#pragma unroll
    for (int i = 0; i < 8; ++i) {
      int kk = kr + 16 * i;
      float* t = tile + (kk >> 6) * 4160 + (kk & 63) * 65 + c4 * 4;
      t[0] = v[i].x; t[1] = v[i].y; t[2] = v[i].z; t[3] = v[i].w;
    }
  }
  __syncthreads();
  {
    const int k8 = (tid & 7) * 8;
#pragma unroll
    for (int hh = 0; hh < 2; ++hh)
#pragma unroll
      for (int i = 0; i < 2; ++i) {
        int nn2 = (tid >> 3) + 32 * i;
        float v[8];
#pragma unroll
        for (int e = 0; e < 8; ++e) v[e] = tile[hh * 4160 + (k8 + e) * 65 + nn2];
        uint4 o; o.x = pack2(v[0], v[1]); o.y = pack2(v[2], v[3]); o.z = pack2(v[4], v[5]); o.w = pack2(v[6], v[7]);
        *(uint4*)(dst + (size_t)(nt * 64 + nn2) * K + kt2 * 128 + hh * 64 + k8) = o;
      }
  }
  __syncthreads();
}

__device__ __forceinline__ void mod_task(PRM p, int t, float* sm) {
  const int l = t / 144, cb = t % 144, tid = get_tid();
  float* sc = sm;
  float* red = sm + 3072;
  for (int i = tid; i < 3072; i += 256) {
    int g = i >> 10, k = i & 1023;
    float v = g == 0 ? p.c_ctx[k] : p.c[(g - 1) * 1024 + k];
    sc[i] = silu_f(v);
  }
  __syncthreads();
  const int c4 = tid & 15, kg = tid >> 4;
  const float* w = p.w_mod + (size_t)l * 1024 * 9216 + (size_t)(kg * 64) * 9216 + cb * 64 + c4 * 4;
  float a[3][4];
#pragma unroll
  for (int g = 0; g < 3; ++g)
#pragma unroll
    for (int q = 0; q < 4; ++q) a[g][q] = 0.f;
  for (int k = 0; k < 64; k += 8) {
    float4 wv[8];
#pragma unroll
    for (int e = 0; e < 8; ++e) wv[e] = *(const float4*)(w + (size_t)(k + e) * 9216);
#pragma unroll
    for (int e = 0; e < 8; ++e) {
      int kk = kg * 64 + k + e;
#pragma unroll
      for (int g = 0; g < 3; ++g) {
        float sv = sc[g * 1024 + kk];
        a[g][0] = fmaf(sv, wv[e].x, a[g][0]); a[g][1] = fmaf(sv, wv[e].y, a[g][1]);
        a[g][2] = fmaf(sv, wv[e].z, a[g][2]); a[g][3] = fmaf(sv, wv[e].w, a[g][3]);
      }
    }
  }
#pragma unroll
  for (int g = 0; g < 3; ++g)
#pragma unroll
    for (int q = 0; q < 4; ++q) red[(kg * 3 + g) * 64 + c4 * 4 + q] = a[g][q];
  __syncthreads();
  if (tid < 192) {
    int g = tid >> 6, c2 = tid & 63;
    float s = 0.f;
#pragma unroll
    for (int q = 0; q < 16; ++q) s += red[(q * 3 + g) * 64 + c2];
    int j = cb * 64 + c2;
    p.mod[(size_t)(l * 3 + g) * 9216 + j] = s + p.b_mod[l * 9216 + j];
  }
  __syncthreads();
}

__device__ __forceinline__ int conv_layer_count(int l) { return (l & 1) ? 2544 : 2680; }
__device__ __forceinline__ void conv_layer_task(PRM p, int l, int u, float* sm) {
  const float* src; u16* dst; int K, N, Npad, perm = 0, tp, mat0;
  const int eo = l >> 1;
  const int nin = (l & 1) ? 304 : 336;
  if (u < 1408) { K = 1024; N = 5632; Npad = 5632; perm = 1; tp = 704; src = p.ffn_in; dst = p.wt_ffn_in; mat0 = l * 2; }
  else if ((u -= 1408) < 704) { K = 2816; N = 1024; Npad = 1024; tp = 352; src = p.ffn_out; dst = p.wt_ffn_out; mat0 = l * 2; }
  else if ((u -= 704) < nin) {
    if (l & 1) { K = 1024; N = 2320; Npad = 2432; tp = 304; src = p.w_in_odd; dst = p.wt_in_o; mat0 = eo; }
    else { K = 1024; N = 2592; Npad = 2688; tp = 336; src = p.w_in_even; dst = p.wt_in_e; mat0 = eo; }
  }
  else if ((u -= nin) < 128) { K = 1024; N = 1024; Npad = 1024; tp = 128; src = p.w_out; dst = p.wt_out; mat0 = l; }
  else if ((u -= 128) < 72) { K = 768; N = 768; Npad = 768; tp = 72; src = p.b_wq_up; dst = p.wt_qup; mat0 = eo; }
  else { u -= 72; K = 256; N = 1024; Npad = 1024; tp = 32; src = p.b_wkv_up; dst = p.wt_kvup; mat0 = eo; }
  int mat = mat0 + u / tp, r = u % tp;
  int nkt = K / 128;
  int kt = r % nkt, nt = r / nkt;
  conv_tile(src + (size_t)mat * K * N, K, N, perm, dst + (size_t)mat * Npad * K, kt, nt, sm);
}

__device__ __forceinline__ void phase0(PRM p, char* smem) {
  float* sm = (float*)smem;
  const int NMOD = 144, NCOPY = 1536, NCONV = 2680;
  const int total = NMOD + NCOPY + NCONV;
  for (int t = get_bid(); t < total; t += vgrid()) {
    if (t < NMOD) { mod_task(p, t, sm); continue; }
    int u = t - NMOD;
    if (u < NCOPY) {
      const int tid = get_tid();
#pragma unroll
      for (int i = 0; i < 4; ++i) {
        size_t idx = ((size_t)u * 1024 + i * 256 + tid);
        const float4* src = idx < (size_t)NPR * 256 ? (const float4*)p.x_prompt + idx : (const float4*)p.x_sample + (idx - (size_t)NPR * 256);
        ((float4*)p.x)[idx] = *src;
      }
      continue;
    }
    conv_layer_task(p, 0, u - NCOPY, sm);
  }
}

__device__ __forceinline__ void norm_phase(PRM p, int l, int which) {
  const int lane = get_tid() & 63, wave = get_tid() >> 6;
  const int nrows_wave = NTOK / 4;
  const int stride = vgrid();
  for (int t0 = get_bid(); t0 < nrows_wave; t0 += 3 * stride) {
    float4 v[3][4];
    float ss[3];
#pragma unroll
    for (int k = 0; k < 3; ++k) {
      const int t = t0 + k * stride;
      if (t < nrows_wave) {
        const float4* xr = (const float4*)(p.x + (size_t)(t * 4 + wave) * 1024);
#pragma unroll
        for (int i = 0; i < 4; ++i) v[k][i] = xr[i * 64 + lane];
      }
    }
#pragma unroll
    for (int k = 0; k < 3; ++k) {
      float a = 0.f;
#pragma unroll
      for (int i = 0; i < 4; ++i) a += v[k][i].x * v[k][i].x + v[k][i].y * v[k][i].y + v[k][i].z * v[k][i].z + v[k][i].w * v[k][i].w;
      ss[k] = wsum(a);
    }
#pragma unroll
    for (int k = 0; k < 3; ++k) {
      const int t = t0 + k * stride;
      if (t >= nrows_wave) continue;
      const int m = t * 4 + wave;
      const float r = rsqrtf(ss[k] * (1.f / 1024.f) + EPS);
      if (which == 3) {
        float4* o = (float4*)(p.out + (size_t)m * 1024);
#pragma unroll
        for (int i = 0; i < 4; ++i) {
          float4 g = ((const float4*)p.final_norm)[i * 64 + lane];
          float4 y; y.x = v[k][i].x * r * g.x; y.y = v[k][i].y * r * g.y; y.z = v[k][i].z * r * g.z; y.w = v[k][i].w * r * g.w;
          o[i * 64 + lane] = y;
        }
      } else {
        const float* md = p.mod + (size_t)(l * 3 + grp_of(m)) * 9216 + which * 3072;
        const float4* sh = (const float4*)md;
        const float4* sc = (const float4*)(md + 1024);
        const float4* gg = (const float4*)(p.norm_g + (size_t)(l * 3 + which) * 1024);
#pragma unroll
        for (int i = 0; i < 4; ++i) {
          float4 g = gg[i * 64 + lane], s = sc[i * 64 + lane], b = sh[i * 64 + lane];
          float y0 = v[k][i].x * r * g.x * (1.f + s.x) + b.x;
          float y1 = v[k][i].y * r * g.y * (1.f + s.y) + b.y;
          float y2 = v[k][i].z * r * g.z * (1.f + s.z) + b.z;
          float y3 = v[k][i].w * r * g.w * (1.f + s.w) + b.w;
          uint2 o; o.x = pack2(y0, y1); o.y = pack2(y2, y3);
          *(uint2*)(p.xn + (size_t)m * 1024 + (i * 64 + lane) * 4) = o;
        }
      }
    }
  }
}

struct EpiP {
  float* C; int ldc;
  const float* gate;
  u16* H;
  u16 *kb, *vtp, *vts; int ctx;
};
enum { EPI_STORE = 0, EPI_RESID = 1, EPI_SWIGLU = 2, EPI_KVUP = 3 };

template <int FI, int FJ, bool SWAP>
__device__ __forceinline__ void g_compute(f32x4 (&acc)[FI][FJ], const u16* Ac, const u16* Bc, int q4, int rsw) {
  __builtin_amdgcn_s_setprio(1);
#pragma unroll
  for (int ks = 0; ks < 2; ++ks) {
    const int co = ((ks * 4 + q4) ^ rsw) << 3;
#pragma unroll
    for (int j0 = 0; j0 < FJ; j0 += 4) {
      bf16x8 b[4];
#pragma unroll
      for (int j = 0; j < 4; ++j) if (j0 + j < FJ) b[j] = *(const bf16x8*)(Bc + (j0 + j) * 1024 + co);
#pragma unroll
      for (int i0 = 0; i0 < FI; i0 += 4) {
        bf16x8 a[4];
#pragma unroll
        for (int i = 0; i < 4; ++i) if (i0 + i < FI) a[i] = *(const bf16x8*)(Ac + (i0 + i) * 1024 + co);
#pragma unroll
        for (int j = 0; j < 4; ++j)
          if (j0 + j < FJ) {
#pragma unroll
            for (int i = 0; i < 4; ++i)
              if (i0 + i < FI) acc[i0 + i][j0 + j] = SWAP ? mfma16(b[j], a[i], acc[i0 + i][j0 + j]) : mfma16(a[i], b[j], acc[i0 + i][j0 + j]);
          }
      }
    }
  }
  __builtin_amdgcn_s_setprio(0);
}

template <int EPI, int WMW, int WNW, int FI, int FJ, int DEPTH>
__device__ __forceinline__ void gemm_tile(const u16* __restrict__ A, const u16* __restrict__ Wt, int K, int tm, int tn, const EpiP& e, char* smem) {
  constexpr int BM = WMW * FI * 16, BN = WNW * FJ * 16;
  constexpr int NA = BM / 64, NB = BN / 64;
  constexpr int BUFSZ = (BM + BN) * 64;
  static_assert(WMW * WNW == 8 && BM % 64 == 0 && BN % 64 == 0, "tile");
  u16* As = (u16*)smem;
  u16* Bs = As + BM * 64;
  const int tid = rtid(), lane = tid & 63, wave = tid >> 6, wm = wave / WNW, wn = wave % WNW, l15 = lane & 15, q4 = lane >> 4;
  const int lr = tid >> 3, lc = tid & 7;
  const u16* Ag = A + (size_t)(tm * BM + lr) * K + lc * 8;
  const u16* Bg = Wt + (size_t)(tn * BN + lr) * K + lc * 8;
  const int st_off = lr * 64 + ((lc ^ ((lr >> 1) & 7)) << 3);
  const int rsw = (l15 >> 1) & 7;
  const int a_row = (wm * FI * 16 + l15) * 64, b_row = (wn * FJ * 16 + l15) * 64;
  f32x4 acc[FI][FJ];
#pragma unroll
  for (int i = 0; i < FI; ++i)
#pragma unroll
    for (int j = 0; j < FJ; ++j) acc[i][j] = (f32x4){0.f, 0.f, 0.f, 0.f};
  const int nk = K >> 6;
#define GL(RA, RB, KT) { _Pragma("unroll") for (int i = 0; i < NA; ++i) RA[i] = *(const u32x4*)(Ag + (size_t)i * 64 * K + (KT) * 64); \
                         _Pragma("unroll") for (int i = 0; i < NB; ++i) RB[i] = *(const u32x4*)(Bg + (size_t)i * 64 * K + (KT) * 64); }
#define GS(RA, RB, BUF) { _Pragma("unroll") for (int i = 0; i < NA; ++i) *(u32x4*)(As + (BUF) * BUFSZ + st_off + i * 4096) = RA[i]; \
                          _Pragma("unroll") for (int i = 0; i < NB; ++i) *(u32x4*)(Bs + (BUF) * BUFSZ + st_off + i * 4096) = RB[i]; }
  if constexpr (DEPTH == 4) {
    static_assert(WMW == 4 && WNW == 2 && FJ == 4 && (FI == 3 || FI == 4), "ring4 tile");
    constexpr int ST = (BM + BN) * 32;
    const int nk32 = K >> 5;
    const int fs = (-(tid >> 4)) & 3;
    const int sc = ((tid & 3) ^ fs) << 3;
    const int r4 = tid >> 2;
    const bool three = (BM == 256) || (tid < 256);
    const u16* sp0 = A + (size_t)(tm * BM + r4) * K + sc;
    const int lo0 = tid * 8;
    const u16* sp1; int lo1; const u16* sp2; int lo2;
    if (BM == 256) {
      sp1 = A + (size_t)(tm * BM + 128 + r4) * K + sc;  lo1 = (tid + 512) * 8;
      sp2 = Wt + (size_t)(tn * BN + r4) * K + sc;       lo2 = BM * 32 + tid * 8;
    } else if (tid < 256) {
      sp1 = A + (size_t)(tm * BM + 128 + r4) * K + sc;  lo1 = (tid + 512) * 8;
      sp2 = Wt + (size_t)(tn * BN + 64 + r4) * K + sc;  lo2 = BM * 32 + (tid + 256) * 8;
    } else {
      sp1 = Wt + (size_t)(tn * BN + (r4 - 64)) * K + sc; lo1 = BM * 32 + (tid - 256) * 8;
      sp2 = sp1; lo2 = lo1;
    }
    const int fr = (-(l15 >> 2)) & 3;
    const int co3 = (q4 ^ fr) << 3;
    const int a_row3 = (wm * FI * 16 + l15) * 32 + co3, b_row3 = BM * 32 + (wn * FJ * 16 + l15) * 32 + co3;
    const unsigned lbase = (unsigned)(size_t)As;
#define GD4(KT, BUF) { __builtin_amdgcn_global_load_lds((const unsigned*)(sp0 + (KT) * 32), (unsigned*)(As + (BUF) * ST + lo0), 16, 0, 0); \
                       __builtin_amdgcn_global_load_lds((const unsigned*)(sp1 + (KT) * 32), (unsigned*)(As + (BUF) * ST + lo1), 16, 0, 0); \
                       if (three) __builtin_amdgcn_global_load_lds((const unsigned*)(sp2 + (KT) * 32), (unsigned*)(As + (BUF) * ST + lo2), 16, 0, 0); }
    asm volatile("s_waitcnt vmcnt(0)" ::: "memory");
    GD4(0, 0);
    if (nk32 > 1) GD4(1, 1);
    if (nk32 > 2) GD4(2, 2);
#define RING4_STEP(J) { \
      const int kt = kt0 + (J); \
      if (kt + 2 < nk32) { if (three) asm volatile("s_waitcnt vmcnt(6)" ::: "memory"); else asm volatile("s_waitcnt vmcnt(4)" ::: "memory"); } \
      else if (kt + 1 < nk32) { if (three) asm volatile("s_waitcnt vmcnt(3)" ::: "memory"); else asm volatile("s_waitcnt vmcnt(2)" ::: "memory"); } \
      else asm volatile("s_waitcnt vmcnt(0)" ::: "memory"); \
      asm volatile("s_waitcnt lgkmcnt(0)" ::: "memory"); \
      __builtin_amdgcn_s_barrier(); \
      asm volatile("" ::: "memory"); \
      const unsigned aad = lbase + (unsigned)(((J) * ST + a_row3) * 2); \
      const unsigned bad = lbase + (unsigned)(((J) * ST + b_row3) * 2); \
      bf16x8 b0, b1, b2, b3, a0, a1, a2, a3; \
      asm volatile("ds_read_b128 %0, %1" : "=v"(b0) : "v"(bad)); \
      asm volatile("ds_read_b128 %0, %1 offset:1024" : "=v"(b1) : "v"(bad)); \
      asm volatile("ds_read_b128 %0, %1 offset:2048" : "=v"(b2) : "v"(bad)); \
      asm volatile("ds_read_b128 %0, %1 offset:3072" : "=v"(b3) : "v"(bad)); \
      asm volatile("ds_read_b128 %0, %1" : "=v"(a0) : "v"(aad)); \
      asm volatile("ds_read_b128 %0, %1 offset:1024" : "=v"(a1) : "v"(aad)); \
      asm volatile("ds_read_b128 %0, %1 offset:2048" : "=v"(a2) : "v"(aad)); \
      if (FI == 4) { asm volatile("ds_read_b128 %0, %1 offset:3072" : "=v"(a3) : "v"(aad)); \
        asm volatile("s_waitcnt lgkmcnt(0)" : "+v"(b0), "+v"(b1), "+v"(b2), "+v"(b3), "+v"(a0), "+v"(a1), "+v"(a2), "+v"(a3)); } \
      else { asm volatile("s_waitcnt lgkmcnt(0)" : "+v"(b0), "+v"(b1), "+v"(b2), "+v"(b3), "+v"(a0), "+v"(a1), "+v"(a2)); a3 = a2; } \
      __builtin_amdgcn_s_setprio(1); \
      { bf16x8 bb[4] = {b0, b1, b2, b3}; bf16x8 aa[4] = {a0, a1, a2, a3}; \
        _Pragma("unroll") for (int j = 0; j < 4; ++j) \
          _Pragma("unroll") for (int i = 0; i < FI; ++i) acc[i][j] = mfma16(bb[j], aa[i], acc[i][j]); } \
      __builtin_amdgcn_s_setprio(0); \
      if (kt + 3 < nk32) GD4(kt + 3, ((J) + 3) & 3);     \
      }
    for (int kt0 = 0; kt0 < nk32; kt0 += 4) {
      RING4_STEP(0) RING4_STEP(1) RING4_STEP(2) RING4_STEP(3)
    }
#undef RING4_STEP
#undef GD4
    __syncthreads();
  } else if constexpr (DEPTH == 3) {
    constexpr int ST = (BM + BN) * 32;
    constexpr int NA4 = BM * 4 / 512, NB4 = BN * 4 / 512;
    const int nk32 = K >> 5;
    const int fs = (-(tid >> 4)) & 3;
    const u16* Ad = A + (size_t)(tm * BM + (tid >> 2)) * K + (((tid & 3) ^ fs) << 3);
    const u16* Bd = Wt + (size_t)(tn * BN + (tid >> 2)) * K + (((tid & 3) ^ fs) << 3);
    u16* Al = As + tid * 8;
    u16* Bl = As + BM * 32 + tid * 8;
    const int fr = (-(l15 >> 2)) & 3;
    const int co3 = (q4 ^ fr) << 3;
    const int a_row3 = (wm * FI * 16 + l15) * 32 + co3, b_row3 = BM * 32 + (wn * FJ * 16 + l15) * 32 + co3;
    static_assert(FI == 8 && FJ == 4, "ring path is written for 8x4 fragments per wave");
    const unsigned lbase = (unsigned)(size_t)As;
#define GD3(KT, BUF) { _Pragma("unroll") for (int i = 0; i < NA4; ++i) __builtin_amdgcn_global_load_lds((const unsigned*)(Ad + (size_t)i * 128 * K + (KT) * 32), (unsigned*)(Al + (BUF) * ST + i * 4096), 16, 0, 0); \
                       _Pragma("unroll") for (int i = 0; i < NB4; ++i) __builtin_amdgcn_global_load_lds((const unsigned*)(Bd + (size_t)i * 128 * K + (KT) * 32), (unsigned*)(Bl + (BUF) * ST + i * 4096), 16, 0, 0); }
    asm volatile("s_waitcnt vmcnt(0)" ::: "memory");
    GD3(0, 0);
    if (nk32 > 1) GD3(1, 1);
    if (nk32 > 2) GD3(2, 2);
#define RING_STEP(J) { \
      const int kt = kt0 + (J); \
      if (kt + 2 < nk32) asm volatile("s_waitcnt vmcnt(%0)" :: "n"(2 * (NA4 + NB4)) : "memory"); \
      else if (kt + 1 < nk32) asm volatile("s_waitcnt vmcnt(%0)" :: "n"(NA4 + NB4) : "memory"); \
      else asm volatile("s_waitcnt vmcnt(0)" ::: "memory"); \
      asm volatile("s_waitcnt lgkmcnt(0)" ::: "memory"); \
      __builtin_amdgcn_s_barrier(); \
      asm volatile("" ::: "memory"); \
      const unsigned aad = lbase + (unsigned)(((J) * ST + a_row3) * 2); \
      const unsigned bad = lbase + (unsigned)(((J) * ST + b_row3) * 2); \
      bf16x8 b0, b1, b2, b3, a0, a1, a2, a3; \
      asm volatile("ds_read_b128 %0, %1" : "=v"(b0) : "v"(bad)); \
      asm volatile("ds_read_b128 %0, %1 offset:1024" : "=v"(b1) : "v"(bad)); \
      asm volatile("ds_read_b128 %0, %1 offset:2048" : "=v"(b2) : "v"(bad)); \
      asm volatile("ds_read_b128 %0, %1 offset:3072" : "=v"(b3) : "v"(bad)); \
      asm volatile("ds_read_b128 %0, %1" : "=v"(a0) : "v"(aad)); \
      asm volatile("ds_read_b128 %0, %1 offset:1024" : "=v"(a1) : "v"(aad)); \
      asm volatile("ds_read_b128 %0, %1 offset:2048" : "=v"(a2) : "v"(aad)); \
      asm volatile("ds_read_b128 %0, %1 offset:3072" : "=v"(a3) : "v"(aad)); \
      __builtin_amdgcn_s_setprio(1); \
      asm volatile("s_waitcnt lgkmcnt(3)" : "+v"(b0), "+v"(b1), "+v"(b2), "+v"(b3), "+v"(a0)); \
      acc[0][0] = mfma16(b0, a0, acc[0][0]); acc[0][1] = mfma16(b1, a0, acc[0][1]); acc[0][2] = mfma16(b2, a0, acc[0][2]); acc[0][3] = mfma16(b3, a0, acc[0][3]); \
      asm volatile("s_waitcnt lgkmcnt(2)" : "+v"(a1)); \
      acc[1][0] = mfma16(b0, a1, acc[1][0]); acc[1][1] = mfma16(b1, a1, acc[1][1]); acc[1][2] = mfma16(b2, a1, acc[1][2]); acc[1][3] = mfma16(b3, a1, acc[1][3]); \
      asm volatile("s_waitcnt lgkmcnt(1)" : "+v"(a2)); \
      acc[2][0] = mfma16(b0, a2, acc[2][0]); acc[2][1] = mfma16(b1, a2, acc[2][1]); acc[2][2] = mfma16(b2, a2, acc[2][2]); acc[2][3] = mfma16(b3, a2, acc[2][3]); \
      asm volatile("s_waitcnt lgkmcnt(0)" : "+v"(a3)); \
      acc[3][0] = mfma16(b0, a3, acc[3][0]); acc[3][1] = mfma16(b1, a3, acc[3][1]); acc[3][2] = mfma16(b2, a3, acc[3][2]); acc[3][3] = mfma16(b3, a3, acc[3][3]); \
      if (kt + 3 < nk32) GD3(kt + 3, ((J) + 3) & 3);     \
      asm volatile("ds_read_b128 %0, %1 offset:4096" : "=v"(a0) : "v"(aad)); \
      asm volatile("ds_read_b128 %0, %1 offset:5120" : "=v"(a1) : "v"(aad)); \
      asm volatile("ds_read_b128 %0, %1 offset:6144" : "=v"(a2) : "v"(aad)); \
      asm volatile("ds_read_b128 %0, %1 offset:7168" : "=v"(a3) : "v"(aad)); \
      asm volatile("s_waitcnt lgkmcnt(3)" : "+v"(a0), "+v"(b0), "+v"(b1), "+v"(b2), "+v"(b3)); \
      acc[4][0] = mfma16(b0, a0, acc[4][0]); acc[4][1] = mfma16(b1, a0, acc[4][1]); acc[4][2] = mfma16(b2, a0, acc[4][2]); acc[4][3] = mfma16(b3, a0, acc[4][3]); \
      asm volatile("s_waitcnt lgkmcnt(2)" : "+v"(a1)); \
      acc[5][0] = mfma16(b0, a1, acc[5][0]); acc[5][1] = mfma16(b1, a1, acc[5][1]); acc[5][2] = mfma16(b2, a1, acc[5][2]); acc[5][3] = mfma16(b3, a1, acc[5][3]); \
      asm volatile("s_waitcnt lgkmcnt(1)" : "+v"(a2)); \
      acc[6][0] = mfma16(b0, a2, acc[6][0]); acc[6][1] = mfma16(b1, a2, acc[6][1]); acc[6][2] = mfma16(b2, a2, acc[6][2]); acc[6][3] = mfma16(b3, a2, acc[6][3]); \
      asm volatile("s_waitcnt lgkmcnt(0)" : "+v"(a3)); \
      acc[7][0] = mfma16(b0, a3, acc[7][0]); acc[7][1] = mfma16(b1, a3, acc[7][1]); acc[7][2] = mfma16(b2, a3, acc[7][2]); acc[7][3] = mfma16(b3, a3, acc[7][3]); \
      __builtin_amdgcn_s_setprio(0); }
    for (int kt0 = 0; kt0 < nk32; kt0 += 4) {
      RING_STEP(0) RING_STEP(1) RING_STEP(2) RING_STEP(3)
    }
#undef RING_STEP
#undef GD3
    __syncthreads();
  } else if constexpr (DEPTH == 0) {
    const int swz = (lr >> 1) & 7;
    const u16* Ad = A + (size_t)(tm * BM + lr) * K + ((lc ^ swz) << 3);
    const u16* Bd = Wt + (size_t)(tn * BN + lr) * K + ((lc ^ swz) << 3);
    u16* Al = As + tid * 8;
    u16* Bl = Bs + tid * 8;
#define GD(KT, BUF) { _Pragma("unroll") for (int i = 0; i < NA; ++i) __builtin_amdgcn_global_load_lds((const unsigned*)(Ad + (size_t)i * 64 * K + (KT) * 64), (unsigned*)(Al + (BUF) * BUFSZ + i * 4096), 16, 0, 0); \
                      _Pragma("unroll") for (int i = 0; i < NB; ++i) __builtin_amdgcn_global_load_lds((const unsigned*)(Bd + (size_t)i * 64 * K + (KT) * 64), (unsigned*)(Bl + (BUF) * BUFSZ + i * 4096), 16, 0, 0); }
    GD(0, 0);
    asm volatile("s_waitcnt vmcnt(0)" ::: "memory");
    __syncthreads();
    for (int kt = 0; kt < nk; kt += 2) {
      if (kt + 1 < nk) GD(kt + 1, 1);
      g_compute<FI, FJ, (EPI != EPI_KVUP)>(acc, As + a_row, Bs + b_row, q4, rsw);
      asm volatile("s_waitcnt vmcnt(0)" ::: "memory");
      __syncthreads();
      if (kt + 1 >= nk) break;
      if (kt + 2 < nk) GD(kt + 2, 0);
      g_compute<FI, FJ, (EPI != EPI_KVUP)>(acc, As + BUFSZ + a_row, Bs + BUFSZ + b_row, q4, rsw);
      asm volatile("s_waitcnt vmcnt(0)" ::: "memory");
      __syncthreads();
    }
#undef GD
  } else if constexpr (DEPTH == 2) {
    u32x4 ra0[NA], rb0[NB], ra1[NA], rb1[NB];
    GL(ra0, rb0, 0);
    if (nk > 1) GL(ra1, rb1, 1);
    GS(ra0, rb0, 0);
    __syncthreads();
    for (int kt = 0; kt < nk; kt += 2) {
      if (kt + 2 < nk) GL(ra0, rb0, kt + 2);
      g_compute<FI, FJ, (EPI != EPI_KVUP)>(acc, As + a_row, Bs + b_row, q4, rsw);
      if (kt + 1 < nk) GS(ra1, rb1, 1);
      __syncthreads();
      if (kt + 1 >= nk) break;
      if (kt + 3 < nk) GL(ra1, rb1, kt + 3);
      g_compute<FI, FJ, (EPI != EPI_KVUP)>(acc, As + BUFSZ + a_row, Bs + BUFSZ + b_row, q4, rsw);
      if (kt + 2 < nk) GS(ra0, rb0, 0);
      __syncthreads();
    }
  } else {
    u32x4 ra0[NA], rb0[NB];
    GL(ra0, rb0, 0);
    GS(ra0, rb0, 0);
    __syncthreads();
    for (int kt = 0; kt < nk; kt += 2) {
      if (kt + 1 < nk) GL(ra0, rb0, kt + 1);
      g_compute<FI, FJ, (EPI != EPI_KVUP)>(acc, As + a_row, Bs + b_row, q4, rsw);
      if (kt + 1 < nk) GS(ra0, rb0, 1);
      __syncthreads();
      if (kt + 1 >= nk) break;
      if (kt + 2 < nk) GL(ra0, rb0, kt + 2);
      g_compute<FI, FJ, (EPI != EPI_KVUP)>(acc, As + BUFSZ + a_row, Bs + BUFSZ + b_row, q4, rsw);
      if (kt + 2 < nk) GS(ra0, rb0, 0);
      __syncthreads();
    }
  }
#undef GL
#undef GS
  const int mb = tm * BM + wm * FI * 16 + q4 * 4;
  const int nb = tn * BN + wn * FJ * 16;
  const int mrow = tm * BM + wm * FI * 16 + l15;
  if (EPI == EPI_STORE) {
#pragma unroll
    for (int i = 0; i < FI; ++i)
#pragma unroll
      for (int j = 0; j < FJ; ++j) *(f32x4*)(e.C + (size_t)(mrow + i * 16) * e.ldc + nb + j * 16 + q4 * 4) = acc[i][j];
  } else if (EPI == EPI_RESID) {
    const float cf = e.ldc ? 0.5f : 1.0f;
    const f32x4 cfv = {cf, cf, cf, cf};
#pragma unroll
    for (int i = 0; i < FI; ++i) {
      const int m = mrow + i * 16;
      const float* gt = e.gate + (size_t)grp_of(m) * 9216;
#pragma unroll
      for (int j = 0; j < FJ; ++j) {
        const int n = nb + j * 16 + q4 * 4;
        f32x4 g = *(const f32x4*)(gt + n);
        f32x4* px = (f32x4*)(e.C + (size_t)m * 1024 + n);
        f32x4 xv = *px;
        xv += g * cfv * acc[i][j];
        *px = xv;
      }
    }
  } else if (EPI == EPI_SWIGLU) {
    const bool odd = (q4 & 1) != 0;
#pragma unroll
    for (int j = 0; j < FJ; ++j) {
      const int hj = ((nb >> 4) + j) * 8 + (q4 >> 1) * 4;
#pragma unroll
      for (int i2 = 0; i2 < FI / 2; ++i2) {
        float hv[4];
#pragma unroll
        for (int r = 0; r < 4; ++r) {
          float send = odd ? acc[2 * i2][j][r] : acc[2 * i2 + 1][j][r];
          float recv = shx(send, 16);
          float g = odd ? recv : acc[2 * i2][j][r];
          float u = odd ? acc[2 * i2 + 1][j][r] : recv;
          hv[r] = silu_f(g) * u;
        }
        const int m = mrow + (2 * i2 + (odd ? 1 : 0)) * 16;
        uint2 o; o.x = pack2(hv[0], hv[1]); o.y = pack2(hv[2], hv[3]);
        *(uint2*)(e.H + (size_t)m * 2816 + hj) = o;
      }
    }
  } else if (EPI == EPI_KVUP) {
#pragma unroll
    for (int j = 0; j < FJ; ++j) {
      const int n0 = nb + j * 16;
      const int hh = n0 >> 7, wb = n0 & 127;
#pragma unroll
      for (int i = 0; i < FI; ++i) {
        const int m0 = mb + i * 16;
        int krow; u16* vt;
        if (e.ctx) {
          int b = m0 >> 9, key = m0 & 511;
          krow = NPR + b * 1536 + 1024 + key;
          vt = e.vts + (size_t)((b * 8 + hh) * 64) * 1536 + 1024 + key;
        } else if (m0 < NPR) {
          int b = m0 >> 8, t = m0 & 255;
          krow = m0;
          vt = e.vtp + (size_t)((b * 8 + hh) * 64) * 256 + t;
        } else {
          int s = m0 - NPR, b = s >> 10, t = s & 1023;
          krow = NPR + b * 1536 + t;
          vt = e.vts + (size_t)((b * 8 + hh) * 64) * 1536 + t;
        }
        if (wb < 64) {
#pragma unroll
          for (int r = 0; r < 4; ++r) e.kb[(size_t)(krow + r) * 768 + hh * 96 + wb + l15] = f2bf(acc[i][j][r]);
        } else {
          const int d = wb - 64 + l15;
          const size_t L = (e.ctx || m0 >= NPR) ? 1536 : 256;
          uint2 o; o.x = pack2(acc[i][j][0], acc[i][j][1]); o.y = pack2(acc[i][j][2], acc[i][j][3]);
          *(uint2*)(vt + (size_t)d * L) = o;
        }
      }
    }
  }
}

template <int EPI, int WMW, int WNW, int FI, int FJ, int DEPTH>
__device__ __forceinline__ void gemm_phase(const u16* A, const u16* Wt, int K, int Mt, int Nt, const EpiP& e, char* smem) {
  for (int t = rbid(); t < Mt * Nt; t += (int)gridDim.x) gemm_tile<EPI, WMW, WNW, FI, FJ, DEPTH>(A, Wt, K, t % Mt, t / Mt, e, smem);
}

__device__ __forceinline__ void ffn_in_phase(PRM p, int l, int which, const EpiP& e, char* smem) {
  const u16* Wt = p.wt_ffn_in + (size_t)(l * 2 + which) * 5632 * 1024;
  const int G = (int)gridDim.x;
  const int nfull = (528 / G) * G;
  for (int t = rbid(); t < nfull; t += G) gemm_tile<EPI_SWIGLU, 2, 4, 8, 4, 3>(p.xn, Wt, 1024, t % 24, t / 24, e, smem);
  const int nq = (528 - nfull) * 4;
  const int bid = rbid();
  for (int u = bid; u < nq; u += G) {
    const int t = nfull + (u >> 2), sub = u & 3;
    gemm_tile<EPI_SWIGLU, 4, 2, 2, 4, 2>(p.xn, Wt, 1024, (t % 24) * 2 + (sub >> 1), (t / 24) * 2 + (sub & 1), e, smem);
  }
  const int tail = nq < G ? nq : G;
  if (l < 3 && bid >= tail) {
    const int vb = rtid() >> 8;
    char* vsm = smem + vb * LDS_HALF;
    const int nfree = (G - tail) * 2;
    const int vrank = (bid - tail) * 2 + vb;
    const int cnt = conv_layer_count(l + 1);
    const int half = cnt >> 1;
    const int lo = which ? half : 0, hi = which ? cnt : half;
    for (int c = lo + vrank; c < hi; c += nfree) conv_layer_task(p, l + 1, c, (float*)vsm);
    for (int c = vrank; c < 72; c += nfree) mod_task(p, (l + 1) * 144 + which * 72 + c, (float*)vsm);
  }
}

__device__ __forceinline__ void rope_store_kb(PRM p, float val, int lane, int t, bool sample, int krow) {
  float outv = val;
  if (sample) {
    float partner = shx(val, 8);
    int w = lane & 15, fi = w & 7;
    float pos = (float)((lane & 16) ? (t & 63) : (t >> 6));
    float fr = __expf(-9.210340372f * (float)fi * 0.125f);
    float s, c; sincos_r(pos * fr, s, c);
    outv = (w < 8) ? val * c - partner * s : val * c + partner * s;
  }
  if (lane < 32) {
    u16 b = f2bf(outv);
#pragma unroll
    for (int h = 0; h < 8; ++h) p.kb[(size_t)krow * 768 + h * 96 + 64 + lane] = b;
  }
}

__device__ __forceinline__ void post_even(PRM p, int e) {
  const int tid = get_tid(), lane = tid & 63, wave = tid >> 6;
  const int NT = NTOK / 4;
  const int NC = 256;
  for (int task = get_bid(); task < NT + NC; task += vgrid()) {
    if (task < NT) {
      const int m0 = task * 4, m = m0 + wave;
      const bool pr = m < NPR;
      const int b = pr ? (m >> 8) : ((m - NPR) >> 10);
      const int t = pr ? (m & 255) : ((m - NPR) & 1023);
      const float* row = p.proj + (size_t)m * 2688;
      {
        float4 a0 = *(const float4*)(row + lane * 8), a1 = *(const float4*)(row + lane * 8 + 4);
        uint4 o; o.x = pack2(a0.x, a0.y); o.y = pack2(a0.z, a0.w); o.z = pack2(a1.x, a1.y); o.w = pack2(a1.z, a1.w);
        *(uint4*)(p.qa + (size_t)m * 512 + lane * 8) = o;
        float4 k0 = *(const float4*)(row + 512 + lane * 8), k1 = *(const float4*)(row + 512 + lane * 8 + 4);
        o.x = pack2(k0.x, k0.y); o.y = pack2(k0.z, k0.w); o.z = pack2(k1.x, k1.y); o.w = pack2(k1.z, k1.w);
        *(uint4*)(p.ka + (size_t)m * 512 + lane * 8) = o;
        if (pr) {
          float* ok = p.out + O_AK + ((size_t)(b * 2 + e) * 256 + t) * 512 + lane * 8;
          *(float4*)ok = k0; *(float4*)(ok + 4) = k1;
          float4 v0 = *(const float4*)(row + 1024 + lane * 8), v1 = *(const float4*)(row + 1024 + lane * 8 + 4);
          float* ov = p.out + O_AV + ((size_t)(b * 2 + e) * 256 + t) * 512 + lane * 8;
          *(float4*)ov = v0; *(float4*)(ov + 4) = v1;
        }
      }
      {
        float4 c0 = *(const float4*)(row + 1536 + lane * 12), c1 = *(const float4*)(row + 1536 + lane * 12 + 4), c2 = *(const float4*)(row + 1536 + lane * 12 + 8);
        float ss = c0.x * c0.x + c0.y * c0.y + c0.z * c0.z + c0.w * c0.w + c1.x * c1.x + c1.y * c1.y + c1.z * c1.z + c1.w * c1.w +
                   c2.x * c2.x + c2.y * c2.y + c2.z * c2.z + c2.w * c2.w;
        ss = wsum(ss);
        float r = rsqrtf(ss * (1.f / 768.f) + EPS);
        const float* g = p.b_q_norm + e * 768 + lane * 12;
        float4 g0 = *(const float4*)g, g1 = *(const float4*)(g + 4), g2 = *(const float4*)(g + 8);
        uint2 o0, o1, o2;
        o0.x = pack2(c0.x * r * g0.x, c0.y * r * g0.y); o0.y = pack2(c0.z * r * g0.z, c0.w * r * g0.w);
        o1.x = pack2(c1.x * r * g1.x, c1.y * r * g1.y); o1.y = pack2(c1.z * r * g1.z, c1.w * r * g1.w);
        o2.x = pack2(c2.x * r * g2.x, c2.y * r * g2.y); o2.y = pack2(c2.z * r * g2.z, c2.w * r * g2.w);
        u16* d = p.cqn + (size_t)m * 768 + lane * 12;
        *(uint2*)d = o0; *(uint2*)(d + 4) = o1; *(uint2*)(d + 8) = o2;
      }
      {
        float4 c0 = *(const float4*)(row + 2304 + lane * 4);
        float ss = wsum(c0.x * c0.x + c0.y * c0.y + c0.z * c0.z + c0.w * c0.w);
        float r = rsqrtf(ss * (1.f / 256.f) + EPS);
        float4 g0 = *(const float4*)(p.b_kv_norm + e * 256 + lane * 4);
        float4 y; y.x = c0.x * r * g0.x; y.y = c0.y * r * g0.y; y.z = c0.z * r * g0.z; y.w = c0.w * r * g0.w;
        uint2 o; o.x = pack2(y.x, y.y); o.y = pack2(y.z, y.w);
        *(uint2*)(p.ckvn + (size_t)m * 256 + lane * 4) = o;
        if (pr) *(float4*)(p.out + O_CKV + ((size_t)(b * 2 + e) * 256 + t) * 256 + lane * 4) = y;
      }
      {
        float val = row[2560 + (lane & 31)];
        if (pr && lane < 32) p.out[O_KR + ((size_t)(b * 2 + e) * 256 + t) * 32 + lane] = val;
        rope_store_kb(p, val, lane, t, !pr, keyrow(m));
      }
      {
        const bool pr0 = m0 < NPR;
        const int b0 = pr0 ? (m0 >> 8) : ((m0 - NPR) >> 10);
        const int t0 = pr0 ? (m0 & 255) : ((m0 - NPR) & 1023);
#pragma unroll
        for (int i = 0; i < 2; ++i) {
          int pp = tid + 256 * i, h = pp >> 6, d = pp & 63;
          const float* src = p.proj + (size_t)m0 * 2688 + 1024 + h * 64 + d;
          float v0 = src[0], v1 = src[2688], v2 = src[2 * 2688], v3 = src[3 * 2688];
          uint2 o; o.x = pack2(v0, v1); o.y = pack2(v2, v3);
          u16* dst = pr0 ? p.vta_p + (size_t)((b0 * 8 + h) * 64 + d) * 256 + t0 : p.vta_s + (size_t)((b0 * 8 + h) * 64 + d) * 1536 + t0;
          *(uint2*)dst = o;
        }
      }
    } else {
      const int ct = task - NT;
      const int b = ct >> 7, key0 = (ct & 127) * 4;
      {
        const float* src = p.cache_a_k + ((size_t)(b * 2 + e) * 512 + key0) * 512;
        u16* dst = p.kactx + ((size_t)b * 512 + key0) * 512;
#pragma unroll
        for (int i = 0; i < 2; ++i) {
          int idx = (tid + 256 * i) * 4;
          float4 v = *(const float4*)(src + idx);
          uint2 o; o.x = pack2(v.x, v.y); o.y = pack2(v.z, v.w);
          *(uint2*)(dst + idx) = o;
        }
      }
      {
        const float* src = p.cache_a_v + ((size_t)(b * 2 + e) * 512 + key0) * 512;
#pragma unroll
        for (int i = 0; i < 2; ++i) {
          int pp = tid + 256 * i, h = pp >> 6, d = pp & 63;
          float v0 = src[pp], v1 = src[512 + pp], v2 = src[1024 + pp], v3 = src[1536 + pp];
          uint2 o; o.x = pack2(v0, v1); o.y = pack2(v2, v3);
          *(uint2*)(p.vta_s + (size_t)((b * 8 + h) * 64 + d) * 1536 + 1024 + key0) = o;
        }
      }
      {
        const float* src = p.cache_b_ckv + ((size_t)(b * 2 + e) * 512 + key0) * 256;
        float4 v = *(const float4*)(src + tid * 4);
        uint2 o; o.x = pack2(v.x, v.y); o.y = pack2(v.z, v.w);
        *(uint2*)(p.cctxn + ((size_t)b * 512 + key0) * 256 + tid * 4) = o;
      }
      {
        const float* src = p.cache_b_krope + ((size_t)(b * 2 + e) * 512 + key0) * 32;
#pragma unroll
        for (int i = 0; i < 4; ++i) {
          int idx = tid + 256 * i;
          int kk = idx >> 8, h = (idx >> 5) & 7, dd = idx & 31;
          p.kb[(size_t)(NPR + b * 1536 + 1024 + key0 + kk) * 768 + h * 96 + 64 + dd] = f2bf(src[kk * 32 + dd]);
        }
      }
    }
  }
}

__device__ __forceinline__ void post_odd(PRM p, int o) {
  const int tid = get_tid(), lane = tid & 63, wave = tid >> 6;
  const int NT = NTOK / 4, NC = 256;
  for (int task = get_bid(); task < NT + NC; task += vgrid()) {
    if (task < NT) {
      const int m0 = task * 4, m = m0 + wave;
      const bool pr = m < NPR;
      const int b = pr ? (m >> 8) : ((m - NPR) >> 10);
      const int t = pr ? (m & 255) : ((m - NPR) & 1023);
      const float* row = p.proj + (size_t)m * 2432;
      float rs = 0.f, rc = 1.f;
      if (!pr) {
        int w = lane & 31, fi = w & 15;
        float pos = (float)((lane & 32) ? (t & 63) : (t >> 6));
        float fr = __expf(-9.210340372f * (float)fi * (1.f / 16.f));
        sincos_r(pos * fr, rs, rc);
      }
      const bool lo = (lane & 16) == 0;
      const float gq = p.d_q_norm[o * 64 + lane], gk = p.d_k_norm[o * 64 + lane];
#pragma unroll
      for (int hd = 0; hd < 8; ++hd) {
        float v = row[1552 + hd * 64 + lane];
        float ss = wsum(v * v);
        float y = v * rsqrtf(ss * (1.f / 64.f) + EPS) * gq;
        if (!pr) { float pt = shx(y, 16); y = lo ? y * rc - pt * rs : y * rc + pt * rs; }
        p.qa[(size_t)m * 512 + hd * 64 + lane] = f2bf(y);
      }
#pragma unroll
      for (int kh = 0; kh < 2; ++kh) {
        float v = row[2064 + kh * 64 + lane];
        float ss = wsum(v * v);
        float y = v * rsqrtf(ss * (1.f / 64.f) + EPS) * gk;
        if (pr) p.out[O_DK + ((size_t)(b * 2 + o) * 256 + t) * 128 + kh * 64 + lane] = y;
        else { float pt = shx(y, 16); y = lo ? y * rc - pt * rs : y * rc + pt * rs; }
        p.kd[(size_t)keyrow(m) * 128 + kh * 64 + lane] = f2bf(y);
        if (pr) p.out[O_DV + ((size_t)(b * 2 + o) * 256 + t) * 128 + kh * 64 + lane] = row[2192 + kh * 64 + lane];
      }
      if (tid < 128) {
        const bool pr0 = m0 < NPR;
        const int b0 = pr0 ? (m0 >> 8) : ((m0 - NPR) >> 10);
        const int t0 = pr0 ? (m0 & 255) : ((m0 - NPR) & 1023);
        int kh = tid >> 6, d = tid & 63;
        const float* src = p.proj + (size_t)m0 * 2432 + 2192 + tid;
        float v0 = src[0], v1 = src[2432], v2 = src[2 * 2432], v3 = src[3 * 2432];
        uint2 oo; oo.x = pack2(v0, v1); oo.y = pack2(v2, v3);
        u16* dst = pr0 ? p.vtd_p + (size_t)((b0 * 2 + kh) * 64 + d) * 256 + t0 : p.vtd_s + (size_t)((b0 * 2 + kh) * 64 + d) * 1536 + t0;
        *(uint2*)dst = oo;
      }
    } else {
      const int ct = task - NT;
      const int b = ct >> 7, key0 = (ct & 127) * 4;
      {
        const float* src = p.cache_d_k + ((size_t)(b * 2 + o) * 512 + key0) * 128;
        if (tid < 128) {
          float4 v = *(const float4*)(src + tid * 4);
          uint2 oo; oo.x = pack2(v.x, v.y); oo.y = pack2(v.z, v.w);
          *(uint2*)(p.kd + (size_t)(NPR + b * 1536 + 1024 + key0) * 128 + tid * 4) = oo;
        } else {
          int pp = tid - 128, kh = pp >> 6, d = pp & 63;
          const float* sv = p.cache_d_v + ((size_t)(b * 2 + o) * 512 + key0) * 128;
          float v0 = sv[pp], v1 = sv[128 + pp], v2 = sv[256 + pp], v3 = sv[384 + pp];
          uint2 oo; oo.x = pack2(v0, v1); oo.y = pack2(v2, v3);
          *(uint2*)(p.vtd_s + (size_t)((b * 2 + kh) * 64 + d) * 1536 + 1024 + key0) = oo;
        }
      }
    }
  }
}

struct AttnSt { float m, l; f32x4 o[4]; };
template <int KS> struct KVf { bf16x8 k0[KS], k1[KS]; s16x4 v0[4], v1[4]; };

template <int KS>
__device__ __forceinline__ void attn_load(KVf<KS>& f, const u16* __restrict__ Kb, int kstride, const u16* __restrict__ Vtb, int vtstride, int l15, int q4) {
  const u16* k0p = Kb + (size_t)l15 * kstride + q4 * 8;
  const u16* k1p = k0p + (size_t)16 * kstride;
#pragma unroll
  for (int ks = 0; ks < KS; ++ks) { f.k0[ks] = *(const bf16x8*)(k0p + ks * 32); f.k1[ks] = *(const bf16x8*)(k1p + ks * 32); }
#pragma unroll
  for (int dt = 0; dt < 4; ++dt) {
    const u16* vp = Vtb + (size_t)(dt * 16 + l15) * vtstride + q4 * 4;
    f.v0[dt] = *(const s16x4*)vp; f.v1[dt] = *(const s16x4*)(vp + 16);
  }
}

template <int KS>
__device__ __forceinline__ void attn_comp(AttnSt& st, const bf16x8 (&qf)[KS], const KVf<KS>& f, float scale, int q4,
                                          bool masked, const float* rpbrow, int qc, int kc0) {
  f32x4 s0 = {0.f, 0.f, 0.f, 0.f}, s1 = {0.f, 0.f, 0.f, 0.f};
#pragma unroll
  for (int ks = 0; ks < KS; ++ks) { s0 = mfma16(f.k0[ks], qf[ks], s0); s1 = mfma16(f.k1[ks], qf[ks], s1); }
  float sv[8];
#pragma unroll
  for (int j = 0; j < 4; ++j) { sv[j] = s0[j] * scale; sv[4 + j] = s1[j] * scale; }
  if (masked) {
    const int cs = min(max(qc - 8, 0), 48);
#pragma unroll
    for (int e = 0; e < 8; ++e) {
      int kc = kc0 + (e >> 2) * 16 + q4 * 4 + (e & 3);
      bool ok = (kc >= cs) && (kc < cs + 16);
      int di = min(max(kc - qc, -15), 15) + 15;
      sv[e] = ok ? sv[e] + rpbrow[di] : -INFINITY;
    }
  }
  float mx = sv[0];
#pragma unroll
  for (int e = 1; e < 8; ++e) mx = fmaxf(mx, sv[e]);
  mx = fmaxf(mx, shx(mx, 16));
  mx = fmaxf(mx, shx(mx, 32));
  const float mnew = fmaxf(st.m, mx);
  const float alpha = __expf(st.m - mnew);
  float pe[8], ls = 0.f;
#pragma unroll
  for (int e = 0; e < 8; ++e) { pe[e] = __expf(sv[e] - mnew); ls += pe[e]; }
  st.l = st.l * alpha + ls;
  st.m = mnew;
  bf16x8 pf;
#pragma unroll
  for (int e = 0; e < 8; ++e) pf[e] = (short)f2bf(pe[e]);
#pragma unroll
  for (int dt = 0; dt < 4; ++dt) {
    bf16x8 vf = (bf16x8){f.v0[dt].x, f.v0[dt].y, f.v0[dt].z, f.v0[dt].w, f.v1[dt].x, f.v1[dt].y, f.v1[dt].z, f.v1[dt].w};
    st.o[dt] *= alpha;
    st.o[dt] = mfma16(vf, pf, st.o[dt]);
  }
}

__device__ __forceinline__ void attn_init(AttnSt& st) {
  st.m = -1e30f; st.l = 0.f;
#pragma unroll
  for (int dt = 0; dt < 4; ++dt) st.o[dt] = (f32x4){0.f, 0.f, 0.f, 0.f};
}
__device__ __forceinline__ void attn_fin(AttnSt& st, u16* outp  , int l15, int q4) {
  float lt = st.l;
  lt += shx(lt, 16);
  lt += shx(lt, 32);
  const float inv = 1.f / lt;
#pragma unroll
  for (int dt = 0; dt < 4; ++dt) {
    uint2 o; o.x = pack2(st.o[dt][0] * inv, st.o[dt][1] * inv); o.y = pack2(st.o[dt][2] * inv, st.o[dt][3] * inv);
    *(uint2*)(outp + (size_t)l15 * 1024 + dt * 16 + q4 * 4) = o;
  }
}

#define AT_VSTR 72
template <int KS> struct ATile { static constexpr int KSTR = KS * 32 + 8; static constexpr int BUF = 64 * (KS * 32 + 8) + 64 * AT_VSTR; };
template <int KS> struct AStage { u32x4 k[KS]; u32x4 v[2]; };

template <int KS>
__device__ __forceinline__ void at_load(AStage<KS>& r, const u16* __restrict__ Kg, int kstride, const u16* __restrict__ Vg, int vtstride, int tid) {
#pragma unroll
  for (int i = 0; i < KS; ++i) {
    int c = tid + 256 * i; int row = c / (KS * 4), ch = c - row * (KS * 4);
    r.k[i] = *(const u32x4*)(Kg + (unsigned)(row * kstride + ch * 8));
  }
#pragma unroll
  for (int i = 0; i < 2; ++i) {
    int c = tid + 256 * i; int row = c >> 3, ch = c & 7;
    r.v[i] = *(const u32x4*)(Vg + (unsigned)(row * vtstride + ch * 8));
  }
}
template <int KS>
__device__ __forceinline__ void at_store(const AStage<KS>& r, u16* buf, int tid) {
  u16* Ks = buf; u16* Vs = buf + 64 * ATile<KS>::KSTR;
#pragma unroll
  for (int i = 0; i < KS; ++i) {
    int c = tid + 256 * i; int row = c / (KS * 4), ch = c - row * (KS * 4);
    *(u32x4*)(Ks + row * ATile<KS>::KSTR + ch * 8) = r.k[i];
  }
#pragma unroll
  for (int i = 0; i < 2; ++i) {
    int c = tid + 256 * i; int row = c >> 3, ch = c & 7;
    *(u32x4*)(Vs + row * AT_VSTR + ch * 8) = r.v[i];
  }
}

template <int KS>
__device__ __forceinline__ void at_comp(AttnSt& st, const bf16x8 (&qf)[KS], const u16* buf, float scale, int l15, int q4,
                                        bool masked, const float* rpbrow, int qc) {
  const u16* Ks = buf; const u16* Vs = buf + 64 * ATile<KS>::KSTR;
  f32x4 s[4];
#pragma unroll
  for (int kt = 0; kt < 4; ++kt) {
    s[kt] = (f32x4){0.f, 0.f, 0.f, 0.f};
#pragma unroll
    for (int ks = 0; ks < KS; ++ks) {
      bf16x8 a = *(const bf16x8*)(Ks + (kt * 16 + l15) * ATile<KS>::KSTR + ks * 32 + q4 * 8);
      s[kt] = mfma16(a, qf[ks], s[kt]);
    }
  }
  float sv[16];
  const float sc2 = scale * 1.4426950408889634f;
#pragma unroll
  for (int kt = 0; kt < 4; ++kt)
#pragma unroll
    for (int j = 0; j < 4; ++j) sv[kt * 4 + j] = s[kt][j] * sc2;
  if (masked) {
    const int cs = min(max(qc - 8, 0), 48);
#pragma unroll
    for (int e = 0; e < 16; ++e) {
      int kc = (e >> 2) * 16 + q4 * 4 + (e & 3);
      bool ok = (kc >= cs) && (kc < cs + 16);
      int di = min(max(kc - qc, -15), 15) + 15;
      sv[e] = ok ? sv[e] + rpbrow[di] : -INFINITY;
    }
  }
  float mx = sv[0];
#pragma unroll
  for (int e = 1; e < 16; ++e) mx = fmaxf(mx, sv[e]);
  mx = fmaxf(mx, shx(mx, 16));
  mx = fmaxf(mx, shx(mx, 32));
  const float mnew = fmaxf(st.m, mx);
  const float alpha = __builtin_amdgcn_exp2f(st.m - mnew);
  float ls = 0.f;
#pragma unroll
  for (int e = 0; e < 16; ++e) { sv[e] = __builtin_amdgcn_exp2f(sv[e] - mnew); ls += sv[e]; }
  st.l = st.l * alpha + ls;
  st.m = mnew;
  bf16x8 pf[2];
#pragma unroll
  for (int hf = 0; hf < 2; ++hf) {
    u32x4 pw;
    pw[0] = pack2(sv[hf * 8 + 0], sv[hf * 8 + 1]); pw[1] = pack2(sv[hf * 8 + 2], sv[hf * 8 + 3]);
    pw[2] = pack2(sv[hf * 8 + 4], sv[hf * 8 + 5]); pw[3] = pack2(sv[hf * 8 + 6], sv[hf * 8 + 7]);
    pf[hf] = __builtin_bit_cast(bf16x8, pw);
  }
#pragma unroll
  for (int dt = 0; dt < 4; ++dt) {
    st.o[dt] *= alpha;
#pragma unroll
    for (int hf = 0; hf < 2; ++hf) {
      const u16* vp = Vs + (dt * 16 + l15) * AT_VSTR + hf * 32 + q4 * 4;
      s16x4 v0 = *(const s16x4*)vp;
      s16x4 v1 = *(const s16x4*)(vp + 16);
      bf16x8 vf = (bf16x8){v0.x, v0.y, v0.z, v0.w, v1.x, v1.y, v1.z, v1.w};
      st.o[dt] = mfma16(vf, pf[hf], st.o[dt]);
    }
  }
}

template <int KS>
__device__ __forceinline__ void at_run_plain(AttnSt& st, const bf16x8 (&qf)[KS], const u16* Kbase, int kstride, const u16* Vbase, int vtstride,
                                             int nt, float scale, u16* lds, int tid, int l15, int q4) {
  AStage<KS> r0, r1;
  at_load<KS>(r0, Kbase, kstride, Vbase, vtstride, tid);
  if (nt > 1) at_load<KS>(r1, Kbase + (size_t)64 * kstride, kstride, Vbase + 64, vtstride, tid);
  at_store<KS>(r0, lds, tid);
  __syncthreads();
  for (int t = 0; t < nt; t += 2) {
    if (t + 2 < nt) at_load<KS>(r0, Kbase + (size_t)(t + 2) * 64 * kstride, kstride, Vbase + (t + 2) * 64, vtstride, tid);
    at_comp<KS>(st, qf, lds, scale, l15, q4, false, nullptr, 0);
    if (t + 1 < nt) at_store<KS>(r1, lds + ATile<KS>::BUF, tid);
    __syncthreads();
    if (t + 1 >= nt) break;
    if (t + 3 < nt) at_load<KS>(r1, Kbase + (size_t)(t + 3) * 64 * kstride, kstride, Vbase + (t + 3) * 64, vtstride, tid);
    at_comp<KS>(st, qf, lds + ATile<KS>::BUF, scale, l15, q4, false, nullptr, 0);
    if (t + 2 < nt) at_store<KS>(r0, lds, tid);
    __syncthreads();
  }
}

__device__ __forceinline__ void load_q64(bf16x8 (&qf)[2], const u16* Q, int qstride, int l15, int q4) {
#pragma unroll
  for (int ks = 0; ks < 2; ++ks) qf[ks] = *(const bf16x8*)(Q + (size_t)l15 * qstride + ks * 32 + q4 * 8);
}
__device__ __forceinline__ void load_q_mla(bf16x8 (&qf)[3], const float* Qf, int l15, int q4, bool sample, int t0) {
  const float* qr = Qf + (size_t)l15 * 768 + q4 * 8;
#pragma unroll
  for (int ks = 0; ks < 3; ++ks) {
    float4 a = *(const float4*)(qr + ks * 32), b = *(const float4*)(qr + ks * 32 + 4);
    float v[8] = {a.x, a.y, a.z, a.w, b.x, b.y, b.z, b.w};
    if (ks == 2 && sample) {
      const int t = t0 + l15;
      const float pos = (float)((q4 & 2) ? (t & 63) : (t >> 6));
#pragma unroll
      for (int jj = 0; jj < 8; ++jj) {
        float pt = shx(v[jj], 16);
        float fr = __expf(-9.210340372f * (float)jj * 0.125f);
        float sn, cs; sincos_r(pos * fr, sn, cs);
        v[jj] = (q4 & 1) ? v[jj] * cs + pt * sn : v[jj] * cs - pt * sn;
      }
    }
#pragma unroll
    for (int jj = 0; jj < 8; ++jj) qf[ks][jj] = (short)f2bf(v[jj]);
  }
}

__device__ __forceinline__ void attn_even_phase(PRM p, int e, char* smem) {
  u16* lds = (u16*)smem;
  const int tid = get_tid(), lane = tid & 63, wave = tid >> 6, l15 = lane & 15, q4 = lane >> 4;
  const float scaleB = 0.10206207261596577f;
  for (int bt = get_bid(); bt < 1536; bt += vgrid()) {
    AttnSt st; attn_init(st);
    if (bt < 256) {
      int qb = bt & 15, h = (bt >> 4) & 7, b = bt >> 7;
      int mq = NPR + b * 1024 + qb * 64 + wave * 16;
      bf16x8 qf[3]; load_q_mla(qf, p.qb + (size_t)mq * 768 + h * 96, l15, q4, true, qb * 64 + wave * 16);
      at_run_plain<3>(st, qf, p.kb + (size_t)(NPR + b * 1536) * 768 + h * 96, 768, p.vtb_s + (size_t)((b * 8 + h) * 64) * 1536, 1536, 24, scaleB, lds, tid, l15, q4);
      attn_fin(st, p.mix + (size_t)mq * 1024 + 512 + h * 64, l15, q4);
    } else if (bt < 512) {
      int u = bt - 256;
      int r = u & 15, h = (u >> 4) & 7, b = u >> 7;
      int mq = NPR + b * 1024 + r * 64 + wave * 16;
      bf16x8 qf[2]; load_q64(qf, p.qa + (size_t)mq * 512 + h * 64, 512, l15, q4);
      const u16* Vt = p.vta_s + (size_t)((b * 8 + h) * 64) * 1536;
      const u16* Kc = p.kactx + (size_t)b * 512 * 512 + h * 64;
      const int rs = min(max(r - 4, 0), 8);
      const u16* Kw = p.ka + (size_t)(NPR + b * 1024 + rs * 64) * 512 + h * 64;
      const float* rpb0 = p.a_rpb + ((size_t)(e * 8 + h) * 15 + (rs - r + 7)) * 31;
      const int qc = wave * 16 + l15;
      float* rpl = (float*)(lds + 2 * ATile<2>::BUF);
      if (tid < 248) { int rr = tid / 31, cc = tid - rr * 31; rpl[rr * 32 + cc] = rpb0[rr * 31 + cc] * 1.4426950408889634f; }
      AStage<2> r0, r1;
#define NB_LOAD(R, T) { if ((T) < 8) at_load<2>(R, Kc + (size_t)(T) * 64 * 512, 512, Vt + 1024 + (T) * 64, 1536, tid); \
                        else at_load<2>(R, Kw + (size_t)((T) - 8) * 64 * 512, 512, Vt + (rs + (T) - 8) * 64, 1536, tid); }
#define NB_COMP(BUFP, T) { if ((T) < 8) at_comp<2>(st, qf, BUFP, 0.125f, l15, q4, false, nullptr, 0); \
                           else at_comp<2>(st, qf, BUFP, 0.125f, l15, q4, true, rpl + ((T) - 8) * 32, qc); }
      NB_LOAD(r0, 0);
      NB_LOAD(r1, 1);
      at_store<2>(r0, lds, tid);
      __syncthreads();
      for (int t = 0; t < 16; t += 2) {
        if (t + 2 < 16) NB_LOAD(r0, t + 2);
        NB_COMP(lds, t);
        at_store<2>(r1, lds + ATile<2>::BUF, tid);
        __syncthreads();
        if (t + 3 < 16) NB_LOAD(r1, t + 3);
        NB_COMP(lds + ATile<2>::BUF, t + 1);
        if (t + 2 < 16) at_store<2>(r0, lds, tid);
        __syncthreads();
      }
#undef NB_LOAD
#undef NB_COMP
      attn_fin(st, p.mix + (size_t)mq * 1024 + h * 64, l15, q4);
    } else if (bt < 1024) {
      int u = bt - 512;
      int qb = u & 3, h = (u >> 2) & 7, b = u >> 5;
      int mq = b * 256 + qb * 64 + wave * 16;
      bf16x8 qf[3]; load_q_mla(qf, p.qb + (size_t)mq * 768 + h * 96, l15, q4, false, 0);
      at_run_plain<3>(st, qf, p.kb + (size_t)(b * 256) * 768 + h * 96, 768, p.vtb_p + (size_t)((b * 8 + h) * 64) * 256, 256, 4, scaleB, lds, tid, l15, q4);
      attn_fin(st, p.mix + (size_t)mq * 1024 + 512 + h * 64, l15, q4);
    } else {
      int u = bt - 1024;
      int qb = u & 3, h = (u >> 2) & 7, b = u >> 5;
      int mq = b * 256 + qb * 64 + wave * 16;
      bf16x8 qf[2]; load_q64(qf, p.qa + (size_t)mq * 512 + h * 64, 512, l15, q4);
      at_run_plain<2>(st, qf, p.ka + (size_t)(b * 256) * 512 + h * 64, 512, p.vta_p + (size_t)((b * 8 + h) * 64) * 256, 256, 4, 0.125f, lds, tid, l15, q4);
      attn_fin(st, p.mix + (size_t)mq * 1024 + h * 64, l15, q4);
    }
  }
}

__device__ __forceinline__ int mslot(int sq, int h, int dir, int j) {
  return sq < 16 ? ((sq * 4 + h) * 2 + dir) * 4 + j : 512 + (((sq - 16) * 4 + h) * 2 + dir) * 16 + j;
}

__device__ __forceinline__ void mlstm1_task(PRM p, int o, int task, float* sm) {
  const int tid = get_tid(), lane = tid & 63, wave = tid >> 6;
  int sq, h, dir, j;
  if (task < 512) { j = task & 3; dir = (task >> 2) & 1; h = (task >> 3) & 3; sq = task >> 5; }
  else { int u = task - 512; j = u & 15; dir = (u >> 4) & 1; h = (u >> 5) & 3; sq = 16 + (u >> 7); }
  const int T = sq < 16 ? 256 : 1024;
  const int base = sq < 16 ? sq * 256 : NPR + (sq - 16) * 1024;
  const int slot = task;
  float* ks = sm;
  float* vs = sm + 4096;
  float* wg = sm + 4096 + 8192;
  if (wave == 0) {
    int s = 64 * j + lane;
    int t = dir ? T - 1 - s : s;
    const float* row = p.proj + (size_t)(base + t) * 2432 + 1536;
    float ig = row[(dir * 2 + 0) * 4 + h] + p.c_gate_bias[o * 16 + (dir * 2 + 0) * 4 + h];
    float fg = row[(dir * 2 + 1) * 4 + h] + p.c_gate_bias[o * 16 + (dir * 2 + 1) * 4 + h];
    float bsum = logsig_f(fg);
#pragma unroll
    for (int off = 1; off < 64; off <<= 1) { float v = __shfl_up(bsum, off); if (lane >= off) bsum += v; }
    float blast = __shfl(bsum, 63);
    float g = blast - bsum + ig;
    float ml = wmaxr(g);
    wg[lane] = __expf(g - ml);
    if (lane == 0) { p.dm[slot * 2] = ml; p.dm[slot * 2 + 1] = blast; }
  }
#pragma unroll
  for (int ii = 0; ii < 4; ++ii) {
    int i = (tid >> 4) + 16 * ii, c4 = tid & 15;
    int s = 64 * j + i; int t = dir ? T - 1 - s : s;
    float4 v = *(const float4*)(p.proj + (size_t)(base + t) * 2432 + 256 + h * 64 + c4 * 4);
    v.x *= 0.125f; v.y *= 0.125f; v.z *= 0.125f; v.w *= 0.125f;
    *(float4*)(ks + i * 64 + c4 * 4) = v;
  }
#pragma unroll
  for (int ii = 0; ii < 8; ++ii) {
    int i = (tid >> 5) + 8 * ii, c4 = tid & 31;
    int s = 64 * j + i; int t = dir ? T - 1 - s : s;
    *(float4*)(vs + i * 128 + c4 * 4) = *(const float4*)(p.proj + (size_t)(base + t) * 2432 + 512 + h * 128 + c4 * 4);
  }
  __syncthreads();
  const int dg = tid & 15, vg8 = tid >> 4;
  f32x4 acc[8];
#pragma unroll
  for (int q = 0; q < 8; ++q) acc[q] = (f32x4){0.f, 0.f, 0.f, 0.f};
  f32x4 nacc = {0.f, 0.f, 0.f, 0.f};
#pragma unroll 4
  for (int i = 0; i < 64; ++i) {
    f32x4 kd = *(const f32x4*)(ks + i * 64 + dg * 4) * wg[i];
    nacc += kd;
    f32x4 va = *(const f32x4*)(vs + i * 128 + vg8 * 8);
    f32x4 vb = *(const f32x4*)(vs + i * 128 + vg8 * 8 + 4);
    acc[0] += kd * va[0]; acc[1] += kd * va[1]; acc[2] += kd * va[2]; acc[3] += kd * va[3];
    acc[4] += kd * vb[0]; acc[5] += kd * vb[1]; acc[6] += kd * vb[2]; acc[7] += kd * vb[3];
  }
  float* dc = p.dC + (size_t)slot * 8192;
#pragma unroll
  for (int q = 0; q < 8; ++q) *(f32x4*)(dc + (vg8 * 8 + q) * 64 + dg * 4) = acc[q];
  if (vg8 == 0) *(f32x4*)(p.dn + slot * 64 + dg * 4) = nacc;
  __syncthreads();
}

__device__ __forceinline__ void mlstm2_task(PRM p, int o, int task, float* sm) {
  const int tid = get_tid(), lane = tid & 63, wave = tid >> 6;
  int sq, h, c;
  if (task < 256) { c = task & 3; h = (task >> 2) & 3; sq = task >> 4; }
  else { int u = task - 256; c = u & 15; h = (u >> 4) & 3; sq = 16 + (u >> 6); }
  const bool pr = sq < 16;
  const int nc = pr ? 4 : 16;
  const int base = (pr ? sq * 256 : NPR + (sq - 16) * 1024) + c * 64;
  float* qT = sm;
  float* kT = sm + 4352;
  float* CT = kT;
  float* St = sm + 2 * 4352;
  float* vh = sm + 3 * 4352;
  float* smalls = sm + 4 * 4352;
  float* bl = smalls;
  float* itb = smalls + 64;
  float* mt = smalls + 128;
  float* w0 = smalls + 192;
  float* nv = smalls + 256;
  float* nq = smalls + 320;
  float* den = smalls + 384;
  float* scal = smalls + 448;

  const int tl = tid >> 4, tx = tid & 15;
  const int l0 = tl * 4, x0 = tx * 4;
  float hacc[2][4][4];
#pragma unroll
  for (int a = 0; a < 2; ++a)
#pragma unroll
    for (int b2 = 0; b2 < 4; ++b2)
#pragma unroll
      for (int c2 = 0; c2 < 4; ++c2) hacc[a][b2][c2] = 0.f;

  f32x4 qv[4], kv[4];
#pragma unroll
  for (int ii = 0; ii < 4; ++ii) {
    int i = (tid >> 4) + 16 * ii, c4 = tid & 15;
    const float* row = p.proj + (size_t)(base + i) * 2432 + h * 64 + c4 * 4;
    qv[ii] = *(const f32x4*)row;
    kv[ii] = *(const f32x4*)(row + 256);
  }
#pragma unroll
  for (int ii = 0; ii < 4; ++ii) {
    int i = (tid >> 4) + 16 * ii, c4 = tid & 15;
    qT[(c4 * 4 + 0) * 68 + i] = qv[ii].x; qT[(c4 * 4 + 1) * 68 + i] = qv[ii].y; qT[(c4 * 4 + 2) * 68 + i] = qv[ii].z; qT[(c4 * 4 + 3) * 68 + i] = qv[ii].w;
  }
#pragma unroll 1
  for (int dir = 0; dir < 2; ++dir) {
    const int j = dir ? nc - 1 - c : c;
    const int slj = mslot(sq, h, dir, j);
    const float mprev = p.mp[slj];
    float cr[16]; f32x4 vr[4];
    const float* cpp = p.cp + (size_t)slj * 8192;
#pragma unroll
    for (int r = 0; r < 16; ++r) cr[r] = cpp[tid + 256 * r];
#pragma unroll
    for (int ii = 0; ii < 4; ++ii) {
      int i = (tid >> 4) + 16 * ii, c4 = tid & 15;
      vr[ii] = *(const f32x4*)(p.proj + (size_t)(base + i) * 2432 + 512 + h * 128 + c4 * 4);
    }
    if (wave == 0) {
      const int i = lane;
      const int tau = dir ? 63 - i : i;
      const float* row = p.proj + (size_t)(base + tau) * 2432 + 1536;
      float ig = row[(dir * 2 + 0) * 4 + h] + p.c_gate_bias[o * 16 + (dir * 2 + 0) * 4 + h];
      float fg = row[(dir * 2 + 1) * 4 + h] + p.c_gate_bias[o * 16 + (dir * 2 + 1) * 4 + h];
      float bsum = logsig_f(fg);
#pragma unroll
      for (int off = 1; off < 64; off <<= 1) { float v = __shfl_up(bsum, off); if (lane >= off) bsum += v; }
      float ib = ig - bsum;
      float pm = ib;
#pragma unroll
      for (int off = 1; off < 64; off <<= 1) { float v = __shfl_up(pm, off); if (lane >= off) pm = fmaxf(pm, v); }
      float mti = fmaxf(bsum + mprev, bsum + pm);
      bl[tau] = bsum; itb[tau] = ib; mt[tau] = mti; w0[tau] = __expf(bsum + mprev - mti);
    }
#pragma unroll
    for (int ii = 0; ii < 4; ++ii) {
      int i = (tid >> 4) + 16 * ii, c4 = tid & 15;
      kT[(c4 * 4 + 0) * 68 + i] = kv[ii].x * 0.125f; kT[(c4 * 4 + 1) * 68 + i] = kv[ii].y * 0.125f;
      kT[(c4 * 4 + 2) * 68 + i] = kv[ii].z * 0.125f; kT[(c4 * 4 + 3) * 68 + i] = kv[ii].w * 0.125f;
    }
    if (tid < 64) nv[tid] = p.np[slj * 64 + tid];
    __syncthreads();
    {
      float a[4][4];
#pragma unroll
      for (int r = 0; r < 4; ++r)
#pragma unroll
        for (int q = 0; q < 4; ++q) a[r][q] = 0.f;
#pragma unroll 2
      for (int d = 0; d < 64; ++d) {
        float4 q4v = *(const float4*)(qT + d * 68 + l0);
        float4 k4v = *(const float4*)(kT + d * 68 + x0);
        float qa[4] = {q4v.x, q4v.y, q4v.z, q4v.w}, kk[4] = {k4v.x, k4v.y, k4v.z, k4v.w};
#pragma unroll
        for (int r = 0; r < 4; ++r)
#pragma unroll
          for (int q = 0; q < 4; ++q) a[r][q] = fmaf(qa[r], kk[q], a[r][q]);
      }
      float rsum[4];
#pragma unroll
      for (int r = 0; r < 4; ++r) {
        const int l = l0 + r;
        const float bll = bl[l], mtl = mt[l];
        rsum[r] = 0.f;
#pragma unroll
        for (int q = 0; q < 4; ++q) {
          const int s = x0 + q;
          const bool ok = dir ? (s >= l) : (s <= l);
          float sv = ok ? a[r][q] * __expf(bll + itb[s] - mtl) : 0.f;
          St[s * 68 + l] = sv;
          rsum[r] += sv;
        }
        rsum[r] += shx(rsum[r], 1); rsum[r] += shx(rsum[r], 2);
        rsum[r] += shx(rsum[r], 4); rsum[r] += shx(rsum[r], 8);
        if (tx == 0) den[l] = rsum[r];
      }
    }
    __syncthreads();
    if (tid < 64) {
      float s = 0.f;
#pragma unroll 4
      for (int d = 0; d < 64; ++d) s = fmaf(qT[d * 68 + tid], nv[d], s);
      nq[tid] = s;
    }
#pragma unroll 1
    for (int vhalf = 0; vhalf < 2; ++vhalf) {
#pragma unroll
      for (int r = 0; r < 16; ++r) {
        int e = tid + 256 * r;
        CT[(e & 63) * 68 + (e >> 6)] = cr[r];
      }
#pragma unroll
      for (int ii = 0; ii < 4; ++ii) {
        int i = (tid >> 4) + 16 * ii, c4 = tid & 15;
        *(f32x4*)(vh + i * 68 + c4 * 4) = vr[ii];
      }
      if (vhalf == 0) {
#pragma unroll
        for (int r = 0; r < 16; ++r) cr[r] = cpp[4096 + tid + 256 * r];
#pragma unroll
        for (int ii = 0; ii < 4; ++ii) {
          int i = (tid >> 4) + 16 * ii, c4 = tid & 15;
          vr[ii] = *(const f32x4*)(p.proj + (size_t)(base + i) * 2432 + 512 + h * 128 + 64 + c4 * 4);
        }
      }
      __syncthreads();
      {
        float a1[4][4], a2[4][4];
#pragma unroll
        for (int r = 0; r < 4; ++r)
#pragma unroll
          for (int q = 0; q < 4; ++q) { a1[r][q] = 0.f; a2[r][q] = 0.f; }
#pragma unroll 2
        for (int s = 0; s < 64; ++s) {
          float4 sa = *(const float4*)(St + s * 68 + l0);
          float4 vb = *(const float4*)(vh + s * 68 + x0);
          float4 qa4 = *(const float4*)(qT + s * 68 + l0);
          float4 cb4 = *(const float4*)(CT + s * 68 + x0);
          float sl4[4] = {sa.x, sa.y, sa.z, sa.w}, vv[4] = {vb.x, vb.y, vb.z, vb.w};
          float qq[4] = {qa4.x, qa4.y, qa4.z, qa4.w}, cc[4] = {cb4.x, cb4.y, cb4.z, cb4.w};
#pragma unroll
          for (int r = 0; r < 4; ++r)
#pragma unroll
            for (int q = 0; q < 4; ++q) { a1[r][q] = fmaf(sl4[r], vv[q], a1[r][q]); a2[r][q] = fmaf(qq[r], cc[q], a2[r][q]); }
        }
#pragma unroll
        for (int r = 0; r < 4; ++r) {
          const int l = l0 + r;
          const float w = w0[l];
          const float dn_ = den[l] + w * nq[l];
          const float dd = fmaxf(fabsf(dn_), __expf(-mt[l]));
          const float inv = 1.f / dd;
#pragma unroll
          for (int q = 0; q < 4; ++q) { float hv = (a1[r][q] + w * a2[r][q]) * inv; if (vhalf == 0) hacc[0][r][q] += hv; else hacc[1][r][q] += hv; }
        }
      }
      __syncthreads();
    }
  }
#pragma unroll
  for (int r = 0; r < 4; ++r) {
    float ss = 0.f;
#pragma unroll
    for (int a = 0; a < 2; ++a)
#pragma unroll
      for (int q = 0; q < 4; ++q) ss += hacc[a][r][q] * hacc[a][r][q];
    ss += shx(ss, 1); ss += shx(ss, 2); ss += shx(ss, 4); ss += shx(ss, 8);
    const float rn = rsqrtf(ss * (1.f / 128.f) + EPS);
    const int m = base + l0 + r;
#pragma unroll
    for (int a = 0; a < 2; ++a) {
      const int v0 = a * 64 + x0;
      float4 co = *(const float4*)(p.proj + (size_t)m * 2432 + 1024 + h * 128 + v0);
      float4 gn = *(const float4*)(p.c_out_norm + (size_t)(o * 4 + h) * 128 + v0);
      float y0 = sigmoid_f(co.x) * hacc[a][r][0] * rn * gn.x;
      float y1 = sigmoid_f(co.y) * hacc[a][r][1] * rn * gn.y;
      float y2 = sigmoid_f(co.z) * hacc[a][r][2] * rn * gn.z;
      float y3 = sigmoid_f(co.w) * hacc[a][r][3] * rn * gn.w;
      uint2 oo; oo.x = pack2(y0, y1); oo.y = pack2(y2, y3);
      *(uint2*)(p.mix + (size_t)m * 1024 + h * 128 + v0) = oo;
    }
  }
  __syncthreads();
}

__device__ __forceinline__ void mlstm2_mfma(PRM p, int o, int task, char* smem) {
  const int tid = get_tid(), lane = tid & 63, wave = tid >> 6, l15 = lane & 15, q4 = lane >> 4;
  int sq, h, c;
  if (task < 256) { c = task & 3; h = (task >> 2) & 3; sq = task >> 4; }
  else { int u = task - 256; c = u & 15; h = (u >> 4) & 3; sq = 16 + (u >> 6); }
  const bool pr = sq < 16;
  const int nc = pr ? 4 : 16;
  const int base = (pr ? sq * 256 : NPR + (sq - 16) * 1024) + c * 64;
  u16* Qb = (u16*)smem;
  u16* Kb = Qb + 64 * 72;
  u16* Vt = Kb + 64 * 72;
  u16* Cb = Vt + 128 * 72;
  float* sml = (float*)(Cb + 128 * 72);
  float* bl = sml; float* itb = sml + 64; float* mt = sml + 128; float* w0 = sml + 192; float* nv = sml + 256;
#pragma unroll
  for (int ii = 0; ii < 4; ++ii) {
    int i = (tid >> 4) + 16 * ii, c4 = tid & 15;
    const float* row = p.proj + (size_t)(base + i) * 2432 + h * 64 + c4 * 4;
    f32x4 qv = *(const f32x4*)row;
    f32x4 kv = *(const f32x4*)(row + 256);
    uint2 a; a.x = pack2(qv[0], qv[1]); a.y = pack2(qv[2], qv[3]);
    uint2 b; b.x = pack2(kv[0] * 0.125f, kv[1] * 0.125f); b.y = pack2(kv[2] * 0.125f, kv[3] * 0.125f);
    *(uint2*)(Qb + i * 72 + c4 * 4) = a;
    *(uint2*)(Kb + i * 72 + c4 * 4) = b;
  }
#pragma unroll
  for (int ii = 0; ii < 8; ++ii) {
    int i = (tid >> 5) + 8 * ii, c4 = tid & 31;
    f32x4 vv = *(const f32x4*)(p.proj + (size_t)(base + i) * 2432 + 512 + h * 128 + c4 * 4);
    unsigned w01 = pack2(vv[0], vv[1]), w23 = pack2(vv[2], vv[3]);
    Vt[(c4 * 4 + 0) * 72 + i] = (u16)(w01 & 0xffffu); Vt[(c4 * 4 + 1) * 72 + i] = (u16)(w01 >> 16);
    Vt[(c4 * 4 + 2) * 72 + i] = (u16)(w23 & 0xffffu); Vt[(c4 * 4 + 3) * 72 + i] = (u16)(w23 >> 16);
  }
  f32x4 hacc[8];
#pragma unroll
  for (int vt = 0; vt < 8; ++vt) hacc[vt] = (f32x4){0.f, 0.f, 0.f, 0.f};
  const int lrow = wave * 16 + l15;
#pragma unroll 1
  for (int dir = 0; dir < 2; ++dir) {
    const int j = dir ? nc - 1 - c : c;
    const int slj = mslot(sq, h, dir, j);
    const float mprev = p.mp[slj];
    {
      const f32x4* cpp = (const f32x4*)(p.cp + (size_t)slj * 8192);
#pragma unroll
      for (int r = 0; r < 8; ++r) {
        int e4 = tid + 256 * r;
        f32x4 cv = cpp[e4];
        uint2 a; a.x = pack2(cv[0], cv[1]); a.y = pack2(cv[2], cv[3]);
        *(uint2*)(Cb + (e4 >> 4) * 72 + (e4 & 15) * 4) = a;
      }
    }
    if (tid < 64) nv[tid] = p.np[slj * 64 + tid];
    if (wave == 0) {
      const int i = lane;
      const int tau = dir ? 63 - i : i;
      const float* row = p.proj + (size_t)(base + tau) * 2432 + 1536;
      float ig = row[(dir * 2 + 0) * 4 + h] + p.c_gate_bias[o * 16 + (dir * 2 + 0) * 4 + h];
      float fg = row[(dir * 2 + 1) * 4 + h] + p.c_gate_bias[o * 16 + (dir * 2 + 1) * 4 + h];
      float bsum = logsig_f(fg);
#pragma unroll
      for (int off = 1; off < 64; off <<= 1) { float v = __shfl_up(bsum, off); if (lane >= off) bsum += v; }
      float ib = ig - bsum;
      float pm = ib;
#pragma unroll
      for (int off = 1; off < 64; off <<= 1) { float v = __shfl_up(pm, off); if (lane >= off) pm = fmaxf(pm, v); }
      float mti = fmaxf(bsum + mprev, bsum + pm);
      bl[tau] = bsum; itb[tau] = ib; mt[tau] = mti; w0[tau] = __expf(bsum + mprev - mti);
    }
    __syncthreads();
    const float bll = bl[lrow], mtl = mt[lrow], w0l = w0[lrow];
    bf16x8 qf[2];
#pragma unroll
    for (int ks = 0; ks < 2; ++ks) qf[ks] = *(const bf16x8*)(Qb + lrow * 72 + ks * 32 + q4 * 8);
    float nqp = 0.f;
#pragma unroll
    for (int ks = 0; ks < 2; ++ks)
#pragma unroll
      for (int jj = 0; jj < 8; ++jj) {
        float qe = __uint_as_float(((unsigned)(unsigned short)qf[ks][jj]) << 16);
        nqp = fmaf(qe, nv[ks * 32 + q4 * 8 + jj], nqp);
      }
    nqp += shx(nqp, 16); nqp += shx(nqp, 32);
    f32x4 oacc[8];
#pragma unroll
    for (int vt = 0; vt < 8; ++vt) {
      oacc[vt] = (f32x4){0.f, 0.f, 0.f, 0.f};
#pragma unroll
      for (int ks = 0; ks < 2; ++ks) {
        bf16x8 a = *(const bf16x8*)(Cb + (vt * 16 + l15) * 72 + ks * 32 + q4 * 8);
        oacc[vt] = mfma16(a, qf[ks], oacc[vt]);
      }
      oacc[vt] *= w0l;
    }
    float sv[16];
    float dsum = 0.f;
#pragma unroll
    for (int st = 0; st < 4; ++st) {
      f32x4 sa = {0.f, 0.f, 0.f, 0.f};
#pragma unroll
      for (int ks = 0; ks < 2; ++ks) {
        bf16x8 a = *(const bf16x8*)(Kb + (st * 16 + l15) * 72 + ks * 32 + q4 * 8);
        sa = mfma16(a, qf[ks], sa);
      }
#pragma unroll
      for (int r = 0; r < 4; ++r) {
        const int sidx = st * 16 + q4 * 4 + r;
        const bool ok = dir ? (sidx >= lrow) : (sidx <= lrow);
        float val = ok ? sa[r] * __expf(bll + itb[sidx] - mtl) : 0.f;
        sv[st * 4 + r] = val;
        dsum += val;
      }
    }
    dsum += shx(dsum, 16); dsum += shx(dsum, 32);
    bf16x8 pf[2];
#pragma unroll
    for (int hf = 0; hf < 2; ++hf) {
      u32x4 pw;
      pw[0] = pack2(sv[hf * 8 + 0], sv[hf * 8 + 1]); pw[1] = pack2(sv[hf * 8 + 2], sv[hf * 8 + 3]);
      pw[2] = pack2(sv[hf * 8 + 4], sv[hf * 8 + 5]); pw[3] = pack2(sv[hf * 8 + 6], sv[hf * 8 + 7]);
      pf[hf] = __builtin_bit_cast(bf16x8, pw);
    }
    const float dn_ = dsum + w0l * nqp;
    const float inv = 1.f / fmaxf(fabsf(dn_), __expf(-mtl));
#pragma unroll
    for (int vt = 0; vt < 8; ++vt) {
#pragma unroll
      for (int hf = 0; hf < 2; ++hf) {
        const u16* vp = Vt + (vt * 16 + l15) * 72 + hf * 32 + q4 * 4;
        s16x4 v0 = *(const s16x4*)vp;
        s16x4 v1 = *(const s16x4*)(vp + 16);
        bf16x8 vf = (bf16x8){v0.x, v0.y, v0.z, v0.w, v1.x, v1.y, v1.z, v1.w};
        oacc[vt] = mfma16(vf, pf[hf], oacc[vt]);
      }
      hacc[vt] += oacc[vt] * inv;
    }
    __syncthreads();
  }
  float ss = 0.f;
#pragma unroll
  for (int vt = 0; vt < 8; ++vt)
#pragma unroll
    for (int r = 0; r < 4; ++r) ss += hacc[vt][r] * hacc[vt][r];
  ss += shx(ss, 16); ss += shx(ss, 32);
  const float rn = rsqrtf(ss * (1.f / 128.f) + EPS);
  const int m = base + lrow;
#pragma unroll
  for (int vt = 0; vt < 8; ++vt) {
    const int v0 = vt * 16 + q4 * 4;
    f32x4 co = *(const f32x4*)(p.proj + (size_t)m * 2432 + 1024 + h * 128 + v0);
    f32x4 gn = *(const f32x4*)(p.c_out_norm + (size_t)(o * 4 + h) * 128 + v0);
    float y0 = sigmoid_f(co[0]) * hacc[vt][0] * rn * gn[0];
    float y1 = sigmoid_f(co[1]) * hacc[vt][1] * rn * gn[1];
    float y2 = sigmoid_f(co[2]) * hacc[vt][2] * rn * gn[2];
    float y3 = sigmoid_f(co[3]) * hacc[vt][3] * rn * gn[3];
    uint2 oo; oo.x = pack2(y0, y1); oo.y = pack2(y2, y3);
    *(uint2*)(p.mix + (size_t)m * 1024 + h * 128 + v0) = oo;
  }
  __syncthreads();
}

__device__ __forceinline__ void mlstm_scan_phase(PRM p, int o) {
  const int tid = get_tid();
  for (int task = get_bid(); task < 576; task += vgrid()) {
    const int sc = task >> 2, slice = task & 3;
    int sq, h, dir;
    if (sc < 128) { sq = sc >> 3; h = (sc >> 1) & 3; dir = sc & 1; }
    else { int u = sc - 128; sq = 16 + (u >> 3); h = (u >> 1) & 3; dir = u & 1; }
    const bool pr = sq < 16;
    const int nc = pr ? 4 : 16;
    const int sidx = pr ? ((sq * 2 + o) * 2 + dir) * 4 + h : 0;
    const int cidx = pr ? 0 : (((sq - 16) * 2 + o) * 2 + dir) * 4 + h;
    const int e0 = slice * 2048 + tid;
    float C[8];
#pragma unroll
    for (int r = 0; r < 8; ++r) C[r] = pr ? 0.f : p.state_C[(size_t)cidx * 8192 + e0 + 256 * r];
    const bool nthr = (slice == 0) && (tid < 64);
    float n = (pr || !nthr) ? 0.f : p.state_n[cidx * 64 + tid];
    float m = pr ? 0.f : p.state_m[cidx];
#pragma unroll 4
    for (int j = 0; j < nc; ++j) {
      const int sl = mslot(sq, h, dir, j);
      float* cp = p.cp + (size_t)sl * 8192 + e0;
      const float* dc = p.dC + (size_t)sl * 8192 + e0;
#pragma unroll
      for (int r = 0; r < 8; ++r) cp[256 * r] = C[r];
      if (nthr) { p.np[sl * 64 + tid] = n; if (tid == 0) p.mp[sl] = m; }
      const float ml = p.dm[sl * 2], bls = p.dm[sl * 2 + 1];
      const float mn = fmaxf(bls + m, ml);
      const float ca = __expf(bls + m - mn), cb = __expf(ml - mn);
#pragma unroll
      for (int r = 0; r < 8; ++r) C[r] = ca * C[r] + cb * dc[256 * r];
      if (nthr) n = ca * n + cb * p.dn[sl * 64 + tid];
      m = mn;
    }
    if (pr) {
      float* oc = p.out + O_CC + (size_t)sidx * 8192 + e0;
#pragma unroll
      for (int r = 0; r < 8; ++r) oc[256 * r] = C[r];
      if (nthr) { p.out[O_CN + (size_t)sidx * 64 + tid] = n; if (tid == 0) p.out[O_CM + sidx] = m; }
    }
  }
}

__device__ __forceinline__ void odd_mid_phase(PRM p, int o, char* smem) {
  u16* lds = (u16*)smem;
  const int tid = get_tid(), lane = tid & 63, wave = tid >> 6, l15 = lane & 15, q4 = lane >> 4;
  for (int bt = get_bid(); bt < 256 + 768 + 512; bt += vgrid()) {
    if (bt < 256) {
      int qb = bt & 15, hq = (bt >> 4) & 7, b = bt >> 7;
      int kvh = hq >> 2;
      int mq = NPR + b * 1024 + qb * 64 + wave * 16;
      AttnSt st; attn_init(st);
      bf16x8 qf[2]; load_q64(qf, p.qa + (size_t)mq * 512 + hq * 64, 512, l15, q4);
      at_run_plain<2>(st, qf, p.kd + (size_t)(NPR + b * 1536) * 128 + kvh * 64, 128, p.vtd_s + (size_t)((b * 2 + kvh) * 64) * 1536, 1536, 24, 0.125f, lds, tid, l15, q4);
      attn_fin(st, p.mix + (size_t)mq * 1024 + 512 + hq * 64, l15, q4);
    } else if (bt < 256 + 768) {
      mlstm1_task(p, o, bt - 256, (float*)smem);
    } else {
      int u = bt - 1024;
      int qb = u & 3, hq = (u >> 2) & 7, b = u >> 5;
      int kvh = hq >> 2;
      int mq = b * 256 + qb * 64 + wave * 16;
      AttnSt st; attn_init(st);
      bf16x8 qf[2]; load_q64(qf, p.qa + (size_t)mq * 512 + hq * 64, 512, l15, q4);
      at_run_plain<2>(st, qf, p.kd + (size_t)(b * 256) * 128 + kvh * 64, 128, p.vtd_p + (size_t)((b * 2 + kvh) * 64) * 256, 256, 4, 0.125f, lds, tid, l15, q4);
      attn_fin(st, p.mix + (size_t)mq * 1024 + 512 + hq * 64, l15, q4);
    }
  }
}

__device__ __forceinline__ void run_phase(PRM p, int ph, char* smem) {
  char* vsm = smem + (rtid() >> 8) * LDS_HALF;
  if (ph == 0) { phase0(p, vsm); return; }
  if (ph == NPHASE - 1) { norm_phase(p, 0, 3); return; }
  const int l = (ph - 1) / 13, s = (ph - 1) % 13;
  const int eo = l >> 1;
  const bool even = (l & 1) == 0;
  EpiP e{};
  const float* modl = p.mod + (size_t)l * 3 * 9216;
  switch (s) {
    case 0: norm_phase(p, l, 0); break;
    case 1: e.H = p.h; ffn_in_phase(p, l, 0, e, smem); break;
    case 2: e.C = p.x; e.gate = modl + 2 * 1024; e.ldc = 1;
            gemm_phase<EPI_RESID, 4, 2, 3, 4, 4>(p.h, p.wt_ffn_out + (size_t)(l * 2 + 0) * 1024 * 2816, 2816, 32, 8, e, smem); break;
    case 3: norm_phase(p, l, 1); break;
    case 4:
      if (even) { e.C = p.proj; e.ldc = 2688; gemm_phase<EPI_STORE, 4, 2, 4, 4, 2>(p.xn, p.wt_in_e + (size_t)eo * 2688 * 1024, 1024, 24, 21, e, smem); }
      else { e.C = p.proj; e.ldc = 2432; gemm_phase<EPI_STORE, 4, 2, 4, 4, 2>(p.xn, p.wt_in_o + (size_t)eo * 2432 * 1024, 1024, 24, 19, e, smem); }
      break;
    case 5: if (even) post_even(p, eo); else post_odd(p, eo); break;
    case 6:
      if (even) {
        EpiP eq{}; eq.C = p.qb; eq.ldc = 768;
        EpiP ek{}; ek.kb = p.kb; ek.vtp = p.vtb_p; ek.vts = p.vtb_s; ek.ctx = 0;
        EpiP ec = ek; ec.ctx = 1;
        const u16* wq = p.wt_qup + (size_t)eo * 768 * 768;
        const u16* wk = p.wt_kvup + (size_t)eo * 1024 * 256;
        for (int t = rbid(); t < 288 + 384 + 64; t += (int)gridDim.x) {
          if (t < 288) gemm_tile<EPI_STORE, 4, 2, 2, 4, 2>(p.cqn, wq, 768, t % 48, t / 48, eq, smem);
          else if (t < 672) { int u = t - 288; gemm_tile<EPI_KVUP, 4, 2, 2, 4, 2>(p.ckvn, wk, 256, u % 48, u / 48, ek, smem); }
          else { int u = t - 672; gemm_tile<EPI_KVUP, 4, 2, 2, 4, 2>(p.cctxn, wk, 256, u % 8, u / 8, ec, smem); }
        }
      } else odd_mid_phase(p, eo, vsm);
      break;
    case 7: if (!even) mlstm_scan_phase(p, eo); break;
    case 8:
      if (even) attn_even_phase(p, eo, vsm);
      else { for (int t = get_bid(); t < 384; t += vgrid()) mlstm2_mfma(p, eo, t, vsm); }
      break;
    case 9: e.C = p.x; e.gate = modl + 5 * 1024; e.ldc = 0;
            gemm_phase<EPI_RESID, 4, 2, 3, 4, 2>(p.mix, p.wt_out + (size_t)l * 1024 * 1024, 1024, 32, 8, e, smem); break;
    case 10: norm_phase(p, l, 2); break;
    case 11: e.H = p.h; ffn_in_phase(p, l, 1, e, smem); break;
    case 12: e.C = p.x; e.gate = modl + 8 * 1024; e.ldc = 1;
             gemm_phase<EPI_RESID, 4, 2, 3, 4, 4>(p.h, p.wt_ffn_out + (size_t)(l * 2 + 1) * 1024 * 2816, 2816, 32, 8, e, smem); break;
  }
}

__global__ void __launch_bounds__(512, 2) mega(Params p) {
  __shared__ __attribute__((aligned(16))) char smem[LDS_BYTES];
  __shared__ uint4 xb_words;
  cg::grid_group grid = cg::this_grid();
  if (threadIdx.x == 0) xb_words = make_uint4(0u, 0u, 0u, 0u);
  __syncthreads();
  XcdBarrier xb = xcd_barrier_post(p.bar, (volatile LAS unsigned*)&xb_words);
  for (int ph = p.ph0; ph < p.ph1; ++ph) {
    const __attribute__((address_space(4))) Params* pp = (const __attribute__((address_space(4))) Params*)__builtin_amdgcn_kernarg_segment_ptr();
    asm volatile("" : "+s"(pp));
    run_phase(*pp, ph, smem);
#ifndef REPMASK
#define REPMASK 0
#endif
#ifndef REPPAR
#define REPPAR 0
#endif
    if (REPMASK) {
      int bit = ph == 0 ? 13 : (ph == NPHASE - 1 ? 14 : (ph - 1) % 13);
      int lay = (ph - 1) / 13;
      bool parok = REPPAR == 0 || ph == 0 || ph == NPHASE - 1 || (REPPAR == 1 && (lay & 1) == 0) || (REPPAR == 2 && (lay & 1) == 1);
      if (((REPMASK >> bit) & 1) && parok) { xcd_barrier(xb); asm volatile("" : "+s"(pp)); run_phase(*pp, ph, smem); }
    }
    if (ph + 1 < p.ph1) {
      if (p.ph1 > 100000) grid.sync();
      xcd_barrier(xb);
    }
  }
}

extern "C" void kernel_launch(void* const* d_in, const int* in_sizes, int n_in, void* d_out, int out_size, void* d_ws, size_t ws_size,
                              hipStream_t stream) {
  static int grid_blocks = 0;
  if (!grid_blocks) {
    int dev = 0, cus = 0, per_cu = 0;
    hipGetDevice(&dev);
    hipDeviceGetAttribute(&cus, hipDeviceAttributeMultiprocessorCount, dev);
    hipOccupancyMaxActiveBlocksPerMultiprocessor(&per_cu, mega, 512, 0);
    per_cu = 1;
    grid_blocks = cus * per_cu;
  }
  Params p{};
  const float** ip = (const float**)&p.x_prompt;
  for (int i = 0; i < 31; ++i) ip[i] = (const float*)d_in[i];
  p.out = (float*)d_out;
  char* w = (char*)d_ws;
  size_t off = 0;
  auto take = [&](size_t bytes) { char* r = w + off; off += (bytes + 255) & ~(size_t)255; return r; };
  p.wt_ffn_in = (u16*)take((size_t)8 * 5632 * 1024 * 2);
  p.wt_ffn_out = (u16*)take((size_t)8 * 1024 * 2816 * 2);
  p.wt_in_e = (u16*)take((size_t)2 * 2688 * 1024 * 2);
  p.wt_in_o = (u16*)take((size_t)2 * 2432 * 1024 * 2);
  p.wt_out = (u16*)take((size_t)4 * 1024 * 1024 * 2);
  p.wt_qup = (u16*)take((size_t)2 * 768 * 768 * 2);
  p.wt_kvup = (u16*)take((size_t)2 * 1024 * 256 * 2);
  p.mod = (float*)take((size_t)12 * 9216 * 4);
  p.x = (float*)take((size_t)NTOK * 1024 * 4);
  p.proj = (float*)take((size_t)NTOK * 2688 * 4);
  p.qb = (float*)take((size_t)NTOK * 768 * 4);
  p.dC = (float*)take((size_t)768 * 8192 * 4);
  p.dn = (float*)take((size_t)768 * 64 * 4);
  p.dm = (float*)take((size_t)768 * 2 * 4);
  p.cp = (float*)take((size_t)768 * 8192 * 4);
  p.np = (float*)take((size_t)768 * 64 * 4);
  p.mp = (float*)take((size_t)768 * 4);
  p.xn = (u16*)take((size_t)NTOK * 1024 * 2);
  p.h = (u16*)take((size_t)NTOK * 2816 * 2);
  p.mix = (u16*)take((size_t)NTOK * 1024 * 2);
  p.qa = (u16*)take((size_t)NTOK * 512 * 2);
  p.ka = (u16*)take((size_t)NTOK * 512 * 2);
  p.kactx = (u16*)take((size_t)1024 * 512 * 2);
  p.vta_p = (u16*)take((size_t)16 * 8 * 64 * 256 * 2);
  p.vta_s = (u16*)take((size_t)2 * 8 * 64 * 1536 * 2);
  p.kb = (u16*)take((size_t)7168 * 768 * 2);
  p.vtb_p = (u16*)take((size_t)16 * 8 * 64 * 256 * 2);
  p.vtb_s = (u16*)take((size_t)2 * 8 * 64 * 1536 * 2);
  p.cqn = (u16*)take((size_t)NTOK * 768 * 2);
  p.ckvn = (u16*)take((size_t)NTOK * 256 * 2);
  p.cctxn = (u16*)take((size_t)1024 * 256 * 2);
  p.kd = (u16*)take((size_t)7168 * 128 * 2);
  p.vtd_p = (u16*)take((size_t)16 * 2 * 64 * 256 * 2);
  p.vtd_s = (u16*)take((size_t)2 * 2 * 64 * 1536 * 2);
  p.bar = (unsigned*)take((size_t)XCD_BAR_WORDS * 4);
  if (off > ws_size) { fprintf(stderr, "kernel_launch: workspace too small: need %zu have %zu\n", off, ws_size); return; }
  hipMemsetAsync(p.bar, 0, (size_t)XCD_BAR_WORDS * 4, stream);
#if MULTI
  for (int ph = 0; ph < NPHASE; ++ph) {
    p.ph0 = ph; p.ph1 = ph + 1;
    hipLaunchKernelGGL(mega, dim3(grid_blocks), dim3(512), 0, stream, p);
  }
#else
  p.ph0 = 0; p.ph1 = NPHASE;
  void* args[] = {&p};
  hipError_t e = hipLaunchCooperativeKernel((void*)mega, dim3(grid_blocks), dim3(512), args, 0, stream);
  if (e != hipSuccess) fprintf(stderr, "cooperative launch failed: %s (grid %d)\n", hipGetErrorString(e), grid_blocks);
#endif
}
```

```cpp
#include <hip/hip_runtime.h>
#include <hip/hip_cooperative_groups.h>
#include <cstdio>
#include <cstdint>
namespace cg = cooperative_groups;

#ifndef MULTI
#define MULTI 0
#endif

typedef unsigned short u16;
typedef __attribute__((ext_vector_type(8))) short bf16x8;
typedef __attribute__((ext_vector_type(4))) short s16x4;
typedef __attribute__((ext_vector_type(4))) float f32x4;
typedef __attribute__((ext_vector_type(4))) unsigned int u32x4;

#define NTOK 6144
#define NPR 4096
#define LDS_HALF 77824
#define LDS_BYTES (2 * LDS_HALF)
#define NPHASE 54
#define EPS 1e-6f

struct Params {
  const float *x_prompt, *x_sample, *cache_a_k, *cache_a_v, *cache_b_ckv, *cache_b_krope, *cache_d_k, *cache_d_v;
  const float *state_C, *state_n, *state_m, *c, *c_ctx, *w_mod, *b_mod, *norm_g, *ffn_in, *ffn_out;
  const float *w_in_even, *w_in_odd, *w_out, *a_rpb, *b_q_norm, *b_wq_up, *b_kv_norm, *b_wkv_up;
  const float *c_gate_bias, *c_out_norm, *d_q_norm, *d_k_norm, *final_norm;
  float* out;
  u16 *wt_ffn_in, *wt_ffn_out, *wt_in_e, *wt_in_o, *wt_out, *wt_qup, *wt_kvup;
  float *mod, *x, *proj, *qb, *dC, *dn, *dm, *cp, *np, *mp;
  u16 *xn, *h, *mix, *qa, *ka, *kactx, *vta_p, *vta_s, *kb, *vtb_p, *vtb_s, *cqn, *ckvn, *cctxn, *kd, *vtd_p, *vtd_s;
  unsigned* bar;
  int ph0, ph1;
};

typedef const __attribute__((address_space(4))) Params& PRM;
#define O_YP 0
#define O_YS 4194304
#define O_AK 6291456
#define O_AV 10485760
#define O_CKV 14680064
#define O_KR 16777216
#define O_DK 17039360
#define O_DV 18087936
#define O_CC 19136512
#define O_CN 21233664
#define O_CM 21250048

__device__ __forceinline__ int get_tid() { int t = threadIdx.x & 255; asm volatile("" : "+v"(t)); return t; }
__device__ __forceinline__ int rtid_raw() { int t = threadIdx.x; asm volatile("" : "+v"(t)); return t; }
__device__ __forceinline__ int get_bid() { int t = blockIdx.x * 2 + __builtin_amdgcn_readfirstlane(rtid_raw() >> 8); asm volatile("" : "+s"(t)); return t; }
__device__ __forceinline__ int vgrid() { return (int)gridDim.x * 2; }
__device__ __forceinline__ int rtid() { int t = threadIdx.x; asm volatile("" : "+v"(t)); return t; }
__device__ __forceinline__ int rbid() { int t = blockIdx.x; asm volatile("" : "+s"(t)); return t; }
typedef __attribute__((ext_vector_type(2))) __bf16 bf16x2_t;
typedef __attribute__((ext_vector_type(2))) float f32x2_t;
__device__ __forceinline__ unsigned pack2(float a, float b) {
  f32x2_t v = {a, b};
  bf16x2_t r = __builtin_convertvector(v, bf16x2_t);
  return __builtin_bit_cast(unsigned, r);
}
__device__ __forceinline__ u16 f2bf(float f) { return (u16)(pack2(f, 0.f) & 0xffffu); }
__device__ __forceinline__ float shx(float v, int m) {
  int l = __builtin_amdgcn_mbcnt_hi(-1, __builtin_amdgcn_mbcnt_lo(-1, 0));
  asm volatile("" : "+v"(l));
  return __int_as_float(__builtin_amdgcn_ds_bpermute((l ^ m) << 2, __float_as_int(v)));
}
__device__ __forceinline__ float wsum(float v) {
#pragma unroll
  for (int o = 32; o; o >>= 1) v += shx(v, o);
  return v;
}
__device__ __forceinline__ float wmaxr(float v) {
#pragma unroll
  for (int o = 32; o; o >>= 1) v = fmaxf(v, shx(v, o));
  return v;
}
__device__ __forceinline__ float silu_f(float x) { return x / (1.f + __expf(-x)); }
__device__ __forceinline__ float sigmoid_f(float x) { return 1.f / (1.f + __expf(-x)); }
__device__ __forceinline__ float logsig_f(float x) { return fminf(x, 0.f) - __logf(1.f + __expf(-fabsf(x))); }
__device__ __forceinline__ void sincos_r(float a, float& s, float& c) {
  float n = rintf(a * 0.15915494309f);
  float r = fmaf(-n, 6.2831855f, a);
  r = fmaf(-n, -1.7484555e-7f, r);
  s = __sinf(r); c = __cosf(r);
}
__device__ __forceinline__ int grp_of(int m) { return m < NPR ? 0 : 1 + ((m - NPR) >> 10); }
__device__ __forceinline__ int keyrow(int m) { return m < NPR ? m : NPR + ((m - NPR) >> 10) * 1536 + ((m - NPR) & 1023); }
__device__ __forceinline__ f32x4 mfma16(bf16x8 a, bf16x8 b, f32x4 c) { return __builtin_amdgcn_mfma_f32_16x16x32_bf16(a, b, c, 0, 0, 0); }

#define XB_TMO      128
#define XB_XCNT(j)  (256  + 64 * (j))
#define XB_XSUB(j)  (1280 + 64 * (j))
#define XB_XGEN(j)  (2304 + 64 * (j))
#define XB_TOP      3328
#define XB_TOPGEN   3392
#define XCD_BAR_WORDS 3456
#define XB_SPIN_CAP (1u << 18)
#define LAS __attribute__((address_space(3)))

__device__ __forceinline__ unsigned xb_ld(unsigned* p)              { return __hip_atomic_load(p, __ATOMIC_RELAXED, __HIP_MEMORY_SCOPE_AGENT); }
__device__ __forceinline__ unsigned xb_add(unsigned* p, unsigned v) { return __hip_atomic_fetch_add(p, v, __ATOMIC_RELAXED, __HIP_MEMORY_SCOPE_AGENT); }
__device__ __forceinline__ unsigned xb_xcc_id() { return (unsigned)__builtin_amdgcn_s_getreg((3 << 11) | 20) & 0xFu; }
#define XB_SPIN(cond, bar) do { unsigned _sp = 0; while (cond) { __builtin_amdgcn_s_sleep(1); \
    if ((++_sp & 255u) == 0u) { if (xb_ld(&(bar)[XB_TMO])) break; if (_sp > XB_SPIN_CAP) { atomicAdd(&(bar)[XB_TMO], 1u); break; } } } } while (0)

struct XcdBarrier {
    unsigned* bar; unsigned x;
    volatile LAS unsigned* st;
};

__device__ __forceinline__ XcdBarrier xcd_barrier_post(unsigned* bar, volatile LAS unsigned* st) {
    XcdBarrier b; b.bar = bar; b.x = xb_xcc_id(); b.st = st;
    if (threadIdx.x == 0) (void)xb_add(&bar[XB_XCNT(b.x)], 1u);
    return b;
}
__device__ __forceinline__ void xcd_barrier_complete(unsigned* bar, unsigned x, unsigned& nloc, unsigned& nx) {
    const unsigned G = gridDim.x * gridDim.y * gridDim.z;
    unsigned sum, cnt, mine, sp = 0u;
    for (;;) {
        sum = 0u; cnt = 0u; mine = 0u;
#pragma unroll
        for (unsigned j = 0; j < 16; ++j) { const unsigned c = xb_ld(&bar[XB_XCNT(j)]); sum += c; cnt += (c > 0u) ? 1u : 0u; mine = (j == x) ? c : mine; }
        if (sum == G) break;
        __builtin_amdgcn_s_sleep(1);
        if ((++sp & 255u) == 0u) { if (xb_ld(&bar[XB_TMO])) break; if (sp > XB_SPIN_CAP) { atomicAdd(&bar[XB_TMO], 1u); break; } }
    }
    nloc = mine > 0u ? mine : 1u; nx = cnt > 0u ? cnt : 1u;
}

__device__ __forceinline__ void xcd_barrier(const XcdBarrier& b) {
    asm volatile("s_waitcnt vmcnt(0)" ::: "memory");
    __syncthreads();
    if (threadIdx.x == 0) {
        unsigned* bar = b.bar;
        __builtin_amdgcn_s_waitcnt(0);
        unsigned nloc = b.st[0], nx = b.st[1];
        if (nloc == 0u) { xcd_barrier_complete(bar, b.x, nloc, nx); b.st[0] = nloc; b.st[1] = nx; }
        const unsigned old = xb_add(&bar[XB_XSUB(b.x)], 1u);
        const unsigned gen = old / nloc;
        if (old + 1u == (gen + 1u) * nloc) {
            __builtin_amdgcn_fence(__ATOMIC_RELEASE, "agent");
            asm volatile("s_waitcnt vmcnt(0)" ::: "memory");
            const unsigned og = xb_add(&bar[XB_TOP], 1u);
            const unsigned tg = og / nx;
            if (og + 1u == (tg + 1u) * nx) xb_add(&bar[XB_TOPGEN], 1u);
            else XB_SPIN(xb_ld(&bar[XB_TOPGEN]) == tg, bar);
            __builtin_amdgcn_fence(__ATOMIC_ACQUIRE, "agent");
            xb_add(&bar[XB_XGEN(b.x)], 1u);
            asm volatile("s_waitcnt vmcnt(0)" ::: "memory");
        } else {
            XB_SPIN(xb_ld(&bar[XB_XGEN(b.x)]) == gen, bar);
            __builtin_amdgcn_fence(__ATOMIC_ACQUIRE, "agent");
            asm volatile("s_waitcnt vmcnt(0)" ::: "memory");
        }
    }
    __syncthreads();
}


__device__ __forceinline__ void conv_tile(const float* __restrict__ src, int K, int N, int perm, u16* __restrict__ dst, int kt4, int nt, float* tile) {
  const int tid = get_tid();
  {
    const int c4 = tid & 15, kr = tid >> 4;
    const int n = nt * 64 + c4 * 4;
    const bool valid = n < N;
    int col = n;
    if (perm) { int G = n >> 4, w = n & 15, sub = w >> 2; col = ((sub & 1) ? 2816 : 0) + G * 8 + (sub >> 1) * 4 + (w & 3); }
    f32x4 v[16];
#pragma unroll
    for (int i = 0; i < 16; ++i) {
      int kk = kr + 16 * i;
      v[i] = valid ? *(const f32x4*)(src + (size_t)(kt4 * 256 + kk) * N + col) : (f32x4){0.f, 0.f, 0.f, 0.f};
    }
#pragma unroll
    for (int i = 0; i < 16; ++i) {
      int kk = kr + 16 * i;
      float* t = tile + (kk >> 6) * 4160 + (kk & 63) * 65 + c4 * 4;
      t[0] = v[i][0]; t[1] = v[i][1]; t[2] = v[i][2]; t[3] = v[i][3];
    }
  }
  __syncthreads();
  {
    const int k8 = (tid & 7) * 8;
#pragma unroll
    for (int hh = 0; hh < 4; ++hh)
#pragma unroll
      for (int i = 0; i < 2; ++i) {
        int nn2 = (tid >> 3) + 32 * i;
        float v[8];
#pragma unroll
        for (int e = 0; e < 8; ++e) v[e] = tile[hh * 4160 + (k8 + e) * 65 + nn2];
        uint4 o; o.x = pack2(v[0], v[1]); o.y = pack2(v[2], v[3]); o.z = pack2(v[4], v[5]); o.w = pack2(v[6], v[7]);
        *(uint4*)(dst + (size_t)(nt * 64 + nn2) * K + kt4 * 256 + hh * 64 + k8) = o;
      }
  }
  __syncthreads();
}

__device__ __forceinline__ void mod_task(PRM p, int t, float* sm) {
  const int l = t / 144, cb = t % 144, tid = get_tid();
  float* sc = sm;
  float* red = sm + 3072;
  for (int i = tid; i < 3072; i += 256) {
    int g = i >> 10, k = i & 1023;
    float v = g == 0 ? p.c_ctx[k] : p.c[(g - 1) * 1024 + k];
    sc[i] = silu_f(v);
  }
  __syncthreads();
  const int c4 = tid & 15, kg = tid >> 4;
  const float* w = p.w_mod + (size_t)l * 1024 * 9216 + (size_t)(kg * 64) * 9216 + cb * 64 + c4 * 4;
  float a[3][4];
#pragma unroll
  for (int g = 0; g < 3; ++g)
#pragma unroll
    for (int q = 0; q < 4; ++q) a[g][q] = 0.f;
  for (int k = 0; k < 64; k += 8) {
    float4 wv[8];
#pragma unroll
    for (int e = 0; e < 8; ++e) wv[e] = *(const float4*)(w + (size_t)(k + e) * 9216);
#pragma unroll
    for (int e = 0; e < 8; ++e) {
      int kk = kg * 64 + k + e;
#pragma unroll
      for (int g = 0; g < 3; ++g) {
        float sv = sc[g * 1024 + kk];
        a[g][0] = fmaf(sv, wv[e].x, a[g][0]); a[g][1] = fmaf(sv, wv[e].y, a[g][1]);
        a[g][2] = fmaf(sv, wv[e].z, a[g][2]); a[g][3] = fmaf(sv, wv[e].w, a[g][3]);
      }
    }
  }
#pragma unroll
  for (int g = 0; g < 3; ++g)
#pragma unroll
    for (int q = 0; q < 4; ++q) red[(kg * 3 + g) * 64 + c4 * 4 + q] = a[g][q];
  __syncthreads();
  if (tid < 192) {
    int g = tid >> 6, c2 = tid & 63;
    float s = 0.f;
#pragma unroll
    for (int q = 0; q < 16; ++q) s += red[(q * 3 + g) * 64 + c2];
    int j = cb * 64 + c2;
    p.mod[(size_t)(l * 3 + g) * 9216 + j] = s + p.b_mod[l * 9216 + j];
  }
  __syncthreads();
}

__device__ __forceinline__ int conv_layer_count(int l) { return (l & 1) ? 1272 : 1340; }
__device__ __forceinline__ void conv_layer_task(PRM p, int l, int u, float* sm) {
  const float* src; u16* dst; int K, N, Npad, perm = 0, tp, mat0;
  const int eo = l >> 1;
  const int nin = (l & 1) ? 152 : 168;
  if (u < 704) { K = 1024; N = 5632; Npad = 5632; perm = 1; tp = 352; src = p.ffn_in; dst = p.wt_ffn_in; mat0 = l * 2; }
  else if ((u -= 704) < 352) { K = 2816; N = 1024; Npad = 1024; tp = 176; src = p.ffn_out; dst = p.wt_ffn_out; mat0 = l * 2; }
  else if ((u -= 352) < nin) {
    if (l & 1) { K = 1024; N = 2320; Npad = 2432; tp = 152; src = p.w_in_odd; dst = p.wt_in_o; mat0 = eo; }
    else { K = 1024; N = 2592; Npad = 2688; tp = 168; src = p.w_in_even; dst = p.wt_in_e; mat0 = eo; }
  }
  else if ((u -= nin) < 64) { K = 1024; N = 1024; Npad = 1024; tp = 64; src = p.w_out; dst = p.wt_out; mat0 = l; }
  else if ((u -= 64) < 36) { K = 768; N = 768; Npad = 768; tp = 36; src = p.b_wq_up; dst = p.wt_qup; mat0 = eo; }
  else { u -= 36; K = 256; N = 1024; Npad = 1024; tp = 16; src = p.b_wkv_up; dst = p.wt_kvup; mat0 = eo; }
  int mat = mat0 + u / tp, r = u % tp;
  int nkt = K / 256;
  int kt = r % nkt, nt = r / nkt;
  conv_tile(src + (size_t)mat * K * N, K, N, perm, dst + (size_t)mat * Npad * K, kt, nt, sm);
}

__device__ __forceinline__ void phase0(PRM p, char* smem) {
  float* sm = (float*)smem;
  const int NMOD = 144, NCOPY = 1536, NCONV = 1340;
  const int total = NMOD + NCOPY + NCONV;
  for (int t = get_bid(); t < total; t += vgrid()) {
    if (t < NMOD) { mod_task(p, t, sm); continue; }
    int u = t - NMOD;
    if (u < NCOPY) {
      const int tid = get_tid();
#pragma unroll
      for (int i = 0; i < 4; ++i) {
        size_t idx = ((size_t)u * 1024 + i * 256 + tid);
        const float4* src = idx < (size_t)NPR * 256 ? (const float4*)p.x_prompt + idx : (const float4*)p.x_sample + (idx - (size_t)NPR * 256);
        ((float4*)p.x)[idx] = *src;
      }
      continue;
    }
    conv_layer_task(p, 0, u - NCOPY, sm);
  }
}

__device__ __forceinline__ void norm_phase(PRM p, int l, int which) {
  const int lane = get_tid() & 63, wave = get_tid() >> 6;
  const int nrows_wave = NTOK / 4;
  const int stride = vgrid();
  for (int t0 = get_bid(); t0 < nrows_wave; t0 += 3 * stride) {
    float4 v[3][4];
    float ss[3];
#pragma unroll
    for (int k = 0; k < 3; ++k) {
      const int t = t0 + k * stride;
      if (t < nrows_wave) {
        const float4* xr = (const float4*)(p.x + (size_t)(t * 4 + wave) * 1024);
#pragma unroll
        for (int i = 0; i < 4; ++i) v[k][i] = xr[i * 64 + lane];
      }
    }
#pragma unroll
    for (int k = 0; k < 3; ++k) {
      float a = 0.f;
#pragma unroll
      for (int i = 0; i < 4; ++i) a += v[k][i].x * v[k][i].x + v[k][i].y * v[k][i].y + v[k][i].z * v[k][i].z + v[k][i].w * v[k][i].w;
      ss[k] = wsum(a);
    }
#pragma unroll
    for (int k = 0; k < 3; ++k) {
      const int t = t0 + k * stride;
      if (t >= nrows_wave) continue;
      const int m = t * 4 + wave;
      const float r = rsqrtf(ss[k] * (1.f / 1024.f) + EPS);
      if (which == 3) {
        float4* o = (float4*)(p.out + (size_t)m * 1024);
#pragma unroll
        for (int i = 0; i < 4; ++i) {
          float4 g = ((const float4*)p.final_norm)[i * 64 + lane];
          float4 y; y.x = v[k][i].x * r * g.x; y.y = v[k][i].y * r * g.y; y.z = v[k][i].z * r * g.z; y.w = v[k][i].w * r * g.w;
          o[i * 64 + lane] = y;
        }
      } else {
        const float* md = p.mod + (size_t)(l * 3 + grp_of(m)) * 9216 + which * 3072;
        const float4* sh = (const float4*)md;
        const float4* sc = (const float4*)(md + 1024);
        const float4* gg = (const float4*)(p.norm_g + (size_t)(l * 3 + which) * 1024);
#pragma unroll
        for (int i = 0; i < 4; ++i) {
          float4 g = gg[i * 64 + lane], s = sc[i * 64 + lane], b = sh[i * 64 + lane];
          float y0 = v[k][i].x * r * g.x * (1.f + s.x) + b.x;
          float y1 = v[k][i].y * r * g.y * (1.f + s.y) + b.y;
          float y2 = v[k][i].z * r * g.z * (1.f + s.z) + b.z;
          float y3 = v[k][i].w * r * g.w * (1.f + s.w) + b.w;
          uint2 o; o.x = pack2(y0, y1); o.y = pack2(y2, y3);
          *(uint2*)(p.xn + (size_t)m * 1024 + (i * 64 + lane) * 4) = o;
        }
      }
    }
  }
}

struct EpiP {
  float* C; int ldc;
  const float* gate;
  u16* H;
  u16 *kb, *vtp, *vts; int ctx;
};
enum { EPI_STORE = 0, EPI_RESID = 1, EPI_SWIGLU = 2, EPI_KVUP = 3 };

template <int FI, int FJ, bool SWAP>
__device__ __forceinline__ void g_compute(f32x4 (&acc)[FI][FJ], const u16* Ac, const u16* Bc, int q4, int rsw) {
  __builtin_amdgcn_s_setprio(1);
#pragma unroll
  for (int ks = 0; ks < 2; ++ks) {
    const int co = ((ks * 4 + q4) ^ rsw) << 3;
#pragma unroll
    for (int j0 = 0; j0 < FJ; j0 += 4) {
      bf16x8 b[4];
#pragma unroll
      for (int j = 0; j < 4; ++j) if (j0 + j < FJ) b[j] = *(const bf16x8*)(Bc + (j0 + j) * 1024 + co);
#pragma unroll
      for (int i0 = 0; i0 < FI; i0 += 4) {
        bf16x8 a[4];
#pragma unroll
        for (int i = 0; i < 4; ++i) if (i0 + i < FI) a[i] = *(const bf16x8*)(Ac + (i0 + i) * 1024 + co);
#pragma unroll
        for (int j = 0; j < 4; ++j)
          if (j0 + j < FJ) {
#pragma unroll
            for (int i = 0; i < 4; ++i)
              if (i0 + i < FI) acc[i0 + i][j0 + j] = SWAP ? mfma16(b[j], a[i], acc[i0 + i][j0 + j]) : mfma16(a[i], b[j], acc[i0 + i][j0 + j]);
          }
      }
    }
  }
  __builtin_amdgcn_s_setprio(0);
}

template <int EPI, int WMW, int WNW, int FI, int FJ, int DEPTH>
__device__ __forceinline__ void gemm_tile(const u16* __restrict__ A, const u16* __restrict__ Wt, int K, int tm, int tn, const EpiP& e, char* smem) {
  constexpr int BM = WMW * FI * 16, BN = WNW * FJ * 16;
  constexpr int NA = BM / 64, NB = BN / 64;
  constexpr int BUFSZ = (BM + BN) * 64;
  static_assert(WMW * WNW == 8 && BM % 64 == 0 && BN % 64 == 0, "tile");
  u16* As = (u16*)smem;
  u16* Bs = As + BM * 64;
  const int tid = rtid(), lane = tid & 63, wave = tid >> 6, wm = wave / WNW, wn = wave % WNW, l15 = lane & 15, q4 = lane >> 4;
  const int lr = tid >> 3, lc = tid & 7;
  const u16* Ag = A + (size_t)(tm * BM + lr) * K + lc * 8;
  const u16* Bg = Wt + (size_t)(tn * BN + lr) * K + lc * 8;
  const int st_off = lr * 64 + ((lc ^ ((lr >> 1) & 7)) << 3);
  const int rsw = (l15 >> 1) & 7;
  const int a_row = (wm * FI * 16 + l15) * 64, b_row = (wn * FJ * 16 + l15) * 64;
  f32x4 acc[FI][FJ];
#pragma unroll
  for (int i = 0; i < FI; ++i)
#pragma unroll
    for (int j = 0; j < FJ; ++j) acc[i][j] = (f32x4){0.f, 0.f, 0.f, 0.f};
  const int nk = K >> 6;
#define GL(RA, RB, KT) { _Pragma("unroll") for (int i = 0; i < NA; ++i) RA[i] = *(const u32x4*)(Ag + (size_t)i * 64 * K + (KT) * 64); \
                         _Pragma("unroll") for (int i = 0; i < NB; ++i) RB[i] = *(const u32x4*)(Bg + (size_t)i * 64 * K + (KT) * 64); }
#define GS(RA, RB, BUF) { _Pragma("unroll") for (int i = 0; i < NA; ++i) *(u32x4*)(As + (BUF) * BUFSZ + st_off + i * 4096) = RA[i]; \
                          _Pragma("unroll") for (int i = 0; i < NB; ++i) *(u32x4*)(Bs + (BUF) * BUFSZ + st_off + i * 4096) = RB[i]; }
  if constexpr (DEPTH == 4) {
    static_assert(WMW == 4 && WNW == 2 && FJ == 4 && (FI == 3 || FI == 4), "ring4 tile");
    constexpr int ST = (BM + BN) * 32;
    const int nk32 = K >> 5;
    const int fs = (-(tid >> 4)) & 3;
    const int sc = ((tid & 3) ^ fs) << 3;
    const int r4 = tid >> 2;
    const bool three = (BM == 256) || (tid < 256);
    const u16* sp0 = A + (size_t)(tm * BM + r4) * K + sc;
    const int lo0 = tid * 8;
    const u16* sp1; int lo1; const u16* sp2; int lo2;
    if (BM == 256) {
      sp1 = A + (size_t)(tm * BM + 128 + r4) * K + sc;  lo1 = (tid + 512) * 8;
      sp2 = Wt + (size_t)(tn * BN + r4) * K + sc;       lo2 = BM * 32 + tid * 8;
    } else if (tid < 256) {
      sp1 = A + (size_t)(tm * BM + 128 + r4) * K + sc;  lo1 = (tid + 512) * 8;
      sp2 = Wt + (size_t)(tn * BN + 64 + r4) * K + sc;  lo2 = BM * 32 + (tid + 256) * 8;
    } else {
      sp1 = Wt + (size_t)(tn * BN + (r4 - 64)) * K + sc; lo1 = BM * 32 + (tid - 256) * 8;
      sp2 = sp1; lo2 = lo1;
    }
    const int fr = (-(l15 >> 2)) & 3;
    const int co3 = (q4 ^ fr) << 3;
    const int a_row3 = (wm * FI * 16 + l15) * 32 + co3, b_row3 = BM * 32 + (wn * FJ * 16 + l15) * 32 + co3;
    const unsigned lbase = (unsigned)(size_t)As;
#define GD4(KT, BUF) { __builtin_amdgcn_global_load_lds((const unsigned*)(sp0 + (KT) * 32), (unsigned*)(As + (BUF) * ST + lo0), 16, 0, 0); \
                       __builtin_amdgcn_global_load_lds((const unsigned*)(sp1 + (KT) * 32), (unsigned*)(As + (BUF) * ST + lo1), 16, 0, 0); \
                       if (three) __builtin_amdgcn_global_load_lds((const unsigned*)(sp2 + (KT) * 32), (unsigned*)(As + (BUF) * ST + lo2), 16, 0, 0); }
    asm volatile("s_waitcnt vmcnt(0)" ::: "memory");
    GD4(0, 0);
    if (nk32 > 1) GD4(1, 1);
    if (nk32 > 2) GD4(2, 2);
#define RING4_STEP(J) { \
      const int kt = kt0 + (J); \
      if (kt + 2 < nk32) { if (three) asm volatile("s_waitcnt vmcnt(6)" ::: "memory"); else asm volatile("s_waitcnt vmcnt(4)" ::: "memory"); } \
      else if (kt + 1 < nk32) { if (three) asm volatile("s_waitcnt vmcnt(3)" ::: "memory"); else asm volatile("s_waitcnt vmcnt(2)" ::: "memory"); } \
      else asm volatile("s_waitcnt vmcnt(0)" ::: "memory"); \
      asm volatile("s_waitcnt lgkmcnt(0)" ::: "memory"); \
      __builtin_amdgcn_s_barrier(); \
      asm volatile("" ::: "memory"); \
      const unsigned aad = lbase + (unsigned)(((J) * ST + a_row3) * 2); \
      const unsigned bad = lbase + (unsigned)(((J) * ST + b_row3) * 2); \
      bf16x8 b0, b1, b2, b3, a0, a1, a2, a3; \
      asm volatile("ds_read_b128 %0, %1" : "=v"(b0) : "v"(bad)); \
      asm volatile("ds_read_b128 %0, %1 offset:1024" : "=v"(b1) : "v"(bad)); \
      asm volatile("ds_read_b128 %0, %1 offset:2048" : "=v"(b2) : "v"(bad)); \
      asm volatile("ds_read_b128 %0, %1 offset:3072" : "=v"(b3) : "v"(bad)); \
      asm volatile("ds_read_b128 %0, %1" : "=v"(a0) : "v"(aad)); \
      asm volatile("ds_read_b128 %0, %1 offset:1024" : "=v"(a1) : "v"(aad)); \
      asm volatile("ds_read_b128 %0, %1 offset:2048" : "=v"(a2) : "v"(aad)); \
      if (FI == 4) { asm volatile("ds_read_b128 %0, %1 offset:3072" : "=v"(a3) : "v"(aad)); \
        asm volatile("s_waitcnt lgkmcnt(0)" : "+v"(b0), "+v"(b1), "+v"(b2), "+v"(b3), "+v"(a0), "+v"(a1), "+v"(a2), "+v"(a3)); } \
      else { asm volatile("s_waitcnt lgkmcnt(0)" : "+v"(b0), "+v"(b1), "+v"(b2), "+v"(b3), "+v"(a0), "+v"(a1), "+v"(a2)); a3 = a2; } \
      __builtin_amdgcn_s_setprio(1); \
      { bf16x8 bb[4] = {b0, b1, b2, b3}; bf16x8 aa[4] = {a0, a1, a2, a3}; \
        _Pragma("unroll") for (int j = 0; j < 4; ++j) \
          _Pragma("unroll") for (int i = 0; i < FI; ++i) acc[i][j] = mfma16(bb[j], aa[i], acc[i][j]); } \
      __builtin_amdgcn_s_setprio(0); \
      if (kt + 3 < nk32) GD4(kt + 3, ((J) + 3) & 3);     \
      }
    for (int kt0 = 0; kt0 < nk32; kt0 += 4) {
      RING4_STEP(0) RING4_STEP(1) RING4_STEP(2) RING4_STEP(3)
    }
#undef RING4_STEP
#undef GD4
    __syncthreads();
  } else if constexpr (DEPTH == 3) {
    constexpr int ST = (BM + BN) * 32;
    constexpr int NA4 = BM * 4 / 512, NB4 = BN * 4 / 512;
    const int nk32 = K >> 5;
    const int fs = (-(tid >> 4)) & 3;
    const u16* Ad = A + (size_t)(tm * BM + (tid >> 2)) * K + (((tid & 3) ^ fs) << 3);
    const u16* Bd = Wt + (size_t)(tn * BN + (tid >> 2)) * K + (((tid & 3) ^ fs) << 3);
    u16* Al = As + tid * 8;
    u16* Bl = As + BM * 32 + tid * 8;
    const int fr = (-(l15 >> 2)) & 3;
    const int co3 = (q4 ^ fr) << 3;
    const int a_row3 = (wm * FI * 16 + l15) * 32 + co3, b_row3 = BM * 32 + (wn * FJ * 16 + l15) * 32 + co3;
    static_assert(FI == 8 && FJ == 4, "ring path is written for 8x4 fragments per wave");
    const unsigned lbase = (unsigned)(size_t)As;
#define GD3(KT, BUF) { _Pragma("unroll") for (int i = 0; i < NA4; ++i) __builtin_amdgcn_global_load_lds((const unsigned*)(Ad + (size_t)i * 128 * K + (KT) * 32), (unsigned*)(Al + (BUF) * ST + i * 4096), 16, 0, 0); \
                       _Pragma("unroll") for (int i = 0; i < NB4; ++i) __builtin_amdgcn_global_load_lds((const unsigned*)(Bd + (size_t)i * 128 * K + (KT) * 32), (unsigned*)(Bl + (BUF) * ST + i * 4096), 16, 0, 0); }
    asm volatile("s_waitcnt vmcnt(0)" ::: "memory");
    GD3(0, 0);
    if (nk32 > 1) GD3(1, 1);
    if (nk32 > 2) GD3(2, 2);
#define RING_STEP(J) { \
      const int kt = kt0 + (J); \
      if (kt + 2 < nk32) asm volatile("s_waitcnt vmcnt(%0)" :: "n"(2 * (NA4 + NB4)) : "memory"); \
      else if (kt + 1 < nk32) asm volatile("s_waitcnt vmcnt(%0)" :: "n"(NA4 + NB4) : "memory"); \
      else asm volatile("s_waitcnt vmcnt(0)" ::: "memory"); \
      asm volatile("s_waitcnt lgkmcnt(0)" ::: "memory"); \
      __builtin_amdgcn_s_barrier(); \
      asm volatile("" ::: "memory"); \
      const unsigned aad = lbase + (unsigned)(((J) * ST + a_row3) * 2); \
      const unsigned bad = lbase + (unsigned)(((J) * ST + b_row3) * 2); \
      bf16x8 b0, b1, b2, b3, a0, a1, a2, a3; \
      asm volatile("ds_read_b128 %0, %1" : "=v"(b0) : "v"(bad)); \
      asm volatile("ds_read_b128 %0, %1 offset:1024" : "=v"(b1) : "v"(bad)); \
      asm volatile("ds_read_b128 %0, %1 offset:2048" : "=v"(b2) : "v"(bad)); \
      asm volatile("ds_read_b128 %0, %1 offset:3072" : "=v"(b3) : "v"(bad)); \
      asm volatile("ds_read_b128 %0, %1" : "=v"(a0) : "v"(aad)); \
      asm volatile("ds_read_b128 %0, %1 offset:1024" : "=v"(a1) : "v"(aad)); \
      asm volatile("ds_read_b128 %0, %1 offset:2048" : "=v"(a2) : "v"(aad)); \
      asm volatile("ds_read_b128 %0, %1 offset:3072" : "=v"(a3) : "v"(aad)); \
      __builtin_amdgcn_s_setprio(1); \
      asm volatile("s_waitcnt lgkmcnt(3)" : "+v"(b0), "+v"(b1), "+v"(b2), "+v"(b3), "+v"(a0)); \
      acc[0][0] = mfma16(b0, a0, acc[0][0]); acc[0][1] = mfma16(b1, a0, acc[0][1]); acc[0][2] = mfma16(b2, a0, acc[0][2]); acc[0][3] = mfma16(b3, a0, acc[0][3]); \
      asm volatile("s_waitcnt lgkmcnt(2)" : "+v"(a1)); \
      acc[1][0] = mfma16(b0, a1, acc[1][0]); acc[1][1] = mfma16(b1, a1, acc[1][1]); acc[1][2] = mfma16(b2, a1, acc[1][2]); acc[1][3] = mfma16(b3, a1, acc[1][3]); \
      asm volatile("s_waitcnt lgkmcnt(1)" : "+v"(a2)); \
      acc[2][0] = mfma16(b0, a2, acc[2][0]); acc[2][1] = mfma16(b1, a2, acc[2][1]); acc[2][2] = mfma16(b2, a2, acc[2][2]); acc[2][3] = mfma16(b3, a2, acc[2][3]); \
      asm volatile("s_waitcnt lgkmcnt(0)" : "+v"(a3)); \
      acc[3][0] = mfma16(b0, a3, acc[3][0]); acc[3][1] = mfma16(b1, a3, acc[3][1]); acc[3][2] = mfma16(b2, a3, acc[3][2]); acc[3][3] = mfma16(b3, a3, acc[3][3]); \
      if (kt + 3 < nk32) GD3(kt + 3, ((J) + 3) & 3);     \
      asm volatile("ds_read_b128 %0, %1 offset:4096" : "=v"(a0) : "v"(aad)); \
      asm volatile("ds_read_b128 %0, %1 offset:5120" : "=v"(a1) : "v"(aad)); \
      asm volatile("ds_read_b128 %0, %1 offset:6144" : "=v"(a2) : "v"(aad)); \
      asm volatile("ds_read_b128 %0, %1 offset:7168" : "=v"(a3) : "v"(aad)); \
      asm volatile("s_waitcnt lgkmcnt(3)" : "+v"(a0), "+v"(b0), "+v"(b1), "+v"(b2), "+v"(b3)); \
      acc[4][0] = mfma16(b0, a0, acc[4][0]); acc[4][1] = mfma16(b1, a0, acc[4][1]); acc[4][2] = mfma16(b2, a0, acc[4][2]); acc[4][3] = mfma16(b3, a0, acc[4][3]); \
      asm volatile("s_waitcnt lgkmcnt(2)" : "+v"(a1)); \
      acc[5][0] = mfma16(b0, a1, acc[5][0]); acc[5][1] = mfma16(b1, a1, acc[5][1]); acc[5][2] = mfma16(b2, a1, acc[5][2]); acc[5][3] = mfma16(b3, a1, acc[5][3]); \
      asm volatile("s_waitcnt lgkmcnt(1)" : "+v"(a2)); \
      acc[6][0] = mfma16(b0, a2, acc[6][0]); acc[6][1] = mfma16(b1, a2, acc[6][1]); acc[6][2] = mfma16(b2, a2, acc[6][2]); acc[6][3] = mfma16(b3, a2, acc[6][3]); \
      asm volatile("s_waitcnt lgkmcnt(0)" : "+v"(a3)); \
      acc[7][0] = mfma16(b0, a3, acc[7][0]); acc[7][1] = mfma16(b1, a3, acc[7][1]); acc[7][2] = mfma16(b2, a3, acc[7][2]); acc[7][3] = mfma16(b3, a3, acc[7][3]); \
      __builtin_amdgcn_s_setprio(0); }
    for (int kt0 = 0; kt0 < nk32; kt0 += 4) {
      RING_STEP(0) RING_STEP(1) RING_STEP(2) RING_STEP(3)
    }
#undef RING_STEP
#undef GD3
    __syncthreads();
  } else if constexpr (DEPTH == 0) {
    const int swz = (lr >> 1) & 7;
    const u16* Ad = A + (size_t)(tm * BM + lr) * K + ((lc ^ swz) << 3);
    const u16* Bd = Wt + (size_t)(tn * BN + lr) * K + ((lc ^ swz) << 3);
    u16* Al = As + tid * 8;
    u16* Bl = Bs + tid * 8;
#define GD(KT, BUF) { _Pragma("unroll") for (int i = 0; i < NA; ++i) __builtin_amdgcn_global_load_lds((const unsigned*)(Ad + (size_t)i * 64 * K + (KT) * 64), (unsigned*)(Al + (BUF) * BUFSZ + i * 4096), 16, 0, 0); \
                      _Pragma("unroll") for (int i = 0; i < NB; ++i) __builtin_amdgcn_global_load_lds((const unsigned*)(Bd + (size_t)i * 64 * K + (KT) * 64), (unsigned*)(Bl + (BUF) * BUFSZ + i * 4096), 16, 0, 0); }
    GD(0, 0);
    asm volatile("s_waitcnt vmcnt(0)" ::: "memory");
    __syncthreads();
    for (int kt = 0; kt < nk; kt += 2) {
      if (kt + 1 < nk) GD(kt + 1, 1);
      g_compute<FI, FJ, (EPI != EPI_KVUP)>(acc, As + a_row, Bs + b_row, q4, rsw);
      asm volatile("s_waitcnt vmcnt(0)" ::: "memory");
      __syncthreads();
      if (kt + 1 >= nk) break;
      if (kt + 2 < nk) GD(kt + 2, 0);
      g_compute<FI, FJ, (EPI != EPI_KVUP)>(acc, As + BUFSZ + a_row, Bs + BUFSZ + b_row, q4, rsw);
      asm volatile("s_waitcnt vmcnt(0)" ::: "memory");
      __syncthreads();
    }
#undef GD
  } else if constexpr (DEPTH == 2) {
    u32x4 ra0[NA], rb0[NB], ra1[NA], rb1[NB];
    GL(ra0, rb0, 0);
    if (nk > 1) GL(ra1, rb1, 1);
    GS(ra0, rb0, 0);
    __syncthreads();
    for (int kt = 0; kt < nk; kt += 2) {
      if (kt + 2 < nk) GL(ra0, rb0, kt + 2);
      g_compute<FI, FJ, (EPI != EPI_KVUP)>(acc, As + a_row, Bs + b_row, q4, rsw);
      if (kt + 1 < nk) GS(ra1, rb1, 1);
      __syncthreads();
      if (kt + 1 >= nk) break;
      if (kt + 3 < nk) GL(ra1, rb1, kt + 3);
      g_compute<FI, FJ, (EPI != EPI_KVUP)>(acc, As + BUFSZ + a_row, Bs + BUFSZ + b_row, q4, rsw);
      if (kt + 2 < nk) GS(ra0, rb0, 0);
      __syncthreads();
    }
  } else {
    u32x4 ra0[NA], rb0[NB];
    GL(ra0, rb0, 0);
    GS(ra0, rb0, 0);
    __syncthreads();
    for (int kt = 0; kt < nk; kt += 2) {
      if (kt + 1 < nk) GL(ra0, rb0, kt + 1);
      g_compute<FI, FJ, (EPI != EPI_KVUP)>(acc, As + a_row, Bs + b_row, q4, rsw);
      if (kt + 1 < nk) GS(ra0, rb0, 1);
      __syncthreads();
      if (kt + 1 >= nk) break;
      if (kt + 2 < nk) GL(ra0, rb0, kt + 2);
      g_compute<FI, FJ, (EPI != EPI_KVUP)>(acc, As + BUFSZ + a_row, Bs + BUFSZ + b_row, q4, rsw);
      if (kt + 2 < nk) GS(ra0, rb0, 0);
      __syncthreads();
    }
  }
#undef GL
#undef GS
  const int mb = tm * BM + wm * FI * 16 + q4 * 4;
  const int nb = tn * BN + wn * FJ * 16;
  const int mrow = tm * BM + wm * FI * 16 + l15;
  if (EPI == EPI_STORE) {
#pragma unroll
    for (int i = 0; i < FI; ++i)
#pragma unroll
      for (int j = 0; j < FJ; ++j) *(f32x4*)(e.C + (size_t)(mrow + i * 16) * e.ldc + nb + j * 16 + q4 * 4) = acc[i][j];
  } else if (EPI == EPI_RESID) {
    const float cf = e.ldc ? 0.5f : 1.0f;
    const f32x4 cfv = {cf, cf, cf, cf};
#pragma unroll
    for (int i = 0; i < FI; ++i) {
      const int m = mrow + i * 16;
      const float* gt = e.gate + (size_t)grp_of(m) * 9216;
#pragma unroll
      for (int j = 0; j < FJ; ++j) {
        const int n = nb + j * 16 + q4 * 4;
        f32x4 g = *(const f32x4*)(gt + n);
        f32x4* px = (f32x4*)(e.C + (size_t)m * 1024 + n);
        f32x4 xv = *px;
        xv += g * cfv * acc[i][j];
        *px = xv;
      }
    }
  } else if (EPI == EPI_SWIGLU) {
    const bool odd = (q4 & 1) != 0;
#pragma unroll
    for (int j = 0; j < FJ; ++j) {
      const int hj = ((nb >> 4) + j) * 8 + (q4 >> 1) * 4;
#pragma unroll
      for (int i2 = 0; i2 < FI / 2; ++i2) {
        float hv[4];
#pragma unroll
        for (int r = 0; r < 4; ++r) {
          float send = odd ? acc[2 * i2][j][r] : acc[2 * i2 + 1][j][r];
          float recv = shx(send, 16);
          float g = odd ? recv : acc[2 * i2][j][r];
          float u = odd ? acc[2 * i2 + 1][j][r] : recv;
          hv[r] = silu_f(g) * u;
        }
        const int m = mrow + (2 * i2 + (odd ? 1 : 0)) * 16;
        uint2 o; o.x = pack2(hv[0], hv[1]); o.y = pack2(hv[2], hv[3]);
        *(uint2*)(e.H + (size_t)m * 2816 + hj) = o;
      }
    }
  } else if (EPI == EPI_KVUP) {
#pragma unroll
    for (int j = 0; j < FJ; ++j) {
      const int n0 = nb + j * 16;
      const int hh = n0 >> 7, wb = n0 & 127;
#pragma unroll
      for (int i = 0; i < FI; ++i) {
        const int m0 = mb + i * 16;
        int krow; u16* vt;
        if (e.ctx) {
          int b = m0 >> 9, key = m0 & 511;
          krow = NPR + b * 1536 + 1024 + key;
          vt = e.vts + (size_t)((b * 8 + hh) * 64) * 1536 + 1024 + key;
        } else if (m0 < NPR) {
          int b = m0 >> 8, t = m0 & 255;
          krow = m0;
          vt = e.vtp + (size_t)((b * 8 + hh) * 64) * 256 + t;
        } else {
          int s = m0 - NPR, b = s >> 10, t = s & 1023;
          krow = NPR + b * 1536 + t;
          vt = e.vts + (size_t)((b * 8 + hh) * 64) * 1536 + t;
        }
        if (wb < 64) {
#pragma unroll
          for (int r = 0; r < 4; ++r) e.kb[(size_t)(krow + r) * 768 + hh * 96 + wb + l15] = f2bf(acc[i][j][r]);
        } else {
          const int d = wb - 64 + l15;
          const size_t L = (e.ctx || m0 >= NPR) ? 1536 : 256;
          uint2 o; o.x = pack2(acc[i][j][0], acc[i][j][1]); o.y = pack2(acc[i][j][2], acc[i][j][3]);
          *(uint2*)(vt + (size_t)d * L) = o;
        }
      }
    }
  }
}

template <int EPI, int WMW, int WNW, int FI, int FJ, int DEPTH>
__device__ __forceinline__ void gemm_phase(const u16* A, const u16* Wt, int K, int Mt, int Nt, const EpiP& e, char* smem) {
  for (int t = rbid(); t < Mt * Nt; t += (int)gridDim.x) gemm_tile<EPI, WMW, WNW, FI, FJ, DEPTH>(A, Wt, K, t % Mt, t / Mt, e, smem);
}

__device__ __forceinline__ void ffn_in_phase(PRM p, int l, int which, const EpiP& e, char* smem) {
  const u16* Wt = p.wt_ffn_in + (size_t)(l * 2 + which) * 5632 * 1024;
  const int G = (int)gridDim.x;
  const int nfull = (528 / G) * G;
  for (int t = rbid(); t < nfull; t += G) gemm_tile<EPI_SWIGLU, 2, 4, 8, 4, 3>(p.xn, Wt, 1024, t % 24, t / 24, e, smem);
  const int nq = (528 - nfull) * 4;
  const int bid = rbid();
  for (int u = bid; u < nq; u += G) {
    const int t = nfull + (u >> 2), sub = u & 3;
    gemm_tile<EPI_SWIGLU, 4, 2, 2, 4, 2>(p.xn, Wt, 1024, (t % 24) * 2 + (sub >> 1), (t / 24) * 2 + (sub & 1), e, smem);
  }
  const int tail = nq < G ? nq : G;
  if (l < 3 && bid >= tail) {
    const int vb = rtid() >> 8;
    char* vsm = smem + vb * LDS_HALF;
    const int nfree = (G - tail) * 2;
    const int vrank = (bid - tail) * 2 + vb;
    const int cnt = conv_layer_count(l + 1);
    const int half = cnt >> 1;
    const int lo = which ? half : 0, hi = which ? cnt : half;
    for (int c = lo + vrank; c < hi; c += nfree) conv_layer_task(p, l + 1, c, (float*)vsm);
    for (int c = vrank; c < 72; c += nfree) mod_task(p, (l + 1) * 144 + which * 72 + c, (float*)vsm);
  }
}

__device__ __forceinline__ void rope_store_kb(PRM p, float val, int lane, int t, bool sample, int krow) {
  float outv = val;
  if (sample) {
    float partner = shx(val, 8);
    int w = lane & 15, fi = w & 7;
    float pos = (float)((lane & 16) ? (t & 63) : (t >> 6));
    float fr = __expf(-9.210340372f * (float)fi * 0.125f);
    float s, c; sincos_r(pos * fr, s, c);
    outv = (w < 8) ? val * c - partner * s : val * c + partner * s;
  }
  if (lane < 32) {
    u16 b = f2bf(outv);
#pragma unroll
    for (int h = 0; h < 8; ++h) p.kb[(size_t)krow * 768 + h * 96 + 64 + lane] = b;
  }
}

__device__ __forceinline__ void post_even(PRM p, int e) {
  const int tid = get_tid(), lane = tid & 63, wave = tid >> 6;
  const int NT = NTOK / 4;
  const int NC = 256;
  for (int task = get_bid(); task < NT + NC; task += vgrid()) {
    if (task < NT) {
      const int m0 = task * 4, m = m0 + wave;
      const bool pr = m < NPR;
      const int b = pr ? (m >> 8) : ((m - NPR) >> 10);
      const int t = pr ? (m & 255) : ((m - NPR) & 1023);
      const float* row = p.proj + (size_t)m * 2688;
      {
        float4 a0 = *(const float4*)(row + lane * 8), a1 = *(const float4*)(row + lane * 8 + 4);
        uint4 o; o.x = pack2(a0.x, a0.y); o.y = pack2(a0.z, a0.w); o.z = pack2(a1.x, a1.y); o.w = pack2(a1.z, a1.w);
        *(uint4*)(p.qa + (size_t)m * 512 + lane * 8) = o;
        float4 k0 = *(const float4*)(row + 512 + lane * 8), k1 = *(const float4*)(row + 512 + lane * 8 + 4);
        o.x = pack2(k0.x, k0.y); o.y = pack2(k0.z, k0.w); o.z = pack2(k1.x, k1.y); o.w = pack2(k1.z, k1.w);
        *(uint4*)(p.ka + (size_t)m * 512 + lane * 8) = o;
        if (pr) {
          float* ok = p.out + O_AK + ((size_t)(b * 2 + e) * 256 + t) * 512 + lane * 8;
          *(float4*)ok = k0; *(float4*)(ok + 4) = k1;
          float4 v0 = *(const float4*)(row + 1024 + lane * 8), v1 = *(const float4*)(row + 1024 + lane * 8 + 4);
          float* ov = p.out + O_AV + ((size_t)(b * 2 + e) * 256 + t) * 512 + lane * 8;
          *(float4*)ov = v0; *(float4*)(ov + 4) = v1;
        }
      }
      {
        float4 c0 = *(const float4*)(row + 1536 + lane * 12), c1 = *(const float4*)(row + 1536 + lane * 12 + 4), c2 = *(const float4*)(row + 1536 + lane * 12 + 8);
        float ss = c0.x * c0.x + c0.y * c0.y + c0.z * c0.z + c0.w * c0.w + c1.x * c1.x + c1.y * c1.y + c1.z * c1.z + c1.w * c1.w +
                   c2.x * c2.x + c2.y * c2.y + c2.z * c2.z + c2.w * c2.w;
        ss = wsum(ss);
        float r = rsqrtf(ss * (1.f / 768.f) + EPS);
        const float* g = p.b_q_norm + e * 768 + lane * 12;
        float4 g0 = *(const float4*)g, g1 = *(const float4*)(g + 4), g2 = *(const float4*)(g + 8);
        uint2 o0, o1, o2;
        o0.x = pack2(c0.x * r * g0.x, c0.y * r * g0.y); o0.y = pack2(c0.z * r * g0.z, c0.w * r * g0.w);
        o1.x = pack2(c1.x * r * g1.x, c1.y * r * g1.y); o1.y = pack2(c1.z * r * g1.z, c1.w * r * g1.w);
        o2.x = pack2(c2.x * r * g2.x, c2.y * r * g2.y); o2.y = pack2(c2.z * r * g2.z, c2.w * r * g2.w);
        u16* d = p.cqn + (size_t)m * 768 + lane * 12;
        *(uint2*)d = o0; *(uint2*)(d + 4) = o1; *(uint2*)(d + 8) = o2;
      }
      {
        float4 c0 = *(const float4*)(row + 2304 + lane * 4);
        float ss = wsum(c0.x * c0.x + c0.y * c0.y + c0.z * c0.z + c0.w * c0.w);
        float r = rsqrtf(ss * (1.f / 256.f) + EPS);
        float4 g0 = *(const float4*)(p.b_kv_norm + e * 256 + lane * 4);
        float4 y; y.x = c0.x * r * g0.x; y.y = c0.y * r * g0.y; y.z = c0.z * r * g0.z; y.w = c0.w * r * g0.w;
        uint2 o; o.x = pack2(y.x, y.y); o.y = pack2(y.z, y.w);
        *(uint2*)(p.ckvn + (size_t)m * 256 + lane * 4) = o;
        if (pr) *(float4*)(p.out + O_CKV + ((size_t)(b * 2 + e) * 256 + t) * 256 + lane * 4) = y;
      }
      {
        float val = row[2560 + (lane & 31)];
        if (pr && lane < 32) p.out[O_KR + ((size_t)(b * 2 + e) * 256 + t) * 32 + lane] = val;
        rope_store_kb(p, val, lane, t, !pr, keyrow(m));
      }
      {
        const bool pr0 = m0 < NPR;
        const int b0 = pr0 ? (m0 >> 8) : ((m0 - NPR) >> 10);
        const int t0 = pr0 ? (m0 & 255) : ((m0 - NPR) & 1023);
#pragma unroll
        for (int i = 0; i < 2; ++i) {
          int pp = tid + 256 * i, h = pp >> 6, d = pp & 63;
          const float* src = p.proj + (size_t)m0 * 2688 + 1024 + h * 64 + d;
          float v0 = src[0], v1 = src[2688], v2 = src[2 * 2688], v3 = src[3 * 2688];
          uint2 o; o.x = pack2(v0, v1); o.y = pack2(v2, v3);
          u16* dst = pr0 ? p.vta_p + (size_t)((b0 * 8 + h) * 64 + d) * 256 + t0 : p.vta_s + (size_t)((b0 * 8 + h) * 64 + d) * 1536 + t0;
          *(uint2*)dst = o;
        }
      }
    } else {
      const int ct = task - NT;
      const int b = ct >> 7, key0 = (ct & 127) * 4;
      {
        const float* src = p.cache_a_k + ((size_t)(b * 2 + e) * 512 + key0) * 512;
        u16* dst = p.kactx + ((size_t)b * 512 + key0) * 512;
#pragma unroll
        for (int i = 0; i < 2; ++i) {
          int idx = (tid + 256 * i) * 4;
          float4 v = *(const float4*)(src + idx);
          uint2 o; o.x = pack2(v.x, v.y); o.y = pack2(v.z, v.w);
          *(uint2*)(dst + idx) = o;
        }
      }
      {
        const float* src = p.cache_a_v + ((size_t)(b * 2 + e) * 512 + key0) * 512;
#pragma unroll
        for (int i = 0; i < 2; ++i) {
          int pp = tid + 256 * i, h = pp >> 6, d = pp & 63;
          float v0 = src[pp], v1 = src[512 + pp], v2 = src[1024 + pp], v3 = src[1536 + pp];
          uint2 o; o.x = pack2(v0, v1); o.y = pack2(v2, v3);
          *(uint2*)(p.vta_s + (size_t)((b * 8 + h) * 64 + d) * 1536 + 1024 + key0) = o;
        }
      }
      {
        const float* src = p.cache_b_ckv + ((size_t)(b * 2 + e) * 512 + key0) * 256;
        float4 v = *(const float4*)(src + tid * 4);
        uint2 o; o.x = pack2(v.x, v.y); o.y = pack2(v.z, v.w);
        *(uint2*)(p.cctxn + ((size_t)b * 512 + key0) * 256 + tid * 4) = o;
      }
      {
        const float* src = p.cache_b_krope + ((size_t)(b * 2 + e) * 512 + key0) * 32;
#pragma unroll
        for (int i = 0; i < 4; ++i) {
          int idx = tid + 256 * i;
          int kk = idx >> 8, h = (idx >> 5) & 7, dd = idx & 31;
          p.kb[(size_t)(NPR + b * 1536 + 1024 + key0 + kk) * 768 + h * 96 + 64 + dd] = f2bf(src[kk * 32 + dd]);
        }
      }
    }
  }
}

__device__ __forceinline__ void post_odd(PRM p, int o) {
  const int tid = get_tid(), lane = tid & 63, wave = tid >> 6;
  const int NT = NTOK / 4, NC = 256;
  for (int task = get_bid(); task < NT + NC; task += vgrid()) {
    if (task < NT) {
      const int m0 = task * 4, m = m0 + wave;
      const bool pr = m < NPR;
      const int b = pr ? (m >> 8) : ((m - NPR) >> 10);
      const int t = pr ? (m & 255) : ((m - NPR) & 1023);
      const float* row = p.proj + (size_t)m * 2432;
      float rs = 0.f, rc = 1.f;
      if (!pr) {
        int w = lane & 31, fi = w & 15;
        float pos = (float)((lane & 32) ? (t & 63) : (t >> 6));
        float fr = __expf(-9.210340372f * (float)fi * (1.f / 16.f));
        sincos_r(pos * fr, rs, rc);
      }
      const bool lo = (lane & 16) == 0;
      const float gq = p.d_q_norm[o * 64 + lane], gk = p.d_k_norm[o * 64 + lane];
#pragma unroll
      for (int hd = 0; hd < 8; ++hd) {
        float v = row[1552 + hd * 64 + lane];
        float ss = wsum(v * v);
        float y = v * rsqrtf(ss * (1.f / 64.f) + EPS) * gq;
        if (!pr) { float pt = shx(y, 16); y = lo ? y * rc - pt * rs : y * rc + pt * rs; }
        p.qa[(size_t)m * 512 + hd * 64 + lane] = f2bf(y);
      }
#pragma unroll
      for (int kh = 0; kh < 2; ++kh) {
        float v = row[2064 + kh * 64 + lane];
        float ss = wsum(v * v);
        float y = v * rsqrtf(ss * (1.f / 64.f) + EPS) * gk;
        if (pr) p.out[O_DK + ((size_t)(b * 2 + o) * 256 + t) * 128 + kh * 64 + lane] = y;
        else { float pt = shx(y, 16); y = lo ? y * rc - pt * rs : y * rc + pt * rs; }
        p.kd[(size_t)keyrow(m) * 128 + kh * 64 + lane] = f2bf(y);
        if (pr) p.out[O_DV + ((size_t)(b * 2 + o) * 256 + t) * 128 + kh * 64 + lane] = row[2192 + kh * 64 + lane];
      }
      if (tid < 128) {
        const bool pr0 = m0 < NPR;
        const int b0 = pr0 ? (m0 >> 8) : ((m0 - NPR) >> 10);
        const int t0 = pr0 ? (m0 & 255) : ((m0 - NPR) & 1023);
        int kh = tid >> 6, d = tid & 63;
        const float* src = p.proj + (size_t)m0 * 2432 + 2192 + tid;
        float v0 = src[0], v1 = src[2432], v2 = src[2 * 2432], v3 = src[3 * 2432];
        uint2 oo; oo.x = pack2(v0, v1); oo.y = pack2(v2, v3);
        u16* dst = pr0 ? p.vtd_p + (size_t)((b0 * 2 + kh) * 64 + d) * 256 + t0 : p.vtd_s + (size_t)((b0 * 2 + kh) * 64 + d) * 1536 + t0;
        *(uint2*)dst = oo;
      }
    } else {
      const int ct = task - NT;
      const int b = ct >> 7, key0 = (ct & 127) * 4;
      {
        const float* src = p.cache_d_k + ((size_t)(b * 2 + o) * 512 + key0) * 128;
        if (tid < 128) {
          float4 v = *(const float4*)(src + tid * 4);
          uint2 oo; oo.x = pack2(v.x, v.y); oo.y = pack2(v.z, v.w);
          *(uint2*)(p.kd + (size_t)(NPR + b * 1536 + 1024 + key0) * 128 + tid * 4) = oo;
        } else {
          int pp = tid - 128, kh = pp >> 6, d = pp & 63;
          const float* sv = p.cache_d_v + ((size_t)(b * 2 + o) * 512 + key0) * 128;
          float v0 = sv[pp], v1 = sv[128 + pp], v2 = sv[256 + pp], v3 = sv[384 + pp];
          uint2 oo; oo.x = pack2(v0, v1); oo.y = pack2(v2, v3);
          *(uint2*)(p.vtd_s + (size_t)((b * 2 + kh) * 64 + d) * 1536 + 1024 + key0) = oo;
        }
      }
    }
  }
}

struct AttnSt { float m, l; f32x4 o[4]; };
template <int KS> struct KVf { bf16x8 k0[KS], k1[KS]; s16x4 v0[4], v1[4]; };

template <int KS>
__device__ __forceinline__ void attn_load(KVf<KS>& f, const u16* __restrict__ Kb, int kstride, const u16* __restrict__ Vtb, int vtstride, int l15, int q4) {
  const u16* k0p = Kb + (size_t)l15 * kstride + q4 * 8;
  const u16* k1p = k0p + (size_t)16 * kstride;
#pragma unroll
  for (int ks = 0; ks < KS; ++ks) { f.k0[ks] = *(const bf16x8*)(k0p + ks * 32); f.k1[ks] = *(const bf16x8*)(k1p + ks * 32); }
#pragma unroll
  for (int dt = 0; dt < 4; ++dt) {
    const u16* vp = Vtb + (size_t)(dt * 16 + l15) * vtstride + q4 * 4;
    f.v0[dt] = *(const s16x4*)vp; f.v1[dt] = *(const s16x4*)(vp + 16);
  }
}

template <int KS>
__device__ __forceinline__ void attn_comp(AttnSt& st, const bf16x8 (&qf)[KS], const KVf<KS>& f, float scale, int q4,
                                          bool masked, const float* rpbrow, int qc, int kc0) {
  f32x4 s0 = {0.f, 0.f, 0.f, 0.f}, s1 = {0.f, 0.f, 0.f, 0.f};
#pragma unroll
  for (int ks = 0; ks < KS; ++ks) { s0 = mfma16(f.k0[ks], qf[ks], s0); s1 = mfma16(f.k1[ks], qf[ks], s1); }
  float sv[8];
#pragma unroll
  for (int j = 0; j < 4; ++j) { sv[j] = s0[j] * scale; sv[4 + j] = s1[j] * scale; }
  if (masked) {
    const int cs = min(max(qc - 8, 0), 48);
#pragma unroll
    for (int e = 0; e < 8; ++e) {
      int kc = kc0 + (e >> 2) * 16 + q4 * 4 + (e & 3);
      bool ok = (kc >= cs) && (kc < cs + 16);
      int di = min(max(kc - qc, -15), 15) + 15;
      sv[e] = ok ? sv[e] + rpbrow[di] : -INFINITY;
    }
  }
  float mx = sv[0];
#pragma unroll
  for (int e = 1; e < 8; ++e) mx = fmaxf(mx, sv[e]);
  mx = fmaxf(mx, shx(mx, 16));
  mx = fmaxf(mx, shx(mx, 32));
  const float mnew = fmaxf(st.m, mx);
  const float alpha = __expf(st.m - mnew);
  float pe[8], ls = 0.f;
#pragma unroll
  for (int e = 0; e < 8; ++e) { pe[e] = __expf(sv[e] - mnew); ls += pe[e]; }
  st.l = st.l * alpha + ls;
  st.m = mnew;
  bf16x8 pf;
#pragma unroll
  for (int e = 0; e < 8; ++e) pf[e] = (short)f2bf(pe[e]);
#pragma unroll
  for (int dt = 0; dt < 4; ++dt) {
    bf16x8 vf = (bf16x8){f.v0[dt].x, f.v0[dt].y, f.v0[dt].z, f.v0[dt].w, f.v1[dt].x, f.v1[dt].y, f.v1[dt].z, f.v1[dt].w};
    st.o[dt] *= alpha;
    st.o[dt] = mfma16(vf, pf, st.o[dt]);
  }
}

__device__ __forceinline__ void attn_init(AttnSt& st) {
  st.m = -1e30f; st.l = 0.f;
#pragma unroll
  for (int dt = 0; dt < 4; ++dt) st.o[dt] = (f32x4){0.f, 0.f, 0.f, 0.f};
}
__device__ __forceinline__ void attn_fin(AttnSt& st, u16* outp  , int l15, int q4) {
  float lt = st.l;
  lt += shx(lt, 16);
  lt += shx(lt, 32);
  const float inv = 1.f / lt;
#pragma unroll
  for (int dt = 0; dt < 4; ++dt) {
    uint2 o; o.x = pack2(st.o[dt][0] * inv, st.o[dt][1] * inv); o.y = pack2(st.o[dt][2] * inv, st.o[dt][3] * inv);
    *(uint2*)(outp + (size_t)l15 * 1024 + dt * 16 + q4 * 4) = o;
  }
}

#define AT_VSTR 72
template <int KS> struct ATile { static constexpr int KSTR = KS * 32 + 8; static constexpr int BUF = 64 * (KS * 32 + 8) + 64 * AT_VSTR; };
template <int KS> struct AStage { u32x4 k[KS]; u32x4 v[2]; };

template <int KS>
__device__ __forceinline__ void at_load(AStage<KS>& r, const u16* __restrict__ Kg, int kstride, const u16* __restrict__ Vg, int vtstride, int tid) {
#pragma unroll
  for (int i = 0; i < KS; ++i) {
    int c = tid + 256 * i; int row = c / (KS * 4), ch = c - row * (KS * 4);
    r.k[i] = *(const u32x4*)(Kg + (unsigned)(row * kstride + ch * 8));
  }
#pragma unroll
  for (int i = 0; i < 2; ++i) {
    int c = tid + 256 * i; int row = c >> 3, ch = c & 7;
    r.v[i] = *(const u32x4*)(Vg + (unsigned)(row * vtstride + ch * 8));
  }
}
template <int KS>
__device__ __forceinline__ void at_store(const AStage<KS>& r, u16* buf, int tid) {
  u16* Ks = buf; u16* Vs = buf + 64 * ATile<KS>::KSTR;
#pragma unroll
  for (int i = 0; i < KS; ++i) {
    int c = tid + 256 * i; int row = c / (KS * 4), ch = c - row * (KS * 4);
    *(u32x4*)(Ks + row * ATile<KS>::KSTR + ch * 8) = r.k[i];
  }
#pragma unroll
  for (int i = 0; i < 2; ++i) {
    int c = tid + 256 * i; int row = c >> 3, ch = c & 7;
    *(u32x4*)(Vs + row * AT_VSTR + ch * 8) = r.v[i];
  }
}

template <int KS>
__device__ __forceinline__ void at_comp(AttnSt& st, const bf16x8 (&qf)[KS], const u16* buf, float scale, int l15, int q4,
                                        bool masked, const float* rpbrow, int qc) {
  const u16* Ks = buf; const u16* Vs = buf + 64 * ATile<KS>::KSTR;
  f32x4 s[4];
#pragma unroll
  for (int kt = 0; kt < 4; ++kt) {
    s[kt] = (f32x4){0.f, 0.f, 0.f, 0.f};
#pragma unroll
    for (int ks = 0; ks < KS; ++ks) {
      bf16x8 a = *(const bf16x8*)(Ks + (kt * 16 + l15) * ATile<KS>::KSTR + ks * 32 + q4 * 8);
      s[kt] = mfma16(a, qf[ks], s[kt]);
    }
  }
  float sv[16];
  const float sc2 = scale * 1.4426950408889634f;
#pragma unroll
  for (int kt = 0; kt < 4; ++kt)
#pragma unroll
    for (int j = 0; j < 4; ++j) sv[kt * 4 + j] = s[kt][j] * sc2;
  if (masked) {
    const int cs = min(max(qc - 8, 0), 48);
#pragma unroll
    for (int e = 0; e < 16; ++e) {
      int kc = (e >> 2) * 16 + q4 * 4 + (e & 3);
      bool ok = (kc >= cs) && (kc < cs + 16);
      int di = min(max(kc - qc, -15), 15) + 15;
      sv[e] = ok ? sv[e] + rpbrow[di] : -INFINITY;
    }
  }
  float mx = sv[0];
#pragma unroll
  for (int e = 1; e < 16; ++e) mx = fmaxf(mx, sv[e]);
  mx = fmaxf(mx, shx(mx, 16));
  mx = fmaxf(mx, shx(mx, 32));
  const float mnew = fmaxf(st.m, mx);
  const float alpha = __builtin_amdgcn_exp2f(st.m - mnew);
  float ls = 0.f;
#pragma unroll
  for (int e = 0; e < 16; ++e) { sv[e] = __builtin_amdgcn_exp2f(sv[e] - mnew); ls += sv[e]; }
  st.l = st.l * alpha + ls;
  st.m = mnew;
  bf16x8 pf[2];
#pragma unroll
  for (int hf = 0; hf < 2; ++hf) {
    u32x4 pw;
    pw[0] = pack2(sv[hf * 8 + 0], sv[hf * 8 + 1]); pw[1] = pack2(sv[hf * 8 + 2], sv[hf * 8 + 3]);
    pw[2] = pack2(sv[hf * 8 + 4], sv[hf * 8 + 5]); pw[3] = pack2(sv[hf * 8 + 6], sv[hf * 8 + 7]);
    pf[hf] = __builtin_bit_cast(bf16x8, pw);
  }
#pragma unroll
  for (int dt = 0; dt < 4; ++dt) {
    st.o[dt] *= alpha;
#pragma unroll
    for (int hf = 0; hf < 2; ++hf) {
      const u16* vp = Vs + (dt * 16 + l15) * AT_VSTR + hf * 32 + q4 * 4;
      s16x4 v0 = *(const s16x4*)vp;
      s16x4 v1 = *(const s16x4*)(vp + 16);
      bf16x8 vf = (bf16x8){v0.x, v0.y, v0.z, v0.w, v1.x, v1.y, v1.z, v1.w};
      st.o[dt] = mfma16(vf, pf[hf], st.o[dt]);
    }
  }
}

template <int KS>
__device__ __forceinline__ void at_run_plain(AttnSt& st, const bf16x8 (&qf)[KS], const u16* Kbase, int kstride, const u16* Vbase, int vtstride,
                                             int nt, float scale, u16* lds, int tid, int l15, int q4) {
  AStage<KS> r0, r1;
  at_load<KS>(r0, Kbase, kstride, Vbase, vtstride, tid);
  if (nt > 1) at_load<KS>(r1, Kbase + (size_t)64 * kstride, kstride, Vbase + 64, vtstride, tid);
  at_store<KS>(r0, lds, tid);
  __syncthreads();
  for (int t = 0; t < nt; t += 2) {
    if (t + 2 < nt) at_load<KS>(r0, Kbase + (size_t)(t + 2) * 64 * kstride, kstride, Vbase + (t + 2) * 64, vtstride, tid);
    at_comp<KS>(st, qf, lds, scale, l15, q4, false, nullptr, 0);
    if (t + 1 < nt) at_store<KS>(r1, lds + ATile<KS>::BUF, tid);
    __syncthreads();
    if (t + 1 >= nt) break;
    if (t + 3 < nt) at_load<KS>(r1, Kbase + (size_t)(t + 3) * 64 * kstride, kstride, Vbase + (t + 3) * 64, vtstride, tid);
    at_comp<KS>(st, qf, lds + ATile<KS>::BUF, scale, l15, q4, false, nullptr, 0);
    if (t + 2 < nt) at_store<KS>(r0, lds, tid);
    __syncthreads();
  }
}

__device__ __forceinline__ void load_q64(bf16x8 (&qf)[2], const u16* Q, int qstride, int l15, int q4) {
#pragma unroll
  for (int ks = 0; ks < 2; ++ks) qf[ks] = *(const bf16x8*)(Q + (size_t)l15 * qstride + ks * 32 + q4 * 8);
}
__device__ __forceinline__ void load_q_mla(bf16x8 (&qf)[3], const float* Qf, int l15, int q4, bool sample, int t0) {
  const float* qr = Qf + (size_t)l15 * 768 + q4 * 8;
#pragma unroll
  for (int ks = 0; ks < 3; ++ks) {
    float4 a = *(const float4*)(qr + ks * 32), b = *(const float4*)(qr + ks * 32 + 4);
    float v[8] = {a.x, a.y, a.z, a.w, b.x, b.y, b.z, b.w};
    if (ks == 2 && sample) {
      const int t = t0 + l15;
      const float pos = (float)((q4 & 2) ? (t & 63) : (t >> 6));
#pragma unroll
      for (int jj = 0; jj < 8; ++jj) {
        float pt = shx(v[jj], 16);
        float fr = __expf(-9.210340372f * (float)jj * 0.125f);
        float sn, cs; sincos_r(pos * fr, sn, cs);
        v[jj] = (q4 & 1) ? v[jj] * cs + pt * sn : v[jj] * cs - pt * sn;
      }
    }
#pragma unroll
    for (int jj = 0; jj < 8; ++jj) qf[ks][jj] = (short)f2bf(v[jj]);
  }
}

__device__ __forceinline__ void attn_even_phase(PRM p, int e, char* smem) {
  u16* lds = (u16*)smem;
  const int tid = get_tid(), lane = tid & 63, wave = tid >> 6, l15 = lane & 15, q4 = lane >> 4;
  const float scaleB = 0.10206207261596577f;
  for (int bt = get_bid(); bt < 1536; bt += vgrid()) {
    AttnSt st; attn_init(st);
    if (bt < 256) {
      int qb = bt & 15, h = (bt >> 4) & 7, b = bt >> 7;
      int mq = NPR + b * 1024 + qb * 64 + wave * 16;
      bf16x8 qf[3]; load_q_mla(qf, p.qb + (size_t)mq * 768 + h * 96, l15, q4, true, qb * 64 + wave * 16);
      at_run_plain<3>(st, qf, p.kb + (size_t)(NPR + b * 1536) * 768 + h * 96, 768, p.vtb_s + (size_t)((b * 8 + h) * 64) * 1536, 1536, 24, scaleB, lds, tid, l15, q4);
      attn_fin(st, p.mix + (size_t)mq * 1024 + 512 + h * 64, l15, q4);
    } else if (bt < 512) {
      int u = bt - 256;
      int r = u & 15, h = (u >> 4) & 7, b = u >> 7;
      int mq = NPR + b * 1024 + r * 64 + wave * 16;
      bf16x8 qf[2]; load_q64(qf, p.qa + (size_t)mq * 512 + h * 64, 512, l15, q4);
      const u16* Vt = p.vta_s + (size_t)((b * 8 + h) * 64) * 1536;
      const u16* Kc = p.kactx + (size_t)b * 512 * 512 + h * 64;
      const int rs = min(max(r - 4, 0), 8);
      const u16* Kw = p.ka + (size_t)(NPR + b * 1024 + rs * 64) * 512 + h * 64;
      const float* rpb0 = p.a_rpb + ((size_t)(e * 8 + h) * 15 + (rs - r + 7)) * 31;
      const int qc = wave * 16 + l15;
      float* rpl = (float*)(lds + 2 * ATile<2>::BUF);
      if (tid < 248) { int rr = tid / 31, cc = tid - rr * 31; rpl[rr * 32 + cc] = rpb0[rr * 31 + cc] * 1.4426950408889634f; }
      AStage<2> r0, r1;
#define NB_LOAD(R, T) { if ((T) < 8) at_load<2>(R, Kc + (size_t)(T) * 64 * 512, 512, Vt + 1024 + (T) * 64, 1536, tid); \
                        else at_load<2>(R, Kw + (size_t)((T) - 8) * 64 * 512, 512, Vt + (rs + (T) - 8) * 64, 1536, tid); }
#define NB_COMP(BUFP, T) { if ((T) < 8) at_comp<2>(st, qf, BUFP, 0.125f, l15, q4, false, nullptr, 0); \
                           else at_comp<2>(st, qf, BUFP, 0.125f, l15, q4, true, rpl + ((T) - 8) * 32, qc); }
      NB_LOAD(r0, 0);
      NB_LOAD(r1, 1);
      at_store<2>(r0, lds, tid);
      __syncthreads();
      for (int t = 0; t < 16; t += 2) {
        if (t + 2 < 16) NB_LOAD(r0, t + 2);
        NB_COMP(lds, t);
        at_store<2>(r1, lds + ATile<2>::BUF, tid);
        __syncthreads();
        if (t + 3 < 16) NB_LOAD(r1, t + 3);
        NB_COMP(lds + ATile<2>::BUF, t + 1);
        if (t + 2 < 16) at_store<2>(r0, lds, tid);
        __syncthreads();
      }
#undef NB_LOAD
#undef NB_COMP
      attn_fin(st, p.mix + (size_t)mq * 1024 + h * 64, l15, q4);
    } else if (bt < 1024) {
      int u = bt - 512;
      int qb = u & 3, h = (u >> 2) & 7, b = u >> 5;
      int mq = b * 256 + qb * 64 + wave * 16;
      bf16x8 qf[3]; load_q_mla(qf, p.qb + (size_t)mq * 768 + h * 96, l15, q4, false, 0);
      at_run_plain<3>(st, qf, p.kb + (size_t)(b * 256) * 768 + h * 96, 768, p.vtb_p + (size_t)((b * 8 + h) * 64) * 256, 256, 4, scaleB, lds, tid, l15, q4);
      attn_fin(st, p.mix + (size_t)mq * 1024 + 512 + h * 64, l15, q4);
    } else {
      int u = bt - 1024;
      int qb = u & 3, h = (u >> 2) & 7, b = u >> 5;
      int mq = b * 256 + qb * 64 + wave * 16;
      bf16x8 qf[2]; load_q64(qf, p.qa + (size_t)mq * 512 + h * 64, 512, l15, q4);
      at_run_plain<2>(st, qf, p.ka + (size_t)(b * 256) * 512 + h * 64, 512, p.vta_p + (size_t)((b * 8 + h) * 64) * 256, 256, 4, 0.125f, lds, tid, l15, q4);
      attn_fin(st, p.mix + (size_t)mq * 1024 + h * 64, l15, q4);
    }
  }
}

__device__ __forceinline__ int mslot(int sq, int h, int dir, int j) {
  return sq < 16 ? ((sq * 4 + h) * 2 + dir) * 4 + j : 512 + (((sq - 16) * 4 + h) * 2 + dir) * 16 + j;
}

__device__ __forceinline__ void mlstm1_task(PRM p, int o, int task, float* sm) {
  const int tid = get_tid(), lane = tid & 63, wave = tid >> 6;
  int sq, h, dir, j;
  if (task < 512) { j = task & 3; dir = (task >> 2) & 1; h = (task >> 3) & 3; sq = task >> 5; }
  else { int u = task - 512; j = u & 15; dir = (u >> 4) & 1; h = (u >> 5) & 3; sq = 16 + (u >> 7); }
  const int T = sq < 16 ? 256 : 1024;
  const int base = sq < 16 ? sq * 256 : NPR + (sq - 16) * 1024;
  const int slot = task;
  float* ks = sm;
  float* vs = sm + 4096;
  float* wg = sm + 4096 + 8192;
  if (wave == 0) {
    int s = 64 * j + lane;
    int t = dir ? T - 1 - s : s;
    const float* row = p.proj + (size_t)(base + t) * 2432 + 1536;
    float ig = row[(dir * 2 + 0) * 4 + h] + p.c_gate_bias[o * 16 + (dir * 2 + 0) * 4 + h];
    float fg = row[(dir * 2 + 1) * 4 + h] + p.c_gate_bias[o * 16 + (dir * 2 + 1) * 4 + h];
    float bsum = logsig_f(fg);
#pragma unroll
    for (int off = 1; off < 64; off <<= 1) { float v = __shfl_up(bsum, off); if (lane >= off) bsum += v; }
    float blast = __shfl(bsum, 63);
    float g = blast - bsum + ig;
    float ml = wmaxr(g);
    wg[lane] = __expf(g - ml);
    if (lane == 0) { p.dm[slot * 2] = ml; p.dm[slot * 2 + 1] = blast; }
  }
#pragma unroll
  for (int ii = 0; ii < 4; ++ii) {
    int i = (tid >> 4) + 16 * ii, c4 = tid & 15;
    int s = 64 * j + i; int t = dir ? T - 1 - s : s;
    float4 v = *(const float4*)(p.proj + (size_t)(base + t) * 2432 + 256 + h * 64 + c4 * 4);
    v.x *= 0.125f; v.y *= 0.125f; v.z *= 0.125f; v.w *= 0.125f;
    *(float4*)(ks + i * 64 + c4 * 4) = v;
  }
#pragma unroll
  for (int ii = 0; ii < 8; ++ii) {
    int i = (tid >> 5) + 8 * ii, c4 = tid & 31;
    int s = 64 * j + i; int t = dir ? T - 1 - s : s;
    *(float4*)(vs + i * 128 + c4 * 4) = *(const float4*)(p.proj + (size_t)(base + t) * 2432 + 512 + h * 128 + c4 * 4);
  }
  __syncthreads();
  const int dg = tid & 15, vg8 = tid >> 4;
  f32x4 acc[8];
#pragma unroll
  for (int q = 0; q < 8; ++q) acc[q] = (f32x4){0.f, 0.f, 0.f, 0.f};
  f32x4 nacc = {0.f, 0.f, 0.f, 0.f};
#pragma unroll 4
  for (int i = 0; i < 64; ++i) {
    f32x4 kd = *(const f32x4*)(ks + i * 64 + dg * 4) * wg[i];
    nacc += kd;
    f32x4 va = *(const f32x4*)(vs + i * 128 + vg8 * 8);
    f32x4 vb = *(const f32x4*)(vs + i * 128 + vg8 * 8 + 4);
    acc[0] += kd * va[0]; acc[1] += kd * va[1]; acc[2] += kd * va[2]; acc[3] += kd * va[3];
    acc[4] += kd * vb[0]; acc[5] += kd * vb[1]; acc[6] += kd * vb[2]; acc[7] += kd * vb[3];
  }
  float* dc = p.dC + (size_t)slot * 8192;
#pragma unroll
  for (int q = 0; q < 8; ++q) *(f32x4*)(dc + (vg8 * 8 + q) * 64 + dg * 4) = acc[q];
  if (vg8 == 0) *(f32x4*)(p.dn + slot * 64 + dg * 4) = nacc;
  __syncthreads();
}

__device__ __forceinline__ void mlstm2_task(PRM p, int o, int task, float* sm) {
  const int tid = get_tid(), lane = tid & 63, wave = tid >> 6;
  int sq, h, c;
  if (task < 256) { c = task & 3; h = (task >> 2) & 3; sq = task >> 4; }
  else { int u = task - 256; c = u & 15; h = (u >> 4) & 3; sq = 16 + (u >> 6); }
  const bool pr = sq < 16;
  const int nc = pr ? 4 : 16;
  const int base = (pr ? sq * 256 : NPR + (sq - 16) * 1024) + c * 64;
  float* qT = sm;
  float* kT = sm + 4352;
  float* CT = kT;
  float* St = sm + 2 * 4352;
  float* vh = sm + 3 * 4352;
  float* smalls = sm + 4 * 4352;
  float* bl = smalls;
  float* itb = smalls + 64;
  float* mt = smalls + 128;
  float* w0 = smalls + 192;
  float* nv = smalls + 256;
  float* nq = smalls + 320;
  float* den = smalls + 384;
  float* scal = smalls + 448;

  const int tl = tid >> 4, tx = tid & 15;
  const int l0 = tl * 4, x0 = tx * 4;
  float hacc[2][4][4];
#pragma unroll
  for (int a = 0; a < 2; ++a)
#pragma unroll
    for (int b2 = 0; b2 < 4; ++b2)
#pragma unroll
      for (int c2 = 0; c2 < 4; ++c2) hacc[a][b2][c2] = 0.f;

  f32x4 qv[4], kv[4];
#pragma unroll
  for (int ii = 0; ii < 4; ++ii) {
    int i = (tid >> 4) + 16 * ii, c4 = tid & 15;
    const float* row = p.proj + (size_t)(base + i) * 2432 + h * 64 + c4 * 4;
    qv[ii] = *(const f32x4*)row;
    kv[ii] = *(const f32x4*)(row + 256);
  }
#pragma unroll
  for (int ii = 0; ii < 4; ++ii) {
    int i = (tid >> 4) + 16 * ii, c4 = tid & 15;
    qT[(c4 * 4 + 0) * 68 + i] = qv[ii].x; qT[(c4 * 4 + 1) * 68 + i] = qv[ii].y; qT[(c4 * 4 + 2) * 68 + i] = qv[ii].z; qT[(c4 * 4 + 3) * 68 + i] = qv[ii].w;
  }
#pragma unroll 1
  for (int dir = 0; dir < 2; ++dir) {
    const int j = dir ? nc - 1 - c : c;
    const int slj = mslot(sq, h, dir, j);
    const float mprev = p.mp[slj];
    float cr[16]; f32x4 vr[4];
    const float* cpp = p.cp + (size_t)slj * 8192;
#pragma unroll
    for (int r = 0; r < 16; ++r) cr[r] = cpp[tid + 256 * r];
#pragma unroll
    for (int ii = 0; ii < 4; ++ii) {
      int i = (tid >> 4) + 16 * ii, c4 = tid & 15;
      vr[ii] = *(const f32x4*)(p.proj + (size_t)(base + i) * 2432 + 512 + h * 128 + c4 * 4);
    }
    if (wave == 0) {
      const int i = lane;
      const int tau = dir ? 63 - i : i;
      const float* row = p.proj + (size_t)(base + tau) * 2432 + 1536;
      float ig = row[(dir * 2 + 0) * 4 + h] + p.c_gate_bias[o * 16 + (dir * 2 + 0) * 4 + h];
      float fg = row[(dir * 2 + 1) * 4 + h] + p.c_gate_bias[o * 16 + (dir * 2 + 1) * 4 + h];
      float bsum = logsig_f(fg);
#pragma unroll
      for (int off = 1; off < 64; off <<= 1) { float v = __shfl_up(bsum, off); if (lane >= off) bsum += v; }
      float ib = ig - bsum;
      float pm = ib;
#pragma unroll
      for (int off = 1; off < 64; off <<= 1) { float v = __shfl_up(pm, off); if (lane >= off) pm = fmaxf(pm, v); }
      float mti = fmaxf(bsum + mprev, bsum + pm);
      bl[tau] = bsum; itb[tau] = ib; mt[tau] = mti; w0[tau] = __expf(bsum + mprev - mti);
    }
#pragma unroll
    for (int ii = 0; ii < 4; ++ii) {
      int i = (tid >> 4) + 16 * ii, c4 = tid & 15;
      kT[(c4 * 4 + 0) * 68 + i] = kv[ii].x * 0.125f; kT[(c4 * 4 + 1) * 68 + i] = kv[ii].y * 0.125f;
      kT[(c4 * 4 + 2) * 68 + i] = kv[ii].z * 0.125f; kT[(c4 * 4 + 3) * 68 + i] = kv[ii].w * 0.125f;
    }
    if (tid < 64) nv[tid] = p.np[slj * 64 + tid];
    __syncthreads();
    {
      float a[4][4];
#pragma unroll
      for (int r = 0; r < 4; ++r)
#pragma unroll
        for (int q = 0; q < 4; ++q) a[r][q] = 0.f;
#pragma unroll 2
      for (int d = 0; d < 64; ++d) {
        float4 q4v = *(const float4*)(qT + d * 68 + l0);
        float4 k4v = *(const float4*)(kT + d * 68 + x0);
        float qa[4] = {q4v.x, q4v.y, q4v.z, q4v.w}, kk[4] = {k4v.x, k4v.y, k4v.z, k4v.w};
#pragma unroll
        for (int r = 0; r < 4; ++r)
#pragma unroll
          for (int q = 0; q < 4; ++q) a[r][q] = fmaf(qa[r], kk[q], a[r][q]);
      }
      float rsum[4];
#pragma unroll
      for (int r = 0; r < 4; ++r) {
        const int l = l0 + r;
        const float bll = bl[l], mtl = mt[l];
        rsum[r] = 0.f;
#pragma unroll
        for (int q = 0; q < 4; ++q) {
          const int s = x0 + q;
          const bool ok = dir ? (s >= l) : (s <= l);
          float sv = ok ? a[r][q] * __expf(bll + itb[s] - mtl) : 0.f;
          St[s * 68 + l] = sv;
          rsum[r] += sv;
        }
        rsum[r] += shx(rsum[r], 1); rsum[r] += shx(rsum[r], 2);
        rsum[r] += shx(rsum[r], 4); rsum[r] += shx(rsum[r], 8);
        if (tx == 0) den[l] = rsum[r];
      }
    }
    __syncthreads();
    if (tid < 64) {
      float s = 0.f;
#pragma unroll 4
      for (int d = 0; d < 64; ++d) s = fmaf(qT[d * 68 + tid], nv[d], s);
      nq[tid] = s;
    }
#pragma unroll 1
    for (int vhalf = 0; vhalf < 2; ++vhalf) {
#pragma unroll
      for (int r = 0; r < 16; ++r) {
        int e = tid + 256 * r;
        CT[(e & 63) * 68 + (e >> 6)] = cr[r];
      }
#pragma unroll
      for (int ii = 0; ii < 4; ++ii) {
        int i = (tid >> 4) + 16 * ii, c4 = tid & 15;
        *(f32x4*)(vh + i * 68 + c4 * 4) = vr[ii];
      }
      if (vhalf == 0) {
#pragma unroll
        for (int r = 0; r < 16; ++r) cr[r] = cpp[4096 + tid + 256 * r];
#pragma unroll
        for (int ii = 0; ii < 4; ++ii) {
          int i = (tid >> 4) + 16 * ii, c4 = tid & 15;
          vr[ii] = *(const f32x4*)(p.proj + (size_t)(base + i) * 2432 + 512 + h * 128 + 64 + c4 * 4);
        }
      }
      __syncthreads();
      {
        float a1[4][4], a2[4][4];
#pragma unroll
        for (int r = 0; r < 4; ++r)
#pragma unroll
          for (int q = 0; q < 4; ++q) { a1[r][q] = 0.f; a2[r][q] = 0.f; }
#pragma unroll 2
        for (int s = 0; s < 64; ++s) {
          float4 sa = *(const float4*)(St + s * 68 + l0);
          float4 vb = *(const float4*)(vh + s * 68 + x0);
          float4 qa4 = *(const float4*)(qT + s * 68 + l0);
          float4 cb4 = *(const float4*)(CT + s * 68 + x0);
          float sl4[4] = {sa.x, sa.y, sa.z, sa.w}, vv[4] = {vb.x, vb.y, vb.z, vb.w};
          float qq[4] = {qa4.x, qa4.y, qa4.z, qa4.w}, cc[4] = {cb4.x, cb4.y, cb4.z, cb4.w};
#pragma unroll
          for (int r = 0; r < 4; ++r)
#pragma unroll
            for (int q = 0; q < 4; ++q) { a1[r][q] = fmaf(sl4[r], vv[q], a1[r][q]); a2[r][q] = fmaf(qq[r], cc[q], a2[r][q]); }
        }
#pragma unroll
        for (int r = 0; r < 4; ++r) {
          const int l = l0 + r;
          const float w = w0[l];
          const float dn_ = den[l] + w * nq[l];
          const float dd = fmaxf(fabsf(dn_), __expf(-mt[l]));
          const float inv = 1.f / dd;
#pragma unroll
          for (int q = 0; q < 4; ++q) { float hv = (a1[r][q] + w * a2[r][q]) * inv; if (vhalf == 0) hacc[0][r][q] += hv; else hacc[1][r][q] += hv; }
        }
      }
      __syncthreads();
    }
  }
#pragma unroll
  for (int r = 0; r < 4; ++r) {
    float ss = 0.f;
#pragma unroll
    for (int a = 0; a < 2; ++a)
#pragma unroll
      for (int q = 0; q < 4; ++q) ss += hacc[a][r][q] * hacc[a][r][q];
    ss += shx(ss, 1); ss += shx(ss, 2); ss += shx(ss, 4); ss += shx(ss, 8);
    const float rn = rsqrtf(ss * (1.f / 128.f) + EPS);
    const int m = base + l0 + r;
#pragma unroll
    for (int a = 0; a < 2; ++a) {
      const int v0 = a * 64 + x0;
      float4 co = *(const float4*)(p.proj + (size_t)m * 2432 + 1024 + h * 128 + v0);
      float4 gn = *(const float4*)(p.c_out_norm + (size_t)(o * 4 + h) * 128 + v0);
      float y0 = sigmoid_f(co.x) * hacc[a][r][0] * rn * gn.x;
      float y1 = sigmoid_f(co.y) * hacc[a][r][1] * rn * gn.y;
      float y2 = sigmoid_f(co.z) * hacc[a][r][2] * rn * gn.z;
      float y3 = sigmoid_f(co.w) * hacc[a][r][3] * rn * gn.w;
      uint2 oo; oo.x = pack2(y0, y1); oo.y = pack2(y2, y3);
      *(uint2*)(p.mix + (size_t)m * 1024 + h * 128 + v0) = oo;
    }
  }
  __syncthreads();
}

__device__ __forceinline__ void mlstm2_mfma(PRM p, int o, int task, char* smem) {
  const int tid = get_tid(), lane = tid & 63, wave = tid >> 6, l15 = lane & 15, q4 = lane >> 4;
  int sq, h, c;
  if (task < 256) { c = task & 3; h = (task >> 2) & 3; sq = task >> 4; }
  else { int u = task - 256; c = u & 15; h = (u >> 4) & 3; sq = 16 + (u >> 6); }
  const bool pr = sq < 16;
  const int nc = pr ? 4 : 16;
  const int base = (pr ? sq * 256 : NPR + (sq - 16) * 1024) + c * 64;
  u16* Qb = (u16*)smem;
  u16* Kb = Qb + 64 * 72;
  u16* Vt = Kb + 64 * 72;
  u16* Cb = Vt + 128 * 72;
  float* sml = (float*)(Cb + 128 * 72);
  float* bl = sml; float* itb = sml + 64; float* mt = sml + 128; float* w0 = sml + 192; float* nv = sml + 256;
#pragma unroll
  for (int ii = 0; ii < 4; ++ii) {
    int i = (tid >> 4) + 16 * ii, c4 = tid & 15;
    const float* row = p.proj + (size_t)(base + i) * 2432 + h * 64 + c4 * 4;
    f32x4 qv = *(const f32x4*)row;
    f32x4 kv = *(const f32x4*)(row + 256);
    uint2 a; a.x = pack2(qv[0], qv[1]); a.y = pack2(qv[2], qv[3]);
    uint2 b; b.x = pack2(kv[0] * 0.125f, kv[1] * 0.125f); b.y = pack2(kv[2] * 0.125f, kv[3] * 0.125f);
    *(uint2*)(Qb + i * 72 + c4 * 4) = a;
    *(uint2*)(Kb + i * 72 + c4 * 4) = b;
  }
#pragma unroll
  for (int ii = 0; ii < 8; ++ii) {
    int i = (tid >> 5) + 8 * ii, c4 = tid & 31;
    f32x4 vv = *(const f32x4*)(p.proj + (size_t)(base + i) * 2432 + 512 + h * 128 + c4 * 4);
    unsigned w01 = pack2(vv[0], vv[1]), w23 = pack2(vv[2], vv[3]);
    Vt[(c4 * 4 + 0) * 72 + i] = (u16)(w01 & 0xffffu); Vt[(c4 * 4 + 1) * 72 + i] = (u16)(w01 >> 16);
    Vt[(c4 * 4 + 2) * 72 + i] = (u16)(w23 & 0xffffu); Vt[(c4 * 4 + 3) * 72 + i] = (u16)(w23 >> 16);
  }
  f32x4 hacc[8];
#pragma unroll
  for (int vt = 0; vt < 8; ++vt) hacc[vt] = (f32x4){0.f, 0.f, 0.f, 0.f};
  const int lrow = wave * 16 + l15;
#pragma unroll 1
  for (int dir = 0; dir < 2; ++dir) {
    const int j = dir ? nc - 1 - c : c;
    const int slj = mslot(sq, h, dir, j);
    const float mprev = p.mp[slj];
    {
      const f32x4* cpp = (const f32x4*)(p.cp + (size_t)slj * 8192);
#pragma unroll
      for (int r = 0; r < 8; ++r) {
        int e4 = tid + 256 * r;
        f32x4 cv = cpp[e4];
        uint2 a; a.x = pack2(cv[0], cv[1]); a.y = pack2(cv[2], cv[3]);
        *(uint2*)(Cb + (e4 >> 4) * 72 + (e4 & 15) * 4) = a;
      }
    }
    if (tid < 64) nv[tid] = p.np[slj * 64 + tid];
    if (wave == 0) {
      const int i = lane;
      const int tau = dir ? 63 - i : i;
      const float* row = p.proj + (size_t)(base + tau) * 2432 + 1536;
      float ig = row[(dir * 2 + 0) * 4 + h] + p.c_gate_bias[o * 16 + (dir * 2 + 0) * 4 + h];
      float fg = row[(dir * 2 + 1) * 4 + h] + p.c_gate_bias[o * 16 + (dir * 2 + 1) * 4 + h];
      float bsum = logsig_f(fg);
#pragma unroll
      for (int off = 1; off < 64; off <<= 1) { float v = __shfl_up(bsum, off); if (lane >= off) bsum += v; }
      float ib = ig - bsum;
      float pm = ib;
#pragma unroll
      for (int off = 1; off < 64; off <<= 1) { float v = __shfl_up(pm, off); if (lane >= off) pm = fmaxf(pm, v); }
      float mti = fmaxf(bsum + mprev, bsum + pm);
      bl[tau] = bsum; itb[tau] = ib; mt[tau] = mti; w0[tau] = __expf(bsum + mprev - mti);
    }
    __syncthreads();
    const float bll = bl[lrow], mtl = mt[lrow], w0l = w0[lrow];
    bf16x8 qf[2];
#pragma unroll
    for (int ks = 0; ks < 2; ++ks) qf[ks] = *(const bf16x8*)(Qb + lrow * 72 + ks * 32 + q4 * 8);
    float nqp = 0.f;
#pragma unroll
    for (int ks = 0; ks < 2; ++ks)
#pragma unroll
      for (int jj = 0; jj < 8; ++jj) {
        float qe = __uint_as_float(((unsigned)(unsigned short)qf[ks][jj]) << 16);
        nqp = fmaf(qe, nv[ks * 32 + q4 * 8 + jj], nqp);
      }
    nqp += shx(nqp, 16); nqp += shx(nqp, 32);
    f32x4 oacc[8];
#pragma unroll
    for (int vt = 0; vt < 8; ++vt) {
      oacc[vt] = (f32x4){0.f, 0.f, 0.f, 0.f};
#pragma unroll
      for (int ks = 0; ks < 2; ++ks) {
        bf16x8 a = *(const bf16x8*)(Cb + (vt * 16 + l15) * 72 + ks * 32 + q4 * 8);
        oacc[vt] = mfma16(a, qf[ks], oacc[vt]);
      }
      oacc[vt] *= w0l;
    }
    float sv[16];
    float dsum = 0.f;
#pragma unroll
    for (int st = 0; st < 4; ++st) {
      f32x4 sa = {0.f, 0.f, 0.f, 0.f};
#pragma unroll
      for (int ks = 0; ks < 2; ++ks) {
        bf16x8 a = *(const bf16x8*)(Kb + (st * 16 + l15) * 72 + ks * 32 + q4 * 8);
        sa = mfma16(a, qf[ks], sa);
      }
#pragma unroll
      for (int r = 0; r < 4; ++r) {
        const int sidx = st * 16 + q4 * 4 + r;
        const bool ok = dir ? (sidx >= lrow) : (sidx <= lrow);
        float val = ok ? sa[r] * __expf(bll + itb[sidx] - mtl) : 0.f;
        sv[st * 4 + r] = val;
        dsum += val;
      }
    }
    dsum += shx(dsum, 16); dsum += shx(dsum, 32);
    bf16x8 pf[2];
#pragma unroll
    for (int hf = 0; hf < 2; ++hf) {
      u32x4 pw;
      pw[0] = pack2(sv[hf * 8 + 0], sv[hf * 8 + 1]); pw[1] = pack2(sv[hf * 8 + 2], sv[hf * 8 + 3]);
      pw[2] = pack2(sv[hf * 8 + 4], sv[hf * 8 + 5]); pw[3] = pack2(sv[hf * 8 + 6], sv[hf * 8 + 7]);
      pf[hf] = __builtin_bit_cast(bf16x8, pw);
    }
    const float dn_ = dsum + w0l * nqp;
    const float inv = 1.f / fmaxf(fabsf(dn_), __expf(-mtl));
#pragma unroll
    for (int vt = 0; vt < 8; ++vt) {
#pragma unroll
      for (int hf = 0; hf < 2; ++hf) {
        const u16* vp = Vt + (vt * 16 + l15) * 72 + hf * 32 + q4 * 4;
        s16x4 v0 = *(const s16x4*)vp;
        s16x4 v1 = *(const s16x4*)(vp + 16);
        bf16x8 vf = (bf16x8){v0.x, v0.y, v0.z, v0.w, v1.x, v1.y, v1.z, v1.w};
        oacc[vt] = mfma16(vf, pf[hf], oacc[vt]);
      }
      hacc[vt] += oacc[vt] * inv;
    }
    __syncthreads();
  }
  float ss = 0.f;
#pragma unroll
  for (int vt = 0; vt < 8; ++vt)
#pragma unroll
    for (int r = 0; r < 4; ++r) ss += hacc[vt][r] * hacc[vt][r];
  ss += shx(ss, 16); ss += shx(ss, 32);
  const float rn = rsqrtf(ss * (1.f / 128.f) + EPS);
  const int m = base + lrow;
#pragma unroll
  for (int vt = 0; vt < 8; ++vt) {
    const int v0 = vt * 16 + q4 * 4;
    f32x4 co = *(const f32x4*)(p.proj + (size_t)m * 2432 + 1024 + h * 128 + v0);
    f32x4 gn = *(const f32x4*)(p.c_out_norm + (size_t)(o * 4 + h) * 128 + v0);
    float y0 = sigmoid_f(co[0]) * hacc[vt][0] * rn * gn[0];
    float y1 = sigmoid_f(co[1]) * hacc[vt][1] * rn * gn[1];
    float y2 = sigmoid_f(co[2]) * hacc[vt][2] * rn * gn[2];
    float y3 = sigmoid_f(co[3]) * hacc[vt][3] * rn * gn[3];
    uint2 oo; oo.x = pack2(y0, y1); oo.y = pack2(y2, y3);
    *(uint2*)(p.mix + (size_t)m * 1024 + h * 128 + v0) = oo;
  }
  __syncthreads();
}

__device__ __forceinline__ void mlstm_scan_phase(PRM p, int o) {
  const int tid = get_tid();
  for (int task = get_bid(); task < 576; task += vgrid()) {
    const int sc = task >> 2, slice = task & 3;
    int sq, h, dir;
    if (sc < 128) { sq = sc >> 3; h = (sc >> 1) & 3; dir = sc & 1; }
    else { int u = sc - 128; sq = 16 + (u >> 3); h = (u >> 1) & 3; dir = u & 1; }
    const bool pr = sq < 16;
    const int nc = pr ? 4 : 16;
    const int sidx = pr ? ((sq * 2 + o) * 2 + dir) * 4 + h : 0;
    const int cidx = pr ? 0 : (((sq - 16) * 2 + o) * 2 + dir) * 4 + h;
    const int e0 = slice * 2048 + tid;
    float C[8];
#pragma unroll
    for (int r = 0; r < 8; ++r) C[r] = pr ? 0.f : p.state_C[(size_t)cidx * 8192 + e0 + 256 * r];
    const bool nthr = (slice == 0) && (tid < 64);
    float n = (pr || !nthr) ? 0.f : p.state_n[cidx * 64 + tid];
    float m = pr ? 0.f : p.state_m[cidx];
#pragma unroll 4
    for (int j = 0; j < nc; ++j) {
      const int sl = mslot(sq, h, dir, j);
      float* cp = p.cp + (size_t)sl * 8192 + e0;
      const float* dc = p.dC + (size_t)sl * 8192 + e0;
#pragma unroll
      for (int r = 0; r < 8; ++r) cp[256 * r] = C[r];
      if (nthr) { p.np[sl * 64 + tid] = n; if (tid == 0) p.mp[sl] = m; }
      const float ml = p.dm[sl * 2], bls = p.dm[sl * 2 + 1];
      const float mn = fmaxf(bls + m, ml);
      const float ca = __expf(bls + m - mn), cb = __expf(ml - mn);
#pragma unroll
      for (int r = 0; r < 8; ++r) C[r] = ca * C[r] + cb * dc[256 * r];
      if (nthr) n = ca * n + cb * p.dn[sl * 64 + tid];
      m = mn;
    }
    if (pr) {
      float* oc = p.out + O_CC + (size_t)sidx * 8192 + e0;
#pragma unroll
      for (int r = 0; r < 8; ++r) oc[256 * r] = C[r];
      if (nthr) { p.out[O_CN + (size_t)sidx * 64 + tid] = n; if (tid == 0) p.out[O_CM + sidx] = m; }
    }
  }
}

__device__ __forceinline__ void odd_mid_phase(PRM p, int o, char* smem) {
  u16* lds = (u16*)smem;
  const int tid = get_tid(), lane = tid & 63, wave = tid >> 6, l15 = lane & 15, q4 = lane >> 4;
  for (int bt = get_bid(); bt < 256 + 768 + 512; bt += vgrid()) {
    if (bt < 256) {
      int qb = bt & 15, hq = (bt >> 4) & 7, b = bt >> 7;
      int kvh = hq >> 2;
      int mq = NPR + b * 1024 + qb * 64 + wave * 16;
      AttnSt st; attn_init(st);
      bf16x8 qf[2]; load_q64(qf, p.qa + (size_t)mq * 512 + hq * 64, 512, l15, q4);
      at_run_plain<2>(st, qf, p.kd + (size_t)(NPR + b * 1536) * 128 + kvh * 64, 128, p.vtd_s + (size_t)((b * 2 + kvh) * 64) * 1536, 1536, 24, 0.125f, lds, tid, l15, q4);
      attn_fin(st, p.mix + (size_t)mq * 1024 + 512 + hq * 64, l15, q4);
    } else if (bt < 256 + 768) {
      mlstm1_task(p, o, bt - 256, (float*)smem);
    } else {
      int u = bt - 1024;
      int qb = u & 3, hq = (u >> 2) & 7, b = u >> 5;
      int kvh = hq >> 2;
      int mq = b * 256 + qb * 64 + wave * 16;
      AttnSt st; attn_init(st);
      bf16x8 qf[2]; load_q64(qf, p.qa + (size_t)mq * 512 + hq * 64, 512, l15, q4);
      at_run_plain<2>(st, qf, p.kd + (size_t)(b * 256) * 128 + kvh * 64, 128, p.vtd_p + (size_t)((b * 2 + kvh) * 64) * 256, 256, 4, 0.125f, lds, tid, l15, q4);
      attn_fin(st, p.mix + (size_t)mq * 1024 + 512 + hq * 64, l15, q4);
    }
  }
}

__device__ __forceinline__ void run_phase(PRM p, int ph, char* smem) {
  char* vsm = smem + (rtid() >> 8) * LDS_HALF;
  if (ph == 0) { phase0(p, vsm); return; }
  if (ph == NPHASE - 1) { norm_phase(p, 0, 3); return; }
  const int l = (ph - 1) / 13, s = (ph - 1) % 13;
  const int eo = l >> 1;
  const bool even = (l & 1) == 0;
  EpiP e{};
  const float* modl = p.mod + (size_t)l * 3 * 9216;
  switch (s) {
    case 0: norm_phase(p, l, 0); break;
    case 1: e.H = p.h; ffn_in_phase(p, l, 0, e, smem); break;
    case 2: e.C = p.x; e.gate = modl + 2 * 1024; e.ldc = 1;
            gemm_phase<EPI_RESID, 4, 2, 3, 4, 4>(p.h, p.wt_ffn_out + (size_t)(l * 2 + 0) * 1024 * 2816, 2816, 32, 8, e, smem); break;
    case 3: norm_phase(p, l, 1); break;
    case 4:
      if (even) { e.C = p.proj; e.ldc = 2688; gemm_phase<EPI_STORE, 4, 2, 4, 4, 2>(p.xn, p.wt_in_e + (size_t)eo * 2688 * 1024, 1024, 24, 21, e, smem); }
      else { e.C = p.proj; e.ldc = 2432; gemm_phase<EPI_STORE, 4, 2, 4, 4, 2>(p.xn, p.wt_in_o + (size_t)eo * 2432 * 1024, 1024, 24, 19, e, smem); }
      break;
    case 5: if (even) post_even(p, eo); else post_odd(p, eo); break;
    case 6:
      if (even) {
        EpiP eq{}; eq.C = p.qb; eq.ldc = 768;
        EpiP ek{}; ek.kb = p.kb; ek.vtp = p.vtb_p; ek.vts = p.vtb_s; ek.ctx = 0;
        EpiP ec = ek; ec.ctx = 1;
        const u16* wq = p.wt_qup + (size_t)eo * 768 * 768;
        const u16* wk = p.wt_kvup + (size_t)eo * 1024 * 256;
        for (int t = rbid(); t < 288 + 384 + 64; t += (int)gridDim.x) {
          if (t < 288) gemm_tile<EPI_STORE, 4, 2, 2, 4, 2>(p.cqn, wq, 768, t % 48, t / 48, eq, smem);
          else if (t < 672) { int u = t - 288; gemm_tile<EPI_KVUP, 4, 2, 2, 4, 2>(p.ckvn, wk, 256, u % 48, u / 48, ek, smem); }
          else { int u = t - 672; gemm_tile<EPI_KVUP, 4, 2, 2, 4, 2>(p.cctxn, wk, 256, u % 8, u / 8, ec, smem); }
        }
      } else odd_mid_phase(p, eo, vsm);
      break;
    case 7: if (!even) mlstm_scan_phase(p, eo); break;
    case 8:
      if (even) attn_even_phase(p, eo, vsm);
      else { for (int t = get_bid(); t < 384; t += vgrid()) mlstm2_mfma(p, eo, t, vsm); }
      break;
    case 9: e.C = p.x; e.gate = modl + 5 * 1024; e.ldc = 0;
            gemm_phase<EPI_RESID, 4, 2, 3, 4, 2>(p.mix, p.wt_out + (size_t)l * 1024 * 1024, 1024, 32, 8, e, smem); break;
    case 10: norm_phase(p, l, 2); break;
    case 11: e.H = p.h; ffn_in_phase(p, l, 1, e, smem); break;
    case 12: e.C = p.x; e.gate = modl + 8 * 1024; e.ldc = 1;
             gemm_phase<EPI_RESID, 4, 2, 3, 4, 4>(p.h, p.wt_ffn_out + (size_t)(l * 2 + 1) * 1024 * 2816, 2816, 32, 8, e, smem); break;
  }
}

__global__ void __launch_bounds__(512, 2) mega(Params p) {
  __shared__ __attribute__((aligned(16))) char smem[LDS_BYTES];
  __shared__ uint4 xb_words;
  cg::grid_group grid = cg::this_grid();
  if (threadIdx.x == 0) xb_words = make_uint4(0u, 0u, 0u, 0u);
  __syncthreads();
  XcdBarrier xb = xcd_barrier_post(p.bar, (volatile LAS unsigned*)&xb_words);
  for (int ph = p.ph0; ph < p.ph1; ++ph) {
    const __attribute__((address_space(4))) Params* pp = (const __attribute__((address_space(4))) Params*)__builtin_amdgcn_kernarg_segment_ptr();
    asm volatile("" : "+s"(pp));
    run_phase(*pp, ph, smem);
#ifndef REPMASK
#define REPMASK 0
#endif
#ifndef REPPAR
#define REPPAR 0
#endif
    if (REPMASK) {
      int bit = ph == 0 ? 13 : (ph == NPHASE - 1 ? 14 : (ph - 1) % 13);
      int lay = (ph - 1) / 13;
      bool parok = REPPAR == 0 || ph == 0 || ph == NPHASE - 1 || (REPPAR == 1 && (lay & 1) == 0) || (REPPAR == 2 && (lay & 1) == 1);
      if (((REPMASK >> bit) & 1) && parok) { xcd_barrier(xb); asm volatile("" : "+s"(pp)); run_phase(*pp, ph, smem); }
    }
    if (ph + 1 < p.ph1) {
      if (p.ph1 > 100000) grid.sync();
      xcd_barrier(xb);
    }
  }
}

extern "C" void kernel_launch(void* const* d_in, const int* in_sizes, int n_in, void* d_out, int out_size, void* d_ws, size_t ws_size,
                              hipStream_t stream) {
  static int grid_blocks = 0;
  if (!grid_blocks) {
    int dev = 0, cus = 0, per_cu = 0;
    hipGetDevice(&dev);
    hipDeviceGetAttribute(&cus, hipDeviceAttributeMultiprocessorCount, dev);
    hipOccupancyMaxActiveBlocksPerMultiprocessor(&per_cu, mega, 512, 0);
    per_cu = 1;
    grid_blocks = cus * per_cu;
  }
  Params p{};
  const float** ip = (const float**)&p.x_prompt;
  for (int i = 0; i < 31; ++i) ip[i] = (const float*)d_in[i];
  p.out = (float*)d_out;
  char* w = (char*)d_ws;
  size_t off = 0;
  auto take = [&](size_t bytes) { char* r = w + off; off += (bytes + 255) & ~(size_t)255; return r; };
  p.wt_ffn_in = (u16*)take((size_t)8 * 5632 * 1024 * 2);
  p.wt_ffn_out = (u16*)take((size_t)8 * 1024 * 2816 * 2);
  p.wt_in_e = (u16*)take((size_t)2 * 2688 * 1024 * 2);
  p.wt_in_o = (u16*)take((size_t)2 * 2432 * 1024 * 2);
  p.wt_out = (u16*)take((size_t)4 * 1024 * 1024 * 2);
  p.wt_qup = (u16*)take((size_t)2 * 768 * 768 * 2);
  p.wt_kvup = (u16*)take((size_t)2 * 1024 * 256 * 2);
  p.mod = (float*)take((size_t)12 * 9216 * 4);
  p.x = (float*)take((size_t)NTOK * 1024 * 4);
  p.proj = (float*)take((size_t)NTOK * 2688 * 4);
  p.qb = (float*)take((size_t)NTOK * 768 * 4);
  p.dC = (float*)take((size_t)768 * 8192 * 4);
  p.dn = (float*)take((size_t)768 * 64 * 4);
  p.dm = (float*)take((size_t)768 * 2 * 4);
  p.cp = (float*)take((size_t)768 * 8192 * 4);
  p.np = (float*)take((size_t)768 * 64 * 4);
  p.mp = (float*)take((size_t)768 * 4);
  p.xn = (u16*)take((size_t)NTOK * 1024 * 2);
  p.h = (u16*)take((size_t)NTOK * 2816 * 2);
  p.mix = (u16*)take((size_t)NTOK * 1024 * 2);
  p.qa = (u16*)take((size_t)NTOK * 512 * 2);
  p.ka = (u16*)take((size_t)NTOK * 512 * 2);
  p.kactx = (u16*)take((size_t)1024 * 512 * 2);
  p.vta_p = (u16*)take((size_t)16 * 8 * 64 * 256 * 2);
  p.vta_s = (u16*)take((size_t)2 * 8 * 64 * 1536 * 2);
  p.kb = (u16*)take((size_t)7168 * 768 * 2);
  p.vtb_p = (u16*)take((size_t)16 * 8 * 64 * 256 * 2);
  p.vtb_s = (u16*)take((size_t)2 * 8 * 64 * 1536 * 2);
  p.cqn = (u16*)take((size_t)NTOK * 768 * 2);
  p.ckvn = (u16*)take((size_t)NTOK * 256 * 2);
  p.cctxn = (u16*)take((size_t)1024 * 256 * 2);
  p.kd = (u16*)take((size_t)7168 * 128 * 2);
  p.vtd_p = (u16*)take((size_t)16 * 2 * 64 * 256 * 2);
  p.vtd_s = (u16*)take((size_t)2 * 2 * 64 * 1536 * 2);
  p.bar = (unsigned*)take((size_t)XCD_BAR_WORDS * 4);
  if (off > ws_size) { fprintf(stderr, "kernel_launch: workspace too small: need %zu have %zu\n", off, ws_size); return; }
  hipMemsetAsync(p.bar, 0, (size_t)XCD_BAR_WORDS * 4, stream);
#if MULTI
  for (int ph = 0; ph < NPHASE; ++ph) {
    p.ph0 = ph; p.ph1 = ph + 1;
    hipLaunchKernelGGL(mega, dim3(grid_blocks), dim3(512), 0, stream, p);
  }
#else
  p.ph0 = 0; p.ph1 = NPHASE;
  void* args[] = {&p};
  hipError_t e = hipLaunchCooperativeKernel((void*)mega, dim3(grid_blocks), dim3(512), args, 0, stream);
  if (e != hipSuccess) fprintf(stderr, "cooperative launch failed: %s (grid %d)\n", hipGetErrorString(e), grid_blocks);
#endif
}
```

```cpp
#include <hip/hip_runtime.h>
#include <hip/hip_cooperative_groups.h>
#include <cstdio>
#include <cstdint>
namespace cg = cooperative_groups;

#ifndef MULTI
#define MULTI 0
#endif

typedef unsigned short u16;
typedef __attribute__((ext_vector_type(8))) short bf16x8;
typedef __attribute__((ext_vector_type(4))) short s16x4;
typedef __attribute__((ext_vector_type(4))) float f32x4;
typedef __attribute__((ext_vector_type(4))) unsigned int u32x4;

#define NTOK 6144
#define NPR 4096
#define LDS_HALF 77824
#define LDS_BYTES (2 * LDS_HALF)
#define NPHASE 54
#define EPS 1e-6f

struct Params {
  const float *x_prompt, *x_sample, *cache_a_k, *cache_a_v, *cache_b_ckv, *cache_b_krope, *cache_d_k, *cache_d_v;
  const float *state_C, *state_n, *state_m, *c, *c_ctx, *w_mod, *b_mod, *norm_g, *ffn_in, *ffn_out;
  const float *w_in_even, *w_in_odd, *w_out, *a_rpb, *b_q_norm, *b_wq_up, *b_kv_norm, *b_wkv_up;
  const float *c_gate_bias, *c_out_norm, *d_q_norm, *d_k_norm, *final_norm;
  float* out;
  u16 *wt_ffn_in, *wt_ffn_out, *wt_in_e, *wt_in_o, *wt_out, *wt_qup, *wt_kvup;
  float *mod, *x, *proj, *qb, *dC, *dn, *dm, *cp, *np, *mp;
  u16 *xn, *h, *mix, *qa, *ka, *kactx, *vta_p, *vta_s, *kb, *vtb_p, *vtb_s, *cqn, *ckvn, *cctxn, *kd, *vtd_p, *vtd_s;
  unsigned* bar;
  int ph0, ph1;
};

typedef const __attribute__((address_space(4))) Params& PRM;
#define O_YP 0
#define O_YS 4194304
#define O_AK 6291456
#define O_AV 10485760
#define O_CKV 14680064
#define O_KR 16777216
#define O_DK 17039360
#define O_DV 18087936
#define O_CC 19136512
#define O_CN 21233664
#define O_CM 21250048

__device__ __forceinline__ int get_tid() { int t = threadIdx.x & 255; asm volatile("" : "+v"(t)); return t; }
__device__ __forceinline__ int rtid_raw() { int t = threadIdx.x; asm volatile("" : "+v"(t)); return t; }
__device__ __forceinline__ int get_bid() { int t = blockIdx.x * 2 + __builtin_amdgcn_readfirstlane(rtid_raw() >> 8); asm volatile("" : "+s"(t)); return t; }
__device__ __forceinline__ int vgrid() { return (int)gridDim.x * 2; }
__device__ __forceinline__ int rtid() { int t = threadIdx.x; asm volatile("" : "+v"(t)); return t; }
__device__ __forceinline__ int rbid() { int t = blockIdx.x; asm volatile("" : "+s"(t)); return t; }
typedef __attribute__((ext_vector_type(2))) __bf16 bf16x2_t;
typedef __attribute__((ext_vector_type(2))) float f32x2_t;
__device__ __forceinline__ unsigned pack2(float a, float b) {
  f32x2_t v = {a, b};
  bf16x2_t r = __builtin_convertvector(v, bf16x2_t);
  return __builtin_bit_cast(unsigned, r);
}
__device__ __forceinline__ u16 f2bf(float f) { return (u16)(pack2(f, 0.f) & 0xffffu); }
__device__ __forceinline__ float shx(float v, int m) {
  int l = __builtin_amdgcn_mbcnt_hi(-1, __builtin_amdgcn_mbcnt_lo(-1, 0));
  asm volatile("" : "+v"(l));
  return __int_as_float(__builtin_amdgcn_ds_bpermute((l ^ m) << 2, __float_as_int(v)));
}
__device__ __forceinline__ float wsum(float v) {
#pragma unroll
  for (int o = 32; o; o >>= 1) v += shx(v, o);
  return v;
}
__device__ __forceinline__ float wmaxr(float v) {
#pragma unroll
  for (int o = 32; o; o >>= 1) v = fmaxf(v, shx(v, o));
  return v;
}
__device__ __forceinline__ float silu_f(float x) { return x / (1.f + __expf(-x)); }
__device__ __forceinline__ float sigmoid_f(float x) { return 1.f / (1.f + __expf(-x)); }
__device__ __forceinline__ float logsig_f(float x) { return fminf(x, 0.f) - __logf(1.f + __expf(-fabsf(x))); }
__device__ __forceinline__ void sincos_r(float a, float& s, float& c) {
  float n = rintf(a * 0.15915494309f);
  float r = fmaf(-n, 6.2831855f, a);
  r = fmaf(-n, -1.7484555e-7f, r);
  s = __sinf(r); c = __cosf(r);
}
__device__ __forceinline__ int grp_of(int m) { return m < NPR ? 0 : 1 + ((m - NPR) >> 10); }
__device__ __forceinline__ int keyrow(int m) { return m < NPR ? m : NPR + ((m - NPR) >> 10) * 1536 + ((m - NPR) & 1023); }
__device__ __forceinline__ f32x4 mfma16(bf16x8 a, bf16x8 b, f32x4 c) { return __builtin_amdgcn_mfma_f32_16x16x32_bf16(a, b, c, 0, 0, 0); }

#define XB_TMO      128
#define XB_XCNT(j)  (256  + 64 * (j))
#define XB_XSUB(j)  (1280 + 64 * (j))
#define XB_XGEN(j)  (2304 + 64 * (j))
#define XB_TOP      3328
#define XB_TOPGEN   3392
#define XCD_BAR_WORDS 3456
#define XB_SPIN_CAP (1u << 18)
#define LAS __attribute__((address_space(3)))

__device__ __forceinline__ unsigned xb_ld(unsigned* p)              { return __hip_atomic_load(p, __ATOMIC_RELAXED, __HIP_MEMORY_SCOPE_AGENT); }
__device__ __forceinline__ unsigned xb_add(unsigned* p, unsigned v) { return __hip_atomic_fetch_add(p, v, __ATOMIC_RELAXED, __HIP_MEMORY_SCOPE_AGENT); }
__device__ __forceinline__ unsigned xb_xcc_id() { return (unsigned)__builtin_amdgcn_s_getreg((3 << 11) | 20) & 0xFu; }
#define XB_SPIN(cond, bar) do { unsigned _sp = 0; while (cond) { __builtin_amdgcn_s_sleep(1); \
    if ((++_sp & 255u) == 0u) { if (xb_ld(&(bar)[XB_TMO])) break; if (_sp > XB_SPIN_CAP) { atomicAdd(&(bar)[XB_TMO], 1u); break; } } } } while (0)

struct XcdBarrier {
    unsigned* bar; unsigned x;
    volatile LAS unsigned* st;
};

__device__ __forceinline__ XcdBarrier xcd_barrier_post(unsigned* bar, volatile LAS unsigned* st) {
    XcdBarrier b; b.bar = bar; b.x = xb_xcc_id(); b.st = st;
    if (threadIdx.x == 0) (void)xb_add(&bar[XB_XCNT(b.x)], 1u);
    return b;
}
__device__ __forceinline__ void xcd_barrier_complete(unsigned* bar, unsigned x, unsigned& nloc, unsigned& nx) {
    const unsigned G = gridDim.x * gridDim.y * gridDim.z;
    unsigned sum, cnt, mine, sp = 0u;
    for (;;) {
        sum = 0u; cnt = 0u; mine = 0u;
#pragma unroll
        for (unsigned j = 0; j < 16; ++j) { const unsigned c = xb_ld(&bar[XB_XCNT(j)]); sum += c; cnt += (c > 0u) ? 1u : 0u; mine = (j == x) ? c : mine; }
        if (sum == G) break;
        __builtin_amdgcn_s_sleep(1);
        if ((++sp & 255u) == 0u) { if (xb_ld(&bar[XB_TMO])) break; if (sp > XB_SPIN_CAP) { atomicAdd(&bar[XB_TMO], 1u); break; } }
    }
    nloc = mine > 0u ? mine : 1u; nx = cnt > 0u ? cnt : 1u;
}

__device__ __forceinline__ void xcd_barrier(const XcdBarrier& b) {
    asm volatile("s_waitcnt vmcnt(0)" ::: "memory");
    __syncthreads();
    if (threadIdx.x == 0) {
        unsigned* bar = b.bar;
        __builtin_amdgcn_s_waitcnt(0);
        unsigned nloc = b.st[0], nx = b.st[1];
        if (nloc == 0u) { xcd_barrier_complete(bar, b.x, nloc, nx); b.st[0] = nloc; b.st[1] = nx; }
        const unsigned old = xb_add(&bar[XB_XSUB(b.x)], 1u);
        const unsigned gen = old / nloc;
        if (old + 1u == (gen + 1u) * nloc) {
            __builtin_amdgcn_fence(__ATOMIC_RELEASE, "agent");
            asm volatile("s_waitcnt vmcnt(0)" ::: "memory");
            const unsigned og = xb_add(&bar[XB_TOP], 1u);
            const unsigned tg = og / nx;
            if (og + 1u == (tg + 1u) * nx) xb_add(&bar[XB_TOPGEN], 1u);
            else XB_SPIN(xb_ld(&bar[XB_TOPGEN]) == tg, bar);
            __builtin_amdgcn_fence(__ATOMIC_ACQUIRE, "agent");
            xb_add(&bar[XB_XGEN(b.x)], 1u);
            asm volatile("s_waitcnt vmcnt(0)" ::: "memory");
        } else {
            XB_SPIN(xb_ld(&bar[XB_XGEN(b.x)]) == gen, bar);
            __builtin_amdgcn_fence(__ATOMIC_ACQUIRE, "agent");
            asm volatile("s_waitcnt vmcnt(0)" ::: "memory");
        }
    }
    __syncthreads();
}


__device__ __forceinline__ void conv_tile(const float* __restrict__ src, int K, int N, int perm, u16* __restrict__ dst, int kt4, int nt, float* tile) {
  const int tid = get_tid();
  {
    const int c4 = tid & 15, kr = tid >> 4;
    const int n = nt * 64 + c4 * 4;
    const bool valid = n < N;
    int col = n;
    if (perm) { int G = n >> 4, w = n & 15, sub = w >> 2; col = ((sub & 1) ? 2816 : 0) + G * 8 + (sub >> 1) * 4 + (w & 3); }
    f32x4 v[16];
#pragma unroll
    for (int i = 0; i < 16; ++i) {
      int kk = kr + 16 * i;
      v[i] = valid ? *(const f32x4*)(src + (size_t)(kt4 * 256 + kk) * N + col) : (f32x4){0.f, 0.f, 0.f, 0.f};
    }
#pragma unroll
    for (int i = 0; i < 16; ++i) {
      int kk = kr + 16 * i;
      float* t = tile + (kk >> 6) * 4160 + (kk & 63) * 65 + c4 * 4;
      t[0] = v[i][0]; t[1] = v[i][1]; t[2] = v[i][2]; t[3] = v[i][3];
    }
  }
  __syncthreads();
  {
    const int k8 = (tid & 7) * 8;
#pragma unroll
    for (int hh = 0; hh < 4; ++hh)
#pragma unroll
      for (int i = 0; i < 2; ++i) {
        int nn2 = (tid >> 3) + 32 * i;
        float v[8];
#pragma unroll
        for (int e = 0; e < 8; ++e) v[e] = tile[hh * 4160 + (k8 + e) * 65 + nn2];
        uint4 o; o.x = pack2(v[0], v[1]); o.y = pack2(v[2], v[3]); o.z = pack2(v[4], v[5]); o.w = pack2(v[6], v[7]);
        *(uint4*)(dst + (size_t)(nt * 64 + nn2) * K + kt4 * 256 + hh * 64 + k8) = o;
      }
  }
  __syncthreads();
}

__device__ __forceinline__ void mod_task(PRM p, int t, float* sm) {
  const int l = t / 144, cb = t % 144, tid = get_tid();
  float* sc = sm;
  float* red = sm + 3072;
  for (int i = tid; i < 3072; i += 256) {
    int g = i >> 10, k = i & 1023;
    float v = g == 0 ? p.c_ctx[k] : p.c[(g - 1) * 1024 + k];
    sc[i] = silu_f(v);
  }
  __syncthreads();
  const int c4 = tid & 15, kg = tid >> 4;
  const float* w = p.w_mod + (size_t)l * 1024 * 9216 + (size_t)(kg * 64) * 9216 + cb * 64 + c4 * 4;
  float a[3][4];
#pragma unroll
  for (int g = 0; g < 3; ++g)
#pragma unroll
    for (int q = 0; q < 4; ++q) a[g][q] = 0.f;
  for (int k = 0; k < 64; k += 8) {
    float4 wv[8];
#pragma unroll
    for (int e = 0; e < 8; ++e) wv[e] = *(const float4*)(w + (size_t)(k + e) * 9216);
#pragma unroll
    for (int e = 0; e < 8; ++e) {
      int kk = kg * 64 + k + e;
#pragma unroll
      for (int g = 0; g < 3; ++g) {
        float sv = sc[g * 1024 + kk];
        a[g][0] = fmaf(sv, wv[e].x, a[g][0]); a[g][1] = fmaf(sv, wv[e].y, a[g][1]);
        a[g][2] = fmaf(sv, wv[e].z, a[g][2]); a[g][3] = fmaf(sv, wv[e].w, a[g][3]);
      }
    }
  }
#pragma unroll
  for (int g = 0; g < 3; ++g)
#pragma unroll
    for (int q = 0; q < 4; ++q) red[(kg * 3 + g) * 64 + c4 * 4 + q] = a[g][q];
  __syncthreads();
  if (tid < 192) {
    int g = tid >> 6, c2 = tid & 63;
    float s = 0.f;
#pragma unroll
    for (int q = 0; q < 16; ++q) s += red[(q * 3 + g) * 64 + c2];
    int j = cb * 64 + c2;
    p.mod[(size_t)(l * 3 + g) * 9216 + j] = s + p.b_mod[l * 9216 + j];
  }
  __syncthreads();
}

__device__ __forceinline__ int conv_layer_count(int l) { return (l & 1) ? 1272 : 1340; }
__device__ __forceinline__ void conv_layer_task(PRM p, int l, int u, float* sm) {
  const float* src; u16* dst; int K, N, Npad, perm = 0, tp, mat0;
  const int eo = l >> 1;
  const int nin = (l & 1) ? 152 : 168;
  if (u < 704) { K = 1024; N = 5632; Npad = 5632; perm = 1; tp = 352; src = p.ffn_in; dst = p.wt_ffn_in; mat0 = l * 2; }
  else if ((u -= 704) < 352) { K = 2816; N = 1024; Npad = 1024; tp = 176; src = p.ffn_out; dst = p.wt_ffn_out; mat0 = l * 2; }
  else if ((u -= 352) < nin) {
    if (l & 1) { K = 1024; N = 2320; Npad = 2432; tp = 152; src = p.w_in_odd; dst = p.wt_in_o; mat0 = eo; }
    else { K = 1024; N = 2592; Npad = 2688; tp = 168; src = p.w_in_even; dst = p.wt_in_e; mat0 = eo; }
  }
  else if ((u -= nin) < 64) { K = 1024; N = 1024; Npad = 1024; tp = 64; src = p.w_out; dst = p.wt_out; mat0 = l; }
  else if ((u -= 64) < 36) { K = 768; N = 768; Npad = 768; tp = 36; src = p.b_wq_up; dst = p.wt_qup; mat0 = eo; }
  else { u -= 36; K = 256; N = 1024; Npad = 1024; tp = 16; src = p.b_wkv_up; dst = p.wt_kvup; mat0 = eo; }
  int mat = mat0 + u / tp, r = u % tp;
  int nkt = K / 256;
  int kt = r % nkt, nt = r / nkt;
  conv_tile(src + (size_t)mat * K * N, K, N, perm, dst + (size_t)mat * Npad * K, kt, nt, sm);
}

__device__ __forceinline__ void phase0(PRM p, char* smem) {
  float* sm = (float*)smem;
  const int NMOD = 144, NCOPY = 0, NCONV = 1340;
  const int total = NMOD + NCOPY + NCONV;
  for (int t = get_bid(); t < total; t += vgrid()) {
    if (t < NMOD) { mod_task(p, t, sm); continue; }
    int u = t - NMOD;
    if (u < NCOPY) {
      const int tid = get_tid();
#pragma unroll
      for (int i = 0; i < 4; ++i) {
        size_t idx = ((size_t)u * 1024 + i * 256 + tid);
        const float4* src = idx < (size_t)NPR * 256 ? (const float4*)p.x_prompt + idx : (const float4*)p.x_sample + (idx - (size_t)NPR * 256);
        ((float4*)p.x)[idx] = *src;
      }
      continue;
    }
    conv_layer_task(p, 0, u - NCOPY, sm);
  }
}

__device__ __forceinline__ void norm_phase(PRM p, int l, int which) {
  const int lane = get_tid() & 63, wave = get_tid() >> 6;
  const int nrows_wave = NTOK / 4;
  const int stride = vgrid();
  for (int t0 = get_bid(); t0 < nrows_wave; t0 += 3 * stride) {
    float4 v[3][4];
    float ss[3];
#pragma unroll
    for (int k = 0; k < 3; ++k) {
      const int t = t0 + k * stride;
      if (t < nrows_wave) {
        const int mm = t * 4 + wave;
        const float* xsrc = (l == 0 && which == 0) ? (mm < NPR ? p.x_prompt + (size_t)mm * 1024 : p.x_sample + (size_t)(mm - NPR) * 1024) : p.x + (size_t)mm * 1024;
        const float4* xr = (const float4*)xsrc;
#pragma unroll
        for (int i = 0; i < 4; ++i) v[k][i] = xr[i * 64 + lane];
      }
    }
#pragma unroll
    for (int k = 0; k < 3; ++k) {
      float a = 0.f;
#pragma unroll
      for (int i = 0; i < 4; ++i) a += v[k][i].x * v[k][i].x + v[k][i].y * v[k][i].y + v[k][i].z * v[k][i].z + v[k][i].w * v[k][i].w;
      ss[k] = wsum(a);
    }
#pragma unroll
    for (int k = 0; k < 3; ++k) {
      const int t = t0 + k * stride;
      if (t >= nrows_wave) continue;
      const int m = t * 4 + wave;
      const float r = rsqrtf(ss[k] * (1.f / 1024.f) + EPS);
      if (which == 3) {
        float4* o = (float4*)(p.out + (size_t)m * 1024);
#pragma unroll
        for (int i = 0; i < 4; ++i) {
          float4 g = ((const float4*)p.final_norm)[i * 64 + lane];
          float4 y; y.x = v[k][i].x * r * g.x; y.y = v[k][i].y * r * g.y; y.z = v[k][i].z * r * g.z; y.w = v[k][i].w * r * g.w;
          o[i * 64 + lane] = y;
        }
      } else {
        const float* md = p.mod + (size_t)(l * 3 + grp_of(m)) * 9216 + which * 3072;
        const float4* sh = (const float4*)md;
        const float4* sc = (const float4*)(md + 1024);
        const float4* gg = (const float4*)(p.norm_g + (size_t)(l * 3 + which) * 1024);
#pragma unroll
        for (int i = 0; i < 4; ++i) {
          float4 g = gg[i * 64 + lane], s = sc[i * 64 + lane], b = sh[i * 64 + lane];
          float y0 = v[k][i].x * r * g.x * (1.f + s.x) + b.x;
          float y1 = v[k][i].y * r * g.y * (1.f + s.y) + b.y;
          float y2 = v[k][i].z * r * g.z * (1.f + s.z) + b.z;
          float y3 = v[k][i].w * r * g.w * (1.f + s.w) + b.w;
          uint2 o; o.x = pack2(y0, y1); o.y = pack2(y2, y3);
          *(uint2*)(p.xn + (size_t)m * 1024 + (i * 64 + lane) * 4) = o;
        }
      }
    }
  }
}

struct EpiP {
  float* C; int ldc;
  const float* gate;
  u16* H;
  u16 *kb, *vtp, *vts; int ctx;
};
enum { EPI_STORE = 0, EPI_RESID = 1, EPI_SWIGLU = 2, EPI_KVUP = 3 };

template <int FI, int FJ, bool SWAP>
__device__ __forceinline__ void g_compute(f32x4 (&acc)[FI][FJ], const u16* Ac, const u16* Bc, int q4, int rsw) {
  __builtin_amdgcn_s_setprio(1);
#pragma unroll
  for (int ks = 0; ks < 2; ++ks) {
    const int co = ((ks * 4 + q4) ^ rsw) << 3;
#pragma unroll
    for (int j0 = 0; j0 < FJ; j0 += 4) {
      bf16x8 b[4];
#pragma unroll
      for (int j = 0; j < 4; ++j) if (j0 + j < FJ) b[j] = *(const bf16x8*)(Bc + (j0 + j) * 1024 + co);
#pragma unroll
      for (int i0 = 0; i0 < FI; i0 += 4) {
        bf16x8 a[4];
#pragma unroll
        for (int i = 0; i < 4; ++i) if (i0 + i < FI) a[i] = *(const bf16x8*)(Ac + (i0 + i) * 1024 + co);
#pragma unroll
        for (int j = 0; j < 4; ++j)
          if (j0 + j < FJ) {
#pragma unroll
            for (int i = 0; i < 4; ++i)
              if (i0 + i < FI) acc[i0 + i][j0 + j] = SWAP ? mfma16(b[j], a[i], acc[i0 + i][j0 + j]) : mfma16(a[i], b[j], acc[i0 + i][j0 + j]);
          }
      }
    }
  }
  __builtin_amdgcn_s_setprio(0);
}

template <int EPI, int WMW, int WNW, int FI, int FJ, int DEPTH>
__device__ __forceinline__ void gemm_tile(const u16* __restrict__ A, const u16* __restrict__ Wt, int K, int tm, int tn, const EpiP& e, char* smem) {
  constexpr int BM = WMW * FI * 16, BN = WNW * FJ * 16;
  constexpr int NA = BM / 64, NB = BN / 64;
  constexpr int BUFSZ = (BM + BN) * 64;
  static_assert(WMW * WNW == 8 && BM % 64 == 0 && BN % 64 == 0, "tile");
  u16* As = (u16*)smem;
  u16* Bs = As + BM * 64;
  const int tid = rtid(), lane = tid & 63, wave = tid >> 6, wm = wave / WNW, wn = wave % WNW, l15 = lane & 15, q4 = lane >> 4;
  const int lr = tid >> 3, lc = tid & 7;
  const u16* Ag = A + (size_t)(tm * BM + lr) * K + lc * 8;
  const u16* Bg = Wt + (size_t)(tn * BN + lr) * K + lc * 8;
  const int st_off = lr * 64 + ((lc ^ ((lr >> 1) & 7)) << 3);
  const int rsw = (l15 >> 1) & 7;
  const int a_row = (wm * FI * 16 + l15) * 64, b_row = (wn * FJ * 16 + l15) * 64;
  f32x4 acc[FI][FJ];
#pragma unroll
  for (int i = 0; i < FI; ++i)
#pragma unroll
    for (int j = 0; j < FJ; ++j) acc[i][j] = (f32x4){0.f, 0.f, 0.f, 0.f};
  const int nk = K >> 6;
#define GL(RA, RB, KT) { _Pragma("unroll") for (int i = 0; i < NA; ++i) RA[i] = *(const u32x4*)(Ag + (size_t)i * 64 * K + (KT) * 64); \
                         _Pragma("unroll") for (int i = 0; i < NB; ++i) RB[i] = *(const u32x4*)(Bg + (size_t)i * 64 * K + (KT) * 64); }
#define GS(RA, RB, BUF) { _Pragma("unroll") for (int i = 0; i < NA; ++i) *(u32x4*)(As + (BUF) * BUFSZ + st_off + i * 4096) = RA[i]; \
                          _Pragma("unroll") for (int i = 0; i < NB; ++i) *(u32x4*)(Bs + (BUF) * BUFSZ + st_off + i * 4096) = RB[i]; }
  if constexpr (DEPTH == 4) {
    static_assert(WMW == 4 && WNW == 2 && FJ == 4 && (FI == 3 || FI == 4), "ring4 tile");
    constexpr int ST = (BM + BN) * 32;
    const int nk32 = K >> 5;
    const int fs = (-(tid >> 4)) & 3;
    const int sc = ((tid & 3) ^ fs) << 3;
    const int r4 = tid >> 2;
    const bool three = (BM == 256) || (tid < 256);
    const u16* sp0 = A + (size_t)(tm * BM + r4) * K + sc;
    const int lo0 = tid * 8;
    const u16* sp1; int lo1; const u16* sp2; int lo2;
    if (BM == 256) {
      sp1 = A + (size_t)(tm * BM + 128 + r4) * K + sc;  lo1 = (tid + 512) * 8;
      sp2 = Wt + (size_t)(tn * BN + r4) * K + sc;       lo2 = BM * 32 + tid * 8;
    } else if (tid < 256) {
      sp1 = A + (size_t)(tm * BM + 128 + r4) * K + sc;  lo1 = (tid + 512) * 8;
      sp2 = Wt + (size_t)(tn * BN + 64 + r4) * K + sc;  lo2 = BM * 32 + (tid + 256) * 8;
    } else {
      sp1 = Wt + (size_t)(tn * BN + (r4 - 64)) * K + sc; lo1 = BM * 32 + (tid - 256) * 8;
      sp2 = sp1; lo2 = lo1;
    }
    const int fr = (-(l15 >> 2)) & 3;
    const int co3 = (q4 ^ fr) << 3;
    const int a_row3 = (wm * FI * 16 + l15) * 32 + co3, b_row3 = BM * 32 + (wn * FJ * 16 + l15) * 32 + co3;
    const unsigned lbase = (unsigned)(size_t)As;
#define GD4(KT, BUF) { __builtin_amdgcn_global_load_lds((const unsigned*)(sp0 + (KT) * 32), (unsigned*)(As + (BUF) * ST + lo0), 16, 0, 0); \
                       __builtin_amdgcn_global_load_lds((const unsigned*)(sp1 + (KT) * 32), (unsigned*)(As + (BUF) * ST + lo1), 16, 0, 0); \
                       if (three) __builtin_amdgcn_global_load_lds((const unsigned*)(sp2 + (KT) * 32), (unsigned*)(As + (BUF) * ST + lo2), 16, 0, 0); }
    asm volatile("s_waitcnt vmcnt(0)" ::: "memory");
    GD4(0, 0);
    if (nk32 > 1) GD4(1, 1);
    if (nk32 > 2) GD4(2, 2);
#define RING4_STEP(J) { \
      const int kt = kt0 + (J); \
      if (kt + 2 < nk32) { if (three) asm volatile("s_waitcnt vmcnt(6)" ::: "memory"); else asm volatile("s_waitcnt vmcnt(4)" ::: "memory"); } \
      else if (kt + 1 < nk32) { if (three) asm volatile("s_waitcnt vmcnt(3)" ::: "memory"); else asm volatile("s_waitcnt vmcnt(2)" ::: "memory"); } \
      else asm volatile("s_waitcnt vmcnt(0)" ::: "memory"); \
      asm volatile("s_waitcnt lgkmcnt(0)" ::: "memory"); \
      __builtin_amdgcn_s_barrier(); \
      asm volatile("" ::: "memory"); \
      const unsigned aad = lbase + (unsigned)(((J) * ST + a_row3) * 2); \
      const unsigned bad = lbase + (unsigned)(((J) * ST + b_row3) * 2); \
      bf16x8 b0, b1, b2, b3, a0, a1, a2, a3; \
      asm volatile("ds_read_b128 %0, %1" : "=v"(b0) : "v"(bad)); \
      asm volatile("ds_read_b128 %0, %1 offset:1024" : "=v"(b1) : "v"(bad)); \
      asm volatile("ds_read_b128 %0, %1 offset:2048" : "=v"(b2) : "v"(bad)); \
      asm volatile("ds_read_b128 %0, %1 offset:3072" : "=v"(b3) : "v"(bad)); \
      asm volatile("ds_read_b128 %0, %1" : "=v"(a0) : "v"(aad)); \
      asm volatile("ds_read_b128 %0, %1 offset:1024" : "=v"(a1) : "v"(aad)); \
      asm volatile("ds_read_b128 %0, %1 offset:2048" : "=v"(a2) : "v"(aad)); \
      if (FI == 4) { asm volatile("ds_read_b128 %0, %1 offset:3072" : "=v"(a3) : "v"(aad)); \
        asm volatile("s_waitcnt lgkmcnt(0)" : "+v"(b0), "+v"(b1), "+v"(b2), "+v"(b3), "+v"(a0), "+v"(a1), "+v"(a2), "+v"(a3)); } \
      else { asm volatile("s_waitcnt lgkmcnt(0)" : "+v"(b0), "+v"(b1), "+v"(b2), "+v"(b3), "+v"(a0), "+v"(a1), "+v"(a2)); a3 = a2; } \
      __builtin_amdgcn_s_setprio(1); \
      { bf16x8 bb[4] = {b0, b1, b2, b3}; bf16x8 aa[4] = {a0, a1, a2, a3}; \
        _Pragma("unroll") for (int j = 0; j < 4; ++j) \
          _Pragma("unroll") for (int i = 0; i < FI; ++i) acc[i][j] = mfma16(bb[j], aa[i], acc[i][j]); } \
      __builtin_amdgcn_s_setprio(0); \
      if (kt + 3 < nk32) GD4(kt + 3, ((J) + 3) & 3);     \
      }
    for (int kt0 = 0; kt0 < nk32; kt0 += 4) {
      RING4_STEP(0) RING4_STEP(1) RING4_STEP(2) RING4_STEP(3)
    }
#undef RING4_STEP
#undef GD4
    __syncthreads();
  } else if constexpr (DEPTH == 3) {
    constexpr int ST = (BM + BN) * 32;
    constexpr int NA4 = BM * 4 / 512, NB4 = BN * 4 / 512;
    const int nk32 = K >> 5;
    const int fs = (-(tid >> 4)) & 3;
    const u16* Ad = A + (size_t)(tm * BM + (tid >> 2)) * K + (((tid & 3) ^ fs) << 3);
    const u16* Bd = Wt + (size_t)(tn * BN + (tid >> 2)) * K + (((tid & 3) ^ fs) << 3);
    u16* Al = As + tid * 8;
    u16* Bl = As + BM * 32 + tid * 8;
    const int fr = (-(l15 >> 2)) & 3;
    const int co3 = (q4 ^ fr) << 3;
    const int a_row3 = (wm * FI * 16 + l15) * 32 + co3, b_row3 = BM * 32 + (wn * FJ * 16 + l15) * 32 + co3;
    static_assert(FI == 8 && FJ == 4, "ring path is written for 8x4 fragments per wave");
    const unsigned lbase = (unsigned)(size_t)As;
#define GD3(KT, BUF) { _Pragma("unroll") for (int i = 0; i < NA4; ++i) __builtin_amdgcn_global_load_lds((const unsigned*)(Ad + (size_t)i * 128 * K + (KT) * 32), (unsigned*)(Al + (BUF) * ST + i * 4096), 16, 0, 0); \
                       _Pragma("unroll") for (int i = 0; i < NB4; ++i) __builtin_amdgcn_global_load_lds((const unsigned*)(Bd + (size_t)i * 128 * K + (KT) * 32), (unsigned*)(Bl + (BUF) * ST + i * 4096), 16, 0, 0); }
    asm volatile("s_waitcnt vmcnt(0)" ::: "memory");
    GD3(0, 0);
    if (nk32 > 1) GD3(1, 1);
    if (nk32 > 2) GD3(2, 2);
#define RING_STEP(J) { \
      const int kt = kt0 + (J); \
      if (kt + 2 < nk32) asm volatile("s_waitcnt vmcnt(%0)" :: "n"(2 * (NA4 + NB4)) : "memory"); \
      else if (kt + 1 < nk32) asm volatile("s_waitcnt vmcnt(%0)" :: "n"(NA4 + NB4) : "memory"); \
      else asm volatile("s_waitcnt vmcnt(0)" ::: "memory"); \
      asm volatile("s_waitcnt lgkmcnt(0)" ::: "memory"); \
      __builtin_amdgcn_s_barrier(); \
      asm volatile("" ::: "memory"); \
      const unsigned aad = lbase + (unsigned)(((J) * ST + a_row3) * 2); \
      const unsigned bad = lbase + (unsigned)(((J) * ST + b_row3) * 2); \
      bf16x8 b0, b1, b2, b3, a0, a1, a2, a3; \
      asm volatile("ds_read_b128 %0, %1" : "=v"(b0) : "v"(bad)); \
      asm volatile("ds_read_b128 %0, %1 offset:1024" : "=v"(b1) : "v"(bad)); \
      asm volatile("ds_read_b128 %0, %1 offset:2048" : "=v"(b2) : "v"(bad)); \
      asm volatile("ds_read_b128 %0, %1 offset:3072" : "=v"(b3) : "v"(bad)); \
      asm volatile("ds_read_b128 %0, %1" : "=v"(a0) : "v"(aad)); \
      asm volatile("ds_read_b128 %0, %1 offset:1024" : "=v"(a1) : "v"(aad)); \
      asm volatile("ds_read_b128 %0, %1 offset:2048" : "=v"(a2) : "v"(aad)); \
      asm volatile("ds_read_b128 %0, %1 offset:3072" : "=v"(a3) : "v"(aad)); \
      __builtin_amdgcn_s_setprio(1); \
      asm volatile("s_waitcnt lgkmcnt(3)" : "+v"(b0), "+v"(b1), "+v"(b2), "+v"(b3), "+v"(a0)); \
      acc[0][0] = mfma16(b0, a0, acc[0][0]); acc[0][1] = mfma16(b1, a0, acc[0][1]); acc[0][2] = mfma16(b2, a0, acc[0][2]); acc[0][3] = mfma16(b3, a0, acc[0][3]); \
      asm volatile("s_waitcnt lgkmcnt(2)" : "+v"(a1)); \
      acc[1][0] = mfma16(b0, a1, acc[1][0]); acc[1][1] = mfma16(b1, a1, acc[1][1]); acc[1][2] = mfma16(b2, a1, acc[1][2]); acc[1][3] = mfma16(b3, a1, acc[1][3]); \
      asm volatile("s_waitcnt lgkmcnt(1)" : "+v"(a2)); \
      acc[2][0] = mfma16(b0, a2, acc[2][0]); acc[2][1] = mfma16(b1, a2, acc[2][1]); acc[2][2] = mfma16(b2, a2, acc[2][2]); acc[2][3] = mfma16(b3, a2, acc[2][3]); \
      asm volatile("s_waitcnt lgkmcnt(0)" : "+v"(a3)); \
      acc[3][0] = mfma16(b0, a3, acc[3][0]); acc[3][1] = mfma16(b1, a3, acc[3][1]); acc[3][2] = mfma16(b2, a3, acc[3][2]); acc[3][3] = mfma16(b3, a3, acc[3][3]); \
      if (kt + 3 < nk32) GD3(kt + 3, ((J) + 3) & 3);     \
      asm volatile("ds_read_b128 %0, %1 offset:4096" : "=v"(a0) : "v"(aad)); \
      asm volatile("ds_read_b128 %0, %1 offset:5120" : "=v"(a1) : "v"(aad)); \
      asm volatile("ds_read_b128 %0, %1 offset:6144" : "=v"(a2) : "v"(aad)); \
      asm volatile("ds_read_b128 %0, %1 offset:7168" : "=v"(a3) : "v"(aad)); \
      asm volatile("s_waitcnt lgkmcnt(3)" : "+v"(a0), "+v"(b0), "+v"(b1), "+v"(b2), "+v"(b3)); \
      acc[4][0] = mfma16(b0, a0, acc[4][0]); acc[4][1] = mfma16(b1, a0, acc[4][1]); acc[4][2] = mfma16(b2, a0, acc[4][2]); acc[4][3] = mfma16(b3, a0, acc[4][3]); \
      asm volatile("s_waitcnt lgkmcnt(2)" : "+v"(a1)); \
      acc[5][0] = mfma16(b0, a1, acc[5][0]); acc[5][1] = mfma16(b1, a1, acc[5][1]); acc[5][2] = mfma16(b2, a1, acc[5][2]); acc[5][3] = mfma16(b3, a1, acc[5][3]); \
      asm volatile("s_waitcnt lgkmcnt(1)" : "+v"(a2)); \
      acc[6][0] = mfma16(b0, a2, acc[6][0]); acc[6][1] = mfma16(b1, a2, acc[6][1]); acc[6][2] = mfma16(b2, a2, acc[6][2]); acc[6][3] = mfma16(b3, a2, acc[6][3]); \
      asm volatile("s_waitcnt lgkmcnt(0)" : "+v"(a3)); \
      acc[7][0] = mfma16(b0, a3, acc[7][0]); acc[7][1] = mfma16(b1, a3, acc[7][1]); acc[7][2] = mfma16(b2, a3, acc[7][2]); acc[7][3] = mfma16(b3, a3, acc[7][3]); \
      __builtin_amdgcn_s_setprio(0); }
    for (int kt0 = 0; kt0 < nk32; kt0 += 4) {
      RING_STEP(0) RING_STEP(1) RING_STEP(2) RING_STEP(3)
    }
#undef RING_STEP
#undef GD3
    __syncthreads();
  } else if constexpr (DEPTH == 0) {
    const int swz = (lr >> 1) & 7;
    const u16* Ad = A + (size_t)(tm * BM + lr) * K + ((lc ^ swz) << 3);
    const u16* Bd = Wt + (size_t)(tn * BN + lr) * K + ((lc ^ swz) << 3);
    u16* Al = As + tid * 8;
    u16* Bl = Bs + tid * 8;
#define GD(KT, BUF) { _Pragma("unroll") for (int i = 0; i < NA; ++i) __builtin_amdgcn_global_load_lds((const unsigned*)(Ad + (size_t)i * 64 * K + (KT) * 64), (unsigned*)(Al + (BUF) * BUFSZ + i * 4096), 16, 0, 0); \
                      _Pragma("unroll") for (int i = 0; i < NB; ++i) __builtin_amdgcn_global_load_lds((const unsigned*)(Bd + (size_t)i * 64 * K + (KT) * 64), (unsigned*)(Bl + (BUF) * BUFSZ + i * 4096), 16, 0, 0); }
    GD(0, 0);
    asm volatile("s_waitcnt vmcnt(0)" ::: "memory");
    __syncthreads();
    for (int kt = 0; kt < nk; kt += 2) {
      if (kt + 1 < nk) GD(kt + 1, 1);
      g_compute<FI, FJ, (EPI != EPI_KVUP)>(acc, As + a_row, Bs + b_row, q4, rsw);
      asm volatile("s_waitcnt vmcnt(0)" ::: "memory");
      __syncthreads();
      if (kt + 1 >= nk) break;
      if (kt + 2 < nk) GD(kt + 2, 0);
      g_compute<FI, FJ, (EPI != EPI_KVUP)>(acc, As + BUFSZ + a_row, Bs + BUFSZ + b_row, q4, rsw);
      asm volatile("s_waitcnt vmcnt(0)" ::: "memory");
      __syncthreads();
    }
#undef GD
  } else if constexpr (DEPTH == 2) {
    u32x4 ra0[NA], rb0[NB], ra1[NA], rb1[NB];
    GL(ra0, rb0, 0);
    if (nk > 1) GL(ra1, rb1, 1);
    GS(ra0, rb0, 0);
    __syncthreads();
    for (int kt = 0; kt < nk; kt += 2) {
      if (kt + 2 < nk) GL(ra0, rb0, kt + 2);
      g_compute<FI, FJ, (EPI != EPI_KVUP)>(acc, As + a_row, Bs + b_row, q4, rsw);
      if (kt + 1 < nk) GS(ra1, rb1, 1);
      __syncthreads();
      if (kt + 1 >= nk) break;
      if (kt + 3 < nk) GL(ra1, rb1, kt + 3);
      g_compute<FI, FJ, (EPI != EPI_KVUP)>(acc, As + BUFSZ + a_row, Bs + BUFSZ + b_row, q4, rsw);
      if (kt + 2 < nk) GS(ra0, rb0, 0);
      __syncthreads();
    }
  } else {
    u32x4 ra0[NA], rb0[NB];
    GL(ra0, rb0, 0);
    GS(ra0, rb0, 0);
    __syncthreads();
    for (int kt = 0; kt < nk; kt += 2) {
      if (kt + 1 < nk) GL(ra0, rb0, kt + 1);
      g_compute<FI, FJ, (EPI != EPI_KVUP)>(acc, As + a_row, Bs + b_row, q4, rsw);
      if (kt + 1 < nk) GS(ra0, rb0, 1);
      __syncthreads();
      if (kt + 1 >= nk) break;
      if (kt + 2 < nk) GL(ra0, rb0, kt + 2);
      g_compute<FI, FJ, (EPI != EPI_KVUP)>(acc, As + BUFSZ + a_row, Bs + BUFSZ + b_row, q4, rsw);
      if (kt + 2 < nk) GS(ra0, rb0, 0);
      __syncthreads();
    }
  }
#undef GL
#undef GS
  const int mb = tm * BM + wm * FI * 16 + q4 * 4;
  const int nb = tn * BN + wn * FJ * 16;
  const int mrow = tm * BM + wm * FI * 16 + l15;
  if (EPI == EPI_STORE) {
#pragma unroll
    for (int i = 0; i < FI; ++i)
#pragma unroll
      for (int j = 0; j < FJ; ++j) *(f32x4*)(e.C + (size_t)(mrow + i * 16) * e.ldc + nb + j * 16 + q4 * 4) = acc[i][j];
  } else if (EPI == EPI_RESID) {
    const float cf = e.ldc ? 0.5f : 1.0f;
    const f32x4 cfv = {cf, cf, cf, cf};
#pragma unroll
    for (int i = 0; i < FI; ++i) {
      const int m = mrow + i * 16;
      const float* gt = e.gate + (size_t)grp_of(m) * 9216;
#pragma unroll
      for (int j = 0; j < FJ; ++j) {
        const int n = nb + j * 16 + q4 * 4;
        f32x4 g = *(const f32x4*)(gt + n);
        f32x4* px = (f32x4*)(e.C + (size_t)m * 1024 + n);
        f32x4 xv;
        if (e.vtp) xv = *(const f32x4*)((m < NPR ? (const float*)e.vtp + (size_t)m * 1024 : (const float*)e.vts + (size_t)(m - NPR) * 1024) + n);
        else xv = *px;
        xv += g * cfv * acc[i][j];
        *px = xv;
      }
    }
  } else if (EPI == EPI_SWIGLU) {
    const bool odd = (q4 & 1) != 0;
#pragma unroll
    for (int j = 0; j < FJ; ++j) {
      const int hj = ((nb >> 4) + j) * 8 + (q4 >> 1) * 4;
#pragma unroll
      for (int i2 = 0; i2 < FI / 2; ++i2) {
        float hv[4];
#pragma unroll
        for (int r = 0; r < 4; ++r) {
          float send = odd ? acc[2 * i2][j][r] : acc[2 * i2 + 1][j][r];
          float recv = shx(send, 16);
          float g = odd ? recv : acc[2 * i2][j][r];
          float u = odd ? acc[2 * i2 + 1][j][r] : recv;
          hv[r] = silu_f(g) * u;
        }
        const int m = mrow + (2 * i2 + (odd ? 1 : 0)) * 16;
        uint2 o; o.x = pack2(hv[0], hv[1]); o.y = pack2(hv[2], hv[3]);
        *(uint2*)(e.H + (size_t)m * 2816 + hj) = o;
      }
    }
  } else if (EPI == EPI_KVUP) {
#pragma unroll
    for (int j = 0; j < FJ; ++j) {
      const int n0 = nb + j * 16;
      const int hh = n0 >> 7, wb = n0 & 127;
#pragma unroll
      for (int i = 0; i < FI; ++i) {
        const int m0 = mb + i * 16;
        int krow; u16* vt;
        if (e.ctx) {
          int b = m0 >> 9, key = m0 & 511;
          krow = NPR + b * 1536 + 1024 + key;
          vt = e.vts + (size_t)((b * 8 + hh) * 64) * 1536 + 1024 + key;
        } else if (m0 < NPR) {
          int b = m0 >> 8, t = m0 & 255;
          krow = m0;
          vt = e.vtp + (size_t)((b * 8 + hh) * 64) * 256 + t;
        } else {
          int s = m0 - NPR, b = s >> 10, t = s & 1023;
          krow = NPR + b * 1536 + t;
          vt = e.vts + (size_t)((b * 8 + hh) * 64) * 1536 + t;
        }
        if (wb < 64) {
#pragma unroll
          for (int r = 0; r < 4; ++r) e.kb[(size_t)(krow + r) * 768 + hh * 96 + wb + l15] = f2bf(acc[i][j][r]);
        } else {
          const int d = wb - 64 + l15;
          const size_t L = (e.ctx || m0 >= NPR) ? 1536 : 256;
          uint2 o; o.x = pack2(acc[i][j][0], acc[i][j][1]); o.y = pack2(acc[i][j][2], acc[i][j][3]);
          *(uint2*)(vt + (size_t)d * L) = o;
        }
      }
    }
  }
}

template <int EPI, int WMW, int WNW, int FI, int FJ, int DEPTH>
__device__ __forceinline__ void gemm_phase(const u16* A, const u16* Wt, int K, int Mt, int Nt, const EpiP& e, char* smem) {
  for (int t = rbid(); t < Mt * Nt; t += (int)gridDim.x) gemm_tile<EPI, WMW, WNW, FI, FJ, DEPTH>(A, Wt, K, t % Mt, t / Mt, e, smem);
}

__device__ __forceinline__ void ffn_in_phase(PRM p, int l, int which, const EpiP& e, char* smem) {
  const u16* Wt = p.wt_ffn_in + (size_t)(l * 2 + which) * 5632 * 1024;
  const int G = (int)gridDim.x;
  const int nfull = (528 / G) * G;
  for (int t = rbid(); t < nfull; t += G) gemm_tile<EPI_SWIGLU, 2, 4, 8, 4, 3>(p.xn, Wt, 1024, t % 24, t / 24, e, smem);
  const int nq = (528 - nfull) * 4;
  const int bid = rbid();
  for (int u = bid; u < nq; u += G) {
    const int t = nfull + (u >> 2), sub = u & 3;
    gemm_tile<EPI_SWIGLU, 4, 2, 2, 4, 2>(p.xn, Wt, 1024, (t % 24) * 2 + (sub >> 1), (t / 24) * 2 + (sub & 1), e, smem);
  }
  const int tail = nq < G ? nq : G;
  if (l < 3 && bid >= tail) {
    const int vb = rtid() >> 8;
    char* vsm = smem + vb * LDS_HALF;
    const int nfree = (G - tail) * 2;
    const int vrank = (bid - tail) * 2 + vb;
    const int cnt = conv_layer_count(l + 1);
    const int half = cnt >> 1;
    const int lo = which ? half : 0, hi = which ? cnt : half;
    for (int c = lo + vrank; c < hi; c += nfree) conv_layer_task(p, l + 1, c, (float*)vsm);
    for (int c = vrank; c < 72; c += nfree) mod_task(p, (l + 1) * 144 + which * 72 + c, (float*)vsm);
  }
}

__device__ __forceinline__ void rope_store_kb(PRM p, float val, int lane, int t, bool sample, int krow) {
  float outv = val;
  if (sample) {
    float partner = shx(val, 8);
    int w = lane & 15, fi = w & 7;
    float pos = (float)((lane & 16) ? (t & 63) : (t >> 6));
    float fr = __expf(-9.210340372f * (float)fi * 0.125f);
    float s, c; sincos_r(pos * fr, s, c);
    outv = (w < 8) ? val * c - partner * s : val * c + partner * s;
  }
  if (lane < 32) {
    u16 b = f2bf(outv);
#pragma unroll
    for (int h = 0; h < 8; ++h) p.kb[(size_t)krow * 768 + h * 96 + 64 + lane] = b;
  }
}

__device__ __forceinline__ void post_even(PRM p, int e) {
  const int tid = get_tid(), lane = tid & 63, wave = tid >> 6;
  const int NT = NTOK / 4;
  const int NC = 256;
  for (int task = get_bid(); task < NT + NC; task += vgrid()) {
    if (task < NT) {
      const int m0 = task * 4, m = m0 + wave;
      const bool pr = m < NPR;
      const int b = pr ? (m >> 8) : ((m - NPR) >> 10);
      const int t = pr ? (m & 255) : ((m - NPR) & 1023);
      const float* row = p.proj + (size_t)m * 2688;
      {
        float4 a0 = *(const float4*)(row + lane * 8), a1 = *(const float4*)(row + lane * 8 + 4);
        uint4 o; o.x = pack2(a0.x, a0.y); o.y = pack2(a0.z, a0.w); o.z = pack2(a1.x, a1.y); o.w = pack2(a1.z, a1.w);
        *(uint4*)(p.qa + (size_t)m * 512 + lane * 8) = o;
        float4 k0 = *(const float4*)(row + 512 + lane * 8), k1 = *(const float4*)(row + 512 + lane * 8 + 4);
        o.x = pack2(k0.x, k0.y); o.y = pack2(k0.z, k0.w); o.z = pack2(k1.x, k1.y); o.w = pack2(k1.z, k1.w);
        *(uint4*)(p.ka + (size_t)m * 512 + lane * 8) = o;
        if (pr) {
          float* ok = p.out + O_AK + ((size_t)(b * 2 + e) * 256 + t) * 512 + lane * 8;
          *(float4*)ok = k0; *(float4*)(ok + 4) = k1;
          float4 v0 = *(const float4*)(row + 1024 + lane * 8), v1 = *(const float4*)(row + 1024 + lane * 8 + 4);
          float* ov = p.out + O_AV + ((size_t)(b * 2 + e) * 256 + t) * 512 + lane * 8;
          *(float4*)ov = v0; *(float4*)(ov + 4) = v1;
        }
      }
      {
        float4 c0 = *(const float4*)(row + 1536 + lane * 12), c1 = *(const float4*)(row + 1536 + lane * 12 + 4), c2 = *(const float4*)(row + 1536 + lane * 12 + 8);
        float ss = c0.x * c0.x + c0.y * c0.y + c0.z * c0.z + c0.w * c0.w + c1.x * c1.x + c1.y * c1.y + c1.z * c1.z + c1.w * c1.w +
                   c2.x * c2.x + c2.y * c2.y + c2.z * c2.z + c2.w * c2.w;
        ss = wsum(ss);
        float r = rsqrtf(ss * (1.f / 768.f) + EPS);
        const float* g = p.b_q_norm + e * 768 + lane * 12;
        float4 g0 = *(const float4*)g, g1 = *(const float4*)(g + 4), g2 = *(const float4*)(g + 8);
        uint2 o0, o1, o2;
        o0.x = pack2(c0.x * r * g0.x, c0.y * r * g0.y); o0.y = pack2(c0.z * r * g0.z, c0.w * r * g0.w);
        o1.x = pack2(c1.x * r * g1.x, c1.y * r * g1.y); o1.y = pack2(c1.z * r * g1.z, c1.w * r * g1.w);
        o2.x = pack2(c2.x * r * g2.x, c2.y * r * g2.y); o2.y = pack2(c2.z * r * g2.z, c2.w * r * g2.w);
        u16* d = p.cqn + (size_t)m * 768 + lane * 12;
        *(uint2*)d = o0; *(uint2*)(d + 4) = o1; *(uint2*)(d + 8) = o2;
      }
      {
        float4 c0 = *(const float4*)(row + 2304 + lane * 4);
        float ss = wsum(c0.x * c0.x + c0.y * c0.y + c0.z * c0.z + c0.w * c0.w);
        float r = rsqrtf(ss * (1.f / 256.f) + EPS);
        float4 g0 = *(const float4*)(p.b_kv_norm + e * 256 + lane * 4);
        float4 y; y.x = c0.x * r * g0.x; y.y = c0.y * r * g0.y; y.z = c0.z * r * g0.z; y.w = c0.w * r * g0.w;
        uint2 o; o.x = pack2(y.x, y.y); o.y = pack2(y.z, y.w);
        *(uint2*)(p.ckvn + (size_t)m * 256 + lane * 4) = o;
        if (pr) *(float4*)(p.out + O_CKV + ((size_t)(b * 2 + e) * 256 + t) * 256 + lane * 4) = y;
      }
      {
        float val = row[2560 + (lane & 31)];
        if (pr && lane < 32) p.out[O_KR + ((size_t)(b * 2 + e) * 256 + t) * 32 + lane] = val;
        rope_store_kb(p, val, lane, t, !pr, keyrow(m));
      }
      {
        const bool pr0 = m0 < NPR;
        const int b0 = pr0 ? (m0 >> 8) : ((m0 - NPR) >> 10);
        const int t0 = pr0 ? (m0 & 255) : ((m0 - NPR) & 1023);
#pragma unroll
        for (int i = 0; i < 2; ++i) {
          int pp = tid + 256 * i, h = pp >> 6, d = pp & 63;
          const float* src = p.proj + (size_t)m0 * 2688 + 1024 + h * 64 + d;
          float v0 = src[0], v1 = src[2688], v2 = src[2 * 2688], v3 = src[3 * 2688];
          uint2 o; o.x = pack2(v0, v1); o.y = pack2(v2, v3);
          u16* dst = pr0 ? p.vta_p + (size_t)((b0 * 8 + h) * 64 + d) * 256 + t0 : p.vta_s + (size_t)((b0 * 8 + h) * 64 + d) * 1536 + t0;
          *(uint2*)dst = o;
        }
      }
    } else {
      const int ct = task - NT;
      const int b = ct >> 7, key0 = (ct & 127) * 4;
      {
        const float* src = p.cache_a_k + ((size_t)(b * 2 + e) * 512 + key0) * 512;
        u16* dst = p.kactx + ((size_t)b * 512 + key0) * 512;
#pragma unroll
        for (int i = 0; i < 2; ++i) {
          int idx = (tid + 256 * i) * 4;
          float4 v = *(const float4*)(src + idx);
          uint2 o; o.x = pack2(v.x, v.y); o.y = pack2(v.z, v.w);
          *(uint2*)(dst + idx) = o;
        }
      }
      {
        const float* src = p.cache_a_v + ((size_t)(b * 2 + e) * 512 + key0) * 512;
#pragma unroll
        for (int i = 0; i < 2; ++i) {
          int pp = tid + 256 * i, h = pp >> 6, d = pp & 63;
          float v0 = src[pp], v1 = src[512 + pp], v2 = src[1024 + pp], v3 = src[1536 + pp];
          uint2 o; o.x = pack2(v0, v1); o.y = pack2(v2, v3);
          *(uint2*)(p.vta_s + (size_t)((b * 8 + h) * 64 + d) * 1536 + 1024 + key0) = o;
        }
      }
      {
        const float* src = p.cache_b_ckv + ((size_t)(b * 2 + e) * 512 + key0) * 256;
        float4 v = *(const float4*)(src + tid * 4);
        uint2 o; o.x = pack2(v.x, v.y); o.y = pack2(v.z, v.w);
        *(uint2*)(p.cctxn + ((size_t)b * 512 + key0) * 256 + tid * 4) = o;
      }
      {
        const float* src = p.cache_b_krope + ((size_t)(b * 2 + e) * 512 + key0) * 32;
#pragma unroll
        for (int i = 0; i < 4; ++i) {
          int idx = tid + 256 * i;
          int kk = idx >> 8, h = (idx >> 5) & 7, dd = idx & 31;
          p.kb[(size_t)(NPR + b * 1536 + 1024 + key0 + kk) * 768 + h * 96 + 64 + dd] = f2bf(src[kk * 32 + dd]);
        }
      }
    }
  }
}

__device__ __forceinline__ void post_odd(PRM p, int o) {
  const int tid = get_tid(), lane = tid & 63, wave = tid >> 6;
  const int NT = NTOK / 4, NC = 256;
  for (int task = get_bid(); task < NT + NC; task += vgrid()) {
    if (task < NT) {
      const int m0 = task * 4, m = m0 + wave;
      const bool pr = m < NPR;
      const int b = pr ? (m >> 8) : ((m - NPR) >> 10);
      const int t = pr ? (m & 255) : ((m - NPR) & 1023);
      const float* row = p.proj + (size_t)m * 2432;
      float rs = 0.f, rc = 1.f;
      if (!pr) {
        int w = lane & 31, fi = w & 15;
        float pos = (float)((lane & 32) ? (t & 63) : (t >> 6));
        float fr = __expf(-9.210340372f * (float)fi * (1.f / 16.f));
        sincos_r(pos * fr, rs, rc);
      }
      const bool lo = (lane & 16) == 0;
      const float gq = p.d_q_norm[o * 64 + lane], gk = p.d_k_norm[o * 64 + lane];
#pragma unroll
      for (int hd = 0; hd < 8; ++hd) {
        float v = row[1552 + hd * 64 + lane];
        float ss = wsum(v * v);
        float y = v * rsqrtf(ss * (1.f / 64.f) + EPS) * gq;
        if (!pr) { float pt = shx(y, 16); y = lo ? y * rc - pt * rs : y * rc + pt * rs; }
        p.qa[(size_t)m * 512 + hd * 64 + lane] = f2bf(y);
      }
#pragma unroll
      for (int kh = 0; kh < 2; ++kh) {
        float v = row[2064 + kh * 64 + lane];
        float ss = wsum(v * v);
        float y = v * rsqrtf(ss * (1.f / 64.f) + EPS) * gk;
        if (pr) p.out[O_DK + ((size_t)(b * 2 + o) * 256 + t) * 128 + kh * 64 + lane] = y;
        else { float pt = shx(y, 16); y = lo ? y * rc - pt * rs : y * rc + pt * rs; }
        p.kd[(size_t)keyrow(m) * 128 + kh * 64 + lane] = f2bf(y);
        if (pr) p.out[O_DV + ((size_t)(b * 2 + o) * 256 + t) * 128 + kh * 64 + lane] = row[2192 + kh * 64 + lane];
      }
      if (tid < 128) {
        const bool pr0 = m0 < NPR;
        const int b0 = pr0 ? (m0 >> 8) : ((m0 - NPR) >> 10);
        const int t0 = pr0 ? (m0 & 255) : ((m0 - NPR) & 1023);
        int kh = tid >> 6, d = tid & 63;
        const float* src = p.proj + (size_t)m0 * 2432 + 2192 + tid;
        float v0 = src[0], v1 = src[2432], v2 = src[2 * 2432], v3 = src[3 * 2432];
        uint2 oo; oo.x = pack2(v0, v1); oo.y = pack2(v2, v3);
        u16* dst = pr0 ? p.vtd_p + (size_t)((b0 * 2 + kh) * 64 + d) * 256 + t0 : p.vtd_s + (size_t)((b0 * 2 + kh) * 64 + d) * 1536 + t0;
        *(uint2*)dst = oo;
      }
    } else {
      const int ct = task - NT;
      const int b = ct >> 7, key0 = (ct & 127) * 4;
      {
        const float* src = p.cache_d_k + ((size_t)(b * 2 + o) * 512 + key0) * 128;
        if (tid < 128) {
          float4 v = *(const float4*)(src + tid * 4);
          uint2 oo; oo.x = pack2(v.x, v.y); oo.y = pack2(v.z, v.w);
          *(uint2*)(p.kd + (size_t)(NPR + b * 1536 + 1024 + key0) * 128 + tid * 4) = oo;
        } else {
          int pp = tid - 128, kh = pp >> 6, d = pp & 63;
          const float* sv = p.cache_d_v + ((size_t)(b * 2 + o) * 512 + key0) * 128;
          float v0 = sv[pp], v1 = sv[128 + pp], v2 = sv[256 + pp], v3 = sv[384 + pp];
          uint2 oo; oo.x = pack2(v0, v1); oo.y = pack2(v2, v3);
          *(uint2*)(p.vtd_s + (size_t)((b * 2 + kh) * 64 + d) * 1536 + 1024 + key0) = oo;
        }
      }
    }
  }
}

struct AttnSt { float m, l; f32x4 o[4]; };
template <int KS> struct KVf { bf16x8 k0[KS], k1[KS]; s16x4 v0[4], v1[4]; };

template <int KS>
__device__ __forceinline__ void attn_load(KVf<KS>& f, const u16* __restrict__ Kb, int kstride, const u16* __restrict__ Vtb, int vtstride, int l15, int q4) {
  const u16* k0p = Kb + (size_t)l15 * kstride + q4 * 8;
  const u16* k1p = k0p + (size_t)16 * kstride;
#pragma unroll
  for (int ks = 0; ks < KS; ++ks) { f.k0[ks] = *(const bf16x8*)(k0p + ks * 32); f.k1[ks] = *(const bf16x8*)(k1p + ks * 32); }
#pragma unroll
  for (int dt = 0; dt < 4; ++dt) {
    const u16* vp = Vtb + (size_t)(dt * 16 + l15) * vtstride + q4 * 4;
    f.v0[dt] = *(const s16x4*)vp; f.v1[dt] = *(const s16x4*)(vp + 16);
  }
}

template <int KS>
__device__ __forceinline__ void attn_comp(AttnSt& st, const bf16x8 (&qf)[KS], const KVf<KS>& f, float scale, int q4,
                                          bool masked, const float* rpbrow, int qc, int kc0) {
  f32x4 s0 = {0.f, 0.f, 0.f, 0.f}, s1 = {0.f, 0.f, 0.f, 0.f};
#pragma unroll
  for (int ks = 0; ks < KS; ++ks) { s0 = mfma16(f.k0[ks], qf[ks], s0); s1 = mfma16(f.k1[ks], qf[ks], s1); }
  float sv[8];
#pragma unroll
  for (int j = 0; j < 4; ++j) { sv[j] = s0[j] * scale; sv[4 + j] = s1[j] * scale; }
  if (masked) {
    const int cs = min(max(qc - 8, 0), 48);
#pragma unroll
    for (int e = 0; e < 8; ++e) {
      int kc = kc0 + (e >> 2) * 16 + q4 * 4 + (e & 3);
      bool ok = (kc >= cs) && (kc < cs + 16);
      int di = min(max(kc - qc, -15), 15) + 15;
      sv[e] = ok ? sv[e] + rpbrow[di] : -INFINITY;
    }
  }
  float mx = sv[0];
#pragma unroll
  for (int e = 1; e < 8; ++e) mx = fmaxf(mx, sv[e]);
  mx = fmaxf(mx, shx(mx, 16));
  mx = fmaxf(mx, shx(mx, 32));
  const float mnew = fmaxf(st.m, mx);
  const float alpha = __expf(st.m - mnew);
  float pe[8], ls = 0.f;
#pragma unroll
  for (int e = 0; e < 8; ++e) { pe[e] = __expf(sv[e] - mnew); ls += pe[e]; }
  st.l = st.l * alpha + ls;
  st.m = mnew;
  bf16x8 pf;
#pragma unroll
  for (int e = 0; e < 8; ++e) pf[e] = (short)f2bf(pe[e]);
#pragma unroll
  for (int dt = 0; dt < 4; ++dt) {
    bf16x8 vf = (bf16x8){f.v0[dt].x, f.v0[dt].y, f.v0[dt].z, f.v0[dt].w, f.v1[dt].x, f.v1[dt].y, f.v1[dt].z, f.v1[dt].w};
    st.o[dt] *= alpha;
    st.o[dt] = mfma16(vf, pf, st.o[dt]);
  }
}

__device__ __forceinline__ void attn_init(AttnSt& st) {
  st.m = -1e30f; st.l = 0.f;
#pragma unroll
  for (int dt = 0; dt < 4; ++dt) st.o[dt] = (f32x4){0.f, 0.f, 0.f, 0.f};
}
__device__ __forceinline__ void attn_fin(AttnSt& st, u16* outp  , int l15, int q4) {
  float lt = st.l;
  lt += shx(lt, 16);
  lt += shx(lt, 32);
  const float inv = 1.f / lt;
#pragma unroll
  for (int dt = 0; dt < 4; ++dt) {
    uint2 o; o.x = pack2(st.o[dt][0] * inv, st.o[dt][1] * inv); o.y = pack2(st.o[dt][2] * inv, st.o[dt][3] * inv);
    *(uint2*)(outp + (size_t)l15 * 1024 + dt * 16 + q4 * 4) = o;
  }
}

#define AT_VSTR 72
template <int KS> struct ATile { static constexpr int KSTR = KS * 32 + 8; static constexpr int BUF = 64 * (KS * 32 + 8) + 64 * AT_VSTR; };
template <int KS> struct AStage { u32x4 k[KS]; u32x4 v[2]; };

template <int KS>
__device__ __forceinline__ void at_load(AStage<KS>& r, const u16* __restrict__ Kg, int kstride, const u16* __restrict__ Vg, int vtstride, int tid) {
#pragma unroll
  for (int i = 0; i < KS; ++i) {
    int c = tid + 256 * i; int row = c / (KS * 4), ch = c - row * (KS * 4);
    r.k[i] = *(const u32x4*)(Kg + (unsigned)(row * kstride + ch * 8));
  }
#pragma unroll
  for (int i = 0; i < 2; ++i) {
    int c = tid + 256 * i; int row = c >> 3, ch = c & 7;
    r.v[i] = *(const u32x4*)(Vg + (unsigned)(row * vtstride + ch * 8));
  }
}
template <int KS>
__device__ __forceinline__ void at_store(const AStage<KS>& r, u16* buf, int tid) {
  u16* Ks = buf; u16* Vs = buf + 64 * ATile<KS>::KSTR;
#pragma unroll
  for (int i = 0; i < KS; ++i) {
    int c = tid + 256 * i; int row = c / (KS * 4), ch = c - row * (KS * 4);
    *(u32x4*)(Ks + row * ATile<KS>::KSTR + ch * 8) = r.k[i];
  }
#pragma unroll
  for (int i = 0; i < 2; ++i) {
    int c = tid + 256 * i; int row = c >> 3, ch = c & 7;
    *(u32x4*)(Vs + row * AT_VSTR + ch * 8) = r.v[i];
  }
}

template <int KS>
__device__ __forceinline__ void at_comp(AttnSt& st, const bf16x8 (&qf)[KS], const u16* buf, float scale, int l15, int q4,
                                        bool masked, const float* rpbrow, int qc) {
  const u16* Ks = buf; const u16* Vs = buf + 64 * ATile<KS>::KSTR;
  f32x4 s[4];
#pragma unroll
  for (int kt = 0; kt < 4; ++kt) {
    s[kt] = (f32x4){0.f, 0.f, 0.f, 0.f};
#pragma unroll
    for (int ks = 0; ks < KS; ++ks) {
      bf16x8 a = *(const bf16x8*)(Ks + (kt * 16 + l15) * ATile<KS>::KSTR + ks * 32 + q4 * 8);
      s[kt] = mfma16(a, qf[ks], s[kt]);
    }
  }
  float sv[16];
  const float sc2 = scale * 1.4426950408889634f;
#pragma unroll
  for (int kt = 0; kt < 4; ++kt)
#pragma unroll
    for (int j = 0; j < 4; ++j) sv[kt * 4 + j] = s[kt][j] * sc2;
  if (masked) {
    const int cs = min(max(qc - 8, 0), 48);
#pragma unroll
    for (int e = 0; e < 16; ++e) {
      int kc = (e >> 2) * 16 + q4 * 4 + (e & 3);
      bool ok = (kc >= cs) && (kc < cs + 16);
      int di = min(max(kc - qc, -15), 15) + 15;
      sv[e] = ok ? sv[e] + rpbrow[di] : -INFINITY;
    }
  }
  float mx = sv[0];
#pragma unroll
  for (int e = 1; e < 16; ++e) mx = fmaxf(mx, sv[e]);
  mx = fmaxf(mx, shx(mx, 16));
  mx = fmaxf(mx, shx(mx, 32));
  const float mnew = fmaxf(st.m, mx);
  const float alpha = __builtin_amdgcn_exp2f(st.m - mnew);
  float ls = 0.f;
#pragma unroll
  for (int e = 0; e < 16; ++e) { sv[e] = __builtin_amdgcn_exp2f(sv[e] - mnew); ls += sv[e]; }
  st.l = st.l * alpha + ls;
  st.m = mnew;
  bf16x8 pf[2];
#pragma unroll
  for (int hf = 0; hf < 2; ++hf) {
    u32x4 pw;
    pw[0] = pack2(sv[hf * 8 + 0], sv[hf * 8 + 1]); pw[1] = pack2(sv[hf * 8 + 2], sv[hf * 8 + 3]);
    pw[2] = pack2(sv[hf * 8 + 4], sv[hf * 8 + 5]); pw[3] = pack2(sv[hf * 8 + 6], sv[hf * 8 + 7]);
    pf[hf] = __builtin_bit_cast(bf16x8, pw);
  }
#pragma unroll
  for (int dt = 0; dt < 4; ++dt) {
    st.o[dt] *= alpha;
#pragma unroll
    for (int hf = 0; hf < 2; ++hf) {
      const u16* vp = Vs + (dt * 16 + l15) * AT_VSTR + hf * 32 + q4 * 4;
      s16x4 v0 = *(const s16x4*)vp;
      s16x4 v1 = *(const s16x4*)(vp + 16);
      bf16x8 vf = (bf16x8){v0.x, v0.y, v0.z, v0.w, v1.x, v1.y, v1.z, v1.w};
      st.o[dt] = mfma16(vf, pf[hf], st.o[dt]);
    }
  }
}

template <int KS>
__device__ __forceinline__ void at_run_plain(AttnSt& st, const bf16x8 (&qf)[KS], const u16* Kbase, int kstride, const u16* Vbase, int vtstride,
                                             int nt, float scale, u16* lds, int tid, int l15, int q4) {
  AStage<KS> r0, r1;
  at_load<KS>(r0, Kbase, kstride, Vbase, vtstride, tid);
  if (nt > 1) at_load<KS>(r1, Kbase + (size_t)64 * kstride, kstride, Vbase + 64, vtstride, tid);
  at_store<KS>(r0, lds, tid);
  __syncthreads();
  for (int t = 0; t < nt; t += 2) {
    if (t + 2 < nt) at_load<KS>(r0, Kbase + (size_t)(t + 2) * 64 * kstride, kstride, Vbase + (t + 2) * 64, vtstride, tid);
    at_comp<KS>(st, qf, lds, scale, l15, q4, false, nullptr, 0);
    if (t + 1 < nt) at_store<KS>(r1, lds + ATile<KS>::BUF, tid);
    __syncthreads();
    if (t + 1 >= nt) break;
    if (t + 3 < nt) at_load<KS>(r1, Kbase + (size_t)(t + 3) * 64 * kstride, kstride, Vbase + (t + 3) * 64, vtstride, tid);
    at_comp<KS>(st, qf, lds + ATile<KS>::BUF, scale, l15, q4, false, nullptr, 0);
    if (t + 2 < nt) at_store<KS>(r0, lds, tid);
    __syncthreads();
  }
}

__device__ __forceinline__ void load_q64(bf16x8 (&qf)[2], const u16* Q, int qstride, int l15, int q4) {
#pragma unroll
  for (int ks = 0; ks < 2; ++ks) qf[ks] = *(const bf16x8*)(Q + (size_t)l15 * qstride + ks * 32 + q4 * 8);
}
__device__ __forceinline__ void load_q_mla(bf16x8 (&qf)[3], const float* Qf, int l15, int q4, bool sample, int t0) {
  const float* qr = Qf + (size_t)l15 * 768 + q4 * 8;
#pragma unroll
  for (int ks = 0; ks < 3; ++ks) {
    float4 a = *(const float4*)(qr + ks * 32), b = *(const float4*)(qr + ks * 32 + 4);
    float v[8] = {a.x, a.y, a.z, a.w, b.x, b.y, b.z, b.w};
    if (ks == 2 && sample) {
      const int t = t0 + l15;
      const float pos = (float)((q4 & 2) ? (t & 63) : (t >> 6));
#pragma unroll
      for (int jj = 0; jj < 8; ++jj) {
        float pt = shx(v[jj], 16);
        float fr = __expf(-9.210340372f * (float)jj * 0.125f);
        float sn, cs; sincos_r(pos * fr, sn, cs);
        v[jj] = (q4 & 1) ? v[jj] * cs + pt * sn : v[jj] * cs - pt * sn;
      }
    }
#pragma unroll
    for (int jj = 0; jj < 8; ++jj) qf[ks][jj] = (short)f2bf(v[jj]);
  }
}

__device__ __forceinline__ void attn_even_phase(PRM p, int e, char* smem) {
  u16* lds = (u16*)smem;
  const int tid = get_tid(), lane = tid & 63, wave = tid >> 6, l15 = lane & 15, q4 = lane >> 4;
  const float scaleB = 0.10206207261596577f;
  for (int bt = get_bid(); bt < 1536; bt += vgrid()) {
    AttnSt st; attn_init(st);
    if (bt < 256) {
      int qb = bt & 15, h = (bt >> 4) & 7, b = bt >> 7;
      int mq = NPR + b * 1024 + qb * 64 + wave * 16;
      bf16x8 qf[3]; load_q_mla(qf, p.qb + (size_t)mq * 768 + h * 96, l15, q4, true, qb * 64 + wave * 16);
      at_run_plain<3>(st, qf, p.kb + (size_t)(NPR + b * 1536) * 768 + h * 96, 768, p.vtb_s + (size_t)((b * 8 + h) * 64) * 1536, 1536, 24, scaleB, lds, tid, l15, q4);
      attn_fin(st, p.mix + (size_t)mq * 1024 + 512 + h * 64, l15, q4);
    } else if (bt < 512) {
      int u = bt - 256;
      int r = u & 15, h = (u >> 4) & 7, b = u >> 7;
      int mq = NPR + b * 1024 + r * 64 + wave * 16;
      bf16x8 qf[2]; load_q64(qf, p.qa + (size_t)mq * 512 + h * 64, 512, l15, q4);
      const u16* Vt = p.vta_s + (size_t)((b * 8 + h) * 64) * 1536;
      const u16* Kc = p.kactx + (size_t)b * 512 * 512 + h * 64;
      const int rs = min(max(r - 4, 0), 8);
      const u16* Kw = p.ka + (size_t)(NPR + b * 1024 + rs * 64) * 512 + h * 64;
      const float* rpb0 = p.a_rpb + ((size_t)(e * 8 + h) * 15 + (rs - r + 7)) * 31;
      const int qc = wave * 16 + l15;
      float* rpl = (float*)(lds + 2 * ATile<2>::BUF);
      if (tid < 248) { int rr = tid / 31, cc = tid - rr * 31; rpl[rr * 32 + cc] = rpb0[rr * 31 + cc] * 1.4426950408889634f; }
      AStage<2> r0, r1;
#define NB_LOAD(R, T) { if ((T) < 8) at_load<2>(R, Kc + (size_t)(T) * 64 * 512, 512, Vt + 1024 + (T) * 64, 1536, tid); \
                        else at_load<2>(R, Kw + (size_t)((T) - 8) * 64 * 512, 512, Vt + (rs + (T) - 8) * 64, 1536, tid); }
#define NB_COMP(BUFP, T) { if ((T) < 8) at_comp<2>(st, qf, BUFP, 0.125f, l15, q4, false, nullptr, 0); \
                           else at_comp<2>(st, qf, BUFP, 0.125f, l15, q4, true, rpl + ((T) - 8) * 32, qc); }
      NB_LOAD(r0, 0);
      NB_LOAD(r1, 1);
      at_store<2>(r0, lds, tid);
      __syncthreads();
      for (int t = 0; t < 16; t += 2) {
        if (t + 2 < 16) NB_LOAD(r0, t + 2);
        NB_COMP(lds, t);
        at_store<2>(r1, lds + ATile<2>::BUF, tid);
        __syncthreads();
        if (t + 3 < 16) NB_LOAD(r1, t + 3);
        NB_COMP(lds + ATile<2>::BUF, t + 1);
        if (t + 2 < 16) at_store<2>(r0, lds, tid);
        __syncthreads();
      }
#undef NB_LOAD
#undef NB_COMP
      attn_fin(st, p.mix + (size_t)mq * 1024 + h * 64, l15, q4);
    } else if (bt < 1024) {
      int u = bt - 512;
      int qb = u & 3, h = (u >> 2) & 7, b = u >> 5;
      int mq = b * 256 + qb * 64 + wave * 16;
      bf16x8 qf[3]; load_q_mla(qf, p.qb + (size_t)mq * 768 + h * 96, l15, q4, false, 0);
      at_run_plain<3>(st, qf, p.kb + (size_t)(b * 256) * 768 + h * 96, 768, p.vtb_p + (size_t)((b * 8 + h) * 64) * 256, 256, 4, scaleB, lds, tid, l15, q4);
      attn_fin(st, p.mix + (size_t)mq * 1024 + 512 + h * 64, l15, q4);
    } else {
      int u = bt - 1024;
      int qb = u & 3, h = (u >> 2) & 7, b = u >> 5;
      int mq = b * 256 + qb * 64 + wave * 16;
      bf16x8 qf[2]; load_q64(qf, p.qa + (size_t)mq * 512 + h * 64, 512, l15, q4);
      at_run_plain<2>(st, qf, p.ka + (size_t)(b * 256) * 512 + h * 64, 512, p.vta_p + (size_t)((b * 8 + h) * 64) * 256, 256, 4, 0.125f, lds, tid, l15, q4);
      attn_fin(st, p.mix + (size_t)mq * 1024 + h * 64, l15, q4);
    }
  }
}

__device__ __forceinline__ int mslot(int sq, int h, int dir, int j) {
  return sq < 16 ? ((sq * 4 + h) * 2 + dir) * 4 + j : 512 + (((sq - 16) * 4 + h) * 2 + dir) * 16 + j;
}

__device__ __forceinline__ void mlstm1_task(PRM p, int o, int task, float* sm) {
  const int tid = get_tid(), lane = tid & 63, wave = tid >> 6;
  int sq, h, dir, j;
  if (task < 512) { j = task & 3; dir = (task >> 2) & 1; h = (task >> 3) & 3; sq = task >> 5; }
  else { int u = task - 512; j = u & 15; dir = (u >> 4) & 1; h = (u >> 5) & 3; sq = 16 + (u >> 7); }
  const int T = sq < 16 ? 256 : 1024;
  const int base = sq < 16 ? sq * 256 : NPR + (sq - 16) * 1024;
  const int slot = task;
  float* ks = sm;
  float* vs = sm + 4096;
  float* wg = sm + 4096 + 8192;
  if (wave == 0) {
    int s = 64 * j + lane;
    int t = dir ? T - 1 - s : s;
    const float* row = p.proj + (size_t)(base + t) * 2432 + 1536;
    float ig = row[(dir * 2 + 0) * 4 + h] + p.c_gate_bias[o * 16 + (dir * 2 + 0) * 4 + h];
    float fg = row[(dir * 2 + 1) * 4 + h] + p.c_gate_bias[o * 16 + (dir * 2 + 1) * 4 + h];
    float bsum = logsig_f(fg);
#pragma unroll
    for (int off = 1; off < 64; off <<= 1) { float v = __shfl_up(bsum, off); if (lane >= off) bsum += v; }
    float blast = __shfl(bsum, 63);
    float g = blast - bsum + ig;
    float ml = wmaxr(g);
    wg[lane] = __expf(g - ml);
    if (lane == 0) { p.dm[slot * 2] = ml; p.dm[slot * 2 + 1] = blast; }
  }
#pragma unroll
  for (int ii = 0; ii < 4; ++ii) {
    int i = (tid >> 4) + 16 * ii, c4 = tid & 15;
    int s = 64 * j + i; int t = dir ? T - 1 - s : s;
    float4 v = *(const float4*)(p.proj + (size_t)(base + t) * 2432 + 256 + h * 64 + c4 * 4);
    v.x *= 0.125f; v.y *= 0.125f; v.z *= 0.125f; v.w *= 0.125f;
    *(float4*)(ks + i * 64 + c4 * 4) = v;
  }
#pragma unroll
  for (int ii = 0; ii < 8; ++ii) {
    int i = (tid >> 5) + 8 * ii, c4 = tid & 31;
    int s = 64 * j + i; int t = dir ? T - 1 - s : s;
    *(float4*)(vs + i * 128 + c4 * 4) = *(const float4*)(p.proj + (size_t)(base + t) * 2432 + 512 + h * 128 + c4 * 4);
  }
  __syncthreads();
  const int dg = tid & 15, vg8 = tid >> 4;
  f32x4 acc[8];
#pragma unroll
  for (int q = 0; q < 8; ++q) acc[q] = (f32x4){0.f, 0.f, 0.f, 0.f};
  f32x4 nacc = {0.f, 0.f, 0.f, 0.f};
#pragma unroll 4
  for (int i = 0; i < 64; ++i) {
    f32x4 kd = *(const f32x4*)(ks + i * 64 + dg * 4) * wg[i];
    nacc += kd;
    f32x4 va = *(const f32x4*)(vs + i * 128 + vg8 * 8);
    f32x4 vb = *(const f32x4*)(vs + i * 128 + vg8 * 8 + 4);
    acc[0] += kd * va[0]; acc[1] += kd * va[1]; acc[2] += kd * va[2]; acc[3] += kd * va[3];
    acc[4] += kd * vb[0]; acc[5] += kd * vb[1]; acc[6] += kd * vb[2]; acc[7] += kd * vb[3];
  }
  float* dc = p.dC + (size_t)slot * 8192;
#pragma unroll
  for (int q = 0; q < 8; ++q) *(f32x4*)(dc + (vg8 * 8 + q) * 64 + dg * 4) = acc[q];
  if (vg8 == 0) *(f32x4*)(p.dn + slot * 64 + dg * 4) = nacc;
  __syncthreads();
}

__device__ __forceinline__ void mlstm2_task(PRM p, int o, int task, float* sm) {
  const int tid = get_tid(), lane = tid & 63, wave = tid >> 6;
  int sq, h, c;
  if (task < 256) { c = task & 3; h = (task >> 2) & 3; sq = task >> 4; }
  else { int u = task - 256; c = u & 15; h = (u >> 4) & 3; sq = 16 + (u >> 6); }
  const bool pr = sq < 16;
  const int nc = pr ? 4 : 16;
  const int base = (pr ? sq * 256 : NPR + (sq - 16) * 1024) + c * 64;
  float* qT = sm;
  float* kT = sm + 4352;
  float* CT = kT;
  float* St = sm + 2 * 4352;
  float* vh = sm + 3 * 4352;
  float* smalls = sm + 4 * 4352;
  float* bl = smalls;
  float* itb = smalls + 64;
  float* mt = smalls + 128;
  float* w0 = smalls + 192;
  float* nv = smalls + 256;
  float* nq = smalls + 320;
  float* den = smalls + 384;
  float* scal = smalls + 448;

  const int tl = tid >> 4, tx = tid & 15;
  const int l0 = tl * 4, x0 = tx * 4;
  float hacc[2][4][4];
#pragma unroll
  for (int a = 0; a < 2; ++a)
#pragma unroll
    for (int b2 = 0; b2 < 4; ++b2)
#pragma unroll
      for (int c2 = 0; c2 < 4; ++c2) hacc[a][b2][c2] = 0.f;

  f32x4 qv[4], kv[4];
#pragma unroll
  for (int ii = 0; ii < 4; ++ii) {
    int i = (tid >> 4) + 16 * ii, c4 = tid & 15;
    const float* row = p.proj + (size_t)(base + i) * 2432 + h * 64 + c4 * 4;
    qv[ii] = *(const f32x4*)row;
    kv[ii] = *(const f32x4*)(row + 256);
  }
#pragma unroll
  for (int ii = 0; ii < 4; ++ii) {
    int i = (tid >> 4) + 16 * ii, c4 = tid & 15;
    qT[(c4 * 4 + 0) * 68 + i] = qv[ii].x; qT[(c4 * 4 + 1) * 68 + i] = qv[ii].y; qT[(c4 * 4 + 2) * 68 + i] = qv[ii].z; qT[(c4 * 4 + 3) * 68 + i] = qv[ii].w;
  }
#pragma unroll 1
  for (int dir = 0; dir < 2; ++dir) {
    const int j = dir ? nc - 1 - c : c;
    const int slj = mslot(sq, h, dir, j);
    const float mprev = p.mp[slj];
    float cr[16]; f32x4 vr[4];
    const float* cpp = p.cp + (size_t)slj * 8192;
#pragma unroll
    for (int r = 0; r < 16; ++r) cr[r] = cpp[tid + 256 * r];
#pragma unroll
    for (int ii = 0; ii < 4; ++ii) {
      int i = (tid >> 4) + 16 * ii, c4 = tid & 15;
      vr[ii] = *(const f32x4*)(p.proj + (size_t)(base + i) * 2432 + 512 + h * 128 + c4 * 4);
    }
    if (wave == 0) {
      const int i = lane;
      const int tau = dir ? 63 - i : i;
      const float* row = p.proj + (size_t)(base + tau) * 2432 + 1536;
      float ig = row[(dir * 2 + 0) * 4 + h] + p.c_gate_bias[o * 16 + (dir * 2 + 0) * 4 + h];
      float fg = row[(dir * 2 + 1) * 4 + h] + p.c_gate_bias[o * 16 + (dir * 2 + 1) * 4 + h];
      float bsum = logsig_f(fg);
#pragma unroll
      for (int off = 1; off < 64; off <<= 1) { float v = __shfl_up(bsum, off); if (lane >= off) bsum += v; }
      float ib = ig - bsum;
      float pm = ib;
#pragma unroll
      for (int off = 1; off < 64; off <<= 1) { float v = __shfl_up(pm, off); if (lane >= off) pm = fmaxf(pm, v); }
      float mti = fmaxf(bsum + mprev, bsum + pm);
      bl[tau] = bsum; itb[tau] = ib; mt[tau] = mti; w0[tau] = __expf(bsum + mprev - mti);
    }
#pragma unroll
    for (int ii = 0; ii < 4; ++ii) {
      int i = (tid >> 4) + 16 * ii, c4 = tid & 15;
      kT[(c4 * 4 + 0) * 68 + i] = kv[ii].x * 0.125f; kT[(c4 * 4 + 1) * 68 + i] = kv[ii].y * 0.125f;
      kT[(c4 * 4 + 2) * 68 + i] = kv[ii].z * 0.125f; kT[(c4 * 4 + 3) * 68 + i] = kv[ii].w * 0.125f;
    }
    if (tid < 64) nv[tid] = p.np[slj * 64 + tid];
    __syncthreads();
    {
      float a[4][4];
#pragma unroll
      for (int r = 0; r < 4; ++r)
#pragma unroll
        for (int q = 0; q < 4; ++q) a[r][q] = 0.f;
#pragma unroll 2
      for (int d = 0; d < 64; ++d) {
        float4 q4v = *(const float4*)(qT + d * 68 + l0);
        float4 k4v = *(const float4*)(kT + d * 68 + x0);
        float qa[4] = {q4v.x, q4v.y, q4v.z, q4v.w}, kk[4] = {k4v.x, k4v.y, k4v.z, k4v.w};
#pragma unroll
        for (int r = 0; r < 4; ++r)
#pragma unroll
          for (int q = 0; q < 4; ++q) a[r][q] = fmaf(qa[r], kk[q], a[r][q]);
      }
      float rsum[4];
#pragma unroll
      for (int r = 0; r < 4; ++r) {
        const int l = l0 + r;
        const float bll = bl[l], mtl = mt[l];
        rsum[r] = 0.f;
#pragma unroll
        for (int q = 0; q < 4; ++q) {
          const int s = x0 + q;
          const bool ok = dir ? (s >= l) : (s <= l);
          float sv = ok ? a[r][q] * __expf(bll + itb[s] - mtl) : 0.f;
          St[s * 68 + l] = sv;
          rsum[r] += sv;
        }
        rsum[r] += shx(rsum[r], 1); rsum[r] += shx(rsum[r], 2);
        rsum[r] += shx(rsum[r], 4); rsum[r] += shx(rsum[r], 8);
        if (tx == 0) den[l] = rsum[r];
      }
    }
    __syncthreads();
    if (tid < 64) {
      float s = 0.f;
#pragma unroll 4
      for (int d = 0; d < 64; ++d) s = fmaf(qT[d * 68 + tid], nv[d], s);
      nq[tid] = s;
    }
#pragma unroll 1
    for (int vhalf = 0; vhalf < 2; ++vhalf) {
#pragma unroll
      for (int r = 0; r < 16; ++r) {
        int e = tid + 256 * r;
        CT[(e & 63) * 68 + (e >> 6)] = cr[r];
      }
#pragma unroll
      for (int ii = 0; ii < 4; ++ii) {
        int i = (tid >> 4) + 16 * ii, c4 = tid & 15;
        *(f32x4*)(vh + i * 68 + c4 * 4) = vr[ii];
      }
      if (vhalf == 0) {
#pragma unroll
        for (int r = 0; r < 16; ++r) cr[r] = cpp[4096 + tid + 256 * r];
#pragma unroll
        for (int ii = 0; ii < 4; ++ii) {
          int i = (tid >> 4) + 16 * ii, c4 = tid & 15;
          vr[ii] = *(const f32x4*)(p.proj + (size_t)(base + i) * 2432 + 512 + h * 128 + 64 + c4 * 4);
        }
      }
      __syncthreads();
      {
        float a1[4][4], a2[4][4];
#pragma unroll
        for (int r = 0; r < 4; ++r)
#pragma unroll
          for (int q = 0; q < 4; ++q) { a1[r][q] = 0.f; a2[r][q] = 0.f; }
#pragma unroll 2
        for (int s = 0; s < 64; ++s) {
          float4 sa = *(const float4*)(St + s * 68 + l0);
          float4 vb = *(const float4*)(vh + s * 68 + x0);
          float4 qa4 = *(const float4*)(qT + s * 68 + l0);
          float4 cb4 = *(const float4*)(CT + s * 68 + x0);
          float sl4[4] = {sa.x, sa.y, sa.z, sa.w}, vv[4] = {vb.x, vb.y, vb.z, vb.w};
          float qq[4] = {qa4.x, qa4.y, qa4.z, qa4.w}, cc[4] = {cb4.x, cb4.y, cb4.z, cb4.w};
#pragma unroll
          for (int r = 0; r < 4; ++r)
#pragma unroll
            for (int q = 0; q < 4; ++q) { a1[r][q] = fmaf(sl4[r], vv[q], a1[r][q]); a2[r][q] = fmaf(qq[r], cc[q], a2[r][q]); }
        }
#pragma unroll
        for (int r = 0; r < 4; ++r) {
          const int l = l0 + r;
          const float w = w0[l];
          const float dn_ = den[l] + w * nq[l];
          const float dd = fmaxf(fabsf(dn_), __expf(-mt[l]));
          const float inv = 1.f / dd;
#pragma unroll
          for (int q = 0; q < 4; ++q) { float hv = (a1[r][q] + w * a2[r][q]) * inv; if (vhalf == 0) hacc[0][r][q] += hv; else hacc[1][r][q] += hv; }
        }
      }
      __syncthreads();
    }
  }
#pragma unroll
  for (int r = 0; r < 4; ++r) {
    float ss = 0.f;
#pragma unroll
    for (int a = 0; a < 2; ++a)
#pragma unroll
      for (int q = 0; q < 4; ++q) ss += hacc[a][r][q] * hacc[a][r][q];
    ss += shx(ss, 1); ss += shx(ss, 2); ss += shx(ss, 4); ss += shx(ss, 8);
    const float rn = rsqrtf(ss * (1.f / 128.f) + EPS);
    const int m = base + l0 + r;
#pragma unroll
    for (int a = 0; a < 2; ++a) {
      const int v0 = a * 64 + x0;
      float4 co = *(const float4*)(p.proj + (size_t)m * 2432 + 1024 + h * 128 + v0);
      float4 gn = *(const float4*)(p.c_out_norm + (size_t)(o * 4 + h) * 128 + v0);
      float y0 = sigmoid_f(co.x) * hacc[a][r][0] * rn * gn.x;
      float y1 = sigmoid_f(co.y) * hacc[a][r][1] * rn * gn.y;
      float y2 = sigmoid_f(co.z) * hacc[a][r][2] * rn * gn.z;
      float y3 = sigmoid_f(co.w) * hacc[a][r][3] * rn * gn.w;
      uint2 oo; oo.x = pack2(y0, y1); oo.y = pack2(y2, y3);
      *(uint2*)(p.mix + (size_t)m * 1024 + h * 128 + v0) = oo;
    }
  }
  __syncthreads();
}

__device__ __forceinline__ void mlstm2_mfma(PRM p, int o, int task, char* smem) {
  const int tid = get_tid(), lane = tid & 63, wave = tid >> 6, l15 = lane & 15, q4 = lane >> 4;
  int sq, h, c;
  if (task < 256) { c = task & 3; h = (task >> 2) & 3; sq = task >> 4; }
  else { int u = task - 256; c = u & 15; h = (u >> 4) & 3; sq = 16 + (u >> 6); }
  const bool pr = sq < 16;
  const int nc = pr ? 4 : 16;
  const int base = (pr ? sq * 256 : NPR + (sq - 16) * 1024) + c * 64;
  u16* Qb = (u16*)smem;
  u16* Kb = Qb + 64 * 72;
  u16* Vt = Kb + 64 * 72;
  u16* Cb = Vt + 128 * 72;
  float* sml = (float*)(Cb + 128 * 72);
  float* bl = sml; float* itb = sml + 64; float* mt = sml + 128; float* w0 = sml + 192; float* nv = sml + 256;
#pragma unroll
  for (int ii = 0; ii < 4; ++ii) {
    int i = (tid >> 4) + 16 * ii, c4 = tid & 15;
    const float* row = p.proj + (size_t)(base + i) * 2432 + h * 64 + c4 * 4;
    f32x4 qv = *(const f32x4*)row;
    f32x4 kv = *(const f32x4*)(row + 256);
    uint2 a; a.x = pack2(qv[0], qv[1]); a.y = pack2(qv[2], qv[3]);
    uint2 b; b.x = pack2(kv[0] * 0.125f, kv[1] * 0.125f); b.y = pack2(kv[2] * 0.125f, kv[3] * 0.125f);
    *(uint2*)(Qb + i * 72 + c4 * 4) = a;
    *(uint2*)(Kb + i * 72 + c4 * 4) = b;
  }
#pragma unroll
  for (int ii = 0; ii < 8; ++ii) {
    int i = (tid >> 5) + 8 * ii, c4 = tid & 31;
    f32x4 vv = *(const f32x4*)(p.proj + (size_t)(base + i) * 2432 + 512 + h * 128 + c4 * 4);
    unsigned w01 = pack2(vv[0], vv[1]), w23 = pack2(vv[2], vv[3]);
    Vt[(c4 * 4 + 0) * 72 + i] = (u16)(w01 & 0xffffu); Vt[(c4 * 4 + 1) * 72 + i] = (u16)(w01 >> 16);
    Vt[(c4 * 4 + 2) * 72 + i] = (u16)(w23 & 0xffffu); Vt[(c4 * 4 + 3) * 72 + i] = (u16)(w23 >> 16);
  }
  f32x4 hacc[8];
#pragma unroll
  for (int vt = 0; vt < 8; ++vt) hacc[vt] = (f32x4){0.f, 0.f, 0.f, 0.f};
  const int lrow = wave * 16 + l15;
#pragma unroll 1
  for (int dir = 0; dir < 2; ++dir) {
    const int j = dir ? nc - 1 - c : c;
    const int slj = mslot(sq, h, dir, j);
    const float mprev = p.mp[slj];
    {
      const f32x4* cpp = (const f32x4*)(p.cp + (size_t)slj * 8192);
#pragma unroll
      for (int r = 0; r < 8; ++r) {
        int e4 = tid + 256 * r;
        f32x4 cv = cpp[e4];
        uint2 a; a.x = pack2(cv[0], cv[1]); a.y = pack2(cv[2], cv[3]);
        *(uint2*)(Cb + (e4 >> 4) * 72 + (e4 & 15) * 4) = a;
      }
    }
    if (tid < 64) nv[tid] = p.np[slj * 64 + tid];
    if (wave == 0) {
      const int i = lane;
      const int tau = dir ? 63 - i : i;
      const float* row = p.proj + (size_t)(base + tau) * 2432 + 1536;
      float ig = row[(dir * 2 + 0) * 4 + h] + p.c_gate_bias[o * 16 + (dir * 2 + 0) * 4 + h];
      float fg = row[(dir * 2 + 1) * 4 + h] + p.c_gate_bias[o * 16 + (dir * 2 + 1) * 4 + h];
      float bsum = logsig_f(fg);
#pragma unroll
      for (int off = 1; off < 64; off <<= 1) { float v = __shfl_up(bsum, off); if (lane >= off) bsum += v; }
      float ib = ig - bsum;
      float pm = ib;
#pragma unroll
      for (int off = 1; off < 64; off <<= 1) { float v = __shfl_up(pm, off); if (lane >= off) pm = fmaxf(pm, v); }
      float mti = fmaxf(bsum + mprev, bsum + pm);
      bl[tau] = bsum; itb[tau] = ib; mt[tau] = mti; w0[tau] = __expf(bsum + mprev - mti);
    }
    __syncthreads();
    const float bll = bl[lrow], mtl = mt[lrow], w0l = w0[lrow];
    bf16x8 qf[2];
#pragma unroll
    for (int ks = 0; ks < 2; ++ks) qf[ks] = *(const bf16x8*)(Qb + lrow * 72 + ks * 32 + q4 * 8);
    float nqp = 0.f;
#pragma unroll
    for (int ks = 0; ks < 2; ++ks)
#pragma unroll
      for (int jj = 0; jj < 8; ++jj) {
        float qe = __uint_as_float(((unsigned)(unsigned short)qf[ks][jj]) << 16);
        nqp = fmaf(qe, nv[ks * 32 + q4 * 8 + jj], nqp);
      }
    nqp += shx(nqp, 16); nqp += shx(nqp, 32);
    f32x4 oacc[8];
#pragma unroll
    for (int vt = 0; vt < 8; ++vt) {
      oacc[vt] = (f32x4){0.f, 0.f, 0.f, 0.f};
#pragma unroll
      for (int ks = 0; ks < 2; ++ks) {
        bf16x8 a = *(const bf16x8*)(Cb + (vt * 16 + l15) * 72 + ks * 32 + q4 * 8);
        oacc[vt] = mfma16(a, qf[ks], oacc[vt]);
      }
      oacc[vt] *= w0l;
    }
    float sv[16];
    float dsum = 0.f;
#pragma unroll
    for (int st = 0; st < 4; ++st) {
      f32x4 sa = {0.f, 0.f, 0.f, 0.f};
#pragma unroll
      for (int ks = 0; ks < 2; ++ks) {
        bf16x8 a = *(const bf16x8*)(Kb + (st * 16 + l15) * 72 + ks * 32 + q4 * 8);
        sa = mfma16(a, qf[ks], sa);
      }
#pragma unroll
      for (int r = 0; r < 4; ++r) {
        const int sidx = st * 16 + q4 * 4 + r;
        const bool ok = dir ? (sidx >= lrow) : (sidx <= lrow);
        float val = ok ? sa[r] * __expf(bll + itb[sidx] - mtl) : 0.f;
        sv[st * 4 + r] = val;
        dsum += val;
      }
    }
    dsum += shx(dsum, 16); dsum += shx(dsum, 32);
    bf16x8 pf[2];
#pragma unroll
    for (int hf = 0; hf < 2; ++hf) {
      u32x4 pw;
      pw[0] = pack2(sv[hf * 8 + 0], sv[hf * 8 + 1]); pw[1] = pack2(sv[hf * 8 + 2], sv[hf * 8 + 3]);
      pw[2] = pack2(sv[hf * 8 + 4], sv[hf * 8 + 5]); pw[3] = pack2(sv[hf * 8 + 6], sv[hf * 8 + 7]);
      pf[hf] = __builtin_bit_cast(bf16x8, pw);
    }
    const float dn_ = dsum + w0l * nqp;
    const float inv = 1.f / fmaxf(fabsf(dn_), __expf(-mtl));
#pragma unroll
    for (int vt = 0; vt < 8; ++vt) {
#pragma unroll
      for (int hf = 0; hf < 2; ++hf) {
        const u16* vp = Vt + (vt * 16 + l15) * 72 + hf * 32 + q4 * 4;
        s16x4 v0 = *(const s16x4*)vp;
        s16x4 v1 = *(const s16x4*)(vp + 16);
        bf16x8 vf = (bf16x8){v0.x, v0.y, v0.z, v0.w, v1.x, v1.y, v1.z, v1.w};
        oacc[vt] = mfma16(vf, pf[hf], oacc[vt]);
      }
      hacc[vt] += oacc[vt] * inv;
    }
    __syncthreads();
  }
  float ss = 0.f;
#pragma unroll
  for (int vt = 0; vt < 8; ++vt)
#pragma unroll
    for (int r = 0; r < 4; ++r) ss += hacc[vt][r] * hacc[vt][r];
  ss += shx(ss, 16); ss += shx(ss, 32);
  const float rn = rsqrtf(ss * (1.f / 128.f) + EPS);
  const int m = base + lrow;
#pragma unroll
  for (int vt = 0; vt < 8; ++vt) {
    const int v0 = vt * 16 + q4 * 4;
    f32x4 co = *(const f32x4*)(p.proj + (size_t)m * 2432 + 1024 + h * 128 + v0);
    f32x4 gn = *(const f32x4*)(p.c_out_norm + (size_t)(o * 4 + h) * 128 + v0);
    float y0 = sigmoid_f(co[0]) * hacc[vt][0] * rn * gn[0];
    float y1 = sigmoid_f(co[1]) * hacc[vt][1] * rn * gn[1];
    float y2 = sigmoid_f(co[2]) * hacc[vt][2] * rn * gn[2];
    float y3 = sigmoid_f(co[3]) * hacc[vt][3] * rn * gn[3];
    uint2 oo; oo.x = pack2(y0, y1); oo.y = pack2(y2, y3);
    *(uint2*)(p.mix + (size_t)m * 1024 + h * 128 + v0) = oo;
  }
  __syncthreads();
}

__device__ __forceinline__ void mlstm_scan_phase(PRM p, int o) {
  const int tid = get_tid();
  for (int task = get_bid(); task < 576; task += vgrid()) {
    const int sc = task >> 2, slice = task & 3;
    int sq, h, dir;
    if (sc < 128) { sq = sc >> 3; h = (sc >> 1) & 3; dir = sc & 1; }
    else { int u = sc - 128; sq = 16 + (u >> 3); h = (u >> 1) & 3; dir = u & 1; }
    const bool pr = sq < 16;
    const int nc = pr ? 4 : 16;
    const int sidx = pr ? ((sq * 2 + o) * 2 + dir) * 4 + h : 0;
    const int cidx = pr ? 0 : (((sq - 16) * 2 + o) * 2 + dir) * 4 + h;
    const int e0 = slice * 2048 + tid;
    float C[8];
#pragma unroll
    for (int r = 0; r < 8; ++r) C[r] = pr ? 0.f : p.state_C[(size_t)cidx * 8192 + e0 + 256 * r];
    const bool nthr = (slice == 0) && (tid < 64);
    float n = (pr || !nthr) ? 0.f : p.state_n[cidx * 64 + tid];
    float m = pr ? 0.f : p.state_m[cidx];
#pragma unroll 4
    for (int j = 0; j < nc; ++j) {
      const int sl = mslot(sq, h, dir, j);
      float* cp = p.cp + (size_t)sl * 8192 + e0;
      const float* dc = p.dC + (size_t)sl * 8192 + e0;
#pragma unroll
      for (int r = 0; r < 8; ++r) cp[256 * r] = C[r];
      if (nthr) { p.np[sl * 64 + tid] = n; if (tid == 0) p.mp[sl] = m; }
      const float ml = p.dm[sl * 2], bls = p.dm[sl * 2 + 1];
      const float mn = fmaxf(bls + m, ml);
      const float ca = __expf(bls + m - mn), cb = __expf(ml - mn);
#pragma unroll
      for (int r = 0; r < 8; ++r) C[r] = ca * C[r] + cb * dc[256 * r];
      if (nthr) n = ca * n + cb * p.dn[sl * 64 + tid];
      m = mn;
    }
    if (pr) {
      float* oc = p.out + O_CC + (size_t)sidx * 8192 + e0;
#pragma unroll
      for (int r = 0; r < 8; ++r) oc[256 * r] = C[r];
      if (nthr) { p.out[O_CN + (size_t)sidx * 64 + tid] = n; if (tid == 0) p.out[O_CM + sidx] = m; }
    }
  }
}

__device__ __forceinline__ void odd_mid_phase(PRM p, int o, char* smem) {
  u16* lds = (u16*)smem;
  const int tid = get_tid(), lane = tid & 63, wave = tid >> 6, l15 = lane & 15, q4 = lane >> 4;
  for (int bt = get_bid(); bt < 256 + 768 + 512; bt += vgrid()) {
    if (bt < 256) {
      int qb = bt & 15, hq = (bt >> 4) & 7, b = bt >> 7;
      int kvh = hq >> 2;
      int mq = NPR + b * 1024 + qb * 64 + wave * 16;
      AttnSt st; attn_init(st);
      bf16x8 qf[2]; load_q64(qf, p.qa + (size_t)mq * 512 + hq * 64, 512, l15, q4);
      at_run_plain<2>(st, qf, p.kd + (size_t)(NPR + b * 1536) * 128 + kvh * 64, 128, p.vtd_s + (size_t)((b * 2 + kvh) * 64) * 1536, 1536, 24, 0.125f, lds, tid, l15, q4);
      attn_fin(st, p.mix + (size_t)mq * 1024 + 512 + hq * 64, l15, q4);
    } else if (bt < 256 + 768) {
      mlstm1_task(p, o, bt - 256, (float*)smem);
    } else {
      int u = bt - 1024;
      int qb = u & 3, hq = (u >> 2) & 7, b = u >> 5;
      int kvh = hq >> 2;
      int mq = b * 256 + qb * 64 + wave * 16;
      AttnSt st; attn_init(st);
      bf16x8 qf[2]; load_q64(qf, p.qa + (size_t)mq * 512 + hq * 64, 512, l15, q4);
      at_run_plain<2>(st, qf, p.kd + (size_t)(b * 256) * 128 + kvh * 64, 128, p.vtd_p + (size_t)((b * 2 + kvh) * 64) * 256, 256, 4, 0.125f, lds, tid, l15, q4);
      attn_fin(st, p.mix + (size_t)mq * 1024 + 512 + hq * 64, l15, q4);
    }
  }
}

__device__ __forceinline__ void run_phase(PRM p, int ph, char* smem) {
  char* vsm = smem + (rtid() >> 8) * LDS_HALF;
  if (ph == 0) { phase0(p, vsm); return; }
  if (ph == NPHASE - 1) { norm_phase(p, 0, 3); return; }
  const int l = (ph - 1) / 13, s = (ph - 1) % 13;
  const int eo = l >> 1;
  const bool even = (l & 1) == 0;
  EpiP e{};
  const float* modl = p.mod + (size_t)l * 3 * 9216;
  switch (s) {
    case 0: norm_phase(p, l, 0); break;
    case 1: e.H = p.h; ffn_in_phase(p, l, 0, e, smem); break;
    case 2: e.C = p.x; e.gate = modl + 2 * 1024; e.ldc = 1;
            if (l == 0) { e.vtp = (u16*)p.x_prompt; e.vts = (u16*)p.x_sample; }
            gemm_phase<EPI_RESID, 4, 2, 3, 4, 4>(p.h, p.wt_ffn_out + (size_t)(l * 2 + 0) * 1024 * 2816, 2816, 32, 8, e, smem); break;
    case 3: norm_phase(p, l, 1); break;
    case 4:
      if (even) { e.C = p.proj; e.ldc = 2688; gemm_phase<EPI_STORE, 4, 2, 4, 4, 2>(p.xn, p.wt_in_e + (size_t)eo * 2688 * 1024, 1024, 24, 21, e, smem); }
      else { e.C = p.proj; e.ldc = 2432; gemm_phase<EPI_STORE, 4, 2, 4, 4, 2>(p.xn, p.wt_in_o + (size_t)eo * 2432 * 1024, 1024, 24, 19, e, smem); }
      break;
    case 5: if (even) post_even(p, eo); else post_odd(p, eo); break;
    case 6:
      if (even) {
        EpiP eq{}; eq.C = p.qb; eq.ldc = 768;
        EpiP ek{}; ek.kb = p.kb; ek.vtp = p.vtb_p; ek.vts = p.vtb_s; ek.ctx = 0;
        EpiP ec = ek; ec.ctx = 1;
        const u16* wq = p.wt_qup + (size_t)eo * 768 * 768;
        const u16* wk = p.wt_kvup + (size_t)eo * 1024 * 256;
        for (int t = rbid(); t < 288 + 384 + 64; t += (int)gridDim.x) {
          if (t < 288) gemm_tile<EPI_STORE, 4, 2, 2, 4, 2>(p.cqn, wq, 768, t % 48, t / 48, eq, smem);
          else if (t < 672) { int u = t - 288; gemm_tile<EPI_KVUP, 4, 2, 2, 4, 2>(p.ckvn, wk, 256, u % 48, u / 48, ek, smem); }
          else { int u = t - 672; gemm_tile<EPI_KVUP, 4, 2, 2, 4, 2>(p.cctxn, wk, 256, u % 8, u / 8, ec, smem); }
        }
      } else odd_mid_phase(p, eo, vsm);
      break;
    case 7: if (!even) mlstm_scan_phase(p, eo); break;
    case 8:
      if (even) attn_even_phase(p, eo, vsm);
      else { for (int t = get_bid(); t < 384; t += vgrid()) mlstm2_mfma(p, eo, t, vsm); }
      break;
    case 9: e.C = p.x; e.gate = modl + 5 * 1024; e.ldc = 0;
            gemm_phase<EPI_RESID, 4, 2, 3, 4, 2>(p.mix, p.wt_out + (size_t)l * 1024 * 1024, 1024, 32, 8, e, smem); break;
    case 10: norm_phase(p, l, 2); break;
    case 11: e.H = p.h; ffn_in_phase(p, l, 1, e, smem); break;
    case 12: e.C = p.x; e.gate = modl + 8 * 1024; e.ldc = 1;
             gemm_phase<EPI_RESID, 4, 2, 3, 4, 4>(p.h, p.wt_ffn_out + (size_t)(l * 2 + 1) * 1024 * 2816, 2816, 32, 8, e, smem); break;
  }
}

__global__ void __launch_bounds__(512, 2) mega(Params p) {
  __shared__ __attribute__((aligned(16))) char smem[LDS_BYTES];
  __shared__ uint4 xb_words;
  cg::grid_group grid = cg::this_grid();
  if (threadIdx.x == 0) xb_words = make_uint4(0u, 0u, 0u, 0u);
  __syncthreads();
  XcdBarrier xb = xcd_barrier_post(p.bar, (volatile LAS unsigned*)&xb_words);
  for (int ph = p.ph0; ph < p.ph1; ++ph) {
    const __attribute__((address_space(4))) Params* pp = (const __attribute__((address_space(4))) Params*)__builtin_amdgcn_kernarg_segment_ptr();
    asm volatile("" : "+s"(pp));
    run_phase(*pp, ph, smem);
#ifndef REPMASK
#define REPMASK 0
#endif
#ifndef REPPAR
#define REPPAR 0
#endif
    if (REPMASK) {
      int bit = ph == 0 ? 13 : (ph == NPHASE - 1 ? 14 : (ph - 1) % 13);
      int lay = (ph - 1) / 13;
      bool parok = REPPAR == 0 || ph == 0 || ph == NPHASE - 1 || (REPPAR == 1 && (lay & 1) == 0) || (REPPAR == 2 && (lay & 1) == 1);
      if (((REPMASK >> bit) & 1) && parok) { xcd_barrier(xb); asm volatile("" : "+s"(pp)); run_phase(*pp, ph, smem); }
    }
    if (ph + 1 < p.ph1) {
      if (p.ph1 > 100000) grid.sync();
      xcd_barrier(xb);
    }
  }
}

extern "C" void kernel_launch(void* const* d_in, const int* in_sizes, int n_in, void* d_out, int out_size, void* d_ws, size_t ws_size,
                              hipStream_t stream) {
  static int grid_blocks = 0;
  if (!grid_blocks) {
    int dev = 0, cus = 0, per_cu = 0;
    hipGetDevice(&dev);
    hipDeviceGetAttribute(&cus, hipDeviceAttributeMultiprocessorCount, dev);
    hipOccupancyMaxActiveBlocksPerMultiprocessor(&per_cu, mega, 512, 0);
    per_cu = 1;
    grid_blocks = cus * per_cu;
  }
  Params p{};
  const float** ip = (const float**)&p.x_prompt;
  for (int i = 0; i < 31; ++i) ip[i] = (const float*)d_in[i];
  p.out = (float*)d_out;
  char* w = (char*)d_ws;
  size_t off = 0;
  auto take = [&](size_t bytes) { char* r = w + off; off += (bytes + 255) & ~(size_t)255; return r; };
  p.wt_ffn_in = (u16*)take((size_t)8 * 5632 * 1024 * 2);
  p.wt_ffn_out = (u16*)take((size_t)8 * 1024 * 2816 * 2);
  p.wt_in_e = (u16*)take((size_t)2 * 2688 * 1024 * 2);
  p.wt_in_o = (u16*)take((size_t)2 * 2432 * 1024 * 2);
  p.wt_out = (u16*)take((size_t)4 * 1024 * 1024 * 2);
  p.wt_qup = (u16*)take((size_t)2 * 768 * 768 * 2);
  p.wt_kvup = (u16*)take((size_t)2 * 1024 * 256 * 2);
  p.mod = (float*)take((size_t)12 * 9216 * 4);
  p.x = (float*)take((size_t)NTOK * 1024 * 4);
  p.proj = (float*)take((size_t)NTOK * 2688 * 4);
  p.qb = (float*)take((size_t)NTOK * 768 * 4);
  p.dC = (float*)take((size_t)768 * 8192 * 4);
  p.dn = (float*)take((size_t)768 * 64 * 4);
  p.dm = (float*)take((size_t)768 * 2 * 4);
  p.cp = (float*)take((size_t)768 * 8192 * 4);
  p.np = (float*)take((size_t)768 * 64 * 4);
  p.mp = (float*)take((size_t)768 * 4);
  p.xn = (u16*)take((size_t)NTOK * 1024 * 2);
  p.h = (u16*)take((size_t)NTOK * 2816 * 2);
  p.mix = (u16*)take((size_t)NTOK * 1024 * 2);
  p.qa = (u16*)take((size_t)NTOK * 512 * 2);
  p.ka = (u16*)take((size_t)NTOK * 512 * 2);
  p.kactx = (u16*)take((size_t)1024 * 512 * 2);
  p.vta_p = (u16*)take((size_t)16 * 8 * 64 * 256 * 2);
  p.vta_s = (u16*)take((size_t)2 * 8 * 64 * 1536 * 2);
  p.kb = (u16*)take((size_t)7168 * 768 * 2);
  p.vtb_p = (u16*)take((size_t)16 * 8 * 64 * 256 * 2);
  p.vtb_s = (u16*)take((size_t)2 * 8 * 64 * 1536 * 2);
  p.cqn = (u16*)take((size_t)NTOK * 768 * 2);
  p.ckvn = (u16*)take((size_t)NTOK * 256 * 2);
  p.cctxn = (u16*)take((size_t)1024 * 256 * 2);
  p.kd = (u16*)take((size_t)7168 * 128 * 2);
  p.vtd_p = (u16*)take((size_t)16 * 2 * 64 * 256 * 2);
  p.vtd_s = (u16*)take((size_t)2 * 2 * 64 * 1536 * 2);
  p.bar = (unsigned*)take((size_t)XCD_BAR_WORDS * 4);
  if (off > ws_size) { fprintf(stderr, "kernel_launch: workspace too small: need %zu have %zu\n", off, ws_size); return; }
  hipMemsetAsync(p.bar, 0, (size_t)XCD_BAR_WORDS * 4, stream);
#if MULTI
  for (int ph = 0; ph < NPHASE; ++ph) {
    p.ph0 = ph; p.ph1 = ph + 1;
    hipLaunchKernelGGL(mega, dim3(grid_blocks), dim3(512), 0, stream, p);
  }
#else
  p.ph0 = 0; p.ph1 = NPHASE;
  void* args[] = {&p};
  hipError_t e = hipLaunchCooperativeKernel((void*)mega, dim3(grid_blocks), dim3(512), args, 0, stream);
  if (e != hipSuccess) fprintf(stderr, "cooperative launch failed: %s (grid %d)\n", hipGetErrorString(e), grid_blocks);
#endif
}
```

```cpp
#include <hip/hip_runtime.h>
#include <hip/hip_cooperative_groups.h>
#include <cstdio>
#include <cstdint>
namespace cg = cooperative_groups;

#ifndef MULTI
#define MULTI 0
#endif

typedef unsigned short u16;
typedef __attribute__((ext_vector_type(8))) short bf16x8;
typedef __attribute__((ext_vector_type(4))) short s16x4;
typedef __attribute__((ext_vector_type(4))) float f32x4;
typedef __attribute__((ext_vector_type(4))) unsigned int u32x4;

#define NTOK 6144
#define NPR 4096
#define LDS_HALF 77824
#define LDS_BYTES (2 * LDS_HALF)
#define NPHASE 54
#define EPS 1e-6f

struct Params {
  const float *x_prompt, *x_sample, *cache_a_k, *cache_a_v, *cache_b_ckv, *cache_b_krope, *cache_d_k, *cache_d_v;
  const float *state_C, *state_n, *state_m, *c, *c_ctx, *w_mod, *b_mod, *norm_g, *ffn_in, *ffn_out;
  const float *w_in_even, *w_in_odd, *w_out, *a_rpb, *b_q_norm, *b_wq_up, *b_kv_norm, *b_wkv_up;
  const float *c_gate_bias, *c_out_norm, *d_q_norm, *d_k_norm, *final_norm;
  float* out;
  u16 *wt_ffn_in, *wt_ffn_out, *wt_in_e, *wt_in_o, *wt_out, *wt_qup, *wt_kvup;
  float *mod, *x, *proj, *qb, *dC, *dn, *dm, *cp, *np, *mp;
  u16 *xn, *h, *mix, *qa, *ka, *kactx, *vta_p, *vta_s, *kb, *vtb_p, *vtb_s, *cqn, *ckvn, *cctxn, *kd, *vtd_p, *vtd_s;
  unsigned* bar;
  int ph0, ph1;
};

typedef const __attribute__((address_space(4))) Params& PRM;
#define O_YP 0
#define O_YS 4194304
#define O_AK 6291456
#define O_AV 10485760
#define O_CKV 14680064
#define O_KR 16777216
#define O_DK 17039360
#define O_DV 18087936
#define O_CC 19136512
#define O_CN 21233664
#define O_CM 21250048

__device__ __forceinline__ int get_tid() { int t = threadIdx.x & 255; asm volatile("" : "+v"(t)); return t; }
__device__ __forceinline__ int rtid_raw() { int t = threadIdx.x; asm volatile("" : "+v"(t)); return t; }
__device__ __forceinline__ int get_bid() { int t = blockIdx.x * 2 + __builtin_amdgcn_readfirstlane(rtid_raw() >> 8); asm volatile("" : "+s"(t)); return t; }
__device__ __forceinline__ int vgrid() { return (int)gridDim.x * 2; }
__device__ __forceinline__ int rtid() { int t = threadIdx.x; asm volatile("" : "+v"(t)); return t; }
__device__ __forceinline__ int rbid() { int t = blockIdx.x; asm volatile("" : "+s"(t)); return t; }
typedef __attribute__((ext_vector_type(2))) __bf16 bf16x2_t;
typedef __attribute__((ext_vector_type(2))) float f32x2_t;
__device__ __forceinline__ unsigned pack2(float a, float b) {
  f32x2_t v = {a, b};
  bf16x2_t r = __builtin_convertvector(v, bf16x2_t);
  return __builtin_bit_cast(unsigned, r);
}
__device__ __forceinline__ u16 f2bf(float f) { return (u16)(pack2(f, 0.f) & 0xffffu); }
__device__ __forceinline__ float shx(float v, int m) {
  int l = __builtin_amdgcn_mbcnt_hi(-1, __builtin_amdgcn_mbcnt_lo(-1, 0));
  asm volatile("" : "+v"(l));
  return __int_as_float(__builtin_amdgcn_ds_bpermute((l ^ m) << 2, __float_as_int(v)));
}
__device__ __forceinline__ float wsum(float v) {
#pragma unroll
  for (int o = 32; o; o >>= 1) v += shx(v, o);
  return v;
}
__device__ __forceinline__ float wmaxr(float v) {
#pragma unroll
  for (int o = 32; o; o >>= 1) v = fmaxf(v, shx(v, o));
  return v;
}
__device__ __forceinline__ float silu_f(float x) { return x / (1.f + __expf(-x)); }
__device__ __forceinline__ float sigmoid_f(float x) { return 1.f / (1.f + __expf(-x)); }
__device__ __forceinline__ float logsig_f(float x) { return fminf(x, 0.f) - __logf(1.f + __expf(-fabsf(x))); }
__device__ __forceinline__ void sincos_r(float a, float& s, float& c) {
  float n = rintf(a * 0.15915494309f);
  float r = fmaf(-n, 6.2831855f, a);
  r = fmaf(-n, -1.7484555e-7f, r);
  s = __sinf(r); c = __cosf(r);
}
__device__ __forceinline__ int grp_of(int m) { return m < NPR ? 0 : 1 + ((m - NPR) >> 10); }
__device__ __forceinline__ int keyrow(int m) { return m < NPR ? m : NPR + ((m - NPR) >> 10) * 1536 + ((m - NPR) & 1023); }
__device__ __forceinline__ f32x4 mfma16(bf16x8 a, bf16x8 b, f32x4 c) { return __builtin_amdgcn_mfma_f32_16x16x32_bf16(a, b, c, 0, 0, 0); }

#define XB_TMO      128
#define XB_XCNT(j)  (256  + 64 * (j))
#define XB_XSUB(j)  (1280 + 64 * (j))
#define XB_XGEN(j)  (2304 + 64 * (j))
#define XB_TOP      3328
#define XB_TOPGEN   3392
#define XCD_BAR_WORDS 3456
#define XB_SPIN_CAP (1u << 18)
#define LAS __attribute__((address_space(3)))

__device__ __forceinline__ unsigned xb_ld(unsigned* p)              { return __hip_atomic_load(p, __ATOMIC_RELAXED, __HIP_MEMORY_SCOPE_AGENT); }
__device__ __forceinline__ unsigned xb_add(unsigned* p, unsigned v) { return __hip_atomic_fetch_add(p, v, __ATOMIC_RELAXED, __HIP_MEMORY_SCOPE_AGENT); }
__device__ __forceinline__ unsigned xb_xcc_id() { return (unsigned)__builtin_amdgcn_s_getreg((3 << 11) | 20) & 0xFu; }
#define XB_SPIN(cond, bar) do { unsigned _sp = 0; while (cond) { __builtin_amdgcn_s_sleep(1); \
    if ((++_sp & 255u) == 0u) { if (xb_ld(&(bar)[XB_TMO])) break; if (_sp > XB_SPIN_CAP) { atomicAdd(&(bar)[XB_TMO], 1u); break; } } } } while (0)

struct XcdBarrier {
    unsigned* bar; unsigned x;
    volatile LAS unsigned* st;
};

__device__ __forceinline__ XcdBarrier xcd_barrier_post(unsigned* bar, volatile LAS unsigned* st) {
    XcdBarrier b; b.bar = bar; b.x = xb_xcc_id(); b.st = st;
    if (threadIdx.x == 0) (void)xb_add(&bar[XB_XCNT(b.x)], 1u);
    return b;
}
__device__ __forceinline__ void xcd_barrier_complete(unsigned* bar, unsigned x, unsigned& nloc, unsigned& nx) {
    const unsigned G = gridDim.x * gridDim.y * gridDim.z;
    unsigned sum, cnt, mine, sp = 0u;
    for (;;) {
        sum = 0u; cnt = 0u; mine = 0u;
#pragma unroll
        for (unsigned j = 0; j < 16; ++j) { const unsigned c = xb_ld(&bar[XB_XCNT(j)]); sum += c; cnt += (c > 0u) ? 1u : 0u; mine = (j == x) ? c : mine; }
        if (sum == G) break;
        __builtin_amdgcn_s_sleep(1);
        if ((++sp & 255u) == 0u) { if (xb_ld(&bar[XB_TMO])) break; if (sp > XB_SPIN_CAP) { atomicAdd(&bar[XB_TMO], 1u); break; } }
    }
    nloc = mine > 0u ? mine : 1u; nx = cnt > 0u ? cnt : 1u;
}

__device__ __forceinline__ void xcd_barrier(const XcdBarrier& b) {
    asm volatile("s_waitcnt vmcnt(0)" ::: "memory");
    __syncthreads();
    if (threadIdx.x == 0) {
        unsigned* bar = b.bar;
        __builtin_amdgcn_s_waitcnt(0);
        unsigned nloc = b.st[0], nx = b.st[1];
        if (nloc == 0u) { xcd_barrier_complete(bar, b.x, nloc, nx); b.st[0] = nloc; b.st[1] = nx; }
        const unsigned old = xb_add(&bar[XB_XSUB(b.x)], 1u);
        const unsigned gen = old / nloc;
        if (old + 1u == (gen + 1u) * nloc) {
            __builtin_amdgcn_fence(__ATOMIC_RELEASE, "agent");
            asm volatile("s_waitcnt vmcnt(0)" ::: "memory");
            const unsigned og = xb_add(&bar[XB_TOP], 1u);
            const unsigned tg = og / nx;
            if (og + 1u == (tg + 1u) * nx) xb_add(&bar[XB_TOPGEN], 1u);
            else XB_SPIN(xb_ld(&bar[XB_TOPGEN]) == tg, bar);
            __builtin_amdgcn_fence(__ATOMIC_ACQUIRE, "agent");
            xb_add(&bar[XB_XGEN(b.x)], 1u);
            asm volatile("s_waitcnt vmcnt(0)" ::: "memory");
        } else {
            XB_SPIN(xb_ld(&bar[XB_XGEN(b.x)]) == gen, bar);
            __builtin_amdgcn_fence(__ATOMIC_ACQUIRE, "agent");
            asm volatile("s_waitcnt vmcnt(0)" ::: "memory");
        }
    }
    __syncthreads();
}


__device__ __forceinline__ void conv_tile(const float* __restrict__ src, int K, int N, int perm, u16* __restrict__ dst, int kt4, int nt, float* tile) {
  const int tid = get_tid();
  {
    const int c4 = tid & 15, kr = tid >> 4;
    const int n = nt * 64 + c4 * 4;
    const bool valid = n < N;
    int col = n;
    if (perm) { int G = n >> 4, w = n & 15, sub = w >> 2; col = ((sub & 1) ? 2816 : 0) + G * 8 + (sub >> 1) * 4 + (w & 3); }
    f32x4 v[16];
#pragma unroll
    for (int i = 0; i < 16; ++i) {
      int kk = kr + 16 * i;
      v[i] = valid ? *(const f32x4*)(src + (size_t)(kt4 * 256 + kk) * N + col) : (f32x4){0.f, 0.f, 0.f, 0.f};
    }
#pragma unroll
    for (int i = 0; i < 16; ++i) {
      int kk = kr + 16 * i;
      float* t = tile + (kk >> 6) * 4160 + (kk & 63) * 65 + c4 * 4;
      t[0] = v[i][0]; t[1] = v[i][1]; t[2] = v[i][2]; t[3] = v[i][3];
    }
  }
  __syncthreads();
  {
    const int k8 = (tid & 7) * 8;
#pragma unroll
    for (int hh = 0; hh < 4; ++hh)
#pragma unroll
      for (int i = 0; i < 2; ++i) {
        int nn2 = (tid >> 3) + 32 * i;
        float v[8];
#pragma unroll
        for (int e = 0; e < 8; ++e) v[e] = tile[hh * 4160 + (k8 + e) * 65 + nn2];
        uint4 o; o.x = pack2(v[0], v[1]); o.y = pack2(v[2], v[3]); o.z = pack2(v[4], v[5]); o.w = pack2(v[6], v[7]);
        *(uint4*)(dst + (size_t)(nt * 64 + nn2) * K + kt4 * 256 + hh * 64 + k8) = o;
      }
  }
  __syncthreads();
}

__device__ __forceinline__ void mod_task(PRM p, int t, float* sm) {
  const int l = t / 144, cb = t % 144, tid = get_tid();
  float* sc = sm;
  float* red = sm + 3072;
  for (int i = tid; i < 3072; i += 256) {
    int g = i >> 10, k = i & 1023;
    float v = g == 0 ? p.c_ctx[k] : p.c[(g - 1) * 1024 + k];
    sc[i] = silu_f(v);
  }
  __syncthreads();
  const int c4 = tid & 15, kg = tid >> 4;
  const float* w = p.w_mod + (size_t)l * 1024 * 9216 + (size_t)(kg * 64) * 9216 + cb * 64 + c4 * 4;
  float a[3][4];
#pragma unroll
  for (int g = 0; g < 3; ++g)
#pragma unroll
    for (int q = 0; q < 4; ++q) a[g][q] = 0.f;
  for (int k = 0; k < 64; k += 8) {
    float4 wv[8];
#pragma unroll
    for (int e = 0; e < 8; ++e) wv[e] = *(const float4*)(w + (size_t)(k + e) * 9216);
#pragma unroll
    for (int e = 0; e < 8; ++e) {
      int kk = kg * 64 + k + e;
#pragma unroll
      for (int g = 0; g < 3; ++g) {
        float sv = sc[g * 1024 + kk];
        a[g][0] = fmaf(sv, wv[e].x, a[g][0]); a[g][1] = fmaf(sv, wv[e].y, a[g][1]);
        a[g][2] = fmaf(sv, wv[e].z, a[g][2]); a[g][3] = fmaf(sv, wv[e].w, a[g][3]);
      }
    }
  }
#pragma unroll
  for (int g = 0; g < 3; ++g)
#pragma unroll
    for (int q = 0; q < 4; ++q) red[(kg * 3 + g) * 64 + c4 * 4 + q] = a[g][q];
  __syncthreads();
  if (tid < 192) {
    int g = tid >> 6, c2 = tid & 63;
    float s = 0.f;
#pragma unroll
    for (int q = 0; q < 16; ++q) s += red[(q * 3 + g) * 64 + c2];
    int j = cb * 64 + c2;
    p.mod[(size_t)(l * 3 + g) * 9216 + j] = s + p.b_mod[l * 9216 + j];
  }
  __syncthreads();
}

__device__ __forceinline__ int conv_layer_count(int l) { return (l & 1) ? 1272 : 1340; }
__device__ __forceinline__ void conv_layer_task(PRM p, int l, int u, float* sm) {
  const float* src; u16* dst; int K, N, Npad, perm = 0, tp, mat0;
  const int eo = l >> 1;
  const int nin = (l & 1) ? 152 : 168;
  if (u < 704) { K = 1024; N = 5632; Npad = 5632; perm = 1; tp = 352; src = p.ffn_in; dst = p.wt_ffn_in; mat0 = l * 2; }
  else if ((u -= 704) < 352) { K = 2816; N = 1024; Npad = 1024; tp = 176; src = p.ffn_out; dst = p.wt_ffn_out; mat0 = l * 2; }
  else if ((u -= 352) < nin) {
    if (l & 1) { K = 1024; N = 2320; Npad = 2432; tp = 152; src = p.w_in_odd; dst = p.wt_in_o; mat0 = eo; }
    else { K = 1024; N = 2592; Npad = 2688; tp = 168; src = p.w_in_even; dst = p.wt_in_e; mat0 = eo; }
  }
  else if ((u -= nin) < 64) { K = 1024; N = 1024; Npad = 1024; tp = 64; src = p.w_out; dst = p.wt_out; mat0 = l; }
  else if ((u -= 64) < 36) { K = 768; N = 768; Npad = 768; tp = 36; src = p.b_wq_up; dst = p.wt_qup; mat0 = eo; }
  else { u -= 36; K = 256; N = 1024; Npad = 1024; tp = 16; src = p.b_wkv_up; dst = p.wt_kvup; mat0 = eo; }
  int mat = mat0 + u / tp, r = u % tp;
  int nkt = K / 256;
  int kt = r % nkt, nt = r / nkt;
  conv_tile(src + (size_t)mat * K * N, K, N, perm, dst + (size_t)mat * Npad * K, kt, nt, sm);
}

__device__ __forceinline__ void phase0(PRM p, char* smem) {
  float* sm = (float*)smem;
  const int NMOD = 144, NCOPY = 0, NCONV = 1340;
  const int total = NMOD + NCOPY + NCONV;
  for (int t = get_bid(); t < total; t += vgrid()) {
    if (t < NMOD) { mod_task(p, t, sm); continue; }
    int u = t - NMOD;
    if (u < NCOPY) {
      const int tid = get_tid();
#pragma unroll
      for (int i = 0; i < 4; ++i) {
        size_t idx = ((size_t)u * 1024 + i * 256 + tid);
        const float4* src = idx < (size_t)NPR * 256 ? (const float4*)p.x_prompt + idx : (const float4*)p.x_sample + (idx - (size_t)NPR * 256);
        ((float4*)p.x)[idx] = *src;
      }
      continue;
    }
    conv_layer_task(p, 0, u - NCOPY, sm);
  }
}

__device__ __forceinline__ void norm_phase(PRM p, int l, int which) {
  const int lane = get_tid() & 63, wave = get_tid() >> 6;
  const int nrows_wave = NTOK / 4;
  const int stride = vgrid();
  for (int t0 = get_bid(); t0 < nrows_wave; t0 += 3 * stride) {
    float4 v[3][4];
    float ss[3];
#pragma unroll
    for (int k = 0; k < 3; ++k) {
      const int t = t0 + k * stride;
      if (t < nrows_wave) {
        const int mm = t * 4 + wave;
        const float* xsrc = (l == 0 && which == 0) ? (mm < NPR ? p.x_prompt + (size_t)mm * 1024 : p.x_sample + (size_t)(mm - NPR) * 1024) : p.x + (size_t)mm * 1024;
        const float4* xr = (const float4*)xsrc;
#pragma unroll
        for (int i = 0; i < 4; ++i) v[k][i] = xr[i * 64 + lane];
      }
    }
#pragma unroll
    for (int k = 0; k < 3; ++k) {
      float a = 0.f;
#pragma unroll
      for (int i = 0; i < 4; ++i) a += v[k][i].x * v[k][i].x + v[k][i].y * v[k][i].y + v[k][i].z * v[k][i].z + v[k][i].w * v[k][i].w;
      ss[k] = wsum(a);
    }
#pragma unroll
    for (int k = 0; k < 3; ++k) {
      const int t = t0 + k * stride;
      if (t >= nrows_wave) continue;
      const int m = t * 4 + wave;
      const float r = rsqrtf(ss[k] * (1.f / 1024.f) + EPS);
      if (which == 3) {
        float4* o = (float4*)(p.out + (size_t)m * 1024);
#pragma unroll
        for (int i = 0; i < 4; ++i) {
          float4 g = ((const float4*)p.final_norm)[i * 64 + lane];
          float4 y; y.x = v[k][i].x * r * g.x; y.y = v[k][i].y * r * g.y; y.z = v[k][i].z * r * g.z; y.w = v[k][i].w * r * g.w;
          o[i * 64 + lane] = y;
        }
      } else {
        const float* md = p.mod + (size_t)(l * 3 + grp_of(m)) * 9216 + which * 3072;
        const float4* sh = (const float4*)md;
        const float4* sc = (const float4*)(md + 1024);
        const float4* gg = (const float4*)(p.norm_g + (size_t)(l * 3 + which) * 1024);
#pragma unroll
        for (int i = 0; i < 4; ++i) {
          float4 g = gg[i * 64 + lane], s = sc[i * 64 + lane], b = sh[i * 64 + lane];
          float y0 = v[k][i].x * r * g.x * (1.f + s.x) + b.x;
          float y1 = v[k][i].y * r * g.y * (1.f + s.y) + b.y;
          float y2 = v[k][i].z * r * g.z * (1.f + s.z) + b.z;
          float y3 = v[k][i].w * r * g.w * (1.f + s.w) + b.w;
          uint2 o; o.x = pack2(y0, y1); o.y = pack2(y2, y3);
          *(uint2*)(p.xn + (size_t)m * 1024 + (i * 64 + lane) * 4) = o;
        }
      }
    }
  }
}

struct EpiP {
  float* C; int ldc;
  const float* gate;
  u16* H;
  u16 *kb, *vtp, *vts; int ctx;
};
enum { EPI_STORE = 0, EPI_RESID = 1, EPI_SWIGLU = 2, EPI_KVUP = 3 };

template <int FI, int FJ, bool SWAP>
__device__ __forceinline__ void g_compute(f32x4 (&acc)[FI][FJ], const u16* Ac, const u16* Bc, int q4, int rsw) {
  __builtin_amdgcn_s_setprio(1);
#pragma unroll
  for (int ks = 0; ks < 2; ++ks) {
    const int co = ((ks * 4 + q4) ^ rsw) << 3;
#pragma unroll
    for (int j0 = 0; j0 < FJ; j0 += 4) {
      bf16x8 b[4];
#pragma unroll
      for (int j = 0; j < 4; ++j) if (j0 + j < FJ) b[j] = *(const bf16x8*)(Bc + (j0 + j) * 1024 + co);
#pragma unroll
      for (int i0 = 0; i0 < FI; i0 += 4) {
        bf16x8 a[4];
#pragma unroll
        for (int i = 0; i < 4; ++i) if (i0 + i < FI) a[i] = *(const bf16x8*)(Ac + (i0 + i) * 1024 + co);
#pragma unroll
        for (int j = 0; j < 4; ++j)
          if (j0 + j < FJ) {
#pragma unroll
            for (int i = 0; i < 4; ++i)
              if (i0 + i < FI) acc[i0 + i][j0 + j] = SWAP ? mfma16(b[j], a[i], acc[i0 + i][j0 + j]) : mfma16(a[i], b[j], acc[i0 + i][j0 + j]);
          }
      }
    }
  }
  __builtin_amdgcn_s_setprio(0);
}

template <int EPI, int WMW, int WNW, int FI, int FJ, int DEPTH>
__device__ __forceinline__ void gemm_tile(const u16* __restrict__ A, const u16* __restrict__ Wt, int K, int tm, int tn, const EpiP& e, char* smem) {
  constexpr int BM = WMW * FI * 16, BN = WNW * FJ * 16;
  constexpr int NA = BM / 64, NB = BN / 64;
  constexpr int BUFSZ = (BM + BN) * 64;
  static_assert(WMW * WNW == 8 && BM % 64 == 0 && BN % 64 == 0, "tile");
  u16* As = (u16*)smem;
  u16* Bs = As + BM * 64;
  const int tid = rtid(), lane = tid & 63, wave = tid >> 6, wm = wave / WNW, wn = wave % WNW, l15 = lane & 15, q4 = lane >> 4;
  const int lr = tid >> 3, lc = tid & 7;
  const u16* Ag = A + (size_t)(tm * BM + lr) * K + lc * 8;
  const u16* Bg = Wt + (size_t)(tn * BN + lr) * K + lc * 8;
  const int st_off = lr * 64 + ((lc ^ ((lr >> 1) & 7)) << 3);
  const int rsw = (l15 >> 1) & 7;
  const int a_row = (wm * FI * 16 + l15) * 64, b_row = (wn * FJ * 16 + l15) * 64;
  f32x4 acc[FI][FJ];
#pragma unroll
  for (int i = 0; i < FI; ++i)
#pragma unroll
    for (int j = 0; j < FJ; ++j) acc[i][j] = (f32x4){0.f, 0.f, 0.f, 0.f};
  const int nk = K >> 6;
#define GL(RA, RB, KT) { _Pragma("unroll") for (int i = 0; i < NA; ++i) RA[i] = *(const u32x4*)(Ag + (size_t)i * 64 * K + (KT) * 64); \
                         _Pragma("unroll") for (int i = 0; i < NB; ++i) RB[i] = *(const u32x4*)(Bg + (size_t)i * 64 * K + (KT) * 64); }
#define GS(RA, RB, BUF) { _Pragma("unroll") for (int i = 0; i < NA; ++i) *(u32x4*)(As + (BUF) * BUFSZ + st_off + i * 4096) = RA[i]; \
                          _Pragma("unroll") for (int i = 0; i < NB; ++i) *(u32x4*)(Bs + (BUF) * BUFSZ + st_off + i * 4096) = RB[i]; }
  if constexpr (DEPTH == 4) {
    static_assert(WMW == 4 && WNW == 2 && FJ == 4 && (FI == 3 || FI == 4), "ring4 tile");
    constexpr int ST = (BM + BN) * 32;
    const int nk32 = K >> 5;
    const int fs = (-(tid >> 4)) & 3;
    const int sc = ((tid & 3) ^ fs) << 3;
    const int r4 = tid >> 2;
    const bool three = (BM == 256) || (tid < 256);
    const u16* sp0 = A + (size_t)(tm * BM + r4) * K + sc;
    const int lo0 = tid * 8;
    const u16* sp1; int lo1; const u16* sp2; int lo2;
    if (BM == 256) {
      sp1 = A + (size_t)(tm * BM + 128 + r4) * K + sc;  lo1 = (tid + 512) * 8;
      sp2 = Wt + (size_t)(tn * BN + r4) * K + sc;       lo2 = BM * 32 + tid * 8;
    } else if (tid < 256) {
      sp1 = A + (size_t)(tm * BM + 128 + r4) * K + sc;  lo1 = (tid + 512) * 8;
      sp2 = Wt + (size_t)(tn * BN + 64 + r4) * K + sc;  lo2 = BM * 32 + (tid + 256) * 8;
    } else {
      sp1 = Wt + (size_t)(tn * BN + (r4 - 64)) * K + sc; lo1 = BM * 32 + (tid - 256) * 8;
      sp2 = sp1; lo2 = lo1;
    }
    const int fr = (-(l15 >> 2)) & 3;
    const int co3 = (q4 ^ fr) << 3;
    const int a_row3 = (wm * FI * 16 + l15) * 32 + co3, b_row3 = BM * 32 + (wn * FJ * 16 + l15) * 32 + co3;
    const unsigned lbase = (unsigned)(size_t)As;
#define GD4(KT, BUF) { __builtin_amdgcn_global_load_lds((const unsigned*)(sp0 + (KT) * 32), (unsigned*)(As + (BUF) * ST + lo0), 16, 0, 0); \
                       __builtin_amdgcn_global_load_lds((const unsigned*)(sp1 + (KT) * 32), (unsigned*)(As + (BUF) * ST + lo1), 16, 0, 0); \
                       if (three) __builtin_amdgcn_global_load_lds((const unsigned*)(sp2 + (KT) * 32), (unsigned*)(As + (BUF) * ST + lo2), 16, 0, 0); }
    asm volatile("s_waitcnt vmcnt(0)" ::: "memory");
    GD4(0, 0);
    if (nk32 > 1) GD4(1, 1);
    if (nk32 > 2) GD4(2, 2);
#define RING4_STEP(J) { \
      const int kt = kt0 + (J); \
      if (kt + 2 < nk32) { if (three) asm volatile("s_waitcnt vmcnt(6)" ::: "memory"); else asm volatile("s_waitcnt vmcnt(4)" ::: "memory"); } \
      else if (kt + 1 < nk32) { if (three) asm volatile("s_waitcnt vmcnt(3)" ::: "memory"); else asm volatile("s_waitcnt vmcnt(2)" ::: "memory"); } \
      else asm volatile("s_waitcnt vmcnt(0)" ::: "memory"); \
      asm volatile("s_waitcnt lgkmcnt(0)" ::: "memory"); \
      __builtin_amdgcn_s_barrier(); \
      asm volatile("" ::: "memory"); \
      const unsigned aad = lbase + (unsigned)(((J) * ST + a_row3) * 2); \
      const unsigned bad = lbase + (unsigned)(((J) * ST + b_row3) * 2); \
      bf16x8 b0, b1, b2, b3, a0, a1, a2, a3; \
      asm volatile("ds_read_b128 %0, %1" : "=v"(b0) : "v"(bad)); \
      asm volatile("ds_read_b128 %0, %1 offset:1024" : "=v"(b1) : "v"(bad)); \
      asm volatile("ds_read_b128 %0, %1 offset:2048" : "=v"(b2) : "v"(bad)); \
      asm volatile("ds_read_b128 %0, %1 offset:3072" : "=v"(b3) : "v"(bad)); \
      asm volatile("ds_read_b128 %0, %1" : "=v"(a0) : "v"(aad)); \
      asm volatile("ds_read_b128 %0, %1 offset:1024" : "=v"(a1) : "v"(aad)); \
      asm volatile("ds_read_b128 %0, %1 offset:2048" : "=v"(a2) : "v"(aad)); \
      if (FI == 4) { asm volatile("ds_read_b128 %0, %1 offset:3072" : "=v"(a3) : "v"(aad)); \
        asm volatile("s_waitcnt lgkmcnt(0)" : "+v"(b0), "+v"(b1), "+v"(b2), "+v"(b3), "+v"(a0), "+v"(a1), "+v"(a2), "+v"(a3)); } \
      else { asm volatile("s_waitcnt lgkmcnt(0)" : "+v"(b0), "+v"(b1), "+v"(b2), "+v"(b3), "+v"(a0), "+v"(a1), "+v"(a2)); a3 = a2; } \
      __builtin_amdgcn_s_setprio(1); \
      { bf16x8 bb[4] = {b0, b1, b2, b3}; bf16x8 aa[4] = {a0, a1, a2, a3}; \
        _Pragma("unroll") for (int j = 0; j < 4; ++j) \
          _Pragma("unroll") for (int i = 0; i < FI; ++i) acc[i][j] = mfma16(bb[j], aa[i], acc[i][j]); } \
      __builtin_amdgcn_s_setprio(0); \
      if (kt + 3 < nk32) GD4(kt + 3, ((J) + 3) & 3);     \
      }
    for (int kt0 = 0; kt0 < nk32; kt0 += 4) {
      RING4_STEP(0) RING4_STEP(1) RING4_STEP(2) RING4_STEP(3)
    }
#undef RING4_STEP
#undef GD4
    __syncthreads();
  } else if constexpr (DEPTH == 3) {
    constexpr int ST = (BM + BN) * 32;
    constexpr int NA4 = BM * 4 / 512, NB4 = BN * 4 / 512;
    const int nk32 = K >> 5;
    const int fs = (-(tid >> 4)) & 3;
    const u16* Ad = A + (size_t)(tm * BM + (tid >> 2)) * K + (((tid & 3) ^ fs) << 3);
    const u16* Bd = Wt + (size_t)(tn * BN + (tid >> 2)) * K + (((tid & 3) ^ fs) << 3);
    u16* Al = As + tid * 8;
    u16* Bl = As + BM * 32 + tid * 8;
    const int fr = (-(l15 >> 2)) & 3;
    const int co3 = (q4 ^ fr) << 3;
    const int a_row3 = (wm * FI * 16 + l15) * 32 + co3, b_row3 = BM * 32 + (wn * FJ * 16 + l15) * 32 + co3;
    static_assert(FI == 8 && FJ == 4, "ring path is written for 8x4 fragments per wave");
    const unsigned lbase = (unsigned)(size_t)As;
#define GD3P(PA, PB, KT, BUF) { _Pragma("unroll") for (int i = 0; i < NA4; ++i) __builtin_amdgcn_global_load_lds((const unsigned*)((PA) + (size_t)i * 128 * K + (KT) * 32), (unsigned*)(Al + (BUF) * ST + i * 4096), 16, 0, 0); \
                               _Pragma("unroll") for (int i = 0; i < NB4; ++i) __builtin_amdgcn_global_load_lds((const unsigned*)((PB) + (size_t)i * 128 * K + (KT) * 32), (unsigned*)(Bl + (BUF) * ST + i * 4096), 16, 0, 0); }
#define GD3(KT, BUF) GD3P(Ad, Bd, KT, BUF)
    asm volatile("s_waitcnt vmcnt(0)" ::: "memory");
    if (!(e.ctx & 1)) {
      GD3(0, 0);
      if (nk32 > 1) GD3(1, 1);
      if (nk32 > 2) GD3(2, 2);
    }
#define RING_STEP(J) { \
      const int kt = kt0 + (J); \
      if (kt + 2 < nk32) asm volatile("s_waitcnt vmcnt(%0)" :: "n"(2 * (NA4 + NB4)) : "memory"); \
      else if (kt + 1 < nk32) asm volatile("s_waitcnt vmcnt(%0)" :: "n"(NA4 + NB4) : "memory"); \
      else asm volatile("s_waitcnt vmcnt(0)" ::: "memory"); \
      asm volatile("s_waitcnt lgkmcnt(0)" ::: "memory"); \
      __builtin_amdgcn_s_barrier(); \
      asm volatile("" ::: "memory"); \
      const unsigned aad = lbase + (unsigned)(((J) * ST + a_row3) * 2); \
      const unsigned bad = lbase + (unsigned)(((J) * ST + b_row3) * 2); \
      bf16x8 b0, b1, b2, b3, a0, a1, a2, a3; \
      asm volatile("ds_read_b128 %0, %1" : "=v"(b0) : "v"(bad)); \
      asm volatile("ds_read_b128 %0, %1 offset:1024" : "=v"(b1) : "v"(bad)); \
      asm volatile("ds_read_b128 %0, %1 offset:2048" : "=v"(b2) : "v"(bad)); \
      asm volatile("ds_read_b128 %0, %1 offset:3072" : "=v"(b3) : "v"(bad)); \
      asm volatile("ds_read_b128 %0, %1" : "=v"(a0) : "v"(aad)); \
      asm volatile("ds_read_b128 %0, %1 offset:1024" : "=v"(a1) : "v"(aad)); \
      asm volatile("ds_read_b128 %0, %1 offset:2048" : "=v"(a2) : "v"(aad)); \
      asm volatile("ds_read_b128 %0, %1 offset:3072" : "=v"(a3) : "v"(aad)); \
      __builtin_amdgcn_s_setprio(1); \
      asm volatile("s_waitcnt lgkmcnt(3)" : "+v"(b0), "+v"(b1), "+v"(b2), "+v"(b3), "+v"(a0)); \
      acc[0][0] = mfma16(b0, a0, acc[0][0]); acc[0][1] = mfma16(b1, a0, acc[0][1]); acc[0][2] = mfma16(b2, a0, acc[0][2]); acc[0][3] = mfma16(b3, a0, acc[0][3]); \
      asm volatile("s_waitcnt lgkmcnt(2)" : "+v"(a1)); \
      acc[1][0] = mfma16(b0, a1, acc[1][0]); acc[1][1] = mfma16(b1, a1, acc[1][1]); acc[1][2] = mfma16(b2, a1, acc[1][2]); acc[1][3] = mfma16(b3, a1, acc[1][3]); \
      asm volatile("s_waitcnt lgkmcnt(1)" : "+v"(a2)); \
      acc[2][0] = mfma16(b0, a2, acc[2][0]); acc[2][1] = mfma16(b1, a2, acc[2][1]); acc[2][2] = mfma16(b2, a2, acc[2][2]); acc[2][3] = mfma16(b3, a2, acc[2][3]); \
      asm volatile("s_waitcnt lgkmcnt(0)" : "+v"(a3)); \
      acc[3][0] = mfma16(b0, a3, acc[3][0]); acc[3][1] = mfma16(b1, a3, acc[3][1]); acc[3][2] = mfma16(b2, a3, acc[3][2]); acc[3][3] = mfma16(b3, a3, acc[3][3]); \
      if (kt + 3 < nk32) GD3(kt + 3, ((J) + 3) & 3);     \
      asm volatile("ds_read_b128 %0, %1 offset:4096" : "=v"(a0) : "v"(aad)); \
      asm volatile("ds_read_b128 %0, %1 offset:5120" : "=v"(a1) : "v"(aad)); \
      asm volatile("ds_read_b128 %0, %1 offset:6144" : "=v"(a2) : "v"(aad)); \
      asm volatile("ds_read_b128 %0, %1 offset:7168" : "=v"(a3) : "v"(aad)); \
      asm volatile("s_waitcnt lgkmcnt(3)" : "+v"(a0), "+v"(b0), "+v"(b1), "+v"(b2), "+v"(b3)); \
      acc[4][0] = mfma16(b0, a0, acc[4][0]); acc[4][1] = mfma16(b1, a0, acc[4][1]); acc[4][2] = mfma16(b2, a0, acc[4][2]); acc[4][3] = mfma16(b3, a0, acc[4][3]); \
      asm volatile("s_waitcnt lgkmcnt(2)" : "+v"(a1)); \
      acc[5][0] = mfma16(b0, a1, acc[5][0]); acc[5][1] = mfma16(b1, a1, acc[5][1]); acc[5][2] = mfma16(b2, a1, acc[5][2]); acc[5][3] = mfma16(b3, a1, acc[5][3]); \
      asm volatile("s_waitcnt lgkmcnt(1)" : "+v"(a2)); \
      acc[6][0] = mfma16(b0, a2, acc[6][0]); acc[6][1] = mfma16(b1, a2, acc[6][1]); acc[6][2] = mfma16(b2, a2, acc[6][2]); acc[6][3] = mfma16(b3, a2, acc[6][3]); \
      asm volatile("s_waitcnt lgkmcnt(0)" : "+v"(a3)); \
      acc[7][0] = mfma16(b0, a3, acc[7][0]); acc[7][1] = mfma16(b1, a3, acc[7][1]); acc[7][2] = mfma16(b2, a3, acc[7][2]); acc[7][3] = mfma16(b3, a3, acc[7][3]); \
      __builtin_amdgcn_s_setprio(0); }
    for (int kt0 = 0; kt0 < nk32; kt0 += 4) {
      RING_STEP(0) RING_STEP(1) RING_STEP(2) RING_STEP(3)
    }
#undef RING_STEP
    __syncthreads();
    if (e.ldc) {
      const int nx = e.ldc - 1;
      const u16* Ad2 = A + (size_t)((nx & 255) * BM + (tid >> 2)) * K + (((tid & 3) ^ fs) << 3);
      const u16* Bd2 = Wt + (size_t)((nx >> 8) * BN + (tid >> 2)) * K + (((tid & 3) ^ fs) << 3);
      GD3P(Ad2, Bd2, 0, 0);
      if (nk32 > 1) GD3P(Ad2, Bd2, 1, 1);
      if (nk32 > 2) GD3P(Ad2, Bd2, 2, 2);
    }
#undef GD3
#undef GD3P
  } else if constexpr (DEPTH == 0) {
    const int swz = (lr >> 1) & 7;
    const u16* Ad = A + (size_t)(tm * BM + lr) * K + ((lc ^ swz) << 3);
    const u16* Bd = Wt + (size_t)(tn * BN + lr) * K + ((lc ^ swz) << 3);
    u16* Al = As + tid * 8;
    u16* Bl = Bs + tid * 8;
#define GD(KT, BUF) { _Pragma("unroll") for (int i = 0; i < NA; ++i) __builtin_amdgcn_global_load_lds((const unsigned*)(Ad + (size_t)i * 64 * K + (KT) * 64), (unsigned*)(Al + (BUF) * BUFSZ + i * 4096), 16, 0, 0); \
                      _Pragma("unroll") for (int i = 0; i < NB; ++i) __builtin_amdgcn_global_load_lds((const unsigned*)(Bd + (size_t)i * 64 * K + (KT) * 64), (unsigned*)(Bl + (BUF) * BUFSZ + i * 4096), 16, 0, 0); }
    GD(0, 0);
    asm volatile("s_waitcnt vmcnt(0)" ::: "memory");
    __syncthreads();
    for (int kt = 0; kt < nk; kt += 2) {
      if (kt + 1 < nk) GD(kt + 1, 1);
      g_compute<FI, FJ, (EPI != EPI_KVUP)>(acc, As + a_row, Bs + b_row, q4, rsw);
      asm volatile("s_waitcnt vmcnt(0)" ::: "memory");
      __syncthreads();
      if (kt + 1 >= nk) break;
      if (kt + 2 < nk) GD(kt + 2, 0);
      g_compute<FI, FJ, (EPI != EPI_KVUP)>(acc, As + BUFSZ + a_row, Bs + BUFSZ + b_row, q4, rsw);
      asm volatile("s_waitcnt vmcnt(0)" ::: "memory");
      __syncthreads();
    }
#undef GD
  } else if constexpr (DEPTH == 2) {
    u32x4 ra0[NA], rb0[NB], ra1[NA], rb1[NB];
    GL(ra0, rb0, 0);
    if (nk > 1) GL(ra1, rb1, 1);
    GS(ra0, rb0, 0);
    __syncthreads();
    for (int kt = 0; kt < nk; kt += 2) {
      if (kt + 2 < nk) GL(ra0, rb0, kt + 2);
      g_compute<FI, FJ, (EPI != EPI_KVUP)>(acc, As + a_row, Bs + b_row, q4, rsw);
      if (kt + 1 < nk) GS(ra1, rb1, 1);
      __syncthreads();
      if (kt + 1 >= nk) break;
      if (kt + 3 < nk) GL(ra1, rb1, kt + 3);
      g_compute<FI, FJ, (EPI != EPI_KVUP)>(acc, As + BUFSZ + a_row, Bs + BUFSZ + b_row, q4, rsw);
      if (kt + 2 < nk) GS(ra0, rb0, 0);
      __syncthreads();
    }
  } else {
    u32x4 ra0[NA], rb0[NB];
    GL(ra0, rb0, 0);
    GS(ra0, rb0, 0);
    __syncthreads();
    for (int kt = 0; kt < nk; kt += 2) {
      if (kt + 1 < nk) GL(ra0, rb0, kt + 1);
      g_compute<FI, FJ, (EPI != EPI_KVUP)>(acc, As + a_row, Bs + b_row, q4, rsw);
      if (kt + 1 < nk) GS(ra0, rb0, 1);
      __syncthreads();
      if (kt + 1 >= nk) break;
      if (kt + 2 < nk) GL(ra0, rb0, kt + 2);
      g_compute<FI, FJ, (EPI != EPI_KVUP)>(acc, As + BUFSZ + a_row, Bs + BUFSZ + b_row, q4, rsw);
      if (kt + 2 < nk) GS(ra0, rb0, 0);
      __syncthreads();
    }
  }
#undef GL
#undef GS
  const int mb = tm * BM + wm * FI * 16 + q4 * 4;
  const int nb = tn * BN + wn * FJ * 16;
  const int mrow = tm * BM + wm * FI * 16 + l15;
  if (EPI == EPI_STORE) {
#pragma unroll
    for (int i = 0; i < FI; ++i)
#pragma unroll
      for (int j = 0; j < FJ; ++j) *(f32x4*)(e.C + (size_t)(mrow + i * 16) * e.ldc + nb + j * 16 + q4 * 4) = acc[i][j];
  } else if (EPI == EPI_RESID) {
    const float cf = e.ldc ? 0.5f : 1.0f;
    const f32x4 cfv = {cf, cf, cf, cf};
#pragma unroll
    for (int i = 0; i < FI; ++i) {
      const int m = mrow + i * 16;
      const float* gt = e.gate + (size_t)grp_of(m) * 9216;
#pragma unroll
      for (int j = 0; j < FJ; ++j) {
        const int n = nb + j * 16 + q4 * 4;
        f32x4 g = *(const f32x4*)(gt + n);
        f32x4* px = (f32x4*)(e.C + (size_t)m * 1024 + n);
        f32x4 xv;
        if (e.vtp) xv = *(const f32x4*)((m < NPR ? (const float*)e.vtp + (size_t)m * 1024 : (const float*)e.vts + (size_t)(m - NPR) * 1024) + n);
        else xv = *px;
        xv += g * cfv * acc[i][j];
        *px = xv;
      }
    }
  } else if (EPI == EPI_SWIGLU) {
    const bool odd = (q4 & 1) != 0;
#pragma unroll
    for (int j = 0; j < FJ; ++j) {
      const int hj = ((nb >> 4) + j) * 8 + (q4 >> 1) * 4;
#pragma unroll
      for (int i2 = 0; i2 < FI / 2; ++i2) {
        float hv[4];
#pragma unroll
        for (int r = 0; r < 4; ++r) {
          float send = odd ? acc[2 * i2][j][r] : acc[2 * i2 + 1][j][r];
          float recv = shx(send, 16);
          float g = odd ? recv : acc[2 * i2][j][r];
          float u = odd ? acc[2 * i2 + 1][j][r] : recv;
          hv[r] = silu_f(g) * u;
        }
        const int m = mrow + (2 * i2 + (odd ? 1 : 0)) * 16;
        uint2 o; o.x = pack2(hv[0], hv[1]); o.y = pack2(hv[2], hv[3]);
        *(uint2*)(e.H + (size_t)m * 2816 + hj) = o;
      }
    }
  } else if (EPI == EPI_KVUP) {
#pragma unroll
    for (int j = 0; j < FJ; ++j) {
      const int n0 = nb + j * 16;
      const int hh = n0 >> 7, wb = n0 & 127;
#pragma unroll
      for (int i = 0; i < FI; ++i) {
        const int m0 = mb + i * 16;
        int krow; u16* vt;
        if (e.ctx) {
          int b = m0 >> 9, key = m0 & 511;
          krow = NPR + b * 1536 + 1024 + key;
          vt = e.vts + (size_t)((b * 8 + hh) * 64) * 1536 + 1024 + key;
        } else if (m0 < NPR) {
          int b = m0 >> 8, t = m0 & 255;
          krow = m0;
          vt = e.vtp + (size_t)((b * 8 + hh) * 64) * 256 + t;
        } else {
          int s = m0 - NPR, b = s >> 10, t = s & 1023;
          krow = NPR + b * 1536 + t;
          vt = e.vts + (size_t)((b * 8 + hh) * 64) * 1536 + t;
        }
        if (wb < 64) {
#pragma unroll
          for (int r = 0; r < 4; ++r) e.kb[(size_t)(krow + r) * 768 + hh * 96 + wb + l15] = f2bf(acc[i][j][r]);
        } else {
          const int d = wb - 64 + l15;
          const size_t L = (e.ctx || m0 >= NPR) ? 1536 : 256;
          uint2 o; o.x = pack2(acc[i][j][0], acc[i][j][1]); o.y = pack2(acc[i][j][2], acc[i][j][3]);
          *(uint2*)(vt + (size_t)d * L) = o;
        }
      }
    }
  }
}

template <int EPI, int WMW, int WNW, int FI, int FJ, int DEPTH>
__device__ __forceinline__ void gemm_phase(const u16* A, const u16* Wt, int K, int Mt, int Nt, const EpiP& e, char* smem) {
  for (int t = rbid(); t < Mt * Nt; t += (int)gridDim.x) gemm_tile<EPI, WMW, WNW, FI, FJ, DEPTH>(A, Wt, K, t % Mt, t / Mt, e, smem);
}

__device__ __forceinline__ void ffn_in_phase(PRM p, int l, int which, const EpiP& e, char* smem) {
  const u16* Wt = p.wt_ffn_in + (size_t)(l * 2 + which) * 5632 * 1024;
  const int G = (int)gridDim.x;
  const int nfull = (528 / G) * G;
  {
    bool first = true;
    for (int t = rbid(); t < nfull; t += G) {
      EpiP e2 = e;
      const int tnx = t + G;
      e2.ctx = first ? 0 : 1;
      e2.ldc = (tnx < nfull) ? ((tnx % 24) | ((tnx / 24) << 8)) + 1 : 0;
      gemm_tile<EPI_SWIGLU, 2, 4, 8, 4, 3>(p.xn, Wt, 1024, t % 24, t / 24, e2, smem);
      first = false;
    }
  }
  const int nq = (528 - nfull) * 4;
  const int bid = rbid();
  for (int u = bid; u < nq; u += G) {
    const int t = nfull + (u >> 2), sub = u & 3;
    gemm_tile<EPI_SWIGLU, 4, 2, 2, 4, 2>(p.xn, Wt, 1024, (t % 24) * 2 + (sub >> 1), (t / 24) * 2 + (sub & 1), e, smem);
  }
  const int tail = nq < G ? nq : G;
  if (l < 3 && bid >= tail) {
    const int vb = rtid() >> 8;
    char* vsm = smem + vb * LDS_HALF;
    const int nfree = (G - tail) * 2;
    const int vrank = (bid - tail) * 2 + vb;
    const int cnt = conv_layer_count(l + 1);
    const int half = cnt >> 1;
    const int lo = which ? half : 0, hi = which ? cnt : half;
    for (int c = lo + vrank; c < hi; c += nfree) conv_layer_task(p, l + 1, c, (float*)vsm);
    for (int c = vrank; c < 72; c += nfree) mod_task(p, (l + 1) * 144 + which * 72 + c, (float*)vsm);
  }
}

__device__ __forceinline__ void rope_store_kb(PRM p, float val, int lane, int t, bool sample, int krow) {
  float outv = val;
  if (sample) {
    float partner = shx(val, 8);
    int w = lane & 15, fi = w & 7;
    float pos = (float)((lane & 16) ? (t & 63) : (t >> 6));
    float fr = __expf(-9.210340372f * (float)fi * 0.125f);
    float s, c; sincos_r(pos * fr, s, c);
    outv = (w < 8) ? val * c - partner * s : val * c + partner * s;
  }
  if (lane < 32) {
    u16 b = f2bf(outv);
#pragma unroll
    for (int h = 0; h < 8; ++h) p.kb[(size_t)krow * 768 + h * 96 + 64 + lane] = b;
  }
}

__device__ __forceinline__ void post_even(PRM p, int e) {
  const int tid = get_tid(), lane = tid & 63, wave = tid >> 6;
  const int NT = NTOK / 4;
  const int NC = 256;
  for (int task = get_bid(); task < NT + NC; task += vgrid()) {
    if (task < NT) {
      const int m0 = task * 4, m = m0 + wave;
      const bool pr = m < NPR;
      const int b = pr ? (m >> 8) : ((m - NPR) >> 10);
      const int t = pr ? (m & 255) : ((m - NPR) & 1023);
      const float* row = p.proj + (size_t)m * 2688;
      {
        float4 a0 = *(const float4*)(row + lane * 8), a1 = *(const float4*)(row + lane * 8 + 4);
        uint4 o; o.x = pack2(a0.x, a0.y); o.y = pack2(a0.z, a0.w); o.z = pack2(a1.x, a1.y); o.w = pack2(a1.z, a1.w);
        *(uint4*)(p.qa + (size_t)m * 512 + lane * 8) = o;
        float4 k0 = *(const float4*)(row + 512 + lane * 8), k1 = *(const float4*)(row + 512 + lane * 8 + 4);
        o.x = pack2(k0.x, k0.y); o.y = pack2(k0.z, k0.w); o.z = pack2(k1.x, k1.y); o.w = pack2(k1.z, k1.w);
        *(uint4*)(p.ka + (size_t)m * 512 + lane * 8) = o;
        if (pr) {
          float* ok = p.out + O_AK + ((size_t)(b * 2 + e) * 256 + t) * 512 + lane * 8;
          *(float4*)ok = k0; *(float4*)(ok + 4) = k1;
          float4 v0 = *(const float4*)(row + 1024 + lane * 8), v1 = *(const float4*)(row + 1024 + lane * 8 + 4);
          float* ov = p.out + O_AV + ((size_t)(b * 2 + e) * 256 + t) * 512 + lane * 8;
          *(float4*)ov = v0; *(float4*)(ov + 4) = v1;
        }
      }
      {
        float4 c0 = *(const float4*)(row + 1536 + lane * 12), c1 = *(const float4*)(row + 1536 + lane * 12 + 4), c2 = *(const float4*)(row + 1536 + lane * 12 + 8);
        float ss = c0.x * c0.x + c0.y * c0.y + c0.z * c0.z + c0.w * c0.w + c1.x * c1.x + c1.y * c1.y + c1.z * c1.z + c1.w * c1.w +
                   c2.x * c2.x + c2.y * c2.y + c2.z * c2.z + c2.w * c2.w;
        ss = wsum(ss);
        float r = rsqrtf(ss * (1.f / 768.f) + EPS);
        const float* g = p.b_q_norm + e * 768 + lane * 12;
        float4 g0 = *(const float4*)g, g1 = *(const float4*)(g + 4), g2 = *(const float4*)(g + 8);
        uint2 o0, o1, o2;
        o0.x = pack2(c0.x * r * g0.x, c0.y * r * g0.y); o0.y = pack2(c0.z * r * g0.z, c0.w * r * g0.w);
        o1.x = pack2(c1.x * r * g1.x, c1.y * r * g1.y); o1.y = pack2(c1.z * r * g1.z, c1.w * r * g1.w);
        o2.x = pack2(c2.x * r * g2.x, c2.y * r * g2.y); o2.y = pack2(c2.z * r * g2.z, c2.w * r * g2.w);
        u16* d = p.cqn + (size_t)m * 768 + lane * 12;
        *(uint2*)d = o0; *(uint2*)(d + 4) = o1; *(uint2*)(d + 8) = o2;
      }
      {
        float4 c0 = *(const float4*)(row + 2304 + lane * 4);
        float ss = wsum(c0.x * c0.x + c0.y * c0.y + c0.z * c0.z + c0.w * c0.w);
        float r = rsqrtf(ss * (1.f / 256.f) + EPS);
        float4 g0 = *(const float4*)(p.b_kv_norm + e * 256 + lane * 4);
        float4 y; y.x = c0.x * r * g0.x; y.y = c0.y * r * g0.y; y.z = c0.z * r * g0.z; y.w = c0.w * r * g0.w;
        uint2 o; o.x = pack2(y.x, y.y); o.y = pack2(y.z, y.w);
        *(uint2*)(p.ckvn + (size_t)m * 256 + lane * 4) = o;
        if (pr) *(float4*)(p.out + O_CKV + ((size_t)(b * 2 + e) * 256 + t) * 256 + lane * 4) = y;
      }
      {
        float val = row[2560 + (lane & 31)];
        if (pr && lane < 32) p.out[O_KR + ((size_t)(b * 2 + e) * 256 + t) * 32 + lane] = val;
        rope_store_kb(p, val, lane, t, !pr, keyrow(m));
      }
      {
        const bool pr0 = m0 < NPR;
        const int b0 = pr0 ? (m0 >> 8) : ((m0 - NPR) >> 10);
        const int t0 = pr0 ? (m0 & 255) : ((m0 - NPR) & 1023);
#pragma unroll
        for (int i = 0; i < 2; ++i) {
          int pp = tid + 256 * i, h = pp >> 6, d = pp & 63;
          const float* src = p.proj + (size_t)m0 * 2688 + 1024 + h * 64 + d;
          float v0 = src[0], v1 = src[2688], v2 = src[2 * 2688], v3 = src[3 * 2688];
          uint2 o; o.x = pack2(v0, v1); o.y = pack2(v2, v3);
          u16* dst = pr0 ? p.vta_p + (size_t)((b0 * 8 + h) * 64 + d) * 256 + t0 : p.vta_s + (size_t)((b0 * 8 + h) * 64 + d) * 1536 + t0;
          *(uint2*)dst = o;
        }
      }
    } else {
      const int ct = task - NT;
      const int b = ct >> 7, key0 = (ct & 127) * 4;
      {
        const float* src = p.cache_a_k + ((size_t)(b * 2 + e) * 512 + key0) * 512;
        u16* dst = p.kactx + ((size_t)b * 512 + key0) * 512;
#pragma unroll
        for (int i = 0; i < 2; ++i) {
          int idx = (tid + 256 * i) * 4;
          float4 v = *(const float4*)(src + idx);
          uint2 o; o.x = pack2(v.x, v.y); o.y = pack2(v.z, v.w);
          *(uint2*)(dst + idx) = o;
        }
      }
      {
        const float* src = p.cache_a_v + ((size_t)(b * 2 + e) * 512 + key0) * 512;
#pragma unroll
        for (int i = 0; i < 2; ++i) {
          int pp = tid + 256 * i, h = pp >> 6, d = pp & 63;
          float v0 = src[pp], v1 = src[512 + pp], v2 = src[1024 + pp], v3 = src[1536 + pp];
          uint2 o; o.x = pack2(v0, v1); o.y = pack2(v2, v3);
          *(uint2*)(p.vta_s + (size_t)((b * 8 + h) * 64 + d) * 1536 + 1024 + key0) = o;
        }
      }
      {
        const float* src = p.cache_b_ckv + ((size_t)(b * 2 + e) * 512 + key0) * 256;
        float4 v = *(const float4*)(src + tid * 4);
        uint2 o; o.x = pack2(v.x, v.y); o.y = pack2(v.z, v.w);
        *(uint2*)(p.cctxn + ((size_t)b * 512 + key0) * 256 + tid * 4) = o;
      }
      {
        const float* src = p.cache_b_krope + ((size_t)(b * 2 + e) * 512 + key0) * 32;
#pragma unroll
        for (int i = 0; i < 4; ++i) {
          int idx = tid + 256 * i;
          int kk = idx >> 8, h = (idx >> 5) & 7, dd = idx & 31;
          p.kb[(size_t)(NPR + b * 1536 + 1024 + key0 + kk) * 768 + h * 96 + 64 + dd] = f2bf(src[kk * 32 + dd]);
        }
      }
    }
  }
}

__device__ __forceinline__ void post_odd(PRM p, int o) {
  const int tid = get_tid(), lane = tid & 63, wave = tid >> 6;
  const int NT = NTOK / 4, NC = 256;
  for (int task = get_bid(); task < NT + NC; task += vgrid()) {
    if (task < NT) {
      const int m0 = task * 4, m = m0 + wave;
      const bool pr = m < NPR;
      const int b = pr ? (m >> 8) : ((m - NPR) >> 10);
      const int t = pr ? (m & 255) : ((m - NPR) & 1023);
      const float* row = p.proj + (size_t)m * 2432;
      float rs = 0.f, rc = 1.f;
      if (!pr) {
        int w = lane & 31, fi = w & 15;
        float pos = (float)((lane & 32) ? (t & 63) : (t >> 6));
        float fr = __expf(-9.210340372f * (float)fi * (1.f / 16.f));
        sincos_r(pos * fr, rs, rc);
      }
      const bool lo = (lane & 16) == 0;
      const float gq = p.d_q_norm[o * 64 + lane], gk = p.d_k_norm[o * 64 + lane];
#pragma unroll
      for (int hd = 0; hd < 8; ++hd) {
        float v = row[1552 + hd * 64 + lane];
        float ss = wsum(v * v);
        float y = v * rsqrtf(ss * (1.f / 64.f) + EPS) * gq;
        if (!pr) { float pt = shx(y, 16); y = lo ? y * rc - pt * rs : y * rc + pt * rs; }
        p.qa[(size_t)m * 512 + hd * 64 + lane] = f2bf(y);
      }
#pragma unroll
      for (int kh = 0; kh < 2; ++kh) {
        float v = row[2064 + kh * 64 + lane];
        float ss = wsum(v * v);
        float y = v * rsqrtf(ss * (1.f / 64.f) + EPS) * gk;
        if (pr) p.out[O_DK + ((size_t)(b * 2 + o) * 256 + t) * 128 + kh * 64 + lane] = y;
        else { float pt = shx(y, 16); y = lo ? y * rc - pt * rs : y * rc + pt * rs; }
        p.kd[(size_t)keyrow(m) * 128 + kh * 64 + lane] = f2bf(y);
        if (pr) p.out[O_DV + ((size_t)(b * 2 + o) * 256 + t) * 128 + kh * 64 + lane] = row[2192 + kh * 64 + lane];
      }
      if (tid < 128) {
        const bool pr0 = m0 < NPR;
        const int b0 = pr0 ? (m0 >> 8) : ((m0 - NPR) >> 10);
        const int t0 = pr0 ? (m0 & 255) : ((m0 - NPR) & 1023);
        int kh = tid >> 6, d = tid & 63;
        const float* src = p.proj + (size_t)m0 * 2432 + 2192 + tid;
        float v0 = src[0], v1 = src[2432], v2 = src[2 * 2432], v3 = src[3 * 2432];
        uint2 oo; oo.x = pack2(v0, v1); oo.y = pack2(v2, v3);
        u16* dst = pr0 ? p.vtd_p + (size_t)((b0 * 2 + kh) * 64 + d) * 256 + t0 : p.vtd_s + (size_t)((b0 * 2 + kh) * 64 + d) * 1536 + t0;
        *(uint2*)dst = oo;
      }
    } else {
      const int ct = task - NT;
      const int b = ct >> 7, key0 = (ct & 127) * 4;
      {
        const float* src = p.cache_d_k + ((size_t)(b * 2 + o) * 512 + key0) * 128;
        if (tid < 128) {
          float4 v = *(const float4*)(src + tid * 4);
          uint2 oo; oo.x = pack2(v.x, v.y); oo.y = pack2(v.z, v.w);
          *(uint2*)(p.kd + (size_t)(NPR + b * 1536 + 1024 + key0) * 128 + tid * 4) = oo;
        } else {
          int pp = tid - 128, kh = pp >> 6, d = pp & 63;
          const float* sv = p.cache_d_v + ((size_t)(b * 2 + o) * 512 + key0) * 128;
          float v0 = sv[pp], v1 = sv[128 + pp], v2 = sv[256 + pp], v3 = sv[384 + pp];
          uint2 oo; oo.x = pack2(v0, v1); oo.y = pack2(v2, v3);
          *(uint2*)(p.vtd_s + (size_t)((b * 2 + kh) * 64 + d) * 1536 + 1024 + key0) = oo;
        }
      }
    }
  }
}

struct AttnSt { float m, l; f32x4 o[4]; };
template <int KS> struct KVf { bf16x8 k0[KS], k1[KS]; s16x4 v0[4], v1[4]; };

template <int KS>
__device__ __forceinline__ void attn_load(KVf<KS>& f, const u16* __restrict__ Kb, int kstride, const u16* __restrict__ Vtb, int vtstride, int l15, int q4) {
  const u16* k0p = Kb + (size_t)l15 * kstride + q4 * 8;
  const u16* k1p = k0p + (size_t)16 * kstride;
#pragma unroll
  for (int ks = 0; ks < KS; ++ks) { f.k0[ks] = *(const bf16x8*)(k0p + ks * 32); f.k1[ks] = *(const bf16x8*)(k1p + ks * 32); }
#pragma unroll
  for (int dt = 0; dt < 4; ++dt) {
    const u16* vp = Vtb + (size_t)(dt * 16 + l15) * vtstride + q4 * 4;
    f.v0[dt] = *(const s16x4*)vp; f.v1[dt] = *(const s16x4*)(vp + 16);
  }
}

template <int KS>
__device__ __forceinline__ void attn_comp(AttnSt& st, const bf16x8 (&qf)[KS], const KVf<KS>& f, float scale, int q4,
                                          bool masked, const float* rpbrow, int qc, int kc0) {
  f32x4 s0 = {0.f, 0.f, 0.f, 0.f}, s1 = {0.f, 0.f, 0.f, 0.f};
#pragma unroll
  for (int ks = 0; ks < KS; ++ks) { s0 = mfma16(f.k0[ks], qf[ks], s0); s1 = mfma16(f.k1[ks], qf[ks], s1); }
  float sv[8];
#pragma unroll
  for (int j = 0; j < 4; ++j) { sv[j] = s0[j] * scale; sv[4 + j] = s1[j] * scale; }
  if (masked) {
    const int cs = min(max(qc - 8, 0), 48);
#pragma unroll
    for (int e = 0; e < 8; ++e) {
      int kc = kc0 + (e >> 2) * 16 + q4 * 4 + (e & 3);
      bool ok = (kc >= cs) && (kc < cs + 16);
      int di = min(max(kc - qc, -15), 15) + 15;
      sv[e] = ok ? sv[e] + rpbrow[di] : -INFINITY;
    }
  }
  float mx = sv[0];
#pragma unroll
  for (int e = 1; e < 8; ++e) mx = fmaxf(mx, sv[e]);
  mx = fmaxf(mx, shx(mx, 16));
  mx = fmaxf(mx, shx(mx, 32));
  const float mnew = fmaxf(st.m, mx);
  const float alpha = __expf(st.m - mnew);
  float pe[8], ls = 0.f;
#pragma unroll
  for (int e = 0; e < 8; ++e) { pe[e] = __expf(sv[e] - mnew); ls += pe[e]; }
  st.l = st.l * alpha + ls;
  st.m = mnew;
  bf16x8 pf;
#pragma unroll
  for (int e = 0; e < 8; ++e) pf[e] = (short)f2bf(pe[e]);
#pragma unroll
  for (int dt = 0; dt < 4; ++dt) {
    bf16x8 vf = (bf16x8){f.v0[dt].x, f.v0[dt].y, f.v0[dt].z, f.v0[dt].w, f.v1[dt].x, f.v1[dt].y, f.v1[dt].z, f.v1[dt].w};
    st.o[dt] *= alpha;
    st.o[dt] = mfma16(vf, pf, st.o[dt]);
  }
}

__device__ __forceinline__ void attn_init(AttnSt& st) {
  st.m = -1e30f; st.l = 0.f;
#pragma unroll
  for (int dt = 0; dt < 4; ++dt) st.o[dt] = (f32x4){0.f, 0.f, 0.f, 0.f};
}
__device__ __forceinline__ void attn_fin(AttnSt& st, u16* outp  , int l15, int q4) {
  float lt = st.l;
  lt += shx(lt, 16);
  lt += shx(lt, 32);
  const float inv = 1.f / lt;
#pragma unroll
  for (int dt = 0; dt < 4; ++dt) {
    uint2 o; o.x = pack2(st.o[dt][0] * inv, st.o[dt][1] * inv); o.y = pack2(st.o[dt][2] * inv, st.o[dt][3] * inv);
    *(uint2*)(outp + (size_t)l15 * 1024 + dt * 16 + q4 * 4) = o;
  }
}

#define AT_VSTR 72
template <int KS> struct ATile { static constexpr int KSTR = KS * 32 + 8; static constexpr int BUF = 64 * (KS * 32 + 8) + 64 * AT_VSTR; };
template <int KS> struct AStage { u32x4 k[KS]; u32x4 v[2]; };

template <int KS>
__device__ __forceinline__ void at_load(AStage<KS>& r, const u16* __restrict__ Kg, int kstride, const u16* __restrict__ Vg, int vtstride, int tid) {
#pragma unroll
  for (int i = 0; i < KS; ++i) {
    int c = tid + 256 * i; int row = c / (KS * 4), ch = c - row * (KS * 4);
    r.k[i] = *(const u32x4*)(Kg + (unsigned)(row * kstride + ch * 8));
  }
#pragma unroll
  for (int i = 0; i < 2; ++i) {
    int c = tid + 256 * i; int row = c >> 3, ch = c & 7;
    r.v[i] = *(const u32x4*)(Vg + (unsigned)(row * vtstride + ch * 8));
  }
}
template <int KS>
__device__ __forceinline__ void at_store(const AStage<KS>& r, u16* buf, int tid) {
  u16* Ks = buf; u16* Vs = buf + 64 * ATile<KS>::KSTR;
#pragma unroll
  for (int i = 0; i < KS; ++i) {
    int c = tid + 256 * i; int row = c / (KS * 4), ch = c - row * (KS * 4);
    *(u32x4*)(Ks + row * ATile<KS>::KSTR + ch * 8) = r.k[i];
  }
#pragma unroll
  for (int i = 0; i < 2; ++i) {
    int c = tid + 256 * i; int row = c >> 3, ch = c & 7;
    *(u32x4*)(Vs + row * AT_VSTR + ch * 8) = r.v[i];
  }
}

template <int KS>
__device__ __forceinline__ void at_comp(AttnSt& st, const bf16x8 (&qf)[KS], const u16* buf, float scale, int l15, int q4,
                                        bool masked, const float* rpbrow, int qc) {
  const u16* Ks = buf; const u16* Vs = buf + 64 * ATile<KS>::KSTR;
  f32x4 s[4];
#pragma unroll
  for (int kt = 0; kt < 4; ++kt) {
    s[kt] = (f32x4){0.f, 0.f, 0.f, 0.f};
#pragma unroll
    for (int ks = 0; ks < KS; ++ks) {
      bf16x8 a = *(const bf16x8*)(Ks + (kt * 16 + l15) * ATile<KS>::KSTR + ks * 32 + q4 * 8);
      s[kt] = mfma16(a, qf[ks], s[kt]);
    }
  }
  float sv[16];
  const float sc2 = scale * 1.4426950408889634f;
#pragma unroll
  for (int kt = 0; kt < 4; ++kt)
#pragma unroll
    for (int j = 0; j < 4; ++j) sv[kt * 4 + j] = s[kt][j] * sc2;
  if (masked) {
    const int cs = min(max(qc - 8, 0), 48);
#pragma unroll
    for (int e = 0; e < 16; ++e) {
      int kc = (e >> 2) * 16 + q4 * 4 + (e & 3);
      bool ok = (kc >= cs) && (kc < cs + 16);
      int di = min(max(kc - qc, -15), 15) + 15;
      sv[e] = ok ? sv[e] + rpbrow[di] : -INFINITY;
    }
  }
  float mx = sv[0];
#pragma unroll
  for (int e = 1; e < 16; ++e) mx = fmaxf(mx, sv[e]);
  mx = fmaxf(mx, shx(mx, 16));
  mx = fmaxf(mx, shx(mx, 32));
  const float mnew = fmaxf(st.m, mx);
  const float alpha = __builtin_amdgcn_exp2f(st.m - mnew);
  float ls = 0.f;
#pragma unroll
  for (int e = 0; e < 16; ++e) { sv[e] = __builtin_amdgcn_exp2f(sv[e] - mnew); ls += sv[e]; }
  st.l = st.l * alpha + ls;
  st.m = mnew;
  bf16x8 pf[2];
#pragma unroll
  for (int hf = 0; hf < 2; ++hf) {
    u32x4 pw;
    pw[0] = pack2(sv[hf * 8 + 0], sv[hf * 8 + 1]); pw[1] = pack2(sv[hf * 8 + 2], sv[hf * 8 + 3]);
    pw[2] = pack2(sv[hf * 8 + 4], sv[hf * 8 + 5]); pw[3] = pack2(sv[hf * 8 + 6], sv[hf * 8 + 7]);
    pf[hf] = __builtin_bit_cast(bf16x8, pw);
  }
#pragma unroll
  for (int dt = 0; dt < 4; ++dt) {
    st.o[dt] *= alpha;
#pragma unroll
    for (int hf = 0; hf < 2; ++hf) {
      const u16* vp = Vs + (dt * 16 + l15) * AT_VSTR + hf * 32 + q4 * 4;
      s16x4 v0 = *(const s16x4*)vp;
      s16x4 v1 = *(const s16x4*)(vp + 16);
      bf16x8 vf = (bf16x8){v0.x, v0.y, v0.z, v0.w, v1.x, v1.y, v1.z, v1.w};
      st.o[dt] = mfma16(vf, pf[hf], st.o[dt]);
    }
  }
}

template <int KS>
__device__ __forceinline__ void at_run_plain(AttnSt& st, const bf16x8 (&qf)[KS], const u16* Kbase, int kstride, const u16* Vbase, int vtstride,
                                             int nt, float scale, u16* lds, int tid, int l15, int q4) {
  AStage<KS> r0, r1;
  at_load<KS>(r0, Kbase, kstride, Vbase, vtstride, tid);
  if (nt > 1) at_load<KS>(r1, Kbase + (size_t)64 * kstride, kstride, Vbase + 64, vtstride, tid);
  at_store<KS>(r0, lds, tid);
  __syncthreads();
  for (int t = 0; t < nt; t += 2) {
    if (t + 2 < nt) at_load<KS>(r0, Kbase + (size_t)(t + 2) * 64 * kstride, kstride, Vbase + (t + 2) * 64, vtstride, tid);
    at_comp<KS>(st, qf, lds, scale, l15, q4, false, nullptr, 0);
    if (t + 1 < nt) at_store<KS>(r1, lds + ATile<KS>::BUF, tid);
    __syncthreads();
    if (t + 1 >= nt) break;
    if (t + 3 < nt) at_load<KS>(r1, Kbase + (size_t)(t + 3) * 64 * kstride, kstride, Vbase + (t + 3) * 64, vtstride, tid);
    at_comp<KS>(st, qf, lds + ATile<KS>::BUF, scale, l15, q4, false, nullptr, 0);
    if (t + 2 < nt) at_store<KS>(r0, lds, tid);
    __syncthreads();
  }
}

__device__ __forceinline__ void load_q64(bf16x8 (&qf)[2], const u16* Q, int qstride, int l15, int q4) {
#pragma unroll
  for (int ks = 0; ks < 2; ++ks) qf[ks] = *(const bf16x8*)(Q + (size_t)l15 * qstride + ks * 32 + q4 * 8);
}
__device__ __forceinline__ void load_q_mla(bf16x8 (&qf)[3], const float* Qf, int l15, int q4, bool sample, int t0) {
  const float* qr = Qf + (size_t)l15 * 768 + q4 * 8;
#pragma unroll
  for (int ks = 0; ks < 3; ++ks) {
    float4 a = *(const float4*)(qr + ks * 32), b = *(const float4*)(qr + ks * 32 + 4);
    float v[8] = {a.x, a.y, a.z, a.w, b.x, b.y, b.z, b.w};
    if (ks == 2 && sample) {
      const int t = t0 + l15;
      const float pos = (float)((q4 & 2) ? (t & 63) : (t >> 6));
#pragma unroll
      for (int jj = 0; jj < 8; ++jj) {
        float pt = shx(v[jj], 16);
        float fr = __expf(-9.210340372f * (float)jj * 0.125f);
        float sn, cs; sincos_r(pos * fr, sn, cs);
        v[jj] = (q4 & 1) ? v[jj] * cs + pt * sn : v[jj] * cs - pt * sn;
      }
    }
#pragma unroll
    for (int jj = 0; jj < 8; ++jj) qf[ks][jj] = (short)f2bf(v[jj]);
  }
}

__device__ __forceinline__ void attn_even_phase(PRM p, int e, char* smem) {
  u16* lds = (u16*)smem;
  const int tid = get_tid(), lane = tid & 63, wave = tid >> 6, l15 = lane & 15, q4 = lane >> 4;
  const float scaleB = 0.10206207261596577f;
  for (int bt = get_bid(); bt < 1536; bt += vgrid()) {
    AttnSt st; attn_init(st);
    if (bt < 256) {
      int qb = bt & 15, h = (bt >> 4) & 7, b = bt >> 7;
      int mq = NPR + b * 1024 + qb * 64 + wave * 16;
      bf16x8 qf[3]; load_q_mla(qf, p.qb + (size_t)mq * 768 + h * 96, l15, q4, true, qb * 64 + wave * 16);
      at_run_plain<3>(st, qf, p.kb + (size_t)(NPR + b * 1536) * 768 + h * 96, 768, p.vtb_s + (size_t)((b * 8 + h) * 64) * 1536, 1536, 24, scaleB, lds, tid, l15, q4);
      attn_fin(st, p.mix + (size_t)mq * 1024 + 512 + h * 64, l15, q4);
    } else if (bt < 512) {
      int u = bt - 256;
      int r = u & 15, h = (u >> 4) & 7, b = u >> 7;
      int mq = NPR + b * 1024 + r * 64 + wave * 16;
      bf16x8 qf[2]; load_q64(qf, p.qa + (size_t)mq * 512 + h * 64, 512, l15, q4);
      const u16* Vt = p.vta_s + (size_t)((b * 8 + h) * 64) * 1536;
      const u16* Kc = p.kactx + (size_t)b * 512 * 512 + h * 64;
      const int rs = min(max(r - 4, 0), 8);
      const u16* Kw = p.ka + (size_t)(NPR + b * 1024 + rs * 64) * 512 + h * 64;
      const float* rpb0 = p.a_rpb + ((size_t)(e * 8 + h) * 15 + (rs - r + 7)) * 31;
      const int qc = wave * 16 + l15;
      float* rpl = (float*)(lds + 2 * ATile<2>::BUF);
      if (tid < 248) { int rr = tid / 31, cc = tid - rr * 31; rpl[rr * 32 + cc] = rpb0[rr * 31 + cc] * 1.4426950408889634f; }
      AStage<2> r0, r1;
#define NB_LOAD(R, T) { if ((T) < 8) at_load<2>(R, Kc + (size_t)(T) * 64 * 512, 512, Vt + 1024 + (T) * 64, 1536, tid); \
                        else at_load<2>(R, Kw + (size_t)((T) - 8) * 64 * 512, 512, Vt + (rs + (T) - 8) * 64, 1536, tid); }
#define NB_COMP(BUFP, T) { if ((T) < 8) at_comp<2>(st, qf, BUFP, 0.125f, l15, q4, false, nullptr, 0); \
                           else at_comp<2>(st, qf, BUFP, 0.125f, l15, q4, true, rpl + ((T) - 8) * 32, qc); }
      NB_LOAD(r0, 0);
      NB_LOAD(r1, 1);
      at_store<2>(r0, lds, tid);
      __syncthreads();
      for (int t = 0; t < 16; t += 2) {
        if (t + 2 < 16) NB_LOAD(r0, t + 2);
        NB_COMP(lds, t);
        at_store<2>(r1, lds + ATile<2>::BUF, tid);
        __syncthreads();
        if (t + 3 < 16) NB_LOAD(r1, t + 3);
        NB_COMP(lds + ATile<2>::BUF, t + 1);
        if (t + 2 < 16) at_store<2>(r0, lds, tid);
        __syncthreads();
      }
#undef NB_LOAD
#undef NB_COMP
      attn_fin(st, p.mix + (size_t)mq * 1024 + h * 64, l15, q4);
    } else if (bt < 1024) {
      int u = bt - 512;
      int qb = u & 3, h = (u >> 2) & 7, b = u >> 5;
      int mq = b * 256 + qb * 64 + wave * 16;
      bf16x8 qf[3]; load_q_mla(qf, p.qb + (size_t)mq * 768 + h * 96, l15, q4, false, 0);
      at_run_plain<3>(st, qf, p.kb + (size_t)(b * 256) * 768 + h * 96, 768, p.vtb_p + (size_t)((b * 8 + h) * 64) * 256, 256, 4, scaleB, lds, tid, l15, q4);
      attn_fin(st, p.mix + (size_t)mq * 1024 + 512 + h * 64, l15, q4);
    } else {
      int u = bt - 1024;
      int qb = u & 3, h = (u >> 2) & 7, b = u >> 5;
      int mq = b * 256 + qb * 64 + wave * 16;
      bf16x8 qf[2]; load_q64(qf, p.qa + (size_t)mq * 512 + h * 64, 512, l15, q4);
      at_run_plain<2>(st, qf, p.ka + (size_t)(b * 256) * 512 + h * 64, 512, p.vta_p + (size_t)((b * 8 + h) * 64) * 256, 256, 4, 0.125f, lds, tid, l15, q4);
      attn_fin(st, p.mix + (size_t)mq * 1024 + h * 64, l15, q4);
    }
  }
}

__device__ __forceinline__ int mslot(int sq, int h, int dir, int j) {
  return sq < 16 ? ((sq * 4 + h) * 2 + dir) * 4 + j : 512 + (((sq - 16) * 4 + h) * 2 + dir) * 16 + j;
}

__device__ __forceinline__ void mlstm1_task(PRM p, int o, int task, float* sm) {
  const int tid = get_tid(), lane = tid & 63, wave = tid >> 6;
  int sq, h, dir, j;
  if (task < 512) { j = task & 3; dir = (task >> 2) & 1; h = (task >> 3) & 3; sq = task >> 5; }
  else { int u = task - 512; j = u & 15; dir = (u >> 4) & 1; h = (u >> 5) & 3; sq = 16 + (u >> 7); }
  const int T = sq < 16 ? 256 : 1024;
  const int base = sq < 16 ? sq * 256 : NPR + (sq - 16) * 1024;
  const int slot = task;
  float* ks = sm;
  float* vs = sm + 4096;
  float* wg = sm + 4096 + 8192;
  if (wave == 0) {
    int s = 64 * j + lane;
    int t = dir ? T - 1 - s : s;
    const float* row = p.proj + (size_t)(base + t) * 2432 + 1536;
    float ig = row[(dir * 2 + 0) * 4 + h] + p.c_gate_bias[o * 16 + (dir * 2 + 0) * 4 + h];
    float fg = row[(dir * 2 + 1) * 4 + h] + p.c_gate_bias[o * 16 + (dir * 2 + 1) * 4 + h];
    float bsum = logsig_f(fg);
#pragma unroll
    for (int off = 1; off < 64; off <<= 1) { float v = __shfl_up(bsum, off); if (lane >= off) bsum += v; }
    float blast = __shfl(bsum, 63);
    float g = blast - bsum + ig;
    float ml = wmaxr(g);
    wg[lane] = __expf(g - ml);
    if (lane == 0) { p.dm[slot * 2] = ml; p.dm[slot * 2 + 1] = blast; }
  }
#pragma unroll
  for (int ii = 0; ii < 4; ++ii) {
    int i = (tid >> 4) + 16 * ii, c4 = tid & 15;
    int s = 64 * j + i; int t = dir ? T - 1 - s : s;
    float4 v = *(const float4*)(p.proj + (size_t)(base + t) * 2432 + 256 + h * 64 + c4 * 4);
    v.x *= 0.125f; v.y *= 0.125f; v.z *= 0.125f; v.w *= 0.125f;
    *(float4*)(ks + i * 64 + c4 * 4) = v;
  }
#pragma unroll
  for (int ii = 0; ii < 8; ++ii) {
    int i = (tid >> 5) + 8 * ii, c4 = tid & 31;
    int s = 64 * j + i; int t = dir ? T - 1 - s : s;
    *(float4*)(vs + i * 128 + c4 * 4) = *(const float4*)(p.proj + (size_t)(base + t) * 2432 + 512 + h * 128 + c4 * 4);
  }
  __syncthreads();
  const int dg = tid & 15, vg8 = tid >> 4;
  f32x4 acc[8];
#pragma unroll
  for (int q = 0; q < 8; ++q) acc[q] = (f32x4){0.f, 0.f, 0.f, 0.f};
  f32x4 nacc = {0.f, 0.f, 0.f, 0.f};
#pragma unroll 4
  for (int i = 0; i < 64; ++i) {
    f32x4 kd = *(const f32x4*)(ks + i * 64 + dg * 4) * wg[i];
    nacc += kd;
    f32x4 va = *(const f32x4*)(vs + i * 128 + vg8 * 8);
    f32x4 vb = *(const f32x4*)(vs + i * 128 + vg8 * 8 + 4);
    acc[0] += kd * va[0]; acc[1] += kd * va[1]; acc[2] += kd * va[2]; acc[3] += kd * va[3];
    acc[4] += kd * vb[0]; acc[5] += kd * vb[1]; acc[6] += kd * vb[2]; acc[7] += kd * vb[3];
  }
  float* dc = p.dC + (size_t)slot * 8192;
#pragma unroll
  for (int q = 0; q < 8; ++q) *(f32x4*)(dc + (vg8 * 8 + q) * 64 + dg * 4) = acc[q];
  if (vg8 == 0) *(f32x4*)(p.dn + slot * 64 + dg * 4) = nacc;
  __syncthreads();
}

__device__ __forceinline__ void mlstm2_task(PRM p, int o, int task, float* sm) {
  const int tid = get_tid(), lane = tid & 63, wave = tid >> 6;
  int sq, h, c;
  if (task < 256) { c = task & 3; h = (task >> 2) & 3; sq = task >> 4; }
  else { int u = task - 256; c = u & 15; h = (u >> 4) & 3; sq = 16 + (u >> 6); }
  const bool pr = sq < 16;
  const int nc = pr ? 4 : 16;
  const int base = (pr ? sq * 256 : NPR + (sq - 16) * 1024) + c * 64;
  float* qT = sm;
  float* kT = sm + 4352;
  float* CT = kT;
  float* St = sm + 2 * 4352;
  float* vh = sm + 3 * 4352;
  float* smalls = sm + 4 * 4352;
  float* bl = smalls;
  float* itb = smalls + 64;
  float* mt = smalls + 128;
  float* w0 = smalls + 192;
  float* nv = smalls + 256;
  float* nq = smalls + 320;
  float* den = smalls + 384;
  float* scal = smalls + 448;

  const int tl = tid >> 4, tx = tid & 15;
  const int l0 = tl * 4, x0 = tx * 4;
  float hacc[2][4][4];
#pragma unroll
  for (int a = 0; a < 2; ++a)
#pragma unroll
    for (int b2 = 0; b2 < 4; ++b2)
#pragma unroll
      for (int c2 = 0; c2 < 4; ++c2) hacc[a][b2][c2] = 0.f;

  f32x4 qv[4], kv[4];
#pragma unroll
  for (int ii = 0; ii < 4; ++ii) {
    int i = (tid >> 4) + 16 * ii, c4 = tid & 15;
    const float* row = p.proj + (size_t)(base + i) * 2432 + h * 64 + c4 * 4;
    qv[ii] = *(const f32x4*)row;
    kv[ii] = *(const f32x4*)(row + 256);
  }
#pragma unroll
  for (int ii = 0; ii < 4; ++ii) {
    int i = (tid >> 4) + 16 * ii, c4 = tid & 15;
    qT[(c4 * 4 + 0) * 68 + i] = qv[ii].x; qT[(c4 * 4 + 1) * 68 + i] = qv[ii].y; qT[(c4 * 4 + 2) * 68 + i] = qv[ii].z; qT[(c4 * 4 + 3) * 68 + i] = qv[ii].w;
  }
#pragma unroll 1
  for (int dir = 0; dir < 2; ++dir) {
    const int j = dir ? nc - 1 - c : c;
    const int slj = mslot(sq, h, dir, j);
    const float mprev = p.mp[slj];
    float cr[16]; f32x4 vr[4];
    const float* cpp = p.cp + (size_t)slj * 8192;
#pragma unroll
    for (int r = 0; r < 16; ++r) cr[r] = cpp[tid + 256 * r];
#pragma unroll
    for (int ii = 0; ii < 4; ++ii) {
      int i = (tid >> 4) + 16 * ii, c4 = tid & 15;
      vr[ii] = *(const f32x4*)(p.proj + (size_t)(base + i) * 2432 + 512 + h * 128 + c4 * 4);
    }
    if (wave == 0) {
      const int i = lane;
      const int tau = dir ? 63 - i : i;
      const float* row = p.proj + (size_t)(base + tau) * 2432 + 1536;
      float ig = row[(dir * 2 + 0) * 4 + h] + p.c_gate_bias[o * 16 + (dir * 2 + 0) * 4 + h];
      float fg = row[(dir * 2 + 1) * 4 + h] + p.c_gate_bias[o * 16 + (dir * 2 + 1) * 4 + h];
      float bsum = logsig_f(fg);
#pragma unroll
      for (int off = 1; off < 64; off <<= 1) { float v = __shfl_up(bsum, off); if (lane >= off) bsum += v; }
      float ib = ig - bsum;
      float pm = ib;
#pragma unroll
      for (int off = 1; off < 64; off <<= 1) { float v = __shfl_up(pm, off); if (lane >= off) pm = fmaxf(pm, v); }
      float mti = fmaxf(bsum + mprev, bsum + pm);
      bl[tau] = bsum; itb[tau] = ib; mt[tau] = mti; w0[tau] = __expf(bsum + mprev - mti);
    }
#pragma unroll
    for (int ii = 0; ii < 4; ++ii) {
      int i = (tid >> 4) + 16 * ii, c4 = tid & 15;
      kT[(c4 * 4 + 0) * 68 + i] = kv[ii].x * 0.125f; kT[(c4 * 4 + 1) * 68 + i] = kv[ii].y * 0.125f;
      kT[(c4 * 4 + 2) * 68 + i] = kv[ii].z * 0.125f; kT[(c4 * 4 + 3) * 68 + i] = kv[ii].w * 0.125f;
    }
    if (tid < 64) nv[tid] = p.np[slj * 64 + tid];
    __syncthreads();
    {
      float a[4][4];
#pragma unroll
      for (int r = 0; r < 4; ++r)
#pragma unroll
        for (int q = 0; q < 4; ++q) a[r][q] = 0.f;
#pragma unroll 2
      for (int d = 0; d < 64; ++d) {
        float4 q4v = *(const float4*)(qT + d * 68 + l0);
        float4 k4v = *(const float4*)(kT + d * 68 + x0);
        float qa[4] = {q4v.x, q4v.y, q4v.z, q4v.w}, kk[4] = {k4v.x, k4v.y, k4v.z, k4v.w};
#pragma unroll
        for (int r = 0; r < 4; ++r)
#pragma unroll
          for (int q = 0; q < 4; ++q) a[r][q] = fmaf(qa[r], kk[q], a[r][q]);
      }
      float rsum[4];
#pragma unroll
      for (int r = 0; r < 4; ++r) {
        const int l = l0 + r;
        const float bll = bl[l], mtl = mt[l];
        rsum[r] = 0.f;
#pragma unroll
        for (int q = 0; q < 4; ++q) {
          const int s = x0 + q;
          const bool ok = dir ? (s >= l) : (s <= l);
          float sv = ok ? a[r][q] * __expf(bll + itb[s] - mtl) : 0.f;
          St[s * 68 + l] = sv;
          rsum[r] += sv;
        }
        rsum[r] += shx(rsum[r], 1); rsum[r] += shx(rsum[r], 2);
        rsum[r] += shx(rsum[r], 4); rsum[r] += shx(rsum[r], 8);
        if (tx == 0) den[l] = rsum[r];
      }
    }
    __syncthreads();
    if (tid < 64) {
      float s = 0.f;
#pragma unroll 4
      for (int d = 0; d < 64; ++d) s = fmaf(qT[d * 68 + tid], nv[d], s);
      nq[tid] = s;
    }
#pragma unroll 1
    for (int vhalf = 0; vhalf < 2; ++vhalf) {
#pragma unroll
      for (int r = 0; r < 16; ++r) {
        int e = tid + 256 * r;
        CT[(e & 63) * 68 + (e >> 6)] = cr[r];
      }
#pragma unroll
      for (int ii = 0; ii < 4; ++ii) {
        int i = (tid >> 4) + 16 * ii, c4 = tid & 15;
        *(f32x4*)(vh + i * 68 + c4 * 4) = vr[ii];
      }
      if (vhalf == 0) {
#pragma unroll
        for (int r = 0; r < 16; ++r) cr[r] = cpp[4096 + tid + 256 * r];
#pragma unroll
        for (int ii = 0; ii < 4; ++ii) {
          int i = (tid >> 4) + 16 * ii, c4 = tid & 15;
          vr[ii] = *(const f32x4*)(p.proj + (size_t)(base + i) * 2432 + 512 + h * 128 + 64 + c4 * 4);
        }
      }
      __syncthreads();
      {
        float a1[4][4], a2[4][4];
#pragma unroll
        for (int r = 0; r < 4; ++r)
#pragma unroll
          for (int q = 0; q < 4; ++q) { a1[r][q] = 0.f; a2[r][q] = 0.f; }
#pragma unroll 2
        for (int s = 0; s < 64; ++s) {
          float4 sa = *(const float4*)(St + s * 68 + l0);
          float4 vb = *(const float4*)(vh + s * 68 + x0);
          float4 qa4 = *(const float4*)(qT + s * 68 + l0);
          float4 cb4 = *(const float4*)(CT + s * 68 + x0);
          float sl4[4] = {sa.x, sa.y, sa.z, sa.w}, vv[4] = {vb.x, vb.y, vb.z, vb.w};
          float qq[4] = {qa4.x, qa4.y, qa4.z, qa4.w}, cc[4] = {cb4.x, cb4.y, cb4.z, cb4.w};
#pragma unroll
          for (int r = 0; r < 4; ++r)
#pragma unroll
            for (int q = 0; q < 4; ++q) { a1[r][q] = fmaf(sl4[r], vv[q], a1[r][q]); a2[r][q] = fmaf(qq[r], cc[q], a2[r][q]); }
        }
#pragma unroll
        for (int r = 0; r < 4; ++r) {
          const int l = l0 + r;
          const float w = w0[l];
          const float dn_ = den[l] + w * nq[l];
          const float dd = fmaxf(fabsf(dn_), __expf(-mt[l]));
          const float inv = 1.f / dd;
#pragma unroll
          for (int q = 0; q < 4; ++q) { float hv = (a1[r][q] + w * a2[r][q]) * inv; if (vhalf == 0) hacc[0][r][q] += hv; else hacc[1][r][q] += hv; }
        }
      }
      __syncthreads();
    }
  }
#pragma unroll
  for (int r = 0; r < 4; ++r) {
    float ss = 0.f;
#pragma unroll
    for (int a = 0; a < 2; ++a)
#pragma unroll
      for (int q = 0; q < 4; ++q) ss += hacc[a][r][q] * hacc[a][r][q];
    ss += shx(ss, 1); ss += shx(ss, 2); ss += shx(ss, 4); ss += shx(ss, 8);
    const float rn = rsqrtf(ss * (1.f / 128.f) + EPS);
    const int m = base + l0 + r;
#pragma unroll
    for (int a = 0; a < 2; ++a) {
      const int v0 = a * 64 + x0;
      float4 co = *(const float4*)(p.proj + (size_t)m * 2432 + 1024 + h * 128 + v0);
      float4 gn = *(const float4*)(p.c_out_norm + (size_t)(o * 4 + h) * 128 + v0);
      float y0 = sigmoid_f(co.x) * hacc[a][r][0] * rn * gn.x;
      float y1 = sigmoid_f(co.y) * hacc[a][r][1] * rn * gn.y;
      float y2 = sigmoid_f(co.z) * hacc[a][r][2] * rn * gn.z;
      float y3 = sigmoid_f(co.w) * hacc[a][r][3] * rn * gn.w;
      uint2 oo; oo.x = pack2(y0, y1); oo.y = pack2(y2, y3);
      *(uint2*)(p.mix + (size_t)m * 1024 + h * 128 + v0) = oo;
    }
  }
  __syncthreads();
}

__device__ __forceinline__ void mlstm2_mfma(PRM p, int o, int task, char* smem) {
  const int tid = get_tid(), lane = tid & 63, wave = tid >> 6, l15 = lane & 15, q4 = lane >> 4;
  int sq, h, c;
  if (task < 256) { c = task & 3; h = (task >> 2) & 3; sq = task >> 4; }
  else { int u = task - 256; c = u & 15; h = (u >> 4) & 3; sq = 16 + (u >> 6); }
  const bool pr = sq < 16;
  const int nc = pr ? 4 : 16;
  const int base = (pr ? sq * 256 : NPR + (sq - 16) * 1024) + c * 64;
  u16* Qb = (u16*)smem;
  u16* Kb = Qb + 64 * 72;
  u16* Vt = Kb + 64 * 72;
  u16* Cb = Vt + 128 * 72;
  float* sml = (float*)(Cb + 128 * 72);
  float* bl = sml; float* itb = sml + 64; float* mt = sml + 128; float* w0 = sml + 192; float* nv = sml + 256;
#pragma unroll
  for (int ii = 0; ii < 4; ++ii) {
    int i = (tid >> 4) + 16 * ii, c4 = tid & 15;
    const float* row = p.proj + (size_t)(base + i) * 2432 + h * 64 + c4 * 4;
    f32x4 qv = *(const f32x4*)row;
    f32x4 kv = *(const f32x4*)(row + 256);
    uint2 a; a.x = pack2(qv[0], qv[1]); a.y = pack2(qv[2], qv[3]);
    uint2 b; b.x = pack2(kv[0] * 0.125f, kv[1] * 0.125f); b.y = pack2(kv[2] * 0.125f, kv[3] * 0.125f);
    *(uint2*)(Qb + i * 72 + c4 * 4) = a;
    *(uint2*)(Kb + i * 72 + c4 * 4) = b;
  }
#pragma unroll
  for (int ii = 0; ii < 8; ++ii) {
    int i = (tid >> 5) + 8 * ii, c4 = tid & 31;
    f32x4 vv = *(const f32x4*)(p.proj + (size_t)(base + i) * 2432 + 512 + h * 128 + c4 * 4);
    unsigned w01 = pack2(vv[0], vv[1]), w23 = pack2(vv[2], vv[3]);
    Vt[(c4 * 4 + 0) * 72 + i] = (u16)(w01 & 0xffffu); Vt[(c4 * 4 + 1) * 72 + i] = (u16)(w01 >> 16);
    Vt[(c4 * 4 + 2) * 72 + i] = (u16)(w23 & 0xffffu); Vt[(c4 * 4 + 3) * 72 + i] = (u16)(w23 >> 16);
  }
  f32x4 hacc[8];
#pragma unroll
  for (int vt = 0; vt < 8; ++vt) hacc[vt] = (f32x4){0.f, 0.f, 0.f, 0.f};
  const int lrow = wave * 16 + l15;
#pragma unroll 1
  for (int dir = 0; dir < 2; ++dir) {
    const int j = dir ? nc - 1 - c : c;
    const int slj = mslot(sq, h, dir, j);
    const float mprev = p.mp[slj];
    {
      const f32x4* cpp = (const f32x4*)(p.cp + (size_t)slj * 8192);
#pragma unroll
      for (int r = 0; r < 8; ++r) {
        int e4 = tid + 256 * r;
        f32x4 cv = cpp[e4];
        uint2 a; a.x = pack2(cv[0], cv[1]); a.y = pack2(cv[2], cv[3]);
        *(uint2*)(Cb + (e4 >> 4) * 72 + (e4 & 15) * 4) = a;
      }
    }
    if (tid < 64) nv[tid] = p.np[slj * 64 + tid];
    if (wave == 0) {
      const int i = lane;
      const int tau = dir ? 63 - i : i;
      const float* row = p.proj + (size_t)(base + tau) * 2432 + 1536;
      float ig = row[(dir * 2 + 0) * 4 + h] + p.c_gate_bias[o * 16 + (dir * 2 + 0) * 4 + h];
      float fg = row[(dir * 2 + 1) * 4 + h] + p.c_gate_bias[o * 16 + (dir * 2 + 1) * 4 + h];
      float bsum = logsig_f(fg);
#pragma unroll
      for (int off = 1; off < 64; off <<= 1) { float v = __shfl_up(bsum, off); if (lane >= off) bsum += v; }
      float ib = ig - bsum;
      float pm = ib;
#pragma unroll
      for (int off = 1; off < 64; off <<= 1) { float v = __shfl_up(pm, off); if (lane >= off) pm = fmaxf(pm, v); }
      float mti = fmaxf(bsum + mprev, bsum + pm);
      bl[tau] = bsum; itb[tau] = ib; mt[tau] = mti; w0[tau] = __expf(bsum + mprev - mti);
    }
    __syncthreads();
    const float bll = bl[lrow], mtl = mt[lrow], w0l = w0[lrow];
    bf16x8 qf[2];
#pragma unroll
    for (int ks = 0; ks < 2; ++ks) qf[ks] = *(const bf16x8*)(Qb + lrow * 72 + ks * 32 + q4 * 8);
    float nqp = 0.f;
#pragma unroll
    for (int ks = 0; ks < 2; ++ks)
#pragma unroll
      for (int jj = 0; jj < 8; ++jj) {
        float qe = __uint_as_float(((unsigned)(unsigned short)qf[ks][jj]) << 16);
        nqp = fmaf(qe, nv[ks * 32 + q4 * 8 + jj], nqp);
      }
    nqp += shx(nqp, 16); nqp += shx(nqp, 32);
    f32x4 oacc[8];
#pragma unroll
    for (int vt = 0; vt < 8; ++vt) {
      oacc[vt] = (f32x4){0.f, 0.f, 0.f, 0.f};
#pragma unroll
      for (int ks = 0; ks < 2; ++ks) {
        bf16x8 a = *(const bf16x8*)(Cb + (vt * 16 + l15) * 72 + ks * 32 + q4 * 8);
        oacc[vt] = mfma16(a, qf[ks], oacc[vt]);
      }
      oacc[vt] *= w0l;
    }
    float sv[16];
    float dsum = 0.f;
#pragma unroll
    for (int st = 0; st < 4; ++st) {
      f32x4 sa = {0.f, 0.f, 0.f, 0.f};
#pragma unroll
      for (int ks = 0; ks < 2; ++ks) {
        bf16x8 a = *(const bf16x8*)(Kb + (st * 16 + l15) * 72 + ks * 32 + q4 * 8);
        sa = mfma16(a, qf[ks], sa);
      }
#pragma unroll
      for (int r = 0; r < 4; ++r) {
        const int sidx = st * 16 + q4 * 4 + r;
        const bool ok = dir ? (sidx >= lrow) : (sidx <= lrow);
        float val = ok ? sa[r] * __expf(bll + itb[sidx] - mtl) : 0.f;
        sv[st * 4 + r] = val;
        dsum += val;
      }
    }
    dsum += shx(dsum, 16); dsum += shx(dsum, 32);
    bf16x8 pf[2];
#pragma unroll
    for (int hf = 0; hf < 2; ++hf) {
      u32x4 pw;
      pw[0] = pack2(sv[hf * 8 + 0], sv[hf * 8 + 1]); pw[1] = pack2(sv[hf * 8 + 2], sv[hf * 8 + 3]);
      pw[2] = pack2(sv[hf * 8 + 4], sv[hf * 8 + 5]); pw[3] = pack2(sv[hf * 8 + 6], sv[hf * 8 + 7]);
      pf[hf] = __builtin_bit_cast(bf16x8, pw);
    }
    const float dn_ = dsum + w0l * nqp;
    const float inv = 1.f / fmaxf(fabsf(dn_), __expf(-mtl));
#pragma unroll
    for (int vt = 0; vt < 8; ++vt) {
#pragma unroll
      for (int hf = 0; hf < 2; ++hf) {
        const u16* vp = Vt + (vt * 16 + l15) * 72 + hf * 32 + q4 * 4;
        s16x4 v0 = *(const s16x4*)vp;
        s16x4 v1 = *(const s16x4*)(vp + 16);
        bf16x8 vf = (bf16x8){v0.x, v0.y, v0.z, v0.w, v1.x, v1.y, v1.z, v1.w};
        oacc[vt] = mfma16(vf, pf[hf], oacc[vt]);
      }
      hacc[vt] += oacc[vt] * inv;
    }
    __syncthreads();
  }
  float ss = 0.f;
#pragma unroll
  for (int vt = 0; vt < 8; ++vt)
#pragma unroll
    for (int r = 0; r < 4; ++r) ss += hacc[vt][r] * hacc[vt][r];
  ss += shx(ss, 16); ss += shx(ss, 32);
  const float rn = rsqrtf(ss * (1.f / 128.f) + EPS);
  const int m = base + lrow;
#pragma unroll
  for (int vt = 0; vt < 8; ++vt) {
    const int v0 = vt * 16 + q4 * 4;
    f32x4 co = *(const f32x4*)(p.proj + (size_t)m * 2432 + 1024 + h * 128 + v0);
    f32x4 gn = *(const f32x4*)(p.c_out_norm + (size_t)(o * 4 + h) * 128 + v0);
    float y0 = sigmoid_f(co[0]) * hacc[vt][0] * rn * gn[0];
    float y1 = sigmoid_f(co[1]) * hacc[vt][1] * rn * gn[1];
    float y2 = sigmoid_f(co[2]) * hacc[vt][2] * rn * gn[2];
    float y3 = sigmoid_f(co[3]) * hacc[vt][3] * rn * gn[3];
    uint2 oo; oo.x = pack2(y0, y1); oo.y = pack2(y2, y3);
    *(uint2*)(p.mix + (size_t)m * 1024 + h * 128 + v0) = oo;
  }
  __syncthreads();
}

__device__ __forceinline__ void mlstm_scan_phase(PRM p, int o) {
  const int tid = get_tid();
  for (int task = get_bid(); task < 576; task += vgrid()) {
    const int sc = task >> 2, slice = task & 3;
    int sq, h, dir;
    if (sc < 128) { sq = sc >> 3; h = (sc >> 1) & 3; dir = sc & 1; }
    else { int u = sc - 128; sq = 16 + (u >> 3); h = (u >> 1) & 3; dir = u & 1; }
    const bool pr = sq < 16;
    const int nc = pr ? 4 : 16;
    const int sidx = pr ? ((sq * 2 + o) * 2 + dir) * 4 + h : 0;
    const int cidx = pr ? 0 : (((sq - 16) * 2 + o) * 2 + dir) * 4 + h;
    const int e0 = slice * 2048 + tid;
    float C[8];
#pragma unroll
    for (int r = 0; r < 8; ++r) C[r] = pr ? 0.f : p.state_C[(size_t)cidx * 8192 + e0 + 256 * r];
    const bool nthr = (slice == 0) && (tid < 64);
    float n = (pr || !nthr) ? 0.f : p.state_n[cidx * 64 + tid];
    float m = pr ? 0.f : p.state_m[cidx];
#pragma unroll 4
    for (int j = 0; j < nc; ++j) {
      const int sl = mslot(sq, h, dir, j);
      float* cp = p.cp + (size_t)sl * 8192 + e0;
      const float* dc = p.dC + (size_t)sl * 8192 + e0;
#pragma unroll
      for (int r = 0; r < 8; ++r) cp[256 * r] = C[r];
      if (nthr) { p.np[sl * 64 + tid] = n; if (tid == 0) p.mp[sl] = m; }
      const float ml = p.dm[sl * 2], bls = p.dm[sl * 2 + 1];
      const float mn = fmaxf(bls + m, ml);
      const float ca = __expf(bls + m - mn), cb = __expf(ml - mn);
#pragma unroll
      for (int r = 0; r < 8; ++r) C[r] = ca * C[r] + cb * dc[256 * r];
      if (nthr) n = ca * n + cb * p.dn[sl * 64 + tid];
      m = mn;
    }
    if (pr) {
      float* oc = p.out + O_CC + (size_t)sidx * 8192 + e0;
#pragma unroll
      for (int r = 0; r < 8; ++r) oc[256 * r] = C[r];
      if (nthr) { p.out[O_CN + (size_t)sidx * 64 + tid] = n; if (tid == 0) p.out[O_CM + sidx] = m; }
    }
  }
}

__device__ __forceinline__ void odd_mid_phase(PRM p, int o, char* smem) {
  u16* lds = (u16*)smem;
  const int tid = get_tid(), lane = tid & 63, wave = tid >> 6, l15 = lane & 15, q4 = lane >> 4;
  for (int bt = get_bid(); bt < 256 + 768 + 512; bt += vgrid()) {
    if (bt < 256) {
      int qb = bt & 15, hq = (bt >> 4) & 7, b = bt >> 7;
      int kvh = hq >> 2;
      int mq = NPR + b * 1024 + qb * 64 + wave * 16;
      AttnSt st; attn_init(st);
      bf16x8 qf[2]; load_q64(qf, p.qa + (size_t)mq * 512 + hq * 64, 512, l15, q4);
      at_run_plain<2>(st, qf, p.kd + (size_t)(NPR + b * 1536) * 128 + kvh * 64, 128, p.vtd_s + (size_t)((b * 2 + kvh) * 64) * 1536, 1536, 24, 0.125f, lds, tid, l15, q4);
      attn_fin(st, p.mix + (size_t)mq * 1024 + 512 + hq * 64, l15, q4);
    } else if (bt < 256 + 768) {
      mlstm1_task(p, o, bt - 256, (float*)smem);
    } else {
      int u = bt - 1024;
      int qb = u & 3, hq = (u >> 2) & 7, b = u >> 5;
      int kvh = hq >> 2;
      int mq = b * 256 + qb * 64 + wave * 16;
      AttnSt st; attn_init(st);
      bf16x8 qf[2]; load_q64(qf, p.qa + (size_t)mq * 512 + hq * 64, 512, l15, q4);
      at_run_plain<2>(st, qf, p.kd + (size_t)(b * 256) * 128 + kvh * 64, 128, p.vtd_p + (size_t)((b * 2 + kvh) * 64) * 256, 256, 4, 0.125f, lds, tid, l15, q4);
      attn_fin(st, p.mix + (size_t)mq * 1024 + 512 + hq * 64, l15, q4);
    }
  }
}

__device__ __forceinline__ void run_phase(PRM p, int ph, char* smem) {
  char* vsm = smem + (rtid() >> 8) * LDS_HALF;
  if (ph == 0) { phase0(p, vsm); return; }
  if (ph == NPHASE - 1) { norm_phase(p, 0, 3); return; }
  const int l = (ph - 1) / 13, s = (ph - 1) % 13;
  const int eo = l >> 1;
  const bool even = (l & 1) == 0;
  EpiP e{};
  const float* modl = p.mod + (size_t)l * 3 * 9216;
  switch (s) {
    case 0: norm_phase(p, l, 0); break;
    case 1: e.H = p.h; ffn_in_phase(p, l, 0, e, smem); break;
    case 2: e.C = p.x; e.gate = modl + 2 * 1024; e.ldc = 1;
            if (l == 0) { e.vtp = (u16*)p.x_prompt; e.vts = (u16*)p.x_sample; }
            gemm_phase<EPI_RESID, 4, 2, 3, 4, 4>(p.h, p.wt_ffn_out + (size_t)(l * 2 + 0) * 1024 * 2816, 2816, 32, 8, e, smem); break;
    case 3: norm_phase(p, l, 1); break;
    case 4:
      if (even) { e.C = p.proj; e.ldc = 2688; gemm_phase<EPI_STORE, 4, 2, 4, 4, 2>(p.xn, p.wt_in_e + (size_t)eo * 2688 * 1024, 1024, 24, 21, e, smem); }
      else { e.C = p.proj; e.ldc = 2432; gemm_phase<EPI_STORE, 4, 2, 4, 4, 2>(p.xn, p.wt_in_o + (size_t)eo * 2432 * 1024, 1024, 24, 19, e, smem); }
      break;
    case 5: if (even) post_even(p, eo); else post_odd(p, eo); break;
    case 6:
      if (even) {
        EpiP eq{}; eq.C = p.qb; eq.ldc = 768;
        EpiP ek{}; ek.kb = p.kb; ek.vtp = p.vtb_p; ek.vts = p.vtb_s; ek.ctx = 0;
        EpiP ec = ek; ec.ctx = 1;
        const u16* wq = p.wt_qup + (size_t)eo * 768 * 768;
        const u16* wk = p.wt_kvup + (size_t)eo * 1024 * 256;
        for (int t = rbid(); t < 288 + 384 + 64; t += (int)gridDim.x) {
          if (t < 288) gemm_tile<EPI_STORE, 4, 2, 2, 4, 2>(p.cqn, wq, 768, t % 48, t / 48, eq, smem);
          else if (t < 672) { int u = t - 288; gemm_tile<EPI_KVUP, 4, 2, 2, 4, 2>(p.ckvn, wk, 256, u % 48, u / 48, ek, smem); }
          else { int u = t - 672; gemm_tile<EPI_KVUP, 4, 2, 2, 4, 2>(p.cctxn, wk, 256, u % 8, u / 8, ec, smem); }
        }
      } else odd_mid_phase(p, eo, vsm);
      break;
    case 7: if (!even) mlstm_scan_phase(p, eo); break;
    case 8:
      if (even) attn_even_phase(p, eo, vsm);
      else { for (int t = get_bid(); t < 384; t += vgrid()) mlstm2_mfma(p, eo, t, vsm); }
      break;
    case 9: e.C = p.x; e.gate = modl + 5 * 1024; e.ldc = 0;
            gemm_phase<EPI_RESID, 4, 2, 3, 4, 2>(p.mix, p.wt_out + (size_t)l * 1024 * 1024, 1024, 32, 8, e, smem); break;
    case 10: norm_phase(p, l, 2); break;
    case 11: e.H = p.h; ffn_in_phase(p, l, 1, e, smem); break;
    case 12: e.C = p.x; e.gate = modl + 8 * 1024; e.ldc = 1;
             gemm_phase<EPI_RESID, 4, 2, 3, 4, 4>(p.h, p.wt_ffn_out + (size_t)(l * 2 + 1) * 1024 * 2816, 2816, 32, 8, e, smem); break;
  }
}

__global__ void __launch_bounds__(512, 2) mega(Params p) {
  __shared__ __attribute__((aligned(16))) char smem[LDS_BYTES];
  __shared__ uint4 xb_words;
  cg::grid_group grid = cg::this_grid();
  if (threadIdx.x == 0) xb_words = make_uint4(0u, 0u, 0u, 0u);
  __syncthreads();
  XcdBarrier xb = xcd_barrier_post(p.bar, (volatile LAS unsigned*)&xb_words);
  for (int ph = p.ph0; ph < p.ph1; ++ph) {
    const __attribute__((address_space(4))) Params* pp = (const __attribute__((address_space(4))) Params*)__builtin_amdgcn_kernarg_segment_ptr();
    asm volatile("" : "+s"(pp));
    run_phase(*pp, ph, smem);
#ifndef REPMASK
#define REPMASK 0
#endif
#ifndef REPPAR
#define REPPAR 0
#endif
    if (REPMASK) {
      int bit = ph == 0 ? 13 : (ph == NPHASE - 1 ? 14 : (ph - 1) % 13);
      int lay = (ph - 1) / 13;
      bool parok = REPPAR == 0 || ph == 0 || ph == NPHASE - 1 || (REPPAR == 1 && (lay & 1) == 0) || (REPPAR == 2 && (lay & 1) == 1);
      if (((REPMASK >> bit) & 1) && parok) { xcd_barrier(xb); asm volatile("" : "+s"(pp)); run_phase(*pp, ph, smem); }
    }
    if (ph + 1 < p.ph1) {
      if (p.ph1 > 100000) grid.sync();
      xcd_barrier(xb);
    }
  }
}

extern "C" void kernel_launch(void* const* d_in, const int* in_sizes, int n_in, void* d_out, int out_size, void* d_ws, size_t ws_size,
                              hipStream_t stream) {
  static int grid_blocks = 0;
  if (!grid_blocks) {
    int dev = 0, cus = 0, per_cu = 0;
    hipGetDevice(&dev);
    hipDeviceGetAttribute(&cus, hipDeviceAttributeMultiprocessorCount, dev);
    hipOccupancyMaxActiveBlocksPerMultiprocessor(&per_cu, mega, 512, 0);
    per_cu = 1;
    grid_blocks = cus * per_cu;
  }
  Params p{};
  const float** ip = (const float**)&p.x_prompt;
  for (int i = 0; i < 31; ++i) ip[i] = (const float*)d_in[i];
  p.out = (float*)d_out;
  char* w = (char*)d_ws;
  size_t off = 0;
  auto take = [&](size_t bytes) { char* r = w + off; off += (bytes + 255) & ~(size_t)255; return r; };
  p.wt_ffn_in = (u16*)take((size_t)8 * 5632 * 1024 * 2);
  p.wt_ffn_out = (u16*)take((size_t)8 * 1024 * 2816 * 2);
  p.wt_in_e = (u16*)take((size_t)2 * 2688 * 1024 * 2);
  p.wt_in_o = (u16*)take((size_t)2 * 2432 * 1024 * 2);
  p.wt_out = (u16*)take((size_t)4 * 1024 * 1024 * 2);
  p.wt_qup = (u16*)take((size_t)2 * 768 * 768 * 2);
  p.wt_kvup = (u16*)take((size_t)2 * 1024 * 256 * 2);
  p.mod = (float*)take((size_t)12 * 9216 * 4);
  p.x = (float*)take((size_t)NTOK * 1024 * 4);
  p.proj = (float*)take((size_t)NTOK * 2688 * 4);
  p.qb = (float*)take((size_t)NTOK * 768 * 4);
  p.dC = (float*)take((size_t)768 * 8192 * 4);
  p.dn = (float*)take((size_t)768 * 64 * 4);
  p.dm = (float*)take((size_t)768 * 2 * 4);
  p.cp = (float*)take((size_t)768 * 8192 * 4);
  p.np = (float*)take((size_t)768 * 64 * 4);
  p.mp = (float*)take((size_t)768 * 4);
  p.xn = (u16*)take((size_t)NTOK * 1024 * 2);
  p.h = (u16*)take((size_t)NTOK * 2816 * 2);
  p.mix = (u16*)take((size_t)NTOK * 1024 * 2);
  p.qa = (u16*)take((size_t)NTOK * 512 * 2);
  p.ka = (u16*)take((size_t)NTOK * 512 * 2);
  p.kactx = (u16*)take((size_t)1024 * 512 * 2);
  p.vta_p = (u16*)take((size_t)16 * 8 * 64 * 256 * 2);
  p.vta_s = (u16*)take((size_t)2 * 8 * 64 * 1536 * 2);
  p.kb = (u16*)take((size_t)7168 * 768 * 2);
  p.vtb_p = (u16*)take((size_t)16 * 8 * 64 * 256 * 2);
  p.vtb_s = (u16*)take((size_t)2 * 8 * 64 * 1536 * 2);
  p.cqn = (u16*)take((size_t)NTOK * 768 * 2);
  p.ckvn = (u16*)take((size_t)NTOK * 256 * 2);
  p.cctxn = (u16*)take((size_t)1024 * 256 * 2);
  p.kd = (u16*)take((size_t)7168 * 128 * 2);
  p.vtd_p = (u16*)take((size_t)16 * 2 * 64 * 256 * 2);
  p.vtd_s = (u16*)take((size_t)2 * 2 * 64 * 1536 * 2);
  p.bar = (unsigned*)take((size_t)XCD_BAR_WORDS * 4);
  if (off > ws_size) { fprintf(stderr, "kernel_launch: workspace too small: need %zu have %zu\n", off, ws_size); return; }
  hipMemsetAsync(p.bar, 0, (size_t)XCD_BAR_WORDS * 4, stream);
#if MULTI
  for (int ph = 0; ph < NPHASE; ++ph) {
    p.ph0 = ph; p.ph1 = ph + 1;
    hipLaunchKernelGGL(mega, dim3(grid_blocks), dim3(512), 0, stream, p);
  }
#else
  p.ph0 = 0; p.ph1 = NPHASE;
  void* args[] = {&p};
  hipError_t e = hipLaunchCooperativeKernel((void*)mega, dim3(grid_blocks), dim3(512), args, 0, stream);
  if (e != hipSuccess) fprintf(stderr, "cooperative launch failed: %s (grid %d)\n", hipGetErrorString(e), grid_blocks);
#endif
}
```

```cpp
#include <hip/hip_runtime.h>
#include <hip/hip_cooperative_groups.h>
#include <cstdio>
#include <cstdint>
namespace cg = cooperative_groups;

#ifndef MULTI
#define MULTI 0
#endif

typedef unsigned short u16;
typedef __attribute__((ext_vector_type(8))) short bf16x8;
typedef __attribute__((ext_vector_type(4))) short s16x4;
typedef __attribute__((ext_vector_type(4))) float f32x4;
typedef __attribute__((ext_vector_type(4))) unsigned int u32x4;

#define NTOK 6144
#define NPR 4096
#define LDS_HALF 77824
#define LDS_BYTES (2 * LDS_HALF)
#define NPHASE 54
#define EPS 1e-6f

struct Params {
  const float *x_prompt, *x_sample, *cache_a_k, *cache_a_v, *cache_b_ckv, *cache_b_krope, *cache_d_k, *cache_d_v;
  const float *state_C, *state_n, *state_m, *c, *c_ctx, *w_mod, *b_mod, *norm_g, *ffn_in, *ffn_out;
  const float *w_in_even, *w_in_odd, *w_out, *a_rpb, *b_q_norm, *b_wq_up, *b_kv_norm, *b_wkv_up;
  const float *c_gate_bias, *c_out_norm, *d_q_norm, *d_k_norm, *final_norm;
  float* out;
  u16 *wt_ffn_in, *wt_ffn_out, *wt_in_e, *wt_in_o, *wt_out, *wt_qup, *wt_kvup;
  float *mod, *x, *proj, *qb, *dC, *dn, *dm, *cp, *np, *mp;
  u16 *xn, *h, *mix, *qa, *ka, *kactx, *vta_p, *vta_s, *kb, *vtb_p, *vtb_s, *cqn, *ckvn, *cctxn, *kd, *vtd_p, *vtd_s;
  unsigned* bar;
  int ph0, ph1;
};

typedef const __attribute__((address_space(4))) Params& PRM;
#define O_YP 0
#define O_YS 4194304
#define O_AK 6291456
#define O_AV 10485760
#define O_CKV 14680064
#define O_KR 16777216
#define O_DK 17039360
#define O_DV 18087936
#define O_CC 19136512
#define O_CN 21233664
#define O_CM 21250048

__device__ __forceinline__ int get_tid() { int t = threadIdx.x & 255; asm volatile("" : "+v"(t)); return t; }
__device__ __forceinline__ int rtid_raw() { int t = threadIdx.x; asm volatile("" : "+v"(t)); return t; }
__device__ __forceinline__ int get_bid() { int t = blockIdx.x * 2 + __builtin_amdgcn_readfirstlane(rtid_raw() >> 8); asm volatile("" : "+s"(t)); return t; }
__device__ __forceinline__ int vgrid() { return (int)gridDim.x * 2; }
__device__ __forceinline__ int rtid() { int t = threadIdx.x; asm volatile("" : "+v"(t)); return t; }
__device__ __forceinline__ int rbid() { int t = blockIdx.x; asm volatile("" : "+s"(t)); return t; }
typedef __attribute__((ext_vector_type(2))) __bf16 bf16x2_t;
typedef __attribute__((ext_vector_type(2))) float f32x2_t;
__device__ __forceinline__ unsigned pack2(float a, float b) {
  f32x2_t v = {a, b};
  bf16x2_t r = __builtin_convertvector(v, bf16x2_t);
  return __builtin_bit_cast(unsigned, r);
}
__device__ __forceinline__ u16 f2bf(float f) { return (u16)(pack2(f, 0.f) & 0xffffu); }
__device__ __forceinline__ float shx(float v, int m) {
  int l = __builtin_amdgcn_mbcnt_hi(-1, __builtin_amdgcn_mbcnt_lo(-1, 0));
  asm volatile("" : "+v"(l));
  return __int_as_float(__builtin_amdgcn_ds_bpermute((l ^ m) << 2, __float_as_int(v)));
}
__device__ __forceinline__ float wsum(float v) {
#pragma unroll
  for (int o = 32; o; o >>= 1) v += shx(v, o);
  return v;
}
__device__ __forceinline__ float wmaxr(float v) {
#pragma unroll
  for (int o = 32; o; o >>= 1) v = fmaxf(v, shx(v, o));
  return v;
}
__device__ __forceinline__ float silu_f(float x) { return x / (1.f + __expf(-x)); }
__device__ __forceinline__ float sigmoid_f(float x) { return 1.f / (1.f + __expf(-x)); }
__device__ __forceinline__ float logsig_f(float x) { return fminf(x, 0.f) - __logf(1.f + __expf(-fabsf(x))); }
__device__ __forceinline__ void sincos_r(float a, float& s, float& c) {
  float n = rintf(a * 0.15915494309f);
  float r = fmaf(-n, 6.2831855f, a);
  r = fmaf(-n, -1.7484555e-7f, r);
  s = __sinf(r); c = __cosf(r);
}
__device__ __forceinline__ int grp_of(int m) { return m < NPR ? 0 : 1 + ((m - NPR) >> 10); }
__device__ __forceinline__ int keyrow(int m) { return m < NPR ? m : NPR + ((m - NPR) >> 10) * 1536 + ((m - NPR) & 1023); }
__device__ __forceinline__ f32x4 mfma16(bf16x8 a, bf16x8 b, f32x4 c) { return __builtin_amdgcn_mfma_f32_16x16x32_bf16(a, b, c, 0, 0, 0); }

#define XB_TMO      128
#define XB_XCNT(j)  (256  + 64 * (j))
#define XB_XSUB(j)  (1280 + 64 * (j))
#define XB_XGEN(j)  (2304 + 64 * (j))
#define XB_TOP      3328
#define XB_TOPGEN   3392
#define XCD_BAR_WORDS 3456
#define XB_SPIN_CAP (1u << 18)
#define LAS __attribute__((address_space(3)))

__device__ __forceinline__ unsigned xb_ld(unsigned* p)              { return __hip_atomic_load(p, __ATOMIC_RELAXED, __HIP_MEMORY_SCOPE_AGENT); }
__device__ __forceinline__ unsigned xb_add(unsigned* p, unsigned v) { return __hip_atomic_fetch_add(p, v, __ATOMIC_RELAXED, __HIP_MEMORY_SCOPE_AGENT); }
__device__ __forceinline__ unsigned xb_xcc_id() { return (unsigned)__builtin_amdgcn_s_getreg((3 << 11) | 20) & 0xFu; }
#define XB_SPIN(cond, bar) do { unsigned _sp = 0; while (cond) { __builtin_amdgcn_s_sleep(1); \
    if ((++_sp & 255u) == 0u) { if (xb_ld(&(bar)[XB_TMO])) break; if (_sp > XB_SPIN_CAP) { atomicAdd(&(bar)[XB_TMO], 1u); break; } } } } while (0)

struct XcdBarrier {
    unsigned* bar; unsigned x;
    volatile LAS unsigned* st;
};

__device__ __forceinline__ XcdBarrier xcd_barrier_post(unsigned* bar, volatile LAS unsigned* st) {
    XcdBarrier b; b.bar = bar; b.x = xb_xcc_id(); b.st = st;
    if (threadIdx.x == 0) (void)xb_add(&bar[XB_XCNT(b.x)], 1u);
    return b;
}
__device__ __forceinline__ void xcd_barrier_complete(unsigned* bar, unsigned x, unsigned& nloc, unsigned& nx) {
    const unsigned G = gridDim.x * gridDim.y * gridDim.z;
    unsigned sum, cnt, mine, sp = 0u;
    for (;;) {
        sum = 0u; cnt = 0u; mine = 0u;
#pragma unroll
        for (unsigned j = 0; j < 16; ++j) { const unsigned c = xb_ld(&bar[XB_XCNT(j)]); sum += c; cnt += (c > 0u) ? 1u : 0u; mine = (j == x) ? c : mine; }
        if (sum == G) break;
        __builtin_amdgcn_s_sleep(1);
        if ((++sp & 255u) == 0u) { if (xb_ld(&bar[XB_TMO])) break; if (sp > XB_SPIN_CAP) { atomicAdd(&bar[XB_TMO], 1u); break; } }
    }
    nloc = mine > 0u ? mine : 1u; nx = cnt > 0u ? cnt : 1u;
}

__device__ __forceinline__ void xcd_barrier(const XcdBarrier& b) {
    asm volatile("s_waitcnt vmcnt(0)" ::: "memory");
    __syncthreads();
    if (threadIdx.x == 0) {
        unsigned* bar = b.bar;
        __builtin_amdgcn_s_waitcnt(0);
        unsigned nloc = b.st[0], nx = b.st[1];
        if (nloc == 0u) { xcd_barrier_complete(bar, b.x, nloc, nx); b.st[0] = nloc; b.st[1] = nx; }
        const unsigned old = xb_add(&bar[XB_XSUB(b.x)], 1u);
        const unsigned gen = old / nloc;
        if (old + 1u == (gen + 1u) * nloc) {
            __builtin_amdgcn_fence(__ATOMIC_RELEASE, "agent");
            asm volatile("s_waitcnt vmcnt(0)" ::: "memory");
            const unsigned og = xb_add(&bar[XB_TOP], 1u);
            const unsigned tg = og / nx;
            if (og + 1u == (tg + 1u) * nx) xb_add(&bar[XB_TOPGEN], 1u);
            else XB_SPIN(xb_ld(&bar[XB_TOPGEN]) == tg, bar);
            __builtin_amdgcn_fence(__ATOMIC_ACQUIRE, "agent");
            xb_add(&bar[XB_XGEN(b.x)], 1u);
            asm volatile("s_waitcnt vmcnt(0)" ::: "memory");
        } else {
            XB_SPIN(xb_ld(&bar[XB_XGEN(b.x)]) == gen, bar);
            __builtin_amdgcn_fence(__ATOMIC_ACQUIRE, "agent");
            asm volatile("s_waitcnt vmcnt(0)" ::: "memory");
        }
    }
    __syncthreads();
}


__device__ __forceinline__ void conv_tile(const float* __restrict__ src, int K, int N, int perm, u16* __restrict__ dst, int kt4, int nt, float* tile) {
  const int tid = get_tid();
  {
    const int c4 = tid & 15, kr = tid >> 4;
    const int n = nt * 64 + c4 * 4;
    const bool valid = n < N;
    int col = n;
    if (perm) { int G = n >> 4, w = n & 15, sub = w >> 2; col = ((sub & 1) ? 2816 : 0) + G * 8 + (sub >> 1) * 4 + (w & 3); }
    f32x4 v[16];
#pragma unroll
    for (int i = 0; i < 16; ++i) {
      int kk = kr + 16 * i;
      v[i] = valid ? *(const f32x4*)(src + (size_t)(kt4 * 256 + kk) * N + col) : (f32x4){0.f, 0.f, 0.f, 0.f};
    }
#pragma unroll
    for (int i = 0; i < 16; ++i) {
      int kk = kr + 16 * i;
      float* t = tile + (kk >> 6) * 4160 + (kk & 63) * 65 + c4 * 4;
      t[0] = v[i][0]; t[1] = v[i][1]; t[2] = v[i][2]; t[3] = v[i][3];
    }
  }
  __syncthreads();
  {
    const int k8 = (tid & 7) * 8;
#pragma unroll
    for (int hh = 0; hh < 4; ++hh)
#pragma unroll
      for (int i = 0; i < 2; ++i) {
        int nn2 = (tid >> 3) + 32 * i;
        float v[8];
#pragma unroll
        for (int e = 0; e < 8; ++e) v[e] = tile[hh * 4160 + (k8 + e) * 65 + nn2];
        uint4 o; o.x = pack2(v[0], v[1]); o.y = pack2(v[2], v[3]); o.z = pack2(v[4], v[5]); o.w = pack2(v[6], v[7]);
        *(uint4*)(dst + (size_t)(nt * 64 + nn2) * K + kt4 * 256 + hh * 64 + k8) = o;
      }
  }
  __syncthreads();
}

__device__ __forceinline__ void mod_task(PRM p, int t, float* sm) {
  const int l = t / 144, cb = t % 144, tid = get_tid();
  float* sc = sm;
  float* red = sm + 3072;
  for (int i = tid; i < 3072; i += 256) {
    int g = i >> 10, k = i & 1023;
    float v = g == 0 ? p.c_ctx[k] : p.c[(g - 1) * 1024 + k];
    sc[i] = silu_f(v);
  }
  __syncthreads();
  const int c4 = tid & 15, kg = tid >> 4;
  const float* w = p.w_mod + (size_t)l * 1024 * 9216 + (size_t)(kg * 64) * 9216 + cb * 64 + c4 * 4;
  float a[3][4];
#pragma unroll
  for (int g = 0; g < 3; ++g)
#pragma unroll
    for (int q = 0; q < 4; ++q) a[g][q] = 0.f;
  for (int k = 0; k < 64; k += 8) {
    float4 wv[8];
#pragma unroll
    for (int e = 0; e < 8; ++e) wv[e] = *(const float4*)(w + (size_t)(k + e) * 9216);
#pragma unroll
    for (int e = 0; e < 8; ++e) {
      int kk = kg * 64 + k + e;
#pragma unroll
      for (int g = 0; g < 3; ++g) {
        float sv = sc[g * 1024 + kk];
        a[g][0] = fmaf(sv, wv[e].x, a[g][0]); a[g][1] = fmaf(sv, wv[e].y, a[g][1]);
        a[g][2] = fmaf(sv, wv[e].z, a[g][2]); a[g][3] = fmaf(sv, wv[e].w, a[g][3]);
      }
    }
  }
#pragma unroll
  for (int g = 0; g < 3; ++g)
#pragma unroll
    for (int q = 0; q < 4; ++q) red[(kg * 3 + g) * 64 + c4 * 4 + q] = a[g][q];
  __syncthreads();
  if (tid < 192) {
    int g = tid >> 6, c2 = tid & 63;
    float s = 0.f;
#pragma unroll
    for (int q = 0; q < 16; ++q) s += red[(q * 3 + g) * 64 + c2];
    int j = cb * 64 + c2;
    p.mod[(size_t)(l * 3 + g) * 9216 + j] = s + p.b_mod[l * 9216 + j];
  }
  __syncthreads();
}

__device__ __forceinline__ int conv_layer_count(int l) { return (l & 1) ? 1272 : 1340; }
__device__ __forceinline__ void conv_layer_task(PRM p, int l, int u, float* sm) {
  const float* src; u16* dst; int K, N, Npad, perm = 0, tp, mat0;
  const int eo = l >> 1;
  const int nin = (l & 1) ? 152 : 168;
  if (u < 704) { K = 1024; N = 5632; Npad = 5632; perm = 1; tp = 352; src = p.ffn_in; dst = p.wt_ffn_in; mat0 = l * 2; }
  else if ((u -= 704) < 352) { K = 2816; N = 1024; Npad = 1024; tp = 176; src = p.ffn_out; dst = p.wt_ffn_out; mat0 = l * 2; }
  else if ((u -= 352) < nin) {
    if (l & 1) { K = 1024; N = 2320; Npad = 2432; tp = 152; src = p.w_in_odd; dst = p.wt_in_o; mat0 = eo; }
    else { K = 1024; N = 2592; Npad = 2688; tp = 168; src = p.w_in_even; dst = p.wt_in_e; mat0 = eo; }
  }
  else if ((u -= nin) < 64) { K = 1024; N = 1024; Npad = 1024; tp = 64; src = p.w_out; dst = p.wt_out; mat0 = l; }
  else if ((u -= 64) < 36) { K = 768; N = 768; Npad = 768; tp = 36; src = p.b_wq_up; dst = p.wt_qup; mat0 = eo; }
  else { u -= 36; K = 256; N = 1024; Npad = 1024; tp = 16; src = p.b_wkv_up; dst = p.wt_kvup; mat0 = eo; }
  int mat = mat0 + u / tp, r = u % tp;
  int nkt = K / 256;
  int kt = r % nkt, nt = r / nkt;
  conv_tile(src + (size_t)mat * K * N, K, N, perm, dst + (size_t)mat * Npad * K, kt, nt, sm);
}

__device__ __forceinline__ void phase0(PRM p, char* smem) {
  float* sm = (float*)smem;
  const int NMOD = 144, NCOPY = 0, NCONV = 1340;
  const int total = NMOD + NCOPY + NCONV;
  for (int t = get_bid(); t < total; t += vgrid()) {
    if (t < NMOD) { mod_task(p, t, sm); continue; }
    int u = t - NMOD;
    if (u < NCOPY) {
      const int tid = get_tid();
#pragma unroll
      for (int i = 0; i < 4; ++i) {
        size_t idx = ((size_t)u * 1024 + i * 256 + tid);
        const float4* src = idx < (size_t)NPR * 256 ? (const float4*)p.x_prompt + idx : (const float4*)p.x_sample + (idx - (size_t)NPR * 256);
        ((float4*)p.x)[idx] = *src;
      }
      continue;
    }
    conv_layer_task(p, 0, u - NCOPY, sm);
  }
}

__device__ __forceinline__ void norm_phase(PRM p, int l, int which) {
  const int lane = get_tid() & 63, wave = get_tid() >> 6;
  const int nrows_wave = NTOK / 4;
  const int stride = vgrid();
  for (int t0 = get_bid(); t0 < nrows_wave; t0 += 3 * stride) {
    float4 v[3][4];
    float ss[3];
#pragma unroll
    for (int k = 0; k < 3; ++k) {
      const int t = t0 + k * stride;
      if (t < nrows_wave) {
        const int mm = t * 4 + wave;
        const float* xsrc = (l == 0 && which == 0) ? (mm < NPR ? p.x_prompt + (size_t)mm * 1024 : p.x_sample + (size_t)(mm - NPR) * 1024) : p.x + (size_t)mm * 1024;
        const float4* xr = (const float4*)xsrc;
#pragma unroll
        for (int i = 0; i < 4; ++i) v[k][i] = xr[i * 64 + lane];
      }
    }
#pragma unroll
    for (int k = 0; k < 3; ++k) {
      float a = 0.f;
#pragma unroll
      for (int i = 0; i < 4; ++i) a += v[k][i].x * v[k][i].x + v[k][i].y * v[k][i].y + v[k][i].z * v[k][i].z + v[k][i].w * v[k][i].w;
      ss[k] = wsum(a);
    }
#pragma unroll
    for (int k = 0; k < 3; ++k) {
      const int t = t0 + k * stride;
      if (t >= nrows_wave) continue;
      const int m = t * 4 + wave;
      const float r = rsqrtf(ss[k] * (1.f / 1024.f) + EPS);
      if (which == 3) {
        float4* o = (float4*)(p.out + (size_t)m * 1024);
#pragma unroll
        for (int i = 0; i < 4; ++i) {
          float4 g = ((const float4*)p.final_norm)[i * 64 + lane];
          float4 y; y.x = v[k][i].x * r * g.x; y.y = v[k][i].y * r * g.y; y.z = v[k][i].z * r * g.z; y.w = v[k][i].w * r * g.w;
          o[i * 64 + lane] = y;
        }
      } else {
        const float* md = p.mod + (size_t)(l * 3 + grp_of(m)) * 9216 + which * 3072;
        const float4* sh = (const float4*)md;
        const float4* sc = (const float4*)(md + 1024);
        const float4* gg = (const float4*)(p.norm_g + (size_t)(l * 3 + which) * 1024);
#pragma unroll
        for (int i = 0; i < 4; ++i) {
          float4 g = gg[i * 64 + lane], s = sc[i * 64 + lane], b = sh[i * 64 + lane];
          float y0 = v[k][i].x * r * g.x * (1.f + s.x) + b.x;
          float y1 = v[k][i].y * r * g.y * (1.f + s.y) + b.y;
          float y2 = v[k][i].z * r * g.z * (1.f + s.z) + b.z;
          float y3 = v[k][i].w * r * g.w * (1.f + s.w) + b.w;
          uint2 o; o.x = pack2(y0, y1); o.y = pack2(y2, y3);
          *(uint2*)(p.xn + (size_t)m * 1024 + (i * 64 + lane) * 4) = o;
        }
      }
    }
  }
}

struct EpiP {
  float* C; int ldc;
  const float* gate;
  u16* H;
  u16 *kb, *vtp, *vts; int ctx;
};
enum { EPI_STORE = 0, EPI_RESID = 1, EPI_SWIGLU = 2, EPI_KVUP = 3 };

template <int FI, int FJ, bool SWAP>
__device__ __forceinline__ void g_compute(f32x4 (&acc)[FI][FJ], const u16* Ac, const u16* Bc, int q4, int rsw) {
  __builtin_amdgcn_s_setprio(1);
#pragma unroll
  for (int ks = 0; ks < 2; ++ks) {
    const int co = ((ks * 4 + q4) ^ rsw) << 3;
#pragma unroll
    for (int j0 = 0; j0 < FJ; j0 += 4) {
      bf16x8 b[4];
#pragma unroll
      for (int j = 0; j < 4; ++j) if (j0 + j < FJ) b[j] = *(const bf16x8*)(Bc + (j0 + j) * 1024 + co);
#pragma unroll
      for (int i0 = 0; i0 < FI; i0 += 4) {
        bf16x8 a[4];
#pragma unroll
        for (int i = 0; i < 4; ++i) if (i0 + i < FI) a[i] = *(const bf16x8*)(Ac + (i0 + i) * 1024 + co);
#pragma unroll
        for (int j = 0; j < 4; ++j)
          if (j0 + j < FJ) {
#pragma unroll
            for (int i = 0; i < 4; ++i)
              if (i0 + i < FI) acc[i0 + i][j0 + j] = SWAP ? mfma16(b[j], a[i], acc[i0 + i][j0 + j]) : mfma16(a[i], b[j], acc[i0 + i][j0 + j]);
          }
      }
    }
  }
  __builtin_amdgcn_s_setprio(0);
}

template <int EPI, int WMW, int WNW, int FI, int FJ, int DEPTH>
__device__ __forceinline__ void gemm_tile(const u16* __restrict__ A, const u16* __restrict__ Wt, int K, int tm, int tn, const EpiP& e, char* smem) {
  constexpr int BM = WMW * FI * 16, BN = WNW * FJ * 16;
  constexpr int NA = BM / 64, NB = BN / 64;
  constexpr int BUFSZ = (BM + BN) * 64;
  static_assert(WMW * WNW == 8 && BM % 64 == 0 && BN % 64 == 0, "tile");
  u16* As = (u16*)smem;
  u16* Bs = As + BM * 64;
  const int tid = rtid(), lane = tid & 63, wave = tid >> 6, wm = wave / WNW, wn = wave % WNW, l15 = lane & 15, q4 = lane >> 4;
  const int lr = tid >> 3, lc = tid & 7;
  const u16* Ag = A + (size_t)(tm * BM + lr) * K + lc * 8;
  const u16* Bg = Wt + (size_t)(tn * BN + lr) * K + lc * 8;
  const int st_off = lr * 64 + ((lc ^ ((lr >> 1) & 7)) << 3);
  const int rsw = (l15 >> 1) & 7;
  const int a_row = (wm * FI * 16 + l15) * 64, b_row = (wn * FJ * 16 + l15) * 64;
  f32x4 acc[FI][FJ];
#pragma unroll
  for (int i = 0; i < FI; ++i)
#pragma unroll
    for (int j = 0; j < FJ; ++j) acc[i][j] = (f32x4){0.f, 0.f, 0.f, 0.f};
  const int nk = K >> 6;
#define GL(RA, RB, KT) { _Pragma("unroll") for (int i = 0; i < NA; ++i) RA[i] = *(const u32x4*)(Ag + (size_t)i * 64 * K + (KT) * 64); \
                         _Pragma("unroll") for (int i = 0; i < NB; ++i) RB[i] = *(const u32x4*)(Bg + (size_t)i * 64 * K + (KT) * 64); }
#define GS(RA, RB, BUF) { _Pragma("unroll") for (int i = 0; i < NA; ++i) *(u32x4*)(As + (BUF) * BUFSZ + st_off + i * 4096) = RA[i]; \
                          _Pragma("unroll") for (int i = 0; i < NB; ++i) *(u32x4*)(Bs + (BUF) * BUFSZ + st_off + i * 4096) = RB[i]; }
  if constexpr (DEPTH == 4) {
    static_assert(WMW == 4 && WNW == 2 && FJ == 4 && (FI == 3 || FI == 4), "ring4 tile");
    constexpr int ST = (BM + BN) * 32;
    const int nk32 = K >> 5;
    const int fs = (-(tid >> 4)) & 3;
    const int sc = ((tid & 3) ^ fs) << 3;
    const int r4 = tid >> 2;
    const bool three = (BM == 256) || (tid < 256);
    const u16* sp0 = A + (size_t)(tm * BM + r4) * K + sc;
    const int lo0 = tid * 8;
    const u16* sp1; int lo1; const u16* sp2; int lo2;
    if (BM == 256) {
      sp1 = A + (size_t)(tm * BM + 128 + r4) * K + sc;  lo1 = (tid + 512) * 8;
      sp2 = Wt + (size_t)(tn * BN + r4) * K + sc;       lo2 = BM * 32 + tid * 8;
    } else if (tid < 256) {
      sp1 = A + (size_t)(tm * BM + 128 + r4) * K + sc;  lo1 = (tid + 512) * 8;
      sp2 = Wt + (size_t)(tn * BN + 64 + r4) * K + sc;  lo2 = BM * 32 + (tid + 256) * 8;
    } else {
      sp1 = Wt + (size_t)(tn * BN + (r4 - 64)) * K + sc; lo1 = BM * 32 + (tid - 256) * 8;
      sp2 = sp1; lo2 = lo1;
    }
    const int fr = (-(l15 >> 2)) & 3;
    const int co3 = (q4 ^ fr) << 3;
    const int a_row3 = (wm * FI * 16 + l15) * 32 + co3, b_row3 = BM * 32 + (wn * FJ * 16 + l15) * 32 + co3;
    const unsigned lbase = (unsigned)(size_t)As;
#define GD4(KT, BUF) { __builtin_amdgcn_global_load_lds((const unsigned*)(sp0 + (KT) * 32), (unsigned*)(As + (BUF) * ST + lo0), 16, 0, 0); \
                       __builtin_amdgcn_global_load_lds((const unsigned*)(sp1 + (KT) * 32), (unsigned*)(As + (BUF) * ST + lo1), 16, 0, 0); \
                       if (three) __builtin_amdgcn_global_load_lds((const unsigned*)(sp2 + (KT) * 32), (unsigned*)(As + (BUF) * ST + lo2), 16, 0, 0); }
    asm volatile("s_waitcnt vmcnt(0)" ::: "memory");
    GD4(0, 0);
    if (nk32 > 1) GD4(1, 1);
    if (nk32 > 2) GD4(2, 2);
#define RING4_STEP(J) { \
      const int kt = kt0 + (J); \
      if (kt + 2 < nk32) { if (three) asm volatile("s_waitcnt vmcnt(6)" ::: "memory"); else asm volatile("s_waitcnt vmcnt(4)" ::: "memory"); } \
      else if (kt + 1 < nk32) { if (three) asm volatile("s_waitcnt vmcnt(3)" ::: "memory"); else asm volatile("s_waitcnt vmcnt(2)" ::: "memory"); } \
      else asm volatile("s_waitcnt vmcnt(0)" ::: "memory"); \
      asm volatile("s_waitcnt lgkmcnt(0)" ::: "memory"); \
      __builtin_amdgcn_s_barrier(); \
      asm volatile("" ::: "memory"); \
      const unsigned aad = lbase + (unsigned)(((J) * ST + a_row3) * 2); \
      const unsigned bad = lbase + (unsigned)(((J) * ST + b_row3) * 2); \
      bf16x8 b0, b1, b2, b3, a0, a1, a2, a3; \
      asm volatile("ds_read_b128 %0, %1" : "=v"(b0) : "v"(bad)); \
      asm volatile("ds_read_b128 %0, %1 offset:1024" : "=v"(b1) : "v"(bad)); \
      asm volatile("ds_read_b128 %0, %1 offset:2048" : "=v"(b2) : "v"(bad)); \
      asm volatile("ds_read_b128 %0, %1 offset:3072" : "=v"(b3) : "v"(bad)); \
      asm volatile("ds_read_b128 %0, %1" : "=v"(a0) : "v"(aad)); \
      asm volatile("ds_read_b128 %0, %1 offset:1024" : "=v"(a1) : "v"(aad)); \
      asm volatile("ds_read_b128 %0, %1 offset:2048" : "=v"(a2) : "v"(aad)); \
      if (FI == 4) { asm volatile("ds_read_b128 %0, %1 offset:3072" : "=v"(a3) : "v"(aad)); \
        asm volatile("s_waitcnt lgkmcnt(0)" : "+v"(b0), "+v"(b1), "+v"(b2), "+v"(b3), "+v"(a0), "+v"(a1), "+v"(a2), "+v"(a3)); } \
      else { asm volatile("s_waitcnt lgkmcnt(0)" : "+v"(b0), "+v"(b1), "+v"(b2), "+v"(b3), "+v"(a0), "+v"(a1), "+v"(a2)); a3 = a2; } \
      __builtin_amdgcn_s_setprio(1); \
      { bf16x8 bb[4] = {b0, b1, b2, b3}; bf16x8 aa[4] = {a0, a1, a2, a3}; \
        _Pragma("unroll") for (int j = 0; j < 4; ++j) \
          _Pragma("unroll") for (int i = 0; i < FI; ++i) acc[i][j] = mfma16(bb[j], aa[i], acc[i][j]); } \
      __builtin_amdgcn_s_setprio(0); \
      if (kt + 3 < nk32) GD4(kt + 3, ((J) + 3) & 3);     \
      }
    for (int kt0 = 0; kt0 < nk32; kt0 += 4) {
      RING4_STEP(0) RING4_STEP(1) RING4_STEP(2) RING4_STEP(3)
    }
#undef RING4_STEP
#undef GD4
    __syncthreads();
  } else if constexpr (DEPTH == 3) {
    constexpr int ST = (BM + BN) * 32;
    constexpr int NA4 = BM * 4 / 512, NB4 = BN * 4 / 512;
    const int nk32 = K >> 5;
    const int fs = (-(tid >> 4)) & 3;
    const u16* Ad = A + (size_t)(tm * BM + (tid >> 2)) * K + (((tid & 3) ^ fs) << 3);
    const u16* Bd = Wt + (size_t)(tn * BN + (tid >> 2)) * K + (((tid & 3) ^ fs) << 3);
    u16* Al = As + tid * 8;
    u16* Bl = As + BM * 32 + tid * 8;
    const int fr = (-(l15 >> 2)) & 3;
    const int co3 = (q4 ^ fr) << 3;
    const int a_row3 = (wm * FI * 16 + l15) * 32 + co3, b_row3 = BM * 32 + (wn * FJ * 16 + l15) * 32 + co3;
    static_assert(FI == 8 && FJ == 4, "ring path is written for 8x4 fragments per wave");
    const unsigned lbase = (unsigned)(size_t)As;
#define GD3P(PA, PB, KT, BUF) { _Pragma("unroll") for (int i = 0; i < NA4; ++i) __builtin_amdgcn_global_load_lds((const unsigned*)((PA) + (size_t)i * 128 * K + (KT) * 32), (unsigned*)(Al + (BUF) * ST + i * 4096), 16, 0, 0); \
                               _Pragma("unroll") for (int i = 0; i < NB4; ++i) __builtin_amdgcn_global_load_lds((const unsigned*)((PB) + (size_t)i * 128 * K + (KT) * 32), (unsigned*)(Bl + (BUF) * ST + i * 4096), 16, 0, 0); }
#define GD3(KT, BUF) GD3P(Ad, Bd, KT, BUF)
    asm volatile("s_waitcnt vmcnt(0)" ::: "memory");
    if (!(e.ctx & 1)) {
      GD3(0, 0);
      if (nk32 > 1) GD3(1, 1);
      if (nk32 > 2) GD3(2, 2);
    }
#define RING_STEP(J) { \
      const int kt = kt0 + (J); \
      if (kt + 2 < nk32) asm volatile("s_waitcnt vmcnt(%0)" :: "n"(2 * (NA4 + NB4)) : "memory"); \
      else if (kt + 1 < nk32) asm volatile("s_waitcnt vmcnt(%0)" :: "n"(NA4 + NB4) : "memory"); \
      else asm volatile("s_waitcnt vmcnt(0)" ::: "memory"); \
      asm volatile("s_waitcnt lgkmcnt(0)" ::: "memory"); \
      __builtin_amdgcn_s_barrier(); \
      asm volatile("" ::: "memory"); \
      const unsigned aad = lbase + (unsigned)(((J) * ST + a_row3) * 2); \
      const unsigned bad = lbase + (unsigned)(((J) * ST + b_row3) * 2); \
      bf16x8 b0, b1, b2, b3, a0, a1, a2, a3; \
      asm volatile("ds_read_b128 %0, %1" : "=v"(b0) : "v"(bad)); \
      asm volatile("ds_read_b128 %0, %1 offset:1024" : "=v"(b1) : "v"(bad)); \
      asm volatile("ds_read_b128 %0, %1 offset:2048" : "=v"(b2) : "v"(bad)); \
      asm volatile("ds_read_b128 %0, %1 offset:3072" : "=v"(b3) : "v"(bad)); \
      asm volatile("ds_read_b128 %0, %1" : "=v"(a0) : "v"(aad)); \
      asm volatile("ds_read_b128 %0, %1 offset:1024" : "=v"(a1) : "v"(aad)); \
      asm volatile("ds_read_b128 %0, %1 offset:2048" : "=v"(a2) : "v"(aad)); \
      asm volatile("ds_read_b128 %0, %1 offset:3072" : "=v"(a3) : "v"(aad)); \
      __builtin_amdgcn_s_setprio(1); \
      asm volatile("s_waitcnt lgkmcnt(3)" : "+v"(b0), "+v"(b1), "+v"(b2), "+v"(b3), "+v"(a0)); \
      acc[0][0] = mfma16(b0, a0, acc[0][0]); acc[0][1] = mfma16(b1, a0, acc[0][1]); acc[0][2] = mfma16(b2, a0, acc[0][2]); acc[0][3] = mfma16(b3, a0, acc[0][3]); \
      asm volatile("s_waitcnt lgkmcnt(2)" : "+v"(a1)); \
      acc[1][0] = mfma16(b0, a1, acc[1][0]); acc[1][1] = mfma16(b1, a1, acc[1][1]); acc[1][2] = mfma16(b2, a1, acc[1][2]); acc[1][3] = mfma16(b3, a1, acc[1][3]); \
      asm volatile("s_waitcnt lgkmcnt(1)" : "+v"(a2)); \
      acc[2][0] = mfma16(b0, a2, acc[2][0]); acc[2][1] = mfma16(b1, a2, acc[2][1]); acc[2][2] = mfma16(b2, a2, acc[2][2]); acc[2][3] = mfma16(b3, a2, acc[2][3]); \
      asm volatile("s_waitcnt lgkmcnt(0)" : "+v"(a3)); \
      acc[3][0] = mfma16(b0, a3, acc[3][0]); acc[3][1] = mfma16(b1, a3, acc[3][1]); acc[3][2] = mfma16(b2, a3, acc[3][2]); acc[3][3] = mfma16(b3, a3, acc[3][3]); \
      if (kt + 3 < nk32) GD3(kt + 3, ((J) + 3) & 3);     \
      asm volatile("ds_read_b128 %0, %1 offset:4096" : "=v"(a0) : "v"(aad)); \
      asm volatile("ds_read_b128 %0, %1 offset:5120" : "=v"(a1) : "v"(aad)); \
      asm volatile("ds_read_b128 %0, %1 offset:6144" : "=v"(a2) : "v"(aad)); \
      asm volatile("ds_read_b128 %0, %1 offset:7168" : "=v"(a3) : "v"(aad)); \
      asm volatile("s_waitcnt lgkmcnt(3)" : "+v"(a0), "+v"(b0), "+v"(b1), "+v"(b2), "+v"(b3)); \
      acc[4][0] = mfma16(b0, a0, acc[4][0]); acc[4][1] = mfma16(b1, a0, acc[4][1]); acc[4][2] = mfma16(b2, a0, acc[4][2]); acc[4][3] = mfma16(b3, a0, acc[4][3]); \
      asm volatile("s_waitcnt lgkmcnt(2)" : "+v"(a1)); \
      acc[5][0] = mfma16(b0, a1, acc[5][0]); acc[5][1] = mfma16(b1, a1, acc[5][1]); acc[5][2] = mfma16(b2, a1, acc[5][2]); acc[5][3] = mfma16(b3, a1, acc[5][3]); \
      asm volatile("s_waitcnt lgkmcnt(1)" : "+v"(a2)); \
      acc[6][0] = mfma16(b0, a2, acc[6][0]); acc[6][1] = mfma16(b1, a2, acc[6][1]); acc[6][2] = mfma16(b2, a2, acc[6][2]); acc[6][3] = mfma16(b3, a2, acc[6][3]); \
      asm volatile("s_waitcnt lgkmcnt(0)" : "+v"(a3)); \
      acc[7][0] = mfma16(b0, a3, acc[7][0]); acc[7][1] = mfma16(b1, a3, acc[7][1]); acc[7][2] = mfma16(b2, a3, acc[7][2]); acc[7][3] = mfma16(b3, a3, acc[7][3]); \
      __builtin_amdgcn_s_setprio(0); }
    for (int kt0 = 0; kt0 < nk32; kt0 += 4) {
      RING_STEP(0) RING_STEP(1) RING_STEP(2) RING_STEP(3)
    }
#undef RING_STEP
    __syncthreads();
    if (e.ldc) {
      const int nx = e.ldc - 1;
      const u16* Ad2 = A + (size_t)((nx & 255) * BM + (tid >> 2)) * K + (((tid & 3) ^ fs) << 3);
      const u16* Bd2 = Wt + (size_t)((nx >> 8) * BN + (tid >> 2)) * K + (((tid & 3) ^ fs) << 3);
      GD3P(Ad2, Bd2, 0, 0);
      if (nk32 > 1) GD3P(Ad2, Bd2, 1, 1);
      if (nk32 > 2) GD3P(Ad2, Bd2, 2, 2);
    }
#undef GD3
#undef GD3P
  } else if constexpr (DEPTH == 0) {
    const int swz = (lr >> 1) & 7;
    const u16* Ad = A + (size_t)(tm * BM + lr) * K + ((lc ^ swz) << 3);
    const u16* Bd = Wt + (size_t)(tn * BN + lr) * K + ((lc ^ swz) << 3);
    u16* Al = As + tid * 8;
    u16* Bl = Bs + tid * 8;
#define GD(KT, BUF) { _Pragma("unroll") for (int i = 0; i < NA; ++i) __builtin_amdgcn_global_load_lds((const unsigned*)(Ad + (size_t)i * 64 * K + (KT) * 64), (unsigned*)(Al + (BUF) * BUFSZ + i * 4096), 16, 0, 0); \
                      _Pragma("unroll") for (int i = 0; i < NB; ++i) __builtin_amdgcn_global_load_lds((const unsigned*)(Bd + (size_t)i * 64 * K + (KT) * 64), (unsigned*)(Bl + (BUF) * BUFSZ + i * 4096), 16, 0, 0); }
    GD(0, 0);
    asm volatile("s_waitcnt vmcnt(0)" ::: "memory");
    __syncthreads();
    for (int kt = 0; kt < nk; kt += 2) {
      if (kt + 1 < nk) GD(kt + 1, 1);
      g_compute<FI, FJ, (EPI != EPI_KVUP)>(acc, As + a_row, Bs + b_row, q4, rsw);
      asm volatile("s_waitcnt vmcnt(0)" ::: "memory");
      __syncthreads();
      if (kt + 1 >= nk) break;
      if (kt + 2 < nk) GD(kt + 2, 0);
      g_compute<FI, FJ, (EPI != EPI_KVUP)>(acc, As + BUFSZ + a_row, Bs + BUFSZ + b_row, q4, rsw);
      asm volatile("s_waitcnt vmcnt(0)" ::: "memory");
      __syncthreads();
    }
#undef GD
  } else if constexpr (DEPTH == 2) {
    u32x4 ra0[NA], rb0[NB], ra1[NA], rb1[NB];
    GL(ra0, rb0, 0);
    if (nk > 1) GL(ra1, rb1, 1);
    GS(ra0, rb0, 0);
    __syncthreads();
    for (int kt = 0; kt < nk; kt += 2) {
      if (kt + 2 < nk) GL(ra0, rb0, kt + 2);
      g_compute<FI, FJ, (EPI != EPI_KVUP)>(acc, As + a_row, Bs + b_row, q4, rsw);
      if (kt + 1 < nk) GS(ra1, rb1, 1);
      __syncthreads();
      if (kt + 1 >= nk) break;
      if (kt + 3 < nk) GL(ra1, rb1, kt + 3);
      g_compute<FI, FJ, (EPI != EPI_KVUP)>(acc, As + BUFSZ + a_row, Bs + BUFSZ + b_row, q4, rsw);
      if (kt + 2 < nk) GS(ra0, rb0, 0);
      __syncthreads();
    }
  } else {
    u32x4 ra0[NA], rb0[NB];
    GL(ra0, rb0, 0);
    GS(ra0, rb0, 0);
    __syncthreads();
    for (int kt = 0; kt < nk; kt += 2) {
      if (kt + 1 < nk) GL(ra0, rb0, kt + 1);
      g_compute<FI, FJ, (EPI != EPI_KVUP)>(acc, As + a_row, Bs + b_row, q4, rsw);
      if (kt + 1 < nk) GS(ra0, rb0, 1);
      __syncthreads();
      if (kt + 1 >= nk) break;
      if (kt + 2 < nk) GL(ra0, rb0, kt + 2);
      g_compute<FI, FJ, (EPI != EPI_KVUP)>(acc, As + BUFSZ + a_row, Bs + BUFSZ + b_row, q4, rsw);
      if (kt + 2 < nk) GS(ra0, rb0, 0);
      __syncthreads();
    }
  }
#undef GL
#undef GS
  const int mb = tm * BM + wm * FI * 16 + q4 * 4;
  const int nb = tn * BN + wn * FJ * 16;
  const int mrow = tm * BM + wm * FI * 16 + l15;
  if (EPI == EPI_STORE) {
#pragma unroll
    for (int i = 0; i < FI; ++i)
#pragma unroll
      for (int j = 0; j < FJ; ++j) *(f32x4*)(e.C + (size_t)(mrow + i * 16) * e.ldc + nb + j * 16 + q4 * 4) = acc[i][j];
  } else if (EPI == EPI_RESID) {
    const float cf = e.ldc ? 0.5f : 1.0f;
    const f32x4 cfv = {cf, cf, cf, cf};
#pragma unroll
    for (int i = 0; i < FI; ++i) {
      const int m = mrow + i * 16;
      const float* gt = e.gate + (size_t)grp_of(m) * 9216;
#pragma unroll
      for (int j = 0; j < FJ; ++j) {
        const int n = nb + j * 16 + q4 * 4;
        f32x4 g = *(const f32x4*)(gt + n);
        f32x4* px = (f32x4*)(e.C + (size_t)m * 1024 + n);
        f32x4 xv;
        if (e.vtp) xv = *(const f32x4*)((m < NPR ? (const float*)e.vtp + (size_t)m * 1024 : (const float*)e.vts + (size_t)(m - NPR) * 1024) + n);
        else xv = *px;
        xv += g * cfv * acc[i][j];
        *px = xv;
      }
    }
  } else if (EPI == EPI_SWIGLU) {
    const bool odd = (q4 & 1) != 0;
#pragma unroll
    for (int j = 0; j < FJ; ++j) {
      const int hj = ((nb >> 4) + j) * 8 + (q4 >> 1) * 4;
#pragma unroll
      for (int i2 = 0; i2 < FI / 2; ++i2) {
        float hv[4];
#pragma unroll
        for (int r = 0; r < 4; ++r) {
          float send = odd ? acc[2 * i2][j][r] : acc[2 * i2 + 1][j][r];
          float recv = shx(send, 16);
          float g = odd ? recv : acc[2 * i2][j][r];
          float u = odd ? acc[2 * i2 + 1][j][r] : recv;
          hv[r] = silu_f(g) * u;
        }
        const int m = mrow + (2 * i2 + (odd ? 1 : 0)) * 16;
        uint2 o; o.x = pack2(hv[0], hv[1]); o.y = pack2(hv[2], hv[3]);
        *(uint2*)(e.H + (size_t)m * 2816 + hj) = o;
      }
    }
  } else if (EPI == EPI_KVUP) {
#pragma unroll
    for (int j = 0; j < FJ; ++j) {
      const int n0 = nb + j * 16;
      const int hh = n0 >> 7, wb = n0 & 127;
#pragma unroll
      for (int i = 0; i < FI; ++i) {
        const int m0 = mb + i * 16;
        int krow; u16* vt;
        if (e.ctx) {
          int b = m0 >> 9, key = m0 & 511;
          krow = NPR + b * 1536 + 1024 + key;
          vt = e.vts + (size_t)((b * 8 + hh) * 64) * 1536 + 1024 + key;
        } else if (m0 < NPR) {
          int b = m0 >> 8, t = m0 & 255;
          krow = m0;
          vt = e.vtp + (size_t)((b * 8 + hh) * 64) * 256 + t;
        } else {
          int s = m0 - NPR, b = s >> 10, t = s & 1023;
          krow = NPR + b * 1536 + t;
          vt = e.vts + (size_t)((b * 8 + hh) * 64) * 1536 + t;
        }
        if (wb < 64) {
#pragma unroll
          for (int r = 0; r < 4; ++r) e.kb[(size_t)(krow + r) * 768 + hh * 96 + wb + l15] = f2bf(acc[i][j][r]);
        } else {
          const int d = wb - 64 + l15;
          const size_t L = (e.ctx || m0 >= NPR) ? 1536 : 256;
          uint2 o; o.x = pack2(acc[i][j][0], acc[i][j][1]); o.y = pack2(acc[i][j][2], acc[i][j][3]);
          *(uint2*)(vt + (size_t)d * L) = o;
        }
      }
    }
  }
}

template <int EPI, int WMW, int WNW, int FI, int FJ, int DEPTH>
__device__ __forceinline__ void gemm_phase(const u16* A, const u16* Wt, int K, int Mt, int Nt, const EpiP& e, char* smem) {
  for (int t = rbid(); t < Mt * Nt; t += (int)gridDim.x) gemm_tile<EPI, WMW, WNW, FI, FJ, DEPTH>(A, Wt, K, t % Mt, t / Mt, e, smem);
}

__device__ __forceinline__ void ffn_in_phase(PRM p, int l, int which, const EpiP& e, char* smem) {
  const u16* Wt = p.wt_ffn_in + (size_t)(l * 2 + which) * 5632 * 1024;
  const int G = (int)gridDim.x;
  const int nfull = (528 / G) * G;
  {
    bool first = true;
    for (int t = rbid(); t < nfull; t += G) {
      EpiP e2 = e;
      const int tnx = t + G;
      e2.ctx = first ? 0 : 1;
      e2.ldc = (tnx < nfull) ? ((tnx % 24) | ((tnx / 24) << 8)) + 1 : 0;
      gemm_tile<EPI_SWIGLU, 2, 4, 8, 4, 3>(p.xn, Wt, 1024, t % 24, t / 24, e2, smem);
      first = false;
    }
  }
  const int nq = (528 - nfull) * 4;
  const int bid = rbid();
  for (int u = bid; u < nq; u += G) {
    const int t = nfull + (u >> 2), sub = u & 3;
    gemm_tile<EPI_SWIGLU, 4, 2, 2, 4, 2>(p.xn, Wt, 1024, (t % 24) * 2 + (sub >> 1), (t / 24) * 2 + (sub & 1), e, smem);
  }
  const int tail = nq < G ? nq : G;
  if (l < 3 && bid >= tail) {
    const int vb = rtid() >> 8;
    char* vsm = smem + vb * LDS_HALF;
    const int nfree = (G - tail) * 2;
    const int vrank = (bid - tail) * 2 + vb;
    const int cnt = conv_layer_count(l + 1);
    const int half = cnt >> 1;
    const int lo = which ? half : 0, hi = which ? cnt : half;
    for (int c = lo + vrank; c < hi; c += nfree) conv_layer_task(p, l + 1, c, (float*)vsm);
    for (int c = nfree - 1 - vrank; c < 72; c += nfree) mod_task(p, (l + 1) * 144 + which * 72 + c, (float*)vsm);
  }
}

__device__ __forceinline__ void rope_store_kb(PRM p, float val, int lane, int t, bool sample, int krow) {
  float outv = val;
  if (sample) {
    float partner = shx(val, 8);
    int w = lane & 15, fi = w & 7;
    float pos = (float)((lane & 16) ? (t & 63) : (t >> 6));
    float fr = __expf(-9.210340372f * (float)fi * 0.125f);
    float s, c; sincos_r(pos * fr, s, c);
    outv = (w < 8) ? val * c - partner * s : val * c + partner * s;
  }
  if (lane < 32) {
    u16 b = f2bf(outv);
#pragma unroll
    for (int h = 0; h < 8; ++h) p.kb[(size_t)krow * 768 + h * 96 + 64 + lane] = b;
  }
}

__device__ __forceinline__ void post_even(PRM p, int e) {
  const int tid = get_tid(), lane = tid & 63, wave = tid >> 6;
  const int NT = NTOK / 4;
  const int NC = 256;
  for (int task = get_bid(); task < NT + NC; task += vgrid()) {
    if (task < NT) {
      const int m0 = task * 4, m = m0 + wave;
      const bool pr = m < NPR;
      const int b = pr ? (m >> 8) : ((m - NPR) >> 10);
      const int t = pr ? (m & 255) : ((m - NPR) & 1023);
      const float* row = p.proj + (size_t)m * 2688;
      {
        float4 a0 = *(const float4*)(row + lane * 8), a1 = *(const float4*)(row + lane * 8 + 4);
        uint4 o; o.x = pack2(a0.x, a0.y); o.y = pack2(a0.z, a0.w); o.z = pack2(a1.x, a1.y); o.w = pack2(a1.z, a1.w);
        *(uint4*)(p.qa + (size_t)m * 512 + lane * 8) = o;
        float4 k0 = *(const float4*)(row + 512 + lane * 8), k1 = *(const float4*)(row + 512 + lane * 8 + 4);
        o.x = pack2(k0.x, k0.y); o.y = pack2(k0.z, k0.w); o.z = pack2(k1.x, k1.y); o.w = pack2(k1.z, k1.w);
        *(uint4*)(p.ka + (size_t)m * 512 + lane * 8) = o;
        if (pr) {
          float* ok = p.out + O_AK + ((size_t)(b * 2 + e) * 256 + t) * 512 + lane * 8;
          *(float4*)ok = k0; *(float4*)(ok + 4) = k1;
          float4 v0 = *(const float4*)(row + 1024 + lane * 8), v1 = *(const float4*)(row + 1024 + lane * 8 + 4);
          float* ov = p.out + O_AV + ((size_t)(b * 2 + e) * 256 + t) * 512 + lane * 8;
          *(float4*)ov = v0; *(float4*)(ov + 4) = v1;
        }
      }
      {
        float4 c0 = *(const float4*)(row + 1536 + lane * 12), c1 = *(const float4*)(row + 1536 + lane * 12 + 4), c2 = *(const float4*)(row + 1536 + lane * 12 + 8);
        float ss = c0.x * c0.x + c0.y * c0.y + c0.z * c0.z + c0.w * c0.w + c1.x * c1.x + c1.y * c1.y + c1.z * c1.z + c1.w * c1.w +
                   c2.x * c2.x + c2.y * c2.y + c2.z * c2.z + c2.w * c2.w;
        ss = wsum(ss);
        float r = rsqrtf(ss * (1.f / 768.f) + EPS);
        const float* g = p.b_q_norm + e * 768 + lane * 12;
        float4 g0 = *(const float4*)g, g1 = *(const float4*)(g + 4), g2 = *(const float4*)(g + 8);
        uint2 o0, o1, o2;
        o0.x = pack2(c0.x * r * g0.x, c0.y * r * g0.y); o0.y = pack2(c0.z * r * g0.z, c0.w * r * g0.w);
        o1.x = pack2(c1.x * r * g1.x, c1.y * r * g1.y); o1.y = pack2(c1.z * r * g1.z, c1.w * r * g1.w);
        o2.x = pack2(c2.x * r * g2.x, c2.y * r * g2.y); o2.y = pack2(c2.z * r * g2.z, c2.w * r * g2.w);
        u16* d = p.cqn + (size_t)m * 768 + lane * 12;
        *(uint2*)d = o0; *(uint2*)(d + 4) = o1; *(uint2*)(d + 8) = o2;
      }
      {
        float4 c0 = *(const float4*)(row + 2304 + lane * 4);
        float ss = wsum(c0.x * c0.x + c0.y * c0.y + c0.z * c0.z + c0.w * c0.w);
        float r = rsqrtf(ss * (1.f / 256.f) + EPS);
        float4 g0 = *(const float4*)(p.b_kv_norm + e * 256 + lane * 4);
        float4 y; y.x = c0.x * r * g0.x; y.y = c0.y * r * g0.y; y.z = c0.z * r * g0.z; y.w = c0.w * r * g0.w;
        uint2 o; o.x = pack2(y.x, y.y); o.y = pack2(y.z, y.w);
        *(uint2*)(p.ckvn + (size_t)m * 256 + lane * 4) = o;
        if (pr) *(float4*)(p.out + O_CKV + ((size_t)(b * 2 + e) * 256 + t) * 256 + lane * 4) = y;
      }
      {
        float val = row[2560 + (lane & 31)];
        if (pr && lane < 32) p.out[O_KR + ((size_t)(b * 2 + e) * 256 + t) * 32 + lane] = val;
        rope_store_kb(p, val, lane, t, !pr, keyrow(m));
      }
      {
        const bool pr0 = m0 < NPR;
        const int b0 = pr0 ? (m0 >> 8) : ((m0 - NPR) >> 10);
        const int t0 = pr0 ? (m0 & 255) : ((m0 - NPR) & 1023);
#pragma unroll
        for (int i = 0; i < 2; ++i) {
          int pp = tid + 256 * i, h = pp >> 6, d = pp & 63;
          const float* src = p.proj + (size_t)m0 * 2688 + 1024 + h * 64 + d;
          float v0 = src[0], v1 = src[2688], v2 = src[2 * 2688], v3 = src[3 * 2688];
          uint2 o; o.x = pack2(v0, v1); o.y = pack2(v2, v3);
          u16* dst = pr0 ? p.vta_p + (size_t)((b0 * 8 + h) * 64 + d) * 256 + t0 : p.vta_s + (size_t)((b0 * 8 + h) * 64 + d) * 1536 + t0;
          *(uint2*)dst = o;
        }
      }
    } else {
      const int ct = task - NT;
      const int b = ct >> 7, key0 = (ct & 127) * 4;
      {
        const float* src = p.cache_a_k + ((size_t)(b * 2 + e) * 512 + key0) * 512;
        u16* dst = p.kactx + ((size_t)b * 512 + key0) * 512;
#pragma unroll
        for (int i = 0; i < 2; ++i) {
          int idx = (tid + 256 * i) * 4;
          float4 v = *(const float4*)(src + idx);
          uint2 o; o.x = pack2(v.x, v.y); o.y = pack2(v.z, v.w);
          *(uint2*)(dst + idx) = o;
        }
      }
      {
        const float* src = p.cache_a_v + ((size_t)(b * 2 + e) * 512 + key0) * 512;
#pragma unroll
        for (int i = 0; i < 2; ++i) {
          int pp = tid + 256 * i, h = pp >> 6, d = pp & 63;
          float v0 = src[pp], v1 = src[512 + pp], v2 = src[1024 + pp], v3 = src[1536 + pp];
          uint2 o; o.x = pack2(v0, v1); o.y = pack2(v2, v3);
          *(uint2*)(p.vta_s + (size_t)((b * 8 + h) * 64 + d) * 1536 + 1024 + key0) = o;
        }
      }
      {
        const float* src = p.cache_b_ckv + ((size_t)(b * 2 + e) * 512 + key0) * 256;
        float4 v = *(const float4*)(src + tid * 4);
        uint2 o; o.x = pack2(v.x, v.y); o.y = pack2(v.z, v.w);
        *(uint2*)(p.cctxn + ((size_t)b * 512 + key0) * 256 + tid * 4) = o;
      }
      {
        const float* src = p.cache_b_krope + ((size_t)(b * 2 + e) * 512 + key0) * 32;
#pragma unroll
        for (int i = 0; i < 4; ++i) {
          int idx = tid + 256 * i;
          int kk = idx >> 8, h = (idx >> 5) & 7, dd = idx & 31;
          p.kb[(size_t)(NPR + b * 1536 + 1024 + key0 + kk) * 768 + h * 96 + 64 + dd] = f2bf(src[kk * 32 + dd]);
        }
      }
    }
  }
}

__device__ __forceinline__ void post_odd(PRM p, int o) {
  const int tid = get_tid(), lane = tid & 63, wave = tid >> 6;
  const int NT = NTOK / 4, NC = 256;
  for (int task = get_bid(); task < NT + NC; task += vgrid()) {
    if (task < NT) {
      const int m0 = task * 4, m = m0 + wave;
      const bool pr = m < NPR;
      const int b = pr ? (m >> 8) : ((m - NPR) >> 10);
      const int t = pr ? (m & 255) : ((m - NPR) & 1023);
      const float* row = p.proj + (size_t)m * 2432;
      float rs = 0.f, rc = 1.f;
      if (!pr) {
        int w = lane & 31, fi = w & 15;
        float pos = (float)((lane & 32) ? (t & 63) : (t >> 6));
        float fr = __expf(-9.210340372f * (float)fi * (1.f / 16.f));
        sincos_r(pos * fr, rs, rc);
      }
      const bool lo = (lane & 16) == 0;
      const float gq = p.d_q_norm[o * 64 + lane], gk = p.d_k_norm[o * 64 + lane];
#pragma unroll
      for (int hd = 0; hd < 8; ++hd) {
        float v = row[1552 + hd * 64 + lane];
        float ss = wsum(v * v);
        float y = v * rsqrtf(ss * (1.f / 64.f) + EPS) * gq;
        if (!pr) { float pt = shx(y, 16); y = lo ? y * rc - pt * rs : y * rc + pt * rs; }
        p.qa[(size_t)m * 512 + hd * 64 + lane] = f2bf(y);
      }
#pragma unroll
      for (int kh = 0; kh < 2; ++kh) {
        float v = row[2064 + kh * 64 + lane];
        float ss = wsum(v * v);
        float y = v * rsqrtf(ss * (1.f / 64.f) + EPS) * gk;
        if (pr) p.out[O_DK + ((size_t)(b * 2 + o) * 256 + t) * 128 + kh * 64 + lane] = y;
        else { float pt = shx(y, 16); y = lo ? y * rc - pt * rs : y * rc + pt * rs; }
        p.kd[(size_t)keyrow(m) * 128 + kh * 64 + lane] = f2bf(y);
        if (pr) p.out[O_DV + ((size_t)(b * 2 + o) * 256 + t) * 128 + kh * 64 + lane] = row[2192 + kh * 64 + lane];
      }
      if (tid < 128) {
        const bool pr0 = m0 < NPR;
        const int b0 = pr0 ? (m0 >> 8) : ((m0 - NPR) >> 10);
        const int t0 = pr0 ? (m0 & 255) : ((m0 - NPR) & 1023);
        int kh = tid >> 6, d = tid & 63;
        const float* src = p.proj + (size_t)m0 * 2432 + 2192 + tid;
        float v0 = src[0], v1 = src[2432], v2 = src[2 * 2432], v3 = src[3 * 2432];
        uint2 oo; oo.x = pack2(v0, v1); oo.y = pack2(v2, v3);
        u16* dst = pr0 ? p.vtd_p + (size_t)((b0 * 2 + kh) * 64 + d) * 256 + t0 : p.vtd_s + (size_t)((b0 * 2 + kh) * 64 + d) * 1536 + t0;
        *(uint2*)dst = oo;
      }
    } else {
      const int ct = task - NT;
      const int b = ct >> 7, key0 = (ct & 127) * 4;
      {
        const float* src = p.cache_d_k + ((size_t)(b * 2 + o) * 512 + key0) * 128;
        if (tid < 128) {
          float4 v = *(const float4*)(src + tid * 4);
          uint2 oo; oo.x = pack2(v.x, v.y); oo.y = pack2(v.z, v.w);
          *(uint2*)(p.kd + (size_t)(NPR + b * 1536 + 1024 + key0) * 128 + tid * 4) = oo;
        } else {
          int pp = tid - 128, kh = pp >> 6, d = pp & 63;
          const float* sv = p.cache_d_v + ((size_t)(b * 2 + o) * 512 + key0) * 128;
          float v0 = sv[pp], v1 = sv[128 + pp], v2 = sv[256 + pp], v3 = sv[384 + pp];
          uint2 oo; oo.x = pack2(v0, v1); oo.y = pack2(v2, v3);
          *(uint2*)(p.vtd_s + (size_t)((b * 2 + kh) * 64 + d) * 1536 + 1024 + key0) = oo;
        }
      }
    }
  }
}

struct AttnSt { float m, l; f32x4 o[4]; };
template <int KS> struct KVf { bf16x8 k0[KS], k1[KS]; s16x4 v0[4], v1[4]; };

template <int KS>
__device__ __forceinline__ void attn_load(KVf<KS>& f, const u16* __restrict__ Kb, int kstride, const u16* __restrict__ Vtb, int vtstride, int l15, int q4) {
  const u16* k0p = Kb + (size_t)l15 * kstride + q4 * 8;
  const u16* k1p = k0p + (size_t)16 * kstride;
#pragma unroll
  for (int ks = 0; ks < KS; ++ks) { f.k0[ks] = *(const bf16x8*)(k0p + ks * 32); f.k1[ks] = *(const bf16x8*)(k1p + ks * 32); }
#pragma unroll
  for (int dt = 0; dt < 4; ++dt) {
    const u16* vp = Vtb + (size_t)(dt * 16 + l15) * vtstride + q4 * 4;
    f.v0[dt] = *(const s16x4*)vp; f.v1[dt] = *(const s16x4*)(vp + 16);
  }
}

template <int KS>
__device__ __forceinline__ void attn_comp(AttnSt& st, const bf16x8 (&qf)[KS], const KVf<KS>& f, float scale, int q4,
                                          bool masked, const float* rpbrow, int qc, int kc0) {
  f32x4 s0 = {0.f, 0.f, 0.f, 0.f}, s1 = {0.f, 0.f, 0.f, 0.f};
#pragma unroll
  for (int ks = 0; ks < KS; ++ks) { s0 = mfma16(f.k0[ks], qf[ks], s0); s1 = mfma16(f.k1[ks], qf[ks], s1); }
  float sv[8];
#pragma unroll
  for (int j = 0; j < 4; ++j) { sv[j] = s0[j] * scale; sv[4 + j] = s1[j] * scale; }
  if (masked) {
    const int cs = min(max(qc - 8, 0), 48);
#pragma unroll
    for (int e = 0; e < 8; ++e) {
      int kc = kc0 + (e >> 2) * 16 + q4 * 4 + (e & 3);
      bool ok = (kc >= cs) && (kc < cs + 16);
      int di = min(max(kc - qc, -15), 15) + 15;
      sv[e] = ok ? sv[e] + rpbrow[di] : -INFINITY;
    }
  }
  float mx = sv[0];
#pragma unroll
  for (int e = 1; e < 8; ++e) mx = fmaxf(mx, sv[e]);
  mx = fmaxf(mx, shx(mx, 16));
  mx = fmaxf(mx, shx(mx, 32));
  const float mnew = fmaxf(st.m, mx);
  const float alpha = __expf(st.m - mnew);
  float pe[8], ls = 0.f;
#pragma unroll
  for (int e = 0; e < 8; ++e) { pe[e] = __expf(sv[e] - mnew); ls += pe[e]; }
  st.l = st.l * alpha + ls;
  st.m = mnew;
  bf16x8 pf;
#pragma unroll
  for (int e = 0; e < 8; ++e) pf[e] = (short)f2bf(pe[e]);
#pragma unroll
  for (int dt = 0; dt < 4; ++dt) {
    bf16x8 vf = (bf16x8){f.v0[dt].x, f.v0[dt].y, f.v0[dt].z, f.v0[dt].w, f.v1[dt].x, f.v1[dt].y, f.v1[dt].z, f.v1[dt].w};
    st.o[dt] *= alpha;
    st.o[dt] = mfma16(vf, pf, st.o[dt]);
  }
}

__device__ __forceinline__ void attn_init(AttnSt& st) {
  st.m = -1e30f; st.l = 0.f;
#pragma unroll
  for (int dt = 0; dt < 4; ++dt) st.o[dt] = (f32x4){0.f, 0.f, 0.f, 0.f};
}
__device__ __forceinline__ void attn_fin(AttnSt& st, u16* outp  , int l15, int q4) {
  float lt = st.l;
  lt += shx(lt, 16);
  lt += shx(lt, 32);
  const float inv = 1.f / lt;
#pragma unroll
  for (int dt = 0; dt < 4; ++dt) {
    uint2 o; o.x = pack2(st.o[dt][0] * inv, st.o[dt][1] * inv); o.y = pack2(st.o[dt][2] * inv, st.o[dt][3] * inv);
    *(uint2*)(outp + (size_t)l15 * 1024 + dt * 16 + q4 * 4) = o;
  }
}

#define AT_VSTR 72
template <int KS> struct ATile { static constexpr int KSTR = KS * 32 + 8; static constexpr int BUF = 64 * (KS * 32 + 8) + 64 * AT_VSTR; };
template <int KS> struct AStage { u32x4 k[KS]; u32x4 v[2]; };

template <int KS>
__device__ __forceinline__ void at_load(AStage<KS>& r, const u16* __restrict__ Kg, int kstride, const u16* __restrict__ Vg, int vtstride, int tid) {
#pragma unroll
  for (int i = 0; i < KS; ++i) {
    int c = tid + 256 * i; int row = c / (KS * 4), ch = c - row * (KS * 4);
    r.k[i] = *(const u32x4*)(Kg + (unsigned)(row * kstride + ch * 8));
  }
#pragma unroll
  for (int i = 0; i < 2; ++i) {
    int c = tid + 256 * i; int row = c >> 3, ch = c & 7;
    r.v[i] = *(const u32x4*)(Vg + (unsigned)(row * vtstride + ch * 8));
  }
}
template <int KS>
__device__ __forceinline__ void at_store(const AStage<KS>& r, u16* buf, int tid) {
  u16* Ks = buf; u16* Vs = buf + 64 * ATile<KS>::KSTR;
#pragma unroll
  for (int i = 0; i < KS; ++i) {
    int c = tid + 256 * i; int row = c / (KS * 4), ch = c - row * (KS * 4);
    *(u32x4*)(Ks + row * ATile<KS>::KSTR + ch * 8) = r.k[i];
  }
#pragma unroll
  for (int i = 0; i < 2; ++i) {
    int c = tid + 256 * i; int row = c >> 3, ch = c & 7;
    *(u32x4*)(Vs + row * AT_VSTR + ch * 8) = r.v[i];
  }
}

template <int KS>
__device__ __forceinline__ void at_comp(AttnSt& st, const bf16x8 (&qf)[KS], const u16* buf, float scale, int l15, int q4,
                                        bool masked, const float* rpbrow, int qc) {
  const u16* Ks = buf; const u16* Vs = buf + 64 * ATile<KS>::KSTR;
  f32x4 s[4];
#pragma unroll
  for (int kt = 0; kt < 4; ++kt) {
    s[kt] = (f32x4){0.f, 0.f, 0.f, 0.f};
#pragma unroll
    for (int ks = 0; ks < KS; ++ks) {
      bf16x8 a = *(const bf16x8*)(Ks + (kt * 16 + l15) * ATile<KS>::KSTR + ks * 32 + q4 * 8);
      s[kt] = mfma16(a, qf[ks], s[kt]);
    }
  }
  float sv[16];
  const float sc2 = scale * 1.4426950408889634f;
#pragma unroll
  for (int kt = 0; kt < 4; ++kt)
#pragma unroll
    for (int j = 0; j < 4; ++j) sv[kt * 4 + j] = s[kt][j] * sc2;
  if (masked) {
    const int cs = min(max(qc - 8, 0), 48);
#pragma unroll
    for (int e = 0; e < 16; ++e) {
      int kc = (e >> 2) * 16 + q4 * 4 + (e & 3);
      bool ok = (kc >= cs) && (kc < cs + 16);
      int di = min(max(kc - qc, -15), 15) + 15;
      sv[e] = ok ? sv[e] + rpbrow[di] : -INFINITY;
    }
  }
  float mx = sv[0];
#pragma unroll
  for (int e = 1; e < 16; ++e) mx = fmaxf(mx, sv[e]);
  mx = fmaxf(mx, shx(mx, 16));
  mx = fmaxf(mx, shx(mx, 32));
  const float mnew = fmaxf(st.m, mx);
  const float alpha = __builtin_amdgcn_exp2f(st.m - mnew);
  float ls = 0.f;
#pragma unroll
  for (int e = 0; e < 16; ++e) { sv[e] = __builtin_amdgcn_exp2f(sv[e] - mnew); ls += sv[e]; }
  st.l = st.l * alpha + ls;
  st.m = mnew;
  bf16x8 pf[2];
#pragma unroll
  for (int hf = 0; hf < 2; ++hf) {
    u32x4 pw;
    pw[0] = pack2(sv[hf * 8 + 0], sv[hf * 8 + 1]); pw[1] = pack2(sv[hf * 8 + 2], sv[hf * 8 + 3]);
    pw[2] = pack2(sv[hf * 8 + 4], sv[hf * 8 + 5]); pw[3] = pack2(sv[hf * 8 + 6], sv[hf * 8 + 7]);
    pf[hf] = __builtin_bit_cast(bf16x8, pw);
  }
#pragma unroll
  for (int dt = 0; dt < 4; ++dt) {
    st.o[dt] *= alpha;
#pragma unroll
    for (int hf = 0; hf < 2; ++hf) {
      const u16* vp = Vs + (dt * 16 + l15) * AT_VSTR + hf * 32 + q4 * 4;
      s16x4 v0 = *(const s16x4*)vp;
      s16x4 v1 = *(const s16x4*)(vp + 16);
      bf16x8 vf = (bf16x8){v0.x, v0.y, v0.z, v0.w, v1.x, v1.y, v1.z, v1.w};
      st.o[dt] = mfma16(vf, pf[hf], st.o[dt]);
    }
  }
}

template <int KS>
__device__ __forceinline__ void at_run_plain(AttnSt& st, const bf16x8 (&qf)[KS], const u16* Kbase, int kstride, const u16* Vbase, int vtstride,
                                             int nt, float scale, u16* lds, int tid, int l15, int q4) {
  AStage<KS> r0, r1;
  at_load<KS>(r0, Kbase, kstride, Vbase, vtstride, tid);
  if (nt > 1) at_load<KS>(r1, Kbase + (size_t)64 * kstride, kstride, Vbase + 64, vtstride, tid);
  at_store<KS>(r0, lds, tid);
  __syncthreads();
  for (int t = 0; t < nt; t += 2) {
    if (t + 2 < nt) at_load<KS>(r0, Kbase + (size_t)(t + 2) * 64 * kstride, kstride, Vbase + (t + 2) * 64, vtstride, tid);
    at_comp<KS>(st, qf, lds, scale, l15, q4, false, nullptr, 0);
    if (t + 1 < nt) at_store<KS>(r1, lds + ATile<KS>::BUF, tid);
    __syncthreads();
    if (t + 1 >= nt) break;
    if (t + 3 < nt) at_load<KS>(r1, Kbase + (size_t)(t + 3) * 64 * kstride, kstride, Vbase + (t + 3) * 64, vtstride, tid);
    at_comp<KS>(st, qf, lds + ATile<KS>::BUF, scale, l15, q4, false, nullptr, 0);
    if (t + 2 < nt) at_store<KS>(r0, lds, tid);
    __syncthreads();
  }
}

__device__ __forceinline__ void load_q64(bf16x8 (&qf)[2], const u16* Q, int qstride, int l15, int q4) {
#pragma unroll
  for (int ks = 0; ks < 2; ++ks) qf[ks] = *(const bf16x8*)(Q + (size_t)l15 * qstride + ks * 32 + q4 * 8);
}
__device__ __forceinline__ void load_q_mla(bf16x8 (&qf)[3], const float* Qf, int l15, int q4, bool sample, int t0) {
  const float* qr = Qf + (size_t)l15 * 768 + q4 * 8;
#pragma unroll
  for (int ks = 0; ks < 3; ++ks) {
    float4 a = *(const float4*)(qr + ks * 32), b = *(const float4*)(qr + ks * 32 + 4);
    float v[8] = {a.x, a.y, a.z, a.w, b.x, b.y, b.z, b.w};
    if (ks == 2 && sample) {
      const int t = t0 + l15;
      const float pos = (float)((q4 & 2) ? (t & 63) : (t >> 6));
#pragma unroll
      for (int jj = 0; jj < 8; ++jj) {
        float pt = shx(v[jj], 16);
        float fr = __expf(-9.210340372f * (float)jj * 0.125f);
        float sn, cs; sincos_r(pos * fr, sn, cs);
        v[jj] = (q4 & 1) ? v[jj] * cs + pt * sn : v[jj] * cs - pt * sn;
      }
    }
#pragma unroll
    for (int jj = 0; jj < 8; ++jj) qf[ks][jj] = (short)f2bf(v[jj]);
  }
}

__device__ __forceinline__ void attn_even_phase(PRM p, int e, char* smem) {
  u16* lds = (u16*)smem;
  const int tid = get_tid(), lane = tid & 63, wave = tid >> 6, l15 = lane & 15, q4 = lane >> 4;
  const float scaleB = 0.10206207261596577f;
  for (int bt = get_bid(); bt < 1536; bt += vgrid()) {
    AttnSt st; attn_init(st);
    if (bt < 256) {
      int qb = bt & 15, h = (bt >> 4) & 7, b = bt >> 7;
      int mq = NPR + b * 1024 + qb * 64 + wave * 16;
      bf16x8 qf[3]; load_q_mla(qf, p.qb + (size_t)mq * 768 + h * 96, l15, q4, true, qb * 64 + wave * 16);
      at_run_plain<3>(st, qf, p.kb + (size_t)(NPR + b * 1536) * 768 + h * 96, 768, p.vtb_s + (size_t)((b * 8 + h) * 64) * 1536, 1536, 24, scaleB, lds, tid, l15, q4);
      attn_fin(st, p.mix + (size_t)mq * 1024 + 512 + h * 64, l15, q4);
    } else if (bt < 512) {
      int u = bt - 256;
      int r = u & 15, h = (u >> 4) & 7, b = u >> 7;
      int mq = NPR + b * 1024 + r * 64 + wave * 16;
      bf16x8 qf[2]; load_q64(qf, p.qa + (size_t)mq * 512 + h * 64, 512, l15, q4);
      const u16* Vt = p.vta_s + (size_t)((b * 8 + h) * 64) * 1536;
      const u16* Kc = p.kactx + (size_t)b * 512 * 512 + h * 64;
      const int rs = min(max(r - 4, 0), 8);
      const u16* Kw = p.ka + (size_t)(NPR + b * 1024 + rs * 64) * 512 + h * 64;
      const float* rpb0 = p.a_rpb + ((size_t)(e * 8 + h) * 15 + (rs - r + 7)) * 31;
      const int qc = wave * 16 + l15;
      float* rpl = (float*)(lds + 2 * ATile<2>::BUF);
      if (tid < 248) { int rr = tid / 31, cc = tid - rr * 31; rpl[rr * 32 + cc] = rpb0[rr * 31 + cc] * 1.4426950408889634f; }
      AStage<2> r0, r1;
#define NB_LOAD(R, T) { if ((T) < 8) at_load<2>(R, Kc + (size_t)(T) * 64 * 512, 512, Vt + 1024 + (T) * 64, 1536, tid); \
                        else at_load<2>(R, Kw + (size_t)((T) - 8) * 64 * 512, 512, Vt + (rs + (T) - 8) * 64, 1536, tid); }
#define NB_COMP(BUFP, T) { if ((T) < 8) at_comp<2>(st, qf, BUFP, 0.125f, l15, q4, false, nullptr, 0); \
                           else at_comp<2>(st, qf, BUFP, 0.125f, l15, q4, true, rpl + ((T) - 8) * 32, qc); }
      NB_LOAD(r0, 0);
      NB_LOAD(r1, 1);
      at_store<2>(r0, lds, tid);
      __syncthreads();
      for (int t = 0; t < 16; t += 2) {
        if (t + 2 < 16) NB_LOAD(r0, t + 2);
        NB_COMP(lds, t);
        at_store<2>(r1, lds + ATile<2>::BUF, tid);
        __syncthreads();
        if (t + 3 < 16) NB_LOAD(r1, t + 3);
        NB_COMP(lds + ATile<2>::BUF, t + 1);
        if (t + 2 < 16) at_store<2>(r0, lds, tid);
        __syncthreads();
      }
#undef NB_LOAD
#undef NB_COMP
      attn_fin(st, p.mix + (size_t)mq * 1024 + h * 64, l15, q4);
    } else if (bt < 1024) {
      int u = bt - 512;
      int qb = u & 3, h = (u >> 2) & 7, b = u >> 5;
      int mq = b * 256 + qb * 64 + wave * 16;
      bf16x8 qf[3]; load_q_mla(qf, p.qb + (size_t)mq * 768 + h * 96, l15, q4, false, 0);
      at_run_plain<3>(st, qf, p.kb + (size_t)(b * 256) * 768 + h * 96, 768, p.vtb_p + (size_t)((b * 8 + h) * 64) * 256, 256, 4, scaleB, lds, tid, l15, q4);
      attn_fin(st, p.mix + (size_t)mq * 1024 + 512 + h * 64, l15, q4);
    } else {
      int u = bt - 1024;
      int qb = u & 3, h = (u >> 2) & 7, b = u >> 5;
      int mq = b * 256 + qb * 64 + wave * 16;
      bf16x8 qf[2]; load_q64(qf, p.qa + (size_t)mq * 512 + h * 64, 512, l15, q4);
      at_run_plain<2>(st, qf, p.ka + (size_t)(b * 256) * 512 + h * 64, 512, p.vta_p + (size_t)((b * 8 + h) * 64) * 256, 256, 4, 0.125f, lds, tid, l15, q4);
      attn_fin(st, p.mix + (size_t)mq * 1024 + h * 64, l15, q4);
    }
  }
}

__device__ __forceinline__ int mslot(int sq, int h, int dir, int j) {
  return sq < 16 ? ((sq * 4 + h) * 2 + dir) * 4 + j : 512 + (((sq - 16) * 4 + h) * 2 + dir) * 16 + j;
}

__device__ __forceinline__ void mlstm1_task(PRM p, int o, int task, float* sm) {
  const int tid = get_tid(), lane = tid & 63, wave = tid >> 6;
  int sq, h, dir, j;
  if (task < 512) { j = task & 3; dir = (task >> 2) & 1; h = (task >> 3) & 3; sq = task >> 5; }
  else { int u = task - 512; j = u & 15; dir = (u >> 4) & 1; h = (u >> 5) & 3; sq = 16 + (u >> 7); }
  const int T = sq < 16 ? 256 : 1024;
  const int base = sq < 16 ? sq * 256 : NPR + (sq - 16) * 1024;
  const int slot = task;
  float* ks = sm;
  float* vs = sm + 4096;
  float* wg = sm + 4096 + 8192;
  if (wave == 0) {
    int s = 64 * j + lane;
    int t = dir ? T - 1 - s : s;
    const float* row = p.proj + (size_t)(base + t) * 2432 + 1536;
    float ig = row[(dir * 2 + 0) * 4 + h] + p.c_gate_bias[o * 16 + (dir * 2 + 0) * 4 + h];
    float fg = row[(dir * 2 + 1) * 4 + h] + p.c_gate_bias[o * 16 + (dir * 2 + 1) * 4 + h];
    float bsum = logsig_f(fg);
#pragma unroll
    for (int off = 1; off < 64; off <<= 1) { float v = __shfl_up(bsum, off); if (lane >= off) bsum += v; }
    float blast = __shfl(bsum, 63);
    float g = blast - bsum + ig;
    float ml = wmaxr(g);
    wg[lane] = __expf(g - ml);
    if (lane == 0) { p.dm[slot * 2] = ml; p.dm[slot * 2 + 1] = blast; }
  }
#pragma unroll
  for (int ii = 0; ii < 4; ++ii) {
    int i = (tid >> 4) + 16 * ii, c4 = tid & 15;
    int s = 64 * j + i; int t = dir ? T - 1 - s : s;
    float4 v = *(const float4*)(p.proj + (size_t)(base + t) * 2432 + 256 + h * 64 + c4 * 4);
    v.x *= 0.125f; v.y *= 0.125f; v.z *= 0.125f; v.w *= 0.125f;
    *(float4*)(ks + i * 64 + c4 * 4) = v;
  }
#pragma unroll
  for (int ii = 0; ii < 8; ++ii) {
    int i = (tid >> 5) + 8 * ii, c4 = tid & 31;
    int s = 64 * j + i; int t = dir ? T - 1 - s : s;
    *(float4*)(vs + i * 128 + c4 * 4) = *(const float4*)(p.proj + (size_t)(base + t) * 2432 + 512 + h * 128 + c4 * 4);
  }
  __syncthreads();
  const int dg = tid & 15, vg8 = tid >> 4;
  f32x4 acc[8];
#pragma unroll
  for (int q = 0; q < 8; ++q) acc[q] = (f32x4){0.f, 0.f, 0.f, 0.f};
  f32x4 nacc = {0.f, 0.f, 0.f, 0.f};
#pragma unroll 4
  for (int i = 0; i < 64; ++i) {
    f32x4 kd = *(const f32x4*)(ks + i * 64 + dg * 4) * wg[i];
    nacc += kd;
    f32x4 va = *(const f32x4*)(vs + i * 128 + vg8 * 8);
    f32x4 vb = *(const f32x4*)(vs + i * 128 + vg8 * 8 + 4);
    acc[0] += kd * va[0]; acc[1] += kd * va[1]; acc[2] += kd * va[2]; acc[3] += kd * va[3];
    acc[4] += kd * vb[0]; acc[5] += kd * vb[1]; acc[6] += kd * vb[2]; acc[7] += kd * vb[3];
  }
  float* dc = p.dC + (size_t)slot * 8192;
#pragma unroll
  for (int q = 0; q < 8; ++q) *(f32x4*)(dc + (vg8 * 8 + q) * 64 + dg * 4) = acc[q];
  if (vg8 == 0) *(f32x4*)(p.dn + slot * 64 + dg * 4) = nacc;
  __syncthreads();
}

__device__ __forceinline__ void mlstm2_task(PRM p, int o, int task, float* sm) {
  const int tid = get_tid(), lane = tid & 63, wave = tid >> 6;
  int sq, h, c;
  if (task < 256) { c = task & 3; h = (task >> 2) & 3; sq = task >> 4; }
  else { int u = task - 256; c = u & 15; h = (u >> 4) & 3; sq = 16 + (u >> 6); }
  const bool pr = sq < 16;
  const int nc = pr ? 4 : 16;
  const int base = (pr ? sq * 256 : NPR + (sq - 16) * 1024) + c * 64;
  float* qT = sm;
  float* kT = sm + 4352;
  float* CT = kT;
  float* St = sm + 2 * 4352;
  float* vh = sm + 3 * 4352;
  float* smalls = sm + 4 * 4352;
  float* bl = smalls;
  float* itb = smalls + 64;
  float* mt = smalls + 128;
  float* w0 = smalls + 192;
  float* nv = smalls + 256;
  float* nq = smalls + 320;
  float* den = smalls + 384;
  float* scal = smalls + 448;

  const int tl = tid >> 4, tx = tid & 15;
  const int l0 = tl * 4, x0 = tx * 4;
  float hacc[2][4][4];
#pragma unroll
  for (int a = 0; a < 2; ++a)
#pragma unroll
    for (int b2 = 0; b2 < 4; ++b2)
#pragma unroll
      for (int c2 = 0; c2 < 4; ++c2) hacc[a][b2][c2] = 0.f;

  f32x4 qv[4], kv[4];
#pragma unroll
  for (int ii = 0; ii < 4; ++ii) {
    int i = (tid >> 4) + 16 * ii, c4 = tid & 15;
    const float* row = p.proj + (size_t)(base + i) * 2432 + h * 64 + c4 * 4;
    qv[ii] = *(const f32x4*)row;
    kv[ii] = *(const f32x4*)(row + 256);
  }
#pragma unroll
  for (int ii = 0; ii < 4; ++ii) {
    int i = (tid >> 4) + 16 * ii, c4 = tid & 15;
    qT[(c4 * 4 + 0) * 68 + i] = qv[ii].x; qT[(c4 * 4 + 1) * 68 + i] = qv[ii].y; qT[(c4 * 4 + 2) * 68 + i] = qv[ii].z; qT[(c4 * 4 + 3) * 68 + i] = qv[ii].w;
  }
#pragma unroll 1
  for (int dir = 0; dir < 2; ++dir) {
    const int j = dir ? nc - 1 - c : c;
    const int slj = mslot(sq, h, dir, j);
    const float mprev = p.mp[slj];
    float cr[16]; f32x4 vr[4];
    const float* cpp = p.cp + (size_t)slj * 8192;
#pragma unroll
    for (int r = 0; r < 16; ++r) cr[r] = cpp[tid + 256 * r];
#pragma unroll
    for (int ii = 0; ii < 4; ++ii) {
      int i = (tid >> 4) + 16 * ii, c4 = tid & 15;
      vr[ii] = *(const f32x4*)(p.proj + (size_t)(base + i) * 2432 + 512 + h * 128 + c4 * 4);
    }
    if (wave == 0) {
      const int i = lane;
      const int tau = dir ? 63 - i : i;
      const float* row = p.proj + (size_t)(base + tau) * 2432 + 1536;
      float ig = row[(dir * 2 + 0) * 4 + h] + p.c_gate_bias[o * 16 + (dir * 2 + 0) * 4 + h];
      float fg = row[(dir * 2 + 1) * 4 + h] + p.c_gate_bias[o * 16 + (dir * 2 + 1) * 4 + h];
      float bsum = logsig_f(fg);
#pragma unroll
      for (int off = 1; off < 64; off <<= 1) { float v = __shfl_up(bsum, off); if (lane >= off) bsum += v; }
      float ib = ig - bsum;
      float pm = ib;
#pragma unroll
      for (int off = 1; off < 64; off <<= 1) { float v = __shfl_up(pm, off); if (lane >= off) pm = fmaxf(pm, v); }
      float mti = fmaxf(bsum + mprev, bsum + pm);
      bl[tau] = bsum; itb[tau] = ib; mt[tau] = mti; w0[tau] = __expf(bsum + mprev - mti);
    }
#pragma unroll
    for (int ii = 0; ii < 4; ++ii) {
      int i = (tid >> 4) + 16 * ii, c4 = tid & 15;
      kT[(c4 * 4 + 0) * 68 + i] = kv[ii].x * 0.125f; kT[(c4 * 4 + 1) * 68 + i] = kv[ii].y * 0.125f;
      kT[(c4 * 4 + 2) * 68 + i] = kv[ii].z * 0.125f; kT[(c4 * 4 + 3) * 68 + i] = kv[ii].w * 0.125f;
    }
    if (tid < 64) nv[tid] = p.np[slj * 64 + tid];
    __syncthreads();
    {
      float a[4][4];
#pragma unroll
      for (int r = 0; r < 4; ++r)
#pragma unroll
        for (int q = 0; q < 4; ++q) a[r][q] = 0.f;
#pragma unroll 2
      for (int d = 0; d < 64; ++d) {
        float4 q4v = *(const float4*)(qT + d * 68 + l0);
        float4 k4v = *(const float4*)(kT + d * 68 + x0);
        float qa[4] = {q4v.x, q4v.y, q4v.z, q4v.w}, kk[4] = {k4v.x, k4v.y, k4v.z, k4v.w};
#pragma unroll
        for (int r = 0; r < 4; ++r)
#pragma unroll
          for (int q = 0; q < 4; ++q) a[r][q] = fmaf(qa[r], kk[q], a[r][q]);
      }
      float rsum[4];
#pragma unroll
      for (int r = 0; r < 4; ++r) {
        const int l = l0 + r;
        const float bll = bl[l], mtl = mt[l];
        rsum[r] = 0.f;
#pragma unroll
        for (int q = 0; q < 4; ++q) {
          const int s = x0 + q;
          const bool ok = dir ? (s >= l) : (s <= l);
          float sv = ok ? a[r][q] * __expf(bll + itb[s] - mtl) : 0.f;
          St[s * 68 + l] = sv;
          rsum[r] += sv;
        }
        rsum[r] += shx(rsum[r], 1); rsum[r] += shx(rsum[r], 2);
        rsum[r] += shx(rsum[r], 4); rsum[r] += shx(rsum[r], 8);
        if (tx == 0) den[l] = rsum[r];
      }
    }
    __syncthreads();
    if (tid < 64) {
      float s = 0.f;
#pragma unroll 4
      for (int d = 0; d < 64; ++d) s = fmaf(qT[d * 68 + tid], nv[d], s);
      nq[tid] = s;
    }
#pragma unroll 1
    for (int vhalf = 0; vhalf < 2; ++vhalf) {
#pragma unroll
      for (int r = 0; r < 16; ++r) {
        int e = tid + 256 * r;
        CT[(e & 63) * 68 + (e >> 6)] = cr[r];
      }
#pragma unroll
      for (int ii = 0; ii < 4; ++ii) {
        int i = (tid >> 4) + 16 * ii, c4 = tid & 15;
        *(f32x4*)(vh + i * 68 + c4 * 4) = vr[ii];
      }
      if (vhalf == 0) {
#pragma unroll
        for (int r = 0; r < 16; ++r) cr[r] = cpp[4096 + tid + 256 * r];
#pragma unroll
        for (int ii = 0; ii < 4; ++ii) {
          int i = (tid >> 4) + 16 * ii, c4 = tid & 15;
          vr[ii] = *(const f32x4*)(p.proj + (size_t)(base + i) * 2432 + 512 + h * 128 + 64 + c4 * 4);
        }
      }
      __syncthreads();
      {
        float a1[4][4], a2[4][4];
#pragma unroll
        for (int r = 0; r < 4; ++r)
#pragma unroll
          for (int q = 0; q < 4; ++q) { a1[r][q] = 0.f; a2[r][q] = 0.f; }
#pragma unroll 2
        for (int s = 0; s < 64; ++s) {
          float4 sa = *(const float4*)(St + s * 68 + l0);
          float4 vb = *(const float4*)(vh + s * 68 + x0);
          float4 qa4 = *(const float4*)(qT + s * 68 + l0);
          float4 cb4 = *(const float4*)(CT + s * 68 + x0);
          float sl4[4] = {sa.x, sa.y, sa.z, sa.w}, vv[4] = {vb.x, vb.y, vb.z, vb.w};
          float qq[4] = {qa4.x, qa4.y, qa4.z, qa4.w}, cc[4] = {cb4.x, cb4.y, cb4.z, cb4.w};
#pragma unroll
          for (int r = 0; r < 4; ++r)
#pragma unroll
            for (int q = 0; q < 4; ++q) { a1[r][q] = fmaf(sl4[r], vv[q], a1[r][q]); a2[r][q] = fmaf(qq[r], cc[q], a2[r][q]); }
        }
#pragma unroll
        for (int r = 0; r < 4; ++r) {
          const int l = l0 + r;
          const float w = w0[l];
          const float dn_ = den[l] + w * nq[l];
          const float dd = fmaxf(fabsf(dn_), __expf(-mt[l]));
          const float inv = 1.f / dd;
#pragma unroll
          for (int q = 0; q < 4; ++q) { float hv = (a1[r][q] + w * a2[r][q]) * inv; if (vhalf == 0) hacc[0][r][q] += hv; else hacc[1][r][q] += hv; }
        }
      }
      __syncthreads();
    }
  }
#pragma unroll
  for (int r = 0; r < 4; ++r) {
    float ss = 0.f;
#pragma unroll
    for (int a = 0; a < 2; ++a)
#pragma unroll
      for (int q = 0; q < 4; ++q) ss += hacc[a][r][q] * hacc[a][r][q];
    ss += shx(ss, 1); ss += shx(ss, 2); ss += shx(ss, 4); ss += shx(ss, 8);
    const float rn = rsqrtf(ss * (1.f / 128.f) + EPS);
    const int m = base + l0 + r;
#pragma unroll
    for (int a = 0; a < 2; ++a) {
      const int v0 = a * 64 + x0;
      float4 co = *(const float4*)(p.proj + (size_t)m * 2432 + 1024 + h * 128 + v0);
      float4 gn = *(const float4*)(p.c_out_norm + (size_t)(o * 4 + h) * 128 + v0);
      float y0 = sigmoid_f(co.x) * hacc[a][r][0] * rn * gn.x;
      float y1 = sigmoid_f(co.y) * hacc[a][r][1] * rn * gn.y;
      float y2 = sigmoid_f(co.z) * hacc[a][r][2] * rn * gn.z;
      float y3 = sigmoid_f(co.w) * hacc[a][r][3] * rn * gn.w;
      uint2 oo; oo.x = pack2(y0, y1); oo.y = pack2(y2, y3);
      *(uint2*)(p.mix + (size_t)m * 1024 + h * 128 + v0) = oo;
    }
  }
  __syncthreads();
}

__device__ __forceinline__ void mlstm2_mfma(PRM p, int o, int task, char* smem) {
  const int tid = get_tid(), lane = tid & 63, wave = tid >> 6, l15 = lane & 15, q4 = lane >> 4;
  int sq, h, c;
  if (task < 256) { c = task & 3; h = (task >> 2) & 3; sq = task >> 4; }
  else { int u = task - 256; c = u & 15; h = (u >> 4) & 3; sq = 16 + (u >> 6); }
  const bool pr = sq < 16;
  const int nc = pr ? 4 : 16;
  const int base = (pr ? sq * 256 : NPR + (sq - 16) * 1024) + c * 64;
  u16* Qb = (u16*)smem;
  u16* Kb = Qb + 64 * 72;
  u16* Vt = Kb + 64 * 72;
  u16* Cb = Vt + 128 * 72;
  float* sml = (float*)(Cb + 128 * 72);
  float* bl = sml; float* itb = sml + 64; float* mt = sml + 128; float* w0 = sml + 192; float* nv = sml + 256;
#pragma unroll
  for (int ii = 0; ii < 4; ++ii) {
    int i = (tid >> 4) + 16 * ii, c4 = tid & 15;
    const float* row = p.proj + (size_t)(base + i) * 2432 + h * 64 + c4 * 4;
    f32x4 qv = *(const f32x4*)row;
    f32x4 kv = *(const f32x4*)(row + 256);
    uint2 a; a.x = pack2(qv[0], qv[1]); a.y = pack2(qv[2], qv[3]);
    uint2 b; b.x = pack2(kv[0] * 0.125f, kv[1] * 0.125f); b.y = pack2(kv[2] * 0.125f, kv[3] * 0.125f);
    *(uint2*)(Qb + i * 72 + c4 * 4) = a;
    *(uint2*)(Kb + i * 72 + c4 * 4) = b;
  }
#pragma unroll
  for (int ii = 0; ii < 8; ++ii) {
    int i = (tid >> 5) + 8 * ii, c4 = tid & 31;
    f32x4 vv = *(const f32x4*)(p.proj + (size_t)(base + i) * 2432 + 512 + h * 128 + c4 * 4);
    unsigned w01 = pack2(vv[0], vv[1]), w23 = pack2(vv[2], vv[3]);
    Vt[(c4 * 4 + 0) * 72 + i] = (u16)(w01 & 0xffffu); Vt[(c4 * 4 + 1) * 72 + i] = (u16)(w01 >> 16);
    Vt[(c4 * 4 + 2) * 72 + i] = (u16)(w23 & 0xffffu); Vt[(c4 * 4 + 3) * 72 + i] = (u16)(w23 >> 16);
  }
  f32x4 hacc[8];
#pragma unroll
  for (int vt = 0; vt < 8; ++vt) hacc[vt] = (f32x4){0.f, 0.f, 0.f, 0.f};
  const int lrow = wave * 16 + l15;
#pragma unroll 1
  for (int dir = 0; dir < 2; ++dir) {
    const int j = dir ? nc - 1 - c : c;
    const int slj = mslot(sq, h, dir, j);
    const float mprev = p.mp[slj];
    {
      const f32x4* cpp = (const f32x4*)(p.cp + (size_t)slj * 8192);
#pragma unroll
      for (int r = 0; r < 8; ++r) {
        int e4 = tid + 256 * r;
        f32x4 cv = cpp[e4];
        uint2 a; a.x = pack2(cv[0], cv[1]); a.y = pack2(cv[2], cv[3]);
        *(uint2*)(Cb + (e4 >> 4) * 72 + (e4 & 15) * 4) = a;
      }
    }
    if (tid < 64) nv[tid] = p.np[slj * 64 + tid];
    if (wave == 0) {
      const int i = lane;
      const int tau = dir ? 63 - i : i;
      const float* row = p.proj + (size_t)(base + tau) * 2432 + 1536;
      float ig = row[(dir * 2 + 0) * 4 + h] + p.c_gate_bias[o * 16 + (dir * 2 + 0) * 4 + h];
      float fg = row[(dir * 2 + 1) * 4 + h] + p.c_gate_bias[o * 16 + (dir * 2 + 1) * 4 + h];
      float bsum = logsig_f(fg);
#pragma unroll
      for (int off = 1; off < 64; off <<= 1) { float v = __shfl_up(bsum, off); if (lane >= off) bsum += v; }
      float ib = ig - bsum;
      float pm = ib;
#pragma unroll
      for (int off = 1; off < 64; off <<= 1) { float v = __shfl_up(pm, off); if (lane >= off) pm = fmaxf(pm, v); }
      float mti = fmaxf(bsum + mprev, bsum + pm);
      bl[tau] = bsum; itb[tau] = ib; mt[tau] = mti; w0[tau] = __expf(bsum + mprev - mti);
    }
    __syncthreads();
    const float bll = bl[lrow], mtl = mt[lrow], w0l = w0[lrow];
    bf16x8 qf[2];
#pragma unroll
    for (int ks = 0; ks < 2; ++ks) qf[ks] = *(const bf16x8*)(Qb + lrow * 72 + ks * 32 + q4 * 8);
    float nqp = 0.f;
#pragma unroll
    for (int ks = 0; ks < 2; ++ks)
#pragma unroll
      for (int jj = 0; jj < 8; ++jj) {
        float qe = __uint_as_float(((unsigned)(unsigned short)qf[ks][jj]) << 16);
        nqp = fmaf(qe, nv[ks * 32 + q4 * 8 + jj], nqp);
      }
    nqp += shx(nqp, 16); nqp += shx(nqp, 32);
    f32x4 oacc[8];
#pragma unroll
    for (int vt = 0; vt < 8; ++vt) {
      oacc[vt] = (f32x4){0.f, 0.f, 0.f, 0.f};
#pragma unroll
      for (int ks = 0; ks < 2; ++ks) {
        bf16x8 a = *(const bf16x8*)(Cb + (vt * 16 + l15) * 72 + ks * 32 + q4 * 8);
        oacc[vt] = mfma16(a, qf[ks], oacc[vt]);
      }
      oacc[vt] *= w0l;
    }
    float sv[16];
    float dsum = 0.f;
#pragma unroll
    for (int st = 0; st < 4; ++st) {
      f32x4 sa = {0.f, 0.f, 0.f, 0.f};
#pragma unroll
      for (int ks = 0; ks < 2; ++ks) {
        bf16x8 a = *(const bf16x8*)(Kb + (st * 16 + l15) * 72 + ks * 32 + q4 * 8);
        sa = mfma16(a, qf[ks], sa);
      }
#pragma unroll
      for (int r = 0; r < 4; ++r) {
        const int sidx = st * 16 + q4 * 4 + r;
        const bool ok = dir ? (sidx >= lrow) : (sidx <= lrow);
        float val = ok ? sa[r] * __expf(bll + itb[sidx] - mtl) : 0.f;
        sv[st * 4 + r] = val;
        dsum += val;
      }
    }
    dsum += shx(dsum, 16); dsum += shx(dsum, 32);
    bf16x8 pf[2];
#pragma unroll
    for (int hf = 0; hf < 2; ++hf) {
      u32x4 pw;
      pw[0] = pack2(sv[hf * 8 + 0], sv[hf * 8 + 1]); pw[1] = pack2(sv[hf * 8 + 2], sv[hf * 8 + 3]);
      pw[2] = pack2(sv[hf * 8 + 4], sv[hf * 8 + 5]); pw[3] = pack2(sv[hf * 8 + 6], sv[hf * 8 + 7]);
      pf[hf] = __builtin_bit_cast(bf16x8, pw);
    }
    const float dn_ = dsum + w0l * nqp;
    const float inv = 1.f / fmaxf(fabsf(dn_), __expf(-mtl));
#pragma unroll
    for (int vt = 0; vt < 8; ++vt) {
#pragma unroll
      for (int hf = 0; hf < 2; ++hf) {
        const u16* vp = Vt + (vt * 16 + l15) * 72 + hf * 32 + q4 * 4;
        s16x4 v0 = *(const s16x4*)vp;
        s16x4 v1 = *(const s16x4*)(vp + 16);
        bf16x8 vf = (bf16x8){v0.x, v0.y, v0.z, v0.w, v1.x, v1.y, v1.z, v1.w};
        oacc[vt] = mfma16(vf, pf[hf], oacc[vt]);
      }
      hacc[vt] += oacc[vt] * inv;
    }
    __syncthreads();
  }
  float ss = 0.f;
#pragma unroll
  for (int vt = 0; vt < 8; ++vt)
#pragma unroll
    for (int r = 0; r < 4; ++r) ss += hacc[vt][r] * hacc[vt][r];
  ss += shx(ss, 16); ss += shx(ss, 32);
  const float rn = rsqrtf(ss * (1.f / 128.f) + EPS);
  const int m = base + lrow;
#pragma unroll
  for (int vt = 0; vt < 8; ++vt) {
    const int v0 = vt * 16 + q4 * 4;
    f32x4 co = *(const f32x4*)(p.proj + (size_t)m * 2432 + 1024 + h * 128 + v0);
    f32x4 gn = *(const f32x4*)(p.c_out_norm + (size_t)(o * 4 + h) * 128 + v0);
    float y0 = sigmoid_f(co[0]) * hacc[vt][0] * rn * gn[0];
    float y1 = sigmoid_f(co[1]) * hacc[vt][1] * rn * gn[1];
    float y2 = sigmoid_f(co[2]) * hacc[vt][2] * rn * gn[2];
    float y3 = sigmoid_f(co[3]) * hacc[vt][3] * rn * gn[3];
    uint2 oo; oo.x = pack2(y0, y1); oo.y = pack2(y2, y3);
    *(uint2*)(p.mix + (size_t)m * 1024 + h * 128 + v0) = oo;
  }
  __syncthreads();
}

__device__ __forceinline__ void mlstm_scan_phase(PRM p, int o) {
  const int tid = get_tid();
  for (int task = get_bid(); task < 576; task += vgrid()) {
    const int sc = task >> 2, slice = task & 3;
    int sq, h, dir;
    if (sc < 128) { sq = sc >> 3; h = (sc >> 1) & 3; dir = sc & 1; }
    else { int u = sc - 128; sq = 16 + (u >> 3); h = (u >> 1) & 3; dir = u & 1; }
    const bool pr = sq < 16;
    const int nc = pr ? 4 : 16;
    const int sidx = pr ? ((sq * 2 + o) * 2 + dir) * 4 + h : 0;
    const int cidx = pr ? 0 : (((sq - 16) * 2 + o) * 2 + dir) * 4 + h;
    const int e0 = slice * 2048 + tid;
    float C[8];
#pragma unroll
    for (int r = 0; r < 8; ++r) C[r] = pr ? 0.f : p.state_C[(size_t)cidx * 8192 + e0 + 256 * r];
    const bool nthr = (slice == 0) && (tid < 64);
    float n = (pr || !nthr) ? 0.f : p.state_n[cidx * 64 + tid];
    float m = pr ? 0.f : p.state_m[cidx];
#pragma unroll 4
    for (int j = 0; j < nc; ++j) {
      const int sl = mslot(sq, h, dir, j);
      float* cp = p.cp + (size_t)sl * 8192 + e0;
      const float* dc = p.dC + (size_t)sl * 8192 + e0;
#pragma unroll
      for (int r = 0; r < 8; ++r) cp[256 * r] = C[r];
      if (nthr) { p.np[sl * 64 + tid] = n; if (tid == 0) p.mp[sl] = m; }
      const float ml = p.dm[sl * 2], bls = p.dm[sl * 2 + 1];
      const float mn = fmaxf(bls + m, ml);
      const float ca = __expf(bls + m - mn), cb = __expf(ml - mn);
#pragma unroll
      for (int r = 0; r < 8; ++r) C[r] = ca * C[r] + cb * dc[256 * r];
      if (nthr) n = ca * n + cb * p.dn[sl * 64 + tid];
      m = mn;
    }
    if (pr) {
      float* oc = p.out + O_CC + (size_t)sidx * 8192 + e0;
#pragma unroll
      for (int r = 0; r < 8; ++r) oc[256 * r] = C[r];
      if (nthr) { p.out[O_CN + (size_t)sidx * 64 + tid] = n; if (tid == 0) p.out[O_CM + sidx] = m; }
    }
  }
}

__device__ __forceinline__ void odd_mid_phase(PRM p, int o, char* smem) {
  u16* lds = (u16*)smem;
  const int tid = get_tid(), lane = tid & 63, wave = tid >> 6, l15 = lane & 15, q4 = lane >> 4;
  for (int bt = get_bid(); bt < 256 + 768 + 512; bt += vgrid()) {
    if (bt < 256) {
      int qb = bt & 15, hq = (bt >> 4) & 7, b = bt >> 7;
      int kvh = hq >> 2;
      int mq = NPR + b * 1024 + qb * 64 + wave * 16;
      AttnSt st; attn_init(st);
      bf16x8 qf[2]; load_q64(qf, p.qa + (size_t)mq * 512 + hq * 64, 512, l15, q4);
      at_run_plain<2>(st, qf, p.kd + (size_t)(NPR + b * 1536) * 128 + kvh * 64, 128, p.vtd_s + (size_t)((b * 2 + kvh) * 64) * 1536, 1536, 24, 0.125f, lds, tid, l15, q4);
      attn_fin(st, p.mix + (size_t)mq * 1024 + 512 + hq * 64, l15, q4);
    } else if (bt < 256 + 768) {
      mlstm1_task(p, o, bt - 256, (float*)smem);
    } else {
      int u = bt - 1024;
      int qb = u & 3, hq = (u >> 2) & 7, b = u >> 5;
      int kvh = hq >> 2;
      int mq = b * 256 + qb * 64 + wave * 16;
      AttnSt st; attn_init(st);
      bf16x8 qf[2]; load_q64(qf, p.qa + (size_t)mq * 512 + hq * 64, 512, l15, q4);
      at_run_plain<2>(st, qf, p.kd + (size_t)(b * 256) * 128 + kvh * 64, 128, p.vtd_p + (size_t)((b * 2 + kvh) * 64) * 256, 256, 4, 0.125f, lds, tid, l15, q4);
      attn_fin(st, p.mix + (size_t)mq * 1024 + 512 + hq * 64, l15, q4);
    }
  }
}

__device__ __forceinline__ void run_phase(PRM p, int ph, char* smem) {
  char* vsm = smem + (rtid() >> 8) * LDS_HALF;
  if (ph == 0) { phase0(p, vsm); return; }
  if (ph == NPHASE - 1) { norm_phase(p, 0, 3); return; }
  const int l = (ph - 1) / 13, s = (ph - 1) % 13;
  const int eo = l >> 1;
  const bool even = (l & 1) == 0;
  EpiP e{};
  const float* modl = p.mod + (size_t)l * 3 * 9216;
  switch (s) {
    case 0: norm_phase(p, l, 0); break;
    case 1: e.H = p.h; ffn_in_phase(p, l, 0, e, smem); break;
    case 2: e.C = p.x; e.gate = modl + 2 * 1024; e.ldc = 1;
            if (l == 0) { e.vtp = (u16*)p.x_prompt; e.vts = (u16*)p.x_sample; }
            gemm_phase<EPI_RESID, 4, 2, 3, 4, 4>(p.h, p.wt_ffn_out + (size_t)(l * 2 + 0) * 1024 * 2816, 2816, 32, 8, e, smem); break;
    case 3: norm_phase(p, l, 1); break;
    case 4:
      if (even) { e.C = p.proj; e.ldc = 2688; gemm_phase<EPI_STORE, 4, 2, 4, 4, 2>(p.xn, p.wt_in_e + (size_t)eo * 2688 * 1024, 1024, 24, 21, e, smem); }
      else { e.C = p.proj; e.ldc = 2432; gemm_phase<EPI_STORE, 4, 2, 4, 4, 2>(p.xn, p.wt_in_o + (size_t)eo * 2432 * 1024, 1024, 24, 19, e, smem); }
      break;
    case 5: if (even) post_even(p, eo); else post_odd(p, eo); break;
    case 6:
      if (even) {
        EpiP eq{}; eq.C = p.qb; eq.ldc = 768;
        EpiP ek{}; ek.kb = p.kb; ek.vtp = p.vtb_p; ek.vts = p.vtb_s; ek.ctx = 0;
        EpiP ec = ek; ec.ctx = 1;
        const u16* wq = p.wt_qup + (size_t)eo * 768 * 768;
        const u16* wk = p.wt_kvup + (size_t)eo * 1024 * 256;
        for (int t = rbid(); t < 288 + 384 + 64; t += (int)gridDim.x) {
          if (t < 288) gemm_tile<EPI_STORE, 4, 2, 2, 4, 2>(p.cqn, wq, 768, t % 48, t / 48, eq, smem);
          else if (t < 672) { int u = t - 288; gemm_tile<EPI_KVUP, 4, 2, 2, 4, 2>(p.ckvn, wk, 256, u % 48, u / 48, ek, smem); }
          else { int u = t - 672; gemm_tile<EPI_KVUP, 4, 2, 2, 4, 2>(p.cctxn, wk, 256, u % 8, u / 8, ec, smem); }
        }
      } else odd_mid_phase(p, eo, vsm);
      break;
    case 7: if (!even) mlstm_scan_phase(p, eo); break;
    case 8:
      if (even) attn_even_phase(p, eo, vsm);
      else { for (int t = get_bid(); t < 384; t += vgrid()) mlstm2_mfma(p, eo, t, vsm); }
      break;
    case 9: e.C = p.x; e.gate = modl + 5 * 1024; e.ldc = 0;
            gemm_phase<EPI_RESID, 4, 2, 3, 4, 2>(p.mix, p.wt_out + (size_t)l * 1024 * 1024, 1024, 32, 8, e, smem); break;
    case 10: norm_phase(p, l, 2); break;
    case 11: e.H = p.h; ffn_in_phase(p, l, 1, e, smem); break;
    case 12: e.C = p.x; e.gate = modl + 8 * 1024; e.ldc = 1;
             gemm_phase<EPI_RESID, 4, 2, 3, 4, 4>(p.h, p.wt_ffn_out + (size_t)(l * 2 + 1) * 1024 * 2816, 2816, 32, 8, e, smem); break;
  }
}

__global__ void __launch_bounds__(512, 2) mega(Params p) {
  __shared__ __attribute__((aligned(16))) char smem[LDS_BYTES];
  __shared__ uint4 xb_words;
  cg::grid_group grid = cg::this_grid();
  if (threadIdx.x == 0) xb_words = make_uint4(0u, 0u, 0u, 0u);
  __syncthreads();
  XcdBarrier xb = xcd_barrier_post(p.bar, (volatile LAS unsigned*)&xb_words);
  for (int ph = p.ph0; ph < p.ph1; ++ph) {
    const __attribute__((address_space(4))) Params* pp = (const __attribute__((address_space(4))) Params*)__builtin_amdgcn_kernarg_segment_ptr();
    asm volatile("" : "+s"(pp));
    run_phase(*pp, ph, smem);
#ifndef REPMASK
#define REPMASK 0
#endif
#ifndef REPPAR
#define REPPAR 0
#endif
    if (REPMASK) {
      int bit = ph == 0 ? 13 : (ph == NPHASE - 1 ? 14 : (ph - 1) % 13);
      int lay = (ph - 1) / 13;
      bool parok = REPPAR == 0 || ph == 0 || ph == NPHASE - 1 || (REPPAR == 1 && (lay & 1) == 0) || (REPPAR == 2 && (lay & 1) == 1);
      if (((REPMASK >> bit) & 1) && parok) { xcd_barrier(xb); asm volatile("" : "+s"(pp)); run_phase(*pp, ph, smem); }
    }
    if (ph + 1 < p.ph1) {
      if (p.ph1 > 100000) grid.sync();
      xcd_barrier(xb);
    }
  }
}

extern "C" void kernel_launch(void* const* d_in, const int* in_sizes, int n_in, void* d_out, int out_size, void* d_ws, size_t ws_size,
                              hipStream_t stream) {
  static int grid_blocks = 0;
  if (!grid_blocks) {
    int dev = 0, cus = 0, per_cu = 0;
    hipGetDevice(&dev);
    hipDeviceGetAttribute(&cus, hipDeviceAttributeMultiprocessorCount, dev);
    hipOccupancyMaxActiveBlocksPerMultiprocessor(&per_cu, mega, 512, 0);
    per_cu = 1;
    grid_blocks = cus * per_cu;
  }
  Params p{};
  const float** ip = (const float**)&p.x_prompt;
  for (int i = 0; i < 31; ++i) ip[i] = (const float*)d_in[i];
  p.out = (float*)d_out;
  char* w = (char*)d_ws;
  size_t off = 0;
  auto take = [&](size_t bytes) { char* r = w + off; off += (bytes + 255) & ~(size_t)255; return r; };
  p.wt_ffn_in = (u16*)take((size_t)8 * 5632 * 1024 * 2);
  p.wt_ffn_out = (u16*)take((size_t)8 * 1024 * 2816 * 2);
  p.wt_in_e = (u16*)take((size_t)2 * 2688 * 1024 * 2);
  p.wt_in_o = (u16*)take((size_t)2 * 2432 * 1024 * 2);
  p.wt_out = (u16*)take((size_t)4 * 1024 * 1024 * 2);
  p.wt_qup = (u16*)take((size_t)2 * 768 * 768 * 2);
  p.wt_kvup = (u16*)take((size_t)2 * 1024 * 256 * 2);
  p.mod = (float*)take((size_t)12 * 9216 * 4);
  p.x = (float*)take((size_t)NTOK * 1024 * 4);
  p.proj = (float*)take((size_t)NTOK * 2688 * 4);
  p.qb = (float*)take((size_t)NTOK * 768 * 4);
  p.dC = (float*)take((size_t)768 * 8192 * 4);
  p.dn = (float*)take((size_t)768 * 64 * 4);
  p.dm = (float*)take((size_t)768 * 2 * 4);
  p.cp = (float*)take((size_t)768 * 8192 * 4);
  p.np = (float*)take((size_t)768 * 64 * 4);
  p.mp = (float*)take((size_t)768 * 4);
  p.xn = (u16*)take((size_t)NTOK * 1024 * 2);
  p.h = (u16*)take((size_t)NTOK * 2816 * 2);
  p.mix = (u16*)take((size_t)NTOK * 1024 * 2);
  p.qa = (u16*)take((size_t)NTOK * 512 * 2);
  p.ka = (u16*)take((size_t)NTOK * 512 * 2);
  p.kactx = (u16*)take((size_t)1024 * 512 * 2);
  p.vta_p = (u16*)take((size_t)16 * 8 * 64 * 256 * 2);
  p.vta_s = (u16*)take((size_t)2 * 8 * 64 * 1536 * 2);
  p.kb = (u16*)take((size_t)7168 * 768 * 2);
  p.vtb_p = (u16*)take((size_t)16 * 8 * 64 * 256 * 2);
  p.vtb_s = (u16*)take((size_t)2 * 8 * 64 * 1536 * 2);
  p.cqn = (u16*)take((size_t)NTOK * 768 * 2);
  p.ckvn = (u16*)take((size_t)NTOK * 256 * 2);
  p.cctxn = (u16*)take((size_t)1024 * 256 * 2);
  p.kd = (u16*)take((size_t)7168 * 128 * 2);
  p.vtd_p = (u16*)take((size_t)16 * 2 * 64 * 256 * 2);
  p.vtd_s = (u16*)take((size_t)2 * 2 * 64 * 1536 * 2);
  p.bar = (unsigned*)take((size_t)XCD_BAR_WORDS * 4);
  if (off > ws_size) { fprintf(stderr, "kernel_launch: workspace too small: need %zu have %zu\n", off, ws_size); return; }
  hipMemsetAsync(p.bar, 0, (size_t)XCD_BAR_WORDS * 4, stream);
#if MULTI
  for (int ph = 0; ph < NPHASE; ++ph) {
    p.ph0 = ph; p.ph1 = ph + 1;
    hipLaunchKernelGGL(mega, dim3(grid_blocks), dim3(512), 0, stream, p);
  }
#else
  p.ph0 = 0; p.ph1 = NPHASE;
  void* args[] = {&p};
  hipError_t e = hipLaunchCooperativeKernel((void*)mega, dim3(grid_blocks), dim3(512), args, 0, stream);
  if (e != hipSuccess) fprintf(stderr, "cooperative launch failed: %s (grid %d)\n", hipGetErrorString(e), grid_blocks);
#endif
}
```

```cpp
#include <hip/hip_runtime.h>
#include <hip/hip_cooperative_groups.h>
#include <cstdio>
#include <cstdint>
namespace cg = cooperative_groups;

#ifndef MULTI
#define MULTI 0
#endif

typedef unsigned short u16;
typedef __attribute__((ext_vector_type(8))) short bf16x8;
typedef __attribute__((ext_vector_type(4))) short s16x4;
typedef __attribute__((ext_vector_type(4))) float f32x4;
typedef __attribute__((ext_vector_type(4))) unsigned int u32x4;

#define NTOK 6144
#define NPR 4096
#define LDS_HALF 77824
#define LDS_BYTES (2 * LDS_HALF)
#define NPHASE 54
#define EPS 1e-6f

struct Params {
  const float *x_prompt, *x_sample, *cache_a_k, *cache_a_v, *cache_b_ckv, *cache_b_krope, *cache_d_k, *cache_d_v;
  const float *state_C, *state_n, *state_m, *c, *c_ctx, *w_mod, *b_mod, *norm_g, *ffn_in, *ffn_out;
  const float *w_in_even, *w_in_odd, *w_out, *a_rpb, *b_q_norm, *b_wq_up, *b_kv_norm, *b_wkv_up;
  const float *c_gate_bias, *c_out_norm, *d_q_norm, *d_k_norm, *final_norm;
  float* out;
  u16 *wt_ffn_in, *wt_ffn_out, *wt_in_e, *wt_in_o, *wt_out, *wt_qup, *wt_kvup;
  float *mod, *x, *proj, *qb, *dC, *dn, *dm, *cp, *np, *mp;
  u16 *xn, *h, *mix, *qa, *ka, *kactx, *vta_p, *vta_s, *kb, *vtb_p, *vtb_s, *cqn, *ckvn, *cctxn, *kd, *vtd_p, *vtd_s;
  unsigned* bar;
  int ph0, ph1;
};

typedef const __attribute__((address_space(4))) Params& PRM;
#define O_YP 0
#define O_YS 4194304
#define O_AK 6291456
#define O_AV 10485760
#define O_CKV 14680064
#define O_KR 16777216
#define O_DK 17039360
#define O_DV 18087936
#define O_CC 19136512
#define O_CN 21233664
#define O_CM 21250048

__device__ __forceinline__ int get_tid() { int t = threadIdx.x & 255; asm volatile("" : "+v"(t)); return t; }
__device__ __forceinline__ int rtid_raw() { int t = threadIdx.x; asm volatile("" : "+v"(t)); return t; }
__device__ __forceinline__ int get_bid() { int t = blockIdx.x * 2 + __builtin_amdgcn_readfirstlane(rtid_raw() >> 8); asm volatile("" : "+s"(t)); return t; }
__device__ __forceinline__ int vgrid() { return (int)gridDim.x * 2; }
__device__ __forceinline__ int rtid() { int t = threadIdx.x; asm volatile("" : "+v"(t)); return t; }
__device__ __forceinline__ int rbid() { int t = blockIdx.x; asm volatile("" : "+s"(t)); return t; }
typedef __attribute__((ext_vector_type(2))) __bf16 bf16x2_t;
typedef __attribute__((ext_vector_type(2))) float f32x2_t;
__device__ __forceinline__ unsigned pack2(float a, float b) {
  f32x2_t v = {a, b};
  bf16x2_t r = __builtin_convertvector(v, bf16x2_t);
  return __builtin_bit_cast(unsigned, r);
}
__device__ __forceinline__ u16 f2bf(float f) { return (u16)(pack2(f, 0.f) & 0xffffu); }
__device__ __forceinline__ float shx(float v, int m) {
  int l = __builtin_amdgcn_mbcnt_hi(-1, __builtin_amdgcn_mbcnt_lo(-1, 0));
  asm volatile("" : "+v"(l));
  return __int_as_float(__builtin_amdgcn_ds_bpermute((l ^ m) << 2, __float_as_int(v)));
}
__device__ __forceinline__ float wsum(float v) {
#pragma unroll
  for (int o = 32; o; o >>= 1) v += shx(v, o);
  return v;
}
__device__ __forceinline__ float wmaxr(float v) {
#pragma unroll
  for (int o = 32; o; o >>= 1) v = fmaxf(v, shx(v, o));
  return v;
}
__device__ __forceinline__ float silu_f(float x) { return x / (1.f + __expf(-x)); }
__device__ __forceinline__ float sigmoid_f(float x) { return 1.f / (1.f + __expf(-x)); }
__device__ __forceinline__ float logsig_f(float x) { return fminf(x, 0.f) - __logf(1.f + __expf(-fabsf(x))); }
__device__ __forceinline__ void sincos_r(float a, float& s, float& c) {
  float n = rintf(a * 0.15915494309f);
  float r = fmaf(-n, 6.2831855f, a);
  r = fmaf(-n, -1.7484555e-7f, r);
  s = __sinf(r); c = __cosf(r);
}
__device__ __forceinline__ int grp_of(int m) { return m < NPR ? 0 : 1 + ((m - NPR) >> 10); }
__device__ __forceinline__ int keyrow(int m) { return m < NPR ? m : NPR + ((m - NPR) >> 10) * 1536 + ((m - NPR) & 1023); }
__device__ __forceinline__ f32x4 mfma16(bf16x8 a, bf16x8 b, f32x4 c) { return __builtin_amdgcn_mfma_f32_16x16x32_bf16(a, b, c, 0, 0, 0); }

#define XB_TMO      128
#define XB_XCNT(j)  (256  + 64 * (j))
#define XB_XSUB(j)  (1280 + 64 * (j))
#define XB_XGEN(j)  (2304 + 64 * (j))
#define XB_TOP      3328
#define XB_TOPGEN   3392
#define XCD_BAR_WORDS 3456
#define XB_SPIN_CAP (1u << 18)
#define LAS __attribute__((address_space(3)))

__device__ __forceinline__ unsigned xb_ld(unsigned* p)              { return __hip_atomic_load(p, __ATOMIC_RELAXED, __HIP_MEMORY_SCOPE_AGENT); }
__device__ __forceinline__ unsigned xb_add(unsigned* p, unsigned v) { return __hip_atomic_fetch_add(p, v, __ATOMIC_RELAXED, __HIP_MEMORY_SCOPE_AGENT); }
__device__ __forceinline__ unsigned xb_xcc_id() { return (unsigned)__builtin_amdgcn_s_getreg((3 << 11) | 20) & 0xFu; }
#define XB_SPIN(cond, bar) do { unsigned _sp = 0; while (cond) { __builtin_amdgcn_s_sleep(1); \
    if ((++_sp & 255u) == 0u) { if (xb_ld(&(bar)[XB_TMO])) break; if (_sp > XB_SPIN_CAP) { atomicAdd(&(bar)[XB_TMO], 1u); break; } } } } while (0)

struct XcdBarrier {
    unsigned* bar; unsigned x;
    volatile LAS unsigned* st;
};

__device__ __forceinline__ XcdBarrier xcd_barrier_post(unsigned* bar, volatile LAS unsigned* st) {
    XcdBarrier b; b.bar = bar; b.x = xb_xcc_id(); b.st = st;
    if (threadIdx.x == 0) (void)xb_add(&bar[XB_XCNT(b.x)], 1u);
    return b;
}
__device__ __forceinline__ void xcd_barrier_complete(unsigned* bar, unsigned x, unsigned& nloc, unsigned& nx) {
    const unsigned G = gridDim.x * gridDim.y * gridDim.z;
    unsigned sum, cnt, mine, sp = 0u;
    for (;;) {
        sum = 0u; cnt = 0u; mine = 0u;
#pragma unroll
        for (unsigned j = 0; j < 16; ++j) { const unsigned c = xb_ld(&bar[XB_XCNT(j)]); sum += c; cnt += (c > 0u) ? 1u : 0u; mine = (j == x) ? c : mine; }
        if (sum == G) break;
        __builtin_amdgcn_s_sleep(1);
        if ((++sp & 255u) == 0u) { if (xb_ld(&bar[XB_TMO])) break; if (sp > XB_SPIN_CAP) { atomicAdd(&bar[XB_TMO], 1u); break; } }
    }
    nloc = mine > 0u ? mine : 1u; nx = cnt > 0u ? cnt : 1u;
}

__device__ __forceinline__ void xcd_barrier(const XcdBarrier& b) {
    asm volatile("s_waitcnt vmcnt(0)" ::: "memory");
    __syncthreads();
    if (threadIdx.x == 0) {
        unsigned* bar = b.bar;
        __builtin_amdgcn_s_waitcnt(0);
        unsigned nloc = b.st[0], nx = b.st[1];
        if (nloc == 0u) { xcd_barrier_complete(bar, b.x, nloc, nx); b.st[0] = nloc; b.st[1] = nx; }
        const unsigned old = xb_add(&bar[XB_XSUB(b.x)], 1u);
        const unsigned gen = old / nloc;
        if (old + 1u == (gen + 1u) * nloc) {
            __builtin_amdgcn_fence(__ATOMIC_RELEASE, "agent");
            asm volatile("s_waitcnt vmcnt(0)" ::: "memory");
            const unsigned og = xb_add(&bar[XB_TOP], 1u);
            const unsigned tg = og / nx;
            if (og + 1u == (tg + 1u) * nx) xb_add(&bar[XB_TOPGEN], 1u);
            else XB_SPIN(xb_ld(&bar[XB_TOPGEN]) == tg, bar);
            __builtin_amdgcn_fence(__ATOMIC_ACQUIRE, "agent");
            xb_add(&bar[XB_XGEN(b.x)], 1u);
            asm volatile("s_waitcnt vmcnt(0)" ::: "memory");
        } else {
            XB_SPIN(xb_ld(&bar[XB_XGEN(b.x)]) == gen, bar);
            __builtin_amdgcn_fence(__ATOMIC_ACQUIRE, "agent");
            asm volatile("s_waitcnt vmcnt(0)" ::: "memory");
        }
    }
    __syncthreads();
}


__device__ __forceinline__ void conv_tile(const float* __restrict__ src, int K, int N, int perm, u16* __restrict__ dst, int kt4, int nt, float* tile) {
  const int tid = get_tid();
  {
    const int c4 = tid & 15, kr = tid >> 4;
    const int n = nt * 64 + c4 * 4;
    const bool valid = n < N;
    int col = n;
    if (perm) { int G = n >> 4, w = n & 15, sub = w >> 2; col = ((sub & 1) ? 2816 : 0) + G * 8 + (sub >> 1) * 4 + (w & 3); }
    f32x4 v[16];
#pragma unroll
    for (int i = 0; i < 16; ++i) {
      int kk = kr + 16 * i;
      v[i] = valid ? *(const f32x4*)(src + (size_t)(kt4 * 256 + kk) * N + col) : (f32x4){0.f, 0.f, 0.f, 0.f};
    }
#pragma unroll
    for (int i = 0; i < 16; ++i) {
      int kk = kr + 16 * i;
      float* t = tile + (kk >> 6) * 4160 + (kk & 63) * 65 + c4 * 4;
      t[0] = v[i][0]; t[1] = v[i][1]; t[2] = v[i][2]; t[3] = v[i][3];
    }
  }
  __syncthreads();
  {
    const int k8 = (tid & 7) * 8;
#pragma unroll
    for (int hh = 0; hh < 4; ++hh)
#pragma unroll
      for (int i = 0; i < 2; ++i) {
        int nn2 = (tid >> 3) + 32 * i;
        float v[8];
#pragma unroll
        for (int e = 0; e < 8; ++e) v[e] = tile[hh * 4160 + (k8 + e) * 65 + nn2];
        uint4 o; o.x = pack2(v[0], v[1]); o.y = pack2(v[2], v[3]); o.z = pack2(v[4], v[5]); o.w = pack2(v[6], v[7]);
        *(uint4*)(dst + (size_t)(nt * 64 + nn2) * K + kt4 * 256 + hh * 64 + k8) = o;
      }
  }
  __syncthreads();
}

__device__ __forceinline__ void mod_task(PRM p, int t, float* sm) {
  const int l = t / 144, cb = t % 144, tid = get_tid();
  float* sc = sm;
  float* red = sm + 3072;
  for (int i = tid; i < 3072; i += 256) {
    int g = i >> 10, k = i & 1023;
    float v = g == 0 ? p.c_ctx[k] : p.c[(g - 1) * 1024 + k];
    sc[i] = silu_f(v);
  }
  __syncthreads();
  const int c4 = tid & 15, kg = tid >> 4;
  const float* w = p.w_mod + (size_t)l * 1024 * 9216 + (size_t)(kg * 64) * 9216 + cb * 64 + c4 * 4;
  float a[3][4];
#pragma unroll
  for (int g = 0; g < 3; ++g)
#pragma unroll
    for (int q = 0; q < 4; ++q) a[g][q] = 0.f;
  for (int k = 0; k < 64; k += 8) {
    float4 wv[8];
#pragma unroll
    for (int e = 0; e < 8; ++e) wv[e] = *(const float4*)(w + (size_t)(k + e) * 9216);
#pragma unroll
    for (int e = 0; e < 8; ++e) {
      int kk = kg * 64 + k + e;
#pragma unroll
      for (int g = 0; g < 3; ++g) {
        float sv = sc[g * 1024 + kk];
        a[g][0] = fmaf(sv, wv[e].x, a[g][0]); a[g][1] = fmaf(sv, wv[e].y, a[g][1]);
        a[g][2] = fmaf(sv, wv[e].z, a[g][2]); a[g][3] = fmaf(sv, wv[e].w, a[g][3]);
      }
    }
  }
#pragma unroll
  for (int g = 0; g < 3; ++g)
#pragma unroll
    for (int q = 0; q < 4; ++q) red[(kg * 3 + g) * 64 + c4 * 4 + q] = a[g][q];
  __syncthreads();
  if (tid < 192) {
    int g = tid >> 6, c2 = tid & 63;
    float s = 0.f;
#pragma unroll
    for (int q = 0; q < 16; ++q) s += red[(q * 3 + g) * 64 + c2];
    int j = cb * 64 + c2;
    p.mod[(size_t)(l * 3 + g) * 9216 + j] = s + p.b_mod[l * 9216 + j];
  }
  __syncthreads();
}

__device__ __forceinline__ int conv_layer_count(int l) { return (l & 1) ? 1272 : 1340; }
__device__ __forceinline__ void conv_layer_task(PRM p, int l, int u, float* sm) {
  const float* src; u16* dst; int K, N, Npad, perm = 0, tp, mat0;
  const int eo = l >> 1;
  const int nin = (l & 1) ? 152 : 168;
  if (u < 704) { K = 1024; N = 5632; Npad = 5632; perm = 1; tp = 352; src = p.ffn_in; dst = p.wt_ffn_in; mat0 = l * 2; }
  else if ((u -= 704) < 352) { K = 2816; N = 1024; Npad = 1024; tp = 176; src = p.ffn_out; dst = p.wt_ffn_out; mat0 = l * 2; }
  else if ((u -= 352) < nin) {
    if (l & 1) { K = 1024; N = 2320; Npad = 2432; tp = 152; src = p.w_in_odd; dst = p.wt_in_o; mat0 = eo; }
    else { K = 1024; N = 2592; Npad = 2688; tp = 168; src = p.w_in_even; dst = p.wt_in_e; mat0 = eo; }
  }
  else if ((u -= nin) < 64) { K = 1024; N = 1024; Npad = 1024; tp = 64; src = p.w_out; dst = p.wt_out; mat0 = l; }
  else if ((u -= 64) < 36) { K = 768; N = 768; Npad = 768; tp = 36; src = p.b_wq_up; dst = p.wt_qup; mat0 = eo; }
  else { u -= 36; K = 256; N = 1024; Npad = 1024; tp = 16; src = p.b_wkv_up; dst = p.wt_kvup; mat0 = eo; }
  int mat = mat0 + u / tp, r = u % tp;
  int nkt = K / 256;
  int kt = r % nkt, nt = r / nkt;
  conv_tile(src + (size_t)mat * K * N, K, N, perm, dst + (size_t)mat * Npad * K, kt, nt, sm);
}

__device__ __forceinline__ void phase0(PRM p, char* smem) {
  float* sm = (float*)smem;
  const int NMOD = 144, NCOPY = 0, NCONV = 1340;
  const int total = NMOD + NCOPY + NCONV;
  for (int t = get_bid(); t < total; t += vgrid()) {
    if (t < NMOD) { mod_task(p, t, sm); continue; }
    int u = t - NMOD;
    if (u < NCOPY) {
      const int tid = get_tid();
#pragma unroll
      for (int i = 0; i < 4; ++i) {
        size_t idx = ((size_t)u * 1024 + i * 256 + tid);
        const float4* src = idx < (size_t)NPR * 256 ? (const float4*)p.x_prompt + idx : (const float4*)p.x_sample + (idx - (size_t)NPR * 256);
        ((float4*)p.x)[idx] = *src;
      }
      continue;
    }
    conv_layer_task(p, 0, u - NCOPY, sm);
  }
}

__device__ __forceinline__ void norm_phase(PRM p, int l, int which) {
  const int lane = get_tid() & 63, wave = get_tid() >> 6;
  const int nrows_wave = NTOK / 4;
  const int stride = vgrid();
  for (int t0 = get_bid(); t0 < nrows_wave; t0 += 3 * stride) {
    float4 v[3][4];
    float ss[3];
#pragma unroll
    for (int k = 0; k < 3; ++k) {
      const int t = t0 + k * stride;
      if (t < nrows_wave) {
        const int mm = t * 4 + wave;
        const float* xsrc = (l == 0 && which == 0) ? (mm < NPR ? p.x_prompt + (size_t)mm * 1024 : p.x_sample + (size_t)(mm - NPR) * 1024) : p.x + (size_t)mm * 1024;
        const float4* xr = (const float4*)xsrc;
#pragma unroll
        for (int i = 0; i < 4; ++i) v[k][i] = xr[i * 64 + lane];
      }
    }
#pragma unroll
    for (int k = 0; k < 3; ++k) {
      float a = 0.f;
#pragma unroll
      for (int i = 0; i < 4; ++i) a += v[k][i].x * v[k][i].x + v[k][i].y * v[k][i].y + v[k][i].z * v[k][i].z + v[k][i].w * v[k][i].w;
      ss[k] = wsum(a);
    }
#pragma unroll
    for (int k = 0; k < 3; ++k) {
      const int t = t0 + k * stride;
      if (t >= nrows_wave) continue;
      const int m = t * 4 + wave;
      const float r = rsqrtf(ss[k] * (1.f / 1024.f) + EPS);
      if (which == 3) {
        float4* o = (float4*)(p.out + (size_t)m * 1024);
#pragma unroll
        for (int i = 0; i < 4; ++i) {
          float4 g = ((const float4*)p.final_norm)[i * 64 + lane];
          float4 y; y.x = v[k][i].x * r * g.x; y.y = v[k][i].y * r * g.y; y.z = v[k][i].z * r * g.z; y.w = v[k][i].w * r * g.w;
          o[i * 64 + lane] = y;
        }
      } else {
        const float* md = p.mod + (size_t)(l * 3 + grp_of(m)) * 9216 + which * 3072;
        const float4* sh = (const float4*)md;
        const float4* sc = (const float4*)(md + 1024);
        const float4* gg = (const float4*)(p.norm_g + (size_t)(l * 3 + which) * 1024);
#pragma unroll
        for (int i = 0; i < 4; ++i) {
          float4 g = gg[i * 64 + lane], s = sc[i * 64 + lane], b = sh[i * 64 + lane];
          float y0 = v[k][i].x * r * g.x * (1.f + s.x) + b.x;
          float y1 = v[k][i].y * r * g.y * (1.f + s.y) + b.y;
          float y2 = v[k][i].z * r * g.z * (1.f + s.z) + b.z;
          float y3 = v[k][i].w * r * g.w * (1.f + s.w) + b.w;
          uint2 o; o.x = pack2(y0, y1); o.y = pack2(y2, y3);
          *(uint2*)(p.xn + (size_t)m * 1024 + (i * 64 + lane) * 4) = o;
        }
      }
    }
  }
}

struct EpiP {
  float* C; int ldc;
  const float* gate;
  u16* H;
  u16 *kb, *vtp, *vts; int ctx;
};
enum { EPI_STORE = 0, EPI_RESID = 1, EPI_SWIGLU = 2, EPI_KVUP = 3 };

template <int FI, int FJ, bool SWAP>
__device__ __forceinline__ void g_compute(f32x4 (&acc)[FI][FJ], const u16* Ac, const u16* Bc, int q4, int rsw) {
  __builtin_amdgcn_s_setprio(1);
#pragma unroll
  for (int ks = 0; ks < 2; ++ks) {
    const int co = ((ks * 4 + q4) ^ rsw) << 3;
#pragma unroll
    for (int j0 = 0; j0 < FJ; j0 += 4) {
      bf16x8 b[4];
#pragma unroll
      for (int j = 0; j < 4; ++j) if (j0 + j < FJ) b[j] = *(const bf16x8*)(Bc + (j0 + j) * 1024 + co);
#pragma unroll
      for (int i0 = 0; i0 < FI; i0 += 4) {
        bf16x8 a[4];
#pragma unroll
        for (int i = 0; i < 4; ++i) if (i0 + i < FI) a[i] = *(const bf16x8*)(Ac + (i0 + i) * 1024 + co);
#pragma unroll
        for (int j = 0; j < 4; ++j)
          if (j0 + j < FJ) {
#pragma unroll
            for (int i = 0; i < 4; ++i)
              if (i0 + i < FI) acc[i0 + i][j0 + j] = SWAP ? mfma16(b[j], a[i], acc[i0 + i][j0 + j]) : mfma16(a[i], b[j], acc[i0 + i][j0 + j]);
          }
      }
    }
  }
  __builtin_amdgcn_s_setprio(0);
}

template <int EPI, int WMW, int WNW, int FI, int FJ, int DEPTH>
__device__ __forceinline__ void gemm_tile(const u16* __restrict__ A, const u16* __restrict__ Wt, int K, int tm, int tn, const EpiP& e, char* smem) {
  constexpr int BM = WMW * FI * 16, BN = WNW * FJ * 16;
  constexpr int NA = BM / 64, NB = BN / 64;
  constexpr int BUFSZ = (BM + BN) * 64;
  static_assert(WMW * WNW == 8 && BM % 64 == 0 && BN % 64 == 0, "tile");
  u16* As = (u16*)smem;
  u16* Bs = As + BM * 64;
  const int tid = rtid(), lane = tid & 63, wave = tid >> 6, wm = wave / WNW, wn = wave % WNW, l15 = lane & 15, q4 = lane >> 4;
  const int lr = tid >> 3, lc = tid & 7;
  const u16* Ag = A + (size_t)(tm * BM + lr) * K + lc * 8;
  const u16* Bg = Wt + (size_t)(tn * BN + lr) * K + lc * 8;
  const int st_off = lr * 64 + ((lc ^ ((lr >> 1) & 7)) << 3);
  const int rsw = (l15 >> 1) & 7;
  const int a_row = (wm * FI * 16 + l15) * 64, b_row = (wn * FJ * 16 + l15) * 64;
  f32x4 acc[FI][FJ];
#pragma unroll
  for (int i = 0; i < FI; ++i)
#pragma unroll
    for (int j = 0; j < FJ; ++j) acc[i][j] = (f32x4){0.f, 0.f, 0.f, 0.f};
  const int nk = K >> 6;
#define GL(RA, RB, KT) { _Pragma("unroll") for (int i = 0; i < NA; ++i) RA[i] = *(const u32x4*)(Ag + (size_t)i * 64 * K + (KT) * 64); \
                         _Pragma("unroll") for (int i = 0; i < NB; ++i) RB[i] = *(const u32x4*)(Bg + (size_t)i * 64 * K + (KT) * 64); }
#define GS(RA, RB, BUF) { _Pragma("unroll") for (int i = 0; i < NA; ++i) *(u32x4*)(As + (BUF) * BUFSZ + st_off + i * 4096) = RA[i]; \
                          _Pragma("unroll") for (int i = 0; i < NB; ++i) *(u32x4*)(Bs + (BUF) * BUFSZ + st_off + i * 4096) = RB[i]; }
  if constexpr (DEPTH == 4) {
    static_assert(WMW == 4 && WNW == 2 && FJ == 4 && (FI == 3 || FI == 4), "ring4 tile");
    constexpr int ST = (BM + BN) * 32;
    const int nk32 = K >> 5;
    const int fs = (-(tid >> 4)) & 3;
    const int sc = ((tid & 3) ^ fs) << 3;
    const int r4 = tid >> 2;
    const bool three = (BM == 256) || (tid < 256);
    const u16* sp0 = A + (size_t)(tm * BM + r4) * K + sc;
    const int lo0 = tid * 8;
    const u16* sp1; int lo1; const u16* sp2; int lo2;
    if (BM == 256) {
      sp1 = A + (size_t)(tm * BM + 128 + r4) * K + sc;  lo1 = (tid + 512) * 8;
      sp2 = Wt + (size_t)(tn * BN + r4) * K + sc;       lo2 = BM * 32 + tid * 8;
    } else if (tid < 256) {
      sp1 = A + (size_t)(tm * BM + 128 + r4) * K + sc;  lo1 = (tid + 512) * 8;
      sp2 = Wt + (size_t)(tn * BN + 64 + r4) * K + sc;  lo2 = BM * 32 + (tid + 256) * 8;
    } else {
      sp1 = Wt + (size_t)(tn * BN + (r4 - 64)) * K + sc; lo1 = BM * 32 + (tid - 256) * 8;
      sp2 = sp1; lo2 = lo1;
    }
    const int fr = (-(l15 >> 2)) & 3;
    const int co3 = (q4 ^ fr) << 3;
    const int a_row3 = (wm * FI * 16 + l15) * 32 + co3, b_row3 = BM * 32 + (wn * FJ * 16 + l15) * 32 + co3;
    const unsigned lbase = (unsigned)(size_t)As;
#define GD4(KT, BUF) { __builtin_amdgcn_global_load_lds((const unsigned*)(sp0 + (KT) * 32), (unsigned*)(As + (BUF) * ST + lo0), 16, 0, 0); \
                       __builtin_amdgcn_global_load_lds((const unsigned*)(sp1 + (KT) * 32), (unsigned*)(As + (BUF) * ST + lo1), 16, 0, 0); \
                       if (three) __builtin_amdgcn_global_load_lds((const unsigned*)(sp2 + (KT) * 32), (unsigned*)(As + (BUF) * ST + lo2), 16, 0, 0); }
    asm volatile("s_waitcnt vmcnt(0)" ::: "memory");
    GD4(0, 0);
    if (nk32 > 1) GD4(1, 1);
    if (nk32 > 2) GD4(2, 2);
#define RING4_STEP(J) { \
      const int kt = kt0 + (J); \
      if (kt + 2 < nk32) { if (three) asm volatile("s_waitcnt vmcnt(6)" ::: "memory"); else asm volatile("s_waitcnt vmcnt(4)" ::: "memory"); } \
      else if (kt + 1 < nk32) { if (three) asm volatile("s_waitcnt vmcnt(3)" ::: "memory"); else asm volatile("s_waitcnt vmcnt(2)" ::: "memory"); } \
      else asm volatile("s_waitcnt vmcnt(0)" ::: "memory"); \
      asm volatile("s_waitcnt lgkmcnt(0)" ::: "memory"); \
      __builtin_amdgcn_s_barrier(); \
      asm volatile("" ::: "memory"); \
      const unsigned aad = lbase + (unsigned)(((J) * ST + a_row3) * 2); \
      const unsigned bad = lbase + (unsigned)(((J) * ST + b_row3) * 2); \
      bf16x8 b0, b1, b2, b3, a0, a1, a2, a3; \
      asm volatile("ds_read_b128 %0, %1" : "=v"(b0) : "v"(bad)); \
      asm volatile("ds_read_b128 %0, %1 offset:1024" : "=v"(b1) : "v"(bad)); \
      asm volatile("ds_read_b128 %0, %1 offset:2048" : "=v"(b2) : "v"(bad)); \
      asm volatile("ds_read_b128 %0, %1 offset:3072" : "=v"(b3) : "v"(bad)); \
      asm volatile("ds_read_b128 %0, %1" : "=v"(a0) : "v"(aad)); \
      asm volatile("ds_read_b128 %0, %1 offset:1024" : "=v"(a1) : "v"(aad)); \
      asm volatile("ds_read_b128 %0, %1 offset:2048" : "=v"(a2) : "v"(aad)); \
      if (FI == 4) { asm volatile("ds_read_b128 %0, %1 offset:3072" : "=v"(a3) : "v"(aad)); \
        asm volatile("s_waitcnt lgkmcnt(0)" : "+v"(b0), "+v"(b1), "+v"(b2), "+v"(b3), "+v"(a0), "+v"(a1), "+v"(a2), "+v"(a3)); } \
      else { asm volatile("s_waitcnt lgkmcnt(0)" : "+v"(b0), "+v"(b1), "+v"(b2), "+v"(b3), "+v"(a0), "+v"(a1), "+v"(a2)); a3 = a2; } \
      __builtin_amdgcn_s_setprio(1); \
      { bf16x8 bb[4] = {b0, b1, b2, b3}; bf16x8 aa[4] = {a0, a1, a2, a3}; \
        _Pragma("unroll") for (int j = 0; j < 4; ++j) \
          _Pragma("unroll") for (int i = 0; i < FI; ++i) acc[i][j] = mfma16(bb[j], aa[i], acc[i][j]); } \
      __builtin_amdgcn_s_setprio(0); \
      if (kt + 3 < nk32) GD4(kt + 3, ((J) + 3) & 3);     \
      }
    for (int kt0 = 0; kt0 < nk32; kt0 += 4) {
      RING4_STEP(0) RING4_STEP(1) RING4_STEP(2) RING4_STEP(3)
    }
#undef RING4_STEP
#undef GD4
    __syncthreads();
  } else if constexpr (DEPTH == 3) {
    constexpr int ST = (BM + BN) * 32;
    constexpr int NA4 = BM * 4 / 512, NB4 = BN * 4 / 512;
    const int nk32 = K >> 5;
    const int fs = (-(tid >> 4)) & 3;
    const u16* Ad = A + (size_t)(tm * BM + (tid >> 2)) * K + (((tid & 3) ^ fs) << 3);
    const u16* Bd = Wt + (size_t)(tn * BN + (tid >> 2)) * K + (((tid & 3) ^ fs) << 3);
    u16* Al = As + tid * 8;
    u16* Bl = As + BM * 32 + tid * 8;
    const int fr = (-(l15 >> 2)) & 3;
    const int co3 = (q4 ^ fr) << 3;
    const int a_row3 = (wm * FI * 16 + l15) * 32 + co3, b_row3 = BM * 32 + (wn * FJ * 16 + l15) * 32 + co3;
    static_assert(FI == 8 && FJ == 4, "ring path is written for 8x4 fragments per wave");
    const unsigned lbase = (unsigned)(size_t)As;
#define GD3P(PA, PB, KT, BUF) { _Pragma("unroll") for (int i = 0; i < NA4; ++i) __builtin_amdgcn_global_load_lds((const unsigned*)((PA) + (size_t)i * 128 * K + (KT) * 32), (unsigned*)(Al + (BUF) * ST + i * 4096), 16, 0, 0); \
                               _Pragma("unroll") for (int i = 0; i < NB4; ++i) __builtin_amdgcn_global_load_lds((const unsigned*)((PB) + (size_t)i * 128 * K + (KT) * 32), (unsigned*)(Bl + (BUF) * ST + i * 4096), 16, 0, 0); }
#define GD3(KT, BUF) GD3P(Ad, Bd, KT, BUF)
    asm volatile("s_waitcnt vmcnt(0)" ::: "memory");
    if (!(e.ctx & 1)) {
      GD3(0, 0);
      if (nk32 > 1) GD3(1, 1);
      if (nk32 > 2) GD3(2, 2);
    }
#define RING_STEP(J) { \
      const int kt = kt0 + (J); \
      if (kt + 2 < nk32) asm volatile("s_waitcnt vmcnt(%0)" :: "n"(2 * (NA4 + NB4)) : "memory"); \
      else if (kt + 1 < nk32) asm volatile("s_waitcnt vmcnt(%0)" :: "n"(NA4 + NB4) : "memory"); \
      else asm volatile("s_waitcnt vmcnt(0)" ::: "memory"); \
      asm volatile("s_waitcnt lgkmcnt(0)" ::: "memory"); \
      __builtin_amdgcn_s_barrier(); \
      asm volatile("" ::: "memory"); \
      const unsigned aad = lbase + (unsigned)(((J) * ST + a_row3) * 2); \
      const unsigned bad = lbase + (unsigned)(((J) * ST + b_row3) * 2); \
      bf16x8 b0, b1, b2, b3, a0, a1, a2, a3; \
      asm volatile("ds_read_b128 %0, %1" : "=v"(b0) : "v"(bad)); \
      asm volatile("ds_read_b128 %0, %1 offset:1024" : "=v"(b1) : "v"(bad)); \
      asm volatile("ds_read_b128 %0, %1 offset:2048" : "=v"(b2) : "v"(bad)); \
      asm volatile("ds_read_b128 %0, %1 offset:3072" : "=v"(b3) : "v"(bad)); \
      asm volatile("ds_read_b128 %0, %1" : "=v"(a0) : "v"(aad)); \
      asm volatile("ds_read_b128 %0, %1 offset:1024" : "=v"(a1) : "v"(aad)); \
      asm volatile("ds_read_b128 %0, %1 offset:2048" : "=v"(a2) : "v"(aad)); \
      asm volatile("ds_read_b128 %0, %1 offset:3072" : "=v"(a3) : "v"(aad)); \
      __builtin_amdgcn_s_setprio(1); \
      asm volatile("s_waitcnt lgkmcnt(3)" : "+v"(b0), "+v"(b1), "+v"(b2), "+v"(b3), "+v"(a0)); \
      acc[0][0] = mfma16(b0, a0, acc[0][0]); acc[0][1] = mfma16(b1, a0, acc[0][1]); acc[0][2] = mfma16(b2, a0, acc[0][2]); acc[0][3] = mfma16(b3, a0, acc[0][3]); \
      asm volatile("s_waitcnt lgkmcnt(2)" : "+v"(a1)); \
      acc[1][0] = mfma16(b0, a1, acc[1][0]); acc[1][1] = mfma16(b1, a1, acc[1][1]); acc[1][2] = mfma16(b2, a1, acc[1][2]); acc[1][3] = mfma16(b3, a1, acc[1][3]); \
      asm volatile("s_waitcnt lgkmcnt(1)" : "+v"(a2)); \
      acc[2][0] = mfma16(b0, a2, acc[2][0]); acc[2][1] = mfma16(b1, a2, acc[2][1]); acc[2][2] = mfma16(b2, a2, acc[2][2]); acc[2][3] = mfma16(b3, a2, acc[2][3]); \
      asm volatile("s_waitcnt lgkmcnt(0)" : "+v"(a3)); \
      acc[3][0] = mfma16(b0, a3, acc[3][0]); acc[3][1] = mfma16(b1, a3, acc[3][1]); acc[3][2] = mfma16(b2, a3, acc[3][2]); acc[3][3] = mfma16(b3, a3, acc[3][3]); \
      if (kt + 3 < nk32) GD3(kt + 3, ((J) + 3) & 3);     \
      asm volatile("ds_read_b128 %0, %1 offset:4096" : "=v"(a0) : "v"(aad)); \
      asm volatile("ds_read_b128 %0, %1 offset:5120" : "=v"(a1) : "v"(aad)); \
      asm volatile("ds_read_b128 %0, %1 offset:6144" : "=v"(a2) : "v"(aad)); \
      asm volatile("ds_read_b128 %0, %1 offset:7168" : "=v"(a3) : "v"(aad)); \
      asm volatile("s_waitcnt lgkmcnt(3)" : "+v"(a0), "+v"(b0), "+v"(b1), "+v"(b2), "+v"(b3)); \
      acc[4][0] = mfma16(b0, a0, acc[4][0]); acc[4][1] = mfma16(b1, a0, acc[4][1]); acc[4][2] = mfma16(b2, a0, acc[4][2]); acc[4][3] = mfma16(b3, a0, acc[4][3]); \
      asm volatile("s_waitcnt lgkmcnt(2)" : "+v"(a1)); \
      acc[5][0] = mfma16(b0, a1, acc[5][0]); acc[5][1] = mfma16(b1, a1, acc[5][1]); acc[5][2] = mfma16(b2, a1, acc[5][2]); acc[5][3] = mfma16(b3, a1, acc[5][3]); \
      asm volatile("s_waitcnt lgkmcnt(1)" : "+v"(a2)); \
      acc[6][0] = mfma16(b0, a2, acc[6][0]); acc[6][1] = mfma16(b1, a2, acc[6][1]); acc[6][2] = mfma16(b2, a2, acc[6][2]); acc[6][3] = mfma16(b3, a2, acc[6][3]); \
      asm volatile("s_waitcnt lgkmcnt(0)" : "+v"(a3)); \
      acc[7][0] = mfma16(b0, a3, acc[7][0]); acc[7][1] = mfma16(b1, a3, acc[7][1]); acc[7][2] = mfma16(b2, a3, acc[7][2]); acc[7][3] = mfma16(b3, a3, acc[7][3]); \
      __builtin_amdgcn_s_setprio(0); }
    for (int kt0 = 0; kt0 < nk32; kt0 += 4) {
      RING_STEP(0) RING_STEP(1) RING_STEP(2) RING_STEP(3)
    }
#undef RING_STEP
    __syncthreads();
    if (e.ldc) {
      const int nx = e.ldc - 1;
      const u16* Ad2 = A + (size_t)((nx & 255) * BM + (tid >> 2)) * K + (((tid & 3) ^ fs) << 3);
      const u16* Bd2 = Wt + (size_t)((nx >> 8) * BN + (tid >> 2)) * K + (((tid & 3) ^ fs) << 3);
      GD3P(Ad2, Bd2, 0, 0);
      if (nk32 > 1) GD3P(Ad2, Bd2, 1, 1);
      if (nk32 > 2) GD3P(Ad2, Bd2, 2, 2);
    }
#undef GD3
#undef GD3P
  } else if constexpr (DEPTH == 0) {
    const int swz = (lr >> 1) & 7;
    const u16* Ad = A + (size_t)(tm * BM + lr) * K + ((lc ^ swz) << 3);
    const u16* Bd = Wt + (size_t)(tn * BN + lr) * K + ((lc ^ swz) << 3);
    u16* Al = As + tid * 8;
    u16* Bl = Bs + tid * 8;
#define GD(KT, BUF) { _Pragma("unroll") for (int i = 0; i < NA; ++i) __builtin_amdgcn_global_load_lds((const unsigned*)(Ad + (size_t)i * 64 * K + (KT) * 64), (unsigned*)(Al + (BUF) * BUFSZ + i * 4096), 16, 0, 0); \
                      _Pragma("unroll") for (int i = 0; i < NB; ++i) __builtin_amdgcn_global_load_lds((const unsigned*)(Bd + (size_t)i * 64 * K + (KT) * 64), (unsigned*)(Bl + (BUF) * BUFSZ + i * 4096), 16, 0, 0); }
    GD(0, 0);
    asm volatile("s_waitcnt vmcnt(0)" ::: "memory");
    __syncthreads();
    for (int kt = 0; kt < nk; kt += 2) {
      if (kt + 1 < nk) GD(kt + 1, 1);
      g_compute<FI, FJ, (EPI != EPI_KVUP)>(acc, As + a_row, Bs + b_row, q4, rsw);
      asm volatile("s_waitcnt vmcnt(0)" ::: "memory");
      __syncthreads();
      if (kt + 1 >= nk) break;
      if (kt + 2 < nk) GD(kt + 2, 0);
      g_compute<FI, FJ, (EPI != EPI_KVUP)>(acc, As + BUFSZ + a_row, Bs + BUFSZ + b_row, q4, rsw);
      asm volatile("s_waitcnt vmcnt(0)" ::: "memory");
      __syncthreads();
    }
#undef GD
  } else if constexpr (DEPTH == 2) {
    u32x4 ra0[NA], rb0[NB], ra1[NA], rb1[NB];
    GL(ra0, rb0, 0);
    if (nk > 1) GL(ra1, rb1, 1);
    GS(ra0, rb0, 0);
    __syncthreads();
    for (int kt = 0; kt < nk; kt += 2) {
      if (kt + 2 < nk) GL(ra0, rb0, kt + 2);
      g_compute<FI, FJ, (EPI != EPI_KVUP)>(acc, As + a_row, Bs + b_row, q4, rsw);
      if (kt + 1 < nk) GS(ra1, rb1, 1);
      __syncthreads();
      if (kt + 1 >= nk) break;
      if (kt + 3 < nk) GL(ra1, rb1, kt + 3);
      g_compute<FI, FJ, (EPI != EPI_KVUP)>(acc, As + BUFSZ + a_row, Bs + BUFSZ + b_row, q4, rsw);
      if (kt + 2 < nk) GS(ra0, rb0, 0);
      __syncthreads();
    }
  } else {
    u32x4 ra0[NA], rb0[NB];
    GL(ra0, rb0, 0);
    GS(ra0, rb0, 0);
    __syncthreads();
    for (int kt = 0; kt < nk; kt += 2) {
      if (kt + 1 < nk) GL(ra0, rb0, kt + 1);
      g_compute<FI, FJ, (EPI != EPI_KVUP)>(acc, As + a_row, Bs + b_row, q4, rsw);
      if (kt + 1 < nk) GS(ra0, rb0, 1);
      __syncthreads();
      if (kt + 1 >= nk) break;
      if (kt + 2 < nk) GL(ra0, rb0, kt + 2);
      g_compute<FI, FJ, (EPI != EPI_KVUP)>(acc, As + BUFSZ + a_row, Bs + BUFSZ + b_row, q4, rsw);
      if (kt + 2 < nk) GS(ra0, rb0, 0);
      __syncthreads();
    }
  }
#undef GL
#undef GS
  const int mb = tm * BM + wm * FI * 16 + q4 * 4;
  const int nb = tn * BN + wn * FJ * 16;
  const int mrow = tm * BM + wm * FI * 16 + l15;
  if (EPI == EPI_STORE) {
#pragma unroll
    for (int i = 0; i < FI; ++i)
#pragma unroll
      for (int j = 0; j < FJ; ++j) *(f32x4*)(e.C + (size_t)(mrow + i * 16) * e.ldc + nb + j * 16 + q4 * 4) = acc[i][j];
  } else if (EPI == EPI_RESID) {
    const float cf = e.ldc ? 0.5f : 1.0f;
    const f32x4 cfv = {cf, cf, cf, cf};
#pragma unroll
    for (int i = 0; i < FI; ++i) {
      const int m = mrow + i * 16;
      const float* gt = e.gate + (size_t)grp_of(m) * 9216;
#pragma unroll
      for (int j = 0; j < FJ; ++j) {
        const int n = nb + j * 16 + q4 * 4;
        f32x4 g = *(const f32x4*)(gt + n);
        f32x4* px = (f32x4*)(e.C + (size_t)m * 1024 + n);
        f32x4 xv;
        if (e.vtp) xv = *(const f32x4*)((m < NPR ? (const float*)e.vtp + (size_t)m * 1024 : (const float*)e.vts + (size_t)(m - NPR) * 1024) + n);
        else xv = *px;
        xv += g * cfv * acc[i][j];
        *px = xv;
      }
    }
  } else if (EPI == EPI_SWIGLU) {
    const bool odd = (q4 & 1) != 0;
#pragma unroll
    for (int j = 0; j < FJ; ++j) {
      const int hj = ((nb >> 4) + j) * 8 + (q4 >> 1) * 4;
#pragma unroll
      for (int i2 = 0; i2 < FI / 2; ++i2) {
        float hv[4];
#pragma unroll
        for (int r = 0; r < 4; ++r) {
          float send = odd ? acc[2 * i2][j][r] : acc[2 * i2 + 1][j][r];
          float recv = shx(send, 16);
          float g = odd ? recv : acc[2 * i2][j][r];
          float u = odd ? acc[2 * i2 + 1][j][r] : recv;
          hv[r] = silu_f(g) * u;
        }
        const int m = mrow + (2 * i2 + (odd ? 1 : 0)) * 16;
        uint2 o; o.x = pack2(hv[0], hv[1]); o.y = pack2(hv[2], hv[3]);
        *(uint2*)(e.H + (size_t)m * 2816 + hj) = o;
      }
    }
  } else if (EPI == EPI_KVUP) {
#pragma unroll
    for (int j = 0; j < FJ; ++j) {
      const int n0 = nb + j * 16;
      const int hh = n0 >> 7, wb = n0 & 127;
#pragma unroll
      for (int i = 0; i < FI; ++i) {
        const int m0 = mb + i * 16;
        int krow; u16* vt;
        if (e.ctx) {
          int b = m0 >> 9, key = m0 & 511;
          krow = NPR + b * 1536 + 1024 + key;
          vt = e.vts + (size_t)((b * 8 + hh) * 64) * 1536 + 1024 + key;
        } else if (m0 < NPR) {
          int b = m0 >> 8, t = m0 & 255;
          krow = m0;
          vt = e.vtp + (size_t)((b * 8 + hh) * 64) * 256 + t;
        } else {
          int s = m0 - NPR, b = s >> 10, t = s & 1023;
          krow = NPR + b * 1536 + t;
          vt = e.vts + (size_t)((b * 8 + hh) * 64) * 1536 + t;
        }
        if (wb < 64) {
#pragma unroll
          for (int r = 0; r < 4; ++r) e.kb[(size_t)(krow + r) * 768 + hh * 96 + wb + l15] = f2bf(acc[i][j][r]);
        } else {
          const int d = wb - 64 + l15;
          const size_t L = (e.ctx || m0 >= NPR) ? 1536 : 256;
          uint2 o; o.x = pack2(acc[i][j][0], acc[i][j][1]); o.y = pack2(acc[i][j][2], acc[i][j][3]);
          *(uint2*)(vt + (size_t)d * L) = o;
        }
      }
    }
  }
}

template <int EPI, int WMW, int WNW, int FI, int FJ, int DEPTH>
__device__ __forceinline__ void gemm_phase(const u16* A, const u16* Wt, int K, int Mt, int Nt, const EpiP& e, char* smem) {
  for (int t = rbid(); t < Mt * Nt; t += (int)gridDim.x) gemm_tile<EPI, WMW, WNW, FI, FJ, DEPTH>(A, Wt, K, t % Mt, t / Mt, e, smem);
}

__device__ __forceinline__ void ffn_in_phase(PRM p, int l, int which, const EpiP& e, char* smem) {
  const u16* Wt = p.wt_ffn_in + (size_t)(l * 2 + which) * 5632 * 1024;
  const int G = (int)gridDim.x;
  const int nfull = (528 / G) * G;
  {
    bool first = true;
    for (int t = rbid(); t < nfull; t += G) {
      EpiP e2 = e;
      const int tnx = t + G;
      e2.ctx = first ? 0 : 1;
      e2.ldc = (tnx < nfull) ? ((tnx % 24) | ((tnx / 24) << 8)) + 1 : 0;
      gemm_tile<EPI_SWIGLU, 2, 4, 8, 4, 3>(p.xn, Wt, 1024, t % 24, t / 24, e2, smem);
      first = false;
    }
  }
  const int nq = (528 - nfull) * 4;
  const int bid = rbid();
  for (int u = bid; u < nq; u += G) {
    const int t = nfull + (u >> 2), sub = u & 3;
    gemm_tile<EPI_SWIGLU, 4, 2, 2, 4, 2>(p.xn, Wt, 1024, (t % 24) * 2 + (sub >> 1), (t / 24) * 2 + (sub & 1), e, smem);
  }
  const int tail = nq < G ? nq : G;
  if (l < 3 && bid >= tail) {
    const int vb = rtid() >> 8;
    char* vsm = smem + vb * LDS_HALF;
    const int nfree = (G - tail) * 2;
    const int vrank = (bid - tail) * 2 + vb;
    const int cnt = conv_layer_count(l + 1);
    const int half = cnt >> 1;
    const int lo = which ? half : 0, hi = which ? cnt : half;
    for (int c = lo + vrank; c < hi; c += nfree) conv_layer_task(p, l + 1, c, (float*)vsm);
    for (int c = nfree - 1 - vrank; c < 72; c += nfree) mod_task(p, (l + 1) * 144 + which * 72 + c, (float*)vsm);
  }
}

__device__ __forceinline__ void rope_store_kb(PRM p, float val, int lane, int t, bool sample, int krow) {
  float outv = val;
  if (sample) {
    float partner = shx(val, 8);
    int w = lane & 15, fi = w & 7;
    float pos = (float)((lane & 16) ? (t & 63) : (t >> 6));
    float fr = __expf(-9.210340372f * (float)fi * 0.125f);
    float s, c; sincos_r(pos * fr, s, c);
    outv = (w < 8) ? val * c - partner * s : val * c + partner * s;
  }
  if (lane < 32) {
    u16 b = f2bf(outv);
#pragma unroll
    for (int h = 0; h < 8; ++h) p.kb[(size_t)krow * 768 + h * 96 + 64 + lane] = b;
  }
}

__device__ __forceinline__ void post_even(PRM p, int e) {
  const int tid = get_tid(), lane = tid & 63, wave = tid >> 6;
  const int NT = NTOK / 4;
  const int NC = 256;
  for (int task = get_bid(); task < NT + NC; task += vgrid()) {
    if (task < NT) {
      const int m0 = task * 4, m = m0 + wave;
      const bool pr = m < NPR;
      const int b = pr ? (m >> 8) : ((m - NPR) >> 10);
      const int t = pr ? (m & 255) : ((m - NPR) & 1023);
      const float* row = p.proj + (size_t)m * 2688;
      {
        float4 a0 = *(const float4*)(row + lane * 8), a1 = *(const float4*)(row + lane * 8 + 4);
        uint4 o; o.x = pack2(a0.x, a0.y); o.y = pack2(a0.z, a0.w); o.z = pack2(a1.x, a1.y); o.w = pack2(a1.z, a1.w);
        *(uint4*)(p.qa + (size_t)m * 512 + lane * 8) = o;
        float4 k0 = *(const float4*)(row + 512 + lane * 8), k1 = *(const float4*)(row + 512 + lane * 8 + 4);
        o.x = pack2(k0.x, k0.y); o.y = pack2(k0.z, k0.w); o.z = pack2(k1.x, k1.y); o.w = pack2(k1.z, k1.w);
        *(uint4*)(p.ka + (size_t)m * 512 + lane * 8) = o;
        if (pr) {
          float* ok = p.out + O_AK + ((size_t)(b * 2 + e) * 256 + t) * 512 + lane * 8;
          *(float4*)ok = k0; *(float4*)(ok + 4) = k1;
          float4 v0 = *(const float4*)(row + 1024 + lane * 8), v1 = *(const float4*)(row + 1024 + lane * 8 + 4);
          float* ov = p.out + O_AV + ((size_t)(b * 2 + e) * 256 + t) * 512 + lane * 8;
          *(float4*)ov = v0; *(float4*)(ov + 4) = v1;
        }
      }
      {
        float4 c0 = *(const float4*)(row + 1536 + lane * 12), c1 = *(const float4*)(row + 1536 + lane * 12 + 4), c2 = *(const float4*)(row + 1536 + lane * 12 + 8);
        float ss = c0.x * c0.x + c0.y * c0.y + c0.z * c0.z + c0.w * c0.w + c1.x * c1.x + c1.y * c1.y + c1.z * c1.z + c1.w * c1.w +
                   c2.x * c2.x + c2.y * c2.y + c2.z * c2.z + c2.w * c2.w;
        ss = wsum(ss);
        float r = rsqrtf(ss * (1.f / 768.f) + EPS);
        const float* g = p.b_q_norm + e * 768 + lane * 12;
        float4 g0 = *(const float4*)g, g1 = *(const float4*)(g + 4), g2 = *(const float4*)(g + 8);
        uint2 o0, o1, o2;
        o0.x = pack2(c0.x * r * g0.x, c0.y * r * g0.y); o0.y = pack2(c0.z * r * g0.z, c0.w * r * g0.w);
        o1.x = pack2(c1.x * r * g1.x, c1.y * r * g1.y); o1.y = pack2(c1.z * r * g1.z, c1.w * r * g1.w);
        o2.x = pack2(c2.x * r * g2.x, c2.y * r * g2.y); o2.y = pack2(c2.z * r * g2.z, c2.w * r * g2.w);
        u16* d = p.cqn + (size_t)m * 768 + lane * 12;
        *(uint2*)d = o0; *(uint2*)(d + 4) = o1; *(uint2*)(d + 8) = o2;
      }
      {
        float4 c0 = *(const float4*)(row + 2304 + lane * 4);
        float ss = wsum(c0.x * c0.x + c0.y * c0.y + c0.z * c0.z + c0.w * c0.w);
        float r = rsqrtf(ss * (1.f / 256.f) + EPS);
        float4 g0 = *(const float4*)(p.b_kv_norm + e * 256 + lane * 4);
        float4 y; y.x = c0.x * r * g0.x; y.y = c0.y * r * g0.y; y.z = c0.z * r * g0.z; y.w = c0.w * r * g0.w;
        uint2 o; o.x = pack2(y.x, y.y); o.y = pack2(y.z, y.w);
        *(uint2*)(p.ckvn + (size_t)m * 256 + lane * 4) = o;
        if (pr) *(float4*)(p.out + O_CKV + ((size_t)(b * 2 + e) * 256 + t) * 256 + lane * 4) = y;
      }
      {
        float val = row[2560 + (lane & 31)];
        if (pr && lane < 32) p.out[O_KR + ((size_t)(b * 2 + e) * 256 + t) * 32 + lane] = val;
        rope_store_kb(p, val, lane, t, !pr, keyrow(m));
      }
      {
        const bool pr0 = m0 < NPR;
        const int b0 = pr0 ? (m0 >> 8) : ((m0 - NPR) >> 10);
        const int t0 = pr0 ? (m0 & 255) : ((m0 - NPR) & 1023);
#pragma unroll
        for (int i = 0; i < 2; ++i) {
          int pp = tid + 256 * i, h = pp >> 6, d = pp & 63;
          const float* src = p.proj + (size_t)m0 * 2688 + 1024 + h * 64 + d;
          float v0 = src[0], v1 = src[2688], v2 = src[2 * 2688], v3 = src[3 * 2688];
          uint2 o; o.x = pack2(v0, v1); o.y = pack2(v2, v3);
          u16* dst = pr0 ? p.vta_p + (size_t)((b0 * 8 + h) * 64 + d) * 256 + t0 : p.vta_s + (size_t)((b0 * 8 + h) * 64 + d) * 1536 + t0;
          *(uint2*)dst = o;
        }
      }
    } else {
      const int ct = task - NT;
      const int b = ct >> 7, key0 = (ct & 127) * 4;
      {
        const float* src = p.cache_a_k + ((size_t)(b * 2 + e) * 512 + key0) * 512;
        u16* dst = p.kactx + ((size_t)b * 512 + key0) * 512;
#pragma unroll
        for (int i = 0; i < 2; ++i) {
          int idx = (tid + 256 * i) * 4;
          float4 v = *(const float4*)(src + idx);
          uint2 o; o.x = pack2(v.x, v.y); o.y = pack2(v.z, v.w);
          *(uint2*)(dst + idx) = o;
        }
      }
      {
        const float* src = p.cache_a_v + ((size_t)(b * 2 + e) * 512 + key0) * 512;
#pragma unroll
        for (int i = 0; i < 2; ++i) {
          int pp = tid + 256 * i, h = pp >> 6, d = pp & 63;
          float v0 = src[pp], v1 = src[512 + pp], v2 = src[1024 + pp], v3 = src[1536 + pp];
          uint2 o; o.x = pack2(v0, v1); o.y = pack2(v2, v3);
          *(uint2*)(p.vta_s + (size_t)((b * 8 + h) * 64 + d) * 1536 + 1024 + key0) = o;
        }
      }
      {
        const float* src = p.cache_b_ckv + ((size_t)(b * 2 + e) * 512 + key0) * 256;
        float4 v = *(const float4*)(src + tid * 4);
        uint2 o; o.x = pack2(v.x, v.y); o.y = pack2(v.z, v.w);
        *(uint2*)(p.cctxn + ((size_t)b * 512 + key0) * 256 + tid * 4) = o;
      }
      {
        const float* src = p.cache_b_krope + ((size_t)(b * 2 + e) * 512 + key0) * 32;
#pragma unroll
        for (int i = 0; i < 4; ++i) {
          int idx = tid + 256 * i;
          int kk = idx >> 8, h = (idx >> 5) & 7, dd = idx & 31;
          p.kb[(size_t)(NPR + b * 1536 + 1024 + key0 + kk) * 768 + h * 96 + 64 + dd] = f2bf(src[kk * 32 + dd]);
        }
      }
    }
  }
}

__device__ __forceinline__ void post_odd(PRM p, int o) {
  const int tid = get_tid(), lane = tid & 63, wave = tid >> 6;
  const int NT = NTOK / 4, NC = 256;
  for (int task = get_bid(); task < NT + NC; task += vgrid()) {
    if (task < NT) {
      const int m0 = task * 4, m = m0 + wave;
      const bool pr = m < NPR;
      const int b = pr ? (m >> 8) : ((m - NPR) >> 10);
      const int t = pr ? (m & 255) : ((m - NPR) & 1023);
      const float* row = p.proj + (size_t)m * 2432;
      float rs = 0.f, rc = 1.f;
      if (!pr) {
        int w = lane & 31, fi = w & 15;
        float pos = (float)((lane & 32) ? (t & 63) : (t >> 6));
        float fr = __expf(-9.210340372f * (float)fi * (1.f / 16.f));
        sincos_r(pos * fr, rs, rc);
      }
      const bool lo = (lane & 16) == 0;
      const float gq = p.d_q_norm[o * 64 + lane], gk = p.d_k_norm[o * 64 + lane];
#pragma unroll
      for (int hd = 0; hd < 8; ++hd) {
        float v = row[1552 + hd * 64 + lane];
        float ss = wsum(v * v);
        float y = v * rsqrtf(ss * (1.f / 64.f) + EPS) * gq;
        if (!pr) { float pt = shx(y, 16); y = lo ? y * rc - pt * rs : y * rc + pt * rs; }
        p.qa[(size_t)m * 512 + hd * 64 + lane] = f2bf(y);
      }
#pragma unroll
      for (int kh = 0; kh < 2; ++kh) {
        float v = row[2064 + kh * 64 + lane];
        float ss = wsum(v * v);
        float y = v * rsqrtf(ss * (1.f / 64.f) + EPS) * gk;
        if (pr) p.out[O_DK + ((size_t)(b * 2 + o) * 256 + t) * 128 + kh * 64 + lane] = y;
        else { float pt = shx(y, 16); y = lo ? y * rc - pt * rs : y * rc + pt * rs; }
        p.kd[(size_t)keyrow(m) * 128 + kh * 64 + lane] = f2bf(y);
        if (pr) p.out[O_DV + ((size_t)(b * 2 + o) * 256 + t) * 128 + kh * 64 + lane] = row[2192 + kh * 64 + lane];
      }
      if (tid < 128) {
        const bool pr0 = m0 < NPR;
        const int b0 = pr0 ? (m0 >> 8) : ((m0 - NPR) >> 10);
        const int t0 = pr0 ? (m0 & 255) : ((m0 - NPR) & 1023);
        int kh = tid >> 6, d = tid & 63;
        const float* src = p.proj + (size_t)m0 * 2432 + 2192 + tid;
        float v0 = src[0], v1 = src[2432], v2 = src[2 * 2432], v3 = src[3 * 2432];
        uint2 oo; oo.x = pack2(v0, v1); oo.y = pack2(v2, v3);
        u16* dst = pr0 ? p.vtd_p + (size_t)((b0 * 2 + kh) * 64 + d) * 256 + t0 : p.vtd_s + (size_t)((b0 * 2 + kh) * 64 + d) * 1536 + t0;
        *(uint2*)dst = oo;
      }
    } else {
      const int ct = task - NT;
      const int b = ct >> 7, key0 = (ct & 127) * 4;
      {
        const float* src = p.cache_d_k + ((size_t)(b * 2 + o) * 512 + key0) * 128;
        if (tid < 128) {
          float4 v = *(const float4*)(src + tid * 4);
          uint2 oo; oo.x = pack2(v.x, v.y); oo.y = pack2(v.z, v.w);
          *(uint2*)(p.kd + (size_t)(NPR + b * 1536 + 1024 + key0) * 128 + tid * 4) = oo;
        } else {
          int pp = tid - 128, kh = pp >> 6, d = pp & 63;
          const float* sv = p.cache_d_v + ((size_t)(b * 2 + o) * 512 + key0) * 128;
          float v0 = sv[pp], v1 = sv[128 + pp], v2 = sv[256 + pp], v3 = sv[384 + pp];
          uint2 oo; oo.x = pack2(v0, v1); oo.y = pack2(v2, v3);
          *(uint2*)(p.vtd_s + (size_t)((b * 2 + kh) * 64 + d) * 1536 + 1024 + key0) = oo;
        }
      }
    }
  }
}

struct AttnSt { float m, l; f32x4 o[4]; };
template <int KS> struct KVf { bf16x8 k0[KS], k1[KS]; s16x4 v0[4], v1[4]; };

template <int KS>
__device__ __forceinline__ void attn_load(KVf<KS>& f, const u16* __restrict__ Kb, int kstride, const u16* __restrict__ Vtb, int vtstride, int l15, int q4) {
  const u16* k0p = Kb + (size_t)l15 * kstride + q4 * 8;
  const u16* k1p = k0p + (size_t)16 * kstride;
#pragma unroll
  for (int ks = 0; ks < KS; ++ks) { f.k0[ks] = *(const bf16x8*)(k0p + ks * 32); f.k1[ks] = *(const bf16x8*)(k1p + ks * 32); }
#pragma unroll
  for (int dt = 0; dt < 4; ++dt) {
    const u16* vp = Vtb + (size_t)(dt * 16 + l15) * vtstride + q4 * 4;
    f.v0[dt] = *(const s16x4*)vp; f.v1[dt] = *(const s16x4*)(vp + 16);
  }
}

template <int KS>
__device__ __forceinline__ void attn_comp(AttnSt& st, const bf16x8 (&qf)[KS], const KVf<KS>& f, float scale, int q4,
                                          bool masked, const float* rpbrow, int qc, int kc0) {
  f32x4 s0 = {0.f, 0.f, 0.f, 0.f}, s1 = {0.f, 0.f, 0.f, 0.f};
#pragma unroll
  for (int ks = 0; ks < KS; ++ks) { s0 = mfma16(f.k0[ks], qf[ks], s0); s1 = mfma16(f.k1[ks], qf[ks], s1); }
  float sv[8];
#pragma unroll
  for (int j = 0; j < 4; ++j) { sv[j] = s0[j] * scale; sv[4 + j] = s1[j] * scale; }
  if (masked) {
    const int cs = min(max(qc - 8, 0), 48);
#pragma unroll
    for (int e = 0; e < 8; ++e) {
      int kc = kc0 + (e >> 2) * 16 + q4 * 4 + (e & 3);
      bool ok = (kc >= cs) && (kc < cs + 16);
      int di = min(max(kc - qc, -15), 15) + 15;
      sv[e] = ok ? sv[e] + rpbrow[di] : -INFINITY;
    }
  }
  float mx = sv[0];
#pragma unroll
  for (int e = 1; e < 8; ++e) mx = fmaxf(mx, sv[e]);
  mx = fmaxf(mx, shx(mx, 16));
  mx = fmaxf(mx, shx(mx, 32));
  const float mnew = fmaxf(st.m, mx);
  const float alpha = __expf(st.m - mnew);
  float pe[8], ls = 0.f;
#pragma unroll
  for (int e = 0; e < 8; ++e) { pe[e] = __expf(sv[e] - mnew); ls += pe[e]; }
  st.l = st.l * alpha + ls;
  st.m = mnew;
  bf16x8 pf;
#pragma unroll
  for (int e = 0; e < 8; ++e) pf[e] = (short)f2bf(pe[e]);
#pragma unroll
  for (int dt = 0; dt < 4; ++dt) {
    bf16x8 vf = (bf16x8){f.v0[dt].x, f.v0[dt].y, f.v0[dt].z, f.v0[dt].w, f.v1[dt].x, f.v1[dt].y, f.v1[dt].z, f.v1[dt].w};
    st.o[dt] *= alpha;
    st.o[dt] = mfma16(vf, pf, st.o[dt]);
  }
}

__device__ __forceinline__ void attn_init(AttnSt& st) {
  st.m = -1e30f; st.l = 0.f;
#pragma unroll
  for (int dt = 0; dt < 4; ++dt) st.o[dt] = (f32x4){0.f, 0.f, 0.f, 0.f};
}
__device__ __forceinline__ void attn_fin(AttnSt& st, u16* outp  , int l15, int q4) {
  float lt = st.l;
  lt += shx(lt, 16);
  lt += shx(lt, 32);
  const float inv = 1.f / lt;
#pragma unroll
  for (int dt = 0; dt < 4; ++dt) {
    uint2 o; o.x = pack2(st.o[dt][0] * inv, st.o[dt][1] * inv); o.y = pack2(st.o[dt][2] * inv, st.o[dt][3] * inv);
    *(uint2*)(outp + (size_t)l15 * 1024 + dt * 16 + q4 * 4) = o;
  }
}

#define AT_VSTR 72
template <int KS> struct ATile { static constexpr int KSTR = KS * 32 + 8; static constexpr int BUF = 64 * (KS * 32 + 8) + 64 * AT_VSTR; };
template <int KS> struct AStage { u32x4 k[KS]; u32x4 v[2]; };

template <int KS>
__device__ __forceinline__ void at_load(AStage<KS>& r, const u16* __restrict__ Kg, int kstride, const u16* __restrict__ Vg, int vtstride, int tid) {
#pragma unroll
  for (int i = 0; i < KS; ++i) {
    int c = tid + 256 * i; int row = c / (KS * 4), ch = c - row * (KS * 4);
    r.k[i] = *(const u32x4*)(Kg + (unsigned)(row * kstride + ch * 8));
  }
#pragma unroll
  for (int i = 0; i < 2; ++i) {
    int c = tid + 256 * i; int row = c >> 3, ch = c & 7;
    r.v[i] = *(const u32x4*)(Vg + (unsigned)(row * vtstride + ch * 8));
  }
}
template <int KS>
__device__ __forceinline__ void at_store(const AStage<KS>& r, u16* buf, int tid) {
  u16* Ks = buf; u16* Vs = buf + 64 * ATile<KS>::KSTR;
#pragma unroll
  for (int i = 0; i < KS; ++i) {
    int c = tid + 256 * i; int row = c / (KS * 4), ch = c - row * (KS * 4);
    *(u32x4*)(Ks + row * ATile<KS>::KSTR + ch * 8) = r.k[i];
  }
#pragma unroll
  for (int i = 0; i < 2; ++i) {
    int c = tid + 256 * i; int row = c >> 3, ch = c & 7;
    *(u32x4*)(Vs + row * AT_VSTR + ch * 8) = r.v[i];
  }
}

template <int KS>
__device__ __forceinline__ void at_comp(AttnSt& st, const bf16x8 (&qf)[KS], const u16* buf, float scale, int l15, int q4,
                                        bool masked, const float* rpbrow, int qc) {
  const u16* Ks = buf; const u16* Vs = buf + 64 * ATile<KS>::KSTR;
  f32x4 s[4];
#pragma unroll
  for (int kt = 0; kt < 4; ++kt) {
    s[kt] = (f32x4){0.f, 0.f, 0.f, 0.f};
#pragma unroll
    for (int ks = 0; ks < KS; ++ks) {
      bf16x8 a = *(const bf16x8*)(Ks + (kt * 16 + l15) * ATile<KS>::KSTR + ks * 32 + q4 * 8);
      s[kt] = mfma16(a, qf[ks], s[kt]);
    }
  }
  float sv[16];
  const float sc2 = scale * 1.4426950408889634f;
#pragma unroll
  for (int kt = 0; kt < 4; ++kt)
#pragma unroll
    for (int j = 0; j < 4; ++j) sv[kt * 4 + j] = s[kt][j] * sc2;
  if (masked) {
    const int cs = min(max(qc - 8, 0), 48);
#pragma unroll
    for (int e = 0; e < 16; ++e) {
      int kc = (e >> 2) * 16 + q4 * 4 + (e & 3);
      bool ok = (kc >= cs) && (kc < cs + 16);
      int di = min(max(kc - qc, -15), 15) + 15;
      sv[e] = ok ? sv[e] + rpbrow[di] : -INFINITY;
    }
  }
  float mx = sv[0];
#pragma unroll
  for (int e = 1; e < 16; ++e) mx = fmaxf(mx, sv[e]);
  mx = fmaxf(mx, shx(mx, 16));
  mx = fmaxf(mx, shx(mx, 32));
  const float mnew = fmaxf(st.m, mx);
  const float alpha = __builtin_amdgcn_exp2f(st.m - mnew);
  float ls = 0.f;
#pragma unroll
  for (int e = 0; e < 16; ++e) { sv[e] = __builtin_amdgcn_exp2f(sv[e] - mnew); ls += sv[e]; }
  st.l = st.l * alpha + ls;
  st.m = mnew;
  bf16x8 pf[2];
#pragma unroll
  for (int hf = 0; hf < 2; ++hf) {
    u32x4 pw;
    pw[0] = pack2(sv[hf * 8 + 0], sv[hf * 8 + 1]); pw[1] = pack2(sv[hf * 8 + 2], sv[hf * 8 + 3]);
    pw[2] = pack2(sv[hf * 8 + 4], sv[hf * 8 + 5]); pw[3] = pack2(sv[hf * 8 + 6], sv[hf * 8 + 7]);
    pf[hf] = __builtin_bit_cast(bf16x8, pw);
  }
#pragma unroll
  for (int dt = 0; dt < 4; ++dt) {
    st.o[dt] *= alpha;
#pragma unroll
    for (int hf = 0; hf < 2; ++hf) {
      const u16* vp = Vs + (dt * 16 + l15) * AT_VSTR + hf * 32 + q4 * 4;
      s16x4 v0 = *(const s16x4*)vp;
      s16x4 v1 = *(const s16x4*)(vp + 16);
      bf16x8 vf = (bf16x8){v0.x, v0.y, v0.z, v0.w, v1.x, v1.y, v1.z, v1.w};
      st.o[dt] = mfma16(vf, pf[hf], st.o[dt]);
    }
  }
}

template <int KS>
__device__ __forceinline__ void at_run_plain(AttnSt& st, const bf16x8 (&qf)[KS], const u16* Kbase, int kstride, const u16* Vbase, int vtstride,
                                             int nt, float scale, u16* lds, int tid, int l15, int q4) {
  AStage<KS> r0, r1;
  at_load<KS>(r0, Kbase, kstride, Vbase, vtstride, tid);
  if (nt > 1) at_load<KS>(r1, Kbase + (size_t)64 * kstride, kstride, Vbase + 64, vtstride, tid);
  at_store<KS>(r0, lds, tid);
  __syncthreads();
  for (int t = 0; t < nt; t += 2) {
    if (t + 2 < nt) at_load<KS>(r0, Kbase + (size_t)(t + 2) * 64 * kstride, kstride, Vbase + (t + 2) * 64, vtstride, tid);
    at_comp<KS>(st, qf, lds, scale, l15, q4, false, nullptr, 0);
    if (t + 1 < nt) at_store<KS>(r1, lds + ATile<KS>::BUF, tid);
    __syncthreads();
    if (t + 1 >= nt) break;
    if (t + 3 < nt) at_load<KS>(r1, Kbase + (size_t)(t + 3) * 64 * kstride, kstride, Vbase + (t + 3) * 64, vtstride, tid);
    at_comp<KS>(st, qf, lds + ATile<KS>::BUF, scale, l15, q4, false, nullptr, 0);
    if (t + 2 < nt) at_store<KS>(r0, lds, tid);
    __syncthreads();
  }
}

__device__ __forceinline__ void load_q64(bf16x8 (&qf)[2], const u16* Q, int qstride, int l15, int q4) {
#pragma unroll
  for (int ks = 0; ks < 2; ++ks) qf[ks] = *(const bf16x8*)(Q + (size_t)l15 * qstride + ks * 32 + q4 * 8);
}
__device__ __forceinline__ void load_q_mla(bf16x8 (&qf)[3], const float* Qf, int l15, int q4, bool sample, int t0) {
  const float* qr = Qf + (size_t)l15 * 768 + q4 * 8;
#pragma unroll
  for (int ks = 0; ks < 3; ++ks) {
    float4 a = *(const float4*)(qr + ks * 32), b = *(const float4*)(qr + ks * 32 + 4);
    float v[8] = {a.x, a.y, a.z, a.w, b.x, b.y, b.z, b.w};
    if (ks == 2 && sample) {
      const int t = t0 + l15;
      const float pos = (float)((q4 & 2) ? (t & 63) : (t >> 6));
#pragma unroll
      for (int jj = 0; jj < 8; ++jj) {
        float pt = shx(v[jj], 16);
        float fr = __expf(-9.210340372f * (float)jj * 0.125f);
        float sn, cs; sincos_r(pos * fr, sn, cs);
        v[jj] = (q4 & 1) ? v[jj] * cs + pt * sn : v[jj] * cs - pt * sn;
      }
    }
#pragma unroll
    for (int jj = 0; jj < 8; ++jj) qf[ks][jj] = (short)f2bf(v[jj]);
  }
}

__device__ __forceinline__ void attn_even_phase(PRM p, int e, char* smem) {
  u16* lds = (u16*)smem;
  const int tid = get_tid(), lane = tid & 63, wave = tid >> 6, l15 = lane & 15, q4 = lane >> 4;
  const float scaleB = 0.10206207261596577f;
  for (int bt = get_bid(); bt < 1536; bt += vgrid()) {
    AttnSt st; attn_init(st);
    if (bt < 256) {
      int qb = bt & 15, h = (bt >> 4) & 7, b = bt >> 7;
      int mq = NPR + b * 1024 + qb * 64 + wave * 16;
      bf16x8 qf[3]; load_q_mla(qf, p.qb + (size_t)mq * 768 + h * 96, l15, q4, true, qb * 64 + wave * 16);
      at_run_plain<3>(st, qf, p.kb + (size_t)(NPR + b * 1536) * 768 + h * 96, 768, p.vtb_s + (size_t)((b * 8 + h) * 64) * 1536, 1536, 24, scaleB, lds, tid, l15, q4);
      attn_fin(st, p.mix + (size_t)mq * 1024 + 512 + h * 64, l15, q4);
    } else if (bt < 512) {
      int u = bt - 256;
      int r = u & 15, h = (u >> 4) & 7, b = u >> 7;
      int mq = NPR + b * 1024 + r * 64 + wave * 16;
      bf16x8 qf[2]; load_q64(qf, p.qa + (size_t)mq * 512 + h * 64, 512, l15, q4);
      const u16* Vt = p.vta_s + (size_t)((b * 8 + h) * 64) * 1536;
      const u16* Kc = p.kactx + (size_t)b * 512 * 512 + h * 64;
      const int rs = min(max(r - 4, 0), 8);
      const u16* Kw = p.ka + (size_t)(NPR + b * 1024 + rs * 64) * 512 + h * 64;
      const float* rpb0 = p.a_rpb + ((size_t)(e * 8 + h) * 15 + (rs - r + 7)) * 31;
      const int qc = wave * 16 + l15;
      float* rpl = (float*)(lds + 2 * ATile<2>::BUF);
      if (tid < 248) { int rr = tid / 31, cc = tid - rr * 31; rpl[rr * 32 + cc] = rpb0[rr * 31 + cc] * 1.4426950408889634f; }
      AStage<2> r0, r1;
#define NB_LOAD(R, T) { if ((T) < 8) at_load<2>(R, Kc + (size_t)(T) * 64 * 512, 512, Vt + 1024 + (T) * 64, 1536, tid); \
                        else at_load<2>(R, Kw + (size_t)((T) - 8) * 64 * 512, 512, Vt + (rs + (T) - 8) * 64, 1536, tid); }
#define NB_COMP(BUFP, T) { if ((T) < 8) at_comp<2>(st, qf, BUFP, 0.125f, l15, q4, false, nullptr, 0); \
                           else at_comp<2>(st, qf, BUFP, 0.125f, l15, q4, true, rpl + ((T) - 8) * 32, qc); }
      NB_LOAD(r0, 0);
      NB_LOAD(r1, 1);
      at_store<2>(r0, lds, tid);
      __syncthreads();
      for (int t = 0; t < 16; t += 2) {
        if (t + 2 < 16) NB_LOAD(r0, t + 2);
        NB_COMP(lds, t);
        at_store<2>(r1, lds + ATile<2>::BUF, tid);
        __syncthreads();
        if (t + 3 < 16) NB_LOAD(r1, t + 3);
        NB_COMP(lds + ATile<2>::BUF, t + 1);
        if (t + 2 < 16) at_store<2>(r0, lds, tid);
        __syncthreads();
      }
#undef NB_LOAD
#undef NB_COMP
      attn_fin(st, p.mix + (size_t)mq * 1024 + h * 64, l15, q4);
    } else if (bt < 1024) {
      int u = bt - 512;
      int qb = u & 3, h = (u >> 2) & 7, b = u >> 5;
      int mq = b * 256 + qb * 64 + wave * 16;
      bf16x8 qf[3]; load_q_mla(qf, p.qb + (size_t)mq * 768 + h * 96, l15, q4, false, 0);
      at_run_plain<3>(st, qf, p.kb + (size_t)(b * 256) * 768 + h * 96, 768, p.vtb_p + (size_t)((b * 8 + h) * 64) * 256, 256, 4, scaleB, lds, tid, l15, q4);
      attn_fin(st, p.mix + (size_t)mq * 1024 + 512 + h * 64, l15, q4);
    } else {
      int u = bt - 1024;
      int qb = u & 3, h = (u >> 2) & 7, b = u >> 5;
      int mq = b * 256 + qb * 64 + wave * 16;
      bf16x8 qf[2]; load_q64(qf, p.qa + (size_t)mq * 512 + h * 64, 512, l15, q4);
      at_run_plain<2>(st, qf, p.ka + (size_t)(b * 256) * 512 + h * 64, 512, p.vta_p + (size_t)((b * 8 + h) * 64) * 256, 256, 4, 0.125f, lds, tid, l15, q4);
      attn_fin(st, p.mix + (size_t)mq * 1024 + h * 64, l15, q4);
    }
  }
}

__device__ __forceinline__ int mslot(int sq, int h, int dir, int j) {
  return sq < 16 ? ((sq * 4 + h) * 2 + dir) * 4 + j : 512 + (((sq - 16) * 4 + h) * 2 + dir) * 16 + j;
}

__device__ __forceinline__ void mlstm1_task(PRM p, int o, int task, float* sm) {
  const int tid = get_tid(), lane = tid & 63, wave = tid >> 6;
  int sq, h, dir, j;
  if (task < 512) { j = task & 3; dir = (task >> 2) & 1; h = (task >> 3) & 3; sq = task >> 5; }
  else { int u = task - 512; j = u & 15; dir = (u >> 4) & 1; h = (u >> 5) & 3; sq = 16 + (u >> 7); }
  const int T = sq < 16 ? 256 : 1024;
  const int base = sq < 16 ? sq * 256 : NPR + (sq - 16) * 1024;
  const int slot = task;
  float* ks = sm;
  float* vs = sm + 4096;
  float* wg = sm + 4096 + 8192;
  if (wave == 0) {
    int s = 64 * j + lane;
    int t = dir ? T - 1 - s : s;
    const float* row = p.proj + (size_t)(base + t) * 2432 + 1536;
    float ig = row[(dir * 2 + 0) * 4 + h] + p.c_gate_bias[o * 16 + (dir * 2 + 0) * 4 + h];
    float fg = row[(dir * 2 + 1) * 4 + h] + p.c_gate_bias[o * 16 + (dir * 2 + 1) * 4 + h];
    float bsum = logsig_f(fg);
#pragma unroll
    for (int off = 1; off < 64; off <<= 1) { float v = __shfl_up(bsum, off); if (lane >= off) bsum += v; }
    float blast = __shfl(bsum, 63);
    float g = blast - bsum + ig;
    float ml = wmaxr(g);
    wg[lane] = __expf(g - ml);
    if (lane == 0) { p.dm[slot * 2] = ml; p.dm[slot * 2 + 1] = blast; }
  }
#pragma unroll
  for (int ii = 0; ii < 4; ++ii) {
    int i = (tid >> 4) + 16 * ii, c4 = tid & 15;
    int s = 64 * j + i; int t = dir ? T - 1 - s : s;
    float4 v = *(const float4*)(p.proj + (size_t)(base + t) * 2432 + 256 + h * 64 + c4 * 4);
    v.x *= 0.125f; v.y *= 0.125f; v.z *= 0.125f; v.w *= 0.125f;
    *(float4*)(ks + i * 64 + c4 * 4) = v;
  }
#pragma unroll
  for (int ii = 0; ii < 8; ++ii) {
    int i = (tid >> 5) + 8 * ii, c4 = tid & 31;
    int s = 64 * j + i; int t = dir ? T - 1 - s : s;
    *(float4*)(vs + i * 128 + c4 * 4) = *(const float4*)(p.proj + (size_t)(base + t) * 2432 + 512 + h * 128 + c4 * 4);
  }
  __syncthreads();
  const int dg = tid & 15, vg8 = tid >> 4;
  f32x4 acc[8];
#pragma unroll
  for (int q = 0; q < 8; ++q) acc[q] = (f32x4){0.f, 0.f, 0.f, 0.f};
  f32x4 nacc = {0.f, 0.f, 0.f, 0.f};
#pragma unroll 4
  for (int i = 0; i < 64; ++i) {
    f32x4 kd = *(const f32x4*)(ks + i * 64 + dg * 4) * wg[i];
    nacc += kd;
    f32x4 va = *(const f32x4*)(vs + i * 128 + vg8 * 8);
    f32x4 vb = *(const f32x4*)(vs + i * 128 + vg8 * 8 + 4);
    acc[0] += kd * va[0]; acc[1] += kd * va[1]; acc[2] += kd * va[2]; acc[3] += kd * va[3];
    acc[4] += kd * vb[0]; acc[5] += kd * vb[1]; acc[6] += kd * vb[2]; acc[7] += kd * vb[3];
  }
  float* dc = p.dC + (size_t)slot * 8192;
#pragma unroll
  for (int q = 0; q < 8; ++q) *(f32x4*)(dc + (vg8 * 8 + q) * 64 + dg * 4) = acc[q];
  if (vg8 == 0) *(f32x4*)(p.dn + slot * 64 + dg * 4) = nacc;
  __syncthreads();
}

__device__ __forceinline__ void mlstm2_task(PRM p, int o, int task, float* sm) {
  const int tid = get_tid(), lane = tid & 63, wave = tid >> 6;
  int sq, h, c;
  if (task < 256) { c = task & 3; h = (task >> 2) & 3; sq = task >> 4; }
  else { int u = task - 256; c = u & 15; h = (u >> 4) & 3; sq = 16 + (u >> 6); }
  const bool pr = sq < 16;
  const int nc = pr ? 4 : 16;
  const int base = (pr ? sq * 256 : NPR + (sq - 16) * 1024) + c * 64;
  float* qT = sm;
  float* kT = sm + 4352;
  float* CT = kT;
  float* St = sm + 2 * 4352;
  float* vh = sm + 3 * 4352;
  float* smalls = sm + 4 * 4352;
  float* bl = smalls;
  float* itb = smalls + 64;
  float* mt = smalls + 128;
  float* w0 = smalls + 192;
  float* nv = smalls + 256;
  float* nq = smalls + 320;
  float* den = smalls + 384;
  float* scal = smalls + 448;

  const int tl = tid >> 4, tx = tid & 15;
  const int l0 = tl * 4, x0 = tx * 4;
  float hacc[2][4][4];
#pragma unroll
  for (int a = 0; a < 2; ++a)
#pragma unroll
    for (int b2 = 0; b2 < 4; ++b2)
#pragma unroll
      for (int c2 = 0; c2 < 4; ++c2) hacc[a][b2][c2] = 0.f;

  f32x4 qv[4], kv[4];
#pragma unroll
  for (int ii = 0; ii < 4; ++ii) {
    int i = (tid >> 4) + 16 * ii, c4 = tid & 15;
    const float* row = p.proj + (size_t)(base + i) * 2432 + h * 64 + c4 * 4;
    qv[ii] = *(const f32x4*)row;
    kv[ii] = *(const f32x4*)(row + 256);
  }
#pragma unroll
  for (int ii = 0; ii < 4; ++ii) {
    int i = (tid >> 4) + 16 * ii, c4 = tid & 15;
    qT[(c4 * 4 + 0) * 68 + i] = qv[ii].x; qT[(c4 * 4 + 1) * 68 + i] = qv[ii].y; qT[(c4 * 4 + 2) * 68 + i] = qv[ii].z; qT[(c4 * 4 + 3) * 68 + i] = qv[ii].w;
  }
#pragma unroll 1
  for (int dir = 0; dir < 2; ++dir) {
    const int j = dir ? nc - 1 - c : c;
    const int slj = mslot(sq, h, dir, j);
    const float mprev = p.mp[slj];
    float cr[16]; f32x4 vr[4];
    const float* cpp = p.cp + (size_t)slj * 8192;
#pragma unroll
    for (int r = 0; r < 16; ++r) cr[r] = cpp[tid + 256 * r];
#pragma unroll
    for (int ii = 0; ii < 4; ++ii) {
      int i = (tid >> 4) + 16 * ii, c4 = tid & 15;
      vr[ii] = *(const f32x4*)(p.proj + (size_t)(base + i) * 2432 + 512 + h * 128 + c4 * 4);
    }
    if (wave == 0) {
      const int i = lane;
      const int tau = dir ? 63 - i : i;
      const float* row = p.proj + (size_t)(base + tau) * 2432 + 1536;
      float ig = row[(dir * 2 + 0) * 4 + h] + p.c_gate_bias[o * 16 + (dir * 2 + 0) * 4 + h];
      float fg = row[(dir * 2 + 1) * 4 + h] + p.c_gate_bias[o * 16 + (dir * 2 + 1) * 4 + h];
      float bsum = logsig_f(fg);
#pragma unroll
      for (int off = 1; off < 64; off <<= 1) { float v = __shfl_up(bsum, off); if (lane >= off) bsum += v; }
      float ib = ig - bsum;
      float pm = ib;
#pragma unroll
      for (int off = 1; off < 64; off <<= 1) { float v = __shfl_up(pm, off); if (lane >= off) pm = fmaxf(pm, v); }
      float mti = fmaxf(bsum + mprev, bsum + pm);
      bl[tau] = bsum; itb[tau] = ib; mt[tau] = mti; w0[tau] = __expf(bsum + mprev - mti);
    }
#pragma unroll
    for (int ii = 0; ii < 4; ++ii) {
      int i = (tid >> 4) + 16 * ii, c4 = tid & 15;
      kT[(c4 * 4 + 0) * 68 + i] = kv[ii].x * 0.125f; kT[(c4 * 4 + 1) * 68 + i] = kv[ii].y * 0.125f;
      kT[(c4 * 4 + 2) * 68 + i] = kv[ii].z * 0.125f; kT[(c4 * 4 + 3) * 68 + i] = kv[ii].w * 0.125f;
    }
    if (tid < 64) nv[tid] = p.np[slj * 64 + tid];
    __syncthreads();
    {
      float a[4][4];
#pragma unroll
      for (int r = 0; r < 4; ++r)
#pragma unroll
        for (int q = 0; q < 4; ++q) a[r][q] = 0.f;
#pragma unroll 2
      for (int d = 0; d < 64; ++d) {
        float4 q4v = *(const float4*)(qT + d * 68 + l0);
        float4 k4v = *(const float4*)(kT + d * 68 + x0);
        float qa[4] = {q4v.x, q4v.y, q4v.z, q4v.w}, kk[4] = {k4v.x, k4v.y, k4v.z, k4v.w};
#pragma unroll
        for (int r = 0; r < 4; ++r)
#pragma unroll
          for (int q = 0; q < 4; ++q) a[r][q] = fmaf(qa[r], kk[q], a[r][q]);
      }
      float rsum[4];
#pragma unroll
      for (int r = 0; r < 4; ++r) {
        const int l = l0 + r;
        const float bll = bl[l], mtl = mt[l];
        rsum[r] = 0.f;
#pragma unroll
        for (int q = 0; q < 4; ++q) {
          const int s = x0 + q;
          const bool ok = dir ? (s >= l) : (s <= l);
          float sv = ok ? a[r][q] * __expf(bll + itb[s] - mtl) : 0.f;
          St[s * 68 + l] = sv;
          rsum[r] += sv;
        }
        rsum[r] += shx(rsum[r], 1); rsum[r] += shx(rsum[r], 2);
        rsum[r] += shx(rsum[r], 4); rsum[r] += shx(rsum[r], 8);
        if (tx == 0) den[l] = rsum[r];
      }
    }
    __syncthreads();
    if (tid < 64) {
      float s = 0.f;
#pragma unroll 4
      for (int d = 0; d < 64; ++d) s = fmaf(qT[d * 68 + tid], nv[d], s);
      nq[tid] = s;
    }
#pragma unroll 1
    for (int vhalf = 0; vhalf < 2; ++vhalf) {
#pragma unroll
      for (int r = 0; r < 16; ++r) {
        int e = tid + 256 * r;
        CT[(e & 63) * 68 + (e >> 6)] = cr[r];
      }
#pragma unroll
      for (int ii = 0; ii < 4; ++ii) {
        int i = (tid >> 4) + 16 * ii, c4 = tid & 15;
        *(f32x4*)(vh + i * 68 + c4 * 4) = vr[ii];
      }
      if (vhalf == 0) {
#pragma unroll
        for (int r = 0; r < 16; ++r) cr[r] = cpp[4096 + tid + 256 * r];
#pragma unroll
        for (int ii = 0; ii < 4; ++ii) {
          int i = (tid >> 4) + 16 * ii, c4 = tid & 15;
          vr[ii] = *(const f32x4*)(p.proj + (size_t)(base + i) * 2432 + 512 + h * 128 + 64 + c4 * 4);
        }
      }
      __syncthreads();
      {
        float a1[4][4], a2[4][4];
#pragma unroll
        for (int r = 0; r < 4; ++r)
#pragma unroll
          for (int q = 0; q < 4; ++q) { a1[r][q] = 0.f; a2[r][q] = 0.f; }
#pragma unroll 2
        for (int s = 0; s < 64; ++s) {
          float4 sa = *(const float4*)(St + s * 68 + l0);
          float4 vb = *(const float4*)(vh + s * 68 + x0);
          float4 qa4 = *(const float4*)(qT + s * 68 + l0);
          float4 cb4 = *(const float4*)(CT + s * 68 + x0);
          float sl4[4] = {sa.x, sa.y, sa.z, sa.w}, vv[4] = {vb.x, vb.y, vb.z, vb.w};
          float qq[4] = {qa4.x, qa4.y, qa4.z, qa4.w}, cc[4] = {cb4.x, cb4.y, cb4.z, cb4.w};
#pragma unroll
          for (int r = 0; r < 4; ++r)
#pragma unroll
            for (int q = 0; q < 4; ++q) { a1[r][q] = fmaf(sl4[r], vv[q], a1[r][q]); a2[r][q] = fmaf(qq[r], cc[q], a2[r][q]); }
        }
#pragma unroll
        for (int r = 0; r < 4; ++r) {
          const int l = l0 + r;
          const float w = w0[l];
          const float dn_ = den[l] + w * nq[l];
          const float dd = fmaxf(fabsf(dn_), __expf(-mt[l]));
          const float inv = 1.f / dd;
#pragma unroll
          for (int q = 0; q < 4; ++q) { float hv = (a1[r][q] + w * a2[r][q]) * inv; if (vhalf == 0) hacc[0][r][q] += hv; else hacc[1][r][q] += hv; }
        }
      }
      __syncthreads();
    }
  }
#pragma unroll
  for (int r = 0; r < 4; ++r) {
    float ss = 0.f;
#pragma unroll
    for (int a = 0; a < 2; ++a)
#pragma unroll
      for (int q = 0; q < 4; ++q) ss += hacc[a][r][q] * hacc[a][r][q];
    ss += shx(ss, 1); ss += shx(ss, 2); ss += shx(ss, 4); ss += shx(ss, 8);
    const float rn = rsqrtf(ss * (1.f / 128.f) + EPS);
    const int m = base + l0 + r;
#pragma unroll
    for (int a = 0; a < 2; ++a) {
      const int v0 = a * 64 + x0;
      float4 co = *(const float4*)(p.proj + (size_t)m * 2432 + 1024 + h * 128 + v0);
      float4 gn = *(const float4*)(p.c_out_norm + (size_t)(o * 4 + h) * 128 + v0);
      float y0 = sigmoid_f(co.x) * hacc[a][r][0] * rn * gn.x;
      float y1 = sigmoid_f(co.y) * hacc[a][r][1] * rn * gn.y;
      float y2 = sigmoid_f(co.z) * hacc[a][r][2] * rn * gn.z;
      float y3 = sigmoid_f(co.w) * hacc[a][r][3] * rn * gn.w;
      uint2 oo; oo.x = pack2(y0, y1); oo.y = pack2(y2, y3);
      *(uint2*)(p.mix + (size_t)m * 1024 + h * 128 + v0) = oo;
    }
  }
  __syncthreads();
}

__device__ __forceinline__ void mlstm2_mfma(PRM p, int o, int task, char* smem) {
  const int tid = get_tid(), lane = tid & 63, wave = tid >> 6, l15 = lane & 15, q4 = lane >> 4;
  int sq, h, c;
  if (task < 256) { c = task & 3; h = (task >> 2) & 3; sq = task >> 4; }
  else { int u = task - 256; c = u & 15; h = (u >> 4) & 3; sq = 16 + (u >> 6); }
  const bool pr = sq < 16;
  const int nc = pr ? 4 : 16;
  const int base = (pr ? sq * 256 : NPR + (sq - 16) * 1024) + c * 64;
  u16* Qb = (u16*)smem;
  u16* Kb = Qb + 64 * 72;
  u16* Vt = Kb + 64 * 72;
  u16* Cb = Vt + 128 * 72;
  float* sml = (float*)(Cb + 128 * 72);
  float* bl = sml; float* itb = sml + 64; float* mt = sml + 128; float* w0 = sml + 192; float* nv = sml + 256;
#pragma unroll
  for (int ii = 0; ii < 4; ++ii) {
    int i = (tid >> 4) + 16 * ii, c4 = tid & 15;
    const float* row = p.proj + (size_t)(base + i) * 2432 + h * 64 + c4 * 4;
    f32x4 qv = *(const f32x4*)row;
    f32x4 kv = *(const f32x4*)(row + 256);
    uint2 a; a.x = pack2(qv[0], qv[1]); a.y = pack2(qv[2], qv[3]);
    uint2 b; b.x = pack2(kv[0] * 0.125f, kv[1] * 0.125f); b.y = pack2(kv[2] * 0.125f, kv[3] * 0.125f);
    *(uint2*)(Qb + i * 72 + c4 * 4) = a;
    *(uint2*)(Kb + i * 72 + c4 * 4) = b;
  }
#pragma unroll
  for (int ii = 0; ii < 8; ++ii) {
    int i = (tid >> 5) + 8 * ii, c4 = tid & 31;
    f32x4 vv = *(const f32x4*)(p.proj + (size_t)(base + i) * 2432 + 512 + h * 128 + c4 * 4);
    unsigned w01 = pack2(vv[0], vv[1]), w23 = pack2(vv[2], vv[3]);
    Vt[(c4 * 4 + 0) * 72 + i] = (u16)(w01 & 0xffffu); Vt[(c4 * 4 + 1) * 72 + i] = (u16)(w01 >> 16);
    Vt[(c4 * 4 + 2) * 72 + i] = (u16)(w23 & 0xffffu); Vt[(c4 * 4 + 3) * 72 + i] = (u16)(w23 >> 16);
  }
  f32x4 hacc[8];
#pragma unroll
  for (int vt = 0; vt < 8; ++vt) hacc[vt] = (f32x4){0.f, 0.f, 0.f, 0.f};
  const int lrow = wave * 16 + l15;
#pragma unroll 1
  for (int dir = 0; dir < 2; ++dir) {
    const int j = dir ? nc - 1 - c : c;
    const int slj = mslot(sq, h, dir, j);
    const float mprev = p.mp[slj];
    {
      const f32x4* cpp = (const f32x4*)(p.cp + (size_t)slj * 8192);
#pragma unroll
      for (int r = 0; r < 8; ++r) {
        int e4 = tid + 256 * r;
        f32x4 cv = cpp[e4];
        uint2 a; a.x = pack2(cv[0], cv[1]); a.y = pack2(cv[2], cv[3]);
        *(uint2*)(Cb + (e4 >> 4) * 72 + (e4 & 15) * 4) = a;
      }
    }
    if (tid < 64) nv[tid] = p.np[slj * 64 + tid];
    if (wave == 0) {
      const int i = lane;
      const int tau = dir ? 63 - i : i;
      const float* row = p.proj + (size_t)(base + tau) * 2432 + 1536;
      float ig = row[(dir * 2 + 0) * 4 + h] + p.c_gate_bias[o * 16 + (dir * 2 + 0) * 4 + h];
      float fg = row[(dir * 2 + 1) * 4 + h] + p.c_gate_bias[o * 16 + (dir * 2 + 1) * 4 + h];
      float bsum = logsig_f(fg);
#pragma unroll
      for (int off = 1; off < 64; off <<= 1) { float v = __shfl_up(bsum, off); if (lane >= off) bsum += v; }
      float ib = ig - bsum;
      float pm = ib;
#pragma unroll
      for (int off = 1; off < 64; off <<= 1) { float v = __shfl_up(pm, off); if (lane >= off) pm = fmaxf(pm, v); }
      float mti = fmaxf(bsum + mprev, bsum + pm);
      bl[tau] = bsum; itb[tau] = ib; mt[tau] = mti; w0[tau] = __expf(bsum + mprev - mti);
    }
    __syncthreads();
    const float bll = bl[lrow], mtl = mt[lrow], w0l = w0[lrow];
    bf16x8 qf[2];
#pragma unroll
    for (int ks = 0; ks < 2; ++ks) qf[ks] = *(const bf16x8*)(Qb + lrow * 72 + ks * 32 + q4 * 8);
    float nqp = 0.f;
#pragma unroll
    for (int ks = 0; ks < 2; ++ks)
#pragma unroll
      for (int jj = 0; jj < 8; ++jj) {
        float qe = __uint_as_float(((unsigned)(unsigned short)qf[ks][jj]) << 16);
        nqp = fmaf(qe, nv[ks * 32 + q4 * 8 + jj], nqp);
      }
    nqp += shx(nqp, 16); nqp += shx(nqp, 32);
    f32x4 oacc[8];
#pragma unroll
    for (int vt = 0; vt < 8; ++vt) {
      oacc[vt] = (f32x4){0.f, 0.f, 0.f, 0.f};
#pragma unroll
      for (int ks = 0; ks < 2; ++ks) {
        bf16x8 a = *(const bf16x8*)(Cb + (vt * 16 + l15) * 72 + ks * 32 + q4 * 8);
        oacc[vt] = mfma16(a, qf[ks], oacc[vt]);
      }
      oacc[vt] *= w0l;
    }
    float sv[16];
    float dsum = 0.f;
#pragma unroll
    for (int st = 0; st < 4; ++st) {
      f32x4 sa = {0.f, 0.f, 0.f, 0.f};
#pragma unroll
      for (int ks = 0; ks < 2; ++ks) {
        bf16x8 a = *(const bf16x8*)(Kb + (st * 16 + l15) * 72 + ks * 32 + q4 * 8);
        sa = mfma16(a, qf[ks], sa);
      }
#pragma unroll
      for (int r = 0; r < 4; ++r) {
        const int sidx = st * 16 + q4 * 4 + r;
        const bool ok = dir ? (sidx >= lrow) : (sidx <= lrow);
        float val = ok ? sa[r] * __expf(bll + itb[sidx] - mtl) : 0.f;
        sv[st * 4 + r] = val;
        dsum += val;
      }
    }
    dsum += shx(dsum, 16); dsum += shx(dsum, 32);
    bf16x8 pf[2];
#pragma unroll
    for (int hf = 0; hf < 2; ++hf) {
      u32x4 pw;
      pw[0] = pack2(sv[hf * 8 + 0], sv[hf * 8 + 1]); pw[1] = pack2(sv[hf * 8 + 2], sv[hf * 8 + 3]);
      pw[2] = pack2(sv[hf * 8 + 4], sv[hf * 8 + 5]); pw[3] = pack2(sv[hf * 8 + 6], sv[hf * 8 + 7]);
      pf[hf] = __builtin_bit_cast(bf16x8, pw);
    }
    const float dn_ = dsum + w0l * nqp;
    const float inv = 1.f / fmaxf(fabsf(dn_), __expf(-mtl));
#pragma unroll
    for (int vt = 0; vt < 8; ++vt) {
#pragma unroll
      for (int hf = 0; hf < 2; ++hf) {
        const u16* vp = Vt + (vt * 16 + l15) * 72 + hf * 32 + q4 * 4;
        s16x4 v0 = *(const s16x4*)vp;
        s16x4 v1 = *(const s16x4*)(vp + 16);
        bf16x8 vf = (bf16x8){v0.x, v0.y, v0.z, v0.w, v1.x, v1.y, v1.z, v1.w};
        oacc[vt] = mfma16(vf, pf[hf], oacc[vt]);
      }
      hacc[vt] += oacc[vt] * inv;
    }
    __syncthreads();
  }
  float ss = 0.f;
#pragma unroll
  for (int vt = 0; vt < 8; ++vt)
#pragma unroll
    for (int r = 0; r < 4; ++r) ss += hacc[vt][r] * hacc[vt][r];
  ss += shx(ss, 16); ss += shx(ss, 32);
  const float rn = rsqrtf(ss * (1.f / 128.f) + EPS);
  const int m = base + lrow;
#pragma unroll
  for (int vt = 0; vt < 8; ++vt) {
    const int v0 = vt * 16 + q4 * 4;
    f32x4 co = *(const f32x4*)(p.proj + (size_t)m * 2432 + 1024 + h * 128 + v0);
    f32x4 gn = *(const f32x4*)(p.c_out_norm + (size_t)(o * 4 + h) * 128 + v0);
    float y0 = sigmoid_f(co[0]) * hacc[vt][0] * rn * gn[0];
    float y1 = sigmoid_f(co[1]) * hacc[vt][1] * rn * gn[1];
    float y2 = sigmoid_f(co[2]) * hacc[vt][2] * rn * gn[2];
    float y3 = sigmoid_f(co[3]) * hacc[vt][3] * rn * gn[3];
    uint2 oo; oo.x = pack2(y0, y1); oo.y = pack2(y2, y3);
    *(uint2*)(p.mix + (size_t)m * 1024 + h * 128 + v0) = oo;
  }
  __syncthreads();
}

__device__ __forceinline__ void mlstm_scan_phase(PRM p, int o) {
  const int tid = get_tid();
  for (int pos = get_bid(); pos < 576; pos += vgrid()) {
    const int task = pos < 448 ? pos : (pos < 512 ? pos + 64 : pos - 64);
    const int sc = task >> 2, slice = task & 3;
    int sq, h, dir;
    if (sc < 128) { sq = sc >> 3; h = (sc >> 1) & 3; dir = sc & 1; }
    else { int u = sc - 128; sq = 16 + (u >> 3); h = (u >> 1) & 3; dir = u & 1; }
    const bool pr = sq < 16;
    const int nc = pr ? 4 : 16;
    const int sidx = pr ? ((sq * 2 + o) * 2 + dir) * 4 + h : 0;
    const int cidx = pr ? 0 : (((sq - 16) * 2 + o) * 2 + dir) * 4 + h;
    const int e0 = slice * 2048 + tid;
    float C[8];
#pragma unroll
    for (int r = 0; r < 8; ++r) C[r] = pr ? 0.f : p.state_C[(size_t)cidx * 8192 + e0 + 256 * r];
    const bool nthr = (slice == 0) && (tid < 64);
    float n = (pr || !nthr) ? 0.f : p.state_n[cidx * 64 + tid];
    float m = pr ? 0.f : p.state_m[cidx];
#pragma unroll 4
    for (int j = 0; j < nc; ++j) {
      const int sl = mslot(sq, h, dir, j);
      float* cp = p.cp + (size_t)sl * 8192 + e0;
      const float* dc = p.dC + (size_t)sl * 8192 + e0;
#pragma unroll
      for (int r = 0; r < 8; ++r) cp[256 * r] = C[r];
      if (nthr) { p.np[sl * 64 + tid] = n; if (tid == 0) p.mp[sl] = m; }
      const float ml = p.dm[sl * 2], bls = p.dm[sl * 2 + 1];
      const float mn = fmaxf(bls + m, ml);
      const float ca = __expf(bls + m - mn), cb = __expf(ml - mn);
#pragma unroll
      for (int r = 0; r < 8; ++r) C[r] = ca * C[r] + cb * dc[256 * r];
      if (nthr) n = ca * n + cb * p.dn[sl * 64 + tid];
      m = mn;
    }
    if (pr) {
      float* oc = p.out + O_CC + (size_t)sidx * 8192 + e0;
#pragma unroll
      for (int r = 0; r < 8; ++r) oc[256 * r] = C[r];
      if (nthr) { p.out[O_CN + (size_t)sidx * 64 + tid] = n; if (tid == 0) p.out[O_CM + sidx] = m; }
    }
  }
}

__device__ __forceinline__ void odd_mid_phase(PRM p, int o, char* smem) {
  u16* lds = (u16*)smem;
  const int tid = get_tid(), lane = tid & 63, wave = tid >> 6, l15 = lane & 15, q4 = lane >> 4;
  for (int bt = get_bid(); bt < 256 + 768 + 512; bt += vgrid()) {
    if (bt < 256) {
      int qb = bt & 15, hq = (bt >> 4) & 7, b = bt >> 7;
      int kvh = hq >> 2;
      int mq = NPR + b * 1024 + qb * 64 + wave * 16;
      AttnSt st; attn_init(st);
      bf16x8 qf[2]; load_q64(qf, p.qa + (size_t)mq * 512 + hq * 64, 512, l15, q4);
      at_run_plain<2>(st, qf, p.kd + (size_t)(NPR + b * 1536) * 128 + kvh * 64, 128, p.vtd_s + (size_t)((b * 2 + kvh) * 64) * 1536, 1536, 24, 0.125f, lds, tid, l15, q4);
      attn_fin(st, p.mix + (size_t)mq * 1024 + 512 + hq * 64, l15, q4);
    } else if (bt < 256 + 768) {
      mlstm1_task(p, o, bt - 256, (float*)smem);
    } else {
      int u = bt - 1024;
      int qb = u & 3, hq = (u >> 2) & 7, b = u >> 5;
      int kvh = hq >> 2;
      int mq = b * 256 + qb * 64 + wave * 16;
      AttnSt st; attn_init(st);
      bf16x8 qf[2]; load_q64(qf, p.qa + (size_t)mq * 512 + hq * 64, 512, l15, q4);
      at_run_plain<2>(st, qf, p.kd + (size_t)(b * 256) * 128 + kvh * 64, 128, p.vtd_p + (size_t)((b * 2 + kvh) * 64) * 256, 256, 4, 0.125f, lds, tid, l15, q4);
      attn_fin(st, p.mix + (size_t)mq * 1024 + 512 + hq * 64, l15, q4);
    }
  }
}

__device__ __forceinline__ void run_phase(PRM p, int ph, char* smem) {
  char* vsm = smem + (rtid() >> 8) * LDS_HALF;
  if (ph == 0) { phase0(p, vsm); return; }
  if (ph == NPHASE - 1) { norm_phase(p, 0, 3); return; }
  const int l = (ph - 1) / 13, s = (ph - 1) % 13;
  const int eo = l >> 1;
  const bool even = (l & 1) == 0;
  EpiP e{};
  const float* modl = p.mod + (size_t)l * 3 * 9216;
  switch (s) {
    case 0: norm_phase(p, l, 0); break;
    case 1: e.H = p.h; ffn_in_phase(p, l, 0, e, smem); break;
    case 2: e.C = p.x; e.gate = modl + 2 * 1024; e.ldc = 1;
            if (l == 0) { e.vtp = (u16*)p.x_prompt; e.vts = (u16*)p.x_sample; }
            gemm_phase<EPI_RESID, 4, 2, 3, 4, 4>(p.h, p.wt_ffn_out + (size_t)(l * 2 + 0) * 1024 * 2816, 2816, 32, 8, e, smem); break;
    case 3: norm_phase(p, l, 1); break;
    case 4:
      if (even) { e.C = p.proj; e.ldc = 2688; gemm_phase<EPI_STORE, 4, 2, 4, 4, 2>(p.xn, p.wt_in_e + (size_t)eo * 2688 * 1024, 1024, 24, 21, e, smem); }
      else { e.C = p.proj; e.ldc = 2432; gemm_phase<EPI_STORE, 4, 2, 4, 4, 2>(p.xn, p.wt_in_o + (size_t)eo * 2432 * 1024, 1024, 24, 19, e, smem); }
      break;
    case 5: if (even) post_even(p, eo); else post_odd(p, eo); break;
    case 6:
      if (even) {
        EpiP eq{}; eq.C = p.qb; eq.ldc = 768;
        EpiP ek{}; ek.kb = p.kb; ek.vtp = p.vtb_p; ek.vts = p.vtb_s; ek.ctx = 0;
        EpiP ec = ek; ec.ctx = 1;
        const u16* wq = p.wt_qup + (size_t)eo * 768 * 768;
        const u16* wk = p.wt_kvup + (size_t)eo * 1024 * 256;
        const int G = (int)gridDim.x, b0 = rbid();
        const int nslot = (G == 256) ? 3 : (736 + G - 1) / G;
        for (int k = 0; k < nslot; ++k) {
          int t;
          if (G == 256) {
            if (k == 0) t = b0;
            else if (b0 < 32) { if (k > 1) break; t = 256 + b0; }
            else t = 288 + (b0 - 32) * 2 + (k - 1);
          } else { t = b0 + k * G; if (t >= 736) break; }
          if (t < 288) gemm_tile<EPI_STORE, 4, 2, 2, 4, 2>(p.cqn, wq, 768, t % 48, t / 48, eq, smem);
          else if (t < 672) { int u = t - 288; gemm_tile<EPI_KVUP, 4, 2, 2, 4, 2>(p.ckvn, wk, 256, u % 48, u / 48, ek, smem); }
          else { int u = t - 672; gemm_tile<EPI_KVUP, 4, 2, 2, 4, 2>(p.cctxn, wk, 256, u % 8, u / 8, ec, smem); }
        }
      } else odd_mid_phase(p, eo, vsm);
      break;
    case 7: if (!even) mlstm_scan_phase(p, eo); break;
    case 8:
      if (even) attn_even_phase(p, eo, vsm);
      else { for (int t = get_bid(); t < 384; t += vgrid()) mlstm2_mfma(p, eo, t, vsm); }
      break;
    case 9: e.C = p.x; e.gate = modl + 5 * 1024; e.ldc = 0;
            gemm_phase<EPI_RESID, 4, 2, 3, 4, 2>(p.mix, p.wt_out + (size_t)l * 1024 * 1024, 1024, 32, 8, e, smem); break;
    case 10: norm_phase(p, l, 2); break;
    case 11: e.H = p.h; ffn_in_phase(p, l, 1, e, smem); break;
    case 12: e.C = p.x; e.gate = modl + 8 * 1024; e.ldc = 1;
             gemm_phase<EPI_RESID, 4, 2, 3, 4, 4>(p.h, p.wt_ffn_out + (size_t)(l * 2 + 1) * 1024 * 2816, 2816, 32, 8, e, smem); break;
  }
}

__global__ void __launch_bounds__(512, 2) mega(Params p) {
  __shared__ __attribute__((aligned(16))) char smem[LDS_BYTES];
  __shared__ uint4 xb_words;
  cg::grid_group grid = cg::this_grid();
  if (threadIdx.x == 0) xb_words = make_uint4(0u, 0u, 0u, 0u);
  __syncthreads();
  XcdBarrier xb = xcd_barrier_post(p.bar, (volatile LAS unsigned*)&xb_words);
  for (int ph = p.ph0; ph < p.ph1; ++ph) {
    const __attribute__((address_space(4))) Params* pp = (const __attribute__((address_space(4))) Params*)__builtin_amdgcn_kernarg_segment_ptr();
    asm volatile("" : "+s"(pp));
    run_phase(*pp, ph, smem);
#ifndef REPMASK
#define REPMASK 0
#endif
#ifndef REPPAR
#define REPPAR 0
#endif
    if (REPMASK) {
      int bit = ph == 0 ? 13 : (ph == NPHASE - 1 ? 14 : (ph - 1) % 13);
      int lay = (ph - 1) / 13;
      bool parok = REPPAR == 0 || ph == 0 || ph == NPHASE - 1 || (REPPAR == 1 && (lay & 1) == 0) || (REPPAR == 2 && (lay & 1) == 1);
      if (((REPMASK >> bit) & 1) && parok) { xcd_barrier(xb); asm volatile("" : "+s"(pp)); run_phase(*pp, ph, smem); }
    }
    if (ph + 1 < p.ph1) {
      if (p.ph1 > 100000) grid.sync();
      xcd_barrier(xb);
    }
  }
}

extern "C" void kernel_launch(void* const* d_in, const int* in_sizes, int n_in, void* d_out, int out_size, void* d_ws, size_t ws_size,
                              hipStream_t stream) {
  static int grid_blocks = 0;
  if (!grid_blocks) {
    int dev = 0, cus = 0, per_cu = 0;
    hipGetDevice(&dev);
    hipDeviceGetAttribute(&cus, hipDeviceAttributeMultiprocessorCount, dev);
    hipOccupancyMaxActiveBlocksPerMultiprocessor(&per_cu, mega, 512, 0);
    per_cu = 1;
    grid_blocks = cus * per_cu;
  }
  Params p{};
  const float** ip = (const float**)&p.x_prompt;
  for (int i = 0; i < 31; ++i) ip[i] = (const float*)d_in[i];
  p.out = (float*)d_out;
  char* w = (char*)d_ws;
  size_t off = 0;
  auto take = [&](size_t bytes) { char* r = w + off; off += (bytes + 255) & ~(size_t)255; return r; };
  p.wt_ffn_in = (u16*)take((size_t)8 * 5632 * 1024 * 2);
  p.wt_ffn_out = (u16*)take((size_t)8 * 1024 * 2816 * 2);
  p.wt_in_e = (u16*)take((size_t)2 * 2688 * 1024 * 2);
  p.wt_in_o = (u16*)take((size_t)2 * 2432 * 1024 * 2);
  p.wt_out = (u16*)take((size_t)4 * 1024 * 1024 * 2);
  p.wt_qup = (u16*)take((size_t)2 * 768 * 768 * 2);
  p.wt_kvup = (u16*)take((size_t)2 * 1024 * 256 * 2);
  p.mod = (float*)take((size_t)12 * 9216 * 4);
  p.x = (float*)take((size_t)NTOK * 1024 * 4);
  p.proj = (float*)take((size_t)NTOK * 2688 * 4);
  p.qb = (float*)take((size_t)NTOK * 768 * 4);
  p.dC = (float*)take((size_t)768 * 8192 * 4);
  p.dn = (float*)take((size_t)768 * 64 * 4);
  p.dm = (float*)take((size_t)768 * 2 * 4);
  p.cp = (float*)take((size_t)768 * 8192 * 4);
  p.np = (float*)take((size_t)768 * 64 * 4);
  p.mp = (float*)take((size_t)768 * 4);
  p.xn = (u16*)take((size_t)NTOK * 1024 * 2);
  p.h = (u16*)take((size_t)NTOK * 2816 * 2);
  p.mix = (u16*)take((size_t)NTOK * 1024 * 2);
  p.qa = (u16*)take((size_t)NTOK * 512 * 2);
  p.ka = (u16*)take((size_t)NTOK * 512 * 2);
  p.kactx = (u16*)take((size_t)1024 * 512 * 2);
  p.vta_p = (u16*)take((size_t)16 * 8 * 64 * 256 * 2);
  p.vta_s = (u16*)take((size_t)2 * 8 * 64 * 1536 * 2);
  p.kb = (u16*)take((size_t)7168 * 768 * 2);
  p.vtb_p = (u16*)take((size_t)16 * 8 * 64 * 256 * 2);
  p.vtb_s = (u16*)take((size_t)2 * 8 * 64 * 1536 * 2);
  p.cqn = (u16*)take((size_t)NTOK * 768 * 2);
  p.ckvn = (u16*)take((size_t)NTOK * 256 * 2);
  p.cctxn = (u16*)take((size_t)1024 * 256 * 2);
  p.kd = (u16*)take((size_t)7168 * 128 * 2);
  p.vtd_p = (u16*)take((size_t)16 * 2 * 64 * 256 * 2);
  p.vtd_s = (u16*)take((size_t)2 * 2 * 64 * 1536 * 2);
  p.bar = (unsigned*)take((size_t)XCD_BAR_WORDS * 4);
  if (off > ws_size) { fprintf(stderr, "kernel_launch: workspace too small: need %zu have %zu\n", off, ws_size); return; }
  hipMemsetAsync(p.bar, 0, (size_t)XCD_BAR_WORDS * 4, stream);
#if MULTI
  for (int ph = 0; ph < NPHASE; ++ph) {
    p.ph0 = ph; p.ph1 = ph + 1;
    hipLaunchKernelGGL(mega, dim3(grid_blocks), dim3(512), 0, stream, p);
  }
#else
  p.ph0 = 0; p.ph1 = NPHASE;
  void* args[] = {&p};
  hipError_t e = hipLaunchCooperativeKernel((void*)mega, dim3(grid_blocks), dim3(512), args, 0, stream);
  if (e != hipSuccess) fprintf(stderr, "cooperative launch failed: %s (grid %d)\n", hipGetErrorString(e), grid_blocks);
#endif
}
```
